# Optimizing an MI355X kernel written in HIP

```python
import jax
import jax.numpy as jnp
from jax import lax
import numpy as np

D_MODEL = 1024
BATCH = 8
SEQ = 4096
DEPTH = 2

CTX_LEN = 256
GRID_W = 64
HEAD_DIM = 64
ROPE_THETA = 10000.0
QBLK = 128
EPS = 1e-6

A_HEADS = (D_MODEL // 2) // HEAD_DIM
A_KV_HEADS = A_HEADS // 4
A_WIDTH = A_HEADS * HEAD_DIM
B_WIDTH = D_MODEL - A_WIDTH
CONV_WIDTH = 31
AB_IN = A_WIDTH + 2 * A_KV_HEADS * HEAD_DIM + 2 * B_WIDTH

C_HEADS = (D_MODEL // 2) // HEAD_DIM
C_KV_HEADS = C_HEADS // 4
C_WIDTH = C_HEADS * HEAD_DIM
WINDOW = 128
D_WIDTH = D_MODEL - C_WIDTH
POOL_SIZES = (2, 4, 8, 16)
POOL_GROUP_WIDTH = D_WIDTH // len(POOL_SIZES)
CD_IN = C_WIDTH + 2 * C_KV_HEADS * HEAD_DIM + D_WIDTH

N_EXPERT_GROUPS = 4
EXPERTS_PER_GROUP = 8
N_EXPERTS = N_EXPERT_GROUPS * EXPERTS_PER_GROUP
TOP_K_INNER = 2
D_EXPERT = D_MODEL // 2
MOE_BLOCK = 128

kernel_name = 'hybrid_dit_gqa_conformer_swa_pool_hmoe'


def _rmsnorm(x, g):
    xf = x.astype(jnp.float32)
    y = xf * lax.rsqrt(jnp.mean(xf * xf, axis=-1, keepdims=True) + EPS)
    return (y * g.astype(jnp.float32)).astype(x.dtype)


def _modulate(h, shift, scale):
    return h * (1 + scale) + shift


def _rope_tables(n_lat):
    rows = n_lat // GRID_W
    row = jnp.repeat(jnp.arange(rows, dtype=jnp.float32), GRID_W)
    col = jnp.tile(jnp.arange(GRID_W, dtype=jnp.float32), rows)
    n_freq = HEAD_DIM // 4
    inv = ROPE_THETA ** (-jnp.arange(n_freq, dtype=jnp.float32) / n_freq)
    ang = jnp.concatenate([row[:, None] * inv, col[:, None] * inv], axis=-1)
    return jnp.cos(ang), jnp.sin(ang)


def _rope(x, cos, sin):
    half = HEAD_DIM // 2
    x1, x2 = x[..., :half], x[..., half:]
    c = cos.astype(x.dtype)
    s = sin.astype(x.dtype)
    return jnp.concatenate([x1 * c - x2 * s, x2 * c + x1 * s], axis=-1)


def _heads(t, n):
    b, s, _ = t.shape
    return t.reshape(b, s, n, HEAD_DIM).transpose(0, 2, 1, 3)


def _group(q, n_kv):
    b, h, s, d = q.shape
    return q.reshape(b, n_kv, h // n_kv, s, d)


def _merge(o):
    b, k, g, s, d = o.shape
    return o.transpose(0, 3, 1, 2, 4).reshape(b, s, k * g * d)


def _attend(q, k, v, mask, sink):
    s = jnp.einsum('bkgqd,bksd->bkgqs', q, k).astype(jnp.float32) * (HEAD_DIM ** -0.5)
    if mask is not None:
        s = jnp.where(mask, s, -jnp.inf)
    if sink is None:
        p = jax.nn.softmax(s, axis=-1)
    else:
        sk = jnp.broadcast_to(sink.astype(jnp.float32)[None, :, :, None, None], s.shape[:-1] + (1,))
        p = jax.nn.softmax(jnp.concatenate([s, sk], axis=-1), axis=-1)[..., :-1]
    return jnp.einsum('bkgqs,bksd->bkgqd', p.astype(v.dtype), v)


def _dense_attn_blocks(q, k, v):
    b, hk, g, s, d = q.shape
    nb = s // QBLK
    qb = jnp.moveaxis(q.reshape(b, hk, g, nb, QBLK, d), 3, 0)
    ob = lax.map(lambda qi: _attend(qi, k, v, None, None), qb)
    return jnp.moveaxis(ob, 0, 3).reshape(b, hk, g, s, d)


def _window_attn_blocks(q, k_lat, v_lat, k_ctx, v_ctx, sink):
    b, hk, g, s, d = q.shape
    nb = s // QBLK
    span = QBLK + 2 * WINDOW
    n_ctx = k_ctx.shape[2]
    pad = ((0, 0), (0, 0), (WINDOW, WINDOW), (0, 0))
    kp = jnp.pad(k_lat, pad)
    vp = jnp.pad(v_lat, pad)
    qb = jnp.moveaxis(q.reshape(b, hk, g, nb, QBLK, d), 3, 0)
    r = jnp.arange(QBLK)
    j = jnp.arange(span)
    ctx_mask = jnp.ones((QBLK, n_ctx), dtype=bool)

    def block(args):
        qi, i = args
        start = i * QBLK
        kw = lax.dynamic_slice_in_dim(kp, start, span, axis=2)
        vw = lax.dynamic_slice_in_dim(vp, start, span, axis=2)
        qpos = start + r
        kpos = start - WINDOW + j
        band = (jnp.abs(qpos[:, None] - kpos[None, :]) <= WINDOW) & ((kpos >= 0) & (kpos < s))[None, :]
        mask = jnp.concatenate([ctx_mask, band], axis=1)
        return _attend(qi, jnp.concatenate([k_ctx, kw], axis=2), jnp.concatenate([v_ctx, vw], axis=2), mask, sink)

    ob = lax.map(block, (qb, jnp.arange(nb)))
    return jnp.moveaxis(ob, 0, 3).reshape(b, hk, g, s, d)


def _conv_module(u, conv_w, conv_b, ln_g, ln_b):
    a, gate = jnp.split(u, 2, axis=-1)
    glu = a * jax.nn.sigmoid(gate)
    y = lax.conv_general_dilated(glu, conv_w[:, None, :], window_strides=(1,),
                                 padding=[(CONV_WIDTH // 2, CONV_WIDTH // 2)],
                                 dimension_numbers=('NWC', 'WIO', 'NWC'),
                                 feature_group_count=B_WIDTH) + conv_b
    yf = y.astype(jnp.float32)
    mu = jnp.mean(yf, axis=-1, keepdims=True)
    var = jnp.mean((yf - mu) ** 2, axis=-1, keepdims=True)
    yn = ((yf - mu) * lax.rsqrt(var + EPS) * ln_g.astype(jnp.float32) + ln_b.astype(jnp.float32)).astype(u.dtype)
    return jax.nn.silu(yn)


def _pool_mixer(u, pool_w, pool_scale):
    b, s, _ = u.shape
    uf = u.astype(jnp.float32)
    cs = jnp.pad(jnp.cumsum(uf, axis=1), ((0, 0), (1, 0), (0, 0)))
    t = jnp.arange(s)
    outs = []
    for gi, w in enumerate(POOL_SIZES):
        lo_c, hi_c = gi * POOL_GROUP_WIDTH, (gi + 1) * POOL_GROUP_WIDTH
        lo = jnp.clip(t - w // 2, 0, s)
        hi = jnp.clip(t - w // 2 + w, 0, s)
        csg = cs[..., lo_c:hi_c]
        mean = (jnp.take(csg, hi, axis=1) - jnp.take(csg, lo, axis=1)) / (hi - lo).astype(jnp.float32)[None, :, None]
        outs.append(mean - uf[..., lo_c:hi_c])
    p = jnp.stack(outs, axis=2).astype(u.dtype)
    y = jnp.einsum('bsgc,gcd->bsgd', p, pool_w).reshape(b, s, D_WIDTH)
    return y * pool_scale


def _mixer_ab(hx, hc, w_in, w_out, q_g, k_g, conv_w, conv_b, ln_g, ln_b, cos, sin, ctx_out):
    kvw = A_KV_HEADS * HEAD_DIM
    o_k, o_v, o_u = A_WIDTH, A_WIDTH + kvw, A_WIDTH + 2 * kvw
    px = hx @ w_in
    qx = _rope(_rmsnorm(_heads(px[..., :o_k], A_HEADS), q_g), cos, sin)
    kx = _rope(_rmsnorm(_heads(px[..., o_k:o_v], A_KV_HEADS), k_g), cos, sin)
    vx = _heads(px[..., o_v:o_u], A_KV_HEADS)
    if ctx_out:
        pc = hc @ w_in
        kvc = pc[..., o_k:o_u]
    else:
        kvc = hc @ w_in[:, o_k:o_u]
    kc = _rmsnorm(_heads(kvc[..., :kvw], A_KV_HEADS), k_g)
    vc = _heads(kvc[..., kvw:], A_KV_HEADS)
    ox = _dense_attn_blocks(_group(qx, A_KV_HEADS), jnp.concatenate([kc, kx], axis=2), jnp.concatenate([vc, vx], axis=2))
    bx = _conv_module(px[..., o_u:], conv_w, conv_b, ln_g, ln_b)
    yx = jnp.concatenate([_merge(ox), bx], axis=-1) @ w_out
    if not ctx_out:
        return yx, None
    qc = _rmsnorm(_heads(pc[..., :o_k], A_HEADS), q_g)
    oc = _attend(_group(qc, A_KV_HEADS), kc, vc, None, None)
    bc = _conv_module(pc[..., o_u:], conv_w, conv_b, ln_g, ln_b)
    yc = jnp.concatenate([_merge(oc), bc], axis=-1) @ w_out
    return yx, yc


def _mixer_cd(hx, hc, w_in, w_out, q_g, k_g, sink, pool_w, pool_scale, cos, sin, ctx_out):
    kvw = C_KV_HEADS * HEAD_DIM
    o_k, o_v, o_u = C_WIDTH, C_WIDTH + kvw, C_WIDTH + 2 * kvw
    sink_g = sink.reshape(C_KV_HEADS, C_HEADS // C_KV_HEADS)
    px = hx @ w_in
    qx = _rope(_rmsnorm(_heads(px[..., :o_k], C_HEADS), q_g), cos, sin)
    kx = _rope(_rmsnorm(_heads(px[..., o_k:o_v], C_KV_HEADS), k_g), cos, sin)
    vx = _heads(px[..., o_v:o_u], C_KV_HEADS)
    if ctx_out:
        pc = hc @ w_in
        kvc = pc[..., o_k:o_u]
    else:
        kvc = hc @ w_in[:, o_k:o_u]
    kc = _rmsnorm(_heads(kvc[..., :kvw], C_KV_HEADS), k_g)
    vc = _heads(kvc[..., kvw:], C_KV_HEADS)
    ox = _window_attn_blocks(_group(qx, C_KV_HEADS), kx, vx, kc, vc, sink_g)
    dx = _pool_mixer(px[..., o_u:], pool_w, pool_scale)
    yx = jnp.concatenate([_merge(ox), dx], axis=-1) @ w_out
    if not ctx_out:
        return yx, None
    qc = _rmsnorm(_heads(pc[..., :o_k], C_HEADS), q_g)
    oc = _attend(_group(qc, C_KV_HEADS), kc, vc, None, sink_g)
    dc = _pool_mixer(pc[..., o_u:], pool_w, pool_scale)
    yc = jnp.concatenate([_merge(oc), dc], axis=-1) @ w_out
    return yx, yc


def _moe(h, grp_w, grp_b, exp_w, exp_b, w_gate, w_up, w_down):
    n_tok, d = h.shape
    tok_idx = jnp.arange(n_tok)
    g_logits = (h @ grp_w).astype(jnp.float32) + grp_b.astype(jnp.float32)
    g_sel = jnp.argmax(g_logits, axis=-1)
    g_w = jax.nn.softmax(g_logits, axis=-1)[tok_idx, g_sel]
    e_logits = ((h @ exp_w).astype(jnp.float32) + exp_b.astype(jnp.float32)).reshape(n_tok, N_EXPERT_GROUPS, EXPERTS_PER_GROUP)[tok_idx, g_sel]
    e_p, e_i = lax.top_k(jax.nn.softmax(e_logits, axis=-1), TOP_K_INNER)
    wts = (g_w[:, None] * e_p / jnp.sum(e_p, axis=-1, keepdims=True)).reshape(-1)
    eid = (g_sel[:, None] * EXPERTS_PER_GROUP + e_i).reshape(-1).astype(jnp.int32)
    n_asg = n_tok * TOP_K_INNER
    flat_tok = jnp.repeat(tok_idx, TOP_K_INNER).astype(jnp.int32)
    order = jnp.argsort(eid)
    se, stok, sw = eid[order], flat_tok[order], wts[order]
    counts = jnp.bincount(eid, length=N_EXPERTS).astype(jnp.int32)
    padded = (counts + MOE_BLOCK - 1) // MOE_BLOCK * MOE_BLOCK
    start = jnp.cumsum(counts) - counts
    pend = jnp.cumsum(padded)
    dest = (pend - padded)[se] + jnp.arange(n_asg, dtype=jnp.int32) - start[se]
    n_blk = -(-(n_asg + N_EXPERTS * (MOE_BLOCK - 1)) // MOE_BLOCK)
    cap = n_blk * MOE_BLOCK
    buf_tok = jnp.full((cap,), n_tok, jnp.int32).at[dest].set(stok)
    buf_w = jnp.zeros((cap,), h.dtype).at[dest].set(sw.astype(h.dtype))
    blk_e = jnp.minimum(jnp.searchsorted(pend, jnp.arange(n_blk, dtype=jnp.int32) * MOE_BLOCK, side='right'), N_EXPERTS - 1)
    h_pad = jnp.concatenate([h, jnp.zeros((1, d), h.dtype)], axis=0)

    def run(args):
        tok, wt, e = args
        xb = h_pad[tok]
        hid = jax.nn.silu(xb @ w_gate[e]) * (xb @ w_up[e])
        return (hid @ w_down[e]) * wt[:, None]

    ys = lax.map(run, (buf_tok.reshape(n_blk, MOE_BLOCK), buf_w.reshape(n_blk, MOE_BLOCK), blk_e))
    out = jnp.zeros((n_tok + 1, d), h.dtype).at[buf_tok].add(ys.reshape(cap, d))
    return out[:n_tok]


def setup_inputs(seed: int = 0) -> dict:
    key = jax.random.key(seed)
    keys = jax.random.split(key, 48)
    counter = iter(range(48))

    def nrm(shape, scale):
        return jax.random.normal(keys[next(counter)], shape, jnp.float32) * scale

    n_even = (DEPTH + 1) // 2
    n_odd = DEPTH // 2
    dm = D_MODEL
    return {
        'x': nrm((BATCH, SEQ, dm), 1.0),
        'c': nrm((BATCH, dm), 1.0),
        'ctx': nrm((BATCH, CTX_LEN, dm), 1.0),
        'c_ctx': nrm((dm,), 1.0),
        'mod_w': nrm((DEPTH, dm, 6 * dm), 0.5 * dm ** -0.5),
        'mod_b': nrm((DEPTH, 6 * dm), 0.02),
        'ln1_g': 1.0 + nrm((DEPTH, dm), 0.02),
        'ln2_g': 1.0 + nrm((DEPTH, dm), 0.02),
        'w_in_ab': nrm((n_even, dm, AB_IN), dm ** -0.5),
        'w_out_ab': nrm((n_even, A_WIDTH + B_WIDTH, dm), dm ** -0.5),
        'q_norm_a': 1.0 + nrm((n_even, HEAD_DIM), 0.02),
        'k_norm_a': 1.0 + nrm((n_even, HEAD_DIM), 0.02),
        'conv_w': nrm((n_even, CONV_WIDTH, B_WIDTH), CONV_WIDTH ** -0.5),
        'conv_b': nrm((n_even, B_WIDTH), 0.02),
        'conv_ln_g': 1.0 + nrm((n_even, B_WIDTH), 0.02),
        'conv_ln_b': nrm((n_even, B_WIDTH), 0.02),
        'w_in_cd': nrm((n_odd, dm, CD_IN), dm ** -0.5),
        'w_out_cd': nrm((n_odd, C_WIDTH + D_WIDTH, dm), dm ** -0.5),
        'q_norm_c': 1.0 + nrm((n_odd, HEAD_DIM), 0.02),
        'k_norm_c': 1.0 + nrm((n_odd, HEAD_DIM), 0.02),
        'sink_c': nrm((n_odd, C_HEADS), 0.5),
        'pool_w': nrm((n_odd, len(POOL_SIZES), POOL_GROUP_WIDTH, POOL_GROUP_WIDTH), POOL_GROUP_WIDTH ** -0.5),
        'pool_scale': 1.0 + nrm((n_odd, D_WIDTH), 0.02),
        'rt_grp_w': nrm((DEPTH, dm, N_EXPERT_GROUPS), dm ** -0.5),
        'rt_grp_b': nrm((DEPTH, N_EXPERT_GROUPS), 0.01),
        'rt_exp_w': nrm((DEPTH, dm, N_EXPERTS), dm ** -0.5),
        'rt_exp_b': nrm((DEPTH, N_EXPERTS), 0.01),
        'ex_gate': nrm((DEPTH, N_EXPERTS, dm, D_EXPERT), dm ** -0.5),
        'ex_up': nrm((DEPTH, N_EXPERTS, dm, D_EXPERT), dm ** -0.5),
        'ex_down': nrm((DEPTH, N_EXPERTS, D_EXPERT, dm), D_EXPERT ** -0.5),
    }


def reference(x, c, ctx, c_ctx, mod_w, mod_b, ln1_g, ln2_g,
              w_in_ab, w_out_ab, q_norm_a, k_norm_a, conv_w, conv_b, conv_ln_g, conv_ln_b,
              w_in_cd, w_out_cd, q_norm_c, k_norm_c, sink_c, pool_w, pool_scale,
              rt_grp_w, rt_grp_b, rt_exp_w, rt_exp_b, ex_gate, ex_up, ex_down):
    b, s, dm = x.shape
    cos, sin = _rope_tables(s)
    for i in range(DEPTH):
        last = i == DEPTH - 1
        li = i // 2
        mod = jax.nn.silu(c) @ mod_w[i] + mod_b[i]
        modc = jax.nn.silu(c_ctx) @ mod_w[i] + mod_b[i]
        sh1, sc1, g1, sh2, sc2, g2 = jnp.split(mod[:, None, :], 6, axis=-1)
        sh1c, sc1c, g1c, sh2c, sc2c, g2c = jnp.split(modc[None, None, :], 6, axis=-1)
        hx = _modulate(_rmsnorm(x, ln1_g[i]), sh1, sc1)
        hc = _modulate(_rmsnorm(ctx, ln1_g[i]), sh1c, sc1c)
        if i % 2 == 0:
            yx, yc = _mixer_ab(hx, hc, w_in_ab[li], w_out_ab[li], q_norm_a[li], k_norm_a[li],
                               conv_w[li], conv_b[li], conv_ln_g[li], conv_ln_b[li], cos, sin, not last)
        else:
            yx, yc = _mixer_cd(hx, hc, w_in_cd[li], w_out_cd[li], q_norm_c[li], k_norm_c[li],
                               sink_c[li], pool_w[li], pool_scale[li], cos, sin, not last)
        x = x + g1 * yx
        hx = _modulate(_rmsnorm(x, ln2_g[i]), sh2, sc2)
        if last:
            ox = _moe(hx.reshape(b * s, dm), rt_grp_w[i], rt_grp_b[i], rt_exp_w[i], rt_exp_b[i],
                      ex_gate[i], ex_up[i], ex_down[i]).reshape(b, s, dm)
            x = x + g2 * ox
        else:
            ctx = ctx + g1c * yc
            hc = _modulate(_rmsnorm(ctx, ln2_g[i]), sh2c, sc2c)
            n_ctx = ctx.shape[1]
            tokens = jnp.concatenate([hc, hx], axis=1).reshape(-1, dm)
            out = _moe(tokens, rt_grp_w[i], rt_grp_b[i], rt_exp_w[i], rt_exp_b[i],
                       ex_gate[i], ex_up[i], ex_down[i]).reshape(b, n_ctx + s, dm)
            ctx = ctx + g2c * out[:, :n_ctx]
            x = x + g2 * out[:, n_ctx:]
    return x
```

```cpp
#include <hip/hip_runtime.h>
#include <cstdio>
#include <cstdint>

#ifndef ONE_LAUNCH
#define ONE_LAUNCH 0
#endif

#define LAS __attribute__((address_space(3)))
#define GAS __attribute__((address_space(1)))
typedef unsigned short bf16_t;
typedef short bf16x8 __attribute__((ext_vector_type(8)));
typedef float f32x4 __attribute__((ext_vector_type(4)));
typedef float f32x2 __attribute__((ext_vector_type(2)));
typedef unsigned u32x4 __attribute__((ext_vector_type(4)));
typedef unsigned u32x2 __attribute__((ext_vector_type(2)));
typedef __bf16 bf16x2_t __attribute__((ext_vector_type(2)));

constexpr int NB = 8, SEQ = 4096, DM = 1024, CTXL = 256, HD = 64;
constexpr int TX = NB * SEQ, TC = NB * CTXL, TT = TX + TC;
constexpr int KVS = CTXL + SEQ;
constexpr int NE = 32;
constexpr int NTILE_MAX = 304, NSLOT = NTILE_MAX * 256;
constexpr float EPS = 1e-6f;
constexpr float LOG2E = 1.4426950408889634f;
constexpr float C2 = 0.125f * LOG2E;
constexpr int NWAVES = 8, NTHREADS = 512;
constexpr int NPH = 18;

enum { I_X = 0, I_C, I_CTX, I_CCTX, I_MODW, I_MODB, I_LN1, I_LN2, I_WINAB, I_WOUTAB, I_QNA, I_KNA, I_CONVW, I_CONVB, I_CLNG, I_CLNB,
       I_WINCD, I_WOUTCD, I_QNC, I_KNC, I_SINK, I_POOLW, I_POOLS, I_RGW, I_RGB, I_REW, I_REB, I_EXG, I_EXU, I_EXD };

constexpr size_t MiB = 1u << 20;
constexpr size_t WS_CTL = 0, CTL_ZERO_BYTES = 1 * MiB;
constexpr size_t WS_MOD = 1 * MiB;
constexpr size_t WS_ROPE = 2 * MiB;
constexpr size_t WS_TOK = 3 * MiB;
constexpr size_t WS_LIST = 4 * MiB;
constexpr size_t WS_WINAB = 10 * MiB;
constexpr size_t WS_WOUTAB = 14 * MiB;
constexpr size_t WS_WINCD = 16 * MiB;
constexpr size_t WS_WOUTCD = 19 * MiB;
constexpr size_t WS_XC = 21 * MiB;
constexpr size_t WS_KN = 30 * MiB;
constexpr size_t WS_VN = 39 * MiB;
constexpr size_t WS_WGU = 48 * MiB;
constexpr size_t WS_WD = 176 * MiB;
constexpr size_t WS_HX = 240 * MiB;
constexpr size_t WS_HID = 308 * MiB;
constexpr size_t WS_Q = 384 * MiB;
constexpr size_t WS_KV = 418 * MiB;
constexpr size_t WS_G = 435 * MiB;
constexpr size_t WS_AO = 469 * MiB;
constexpr size_t WS_YB = 384 * MiB;
constexpr size_t WS_END = 537 * MiB;
static_assert(WS_YB + (size_t)NSLOT * 1024 * 2 <= WS_END && WS_AO + (size_t)TT * 1024 * 2 <= WS_END, "ws map");
constexpr int CW_CNT = 256;
constexpr int CW_BAR = 8192;

constexpr int RING_BYTES = 131072;
constexpr int LDS_MISC = RING_BYTES;
constexpr int LDS_TAB = RING_BYTES + 256;
constexpr int LDS_BYTES = 147456;

__device__ __forceinline__ unsigned pk2(float lo, float hi) { f32x2 v = {lo, hi}; bf16x2_t b = __builtin_convertvector(v, bf16x2_t); return __builtin_bit_cast(unsigned, b); }
__device__ __forceinline__ float bflo(unsigned w) { return __uint_as_float(w << 16); }
__device__ __forceinline__ float bfhi(unsigned w) { return __uint_as_float(w & 0xffff0000u); }
__device__ __forceinline__ float bf2f(bf16_t h) { return __uint_as_float((unsigned)h << 16); }
__device__ __forceinline__ float wave_sum(float v) {
#pragma unroll
    for (int o = 1; o < 64; o <<= 1) v += __shfl_xor(v, o);
    return v;
}
__device__ __forceinline__ float sigmoidf_(float v) { return 1.f / (1.f + __expf(-v)); }

#define XB_TMO      128
#define XB_XCNT(j)  (256  + 64 * (j))
#define XB_XSUB(j)  (1280 + 64 * (j))
#define XB_XGEN(j)  (2304 + 64 * (j))
#define XB_TOP      3328
#define XB_TOPGEN   3392
#define XCD_BAR_WORDS 3456
#define XB_SPIN_CAP (1u << 18)
__device__ __forceinline__ unsigned xb_ld(unsigned* p)              { return __hip_atomic_load(p, __ATOMIC_RELAXED, __HIP_MEMORY_SCOPE_AGENT); }
__device__ __forceinline__ unsigned xb_add(unsigned* p, unsigned v) { return __hip_atomic_fetch_add(p, v, __ATOMIC_RELAXED, __HIP_MEMORY_SCOPE_AGENT); }
__device__ __forceinline__ unsigned xb_xcc_id() { return (unsigned)__builtin_amdgcn_s_getreg((3 << 11) | 20) & 0xFu; }
#define XB_SPIN(cond, bar) do { unsigned _sp = 0; while (cond) { __builtin_amdgcn_s_sleep(1); \
    if ((++_sp & 255u) == 0u) { if (xb_ld(&(bar)[XB_TMO])) break; if (_sp > XB_SPIN_CAP) { atomicAdd(&(bar)[XB_TMO], 1u); break; } } } } while (0)
struct XcdBarrier { unsigned* bar; unsigned x; volatile LAS unsigned* st; };
__device__ __forceinline__ XcdBarrier xcd_barrier_post(unsigned* bar, volatile LAS unsigned* st) {
    XcdBarrier b; b.bar = bar; b.x = xb_xcc_id(); b.st = st;
    if (threadIdx.x == 0) (void)xb_add(&bar[XB_XCNT(b.x)], 1u);
    return b;
}
__device__ __forceinline__ void xcd_barrier_complete(unsigned* bar, unsigned x, unsigned& nloc, unsigned& nx) {
    const unsigned G = gridDim.x * gridDim.y * gridDim.z;
    unsigned sum, cnt, mine, sp = 0u;
    for (;;) {
        sum = 0u; cnt = 0u; mine = 0u;
#pragma unroll
        for (unsigned j = 0; j < 16; ++j) { const unsigned c = xb_ld(&bar[XB_XCNT(j)]); sum += c; cnt += (c > 0u) ? 1u : 0u; mine = (j == x) ? c : mine; }
        if (sum == G) break;
        __builtin_amdgcn_s_sleep(1);
        if ((++sp & 255u) == 0u) { if (xb_ld(&bar[XB_TMO])) break; if (sp > XB_SPIN_CAP) { atomicAdd(&bar[XB_TMO], 1u); break; } }
    }
    nloc = mine > 0u ? mine : 1u; nx = cnt > 0u ? cnt : 1u;
}
__device__ __forceinline__ void xcd_barrier(const XcdBarrier& b) {
    asm volatile("s_waitcnt vmcnt(0)" ::: "memory");
    __syncthreads();
    if (threadIdx.x == 0) {
        unsigned* bar = b.bar;
        __builtin_amdgcn_s_waitcnt(0);
        unsigned nloc = b.st[0], nx = b.st[1];
        if (nloc == 0u) { xcd_barrier_complete(bar, b.x, nloc, nx); b.st[0] = nloc; b.st[1] = nx; }
        const unsigned old = xb_add(&bar[XB_XSUB(b.x)], 1u);
        const unsigned gen = old / nloc;
        if (old + 1u == (gen + 1u) * nloc) {
            __builtin_amdgcn_fence(__ATOMIC_RELEASE, "agent");
            asm volatile("s_waitcnt vmcnt(0)" ::: "memory");
            const unsigned og = xb_add(&bar[XB_TOP], 1u);
            const unsigned tg = og / nx;
            if (og + 1u == (tg + 1u) * nx) xb_add(&bar[XB_TOPGEN], 1u);
            else XB_SPIN(xb_ld(&bar[XB_TOPGEN]) == tg, bar);
            __builtin_amdgcn_fence(__ATOMIC_ACQUIRE, "agent");
            xb_add(&bar[XB_XGEN(b.x)], 1u);
            asm volatile("s_waitcnt vmcnt(0)" ::: "memory");
        } else {
            XB_SPIN(xb_ld(&bar[XB_XGEN(b.x)]) == gen, bar);
            __builtin_amdgcn_fence(__ATOMIC_ACQUIRE, "agent");
            asm volatile("s_waitcnt vmcnt(0)" ::: "memory");
        }
    }
    __syncthreads();
}

struct Params { const float* in[30]; float* out; unsigned char* ws; int ph_lo, ph_hi; };
struct Frame {
    LAS unsigned char* lds;
    const float* const* in;
    float* out; unsigned char* ws;
    int tid, lane, wave, vcu, G;
    __device__ __forceinline__ const float* mod(int l, int r, int chunk) const { return (const float*)(ws + WS_MOD) + ((size_t)(l * 9 + r) * 6144 + chunk * 1024); }
    __device__ __forceinline__ float* xr_row(int row) const { return row < TX ? out + (size_t)row * DM : (float*)(ws + WS_XC) + (size_t)(row - TX) * DM; }
    __device__ __forceinline__ const float* xin_row(int row) const { return row < TX ? in[I_X] + (size_t)row * DM : in[I_CTX] + (size_t)(row - TX) * DM; }
    __device__ __forceinline__ unsigned* cnt(int l) const { return (unsigned*)(ws + WS_CTL) + CW_CNT + l * 32 * 64; }
};
__device__ __forceinline__ int modrow(int row) { return row < TX ? (row >> 12) : 8; }

__device__ __forceinline__ void p0_mod_item(const Frame& F, int item) {
    const int l = item / 96, cg = item % 96;
    LAS float* sc = (LAS float*)F.lds;
    LAS float* red = sc + 9 * 1024;
    for (int i = F.tid; i < 9 * 1024; i += NTHREADS) { const int r = i >> 10, k = i & 1023; const float v = r < 8 ? F.in[I_C][r * 1024 + k] : F.in[I_CCTX][k]; sc[i] = v / (1.f + expf(-v)); }
    __syncthreads();
    const float* W = F.in[I_MODW] + (size_t)l * 1024 * 6144 + cg * 64 + F.lane;
    float acc[9];
#pragma unroll
    for (int r = 0; r < 9; ++r) acc[r] = 0.f;
#pragma unroll 8
    for (int kk = 0; kk < 128; ++kk) { const int k = F.wave * 128 + kk; const float w = W[(size_t)k * 6144];
#pragma unroll
        for (int r = 0; r < 9; ++r) acc[r] += sc[r * 1024 + k] * w; }
#pragma unroll
    for (int r = 0; r < 9; ++r) red[(F.wave * 9 + r) * 64 + F.lane] = acc[r];
    __syncthreads();
    for (int i = F.tid; i < 9 * 64; i += NTHREADS) { const int r = i >> 6, ln = i & 63; float s = 0.f;
#pragma unroll
        for (int w = 0; w < 8; ++w) s += red[(w * 9 + r) * 64 + ln];
        ((float*)(F.ws + WS_MOD))[(size_t)(l * 9 + r) * 6144 + cg * 64 + ln] = s + F.in[I_MODB][l * 6144 + cg * 64 + ln]; }
    __syncthreads();
}
__device__ __forceinline__ void transpose_item(const float* W, int ldw, int k0, int n0, bf16_t* WT, int ldt, int drow0, int kcol0, LAS float* scr, int lane) {
    const int kr = lane >> 3, nq = lane & 7;
    f32x4 v[8];
#pragma unroll
    for (int i = 0; i < 8; ++i) v[i] = *(const f32x4*)(W + (size_t)(k0 + 8 * i + kr) * ldw + n0 + 4 * nq);
#pragma unroll
    for (int i = 0; i < 8; ++i) { LAS float* s = scr + (8 * i + kr) * 33 + 4 * nq; s[0] = v[i][0]; s[1] = v[i][1]; s[2] = v[i][2]; s[3] = v[i][3]; }
    asm volatile("s_waitcnt lgkmcnt(0)" ::: "memory");
    const int c = lane & 7;
#pragma unroll
    for (int j = 0; j < 4; ++j) { const int n = (lane >> 3) + 8 * j; const LAS float* s = scr + (8 * c) * 33 + n;
        u32x4 o; o.x = pk2(s[0 * 33], s[1 * 33]); o.y = pk2(s[2 * 33], s[3 * 33]); o.z = pk2(s[4 * 33], s[5 * 33]); o.w = pk2(s[6 * 33], s[7 * 33]);
        *(u32x4*)(WT + (size_t)(drow0 + n) * ldt + kcol0 + k0 + 8 * c) = o; }
    asm volatile("s_waitcnt lgkmcnt(0)" ::: "memory");
}
__device__ __forceinline__ void p0_prologue(const Frame& F) {
    for (int it = F.vcu; it < 192; it += F.G) p0_mod_item(F, it);
    const int gw = F.vcu * NWAVES + F.wave, NGW = F.G * NWAVES;
    const int gt = gw * 64 + F.lane, NGT = NGW * 64;
    { float* rc = (float*)(F.ws + WS_ROPE); float* rs = rc + SEQ * 32;
      for (int i = gt; i < SEQ * 32; i += NGT) { const int s = i >> 5, d = i & 31, f = d & 15; const float pos = (float)(d < 16 ? (s >> 6) : (s & 63));
          const float inv = exp2f(-(float)f * (13.287712379549449f / 16.f)); const float a = pos * inv; rc[i] = cosf(a); rs[i] = sinf(a); } }
    { bf16_t* WT = (bf16_t*)(F.ws + WS_WOUTCD); const float* pw = F.in[I_POOLW]; const float* ps = F.in[I_POOLS]; const float* wo = F.in[I_WOUTCD];
      for (int i = gt; i < 512 * 1024; i += NGT) { const int kk = i >> 10, d = i & 1023, g = kk >> 7; float s = 0.f;
          const float* pwr = pw + (size_t)kk * 128; const float* psr = ps + g * 128; const float* wor = wo + (size_t)(512 + g * 128) * 1024 + d;
#pragma unroll 8
          for (int dp = 0; dp < 128; ++dp) s += pwr[dp] * psr[dp] * wor[(size_t)dp * 1024];
          WT[(size_t)d * 1024 + 512 + kk] = (bf16_t)(pk2(s, 0.f) & 0xffffu); } }
    LAS float* scr = (LAS float*)(F.lds + F.wave * 8448);
    constexpr int N_AB = 16 * 56, N_OAB = 16 * 32, N_CD = 16 * 40, N_OCD = 8 * 32, N_G = 64 * 256, N_U = 64 * 256, N_D = 64 * 256;
    constexpr int NITEMS = N_AB + N_OAB + N_CD + N_OCD + N_G + N_U + N_D;
    for (int it = gw; it < NITEMS; it += NGW) {
        int r = it;
        if (r < N_AB) { const int kb = r / 56, nb = r % 56, n0 = nb * 32; int d0;
            if (n0 < 768) d0 = n0; else if (n0 < 1280) { const int j = n0 - 768; d0 = 768 + (j >> 7) * 256 + (j & 127); } else { const int j = n0 - 1280; d0 = 768 + (j >> 7) * 256 + 128 + (j & 127); }
            transpose_item(F.in[I_WINAB], 1792, kb * 64, n0, (bf16_t*)(F.ws + WS_WINAB), 1024, d0, 0, scr, F.lane); continue; } r -= N_AB;
        if (r < N_OAB) { const int kb = r / 32, nb = r % 32; transpose_item(F.in[I_WOUTAB], 1024, kb * 64, nb * 32, (bf16_t*)(F.ws + WS_WOUTAB), 1024, nb * 32, 0, scr, F.lane); continue; } r -= N_OAB;
        if (r < N_CD) { const int kb = r / 40, nb = r % 40; transpose_item(F.in[I_WINCD], 1280, kb * 64, nb * 32, (bf16_t*)(F.ws + WS_WINCD), 1024, nb * 32, 0, scr, F.lane); continue; } r -= N_CD;
        if (r < N_OCD) { const int kb = r / 32, nb = r % 32; transpose_item(F.in[I_WOUTCD], 1024, kb * 64, nb * 32, (bf16_t*)(F.ws + WS_WOUTCD), 1024, nb * 32, 0, scr, F.lane); continue; } r -= N_OCD;
        if (r < N_G + N_U) { const bool up = r >= N_G; if (up) r -= N_G; const int le = r >> 8, q = r & 255, kb = q >> 4, nb = q & 15, n0 = nb * 32;
            const int d0 = (n0 >> 7) * 256 + (up ? 128 : 0) + (n0 & 127);
            transpose_item(F.in[up ? I_EXU : I_EXG] + (size_t)le * 1024 * 512, 512, kb * 64, n0, (bf16_t*)(F.ws + WS_WGU) + (size_t)le * 1024 * 1024, 1024, d0, 0, scr, F.lane); continue; } r -= N_G + N_U;
        { const int le = r >> 8, q = r & 255, kb = q >> 5, nb = q & 31;
            transpose_item(F.in[I_EXD] + (size_t)le * 512 * 1024, 1024, kb * 64, nb * 32, (bf16_t*)(F.ws + WS_WD) + (size_t)le * 1024 * 512, 512, nb * 32, 0, scr, F.lane); }
    }
}

__device__ __forceinline__ void norm_mod_row(const float* xrow, const float* g, const float* sh, const float* sc, int lane, f32x4 (&h)[4]) {
    f32x4 v[4]; float ss = 0.f;
#pragma unroll
    for (int j = 0; j < 4; ++j) { v[j] = *(const f32x4*)(xrow + 4 * lane + 256 * j); ss += (v[j][0] * v[j][0] + v[j][1] * v[j][1]) + (v[j][2] * v[j][2] + v[j][3] * v[j][3]); }
    const float rms = 1.0f / sqrtf(wave_sum(ss) * (1.f / 1024.f) + EPS);
#pragma unroll
    for (int j = 0; j < 4; ++j) { const int c = 4 * lane + 256 * j; const f32x4 gg = *(const f32x4*)(g + c), s1 = *(const f32x4*)(sc + c), s0 = *(const f32x4*)(sh + c);
        h[j] = (v[j] * rms * gg) * (1.f + s1) + s0; }
}
__device__ __forceinline__ void store_row_bf16(bf16_t* orow, int lane, const f32x4 (&h)[4]) {
#pragma unroll
    for (int j = 0; j < 4; ++j) { u32x2 o; o.x = pk2(h[j][0], h[j][1]); o.y = pk2(h[j][2], h[j][3]); *(u32x2*)(orow + 4 * lane + 256 * j) = o; }
}
__device__ __forceinline__ void p_norm1_l0(const Frame& F) {
    const int gw = F.vcu * NWAVES + F.wave, NGW = F.G * NWAVES;
    bf16_t* HX = (bf16_t*)(F.ws + WS_HX);
    for (int row = gw; row < TT; row += NGW) { const int r = modrow(row); f32x4 h[4];
        norm_mod_row(F.xin_row(row), F.in[I_LN1], F.mod(0, r, 0), F.mod(0, r, 1), F.lane, h);
        store_row_bf16(HX + (size_t)row * DM, F.lane, h); }
}

struct Unit { int pm, pn, e; };
struct SchedDense {
    const bf16_t* Bt; int K, nMa, nN, nMb, pnb, vcu, G;
    __device__ __forceinline__ bool next(int i, Unit& u) const { int L = i * G + vcu; const int na = nMa * nN; u.e = 0;
        if (L < na) { u.pm = L / nN; u.pn = L % nN; return true; } L -= na; if (L < nMb) { u.pm = nMa + L; u.pn = pnb; return true; } return false; }
    __device__ __forceinline__ int arow(const Unit& u, int r) const { return u.pm * 256 + r; }
    __device__ __forceinline__ const bf16_t* bbase(const Unit& u) const { return Bt + (size_t)u.pn * 256 * K; }
};
struct MoeTab { const LAS int* tile_e; const LAS int* tile0; const LAS int* cnt; int ntiles; };
struct SchedMoe {
    const bf16_t* Wt; size_t estride; int K; MoeTab tb; const unsigned* list; bool gather; int vcu, G;
    __device__ __forceinline__ bool next(int i, Unit& u) const { const int L = i * G + vcu; if (L >= tb.ntiles * 4) return false; u.pm = L >> 2; u.pn = L & 3; u.e = tb.tile_e[u.pm]; return true; }
    __device__ __forceinline__ int arow(const Unit& u, int r) const {
        if (!gather) return u.pm * 256 + r;
        int idx = (u.pm - tb.tile0[u.e]) * 256 + r; const int c = tb.cnt[u.e]; idx = idx < c ? idx : c - 1;
        return (int)list[(size_t)u.e * TT + idx]; }
    __device__ __forceinline__ const bf16_t* bbase(const Unit& u) const { return Wt + (size_t)u.e * estride + (size_t)u.pn * 256 * K; }
};
__device__ __forceinline__ MoeTab moe_tables(const Frame& F, int l) {
    LAS int* tile_e = (LAS int*)(F.lds + LDS_TAB); LAS int* tile0 = tile_e + NTILE_MAX; LAS int* cntl = tile0 + 33; LAS int* nt = cntl + 32;
    __syncthreads();
    if (F.tid == 0) { int t = 0; unsigned* cg = F.cnt(l);
        for (int e = 0; e < NE; ++e) { const int c = (int)__hip_atomic_load(cg + e * 64, __ATOMIC_RELAXED, __HIP_MEMORY_SCOPE_AGENT); const int n = (c + 255) >> 8; tile0[e] = t; cntl[e] = c;
            for (int j = 0; j < n; ++j) tile_e[t + j] = e; t += n; }
        tile0[32] = t; nt[0] = t; }
    __syncthreads();
    MoeTab tb; tb.tile_e = tile_e; tb.tile0 = tile0; tb.cnt = cntl; tb.ntiles = nt[0]; return tb;
}

template <class Sched, class Epi>
__device__ __forceinline__ void gemm_simple(const Frame& F, const bf16_t* A, int K, const Sched& S, const Epi& E) {
    const int wr = F.wave >> 2, wc = F.wave & 3, fr = F.lane & 15, fq = F.lane >> 4;
    Unit u;
    for (int i = 0; S.next(i, u); ++i) {
        f32x4 acc[2][2][4][2];
#pragma unroll
        for (int a = 0; a < 2; ++a)
#pragma unroll
            for (int b = 0; b < 2; ++b)
#pragma unroll
                for (int m = 0; m < 4; ++m)
#pragma unroll
                    for (int n = 0; n < 2; ++n) acc[a][b][m][n] = (f32x4){0.f, 0.f, 0.f, 0.f};
        unsigned aoff[2][4], boff[2][2];
#pragma unroll
        for (int a = 0; a < 2; ++a)
#pragma unroll
            for (int m = 0; m < 4; ++m) aoff[a][m] = (unsigned)S.arow(u, 128 * a + 64 * wr + 16 * m + fr) * (unsigned)K + 8u * fq;
        const bf16_t* bb = S.bbase(u);
#pragma unroll
        for (int b = 0; b < 2; ++b)
#pragma unroll
            for (int n = 0; n < 2; ++n) boff[b][n] = (unsigned)(128 * b + 32 * wc + 8 * (fr >> 2) + 4 * n + (fr & 3)) * (unsigned)K + 8u * fq;
#pragma unroll 1
        for (int k0 = 0; k0 < K; k0 += 32) {
            bf16x8 bf[2][2];
#pragma unroll
            for (int b = 0; b < 2; ++b)
#pragma unroll
                for (int n = 0; n < 2; ++n) bf[b][n] = *(const bf16x8*)(bb + boff[b][n] + k0);
#pragma unroll
            for (int a = 0; a < 2; ++a) {
                bf16x8 af[4];
#pragma unroll
                for (int m = 0; m < 4; ++m) af[m] = *(const bf16x8*)(A + aoff[a][m] + k0);
#pragma unroll
                for (int b = 0; b < 2; ++b)
#pragma unroll
                    for (int m = 0; m < 4; ++m)
#pragma unroll
                        for (int n = 0; n < 2; ++n) acc[a][b][m][n] = __builtin_amdgcn_mfma_f32_16x16x32_bf16(bf[b][n], af[m], acc[a][b][m][n], 0, 0, 0);
            }
        }
        E(acc, u, wr, wc, fr, fq);
    }
}

__device__ __forceinline__ u32x4 pack8(const f32x4& a, const f32x4& b) { u32x4 w; w.x = pk2(a[0], a[1]); w.y = pk2(a[2], a[3]); w.z = pk2(b[0], b[1]); w.w = pk2(b[2], b[3]); return w; }
template <bool GLU> struct EpiInProj {
    bf16_t* Q; bf16_t* KV; bf16_t* Gb;
    __device__ __forceinline__ void operator()(const f32x4 (&acc)[2][2][4][2], const Unit& u, int wr, int wc, int fr, int fq) const {
#pragma unroll
        for (int ai = 0; ai < 2; ++ai)
#pragma unroll
            for (int m = 0; m < 4; ++m) { const size_t row = (size_t)u.pm * 256 + 128 * ai + 64 * wr + 16 * m + fr; const int cl = 32 * wc + 8 * fq;
                if (u.pn < 2) { *(u32x4*)(Q + row * 512 + u.pn * 256 + cl) = pack8(acc[ai][0][m][0], acc[ai][0][m][1]); *(u32x4*)(Q + row * 512 + u.pn * 256 + 128 + cl) = pack8(acc[ai][1][m][0], acc[ai][1][m][1]); }
                else if (u.pn == 2) { *(u32x4*)(KV + row * 256 + cl) = pack8(acc[ai][0][m][0], acc[ai][0][m][1]); *(u32x4*)(KV + row * 256 + 128 + cl) = pack8(acc[ai][1][m][0], acc[ai][1][m][1]); }
                else if (GLU) { f32x4 g0, g1;
#pragma unroll
                    for (int j = 0; j < 4; ++j) { g0[j] = acc[ai][0][m][0][j] * sigmoidf_(acc[ai][1][m][0][j]); g1[j] = acc[ai][0][m][1][j] * sigmoidf_(acc[ai][1][m][1][j]); }
                    *(u32x4*)(Gb + row * 512 + (u.pn - 3) * 128 + cl) = pack8(g0, g1); }
                else { *(u32x4*)(Gb + row * 512 + (u.pn - 3) * 256 + cl) = pack8(acc[ai][0][m][0], acc[ai][0][m][1]); *(u32x4*)(Gb + row * 512 + (u.pn - 3) * 256 + 128 + cl) = pack8(acc[ai][1][m][0], acc[ai][1][m][1]); }
            }
    }
};
template <bool L0> struct EpiOutProj {
    Frame F; int l;
    __device__ __forceinline__ void operator()(const f32x4 (&acc)[2][2][4][2], const Unit& u, int wr, int wc, int fr, int fq) const {
#pragma unroll
        for (int ai = 0; ai < 2; ++ai)
#pragma unroll
            for (int m = 0; m < 4; ++m) { const int row = u.pm * 256 + 128 * ai + 64 * wr + 16 * m + fr; const float* g1 = F.mod(l, modrow(row), 2);
                const float* src = L0 ? F.xin_row(row) : F.xr_row(row); float* dst = F.xr_row(row);
#pragma unroll
                for (int bj = 0; bj < 2; ++bj)
#pragma unroll
                    for (int n = 0; n < 2; ++n) { const int c = u.pn * 256 + 128 * bj + 32 * wc + 8 * fq + 4 * n;
                        const f32x4 xv = *(const f32x4*)(src + c), gv = *(const f32x4*)(g1 + c); *(f32x4*)(dst + c) = xv + gv * acc[ai][bj][m][n]; } }
    }
};
struct EpiMoe1 {
    bf16_t* HID;
    __device__ __forceinline__ void operator()(const f32x4 (&acc)[2][2][4][2], const Unit& u, int wr, int wc, int fr, int fq) const {
#pragma unroll
        for (int ai = 0; ai < 2; ++ai)
#pragma unroll
            for (int m = 0; m < 4; ++m) { const size_t slot = (size_t)u.pm * 256 + 128 * ai + 64 * wr + 16 * m + fr; f32x4 h0, h1;
#pragma unroll
                for (int j = 0; j < 4; ++j) { const float a = acc[ai][0][m][0][j], b = acc[ai][0][m][1][j]; h0[j] = a * sigmoidf_(a) * acc[ai][1][m][0][j]; h1[j] = b * sigmoidf_(b) * acc[ai][1][m][1][j]; }
                *(u32x4*)(HID + slot * 512 + u.pn * 128 + 32 * wc + 8 * fq) = pack8(h0, h1); }
    }
};
struct EpiMoe2 {
    bf16_t* YB;
    __device__ __forceinline__ void operator()(const f32x4 (&acc)[2][2][4][2], const Unit& u, int wr, int wc, int fr, int fq) const {
#pragma unroll
        for (int ai = 0; ai < 2; ++ai)
#pragma unroll
            for (int m = 0; m < 4; ++m) { const size_t slot = (size_t)u.pm * 256 + 128 * ai + 64 * wr + 16 * m + fr;
#pragma unroll
                for (int bj = 0; bj < 2; ++bj) *(u32x4*)(YB + slot * 1024 + u.pn * 256 + 128 * bj + 32 * wc + 8 * fq) = pack8(acc[ai][bj][m][0], acc[ai][bj][m][1]); }
    }
};

__device__ __forceinline__ void p_qkv_post(const Frame& F, const float* qg, const float* kg, bool ctx_q) {
    const int gw = F.vcu * NWAVES + F.wave, NGW = F.G * NWAVES, lane = F.lane;
    bf16_t* Q = (bf16_t*)(F.ws + WS_Q); const bf16_t* KV = (const bf16_t*)(F.ws + WS_KV); bf16_t* Kn = (bf16_t*)(F.ws + WS_KN); bf16_t* Vn = (bf16_t*)(F.ws + WS_VN);
    const float* rc = (const float*)(F.ws + WS_ROPE); const float* rs = rc + SEQ * 32;
    const int i8 = lane & 7, dd0 = 8 * (i8 & 3);
    float gq[8], gk[8];
#pragma unroll
    for (int j = 0; j < 8; ++j) { gq[j] = qg[i8 * 8 + j]; gk[j] = kg[i8 * 8 + j]; }
    for (int row = gw; row < TT; row += NGW) {
        const bool isctx = row >= TX; const int b = isctx ? (row - TX) >> 8 : row >> 12, s = isctx ? (row - TX) & 255 : row & 4095;
        float cs[8], sn[8];
#pragma unroll
        for (int j = 0; j < 8; ++j) { cs[j] = 1.f; sn[j] = 0.f; }
        if (!isctx) {
#pragma unroll
            for (int j = 0; j < 8; ++j) { cs[j] = rc[s * 32 + dd0 + j]; sn[j] = rs[s * 32 + dd0 + j]; } }
        const float sgn = (i8 < 4) ? -1.f : 1.f;
        if (!isctx || ctx_q) {
            const u32x4 w = *(const u32x4*)(Q + (size_t)row * 512 + lane * 8);
            float x[8] = {bflo(w.x), bfhi(w.x), bflo(w.y), bfhi(w.y), bflo(w.z), bfhi(w.z), bflo(w.w), bfhi(w.w)};
            float ss = 0.f;
#pragma unroll
            for (int j = 0; j < 8; ++j) ss += x[j] * x[j];
            ss += __shfl_xor(ss, 1); ss += __shfl_xor(ss, 2); ss += __shfl_xor(ss, 4);
            const float rms = 1.0f / sqrtf(ss * (1.f / 64.f) + EPS);
            float y[8], o[8];
#pragma unroll
            for (int j = 0; j < 8; ++j) y[j] = x[j] * rms * gq[j];
#pragma unroll
            for (int j = 0; j < 8; ++j) { const float yp = __shfl_xor(y[j], 4); o[j] = (y[j] * cs[j] + sgn * yp * sn[j]) * C2; }
            u32x4 ow; ow.x = pk2(o[0], o[1]); ow.y = pk2(o[2], o[3]); ow.z = pk2(o[4], o[5]); ow.w = pk2(o[6], o[7]);
            *(u32x4*)(Q + (size_t)row * 512 + lane * 8) = ow;
        }
        {
            const int l32 = lane & 31;
            const u32x4 w = *(const u32x4*)(KV + (size_t)row * 256 + l32 * 8);
            float x[8] = {bflo(w.x), bfhi(w.x), bflo(w.y), bfhi(w.y), bflo(w.z), bfhi(w.z), bflo(w.w), bfhi(w.w)};
            float ss = 0.f;
#pragma unroll
            for (int j = 0; j < 8; ++j) ss += x[j] * x[j];
            ss += __shfl_xor(ss, 1); ss += __shfl_xor(ss, 2); ss += __shfl_xor(ss, 4);
            const float rms = 1.0f / sqrtf(ss * (1.f / 64.f) + EPS);
            float y[8], o[8];
#pragma unroll
            for (int j = 0; j < 8; ++j) y[j] = x[j] * rms * gk[j];
#pragma unroll
            for (int j = 0; j < 8; ++j) { const float yp = __shfl_xor(y[j], 4); o[j] = y[j] * cs[j] + sgn * yp * sn[j]; }
            const size_t kvrow = (size_t)b * KVS + (isctx ? s : CTXL + s);
            if (lane < 16) { u32x4 ow; ow.x = pk2(o[0], o[1]); ow.y = pk2(o[2], o[3]); ow.z = pk2(o[4], o[5]); ow.w = pk2(o[6], o[7]); *(u32x4*)(Kn + kvrow * 128 + lane * 8) = ow; }
            else if (lane < 32) { *(u32x4*)(Vn + kvrow * 128 + (lane - 16) * 8) = w; }
        }
    }
}
__device__ __forceinline__ void p_conv(const Frame& F) {
    const bf16_t* Gb = (const bf16_t*)(F.ws + WS_G); bf16_t* AO = (bf16_t*)(F.ws + WS_AO);
    LAS bf16_t* gl = (LAS bf16_t*)F.lds;
    LAS float* yl = (LAS float*)(F.lds + 65536);
    const int c = F.tid;
    float w[31];
#pragma unroll
    for (int j = 0; j < 31; ++j) w[j] = F.in[I_CONVW][j * 512 + c];
    const float bias = F.in[I_CONVB][c];
    for (int item = F.vcu; item < 1024 + 64; item += F.G) {
        int rowbase, t0, len;
        if (item < 1024) { rowbase = (item >> 7) * SEQ; t0 = (item & 127) * 32; len = SEQ; } else { const int it = item - 1024; rowbase = TX + (it >> 3) * CTXL; t0 = (it & 7) * 32; len = CTXL; }
        __syncthreads();
        for (int ch = F.tid; ch < 62 * 64; ch += NTHREADS) { const int r = ch >> 6, p = t0 - 15 + r; u32x4 v = (u32x4){0u, 0u, 0u, 0u};
            if (p >= 0 && p < len) v = *(const u32x4*)(Gb + (size_t)(rowbase + p) * 512 + (ch & 63) * 8);
            *(LAS u32x4*)(gl + r * 512 + (ch & 63) * 8) = v; }
        __syncthreads();
        float g[62];
#pragma unroll
        for (int r = 0; r < 62; ++r) g[r] = bf2f(gl[r * 512 + c]);
#pragma unroll
        for (int t = 0; t < 32; ++t) { float y = bias;
#pragma unroll
            for (int j = 0; j < 31; ++j) y += g[t + j] * w[j];
            yl[t * 512 + c] = y; }
        __syncthreads();
#pragma unroll
        for (int tt = 0; tt < 4; ++tt) { const int t = 4 * F.wave + tt; float v[8]; float s = 0.f;
#pragma unroll
            for (int j = 0; j < 8; ++j) { v[j] = yl[t * 512 + F.lane + 64 * j]; s += v[j]; }
            const float mean = wave_sum(s) * (1.f / 512.f); float q = 0.f;
#pragma unroll
            for (int j = 0; j < 8; ++j) { v[j] -= mean; q += v[j] * v[j]; }
            const float rstd = 1.0f / sqrtf(wave_sum(q) * (1.f / 512.f) + EPS);
            bf16_t* orow = AO + (size_t)(rowbase + t0 + t) * 1024 + 512;
#pragma unroll
            for (int j = 0; j < 8; ++j) { const int cc = F.lane + 64 * j; const float yn = v[j] * rstd * F.in[I_CLNG][cc] + F.in[I_CLNB][cc]; orow[cc] = (bf16_t)(pk2(yn * sigmoidf_(yn), 0.f) & 0xffffu); } }
    }
    __syncthreads();
}
__device__ __forceinline__ void p_pool(const Frame& F) {
    const int gw = F.vcu * NWAVES + F.wave, NGW = F.G * NWAVES, lane = F.lane;
    const bf16_t* U = (const bf16_t*)(F.ws + WS_G); bf16_t* AO = (bf16_t*)(F.ws + WS_AO);
    const int wdt = 2 << (lane >> 4);
    for (int row = gw; row < TX; row += NGW) {
        const int t = row & 4095, rb = row - t;
        int lo = t - (wdt >> 1), hi = lo + wdt; lo = lo < 0 ? 0 : lo; hi = hi > SEQ ? SEQ : hi;
        float s[8];
#pragma unroll
        for (int j = 0; j < 8; ++j) s[j] = 0.f;
        for (int i = 0; i < 16; ++i) { const int p = lo + i; if (p < hi) { const u32x4 w = *(const u32x4*)(U + (size_t)(rb + p) * 512 + lane * 8);
            s[0] += bflo(w.x); s[1] += bfhi(w.x); s[2] += bflo(w.y); s[3] += bfhi(w.y); s[4] += bflo(w.z); s[5] += bfhi(w.z); s[6] += bflo(w.w); s[7] += bfhi(w.w); } }
        const u32x4 w = *(const u32x4*)(U + (size_t)row * 512 + lane * 8); const float inv = 1.f / (float)(hi - lo);
        float o[8] = {s[0] * inv - bflo(w.x), s[1] * inv - bfhi(w.x), s[2] * inv - bflo(w.y), s[3] * inv - bfhi(w.y), s[4] * inv - bflo(w.z), s[5] * inv - bfhi(w.z), s[6] * inv - bflo(w.w), s[7] * inv - bfhi(w.w)};
        u32x4 ow; ow.x = pk2(o[0], o[1]); ow.y = pk2(o[2], o[3]); ow.z = pk2(o[4], o[5]); ow.w = pk2(o[6], o[7]);
        *(u32x4*)(AO + (size_t)row * 1024 + 512 + lane * 8) = ow;
    }
}

template <int LAYER> __device__ __forceinline__ void attn_simple(const Frame& F) {
    const bf16_t* Q = (const bf16_t*)(F.ws + WS_Q); const bf16_t* Kn = (const bf16_t*)(F.ws + WS_KN); const bf16_t* Vn = (const bf16_t*)(F.ws + WS_VN); bf16_t* AO = (bf16_t*)(F.ws + WS_AO);
    const int nunits = LAYER == 0 ? 512 + 64 : 512;
    for (int u = F.vcu; u < nunits; u += F.G) {
        int b, h, row, s; bool valid = true, isctx = false;
        if (u < 512) { b = u >> 6; h = (u >> 3) & 7; s = (u & 7) * 512 + F.tid; row = b * SEQ + s; }
        else { const int uc = u - 512; b = uc >> 3; h = uc & 7; s = F.tid; valid = F.tid < 256; row = TX + b * CTXL + (valid ? s : 0); isctx = true; }
        float q[64], o[64];
        { const u32x4* qp = (const u32x4*)(Q + (size_t)row * 512 + h * 64);
#pragma unroll
          for (int c = 0; c < 8; ++c) { const u32x4 w = qp[c]; q[8 * c] = bflo(w.x); q[8 * c + 1] = bfhi(w.x); q[8 * c + 2] = bflo(w.y); q[8 * c + 3] = bfhi(w.y); q[8 * c + 4] = bflo(w.z); q[8 * c + 5] = bfhi(w.z); q[8 * c + 6] = bflo(w.w); q[8 * c + 7] = bfhi(w.w); } }
#pragma unroll
        for (int d = 0; d < 64; ++d) o[d] = 0.f;
        float mx = -1e30f, l = 0.f;
        const bf16_t* Kb = Kn + (size_t)b * KVS * 128 + (h >> 2) * 64; const bf16_t* Vb = Vn + (size_t)b * KVS * 128 + (h >> 2) * 64;
        int k_lo2 = 0, k_hi2 = 0;
        const int k_hi1 = CTXL;
        if (LAYER == 0) { if (!isctx) { k_lo2 = CTXL; k_hi2 = KVS; } }
        else { const int s0 = (u & 7) * 512; int lo = s0 - 128, hi = s0 + 511 + 128 + 1; lo = lo < 0 ? 0 : lo; hi = hi > SEQ ? SEQ : hi; k_lo2 = CTXL + lo; k_hi2 = CTXL + hi; }
        for (int part = 0; part < 2; ++part) {
            const int kb = part == 0 ? 0 : k_lo2, ke = part == 0 ? k_hi1 : k_hi2;
            for (int key = kb; key < ke; ++key) {
                const u32x4* kp = (const u32x4*)(Kb + (size_t)key * 128); float sd = 0.f;
#pragma unroll
                for (int c = 0; c < 8; ++c) { const u32x4 w = kp[c];
                    sd += q[8 * c] * bflo(w.x) + q[8 * c + 1] * bfhi(w.x) + q[8 * c + 2] * bflo(w.y) + q[8 * c + 3] * bfhi(w.y) + q[8 * c + 4] * bflo(w.z) + q[8 * c + 5] * bfhi(w.z) + q[8 * c + 6] * bflo(w.w) + q[8 * c + 7] * bfhi(w.w); }
                bool use = valid;
                if (LAYER == 1 && part == 1) { const int j = key - CTXL; const int dlt = s - j; use = use && (dlt <= 128 && dlt >= -128); }
                const float mn = fmaxf(mx, sd); const float mnew = use ? mn : mx;
                const float alpha = exp2f(mx - mnew), p = use ? exp2f(sd - mnew) : 0.f;
                mx = mnew; l = l * alpha + p;
                const u32x4* vp = (const u32x4*)(Vb + (size_t)key * 128);
#pragma unroll
                for (int c = 0; c < 8; ++c) { const u32x4 w = vp[c];
                    o[8 * c] = o[8 * c] * alpha + p * bflo(w.x); o[8 * c + 1] = o[8 * c + 1] * alpha + p * bfhi(w.x); o[8 * c + 2] = o[8 * c + 2] * alpha + p * bflo(w.y); o[8 * c + 3] = o[8 * c + 3] * alpha + p * bfhi(w.y);
                    o[8 * c + 4] = o[8 * c + 4] * alpha + p * bflo(w.z); o[8 * c + 5] = o[8 * c + 5] * alpha + p * bfhi(w.z); o[8 * c + 6] = o[8 * c + 6] * alpha + p * bflo(w.w); o[8 * c + 7] = o[8 * c + 7] * alpha + p * bfhi(w.w); }
            }
        }
        if (LAYER == 1) l += exp2f(F.in[I_SINK][h] * LOG2E - mx);
        const float il = 1.f / l;
        if (valid) { u32x4* op = (u32x4*)(AO + (size_t)row * 1024 + h * 64);
#pragma unroll
            for (int c = 0; c < 8; ++c) { u32x4 w; w.x = pk2(o[8 * c] * il, o[8 * c + 1] * il); w.y = pk2(o[8 * c + 2] * il, o[8 * c + 3] * il); w.z = pk2(o[8 * c + 4] * il, o[8 * c + 5] * il); w.w = pk2(o[8 * c + 6] * il, o[8 * c + 7] * il); op[c] = w; } }
    }
}

__device__ __forceinline__ void p_router(const Frame& F, int l, int ntok) {
    const int gw = F.vcu * NWAVES + F.wave, NGW = F.G * NWAVES, lane = F.lane;
    bf16_t* HX = (bf16_t*)(F.ws + WS_HX);
    const float* gwt = F.in[I_RGW] + (size_t)l * 1024 * 4; const float* ewt = F.in[I_REW] + (size_t)l * 1024 * 32;
    const float* gb = F.in[I_RGB] + l * 4; const float* eb = F.in[I_REB] + l * 32;
    unsigned* tokslot = (unsigned*)(F.ws + WS_TOK); float* tokw = (float*)(F.ws + WS_TOK + 512 * 1024); unsigned* list = (unsigned*)(F.ws + WS_LIST);
    unsigned* cnt = F.cnt(l);
    for (int row = gw; row < ntok; row += NGW) {
        const int r = modrow(row); f32x4 h[4];
        norm_mod_row(F.xr_row(row), F.in[I_LN2] + l * 1024, F.mod(l, r, 3), F.mod(l, r, 4), lane, h);
        store_row_bf16(HX + (size_t)row * DM, lane, h);
        float lg[4], le[32];
#pragma unroll
        for (int o = 0; o < 4; ++o) lg[o] = 0.f;
#pragma unroll
        for (int o = 0; o < 32; ++o) le[o] = 0.f;
#pragma unroll
        for (int j = 0; j < 4; ++j) {
            const float* gp = gwt + (size_t)(4 * lane + 256 * j) * 4; const float* ep = ewt + (size_t)(4 * lane + 256 * j) * 32;
            asm volatile("" : "+v"(gp), "+v"(ep));
#pragma unroll
            for (int i = 0; i < 4; ++i) { const float hv = h[j][i];
                const f32x4 g4 = *(const f32x4*)(gp + i * 4);
                lg[0] += hv * g4[0]; lg[1] += hv * g4[1]; lg[2] += hv * g4[2]; lg[3] += hv * g4[3];
#pragma unroll
                for (int q = 0; q < 8; ++q) { const f32x4 e4 = *(const f32x4*)(ep + i * 32 + 4 * q); le[4 * q] += hv * e4[0]; le[4 * q + 1] += hv * e4[1]; le[4 * q + 2] += hv * e4[2]; le[4 * q + 3] += hv * e4[3]; } }
            __builtin_amdgcn_sched_barrier(0); }
#pragma unroll
        for (int o = 0; o < 4; ++o) lg[o] = wave_sum(lg[o]) + gb[o];
#pragma unroll
        for (int o = 0; o < 32; ++o) { le[o] = wave_sum(le[o]) + eb[o]; if ((o & 3) == 3) __builtin_amdgcn_sched_barrier(0); }
        int gs = 0; float gm = lg[0];
#pragma unroll
        for (int o = 1; o < 4; ++o) if (lg[o] > gm) { gm = lg[o]; gs = o; }
        float gden = 0.f;
#pragma unroll
        for (int o = 0; o < 4; ++o) gden += expf(lg[o] - gm);
        const float g_w = 1.f / gden;
        float el[8];
#pragma unroll
        for (int i = 0; i < 8; ++i) { el[i] = le[i];
#pragma unroll
            for (int g = 1; g < 4; ++g) el[i] = (gs == g) ? le[g * 8 + i] : el[i]; }
        int i1 = 0; float m1 = el[0];
#pragma unroll
        for (int i = 1; i < 8; ++i) if (el[i] > m1) { m1 = el[i]; i1 = i; }
        int i2 = -1; float m2 = -3.0e38f;
#pragma unroll
        for (int i = 0; i < 8; ++i) if (i != i1 && el[i] > m2) { m2 = el[i]; i2 = i; }
        const float p2 = expf(m2 - m1); const float w1 = g_w / (1.f + p2), w2 = g_w * p2 / (1.f + p2);
        if (lane == 0) { const int e1 = gs * 8 + i1, e2 = gs * 8 + i2;
            const unsigned pos1 = atomicAdd(cnt + e1 * 64, 1u), pos2 = atomicAdd(cnt + e2 * 64, 1u);
            list[(size_t)e1 * TT + pos1] = (unsigned)row; list[(size_t)e2 * TT + pos2] = (unsigned)row;
            tokslot[2 * row] = ((unsigned)e1 << 16) | pos1; tokslot[2 * row + 1] = ((unsigned)e2 << 16) | pos2; tokw[2 * row] = w1; tokw[2 * row + 1] = w2; }
    }
}
template <bool LAST> __device__ __forceinline__ void p_combine(const Frame& F, int l, int ntok, const MoeTab& tb) {
    const int gw = F.vcu * NWAVES + F.wave, NGW = F.G * NWAVES, lane = F.lane;
    const bf16_t* YB = (const bf16_t*)(F.ws + WS_YB); bf16_t* HX = (bf16_t*)(F.ws + WS_HX);
    const unsigned* tokslot = (const unsigned*)(F.ws + WS_TOK); const float* tokw = (const float*)(F.ws + WS_TOK + 512 * 1024);
    for (int row = gw; row < ntok; row += NGW) {
        const unsigned sa = tokslot[2 * row], sb = tokslot[2 * row + 1]; const float wa = tokw[2 * row], wb = tokw[2 * row + 1];
        const size_t slota = (size_t)tb.tile0[sa >> 16] * 256 + (sa & 0xffffu), slotb = (size_t)tb.tile0[sb >> 16] * 256 + (sb & 0xffffu);
        const int r = modrow(row); const float* g2 = F.mod(l, r, 5); float* xr = F.xr_row(row);
        float ss = 0.f; f32x4 v[4];
#pragma unroll
        for (int j = 0; j < 4; ++j) { const int c = 4 * lane + 256 * j; const u32x2 ya = *(const u32x2*)(YB + slota * 1024 + c), yb = *(const u32x2*)(YB + slotb * 1024 + c);
            const f32x4 x1 = *(const f32x4*)(xr + c), gv = *(const f32x4*)(g2 + c);
            f32x4 y; y[0] = wa * bflo(ya.x) + wb * bflo(yb.x); y[1] = wa * bfhi(ya.x) + wb * bfhi(yb.x); y[2] = wa * bflo(ya.y) + wb * bflo(yb.y); y[3] = wa * bfhi(ya.y) + wb * bfhi(yb.y);
            v[j] = x1 + gv * y; *(f32x4*)(xr + c) = v[j];
            ss += (v[j][0] * v[j][0] + v[j][1] * v[j][1]) + (v[j][2] * v[j][2] + v[j][3] * v[j][3]); }
        if (!LAST) { const float rms = 1.0f / sqrtf(wave_sum(ss) * (1.f / 1024.f) + EPS); const float* g = F.in[I_LN1] + (l + 1) * 1024; const float* sh = F.mod(l + 1, r, 0); const float* sc = F.mod(l + 1, r, 1); f32x4 h[4];
#pragma unroll
            for (int j = 0; j < 4; ++j) { const int c = 4 * lane + 256 * j; h[j] = (v[j] * rms * *(const f32x4*)(g + c)) * (1.f + *(const f32x4*)(sc + c)) + *(const f32x4*)(sh + c); }
            store_row_bf16(HX + (size_t)row * DM, lane, h); }
    }
}

__global__ void __launch_bounds__(NTHREADS, 2) fwd_kernel(Params P) {
    extern __shared__ __attribute__((aligned(16))) unsigned char lds_raw[];
    Frame F;
    F.lds = (LAS unsigned char*)lds_raw; F.in = P.in; F.out = P.out; F.ws = P.ws;
    F.tid = threadIdx.x; F.lane = F.tid & 63; F.wave = __builtin_amdgcn_readfirstlane(F.tid >> 6);
    F.G = gridDim.x; { const int bx = blockIdx.x; F.vcu = (F.G % 8 == 0) ? (bx % 8) * (F.G / 8) + bx / 8 : bx; }
    volatile LAS unsigned* misc = (volatile LAS unsigned*)(F.lds + LDS_MISC);
    if (F.tid < 16) misc[F.tid] = 0u;
    __syncthreads();
#if ONE_LAUNCH
    XcdBarrier bar = xcd_barrier_post((unsigned*)(F.ws + WS_CTL) + CW_BAR, misc + 8);
#define GRID_BAR() do { xcd_barrier(bar); } while (0)
#else
#define GRID_BAR() do { } while (0)
#endif
    const int lo = P.ph_lo, hi = P.ph_hi;
#ifndef PHMASK
#define PHMASK 0xFFFFFFFFu
#endif
#define IN(k) (((PHMASK >> (k)) & 1u) && lo <= (k) && (k) < hi)
#define SEAM(k) do { if (IN((k) + 1)) GRID_BAR(); } while (0)
    bf16_t* HX = (bf16_t*)(F.ws + WS_HX); bf16_t* Qb = (bf16_t*)(F.ws + WS_Q); bf16_t* KVb = (bf16_t*)(F.ws + WS_KV); bf16_t* Gb = (bf16_t*)(F.ws + WS_G); bf16_t* AO = (bf16_t*)(F.ws + WS_AO);
    bf16_t* HID = (bf16_t*)(F.ws + WS_HID); bf16_t* YB = (bf16_t*)(F.ws + WS_YB);

    if (IN(0)) { p0_prologue(F); SEAM(0); }
    if (IN(1)) { p_norm1_l0(F); SEAM(1); }
    if (IN(2)) { SchedDense S{(const bf16_t*)(F.ws + WS_WINAB), 1024, TT / 256, 7, 0, 0, F.vcu, F.G}; EpiInProj<true> E{Qb, KVb, Gb}; gemm_simple(F, HX, 1024, S, E); SEAM(2); }
    if (IN(3)) { p_qkv_post(F, F.in[I_QNA], F.in[I_KNA], true); p_conv(F); SEAM(3); }
    if (IN(4)) { attn_simple<0>(F); SEAM(4); }
    if (IN(5)) { SchedDense S{(const bf16_t*)(F.ws + WS_WOUTAB), 1024, TT / 256, 4, 0, 0, F.vcu, F.G}; EpiOutProj<true> E{F, 0}; gemm_simple(F, AO, 1024, S, E); SEAM(5); }
    if (IN(6)) { p_router(F, 0, TT); SEAM(6); }
    if (IN(7)) { const MoeTab tb = moe_tables(F, 0); SchedMoe S{(const bf16_t*)(F.ws + WS_WGU), (size_t)1024 * 1024, 1024, tb, (const unsigned*)(F.ws + WS_LIST), true, F.vcu, F.G}; EpiMoe1 E{HID}; gemm_simple(F, HX, 1024, S, E); SEAM(7); }
    if (IN(8)) { const MoeTab tb = moe_tables(F, 0); SchedMoe S{(const bf16_t*)(F.ws + WS_WD), (size_t)1024 * 512, 512, tb, nullptr, false, F.vcu, F.G}; EpiMoe2 E{YB}; gemm_simple(F, HID, 512, S, E); SEAM(8); }
    if (IN(9)) { const MoeTab tb = moe_tables(F, 0); p_combine<false>(F, 0, TT, tb); SEAM(9); }
    if (IN(10)) { SchedDense S{(const bf16_t*)(F.ws + WS_WINCD), 1024, TX / 256, 5, TC / 256, 2, F.vcu, F.G}; EpiInProj<false> E{Qb, KVb, Gb}; gemm_simple(F, HX, 1024, S, E); SEAM(10); }
    if (IN(11)) { p_qkv_post(F, F.in[I_QNC], F.in[I_KNC], false); p_pool(F); SEAM(11); }
    if (IN(12)) { attn_simple<1>(F); SEAM(12); }
    if (IN(13)) { SchedDense S{(const bf16_t*)(F.ws + WS_WOUTCD), 1024, TX / 256, 4, 0, 0, F.vcu, F.G}; EpiOutProj<false> E{F, 1}; gemm_simple(F, AO, 1024, S, E); SEAM(13); }
    if (IN(14)) { p_router(F, 1, TX); SEAM(14); }
    if (IN(15)) { const MoeTab tb = moe_tables(F, 1); SchedMoe S{(const bf16_t*)(F.ws + WS_WGU) + (size_t)32 * 1024 * 1024, (size_t)1024 * 1024, 1024, tb, (const unsigned*)(F.ws + WS_LIST), true, F.vcu, F.G}; EpiMoe1 E{HID}; gemm_simple(F, HX, 1024, S, E); SEAM(15); }
    if (IN(16)) { const MoeTab tb = moe_tables(F, 1); SchedMoe S{(const bf16_t*)(F.ws + WS_WD) + (size_t)32 * 1024 * 512, (size_t)1024 * 512, 512, tb, nullptr, false, F.vcu, F.G}; EpiMoe2 E{YB}; gemm_simple(F, HID, 512, S, E); SEAM(16); }
    if (IN(17)) { const MoeTab tb = moe_tables(F, 1); p_combine<true>(F, 1, TX, tb); }
#undef IN
#undef SEAM
}

extern "C" void kernel_launch(void* const* d_in, const int* in_sizes, int n_in, void* d_out, int out_size, void* d_ws, size_t ws_size, hipStream_t stream) {
    static int grid = 0;
    if (grid == 0) {
        if (n_in != 30 || out_size != TX * DM || ws_size < WS_END) { fprintf(stderr, "kernel_launch: unexpected shapes (n_in %d out %d ws %zu)\n", n_in, out_size, ws_size); grid = -1; return; }
        int dev = 0, cus = 0;
        if (hipGetDevice(&dev) != hipSuccess || hipDeviceGetAttribute(&cus, hipDeviceAttributeMultiprocessorCount, dev) != hipSuccess) { grid = -1; return; }
        if (hipFuncSetAttribute((const void*)fwd_kernel, hipFuncAttributeMaxDynamicSharedMemorySize, LDS_BYTES) != hipSuccess) { fprintf(stderr, "kernel_launch: hipFuncSetAttribute failed\n"); grid = -1; return; }
        int per_cu = 0;
        if (hipOccupancyMaxActiveBlocksPerMultiprocessor(&per_cu, (const void*)fwd_kernel, NTHREADS, LDS_BYTES) != hipSuccess || per_cu < 1) { fprintf(stderr, "kernel_launch: occupancy query says %d\n", per_cu); }
        (void)hipGetLastError();
        grid = cus;
    }
    if (grid < 0) return;
    (void)hipMemsetAsync((char*)d_ws + WS_CTL, 0, CTL_ZERO_BYTES, stream);
    Params p{};
    for (int i = 0; i < 30; ++i) p.in[i] = (const float*)d_in[i];
    p.out = (float*)d_out; p.ws = (unsigned char*)d_ws;
#if ONE_LAUNCH
    p.ph_lo = 0; p.ph_hi = NPH;
    hipLaunchKernelGGL(fwd_kernel, dim3(grid), dim3(NTHREADS), LDS_BYTES, stream, p);
#else
    for (int ph = 0; ph < NPH; ++ph) { p.ph_lo = ph; p.ph_hi = ph + 1; hipLaunchKernelGGL(fwd_kernel, dim3(grid), dim3(NTHREADS), LDS_BYTES, stream, p); }
#endif
}
```

```cpp
#include <hip/hip_runtime.h>
#include <cstdio>
#include <cstdint>

#ifndef ONE_LAUNCH
#define ONE_LAUNCH 1
#endif

#define LAS __attribute__((address_space(3)))
#define GAS __attribute__((address_space(1)))
typedef unsigned short bf16_t;
typedef short bf16x8 __attribute__((ext_vector_type(8)));
typedef float f32x4 __attribute__((ext_vector_type(4)));
typedef float f32x2 __attribute__((ext_vector_type(2)));
typedef unsigned u32x4 __attribute__((ext_vector_type(4)));
typedef unsigned u32x2 __attribute__((ext_vector_type(2)));
typedef __bf16 bf16x2_t __attribute__((ext_vector_type(2)));

constexpr int NB = 8, SEQ = 4096, DM = 1024, CTXL = 256, HD = 64;
constexpr int TX = NB * SEQ, TC = NB * CTXL, TT = TX + TC;
constexpr int KVS = CTXL + SEQ;
constexpr int NE = 32;
constexpr int NTILE_MAX = 304, NSLOT = NTILE_MAX * 256;
constexpr float EPS = 1e-6f;
constexpr float LOG2E = 1.4426950408889634f;
constexpr float C2 = 0.125f * LOG2E;
constexpr int NWAVES = 8, NTHREADS = 512;
constexpr int NPH = 18;

enum { I_X = 0, I_C, I_CTX, I_CCTX, I_MODW, I_MODB, I_LN1, I_LN2, I_WINAB, I_WOUTAB, I_QNA, I_KNA, I_CONVW, I_CONVB, I_CLNG, I_CLNB,
       I_WINCD, I_WOUTCD, I_QNC, I_KNC, I_SINK, I_POOLW, I_POOLS, I_RGW, I_RGB, I_REW, I_REB, I_EXG, I_EXU, I_EXD };

constexpr size_t MiB = 1u << 20;
constexpr size_t WS_CTL = 0, CTL_ZERO_BYTES = 1 * MiB;
constexpr size_t WS_MOD = 1 * MiB;
constexpr size_t WS_ROPE = 2 * MiB;
constexpr size_t WS_TOK = 3 * MiB;
constexpr size_t WS_LIST = 4 * MiB;
constexpr size_t WS_WINAB = 10 * MiB;
constexpr size_t WS_WOUTAB = 14 * MiB;
constexpr size_t WS_WINCD = 16 * MiB;
constexpr size_t WS_WOUTCD = 19 * MiB;
constexpr size_t WS_XC = 21 * MiB;
constexpr size_t WS_KN = 30 * MiB;
constexpr size_t WS_VN = 39 * MiB;
constexpr size_t WS_WGU = 48 * MiB;
constexpr size_t WS_WD = 176 * MiB;
constexpr size_t WS_HX = 240 * MiB;
constexpr size_t WS_HID = 308 * MiB;
constexpr size_t WS_Q = 384 * MiB;
constexpr size_t WS_KV = 418 * MiB;
constexpr size_t WS_G = 435 * MiB;
constexpr size_t WS_AO = 469 * MiB;
constexpr size_t WS_YB = 384 * MiB;
constexpr size_t WS_END = 537 * MiB;
static_assert(WS_YB + (size_t)NSLOT * 1024 * 2 <= WS_END && WS_AO + (size_t)TT * 1024 * 2 <= WS_END, "ws map");
constexpr int CW_CNT = 256;
constexpr int CW_BAR = 8192;

constexpr int RING_BYTES = 131072;
constexpr int LDS_MISC = RING_BYTES;
constexpr int LDS_TAB = RING_BYTES + 256;
constexpr int LDS_BYTES = 147456;

__device__ __forceinline__ unsigned pk2(float lo, float hi) { f32x2 v = {lo, hi}; bf16x2_t b = __builtin_convertvector(v, bf16x2_t); return __builtin_bit_cast(unsigned, b); }
__device__ __forceinline__ float bflo(unsigned w) { return __uint_as_float(w << 16); }
__device__ __forceinline__ float bfhi(unsigned w) { return __uint_as_float(w & 0xffff0000u); }
__device__ __forceinline__ float bf2f(bf16_t h) { return __uint_as_float((unsigned)h << 16); }
__device__ __forceinline__ float wave_sum(float v) {
#pragma unroll
    for (int o = 1; o < 64; o <<= 1) v += __shfl_xor(v, o);
    return v;
}
__device__ __forceinline__ float sigmoidf_(float v) { return 1.f / (1.f + __expf(-v)); }

#define XB_TMO      128
#define XB_XCNT(j)  (256  + 64 * (j))
#define XB_XSUB(j)  (1280 + 64 * (j))
#define XB_XGEN(j)  (2304 + 64 * (j))
#define XB_TOP      3328
#define XB_TOPGEN   3392
#define XCD_BAR_WORDS 3456
#define XB_SPIN_CAP (1u << 18)
__device__ __forceinline__ unsigned xb_ld(unsigned* p)              { return __hip_atomic_load(p, __ATOMIC_RELAXED, __HIP_MEMORY_SCOPE_AGENT); }
__device__ __forceinline__ unsigned xb_add(unsigned* p, unsigned v) { return __hip_atomic_fetch_add(p, v, __ATOMIC_RELAXED, __HIP_MEMORY_SCOPE_AGENT); }
__device__ __forceinline__ unsigned xb_xcc_id() { return (unsigned)__builtin_amdgcn_s_getreg((3 << 11) | 20) & 0xFu; }
#define XB_SPIN(cond, bar) do { unsigned _sp = 0; while (cond) { __builtin_amdgcn_s_sleep(1); \
    if ((++_sp & 255u) == 0u) { if (xb_ld(&(bar)[XB_TMO])) break; if (_sp > XB_SPIN_CAP) { atomicAdd(&(bar)[XB_TMO], 1u); break; } } } } while (0)
struct XcdBarrier { unsigned* bar; unsigned x; volatile LAS unsigned* st; };
__device__ __forceinline__ XcdBarrier xcd_barrier_post(unsigned* bar, volatile LAS unsigned* st) {
    XcdBarrier b; b.bar = bar; b.x = xb_xcc_id(); b.st = st;
    if (threadIdx.x == 0) (void)xb_add(&bar[XB_XCNT(b.x)], 1u);
    return b;
}
__device__ __forceinline__ void xcd_barrier_complete(unsigned* bar, unsigned x, unsigned& nloc, unsigned& nx) {
    const unsigned G = gridDim.x * gridDim.y * gridDim.z;
    unsigned sum, cnt, mine, sp = 0u;
    for (;;) {
        sum = 0u; cnt = 0u; mine = 0u;
#pragma unroll
        for (unsigned j = 0; j < 16; ++j) { const unsigned c = xb_ld(&bar[XB_XCNT(j)]); sum += c; cnt += (c > 0u) ? 1u : 0u; mine = (j == x) ? c : mine; }
        if (sum == G) break;
        __builtin_amdgcn_s_sleep(1);
        if ((++sp & 255u) == 0u) { if (xb_ld(&bar[XB_TMO])) break; if (sp > XB_SPIN_CAP) { atomicAdd(&bar[XB_TMO], 1u); break; } }
    }
    nloc = mine > 0u ? mine : 1u; nx = cnt > 0u ? cnt : 1u;
}
__device__ __forceinline__ void xcd_barrier(const XcdBarrier& b) {
    asm volatile("s_waitcnt vmcnt(0)" ::: "memory");
    __syncthreads();
    if (threadIdx.x == 0) {
        unsigned* bar = b.bar;
        __builtin_amdgcn_s_waitcnt(0);
        unsigned nloc = b.st[0], nx = b.st[1];
        if (nloc == 0u) { xcd_barrier_complete(bar, b.x, nloc, nx); b.st[0] = nloc; b.st[1] = nx; }
        const unsigned old = xb_add(&bar[XB_XSUB(b.x)], 1u);
        const unsigned gen = old / nloc;
        if (old + 1u == (gen + 1u) * nloc) {
            __builtin_amdgcn_fence(__ATOMIC_RELEASE, "agent");
            asm volatile("s_waitcnt vmcnt(0)" ::: "memory");
            const unsigned og = xb_add(&bar[XB_TOP], 1u);
            const unsigned tg = og / nx;
            if (og + 1u == (tg + 1u) * nx) xb_add(&bar[XB_TOPGEN], 1u);
            else XB_SPIN(xb_ld(&bar[XB_TOPGEN]) == tg, bar);
            __builtin_amdgcn_fence(__ATOMIC_ACQUIRE, "agent");
            xb_add(&bar[XB_XGEN(b.x)], 1u);
            asm volatile("s_waitcnt vmcnt(0)" ::: "memory");
        } else {
            XB_SPIN(xb_ld(&bar[XB_XGEN(b.x)]) == gen, bar);
            __builtin_amdgcn_fence(__ATOMIC_ACQUIRE, "agent");
            asm volatile("s_waitcnt vmcnt(0)" ::: "memory");
        }
    }
    __syncthreads();
}

struct Params { const float* in[30]; float* out; unsigned char* ws; int ph_lo, ph_hi; };
struct Frame {
    LAS unsigned char* lds;
    const float* const* in;
    float* out; unsigned char* ws;
    int tid, lane, wave, vcu, G;
    __device__ __forceinline__ const float* mod(int l, int r, int chunk) const { return (const float*)(ws + WS_MOD) + ((size_t)(l * 9 + r) * 6144 + chunk * 1024); }
    __device__ __forceinline__ float* xr_row(int row) const { return row < TX ? out + (size_t)row * DM : (float*)(ws + WS_XC) + (size_t)(row - TX) * DM; }
    __device__ __forceinline__ const float* xin_row(int row) const { return row < TX ? in[I_X] + (size_t)row * DM : in[I_CTX] + (size_t)(row - TX) * DM; }
    __device__ __forceinline__ unsigned* cnt(int l) const { return (unsigned*)(ws + WS_CTL) + CW_CNT + l * 32 * 64; }
};
__device__ __forceinline__ int modrow(int row) { return row < TX ? (row >> 12) : 8; }

__device__ __forceinline__ void p0_mod_item(const Frame& F, int item) {
    const int l = item / 96, cg = item % 96;
    LAS float* sc = (LAS float*)F.lds;
    LAS float* red = sc + 9 * 1024;
    for (int i = F.tid; i < 9 * 1024; i += NTHREADS) { const int r = i >> 10, k = i & 1023; const float v = r < 8 ? F.in[I_C][r * 1024 + k] : F.in[I_CCTX][k]; sc[i] = v / (1.f + expf(-v)); }
    __syncthreads();
    const float* W = F.in[I_MODW] + (size_t)l * 1024 * 6144 + cg * 64 + F.lane;
    float acc[9];
#pragma unroll
    for (int r = 0; r < 9; ++r) acc[r] = 0.f;
#pragma unroll 8
    for (int kk = 0; kk < 128; ++kk) { const int k = F.wave * 128 + kk; const float w = W[(size_t)k * 6144];
#pragma unroll
        for (int r = 0; r < 9; ++r) acc[r] += sc[r * 1024 + k] * w; }
#pragma unroll
    for (int r = 0; r < 9; ++r) red[(F.wave * 9 + r) * 64 + F.lane] = acc[r];
    __syncthreads();
    for (int i = F.tid; i < 9 * 64; i += NTHREADS) { const int r = i >> 6, ln = i & 63; float s = 0.f;
#pragma unroll
        for (int w = 0; w < 8; ++w) s += red[(w * 9 + r) * 64 + ln];
        ((float*)(F.ws + WS_MOD))[(size_t)(l * 9 + r) * 6144 + cg * 64 + ln] = s + F.in[I_MODB][l * 6144 + cg * 64 + ln]; }
    __syncthreads();
}
__device__ __forceinline__ void transpose_item(const float* W, int ldw, int k0, int n0, bf16_t* WT, int ldt, int drow0, int kcol0, LAS float* scr, int lane) {
    const int kr = lane >> 3, nq = lane & 7;
    f32x4 v[8];
#pragma unroll
    for (int i = 0; i < 8; ++i) v[i] = *(const f32x4*)(W + (size_t)(k0 + 8 * i + kr) * ldw + n0 + 4 * nq);
#pragma unroll
    for (int i = 0; i < 8; ++i) { LAS float* s = scr + (8 * i + kr) * 33 + 4 * nq; s[0] = v[i][0]; s[1] = v[i][1]; s[2] = v[i][2]; s[3] = v[i][3]; }
    asm volatile("s_waitcnt lgkmcnt(0)" ::: "memory");
    const int c = lane & 7;
#pragma unroll
    for (int j = 0; j < 4; ++j) { const int n = (lane >> 3) + 8 * j; const LAS float* s = scr + (8 * c) * 33 + n;
        u32x4 o; o.x = pk2(s[0 * 33], s[1 * 33]); o.y = pk2(s[2 * 33], s[3 * 33]); o.z = pk2(s[4 * 33], s[5 * 33]); o.w = pk2(s[6 * 33], s[7 * 33]);
        *(u32x4*)(WT + (size_t)(drow0 + n) * ldt + kcol0 + k0 + 8 * c) = o; }
    asm volatile("s_waitcnt lgkmcnt(0)" ::: "memory");
}
__device__ __forceinline__ void p0_prologue(const Frame& F) {
    for (int it = F.vcu; it < 192; it += F.G) p0_mod_item(F, it);
    const int gw = F.vcu * NWAVES + F.wave, NGW = F.G * NWAVES;
    const int gt = gw * 64 + F.lane, NGT = NGW * 64;
    { float* rc = (float*)(F.ws + WS_ROPE); float* rs = rc + SEQ * 32;
      for (int i = gt; i < SEQ * 32; i += NGT) { const int s = i >> 5, d = i & 31, f = d & 15; const float pos = (float)(d < 16 ? (s >> 6) : (s & 63));
          const float inv = exp2f(-(float)f * (13.287712379549449f / 16.f)); const float a = pos * inv; rc[i] = cosf(a); rs[i] = sinf(a); } }
    { bf16_t* WT = (bf16_t*)(F.ws + WS_WOUTCD); const float* pw = F.in[I_POOLW]; const float* ps = F.in[I_POOLS]; const float* wo = F.in[I_WOUTCD];
      for (int i = gt; i < 512 * 1024; i += NGT) { const int kk = i >> 10, d = i & 1023, g = kk >> 7; float s = 0.f;
          const float* pwr = pw + (size_t)kk * 128; const float* psr = ps + g * 128; const float* wor = wo + (size_t)(512 + g * 128) * 1024 + d;
#pragma unroll 8
          for (int dp = 0; dp < 128; ++dp) s += pwr[dp] * psr[dp] * wor[(size_t)dp * 1024];
          WT[(size_t)d * 1024 + 512 + kk] = (bf16_t)(pk2(s, 0.f) & 0xffffu); } }
    LAS float* scr = (LAS float*)(F.lds + F.wave * 8448);
    constexpr int N_AB = 16 * 56, N_OAB = 16 * 32, N_CD = 16 * 40, N_OCD = 8 * 32, N_G = 64 * 256, N_U = 64 * 256, N_D = 64 * 256;
    constexpr int NITEMS = N_AB + N_OAB + N_CD + N_OCD + N_G + N_U + N_D;
    for (int it = gw; it < NITEMS; it += NGW) {
        int r = it;
        if (r < N_AB) { const int kb = r / 56, nb = r % 56, n0 = nb * 32; int d0;
            if (n0 < 768) d0 = n0; else if (n0 < 1280) { const int j = n0 - 768; d0 = 768 + (j >> 7) * 256 + (j & 127); } else { const int j = n0 - 1280; d0 = 768 + (j >> 7) * 256 + 128 + (j & 127); }
            transpose_item(F.in[I_WINAB], 1792, kb * 64, n0, (bf16_t*)(F.ws + WS_WINAB), 1024, d0, 0, scr, F.lane); continue; } r -= N_AB;
        if (r < N_OAB) { const int kb = r / 32, nb = r % 32; transpose_item(F.in[I_WOUTAB], 1024, kb * 64, nb * 32, (bf16_t*)(F.ws + WS_WOUTAB), 1024, nb * 32, 0, scr, F.lane); continue; } r -= N_OAB;
        if (r < N_CD) { const int kb = r / 40, nb = r % 40; transpose_item(F.in[I_WINCD], 1280, kb * 64, nb * 32, (bf16_t*)(F.ws + WS_WINCD), 1024, nb * 32, 0, scr, F.lane); continue; } r -= N_CD;
        if (r < N_OCD) { const int kb = r / 32, nb = r % 32; transpose_item(F.in[I_WOUTCD], 1024, kb * 64, nb * 32, (bf16_t*)(F.ws + WS_WOUTCD), 1024, nb * 32, 0, scr, F.lane); continue; } r -= N_OCD;
        if (r < N_G + N_U) { const bool up = r >= N_G; if (up) r -= N_G; const int le = r >> 8, q = r & 255, kb = q >> 4, nb = q & 15, n0 = nb * 32;
            const int d0 = (n0 >> 7) * 256 + (up ? 128 : 0) + (n0 & 127);
            transpose_item(F.in[up ? I_EXU : I_EXG] + (size_t)le * 1024 * 512, 512, kb * 64, n0, (bf16_t*)(F.ws + WS_WGU) + (size_t)le * 1024 * 1024, 1024, d0, 0, scr, F.lane); continue; } r -= N_G + N_U;
        { const int le = r >> 8, q = r & 255, kb = q >> 5, nb = q & 31;
            transpose_item(F.in[I_EXD] + (size_t)le * 512 * 1024, 1024, kb * 64, nb * 32, (bf16_t*)(F.ws + WS_WD) + (size_t)le * 1024 * 512, 512, nb * 32, 0, scr, F.lane); }
    }
}

__device__ __forceinline__ void norm_mod_row(const float* xrow, const float* g, const float* sh, const float* sc, int lane, f32x4 (&h)[4]) {
    f32x4 v[4]; float ss = 0.f;
#pragma unroll
    for (int j = 0; j < 4; ++j) { v[j] = *(const f32x4*)(xrow + 4 * lane + 256 * j); ss += (v[j][0] * v[j][0] + v[j][1] * v[j][1]) + (v[j][2] * v[j][2] + v[j][3] * v[j][3]); }
    const float rms = 1.0f / sqrtf(wave_sum(ss) * (1.f / 1024.f) + EPS);
#pragma unroll
    for (int j = 0; j < 4; ++j) { const int c = 4 * lane + 256 * j; const f32x4 gg = *(const f32x4*)(g + c), s1 = *(const f32x4*)(sc + c), s0 = *(const f32x4*)(sh + c);
        h[j] = (v[j] * rms * gg) * (1.f + s1) + s0; }
}
__device__ __forceinline__ void store_row_bf16(bf16_t* orow, int lane, const f32x4 (&h)[4]) {
#pragma unroll
    for (int j = 0; j < 4; ++j) { u32x2 o; o.x = pk2(h[j][0], h[j][1]); o.y = pk2(h[j][2], h[j][3]); *(u32x2*)(orow + 4 * lane + 256 * j) = o; }
}
__device__ __forceinline__ void p_norm1_l0(const Frame& F) {
    const int gw = F.vcu * NWAVES + F.wave, NGW = F.G * NWAVES;
    bf16_t* HX = (bf16_t*)(F.ws + WS_HX);
    for (int row = gw; row < TT; row += NGW) { const int r = modrow(row); f32x4 h[4];
        norm_mod_row(F.xin_row(row), F.in[I_LN1], F.mod(0, r, 0), F.mod(0, r, 1), F.lane, h);
        store_row_bf16(HX + (size_t)row * DM, F.lane, h); }
}

struct Unit { int pm, pn, e; };
struct SchedDense {
    const bf16_t* Bt; int K, nMa, nN, nMb, pnb, vcu, G;
    __device__ __forceinline__ bool next(int i, Unit& u) const { int L = i * G + vcu; const int na = nMa * nN; u.e = 0;
        if (L < na) { u.pm = L / nN; u.pn = L % nN; return true; } L -= na; if (L < nMb) { u.pm = nMa + L; u.pn = pnb; return true; } return false; }
    __device__ __forceinline__ int arow(const Unit& u, int r) const { return u.pm * 256 + r; }
    __device__ __forceinline__ const bf16_t* bbase(const Unit& u) const { return Bt + (size_t)u.pn * 256 * K; }
};
struct MoeTab { const LAS int* tile_e; const LAS int* tile0; const LAS int* cnt; int ntiles; };
struct SchedMoe {
    const bf16_t* Wt; size_t estride; int K; MoeTab tb; const unsigned* list; bool gather; int vcu, G;
    __device__ __forceinline__ bool next(int i, Unit& u) const { const int L = i * G + vcu; if (L >= tb.ntiles * 4) return false; u.pm = L >> 2; u.pn = L & 3; u.e = tb.tile_e[u.pm]; return true; }
    __device__ __forceinline__ int arow(const Unit& u, int r) const {
        if (!gather) return u.pm * 256 + r;
        int idx = (u.pm - tb.tile0[u.e]) * 256 + r; const int c = tb.cnt[u.e]; idx = idx < c ? idx : c - 1;
        return (int)list[(size_t)u.e * TT + idx]; }
    __device__ __forceinline__ const bf16_t* bbase(const Unit& u) const { return Wt + (size_t)u.e * estride + (size_t)u.pn * 256 * K; }
};
__device__ __forceinline__ MoeTab moe_tables(const Frame& F, int l) {
    LAS int* tile_e = (LAS int*)(F.lds + LDS_TAB); LAS int* tile0 = tile_e + NTILE_MAX; LAS int* cntl = tile0 + 33; LAS int* nt = cntl + 32;
    __syncthreads();
    if (F.tid == 0) { int t = 0; unsigned* cg = F.cnt(l);
        for (int e = 0; e < NE; ++e) { const int c = (int)__hip_atomic_load(cg + e * 64, __ATOMIC_RELAXED, __HIP_MEMORY_SCOPE_AGENT); const int n = (c + 255) >> 8; tile0[e] = t; cntl[e] = c;
            for (int j = 0; j < n; ++j) tile_e[t + j] = e; t += n; }
        tile0[32] = t; nt[0] = t; }
    __syncthreads();
    MoeTab tb; tb.tile_e = tile_e; tb.tile0 = tile0; tb.cnt = cntl; tb.ntiles = nt[0]; return tb;
}

template <class Sched, class Epi>
__device__ __forceinline__ void gemm_simple(const Frame& F, const bf16_t* A, int K, const Sched& S, const Epi& E) {
    const int wr = F.wave >> 2, wc = F.wave & 3, fr = F.lane & 15, fq = F.lane >> 4;
    Unit u;
    for (int i = 0; S.next(i, u); ++i) {
        f32x4 acc[2][2][4][2];
#pragma unroll
        for (int a = 0; a < 2; ++a)
#pragma unroll
            for (int b = 0; b < 2; ++b)
#pragma unroll
                for (int m = 0; m < 4; ++m)
#pragma unroll
                    for (int n = 0; n < 2; ++n) acc[a][b][m][n] = (f32x4){0.f, 0.f, 0.f, 0.f};
        unsigned aoff[2][4], boff[2][2];
#pragma unroll
        for (int a = 0; a < 2; ++a)
#pragma unroll
            for (int m = 0; m < 4; ++m) aoff[a][m] = (unsigned)S.arow(u, 128 * a + 64 * wr + 16 * m + fr) * (unsigned)K + 8u * fq;
        const bf16_t* bb = S.bbase(u);
#pragma unroll
        for (int b = 0; b < 2; ++b)
#pragma unroll
            for (int n = 0; n < 2; ++n) boff[b][n] = (unsigned)(128 * b + 32 * wc + 8 * (fr >> 2) + 4 * n + (fr & 3)) * (unsigned)K + 8u * fq;
#pragma unroll 1
        for (int k0 = 0; k0 < K; k0 += 32) {
            bf16x8 bf[2][2];
#pragma unroll
            for (int b = 0; b < 2; ++b)
#pragma unroll
                for (int n = 0; n < 2; ++n) bf[b][n] = *(const bf16x8*)(bb + boff[b][n] + k0);
#pragma unroll
            for (int a = 0; a < 2; ++a) {
                bf16x8 af[4];
#pragma unroll
                for (int m = 0; m < 4; ++m) af[m] = *(const bf16x8*)(A + aoff[a][m] + k0);
#pragma unroll
                for (int b = 0; b < 2; ++b)
#pragma unroll
                    for (int m = 0; m < 4; ++m)
#pragma unroll
                        for (int n = 0; n < 2; ++n) acc[a][b][m][n] = __builtin_amdgcn_mfma_f32_16x16x32_bf16(bf[b][n], af[m], acc[a][b][m][n], 0, 0, 0);
            }
        }
        E(acc, u, wr, wc, fr, fq);
    }
}

__device__ __forceinline__ u32x4 pack8(const f32x4& a, const f32x4& b) { u32x4 w; w.x = pk2(a[0], a[1]); w.y = pk2(a[2], a[3]); w.z = pk2(b[0], b[1]); w.w = pk2(b[2], b[3]); return w; }
template <bool GLU> struct EpiInProj {
    bf16_t* Q; bf16_t* KV; bf16_t* Gb;
    __device__ __forceinline__ void operator()(const f32x4 (&acc)[2][2][4][2], const Unit& u, int wr, int wc, int fr, int fq) const {
#pragma unroll
        for (int ai = 0; ai < 2; ++ai)
#pragma unroll
            for (int m = 0; m < 4; ++m) { const size_t row = (size_t)u.pm * 256 + 128 * ai + 64 * wr + 16 * m + fr; const int cl = 32 * wc + 8 * fq;
                if (u.pn < 2) { *(u32x4*)(Q + row * 512 + u.pn * 256 + cl) = pack8(acc[ai][0][m][0], acc[ai][0][m][1]); *(u32x4*)(Q + row * 512 + u.pn * 256 + 128 + cl) = pack8(acc[ai][1][m][0], acc[ai][1][m][1]); }
                else if (u.pn == 2) { *(u32x4*)(KV + row * 256 + cl) = pack8(acc[ai][0][m][0], acc[ai][0][m][1]); *(u32x4*)(KV + row * 256 + 128 + cl) = pack8(acc[ai][1][m][0], acc[ai][1][m][1]); }
                else if (GLU) { f32x4 g0, g1;
#pragma unroll
                    for (int j = 0; j < 4; ++j) { g0[j] = acc[ai][0][m][0][j] * sigmoidf_(acc[ai][1][m][0][j]); g1[j] = acc[ai][0][m][1][j] * sigmoidf_(acc[ai][1][m][1][j]); }
                    *(u32x4*)(Gb + row * 512 + (u.pn - 3) * 128 + cl) = pack8(g0, g1); }
                else { *(u32x4*)(Gb + row * 512 + (u.pn - 3) * 256 + cl) = pack8(acc[ai][0][m][0], acc[ai][0][m][1]); *(u32x4*)(Gb + row * 512 + (u.pn - 3) * 256 + 128 + cl) = pack8(acc[ai][1][m][0], acc[ai][1][m][1]); }
            }
    }
};
template <bool L0> struct EpiOutProj {
    Frame F; int l;
    __device__ __forceinline__ void operator()(const f32x4 (&acc)[2][2][4][2], const Unit& u, int wr, int wc, int fr, int fq) const {
#pragma unroll
        for (int ai = 0; ai < 2; ++ai)
#pragma unroll
            for (int m = 0; m < 4; ++m) { const int row = u.pm * 256 + 128 * ai + 64 * wr + 16 * m + fr; const float* g1 = F.mod(l, modrow(row), 2);
                const float* src = L0 ? F.xin_row(row) : F.xr_row(row); float* dst = F.xr_row(row);
#pragma unroll
                for (int bj = 0; bj < 2; ++bj)
#pragma unroll
                    for (int n = 0; n < 2; ++n) { const int c = u.pn * 256 + 128 * bj + 32 * wc + 8 * fq + 4 * n;
                        const f32x4 xv = *(const f32x4*)(src + c), gv = *(const f32x4*)(g1 + c); *(f32x4*)(dst + c) = xv + gv * acc[ai][bj][m][n]; } }
    }
};
struct EpiMoe1 {
    bf16_t* HID;
    __device__ __forceinline__ void operator()(const f32x4 (&acc)[2][2][4][2], const Unit& u, int wr, int wc, int fr, int fq) const {
#pragma unroll
        for (int ai = 0; ai < 2; ++ai)
#pragma unroll
            for (int m = 0; m < 4; ++m) { const size_t slot = (size_t)u.pm * 256 + 128 * ai + 64 * wr + 16 * m + fr; f32x4 h0, h1;
#pragma unroll
                for (int j = 0; j < 4; ++j) { const float a = acc[ai][0][m][0][j], b = acc[ai][0][m][1][j]; h0[j] = a * sigmoidf_(a) * acc[ai][1][m][0][j]; h1[j] = b * sigmoidf_(b) * acc[ai][1][m][1][j]; }
                *(u32x4*)(HID + slot * 512 + u.pn * 128 + 32 * wc + 8 * fq) = pack8(h0, h1); }
    }
};
struct EpiMoe2 {
    bf16_t* YB;
    __device__ __forceinline__ void operator()(const f32x4 (&acc)[2][2][4][2], const Unit& u, int wr, int wc, int fr, int fq) const {
#pragma unroll
        for (int ai = 0; ai < 2; ++ai)
#pragma unroll
            for (int m = 0; m < 4; ++m) { const size_t slot = (size_t)u.pm * 256 + 128 * ai + 64 * wr + 16 * m + fr;
#pragma unroll
                for (int bj = 0; bj < 2; ++bj) *(u32x4*)(YB + slot * 1024 + u.pn * 256 + 128 * bj + 32 * wc + 8 * fq) = pack8(acc[ai][bj][m][0], acc[ai][bj][m][1]); }
    }
};

__device__ __forceinline__ void p_qkv_post(const Frame& F, const float* qg, const float* kg, bool ctx_q) {
    const int gw = F.vcu * NWAVES + F.wave, NGW = F.G * NWAVES, lane = F.lane;
    bf16_t* Q = (bf16_t*)(F.ws + WS_Q); const bf16_t* KV = (const bf16_t*)(F.ws + WS_KV); bf16_t* Kn = (bf16_t*)(F.ws + WS_KN); bf16_t* Vn = (bf16_t*)(F.ws + WS_VN);
    const float* rc = (const float*)(F.ws + WS_ROPE); const float* rs = rc + SEQ * 32;
    const int i8 = lane & 7, dd0 = 8 * (i8 & 3);
    float gq[8], gk[8];
#pragma unroll
    for (int j = 0; j < 8; ++j) { gq[j] = qg[i8 * 8 + j]; gk[j] = kg[i8 * 8 + j]; }
    for (int row = gw; row < TT; row += NGW) {
        const bool isctx = row >= TX; const int b = isctx ? (row - TX) >> 8 : row >> 12, s = isctx ? (row - TX) & 255 : row & 4095;
        float cs[8], sn[8];
#pragma unroll
        for (int j = 0; j < 8; ++j) { cs[j] = 1.f; sn[j] = 0.f; }
        if (!isctx) {
#pragma unroll
            for (int j = 0; j < 8; ++j) { cs[j] = rc[s * 32 + dd0 + j]; sn[j] = rs[s * 32 + dd0 + j]; } }
        const float sgn = (i8 < 4) ? -1.f : 1.f;
        if (!isctx || ctx_q) {
            const u32x4 w = *(const u32x4*)(Q + (size_t)row * 512 + lane * 8);
            float x[8] = {bflo(w.x), bfhi(w.x), bflo(w.y), bfhi(w.y), bflo(w.z), bfhi(w.z), bflo(w.w), bfhi(w.w)};
            float ss = 0.f;
#pragma unroll
            for (int j = 0; j < 8; ++j) ss += x[j] * x[j];
            ss += __shfl_xor(ss, 1); ss += __shfl_xor(ss, 2); ss += __shfl_xor(ss, 4);
            const float rms = 1.0f / sqrtf(ss * (1.f / 64.f) + EPS);
            float y[8], o[8];
#pragma unroll
            for (int j = 0; j < 8; ++j) y[j] = x[j] * rms * gq[j];
#pragma unroll
            for (int j = 0; j < 8; ++j) { const float yp = __shfl_xor(y[j], 4); o[j] = (y[j] * cs[j] + sgn * yp * sn[j]) * C2; }
            u32x4 ow; ow.x = pk2(o[0], o[1]); ow.y = pk2(o[2], o[3]); ow.z = pk2(o[4], o[5]); ow.w = pk2(o[6], o[7]);
            *(u32x4*)(Q + (size_t)row * 512 + lane * 8) = ow;
        }
        {
            const int l32 = lane & 31;
            const u32x4 w = *(const u32x4*)(KV + (size_t)row * 256 + l32 * 8);
            float x[8] = {bflo(w.x), bfhi(w.x), bflo(w.y), bfhi(w.y), bflo(w.z), bfhi(w.z), bflo(w.w), bfhi(w.w)};
            float ss = 0.f;
#pragma unroll
            for (int j = 0; j < 8; ++j) ss += x[j] * x[j];
            ss += __shfl_xor(ss, 1); ss += __shfl_xor(ss, 2); ss += __shfl_xor(ss, 4);
            const float rms = 1.0f / sqrtf(ss * (1.f / 64.f) + EPS);
            float y[8], o[8];
#pragma unroll
            for (int j = 0; j < 8; ++j) y[j] = x[j] * rms * gk[j];
#pragma unroll
            for (int j = 0; j < 8; ++j) { const float yp = __shfl_xor(y[j], 4); o[j] = y[j] * cs[j] + sgn * yp * sn[j]; }
            const size_t kvrow = (size_t)b * KVS + (isctx ? s : CTXL + s);
            if (lane < 16) { u32x4 ow; ow.x = pk2(o[0], o[1]); ow.y = pk2(o[2], o[3]); ow.z = pk2(o[4], o[5]); ow.w = pk2(o[6], o[7]); *(u32x4*)(Kn + kvrow * 128 + lane * 8) = ow; }
            else if (lane < 32) { *(u32x4*)(Vn + kvrow * 128 + (lane - 16) * 8) = w; }
        }
    }
}
__device__ __forceinline__ void p_conv(const Frame& F) {
    const bf16_t* Gb = (const bf16_t*)(F.ws + WS_G); bf16_t* AO = (bf16_t*)(F.ws + WS_AO);
    LAS bf16_t* gl = (LAS bf16_t*)F.lds;
    LAS float* yl = (LAS float*)(F.lds + 65536);
    const int c = F.tid;
    float w[31];
#pragma unroll
    for (int j = 0; j < 31; ++j) w[j] = F.in[I_CONVW][j * 512 + c];
    const float bias = F.in[I_CONVB][c];
    for (int item = F.vcu; item < 1024 + 64; item += F.G) {
        int rowbase, t0, len;
        if (item < 1024) { rowbase = (item >> 7) * SEQ; t0 = (item & 127) * 32; len = SEQ; } else { const int it = item - 1024; rowbase = TX + (it >> 3) * CTXL; t0 = (it & 7) * 32; len = CTXL; }
        __syncthreads();
        for (int ch = F.tid; ch < 62 * 64; ch += NTHREADS) { const int r = ch >> 6, p = t0 - 15 + r; u32x4 v = (u32x4){0u, 0u, 0u, 0u};
            if (p >= 0 && p < len) v = *(const u32x4*)(Gb + (size_t)(rowbase + p) * 512 + (ch & 63) * 8);
            *(LAS u32x4*)(gl + r * 512 + (ch & 63) * 8) = v; }
        __syncthreads();
        float g[62];
#pragma unroll
        for (int r = 0; r < 62; ++r) g[r] = bf2f(gl[r * 512 + c]);
#pragma unroll
        for (int t = 0; t < 32; ++t) { float y = bias;
#pragma unroll
            for (int j = 0; j < 31; ++j) y += g[t + j] * w[j];
            yl[t * 512 + c] = y; }
        __syncthreads();
#pragma unroll
        for (int tt = 0; tt < 4; ++tt) { const int t = 4 * F.wave + tt; float v[8]; float s = 0.f;
#pragma unroll
            for (int j = 0; j < 8; ++j) { v[j] = yl[t * 512 + F.lane + 64 * j]; s += v[j]; }
            const float mean = wave_sum(s) * (1.f / 512.f); float q = 0.f;
#pragma unroll
            for (int j = 0; j < 8; ++j) { v[j] -= mean; q += v[j] * v[j]; }
            const float rstd = 1.0f / sqrtf(wave_sum(q) * (1.f / 512.f) + EPS);
            bf16_t* orow = AO + (size_t)(rowbase + t0 + t) * 1024 + 512;
#pragma unroll
            for (int j = 0; j < 8; ++j) { const int cc = F.lane + 64 * j; const float yn = v[j] * rstd * F.in[I_CLNG][cc] + F.in[I_CLNB][cc]; orow[cc] = (bf16_t)(pk2(yn * sigmoidf_(yn), 0.f) & 0xffffu); } }
    }
    __syncthreads();
}
__device__ __forceinline__ void p_pool(const Frame& F) {
    const int gw = F.vcu * NWAVES + F.wave, NGW = F.G * NWAVES, lane = F.lane;
    const bf16_t* U = (const bf16_t*)(F.ws + WS_G); bf16_t* AO = (bf16_t*)(F.ws + WS_AO);
    const int wdt = 2 << (lane >> 4);
    for (int row = gw; row < TX; row += NGW) {
        const int t = row & 4095, rb = row - t;
        int lo = t - (wdt >> 1), hi = lo + wdt; lo = lo < 0 ? 0 : lo; hi = hi > SEQ ? SEQ : hi;
        float s[8];
#pragma unroll
        for (int j = 0; j < 8; ++j) s[j] = 0.f;
        for (int i = 0; i < 16; ++i) { const int p = lo + i; if (p < hi) { const u32x4 w = *(const u32x4*)(U + (size_t)(rb + p) * 512 + lane * 8);
            s[0] += bflo(w.x); s[1] += bfhi(w.x); s[2] += bflo(w.y); s[3] += bfhi(w.y); s[4] += bflo(w.z); s[5] += bfhi(w.z); s[6] += bflo(w.w); s[7] += bfhi(w.w); } }
        const u32x4 w = *(const u32x4*)(U + (size_t)row * 512 + lane * 8); const float inv = 1.f / (float)(hi - lo);
        float o[8] = {s[0] * inv - bflo(w.x), s[1] * inv - bfhi(w.x), s[2] * inv - bflo(w.y), s[3] * inv - bfhi(w.y), s[4] * inv - bflo(w.z), s[5] * inv - bfhi(w.z), s[6] * inv - bflo(w.w), s[7] * inv - bfhi(w.w)};
        u32x4 ow; ow.x = pk2(o[0], o[1]); ow.y = pk2(o[2], o[3]); ow.z = pk2(o[4], o[5]); ow.w = pk2(o[6], o[7]);
        *(u32x4*)(AO + (size_t)row * 1024 + 512 + lane * 8) = ow;
    }
}

template <int LAYER> __device__ __forceinline__ void attn_simple(const Frame& F) {
    const bf16_t* Q = (const bf16_t*)(F.ws + WS_Q); const bf16_t* Kn = (const bf16_t*)(F.ws + WS_KN); const bf16_t* Vn = (const bf16_t*)(F.ws + WS_VN); bf16_t* AO = (bf16_t*)(F.ws + WS_AO);
    const int nunits = LAYER == 0 ? 512 + 64 : 512;
    for (int u = F.vcu; u < nunits; u += F.G) {
        int b, h, row, s; bool valid = true, isctx = false;
        if (u < 512) { b = u >> 6; h = (u >> 3) & 7; s = (u & 7) * 512 + F.tid; row = b * SEQ + s; }
        else { const int uc = u - 512; b = uc >> 3; h = uc & 7; s = F.tid; valid = F.tid < 256; row = TX + b * CTXL + (valid ? s : 0); isctx = true; }
        float q[64], o[64];
        { const u32x4* qp = (const u32x4*)(Q + (size_t)row * 512 + h * 64);
#pragma unroll
          for (int c = 0; c < 8; ++c) { const u32x4 w = qp[c]; q[8 * c] = bflo(w.x); q[8 * c + 1] = bfhi(w.x); q[8 * c + 2] = bflo(w.y); q[8 * c + 3] = bfhi(w.y); q[8 * c + 4] = bflo(w.z); q[8 * c + 5] = bfhi(w.z); q[8 * c + 6] = bflo(w.w); q[8 * c + 7] = bfhi(w.w); } }
#pragma unroll
        for (int d = 0; d < 64; ++d) o[d] = 0.f;
        float mx = -1e30f, l = 0.f;
        const bf16_t* Kb = Kn + (size_t)b * KVS * 128 + (h >> 2) * 64; const bf16_t* Vb = Vn + (size_t)b * KVS * 128 + (h >> 2) * 64;
        int k_lo2 = 0, k_hi2 = 0;
        const int k_hi1 = CTXL;
        if (LAYER == 0) { if (!isctx) { k_lo2 = CTXL; k_hi2 = KVS; } }
        else { const int s0 = (u & 7) * 512; int lo = s0 - 128, hi = s0 + 511 + 128 + 1; lo = lo < 0 ? 0 : lo; hi = hi > SEQ ? SEQ : hi; k_lo2 = CTXL + lo; k_hi2 = CTXL + hi; }
        for (int part = 0; part < 2; ++part) {
            const int kb = part == 0 ? 0 : k_lo2, ke = part == 0 ? k_hi1 : k_hi2;
            for (int key = kb; key < ke; ++key) {
                const u32x4* kp = (const u32x4*)(Kb + (size_t)key * 128); float sd = 0.f;
#pragma unroll
                for (int c = 0; c < 8; ++c) { const u32x4 w = kp[c];
                    sd += q[8 * c] * bflo(w.x) + q[8 * c + 1] * bfhi(w.x) + q[8 * c + 2] * bflo(w.y) + q[8 * c + 3] * bfhi(w.y) + q[8 * c + 4] * bflo(w.z) + q[8 * c + 5] * bfhi(w.z) + q[8 * c + 6] * bflo(w.w) + q[8 * c + 7] * bfhi(w.w); }
                bool use = valid;
                if (LAYER == 1 && part == 1) { const int j = key - CTXL; const int dlt = s - j; use = use && (dlt <= 128 && dlt >= -128); }
                const float mn = fmaxf(mx, sd); const float mnew = use ? mn : mx;
                const float alpha = exp2f(mx - mnew), p = use ? exp2f(sd - mnew) : 0.f;
                mx = mnew; l = l * alpha + p;
                const u32x4* vp = (const u32x4*)(Vb + (size_t)key * 128);
#pragma unroll
                for (int c = 0; c < 8; ++c) { const u32x4 w = vp[c];
                    o[8 * c] = o[8 * c] * alpha + p * bflo(w.x); o[8 * c + 1] = o[8 * c + 1] * alpha + p * bfhi(w.x); o[8 * c + 2] = o[8 * c + 2] * alpha + p * bflo(w.y); o[8 * c + 3] = o[8 * c + 3] * alpha + p * bfhi(w.y);
                    o[8 * c + 4] = o[8 * c + 4] * alpha + p * bflo(w.z); o[8 * c + 5] = o[8 * c + 5] * alpha + p * bfhi(w.z); o[8 * c + 6] = o[8 * c + 6] * alpha + p * bflo(w.w); o[8 * c + 7] = o[8 * c + 7] * alpha + p * bfhi(w.w); }
            }
        }
        if (LAYER == 1) l += exp2f(F.in[I_SINK][h] * LOG2E - mx);
        const float il = 1.f / l;
        if (valid) { u32x4* op = (u32x4*)(AO + (size_t)row * 1024 + h * 64);
#pragma unroll
            for (int c = 0; c < 8; ++c) { u32x4 w; w.x = pk2(o[8 * c] * il, o[8 * c + 1] * il); w.y = pk2(o[8 * c + 2] * il, o[8 * c + 3] * il); w.z = pk2(o[8 * c + 4] * il, o[8 * c + 5] * il); w.w = pk2(o[8 * c + 6] * il, o[8 * c + 7] * il); op[c] = w; } }
    }
}

__device__ __forceinline__ void p_router(const Frame& F, int l, int ntok) {
    const int gw = F.vcu * NWAVES + F.wave, NGW = F.G * NWAVES, lane = F.lane;
    bf16_t* HX = (bf16_t*)(F.ws + WS_HX);
    const float* gwt = F.in[I_RGW] + (size_t)l * 1024 * 4; const float* ewt = F.in[I_REW] + (size_t)l * 1024 * 32;
    const float* gb = F.in[I_RGB] + l * 4; const float* eb = F.in[I_REB] + l * 32;
    unsigned* tokslot = (unsigned*)(F.ws + WS_TOK); float* tokw = (float*)(F.ws + WS_TOK + 512 * 1024); unsigned* list = (unsigned*)(F.ws + WS_LIST);
    unsigned* cnt = F.cnt(l);
    for (int row = gw; row < ntok; row += NGW) {
        const int r = modrow(row); f32x4 h[4];
        norm_mod_row(F.xr_row(row), F.in[I_LN2] + l * 1024, F.mod(l, r, 3), F.mod(l, r, 4), lane, h);
        store_row_bf16(HX + (size_t)row * DM, lane, h);
        float lg[4], le[32];
#pragma unroll
        for (int o = 0; o < 4; ++o) lg[o] = 0.f;
#pragma unroll
        for (int o = 0; o < 32; ++o) le[o] = 0.f;
#pragma unroll
        for (int j = 0; j < 4; ++j) {
            const float* gp = gwt + (size_t)(4 * lane + 256 * j) * 4; const float* ep = ewt + (size_t)(4 * lane + 256 * j) * 32;
            asm volatile("" : "+v"(gp), "+v"(ep));
#pragma unroll
            for (int i = 0; i < 4; ++i) { const float hv = h[j][i];
                const f32x4 g4 = *(const f32x4*)(gp + i * 4);
                lg[0] += hv * g4[0]; lg[1] += hv * g4[1]; lg[2] += hv * g4[2]; lg[3] += hv * g4[3];
#pragma unroll
                for (int q = 0; q < 8; ++q) { const f32x4 e4 = *(const f32x4*)(ep + i * 32 + 4 * q); le[4 * q] += hv * e4[0]; le[4 * q + 1] += hv * e4[1]; le[4 * q + 2] += hv * e4[2]; le[4 * q + 3] += hv * e4[3]; } }
            __builtin_amdgcn_sched_barrier(0); }
#pragma unroll
        for (int o = 0; o < 4; ++o) lg[o] = wave_sum(lg[o]) + gb[o];
#pragma unroll
        for (int o = 0; o < 32; ++o) { le[o] = wave_sum(le[o]) + eb[o]; if ((o & 3) == 3) __builtin_amdgcn_sched_barrier(0); }
        int gs = 0; float gm = lg[0];
#pragma unroll
        for (int o = 1; o < 4; ++o) if (lg[o] > gm) { gm = lg[o]; gs = o; }
        float gden = 0.f;
#pragma unroll
        for (int o = 0; o < 4; ++o) gden += expf(lg[o] - gm);
        const float g_w = 1.f / gden;
        float el[8];
#pragma unroll
        for (int i = 0; i < 8; ++i) { el[i] = le[i];
#pragma unroll
            for (int g = 1; g < 4; ++g) el[i] = (gs == g) ? le[g * 8 + i] : el[i]; }
        int i1 = 0; float m1 = el[0];
#pragma unroll
        for (int i = 1; i < 8; ++i) if (el[i] > m1) { m1 = el[i]; i1 = i; }
        int i2 = -1; float m2 = -3.0e38f;
#pragma unroll
        for (int i = 0; i < 8; ++i) if (i != i1 && el[i] > m2) { m2 = el[i]; i2 = i; }
        const float p2 = expf(m2 - m1); const float w1 = g_w / (1.f + p2), w2 = g_w * p2 / (1.f + p2);
        if (lane == 0) { const int e1 = gs * 8 + i1, e2 = gs * 8 + i2;
            const unsigned pos1 = atomicAdd(cnt + e1 * 64, 1u), pos2 = atomicAdd(cnt + e2 * 64, 1u);
            list[(size_t)e1 * TT + pos1] = (unsigned)row; list[(size_t)e2 * TT + pos2] = (unsigned)row;
            tokslot[2 * row] = ((unsigned)e1 << 16) | pos1; tokslot[2 * row + 1] = ((unsigned)e2 << 16) | pos2; tokw[2 * row] = w1; tokw[2 * row + 1] = w2; }
    }
}
template <bool LAST> __device__ __forceinline__ void p_combine(const Frame& F, int l, int ntok, const MoeTab& tb) {
    const int gw = F.vcu * NWAVES + F.wave, NGW = F.G * NWAVES, lane = F.lane;
    const bf16_t* YB = (const bf16_t*)(F.ws + WS_YB); bf16_t* HX = (bf16_t*)(F.ws + WS_HX);
    const unsigned* tokslot = (const unsigned*)(F.ws + WS_TOK); const float* tokw = (const float*)(F.ws + WS_TOK + 512 * 1024);
    for (int row = gw; row < ntok; row += NGW) {
        const unsigned sa = tokslot[2 * row], sb = tokslot[2 * row + 1]; const float wa = tokw[2 * row], wb = tokw[2 * row + 1];
        const size_t slota = (size_t)tb.tile0[sa >> 16] * 256 + (sa & 0xffffu), slotb = (size_t)tb.tile0[sb >> 16] * 256 + (sb & 0xffffu);
        const int r = modrow(row); const float* g2 = F.mod(l, r, 5); float* xr = F.xr_row(row);
        float ss = 0.f; f32x4 v[4];
#pragma unroll
        for (int j = 0; j < 4; ++j) { const int c = 4 * lane + 256 * j; const u32x2 ya = *(const u32x2*)(YB + slota * 1024 + c), yb = *(const u32x2*)(YB + slotb * 1024 + c);
            const f32x4 x1 = *(const f32x4*)(xr + c), gv = *(const f32x4*)(g2 + c);
            f32x4 y; y[0] = wa * bflo(ya.x) + wb * bflo(yb.x); y[1] = wa * bfhi(ya.x) + wb * bfhi(yb.x); y[2] = wa * bflo(ya.y) + wb * bflo(yb.y); y[3] = wa * bfhi(ya.y) + wb * bfhi(yb.y);
            v[j] = x1 + gv * y; *(f32x4*)(xr + c) = v[j];
            ss += (v[j][0] * v[j][0] + v[j][1] * v[j][1]) + (v[j][2] * v[j][2] + v[j][3] * v[j][3]); }
        if (!LAST) { const float rms = 1.0f / sqrtf(wave_sum(ss) * (1.f / 1024.f) + EPS); const float* g = F.in[I_LN1] + (l + 1) * 1024; const float* sh = F.mod(l + 1, r, 0); const float* sc = F.mod(l + 1, r, 1); f32x4 h[4];
#pragma unroll
            for (int j = 0; j < 4; ++j) { const int c = 4 * lane + 256 * j; h[j] = (v[j] * rms * *(const f32x4*)(g + c)) * (1.f + *(const f32x4*)(sc + c)) + *(const f32x4*)(sh + c); }
            store_row_bf16(HX + (size_t)row * DM, lane, h); }
    }
}

__global__ void __launch_bounds__(NTHREADS, 2) fwd_kernel(Params P) {
    extern __shared__ __attribute__((aligned(16))) unsigned char lds_raw[];
    Frame F;
    F.lds = (LAS unsigned char*)lds_raw; F.in = P.in; F.out = P.out; F.ws = P.ws;
    F.tid = threadIdx.x; F.lane = F.tid & 63; F.wave = __builtin_amdgcn_readfirstlane(F.tid >> 6);
    F.G = gridDim.x; { const int bx = blockIdx.x; F.vcu = (F.G % 8 == 0) ? (bx % 8) * (F.G / 8) + bx / 8 : bx; }
    volatile LAS unsigned* misc = (volatile LAS unsigned*)(F.lds + LDS_MISC);
    if (F.tid < 16) misc[F.tid] = 0u;
    __syncthreads();
#if ONE_LAUNCH
    XcdBarrier bar = xcd_barrier_post((unsigned*)(F.ws + WS_CTL) + CW_BAR, misc + 8);
#define GRID_BAR() do { xcd_barrier(bar); } while (0)
#else
#define GRID_BAR() do { } while (0)
#endif
    const int lo = P.ph_lo, hi = P.ph_hi;
#ifndef PHMASK
#define PHMASK 0xFFFFFFFFu
#endif
#define IN(k) (((PHMASK >> (k)) & 1u) && lo <= (k) && (k) < hi)
#define SEAM(k) do { if (IN((k) + 1)) GRID_BAR(); } while (0)
    bf16_t* HX = (bf16_t*)(F.ws + WS_HX); bf16_t* Qb = (bf16_t*)(F.ws + WS_Q); bf16_t* KVb = (bf16_t*)(F.ws + WS_KV); bf16_t* Gb = (bf16_t*)(F.ws + WS_G); bf16_t* AO = (bf16_t*)(F.ws + WS_AO);
    bf16_t* HID = (bf16_t*)(F.ws + WS_HID); bf16_t* YB = (bf16_t*)(F.ws + WS_YB);

    if (IN(0)) { p0_prologue(F); SEAM(0); }
    if (IN(1)) { p_norm1_l0(F); SEAM(1); }
    if (IN(2)) { SchedDense S{(const bf16_t*)(F.ws + WS_WINAB), 1024, TT / 256, 7, 0, 0, F.vcu, F.G}; EpiInProj<true> E{Qb, KVb, Gb}; gemm_simple(F, HX, 1024, S, E); SEAM(2); }
    if (IN(3)) { p_qkv_post(F, F.in[I_QNA], F.in[I_KNA], true); p_conv(F); SEAM(3); }
    if (IN(4)) { attn_simple<0>(F); SEAM(4); }
    if (IN(5)) { SchedDense S{(const bf16_t*)(F.ws + WS_WOUTAB), 1024, TT / 256, 4, 0, 0, F.vcu, F.G}; EpiOutProj<true> E{F, 0}; gemm_simple(F, AO, 1024, S, E); SEAM(5); }
    if (IN(6)) { p_router(F, 0, TT); SEAM(6); }
    if (IN(7)) { const MoeTab tb = moe_tables(F, 0); SchedMoe S{(const bf16_t*)(F.ws + WS_WGU), (size_t)1024 * 1024, 1024, tb, (const unsigned*)(F.ws + WS_LIST), true, F.vcu, F.G}; EpiMoe1 E{HID}; gemm_simple(F, HX, 1024, S, E); SEAM(7); }
    if (IN(8)) { const MoeTab tb = moe_tables(F, 0); SchedMoe S{(const bf16_t*)(F.ws + WS_WD), (size_t)1024 * 512, 512, tb, nullptr, false, F.vcu, F.G}; EpiMoe2 E{YB}; gemm_simple(F, HID, 512, S, E); SEAM(8); }
    if (IN(9)) { const MoeTab tb = moe_tables(F, 0); p_combine<false>(F, 0, TT, tb); SEAM(9); }
    if (IN(10)) { SchedDense S{(const bf16_t*)(F.ws + WS_WINCD), 1024, TX / 256, 5, TC / 256, 2, F.vcu, F.G}; EpiInProj<false> E{Qb, KVb, Gb}; gemm_simple(F, HX, 1024, S, E); SEAM(10); }
    if (IN(11)) { p_qkv_post(F, F.in[I_QNC], F.in[I_KNC], false); p_pool(F); SEAM(11); }
    if (IN(12)) { attn_simple<1>(F); SEAM(12); }
    if (IN(13)) { SchedDense S{(const bf16_t*)(F.ws + WS_WOUTCD), 1024, TX / 256, 4, 0, 0, F.vcu, F.G}; EpiOutProj<false> E{F, 1}; gemm_simple(F, AO, 1024, S, E); SEAM(13); }
    if (IN(14)) { p_router(F, 1, TX); SEAM(14); }
    if (IN(15)) { const MoeTab tb = moe_tables(F, 1); SchedMoe S{(const bf16_t*)(F.ws + WS_WGU) + (size_t)32 * 1024 * 1024, (size_t)1024 * 1024, 1024, tb, (const unsigned*)(F.ws + WS_LIST), true, F.vcu, F.G}; EpiMoe1 E{HID}; gemm_simple(F, HX, 1024, S, E); SEAM(15); }
    if (IN(16)) { const MoeTab tb = moe_tables(F, 1); SchedMoe S{(const bf16_t*)(F.ws + WS_WD) + (size_t)32 * 1024 * 512, (size_t)1024 * 512, 512, tb, nullptr, false, F.vcu, F.G}; EpiMoe2 E{YB}; gemm_simple(F, HID, 512, S, E); SEAM(16); }
    if (IN(17)) { const MoeTab tb = moe_tables(F, 1); p_combine<true>(F, 1, TX, tb); }
#undef IN
#undef SEAM
}

extern "C" void kernel_launch(void* const* d_in, const int* in_sizes, int n_in, void* d_out, int out_size, void* d_ws, size_t ws_size, hipStream_t stream) {
    static int grid = 0;
    if (grid == 0) {
        if (n_in != 30 || out_size != TX * DM || ws_size < WS_END) { fprintf(stderr, "kernel_launch: unexpected shapes (n_in %d out %d ws %zu)\n", n_in, out_size, ws_size); grid = -1; return; }
        int dev = 0, cus = 0;
        if (hipGetDevice(&dev) != hipSuccess || hipDeviceGetAttribute(&cus, hipDeviceAttributeMultiprocessorCount, dev) != hipSuccess) { grid = -1; return; }
        if (hipFuncSetAttribute((const void*)fwd_kernel, hipFuncAttributeMaxDynamicSharedMemorySize, LDS_BYTES) != hipSuccess) { fprintf(stderr, "kernel_launch: hipFuncSetAttribute failed\n"); grid = -1; return; }
        int per_cu = 0;
        if (hipOccupancyMaxActiveBlocksPerMultiprocessor(&per_cu, (const void*)fwd_kernel, NTHREADS, LDS_BYTES) != hipSuccess || per_cu < 1) { fprintf(stderr, "kernel_launch: occupancy query says %d\n", per_cu); }
        (void)hipGetLastError();
        grid = cus;
    }
    if (grid < 0) return;
    (void)hipMemsetAsync((char*)d_ws + WS_CTL, 0, CTL_ZERO_BYTES, stream);
    Params p{};
    for (int i = 0; i < 30; ++i) p.in[i] = (const float*)d_in[i];
    p.out = (float*)d_out; p.ws = (unsigned char*)d_ws;
#if ONE_LAUNCH
    p.ph_lo = 0; p.ph_hi = NPH;
    hipLaunchKernelGGL(fwd_kernel, dim3(grid), dim3(NTHREADS), LDS_BYTES, stream, p);
#else
    for (int ph = 0; ph < NPH; ++ph) { p.ph_lo = ph; p.ph_hi = ph + 1; hipLaunchKernelGGL(fwd_kernel, dim3(grid), dim3(NTHREADS), LDS_BYTES, stream, p); }
#endif
}
```

```cpp
#include <hip/hip_runtime.h>
#include <cstdio>
#include <cstdint>

#ifndef ONE_LAUNCH
#define ONE_LAUNCH 1
#endif

#define LAS __attribute__((address_space(3)))
#define GAS __attribute__((address_space(1)))
typedef unsigned short bf16_t;
typedef short bf16x8 __attribute__((ext_vector_type(8)));
typedef float f32x4 __attribute__((ext_vector_type(4)));
typedef float f32x2 __attribute__((ext_vector_type(2)));
typedef unsigned u32x4 __attribute__((ext_vector_type(4)));
typedef unsigned u32x2 __attribute__((ext_vector_type(2)));
typedef __bf16 bf16x2_t __attribute__((ext_vector_type(2)));

constexpr int NB = 8, SEQ = 4096, DM = 1024, CTXL = 256, HD = 64;
constexpr int TX = NB * SEQ, TC = NB * CTXL, TT = TX + TC;
constexpr int KVS = CTXL + SEQ;
constexpr int NE = 32;
constexpr int NTILE_MAX = 304, NSLOT = NTILE_MAX * 256;
constexpr float EPS = 1e-6f;
constexpr float LOG2E = 1.4426950408889634f;
constexpr float C2 = 0.125f * LOG2E;
constexpr int NWAVES = 8, NTHREADS = 512;
constexpr int NPH = 18;

enum { I_X = 0, I_C, I_CTX, I_CCTX, I_MODW, I_MODB, I_LN1, I_LN2, I_WINAB, I_WOUTAB, I_QNA, I_KNA, I_CONVW, I_CONVB, I_CLNG, I_CLNB,
       I_WINCD, I_WOUTCD, I_QNC, I_KNC, I_SINK, I_POOLW, I_POOLS, I_RGW, I_RGB, I_REW, I_REB, I_EXG, I_EXU, I_EXD };

constexpr size_t MiB = 1u << 20;
constexpr size_t WS_CTL = 0, CTL_ZERO_BYTES = 1 * MiB;
constexpr size_t WS_MOD = 1 * MiB;
constexpr size_t WS_ROPE = 2 * MiB;
constexpr size_t WS_TOK = 3 * MiB;
constexpr size_t WS_LIST = 4 * MiB;
constexpr size_t WS_WINAB = 10 * MiB;
constexpr size_t WS_WOUTAB = 14 * MiB;
constexpr size_t WS_WINCD = 16 * MiB;
constexpr size_t WS_WOUTCD = 19 * MiB;
constexpr size_t WS_XC = 21 * MiB;
constexpr size_t WS_KN = 30 * MiB;
constexpr size_t WS_VN = 39 * MiB;
constexpr size_t WS_WGU = 48 * MiB;
constexpr size_t WS_WD = 176 * MiB;
constexpr size_t WS_HX = 240 * MiB;
constexpr size_t WS_HID = 308 * MiB;
constexpr size_t WS_Q = 384 * MiB;
constexpr size_t WS_KV = 418 * MiB;
constexpr size_t WS_G = 435 * MiB;
constexpr size_t WS_AO = 469 * MiB;
constexpr size_t WS_YB = 384 * MiB;
constexpr size_t WS_END = 537 * MiB;
static_assert(WS_YB + (size_t)NSLOT * 1024 * 2 <= WS_END && WS_AO + (size_t)TT * 1024 * 2 <= WS_END, "ws map");
constexpr int CW_CNT = 256;
constexpr int CW_BAR = 8192;

constexpr int RING_BYTES = 131072;
constexpr int LDS_MISC = RING_BYTES;
constexpr int LDS_TAB = RING_BYTES + 256;
constexpr int LDS_BYTES = 147456;

__device__ __forceinline__ unsigned pk2(float lo, float hi) { f32x2 v = {lo, hi}; bf16x2_t b = __builtin_convertvector(v, bf16x2_t); return __builtin_bit_cast(unsigned, b); }
__device__ __forceinline__ float bflo(unsigned w) { return __uint_as_float(w << 16); }
__device__ __forceinline__ float bfhi(unsigned w) { return __uint_as_float(w & 0xffff0000u); }
__device__ __forceinline__ float bf2f(bf16_t h) { return __uint_as_float((unsigned)h << 16); }
__device__ __forceinline__ float wave_sum(float v) {
#pragma unroll
    for (int o = 1; o < 64; o <<= 1) v += __shfl_xor(v, o);
    return v;
}
__device__ __forceinline__ float sigmoidf_(float v) { return 1.f / (1.f + __expf(-v)); }

#define XB_TMO      128
#define XB_XCNT(j)  (256  + 64 * (j))
#define XB_XSUB(j)  (1280 + 64 * (j))
#define XB_XGEN(j)  (2304 + 64 * (j))
#define XB_TOP      3328
#define XB_TOPGEN   3392
#define XCD_BAR_WORDS 3456
#define XB_SPIN_CAP (1u << 18)
__device__ __forceinline__ unsigned xb_ld(unsigned* p)              { return __hip_atomic_load(p, __ATOMIC_RELAXED, __HIP_MEMORY_SCOPE_AGENT); }
__device__ __forceinline__ unsigned xb_add(unsigned* p, unsigned v) { return __hip_atomic_fetch_add(p, v, __ATOMIC_RELAXED, __HIP_MEMORY_SCOPE_AGENT); }
__device__ __forceinline__ unsigned xb_xcc_id() { return (unsigned)__builtin_amdgcn_s_getreg((3 << 11) | 20) & 0xFu; }
#define XB_SPIN(cond, bar) do { unsigned _sp = 0; while (cond) { __builtin_amdgcn_s_sleep(1); \
    if ((++_sp & 255u) == 0u) { if (xb_ld(&(bar)[XB_TMO])) break; if (_sp > XB_SPIN_CAP) { atomicAdd(&(bar)[XB_TMO], 1u); break; } } } } while (0)
struct XcdBarrier { unsigned* bar; unsigned x; volatile LAS unsigned* st; };
__device__ __forceinline__ XcdBarrier xcd_barrier_post(unsigned* bar, volatile LAS unsigned* st) {
    XcdBarrier b; b.bar = bar; b.x = xb_xcc_id(); b.st = st;
    if (threadIdx.x == 0) (void)xb_add(&bar[XB_XCNT(b.x)], 1u);
    return b;
}
__device__ __forceinline__ void xcd_barrier_complete(unsigned* bar, unsigned x, unsigned& nloc, unsigned& nx) {
    const unsigned G = gridDim.x * gridDim.y * gridDim.z;
    unsigned sum, cnt, mine, sp = 0u;
    for (;;) {
        sum = 0u; cnt = 0u; mine = 0u;
#pragma unroll
        for (unsigned j = 0; j < 16; ++j) { const unsigned c = xb_ld(&bar[XB_XCNT(j)]); sum += c; cnt += (c > 0u) ? 1u : 0u; mine = (j == x) ? c : mine; }
        if (sum == G) break;
        __builtin_amdgcn_s_sleep(1);
        if ((++sp & 255u) == 0u) { if (xb_ld(&bar[XB_TMO])) break; if (sp > XB_SPIN_CAP) { atomicAdd(&bar[XB_TMO], 1u); break; } }
    }
    nloc = mine > 0u ? mine : 1u; nx = cnt > 0u ? cnt : 1u;
}
__device__ __forceinline__ void xcd_barrier(const XcdBarrier& b) {
    asm volatile("s_waitcnt vmcnt(0)" ::: "memory");
    __syncthreads();
    if (threadIdx.x == 0) {
        unsigned* bar = b.bar;
        __builtin_amdgcn_s_waitcnt(0);
        unsigned nloc = b.st[0], nx = b.st[1];
        if (nloc == 0u) { xcd_barrier_complete(bar, b.x, nloc, nx); b.st[0] = nloc; b.st[1] = nx; }
        const unsigned old = xb_add(&bar[XB_XSUB(b.x)], 1u);
        const unsigned gen = old / nloc;
        if (old + 1u == (gen + 1u) * nloc) {
            __builtin_amdgcn_fence(__ATOMIC_RELEASE, "agent");
            asm volatile("s_waitcnt vmcnt(0)" ::: "memory");
            const unsigned og = xb_add(&bar[XB_TOP], 1u);
            const unsigned tg = og / nx;
            if (og + 1u == (tg + 1u) * nx) xb_add(&bar[XB_TOPGEN], 1u);
            else XB_SPIN(xb_ld(&bar[XB_TOPGEN]) == tg, bar);
            __builtin_amdgcn_fence(__ATOMIC_ACQUIRE, "agent");
            xb_add(&bar[XB_XGEN(b.x)], 1u);
            asm volatile("s_waitcnt vmcnt(0)" ::: "memory");
        } else {
            XB_SPIN(xb_ld(&bar[XB_XGEN(b.x)]) == gen, bar);
            __builtin_amdgcn_fence(__ATOMIC_ACQUIRE, "agent");
            asm volatile("s_waitcnt vmcnt(0)" ::: "memory");
        }
    }
    __syncthreads();
}

struct Params { const float* in[30]; float* out; unsigned char* ws; int ph_lo, ph_hi; };
struct Frame {
    LAS unsigned char* lds;
    const float* const* in;
    float* out; unsigned char* ws;
    int tid, lane, wave, vcu, G;
    __device__ __forceinline__ const float* mod(int l, int r, int chunk) const { return (const float*)(ws + WS_MOD) + ((size_t)(l * 9 + r) * 6144 + chunk * 1024); }
    __device__ __forceinline__ float* xr_row(int row) const { return row < TX ? out + (size_t)row * DM : (float*)(ws + WS_XC) + (size_t)(row - TX) * DM; }
    __device__ __forceinline__ const float* xin_row(int row) const { return row < TX ? in[I_X] + (size_t)row * DM : in[I_CTX] + (size_t)(row - TX) * DM; }
    __device__ __forceinline__ unsigned* cnt(int l) const { return (unsigned*)(ws + WS_CTL) + CW_CNT + l * 32 * 64; }
};
__device__ __forceinline__ int modrow(int row) { return row < TX ? (row >> 12) : 8; }

__device__ __forceinline__ void p0_mod_item(const Frame& F, int item) {
    const int l = item / 96, cg = item % 96;
    LAS float* sc = (LAS float*)F.lds;
    LAS float* red = sc + 9 * 1024;
    for (int i = F.tid; i < 9 * 1024; i += NTHREADS) { const int r = i >> 10, k = i & 1023; const float v = r < 8 ? F.in[I_C][r * 1024 + k] : F.in[I_CCTX][k]; sc[i] = v / (1.f + expf(-v)); }
    __syncthreads();
    const float* W = F.in[I_MODW] + (size_t)l * 1024 * 6144 + cg * 64 + F.lane;
    float acc[9];
#pragma unroll
    for (int r = 0; r < 9; ++r) acc[r] = 0.f;
#pragma unroll 8
    for (int kk = 0; kk < 128; ++kk) { const int k = F.wave * 128 + kk; const float w = W[(size_t)k * 6144];
#pragma unroll
        for (int r = 0; r < 9; ++r) acc[r] += sc[r * 1024 + k] * w; }
#pragma unroll
    for (int r = 0; r < 9; ++r) red[(F.wave * 9 + r) * 64 + F.lane] = acc[r];
    __syncthreads();
    for (int i = F.tid; i < 9 * 64; i += NTHREADS) { const int r = i >> 6, ln = i & 63; float s = 0.f;
#pragma unroll
        for (int w = 0; w < 8; ++w) s += red[(w * 9 + r) * 64 + ln];
        ((float*)(F.ws + WS_MOD))[(size_t)(l * 9 + r) * 6144 + cg * 64 + ln] = s + F.in[I_MODB][l * 6144 + cg * 64 + ln]; }
    __syncthreads();
}
__device__ __forceinline__ void transpose_item(const float* W, int ldw, int k0, int n0, bf16_t* WT, int ldt, int drow0, int kcol0, LAS float* scr, int lane) {
    const int kr = lane >> 3, nq = lane & 7;
    f32x4 v[8];
#pragma unroll
    for (int i = 0; i < 8; ++i) v[i] = *(const f32x4*)(W + (size_t)(k0 + 8 * i + kr) * ldw + n0 + 4 * nq);
#pragma unroll
    for (int i = 0; i < 8; ++i) { LAS float* s = scr + (8 * i + kr) * 33 + 4 * nq; s[0] = v[i][0]; s[1] = v[i][1]; s[2] = v[i][2]; s[3] = v[i][3]; }
    asm volatile("s_waitcnt lgkmcnt(0)" ::: "memory");
    const int c = lane & 7;
#pragma unroll
    for (int j = 0; j < 4; ++j) { const int n = (lane >> 3) + 8 * j; const LAS float* s = scr + (8 * c) * 33 + n;
        u32x4 o; o.x = pk2(s[0 * 33], s[1 * 33]); o.y = pk2(s[2 * 33], s[3 * 33]); o.z = pk2(s[4 * 33], s[5 * 33]); o.w = pk2(s[6 * 33], s[7 * 33]);
        *(u32x4*)(WT + (size_t)(drow0 + n) * ldt + kcol0 + k0 + 8 * c) = o; }
    asm volatile("s_waitcnt lgkmcnt(0)" ::: "memory");
}
__device__ __forceinline__ void p0_prologue(const Frame& F) {
    for (int it = F.vcu; it < 192; it += F.G) p0_mod_item(F, it);
    const int gw = F.vcu * NWAVES + F.wave, NGW = F.G * NWAVES;
    const int gt = gw * 64 + F.lane, NGT = NGW * 64;
    { float* rc = (float*)(F.ws + WS_ROPE); float* rs = rc + SEQ * 32;
      for (int i = gt; i < SEQ * 32; i += NGT) { const int s = i >> 5, d = i & 31, f = d & 15; const float pos = (float)(d < 16 ? (s >> 6) : (s & 63));
          const float inv = exp2f(-(float)f * (13.287712379549449f / 16.f)); const float a = pos * inv; rc[i] = cosf(a); rs[i] = sinf(a); } }
    { bf16_t* WT = (bf16_t*)(F.ws + WS_WOUTCD); const float* pw = F.in[I_POOLW]; const float* ps = F.in[I_POOLS]; const float* wo = F.in[I_WOUTCD];
      for (int i = gt; i < 512 * 1024; i += NGT) { const int kk = i >> 10, d = i & 1023, g = kk >> 7; float s = 0.f;
          const float* pwr = pw + (size_t)kk * 128; const float* psr = ps + g * 128; const float* wor = wo + (size_t)(512 + g * 128) * 1024 + d;
#pragma unroll 8
          for (int dp = 0; dp < 128; ++dp) s += pwr[dp] * psr[dp] * wor[(size_t)dp * 1024];
          WT[(size_t)d * 1024 + 512 + kk] = (bf16_t)(pk2(s, 0.f) & 0xffffu); } }
    LAS float* scr = (LAS float*)(F.lds + F.wave * 8448);
    constexpr int N_AB = 16 * 56, N_OAB = 16 * 32, N_CD = 16 * 40, N_OCD = 8 * 32, N_G = 64 * 256, N_U = 64 * 256, N_D = 64 * 256;
    constexpr int NITEMS = N_AB + N_OAB + N_CD + N_OCD + N_G + N_U + N_D;
    for (int it = gw; it < NITEMS; it += NGW) {
        int r = it;
        if (r < N_AB) { const int kb = r / 56, nb = r % 56, n0 = nb * 32; int d0;
            if (n0 < 768) d0 = n0; else if (n0 < 1280) { const int j = n0 - 768; d0 = 768 + (j >> 7) * 256 + (j & 127); } else { const int j = n0 - 1280; d0 = 768 + (j >> 7) * 256 + 128 + (j & 127); }
            transpose_item(F.in[I_WINAB], 1792, kb * 64, n0, (bf16_t*)(F.ws + WS_WINAB), 1024, d0, 0, scr, F.lane); continue; } r -= N_AB;
        if (r < N_OAB) { const int kb = r / 32, nb = r % 32; transpose_item(F.in[I_WOUTAB], 1024, kb * 64, nb * 32, (bf16_t*)(F.ws + WS_WOUTAB), 1024, nb * 32, 0, scr, F.lane); continue; } r -= N_OAB;
        if (r < N_CD) { const int kb = r / 40, nb = r % 40; transpose_item(F.in[I_WINCD], 1280, kb * 64, nb * 32, (bf16_t*)(F.ws + WS_WINCD), 1024, nb * 32, 0, scr, F.lane); continue; } r -= N_CD;
        if (r < N_OCD) { const int kb = r / 32, nb = r % 32; transpose_item(F.in[I_WOUTCD], 1024, kb * 64, nb * 32, (bf16_t*)(F.ws + WS_WOUTCD), 1024, nb * 32, 0, scr, F.lane); continue; } r -= N_OCD;
        if (r < N_G + N_U) { const bool up = r >= N_G; if (up) r -= N_G; const int le = r >> 8, q = r & 255, kb = q >> 4, nb = q & 15, n0 = nb * 32;
            const int d0 = (n0 >> 7) * 256 + (up ? 128 : 0) + (n0 & 127);
            transpose_item(F.in[up ? I_EXU : I_EXG] + (size_t)le * 1024 * 512, 512, kb * 64, n0, (bf16_t*)(F.ws + WS_WGU) + (size_t)le * 1024 * 1024, 1024, d0, 0, scr, F.lane); continue; } r -= N_G + N_U;
        { const int le = r >> 8, q = r & 255, kb = q >> 5, nb = q & 31;
            transpose_item(F.in[I_EXD] + (size_t)le * 512 * 1024, 1024, kb * 64, nb * 32, (bf16_t*)(F.ws + WS_WD) + (size_t)le * 1024 * 512, 512, nb * 32, 0, scr, F.lane); }
    }
}

__device__ __forceinline__ void norm_mod_row(const float* xrow, const float* g, const float* sh, const float* sc, int lane, f32x4 (&h)[4]) {
    f32x4 v[4]; float ss = 0.f;
#pragma unroll
    for (int j = 0; j < 4; ++j) { v[j] = *(const f32x4*)(xrow + 4 * lane + 256 * j); ss += (v[j][0] * v[j][0] + v[j][1] * v[j][1]) + (v[j][2] * v[j][2] + v[j][3] * v[j][3]); }
    const float rms = 1.0f / sqrtf(wave_sum(ss) * (1.f / 1024.f) + EPS);
#pragma unroll
    for (int j = 0; j < 4; ++j) { const int c = 4 * lane + 256 * j; const f32x4 gg = *(const f32x4*)(g + c), s1 = *(const f32x4*)(sc + c), s0 = *(const f32x4*)(sh + c);
        h[j] = (v[j] * rms * gg) * (1.f + s1) + s0; }
}
__device__ __forceinline__ void store_row_bf16(bf16_t* orow, int lane, const f32x4 (&h)[4]) {
#pragma unroll
    for (int j = 0; j < 4; ++j) { u32x2 o; o.x = pk2(h[j][0], h[j][1]); o.y = pk2(h[j][2], h[j][3]); *(u32x2*)(orow + 4 * lane + 256 * j) = o; }
}
__device__ __forceinline__ void p_norm1_l0(const Frame& F) {
    const int gw = F.vcu * NWAVES + F.wave, NGW = F.G * NWAVES;
    bf16_t* HX = (bf16_t*)(F.ws + WS_HX);
    for (int row = gw; row < TT; row += NGW) { const int r = modrow(row); f32x4 h[4];
        norm_mod_row(F.xin_row(row), F.in[I_LN1], F.mod(0, r, 0), F.mod(0, r, 1), F.lane, h);
        store_row_bf16(HX + (size_t)row * DM, F.lane, h); }
}

struct Unit { int pm, pn, e; };
struct SchedDense {
    const bf16_t* Bt; int K, nMa, nN, nMb, pnb, vcu, G;
    __device__ __forceinline__ bool next(int i, Unit& u) const { int L = i * G + vcu; const int na = nMa * nN; u.e = 0;
        if (L < na) { u.pm = L / nN; u.pn = L % nN; return true; } L -= na; if (L < nMb) { u.pm = nMa + L; u.pn = pnb; return true; } return false; }
    __device__ __forceinline__ int arow(const Unit& u, int r) const { return u.pm * 256 + r; }
    __device__ __forceinline__ const bf16_t* bbase(const Unit& u) const { return Bt + (size_t)u.pn * 256 * K; }
};
struct MoeTab { const LAS int* tile_e; const LAS int* tile0; const LAS int* cnt; int ntiles; };
struct SchedMoe {
    const bf16_t* Wt; size_t estride; int K; MoeTab tb; const unsigned* list; bool gather; int vcu, G;
    __device__ __forceinline__ bool next(int i, Unit& u) const { const int L = i * G + vcu; if (L >= tb.ntiles * 4) return false; u.pm = L >> 2; u.pn = L & 3; u.e = tb.tile_e[u.pm]; return true; }
    __device__ __forceinline__ int arow(const Unit& u, int r) const {
        if (!gather) return u.pm * 256 + r;
        int idx = (u.pm - tb.tile0[u.e]) * 256 + r; const int c = tb.cnt[u.e]; idx = idx < c ? idx : c - 1;
        return (int)list[(size_t)u.e * TT + idx]; }
    __device__ __forceinline__ const bf16_t* bbase(const Unit& u) const { return Wt + (size_t)u.e * estride + (size_t)u.pn * 256 * K; }
};
__device__ __forceinline__ MoeTab moe_tables(const Frame& F, int l) {
    LAS int* tile_e = (LAS int*)(F.lds + LDS_TAB); LAS int* tile0 = tile_e + NTILE_MAX; LAS int* cntl = tile0 + 33; LAS int* nt = cntl + 32;
    __syncthreads();
    if (F.tid == 0) { int t = 0; unsigned* cg = F.cnt(l);
        for (int e = 0; e < NE; ++e) { const int c = (int)__hip_atomic_load(cg + e * 64, __ATOMIC_RELAXED, __HIP_MEMORY_SCOPE_AGENT); const int n = (c + 255) >> 8; tile0[e] = t; cntl[e] = c;
            for (int j = 0; j < n; ++j) tile_e[t + j] = e; t += n; }
        tile0[32] = t; nt[0] = t; }
    __syncthreads();
    MoeTab tb; tb.tile_e = tile_e; tb.tile0 = tile0; tb.cnt = cntl; tb.ntiles = nt[0]; return tb;
}

template <class Sched, class Epi>
__device__ __forceinline__ void gemm_simple(const Frame& F, const bf16_t* A, int K, const Sched& S, const Epi& E) {
    const int wr = F.wave >> 2, wc = F.wave & 3, fr = F.lane & 15, fq = F.lane >> 4;
    Unit u;
    for (int i = 0; S.next(i, u); ++i) {
        f32x4 acc[2][2][4][2];
#pragma unroll
        for (int a = 0; a < 2; ++a)
#pragma unroll
            for (int b = 0; b < 2; ++b)
#pragma unroll
                for (int m = 0; m < 4; ++m)
#pragma unroll
                    for (int n = 0; n < 2; ++n) acc[a][b][m][n] = (f32x4){0.f, 0.f, 0.f, 0.f};
        unsigned aoff[2][4], boff[2][2];
#pragma unroll
        for (int a = 0; a < 2; ++a)
#pragma unroll
            for (int m = 0; m < 4; ++m) aoff[a][m] = (unsigned)S.arow(u, 128 * a + 64 * wr + 16 * m + fr) * (unsigned)K + 8u * fq;
        const bf16_t* bb = S.bbase(u);
#pragma unroll
        for (int b = 0; b < 2; ++b)
#pragma unroll
            for (int n = 0; n < 2; ++n) boff[b][n] = (unsigned)(128 * b + 32 * wc + 8 * (fr >> 2) + 4 * n + (fr & 3)) * (unsigned)K + 8u * fq;
#pragma unroll 1
        for (int k0 = 0; k0 < K; k0 += 32) {
            bf16x8 bf[2][2];
#pragma unroll
            for (int b = 0; b < 2; ++b)
#pragma unroll
                for (int n = 0; n < 2; ++n) bf[b][n] = *(const bf16x8*)(bb + boff[b][n] + k0);
#pragma unroll
            for (int a = 0; a < 2; ++a) {
                bf16x8 af[4];
#pragma unroll
                for (int m = 0; m < 4; ++m) af[m] = *(const bf16x8*)(A + aoff[a][m] + k0);
#pragma unroll
                for (int b = 0; b < 2; ++b)
#pragma unroll
                    for (int m = 0; m < 4; ++m)
#pragma unroll
                        for (int n = 0; n < 2; ++n) acc[a][b][m][n] = __builtin_amdgcn_mfma_f32_16x16x32_bf16(bf[b][n], af[m], acc[a][b][m][n], 0, 0, 0);
            }
        }
        E(acc, u, wr, wc, fr, fq);
    }
}

namespace pg8 {
constexpr int BM = 256, BK = 64, HALF = 128, HTB = HALF * BK * 2;
__device__ __forceinline__ int lds_byte(int r, int c) { const int st = (r >> 4) * 2 + (c >> 5), rr = r & 15, cc = c & 31, ob = rr * 64 + cc * 2; return st * 1024 + (ob ^ (((ob >> 9) & 1) << 5)); }
__device__ __forceinline__ void stage_rc(int b, int& R, int& C) { const int st = b / 1024, sb = b % 1024, swz = sb ^ (((sb >> 9) & 1) << 5); R = (st >> 1) * 16 + swz / 64; C = (st & 1) * 32 + (swz % 64) / 2; }
__device__ __forceinline__ int perm32(int rho) { const int n = rho >> 4, i = rho & 15; return 8 * (i >> 2) + 4 * n + (i & 3); }
}
template <class Sched, class Epi>
__device__ __forceinline__ void gemm_fast(const Frame& F, const bf16_t* A, int K, const Sched& S, const Epi& E) {
    using namespace pg8;
    LAS unsigned char* lds = F.lds;
    const int tid = F.tid, wid = F.wave, lane = F.lane, wr = wid >> 2, wc = wid & 3, fr = lane & 15, fq = lane >> 4;
    const int nt = K / BK;
    int RA[2], CA[2]; unsigned voffB[2];
#pragma unroll
    for (int i = 0; i < 2; ++i) { int R, C; stage_rc(tid * 16 + i * 8192, R, C); RA[i] = R; CA[i] = C; const int Rb = (R & ~31) + perm32(R & 31); voffB[i] = (unsigned)(Rb * K + C) * 2u; }
    const size_t kstep = (size_t)(BK * 2);
    const size_t hstep = (size_t)HALF * K * 2;
    const unsigned ldsw = (unsigned)wid * 1024u;
    const int aoff = lds_byte(wr * 64 + fr, fq * 8), boff = lds_byte(wc * 32 + fr, fq * 8);
    const char* Ab = (const char*)A;
#define PG8_SA(b, h) (((b) * 2 + (h)) * HTB)
#define PG8_SB(b, h) ((4 + (b) * 2 + (h)) * HTB)
#define PG8_STAGE(bufoff, gbase, voff) do { _Pragma("unroll") for (int _i = 0; _i < 2; ++_i) \
        __builtin_amdgcn_global_load_lds((const unsigned*)((const char*)(gbase) + (voff)[_i]), (LAS unsigned*)(lds + (bufoff) + ldsw + _i * 8192), 16, 0, 0); } while (0)
#define PG8_LDA(dst, b, h) do { _Pragma("unroll") for (int m = 0; m < 4; ++m) _Pragma("unroll") for (int k = 0; k < 2; ++k) dst[m][k] = *(const LAS bf16x8*)(lds + PG8_SA(b, h) + aoff + m * 2048 + k * 1024); } while (0)
#define PG8_LDB(dst, b, h) do { _Pragma("unroll") for (int n = 0; n < 2; ++n) _Pragma("unroll") for (int k = 0; k < 2; ++k) dst[n][k] = *(const LAS bf16x8*)(lds + PG8_SB(b, h) + boff + n * 2048 + k * 1024); } while (0)
#define PG8_MMA(ai, bj, At, Bt) do { __builtin_amdgcn_s_setprio(1); _Pragma("unroll") for (int m = 0; m < 4; ++m) _Pragma("unroll") for (int n = 0; n < 2; ++n) _Pragma("unroll") for (int k = 0; k < 2; ++k) \
        acc[ai][bj][m][n] = __builtin_amdgcn_mfma_f32_16x16x32_bf16(Bt[n][k], At[m][k], acc[ai][bj][m][n], 0, 0, 0); __builtin_amdgcn_s_setprio(0); } while (0)
#define PG8_WAIT_V(n) asm volatile("s_waitcnt vmcnt(" #n ")" ::: "memory")
#define PG8_WAIT_L(n) asm volatile("s_waitcnt lgkmcnt(" #n ")" ::: "memory")
#define PG8_BAR __builtin_amdgcn_s_barrier()
#define PG8_SCHED __builtin_amdgcn_sched_barrier(0)
#define PG8_VOFF(dst, u) do { _Pragma("unroll") for (int _h = 0; _h < 2; ++_h) _Pragma("unroll") for (int _i = 0; _i < 2; ++_i) \
        dst[_h][_i] = (unsigned)S.arow(u, 128 * _h + RA[_i]) * (unsigned)(K * 2) + (unsigned)(CA[_i] * 2); } while (0)
    Unit cur, nxt; int ui = 0;
    if (!S.next(0, cur)) return;
    f32x4 acc[2][2][4][2];
#pragma unroll
    for (int a = 0; a < 2; ++a)
#pragma unroll
        for (int b = 0; b < 2; ++b)
#pragma unroll
            for (int m = 0; m < 4; ++m)
#pragma unroll
                for (int n = 0; n < 2; ++n) acc[a][b][m][n] = (f32x4){0.f, 0.f, 0.f, 0.f};
    bf16x8 At[4][2], B0[2][2], B1[2][2];
    unsigned vC[2][2], vN[2][2];
    PG8_VOFF(vC, cur);
    const char* cB = (const char*)S.bbase(cur);
    PG8_STAGE(PG8_SB(0, 0), cB, voffB); PG8_STAGE(PG8_SB(0, 1), cB + hstep, voffB); PG8_STAGE(PG8_SA(0, 0), Ab, vC[0]); PG8_STAGE(PG8_SA(0, 1), Ab, vC[1]);
    if (wr == 1) PG8_BAR;
    PG8_WAIT_V(2); PG8_BAR;
    PG8_STAGE(PG8_SB(1, 0), cB + kstep, voffB); PG8_STAGE(PG8_SA(1, 0), Ab + kstep, vC[0]); PG8_STAGE(PG8_SB(1, 1), cB + hstep + kstep, voffB);
    PG8_WAIT_V(6); PG8_BAR;
    for (;;) {
        const bool has_next = S.next(ui + 1, nxt);
        const char* nB = cB;
        if (has_next) { PG8_VOFF(vN, nxt); nB = (const char*)S.bbase(nxt); }
        else {
#pragma unroll
            for (int h = 0; h < 2; ++h)
#pragma unroll
                for (int i = 0; i < 2; ++i) vN[h][i] = vC[h][i]; }
        for (int t = 0; t < nt; t += 2) {
            const bool last = (t == nt - 2);
            const char* a1 = Ab + (size_t)(t + 1) * kstep;
            const char* a2 = last ? Ab : Ab + (size_t)(t + 2) * kstep; const char* b2 = last ? nB : cB + (size_t)(t + 2) * kstep;
            const char* a3 = a2 + kstep; const char* b3 = b2 + kstep;
            unsigned v2[2][2];
#pragma unroll
            for (int h = 0; h < 2; ++h)
#pragma unroll
                for (int i = 0; i < 2; ++i) v2[h][i] = last ? vN[h][i] : vC[h][i];
            PG8_LDB(B0, 0, 0); PG8_LDB(B1, 0, 1); PG8_SCHED; PG8_LDA(At, 0, 0); PG8_STAGE(PG8_SA(1, 1), a1, vC[1]);
            PG8_WAIT_V(8); PG8_WAIT_L(0); PG8_BAR; PG8_MMA(0, 0, At, B0); PG8_MMA(0, 1, At, B1); PG8_BAR; PG8_SCHED;
            PG8_LDA(At, 0, 1); PG8_STAGE(PG8_SB(0, 0), b2, voffB); PG8_STAGE(PG8_SB(0, 1), b2 + hstep, voffB); PG8_STAGE(PG8_SA(0, 0), a2, v2[0]);
            PG8_WAIT_V(8); PG8_WAIT_L(0); PG8_BAR; PG8_MMA(1, 0, At, B0); PG8_MMA(1, 1, At, B1); PG8_BAR; PG8_SCHED;
            PG8_LDB(B0, 1, 0); PG8_LDB(B1, 1, 1); PG8_SCHED; PG8_LDA(At, 1, 0); PG8_STAGE(PG8_SA(0, 1), a2, v2[1]);
            PG8_WAIT_V(8); PG8_WAIT_L(0); PG8_BAR; PG8_MMA(0, 0, At, B0); PG8_MMA(0, 1, At, B1); PG8_BAR; PG8_SCHED;
            PG8_LDA(At, 1, 1); PG8_STAGE(PG8_SB(1, 0), b3, voffB); PG8_STAGE(PG8_SB(1, 1), b3 + hstep, voffB); PG8_STAGE(PG8_SA(1, 0), a3, v2[0]);
            PG8_WAIT_V(8); PG8_WAIT_L(0); PG8_BAR; PG8_MMA(1, 0, At, B0); PG8_MMA(1, 1, At, B1); PG8_BAR; PG8_SCHED;
        }
        if (wr == 0) PG8_BAR;
        E(acc, cur, wr, wc, fr, fq);
        if (!has_next) break;
#pragma unroll
        for (int a = 0; a < 2; ++a)
#pragma unroll
            for (int b = 0; b < 2; ++b)
#pragma unroll
                for (int m = 0; m < 4; ++m)
#pragma unroll
                    for (int n = 0; n < 2; ++n) acc[a][b][m][n] = (f32x4){0.f, 0.f, 0.f, 0.f};
        cur = nxt; cB = nB; ++ui;
#pragma unroll
        for (int h = 0; h < 2; ++h)
#pragma unroll
            for (int i = 0; i < 2; ++i) vC[h][i] = vN[h][i];
        if (wr == 1) PG8_BAR;
    }
    PG8_WAIT_V(0);
    PG8_BAR;
#undef PG8_SA
#undef PG8_SB
#undef PG8_STAGE
#undef PG8_LDA
#undef PG8_LDB
#undef PG8_MMA
#undef PG8_WAIT_V
#undef PG8_WAIT_L
#undef PG8_BAR
#undef PG8_SCHED
#undef PG8_VOFF
}
#ifndef GEMM_SIMPLE
#define GEMM gemm_fast
#else
#define GEMM gemm_simple
#endif

__device__ __forceinline__ u32x4 pack8(const f32x4& a, const f32x4& b) { u32x4 w; w.x = pk2(a[0], a[1]); w.y = pk2(a[2], a[3]); w.z = pk2(b[0], b[1]); w.w = pk2(b[2], b[3]); return w; }
template <bool GLU> struct EpiInProj {
    bf16_t* Q; bf16_t* KV; bf16_t* Gb;
    __device__ __forceinline__ void operator()(const f32x4 (&acc)[2][2][4][2], const Unit& u, int wr, int wc, int fr, int fq) const {
#pragma unroll
        for (int ai = 0; ai < 2; ++ai)
#pragma unroll
            for (int m = 0; m < 4; ++m) { const size_t row = (size_t)u.pm * 256 + 128 * ai + 64 * wr + 16 * m + fr; const int cl = 32 * wc + 8 * fq;
                if (u.pn < 2) { *(u32x4*)(Q + row * 512 + u.pn * 256 + cl) = pack8(acc[ai][0][m][0], acc[ai][0][m][1]); *(u32x4*)(Q + row * 512 + u.pn * 256 + 128 + cl) = pack8(acc[ai][1][m][0], acc[ai][1][m][1]); }
                else if (u.pn == 2) { *(u32x4*)(KV + row * 256 + cl) = pack8(acc[ai][0][m][0], acc[ai][0][m][1]); *(u32x4*)(KV + row * 256 + 128 + cl) = pack8(acc[ai][1][m][0], acc[ai][1][m][1]); }
                else if (GLU) { f32x4 g0, g1;
#pragma unroll
                    for (int j = 0; j < 4; ++j) { g0[j] = acc[ai][0][m][0][j] * sigmoidf_(acc[ai][1][m][0][j]); g1[j] = acc[ai][0][m][1][j] * sigmoidf_(acc[ai][1][m][1][j]); }
                    *(u32x4*)(Gb + row * 512 + (u.pn - 3) * 128 + cl) = pack8(g0, g1); }
                else { *(u32x4*)(Gb + row * 512 + (u.pn - 3) * 256 + cl) = pack8(acc[ai][0][m][0], acc[ai][0][m][1]); *(u32x4*)(Gb + row * 512 + (u.pn - 3) * 256 + 128 + cl) = pack8(acc[ai][1][m][0], acc[ai][1][m][1]); }
            }
    }
};
template <bool L0> struct EpiOutProj {
    Frame F; int l;
    __device__ __forceinline__ void operator()(const f32x4 (&acc)[2][2][4][2], const Unit& u, int wr, int wc, int fr, int fq) const {
#pragma unroll
        for (int ai = 0; ai < 2; ++ai)
#pragma unroll
            for (int m = 0; m < 4; ++m) { const int row = u.pm * 256 + 128 * ai + 64 * wr + 16 * m + fr; const float* g1 = F.mod(l, modrow(row), 2);
                const float* src = L0 ? F.xin_row(row) : F.xr_row(row); float* dst = F.xr_row(row);
#pragma unroll
                for (int bj = 0; bj < 2; ++bj)
#pragma unroll
                    for (int n = 0; n < 2; ++n) { const int c = u.pn * 256 + 128 * bj + 32 * wc + 8 * fq + 4 * n;
                        const f32x4 xv = *(const f32x4*)(src + c), gv = *(const f32x4*)(g1 + c); *(f32x4*)(dst + c) = xv + gv * acc[ai][bj][m][n]; } }
    }
};
struct EpiMoe1 {
    bf16_t* HID;
    __device__ __forceinline__ void operator()(const f32x4 (&acc)[2][2][4][2], const Unit& u, int wr, int wc, int fr, int fq) const {
#pragma unroll
        for (int ai = 0; ai < 2; ++ai)
#pragma unroll
            for (int m = 0; m < 4; ++m) { const size_t slot = (size_t)u.pm * 256 + 128 * ai + 64 * wr + 16 * m + fr; f32x4 h0, h1;
#pragma unroll
                for (int j = 0; j < 4; ++j) { const float a = acc[ai][0][m][0][j], b = acc[ai][0][m][1][j]; h0[j] = a * sigmoidf_(a) * acc[ai][1][m][0][j]; h1[j] = b * sigmoidf_(b) * acc[ai][1][m][1][j]; }
                *(u32x4*)(HID + slot * 512 + u.pn * 128 + 32 * wc + 8 * fq) = pack8(h0, h1); }
    }
};
struct EpiMoe2 {
    bf16_t* YB;
    __device__ __forceinline__ void operator()(const f32x4 (&acc)[2][2][4][2], const Unit& u, int wr, int wc, int fr, int fq) const {
#pragma unroll
        for (int ai = 0; ai < 2; ++ai)
#pragma unroll
            for (int m = 0; m < 4; ++m) { const size_t slot = (size_t)u.pm * 256 + 128 * ai + 64 * wr + 16 * m + fr;
#pragma unroll
                for (int bj = 0; bj < 2; ++bj) *(u32x4*)(YB + slot * 1024 + u.pn * 256 + 128 * bj + 32 * wc + 8 * fq) = pack8(acc[ai][bj][m][0], acc[ai][bj][m][1]); }
    }
};

__device__ __forceinline__ void p_qkv_post(const Frame& F, const float* qg, const float* kg, bool ctx_q) {
    const int gw = F.vcu * NWAVES + F.wave, NGW = F.G * NWAVES, lane = F.lane;
    bf16_t* Q = (bf16_t*)(F.ws + WS_Q); const bf16_t* KV = (const bf16_t*)(F.ws + WS_KV); bf16_t* Kn = (bf16_t*)(F.ws + WS_KN); bf16_t* Vn = (bf16_t*)(F.ws + WS_VN);
    const float* rc = (const float*)(F.ws + WS_ROPE); const float* rs = rc + SEQ * 32;
    const int i8 = lane & 7, dd0 = 8 * (i8 & 3);
    float gq[8], gk[8];
#pragma unroll
    for (int j = 0; j < 8; ++j) { gq[j] = qg[i8 * 8 + j]; gk[j] = kg[i8 * 8 + j]; }
    for (int row = gw; row < TT; row += NGW) {
        const bool isctx = row >= TX; const int b = isctx ? (row - TX) >> 8 : row >> 12, s = isctx ? (row - TX) & 255 : row & 4095;
        float cs[8], sn[8];
#pragma unroll
        for (int j = 0; j < 8; ++j) { cs[j] = 1.f; sn[j] = 0.f; }
        if (!isctx) {
#pragma unroll
            for (int j = 0; j < 8; ++j) { cs[j] = rc[s * 32 + dd0 + j]; sn[j] = rs[s * 32 + dd0 + j]; } }
        const float sgn = (i8 < 4) ? -1.f : 1.f;
        if (!isctx || ctx_q) {
            const u32x4 w = *(const u32x4*)(Q + (size_t)row * 512 + lane * 8);
            float x[8] = {bflo(w.x), bfhi(w.x), bflo(w.y), bfhi(w.y), bflo(w.z), bfhi(w.z), bflo(w.w), bfhi(w.w)};
            float ss = 0.f;
#pragma unroll
            for (int j = 0; j < 8; ++j) ss += x[j] * x[j];
            ss += __shfl_xor(ss, 1); ss += __shfl_xor(ss, 2); ss += __shfl_xor(ss, 4);
            const float rms = 1.0f / sqrtf(ss * (1.f / 64.f) + EPS);
            float y[8], o[8];
#pragma unroll
            for (int j = 0; j < 8; ++j) y[j] = x[j] * rms * gq[j];
#pragma unroll
            for (int j = 0; j < 8; ++j) { const float yp = __shfl_xor(y[j], 4); o[j] = (y[j] * cs[j] + sgn * yp * sn[j]) * C2; }
            u32x4 ow; ow.x = pk2(o[0], o[1]); ow.y = pk2(o[2], o[3]); ow.z = pk2(o[4], o[5]); ow.w = pk2(o[6], o[7]);
            *(u32x4*)(Q + (size_t)row * 512 + lane * 8) = ow;
        }
        {
            const int l32 = lane & 31;
            const u32x4 w = *(const u32x4*)(KV + (size_t)row * 256 + l32 * 8);
            float x[8] = {bflo(w.x), bfhi(w.x), bflo(w.y), bfhi(w.y), bflo(w.z), bfhi(w.z), bflo(w.w), bfhi(w.w)};
            float ss = 0.f;
#pragma unroll
            for (int j = 0; j < 8; ++j) ss += x[j] * x[j];
            ss += __shfl_xor(ss, 1); ss += __shfl_xor(ss, 2); ss += __shfl_xor(ss, 4);
            const float rms = 1.0f / sqrtf(ss * (1.f / 64.f) + EPS);
            float y[8], o[8];
#pragma unroll
            for (int j = 0; j < 8; ++j) y[j] = x[j] * rms * gk[j];
#pragma unroll
            for (int j = 0; j < 8; ++j) { const float yp = __shfl_xor(y[j], 4); o[j] = y[j] * cs[j] + sgn * yp * sn[j]; }
            const size_t kvrow = (size_t)b * KVS + (isctx ? s : CTXL + s);
            if (lane < 16) { u32x4 ow; ow.x = pk2(o[0], o[1]); ow.y = pk2(o[2], o[3]); ow.z = pk2(o[4], o[5]); ow.w = pk2(o[6], o[7]); *(u32x4*)(Kn + kvrow * 128 + lane * 8) = ow; }
            else if (lane < 32) { *(u32x4*)(Vn + kvrow * 128 + (lane - 16) * 8) = w; }
        }
    }
}
__device__ __forceinline__ void p_conv(const Frame& F) {
    const bf16_t* Gb = (const bf16_t*)(F.ws + WS_G); bf16_t* AO = (bf16_t*)(F.ws + WS_AO);
    LAS bf16_t* gl = (LAS bf16_t*)F.lds;
    LAS float* yl = (LAS float*)(F.lds + 65536);
    const int c = F.tid;
    float w[31];
#pragma unroll
    for (int j = 0; j < 31; ++j) w[j] = F.in[I_CONVW][j * 512 + c];
    const float bias = F.in[I_CONVB][c];
    for (int item = F.vcu; item < 1024 + 64; item += F.G) {
        int rowbase, t0, len;
        if (item < 1024) { rowbase = (item >> 7) * SEQ; t0 = (item & 127) * 32; len = SEQ; } else { const int it = item - 1024; rowbase = TX + (it >> 3) * CTXL; t0 = (it & 7) * 32; len = CTXL; }
        __syncthreads();
        for (int ch = F.tid; ch < 62 * 64; ch += NTHREADS) { const int r = ch >> 6, p = t0 - 15 + r; u32x4 v = (u32x4){0u, 0u, 0u, 0u};
            if (p >= 0 && p < len) v = *(const u32x4*)(Gb + (size_t)(rowbase + p) * 512 + (ch & 63) * 8);
            *(LAS u32x4*)(gl + r * 512 + (ch & 63) * 8) = v; }
        __syncthreads();
        float g[62];
#pragma unroll
        for (int r = 0; r < 62; ++r) g[r] = bf2f(gl[r * 512 + c]);
#pragma unroll
        for (int t = 0; t < 32; ++t) { float y = bias;
#pragma unroll
            for (int j = 0; j < 31; ++j) y += g[t + j] * w[j];
            yl[t * 512 + c] = y; }
        __syncthreads();
#pragma unroll
        for (int tt = 0; tt < 4; ++tt) { const int t = 4 * F.wave + tt; float v[8]; float s = 0.f;
#pragma unroll
            for (int j = 0; j < 8; ++j) { v[j] = yl[t * 512 + F.lane + 64 * j]; s += v[j]; }
            const float mean = wave_sum(s) * (1.f / 512.f); float q = 0.f;
#pragma unroll
            for (int j = 0; j < 8; ++j) { v[j] -= mean; q += v[j] * v[j]; }
            const float rstd = 1.0f / sqrtf(wave_sum(q) * (1.f / 512.f) + EPS);
            bf16_t* orow = AO + (size_t)(rowbase + t0 + t) * 1024 + 512;
#pragma unroll
            for (int j = 0; j < 8; ++j) { const int cc = F.lane + 64 * j; const float yn = v[j] * rstd * F.in[I_CLNG][cc] + F.in[I_CLNB][cc]; orow[cc] = (bf16_t)(pk2(yn * sigmoidf_(yn), 0.f) & 0xffffu); } }
    }
    __syncthreads();
}
__device__ __forceinline__ void p_pool(const Frame& F) {
    const int gw = F.vcu * NWAVES + F.wave, NGW = F.G * NWAVES, lane = F.lane;
    const bf16_t* U = (const bf16_t*)(F.ws + WS_G); bf16_t* AO = (bf16_t*)(F.ws + WS_AO);
    const int wdt = 2 << (lane >> 4);
    for (int row = gw; row < TX; row += NGW) {
        const int t = row & 4095, rb = row - t;
        int lo = t - (wdt >> 1), hi = lo + wdt; lo = lo < 0 ? 0 : lo; hi = hi > SEQ ? SEQ : hi;
        float s[8];
#pragma unroll
        for (int j = 0; j < 8; ++j) s[j] = 0.f;
        for (int i = 0; i < 16; ++i) { const int p = lo + i; if (p < hi) { const u32x4 w = *(const u32x4*)(U + (size_t)(rb + p) * 512 + lane * 8);
            s[0] += bflo(w.x); s[1] += bfhi(w.x); s[2] += bflo(w.y); s[3] += bfhi(w.y); s[4] += bflo(w.z); s[5] += bfhi(w.z); s[6] += bflo(w.w); s[7] += bfhi(w.w); } }
        const u32x4 w = *(const u32x4*)(U + (size_t)row * 512 + lane * 8); const float inv = 1.f / (float)(hi - lo);
        float o[8] = {s[0] * inv - bflo(w.x), s[1] * inv - bfhi(w.x), s[2] * inv - bflo(w.y), s[3] * inv - bfhi(w.y), s[4] * inv - bflo(w.z), s[5] * inv - bfhi(w.z), s[6] * inv - bflo(w.w), s[7] * inv - bfhi(w.w)};
        u32x4 ow; ow.x = pk2(o[0], o[1]); ow.y = pk2(o[2], o[3]); ow.z = pk2(o[4], o[5]); ow.w = pk2(o[6], o[7]);
        *(u32x4*)(AO + (size_t)row * 1024 + 512 + lane * 8) = ow;
    }
}

template <int LAYER> __device__ __forceinline__ void attn_simple(const Frame& F) {
    const bf16_t* Q = (const bf16_t*)(F.ws + WS_Q); const bf16_t* Kn = (const bf16_t*)(F.ws + WS_KN); const bf16_t* Vn = (const bf16_t*)(F.ws + WS_VN); bf16_t* AO = (bf16_t*)(F.ws + WS_AO);
    const int nunits = LAYER == 0 ? 512 + 64 : 512;
    for (int u = F.vcu; u < nunits; u += F.G) {
        int b, h, row, s; bool valid = true, isctx = false;
        if (u < 512) { b = u >> 6; h = (u >> 3) & 7; s = (u & 7) * 512 + F.tid; row = b * SEQ + s; }
        else { const int uc = u - 512; b = uc >> 3; h = uc & 7; s = F.tid; valid = F.tid < 256; row = TX + b * CTXL + (valid ? s : 0); isctx = true; }
        float q[64], o[64];
        { const u32x4* qp = (const u32x4*)(Q + (size_t)row * 512 + h * 64);
#pragma unroll
          for (int c = 0; c < 8; ++c) { const u32x4 w = qp[c]; q[8 * c] = bflo(w.x); q[8 * c + 1] = bfhi(w.x); q[8 * c + 2] = bflo(w.y); q[8 * c + 3] = bfhi(w.y); q[8 * c + 4] = bflo(w.z); q[8 * c + 5] = bfhi(w.z); q[8 * c + 6] = bflo(w.w); q[8 * c + 7] = bfhi(w.w); } }
#pragma unroll
        for (int d = 0; d < 64; ++d) o[d] = 0.f;
        float mx = -1e30f, l = 0.f;
        const bf16_t* Kb = Kn + (size_t)b * KVS * 128 + (h >> 2) * 64; const bf16_t* Vb = Vn + (size_t)b * KVS * 128 + (h >> 2) * 64;
        int k_lo2 = 0, k_hi2 = 0;
        const int k_hi1 = CTXL;
        if (LAYER == 0) { if (!isctx) { k_lo2 = CTXL; k_hi2 = KVS; } }
        else { const int s0 = (u & 7) * 512; int lo = s0 - 128, hi = s0 + 511 + 128 + 1; lo = lo < 0 ? 0 : lo; hi = hi > SEQ ? SEQ : hi; k_lo2 = CTXL + lo; k_hi2 = CTXL + hi; }
        for (int part = 0; part < 2; ++part) {
            const int kb = part == 0 ? 0 : k_lo2, ke = part == 0 ? k_hi1 : k_hi2;
            for (int key = kb; key < ke; ++key) {
                const u32x4* kp = (const u32x4*)(Kb + (size_t)key * 128); float sd = 0.f;
#pragma unroll
                for (int c = 0; c < 8; ++c) { const u32x4 w = kp[c];
                    sd += q[8 * c] * bflo(w.x) + q[8 * c + 1] * bfhi(w.x) + q[8 * c + 2] * bflo(w.y) + q[8 * c + 3] * bfhi(w.y) + q[8 * c + 4] * bflo(w.z) + q[8 * c + 5] * bfhi(w.z) + q[8 * c + 6] * bflo(w.w) + q[8 * c + 7] * bfhi(w.w); }
                bool use = valid;
                if (LAYER == 1 && part == 1) { const int j = key - CTXL; const int dlt = s - j; use = use && (dlt <= 128 && dlt >= -128); }
                const float mn = fmaxf(mx, sd); const float mnew = use ? mn : mx;
                const float alpha = exp2f(mx - mnew), p = use ? exp2f(sd - mnew) : 0.f;
                mx = mnew; l = l * alpha + p;
                const u32x4* vp = (const u32x4*)(Vb + (size_t)key * 128);
#pragma unroll
                for (int c = 0; c < 8; ++c) { const u32x4 w = vp[c];
                    o[8 * c] = o[8 * c] * alpha + p * bflo(w.x); o[8 * c + 1] = o[8 * c + 1] * alpha + p * bfhi(w.x); o[8 * c + 2] = o[8 * c + 2] * alpha + p * bflo(w.y); o[8 * c + 3] = o[8 * c + 3] * alpha + p * bfhi(w.y);
                    o[8 * c + 4] = o[8 * c + 4] * alpha + p * bflo(w.z); o[8 * c + 5] = o[8 * c + 5] * alpha + p * bfhi(w.z); o[8 * c + 6] = o[8 * c + 6] * alpha + p * bflo(w.w); o[8 * c + 7] = o[8 * c + 7] * alpha + p * bfhi(w.w); }
            }
        }
        if (LAYER == 1) l += exp2f(F.in[I_SINK][h] * LOG2E - mx);
        const float il = 1.f / l;
        if (valid) { u32x4* op = (u32x4*)(AO + (size_t)row * 1024 + h * 64);
#pragma unroll
            for (int c = 0; c < 8; ++c) { u32x4 w; w.x = pk2(o[8 * c] * il, o[8 * c + 1] * il); w.y = pk2(o[8 * c + 2] * il, o[8 * c + 3] * il); w.z = pk2(o[8 * c + 4] * il, o[8 * c + 5] * il); w.w = pk2(o[8 * c + 6] * il, o[8 * c + 7] * il); op[c] = w; } }
    }
}

__device__ __forceinline__ void p_router(const Frame& F, int l, int ntok) {
    const int gw = F.vcu * NWAVES + F.wave, NGW = F.G * NWAVES, lane = F.lane;
    bf16_t* HX = (bf16_t*)(F.ws + WS_HX);
    const float* gwt = F.in[I_RGW] + (size_t)l * 1024 * 4; const float* ewt = F.in[I_REW] + (size_t)l * 1024 * 32;
    const float* gb = F.in[I_RGB] + l * 4; const float* eb = F.in[I_REB] + l * 32;
    unsigned* tokslot = (unsigned*)(F.ws + WS_TOK); float* tokw = (float*)(F.ws + WS_TOK + 512 * 1024); unsigned* list = (unsigned*)(F.ws + WS_LIST);
    unsigned* cnt = F.cnt(l);
    for (int row = gw; row < ntok; row += NGW) {
        const int r = modrow(row); f32x4 h[4];
        norm_mod_row(F.xr_row(row), F.in[I_LN2] + l * 1024, F.mod(l, r, 3), F.mod(l, r, 4), lane, h);
        store_row_bf16(HX + (size_t)row * DM, lane, h);
        float lg[4], le[32];
#pragma unroll
        for (int o = 0; o < 4; ++o) lg[o] = 0.f;
#pragma unroll
        for (int o = 0; o < 32; ++o) le[o] = 0.f;
#pragma unroll
        for (int j = 0; j < 4; ++j) {
            const float* gp = gwt + (size_t)(4 * lane + 256 * j) * 4; const float* ep = ewt + (size_t)(4 * lane + 256 * j) * 32;
            asm volatile("" : "+v"(gp), "+v"(ep));
#pragma unroll
            for (int i = 0; i < 4; ++i) { const float hv = h[j][i];
                const f32x4 g4 = *(const f32x4*)(gp + i * 4);
                lg[0] += hv * g4[0]; lg[1] += hv * g4[1]; lg[2] += hv * g4[2]; lg[3] += hv * g4[3];
#pragma unroll
                for (int q = 0; q < 8; ++q) { const f32x4 e4 = *(const f32x4*)(ep + i * 32 + 4 * q); le[4 * q] += hv * e4[0]; le[4 * q + 1] += hv * e4[1]; le[4 * q + 2] += hv * e4[2]; le[4 * q + 3] += hv * e4[3]; } }
            __builtin_amdgcn_sched_barrier(0); }
#pragma unroll
        for (int o = 0; o < 4; ++o) lg[o] = wave_sum(lg[o]) + gb[o];
#pragma unroll
        for (int o = 0; o < 32; ++o) { le[o] = wave_sum(le[o]) + eb[o]; if ((o & 3) == 3) __builtin_amdgcn_sched_barrier(0); }
        int gs = 0; float gm = lg[0];
#pragma unroll
        for (int o = 1; o < 4; ++o) if (lg[o] > gm) { gm = lg[o]; gs = o; }
        float gden = 0.f;
#pragma unroll
        for (int o = 0; o < 4; ++o) gden += expf(lg[o] - gm);
        const float g_w = 1.f / gden;
        float el[8];
#pragma unroll
        for (int i = 0; i < 8; ++i) { el[i] = le[i];
#pragma unroll
            for (int g = 1; g < 4; ++g) el[i] = (gs == g) ? le[g * 8 + i] : el[i]; }
        int i1 = 0; float m1 = el[0];
#pragma unroll
        for (int i = 1; i < 8; ++i) if (el[i] > m1) { m1 = el[i]; i1 = i; }
        int i2 = -1; float m2 = -3.0e38f;
#pragma unroll
        for (int i = 0; i < 8; ++i) if (i != i1 && el[i] > m2) { m2 = el[i]; i2 = i; }
        const float p2 = expf(m2 - m1); const float w1 = g_w / (1.f + p2), w2 = g_w * p2 / (1.f + p2);
        if (lane == 0) { const int e1 = gs * 8 + i1, e2 = gs * 8 + i2;
            const unsigned pos1 = atomicAdd(cnt + e1 * 64, 1u), pos2 = atomicAdd(cnt + e2 * 64, 1u);
            list[(size_t)e1 * TT + pos1] = (unsigned)row; list[(size_t)e2 * TT + pos2] = (unsigned)row;
            tokslot[2 * row] = ((unsigned)e1 << 16) | pos1; tokslot[2 * row + 1] = ((unsigned)e2 << 16) | pos2; tokw[2 * row] = w1; tokw[2 * row + 1] = w2; }
    }
}
template <bool LAST> __device__ __forceinline__ void p_combine(const Frame& F, int l, int ntok, const MoeTab& tb) {
    const int gw = F.vcu * NWAVES + F.wave, NGW = F.G * NWAVES, lane = F.lane;
    const bf16_t* YB = (const bf16_t*)(F.ws + WS_YB); bf16_t* HX = (bf16_t*)(F.ws + WS_HX);
    const unsigned* tokslot = (const unsigned*)(F.ws + WS_TOK); const float* tokw = (const float*)(F.ws + WS_TOK + 512 * 1024);
    for (int row = gw; row < ntok; row += NGW) {
        const unsigned sa = tokslot[2 * row], sb = tokslot[2 * row + 1]; const float wa = tokw[2 * row], wb = tokw[2 * row + 1];
        const size_t slota = (size_t)tb.tile0[sa >> 16] * 256 + (sa & 0xffffu), slotb = (size_t)tb.tile0[sb >> 16] * 256 + (sb & 0xffffu);
        const int r = modrow(row); const float* g2 = F.mod(l, r, 5); float* xr = F.xr_row(row);
        float ss = 0.f; f32x4 v[4];
#pragma unroll
        for (int j = 0; j < 4; ++j) { const int c = 4 * lane + 256 * j; const u32x2 ya = *(const u32x2*)(YB + slota * 1024 + c), yb = *(const u32x2*)(YB + slotb * 1024 + c);
            const f32x4 x1 = *(const f32x4*)(xr + c), gv = *(const f32x4*)(g2 + c);
            f32x4 y; y[0] = wa * bflo(ya.x) + wb * bflo(yb.x); y[1] = wa * bfhi(ya.x) + wb * bfhi(yb.x); y[2] = wa * bflo(ya.y) + wb * bflo(yb.y); y[3] = wa * bfhi(ya.y) + wb * bfhi(yb.y);
            v[j] = x1 + gv * y; *(f32x4*)(xr + c) = v[j];
            ss += (v[j][0] * v[j][0] + v[j][1] * v[j][1]) + (v[j][2] * v[j][2] + v[j][3] * v[j][3]); }
        if (!LAST) { const float rms = 1.0f / sqrtf(wave_sum(ss) * (1.f / 1024.f) + EPS); const float* g = F.in[I_LN1] + (l + 1) * 1024; const float* sh = F.mod(l + 1, r, 0); const float* sc = F.mod(l + 1, r, 1); f32x4 h[4];
#pragma unroll
            for (int j = 0; j < 4; ++j) { const int c = 4 * lane + 256 * j; h[j] = (v[j] * rms * *(const f32x4*)(g + c)) * (1.f + *(const f32x4*)(sc + c)) + *(const f32x4*)(sh + c); }
            store_row_bf16(HX + (size_t)row * DM, lane, h); }
    }
}

__global__ void __launch_bounds__(NTHREADS, 2) fwd_kernel(Params P) {
    extern __shared__ __attribute__((aligned(16))) unsigned char lds_raw[];
    Frame F;
    F.lds = (LAS unsigned char*)lds_raw; F.in = P.in; F.out = P.out; F.ws = P.ws;
    F.tid = threadIdx.x; F.lane = F.tid & 63; F.wave = __builtin_amdgcn_readfirstlane(F.tid >> 6);
    F.G = gridDim.x; { const int bx = blockIdx.x; F.vcu = (F.G % 8 == 0) ? (bx % 8) * (F.G / 8) + bx / 8 : bx; }
    volatile LAS unsigned* misc = (volatile LAS unsigned*)(F.lds + LDS_MISC);
    if (F.tid < 16) misc[F.tid] = 0u;
    __syncthreads();
#if ONE_LAUNCH
    XcdBarrier bar = xcd_barrier_post((unsigned*)(F.ws + WS_CTL) + CW_BAR, misc + 8);
#define GRID_BAR() do { xcd_barrier(bar); } while (0)
#else
#define GRID_BAR() do { } while (0)
#endif
    const int lo = P.ph_lo, hi = P.ph_hi;
#ifndef PHMASK
#define PHMASK 0xFFFFFFFFu
#endif
#define IN(k) (((PHMASK >> (k)) & 1u) && lo <= (k) && (k) < hi)
#define SEAM(k) do { if (IN((k) + 1)) GRID_BAR(); } while (0)
    bf16_t* HX = (bf16_t*)(F.ws + WS_HX); bf16_t* Qb = (bf16_t*)(F.ws + WS_Q); bf16_t* KVb = (bf16_t*)(F.ws + WS_KV); bf16_t* Gb = (bf16_t*)(F.ws + WS_G); bf16_t* AO = (bf16_t*)(F.ws + WS_AO);
    bf16_t* HID = (bf16_t*)(F.ws + WS_HID); bf16_t* YB = (bf16_t*)(F.ws + WS_YB);

    if (IN(0)) { p0_prologue(F); SEAM(0); }
    if (IN(1)) { p_norm1_l0(F); SEAM(1); }
    if (IN(2)) { SchedDense S{(const bf16_t*)(F.ws + WS_WINAB), 1024, TT / 256, 7, 0, 0, F.vcu, F.G}; EpiInProj<true> E{Qb, KVb, Gb}; GEMM(F, HX, 1024, S, E); SEAM(2); }
    if (IN(3)) { p_qkv_post(F, F.in[I_QNA], F.in[I_KNA], true); p_conv(F); SEAM(3); }
    if (IN(4)) { attn_simple<0>(F); SEAM(4); }
    if (IN(5)) { SchedDense S{(const bf16_t*)(F.ws + WS_WOUTAB), 1024, TT / 256, 4, 0, 0, F.vcu, F.G}; EpiOutProj<true> E{F, 0}; GEMM(F, AO, 1024, S, E); SEAM(5); }
    if (IN(6)) { p_router(F, 0, TT); SEAM(6); }
    if (IN(7)) { const MoeTab tb = moe_tables(F, 0); SchedMoe S{(const bf16_t*)(F.ws + WS_WGU), (size_t)1024 * 1024, 1024, tb, (const unsigned*)(F.ws + WS_LIST), true, F.vcu, F.G}; EpiMoe1 E{HID}; GEMM(F, HX, 1024, S, E); SEAM(7); }
    if (IN(8)) { const MoeTab tb = moe_tables(F, 0); SchedMoe S{(const bf16_t*)(F.ws + WS_WD), (size_t)1024 * 512, 512, tb, nullptr, false, F.vcu, F.G}; EpiMoe2 E{YB}; GEMM(F, HID, 512, S, E); SEAM(8); }
    if (IN(9)) { const MoeTab tb = moe_tables(F, 0); p_combine<false>(F, 0, TT, tb); SEAM(9); }
    if (IN(10)) { SchedDense S{(const bf16_t*)(F.ws + WS_WINCD), 1024, TX / 256, 5, TC / 256, 2, F.vcu, F.G}; EpiInProj<false> E{Qb, KVb, Gb}; GEMM(F, HX, 1024, S, E); SEAM(10); }
    if (IN(11)) { p_qkv_post(F, F.in[I_QNC], F.in[I_KNC], false); p_pool(F); SEAM(11); }
    if (IN(12)) { attn_simple<1>(F); SEAM(12); }
    if (IN(13)) { SchedDense S{(const bf16_t*)(F.ws + WS_WOUTCD), 1024, TX / 256, 4, 0, 0, F.vcu, F.G}; EpiOutProj<false> E{F, 1}; GEMM(F, AO, 1024, S, E); SEAM(13); }
    if (IN(14)) { p_router(F, 1, TX); SEAM(14); }
    if (IN(15)) { const MoeTab tb = moe_tables(F, 1); SchedMoe S{(const bf16_t*)(F.ws + WS_WGU) + (size_t)32 * 1024 * 1024, (size_t)1024 * 1024, 1024, tb, (const unsigned*)(F.ws + WS_LIST), true, F.vcu, F.G}; EpiMoe1 E{HID}; GEMM(F, HX, 1024, S, E); SEAM(15); }
    if (IN(16)) { const MoeTab tb = moe_tables(F, 1); SchedMoe S{(const bf16_t*)(F.ws + WS_WD) + (size_t)32 * 1024 * 512, (size_t)1024 * 512, 512, tb, nullptr, false, F.vcu, F.G}; EpiMoe2 E{YB}; GEMM(F, HID, 512, S, E); SEAM(16); }
    if (IN(17)) { const MoeTab tb = moe_tables(F, 1); p_combine<true>(F, 1, TX, tb); }
#undef IN
#undef SEAM
}

extern "C" void kernel_launch(void* const* d_in, const int* in_sizes, int n_in, void* d_out, int out_size, void* d_ws, size_t ws_size, hipStream_t stream) {
    static int grid = 0;
    if (grid == 0) {
        if (n_in != 30 || out_size != TX * DM || ws_size < WS_END) { fprintf(stderr, "kernel_launch: unexpected shapes (n_in %d out %d ws %zu)\n", n_in, out_size, ws_size); grid = -1; return; }
        int dev = 0, cus = 0;
        if (hipGetDevice(&dev) != hipSuccess || hipDeviceGetAttribute(&cus, hipDeviceAttributeMultiprocessorCount, dev) != hipSuccess) { grid = -1; return; }
        if (hipFuncSetAttribute((const void*)fwd_kernel, hipFuncAttributeMaxDynamicSharedMemorySize, LDS_BYTES) != hipSuccess) { fprintf(stderr, "kernel_launch: hipFuncSetAttribute failed\n"); grid = -1; return; }
        int per_cu = 0;
        if (hipOccupancyMaxActiveBlocksPerMultiprocessor(&per_cu, (const void*)fwd_kernel, NTHREADS, LDS_BYTES) != hipSuccess || per_cu < 1) { fprintf(stderr, "kernel_launch: occupancy query says %d\n", per_cu); }
        (void)hipGetLastError();
        grid = cus;
    }
    if (grid < 0) return;
    (void)hipMemsetAsync((char*)d_ws + WS_CTL, 0, CTL_ZERO_BYTES, stream);
    Params p{};
    for (int i = 0; i < 30; ++i) p.in[i] = (const float*)d_in[i];
    p.out = (float*)d_out; p.ws = (unsigned char*)d_ws;
#if ONE_LAUNCH
    p.ph_lo = 0; p.ph_hi = NPH;
    hipLaunchKernelGGL(fwd_kernel, dim3(grid), dim3(NTHREADS), LDS_BYTES, stream, p);
#else
    for (int ph = 0; ph < NPH; ++ph) { p.ph_lo = ph; p.ph_hi = ph + 1; hipLaunchKernelGGL(fwd_kernel, dim3(grid), dim3(NTHREADS), LDS_BYTES, stream, p); }
#endif
}
```

```cpp
#include <hip/hip_runtime.h>
#include <cstdio>
#include <cstdint>

#ifndef ONE_LAUNCH
#define ONE_LAUNCH 1
#endif

#define LAS __attribute__((address_space(3)))
#define GAS __attribute__((address_space(1)))
typedef unsigned short bf16_t;
typedef short bf16x8 __attribute__((ext_vector_type(8)));
typedef float f32x4 __attribute__((ext_vector_type(4)));
typedef float f32x2 __attribute__((ext_vector_type(2)));
typedef unsigned u32x4 __attribute__((ext_vector_type(4)));
typedef unsigned u32x2 __attribute__((ext_vector_type(2)));
typedef __bf16 bf16x2_t __attribute__((ext_vector_type(2)));

constexpr int NB = 8, SEQ = 4096, DM = 1024, CTXL = 256, HD = 64;
constexpr int TX = NB * SEQ, TC = NB * CTXL, TT = TX + TC;
constexpr int KVS = CTXL + SEQ;
constexpr int NE = 32;
constexpr int NTILE_MAX = 304, NSLOT = NTILE_MAX * 256;
constexpr float EPS = 1e-6f;
constexpr float LOG2E = 1.4426950408889634f;
constexpr float C2 = 0.125f * LOG2E;
constexpr int NWAVES = 8, NTHREADS = 512;
constexpr int NPH = 18;

enum { I_X = 0, I_C, I_CTX, I_CCTX, I_MODW, I_MODB, I_LN1, I_LN2, I_WINAB, I_WOUTAB, I_QNA, I_KNA, I_CONVW, I_CONVB, I_CLNG, I_CLNB,
       I_WINCD, I_WOUTCD, I_QNC, I_KNC, I_SINK, I_POOLW, I_POOLS, I_RGW, I_RGB, I_REW, I_REB, I_EXG, I_EXU, I_EXD };

constexpr size_t MiB = 1u << 20;
constexpr size_t WS_CTL = 0, CTL_ZERO_BYTES = 1 * MiB;
constexpr size_t WS_MOD = 1 * MiB;
constexpr size_t WS_ROPE = 2 * MiB;
constexpr size_t WS_TOK = 3 * MiB;
constexpr size_t WS_LIST = 4 * MiB;
constexpr size_t WS_WINAB = 10 * MiB;
constexpr size_t WS_WOUTAB = 14 * MiB;
constexpr size_t WS_WINCD = 16 * MiB;
constexpr size_t WS_WOUTCD = 19 * MiB;
constexpr size_t WS_XC = 21 * MiB;
constexpr size_t WS_KN = 30 * MiB;
constexpr size_t WS_VN = 39 * MiB;
constexpr size_t WS_WGU = 48 * MiB;
constexpr size_t WS_WD = 176 * MiB;
constexpr size_t WS_HX = 240 * MiB;
constexpr size_t WS_HID = 308 * MiB;
constexpr size_t WS_Q = 384 * MiB;
constexpr size_t WS_KV = 418 * MiB;
constexpr size_t WS_G = 435 * MiB;
constexpr size_t WS_AO = 469 * MiB;
constexpr size_t WS_YB = 384 * MiB;
constexpr size_t WS_SS = 537 * MiB;
constexpr size_t WS_WR = 9 * MiB;
constexpr size_t WS_END = 540 * MiB;
static_assert(WS_YB + (size_t)NSLOT * 1024 * 2 <= WS_END && WS_AO + (size_t)TT * 1024 * 2 <= WS_END, "ws map");
constexpr int CW_CNT = 256;
constexpr int CW_BAR = 8192;

constexpr int RING_BYTES = 131072;
constexpr int LDS_MISC = RING_BYTES;
constexpr int LDS_TAB = RING_BYTES + 256;
constexpr int LDS_BYTES = 147456;

__device__ __forceinline__ unsigned pk2(float lo, float hi) { f32x2 v = {lo, hi}; bf16x2_t b = __builtin_convertvector(v, bf16x2_t); return __builtin_bit_cast(unsigned, b); }
__device__ __forceinline__ float bflo(unsigned w) { return __uint_as_float(w << 16); }
__device__ __forceinline__ float bfhi(unsigned w) { return __uint_as_float(w & 0xffff0000u); }
__device__ __forceinline__ float bf2f(bf16_t h) { return __uint_as_float((unsigned)h << 16); }
__device__ __forceinline__ float wave_sum(float v) {
#pragma unroll
    for (int o = 1; o < 64; o <<= 1) v += __shfl_xor(v, o);
    return v;
}
__device__ __forceinline__ float sigmoidf_(float v) { return 1.f / (1.f + __expf(-v)); }

#define XB_TMO      128
#define XB_XCNT(j)  (256  + 64 * (j))
#define XB_XSUB(j)  (1280 + 64 * (j))
#define XB_XGEN(j)  (2304 + 64 * (j))
#define XB_TOP      3328
#define XB_TOPGEN   3392
#define XCD_BAR_WORDS 3456
#define XB_SPIN_CAP (1u << 18)
__device__ __forceinline__ unsigned xb_ld(unsigned* p)              { return __hip_atomic_load(p, __ATOMIC_RELAXED, __HIP_MEMORY_SCOPE_AGENT); }
__device__ __forceinline__ unsigned xb_add(unsigned* p, unsigned v) { return __hip_atomic_fetch_add(p, v, __ATOMIC_RELAXED, __HIP_MEMORY_SCOPE_AGENT); }
__device__ __forceinline__ unsigned xb_xcc_id() { return (unsigned)__builtin_amdgcn_s_getreg((3 << 11) | 20) & 0xFu; }
#define XB_SPIN(cond, bar) do { unsigned _sp = 0; while (cond) { __builtin_amdgcn_s_sleep(1); \
    if ((++_sp & 255u) == 0u) { if (xb_ld(&(bar)[XB_TMO])) break; if (_sp > XB_SPIN_CAP) { atomicAdd(&(bar)[XB_TMO], 1u); break; } } } } while (0)
struct XcdBarrier { unsigned* bar; unsigned x; volatile LAS unsigned* st; };
__device__ __forceinline__ XcdBarrier xcd_barrier_post(unsigned* bar, volatile LAS unsigned* st) {
    XcdBarrier b; b.bar = bar; b.x = xb_xcc_id(); b.st = st;
    if (threadIdx.x == 0) (void)xb_add(&bar[XB_XCNT(b.x)], 1u);
    return b;
}
__device__ __forceinline__ void xcd_barrier_complete(unsigned* bar, unsigned x, unsigned& nloc, unsigned& nx) {
    const unsigned G = gridDim.x * gridDim.y * gridDim.z;
    unsigned sum, cnt, mine, sp = 0u;
    for (;;) {
        sum = 0u; cnt = 0u; mine = 0u;
#pragma unroll
        for (unsigned j = 0; j < 16; ++j) { const unsigned c = xb_ld(&bar[XB_XCNT(j)]); sum += c; cnt += (c > 0u) ? 1u : 0u; mine = (j == x) ? c : mine; }
        if (sum == G) break;
        __builtin_amdgcn_s_sleep(1);
        if ((++sp & 255u) == 0u) { if (xb_ld(&bar[XB_TMO])) break; if (sp > XB_SPIN_CAP) { atomicAdd(&bar[XB_TMO], 1u); break; } }
    }
    nloc = mine > 0u ? mine : 1u; nx = cnt > 0u ? cnt : 1u;
}
__device__ __forceinline__ void xcd_barrier(const XcdBarrier& b) {
    asm volatile("s_waitcnt vmcnt(0)" ::: "memory");
    __syncthreads();
    if (threadIdx.x == 0) {
        unsigned* bar = b.bar;
        __builtin_amdgcn_s_waitcnt(0);
        unsigned nloc = b.st[0], nx = b.st[1];
        if (nloc == 0u) { xcd_barrier_complete(bar, b.x, nloc, nx); b.st[0] = nloc; b.st[1] = nx; }
        const unsigned old = xb_add(&bar[XB_XSUB(b.x)], 1u);
        const unsigned gen = old / nloc;
        if (old + 1u == (gen + 1u) * nloc) {
            __builtin_amdgcn_fence(__ATOMIC_RELEASE, "agent");
            asm volatile("s_waitcnt vmcnt(0)" ::: "memory");
            const unsigned og = xb_add(&bar[XB_TOP], 1u);
            const unsigned tg = og / nx;
            if (og + 1u == (tg + 1u) * nx) xb_add(&bar[XB_TOPGEN], 1u);
            else XB_SPIN(xb_ld(&bar[XB_TOPGEN]) == tg, bar);
            __builtin_amdgcn_fence(__ATOMIC_ACQUIRE, "agent");
            xb_add(&bar[XB_XGEN(b.x)], 1u);
            asm volatile("s_waitcnt vmcnt(0)" ::: "memory");
        } else {
            XB_SPIN(xb_ld(&bar[XB_XGEN(b.x)]) == gen, bar);
            __builtin_amdgcn_fence(__ATOMIC_ACQUIRE, "agent");
            asm volatile("s_waitcnt vmcnt(0)" ::: "memory");
        }
    }
    __syncthreads();
}

struct Params { const float* in[30]; float* out; unsigned char* ws; int ph_lo, ph_hi; };
struct Frame {
    LAS unsigned char* lds;
    const float* const* in;
    float* out; unsigned char* ws;
    int tid, lane, wave, vcu, G;
    __device__ __forceinline__ const float* mod(int l, int r, int chunk) const { return (const float*)(ws + WS_MOD) + ((size_t)(l * 9 + r) * 6144 + chunk * 1024); }
    __device__ __forceinline__ float* xr_row(int row) const { return row < TX ? out + (size_t)row * DM : (float*)(ws + WS_XC) + (size_t)(row - TX) * DM; }
    __device__ __forceinline__ const float* xin_row(int row) const { return row < TX ? in[I_X] + (size_t)row * DM : in[I_CTX] + (size_t)(row - TX) * DM; }
    __device__ __forceinline__ unsigned* cnt(int l) const { return (unsigned*)(ws + WS_CTL) + CW_CNT + l * 32 * 64; }
};
__device__ __forceinline__ int modrow(int row) { return row < TX ? (row >> 12) : 8; }

__device__ __forceinline__ void p0_mod_item(const Frame& F, int item) {
    const int l = item / 96, cg = item % 96;
    LAS float* sc = (LAS float*)F.lds;
    LAS float* red = sc + 9 * 1024;
    for (int i = F.tid; i < 9 * 1024; i += NTHREADS) { const int r = i >> 10, k = i & 1023; const float v = r < 8 ? F.in[I_C][r * 1024 + k] : F.in[I_CCTX][k]; sc[i] = v / (1.f + expf(-v)); }
    __syncthreads();
    const float* W = F.in[I_MODW] + (size_t)l * 1024 * 6144 + cg * 64 + F.lane;
    float acc[9];
#pragma unroll
    for (int r = 0; r < 9; ++r) acc[r] = 0.f;
#pragma unroll 8
    for (int kk = 0; kk < 128; ++kk) { const int k = F.wave * 128 + kk; const float w = W[(size_t)k * 6144];
#pragma unroll
        for (int r = 0; r < 9; ++r) acc[r] += sc[r * 1024 + k] * w; }
#pragma unroll
    for (int r = 0; r < 9; ++r) red[(F.wave * 9 + r) * 64 + F.lane] = acc[r];
    __syncthreads();
    for (int i = F.tid; i < 9 * 64; i += NTHREADS) { const int r = i >> 6, ln = i & 63; float s = 0.f;
#pragma unroll
        for (int w = 0; w < 8; ++w) s += red[(w * 9 + r) * 64 + ln];
        ((float*)(F.ws + WS_MOD))[(size_t)(l * 9 + r) * 6144 + cg * 64 + ln] = s + F.in[I_MODB][l * 6144 + cg * 64 + ln]; }
    __syncthreads();
}
__device__ __forceinline__ void transpose_item(const float* W, int ldw, int k0, int n0, bf16_t* WT, int ldt, int drow0, int kcol0, LAS float* scr, int lane) {
    const int kr = lane >> 3, nq = lane & 7;
    f32x4 v[8];
#pragma unroll
    for (int i = 0; i < 8; ++i) v[i] = *(const f32x4*)(W + (size_t)(k0 + 8 * i + kr) * ldw + n0 + 4 * nq);
#pragma unroll
    for (int i = 0; i < 8; ++i) { LAS float* s = scr + (8 * i + kr) * 33 + 4 * nq; s[0] = v[i][0]; s[1] = v[i][1]; s[2] = v[i][2]; s[3] = v[i][3]; }
    asm volatile("s_waitcnt lgkmcnt(0)" ::: "memory");
    const int c = lane & 7;
#pragma unroll
    for (int j = 0; j < 4; ++j) { const int n = (lane >> 3) + 8 * j; const LAS float* s = scr + (8 * c) * 33 + n;
        u32x4 o; o.x = pk2(s[0 * 33], s[1 * 33]); o.y = pk2(s[2 * 33], s[3 * 33]); o.z = pk2(s[4 * 33], s[5 * 33]); o.w = pk2(s[6 * 33], s[7 * 33]);
        *(u32x4*)(WT + (size_t)(drow0 + n) * ldt + kcol0 + k0 + 8 * c) = o; }
    asm volatile("s_waitcnt lgkmcnt(0)" ::: "memory");
}
__device__ __forceinline__ void p0_prologue(const Frame& F) {
    for (int it = F.vcu; it < 192; it += F.G) p0_mod_item(F, it);
    const int gw = F.vcu * NWAVES + F.wave, NGW = F.G * NWAVES;
    const int gt = gw * 64 + F.lane, NGT = NGW * 64;
    { float* rc = (float*)(F.ws + WS_ROPE); float* rs = rc + SEQ * 32;
      for (int i = gt; i < SEQ * 32; i += NGT) { const int s = i >> 5, d = i & 31, f = d & 15; const float pos = (float)(d < 16 ? (s >> 6) : (s & 63));
          const float inv = exp2f(-(float)f * (13.287712379549449f / 16.f)); const float a = pos * inv; rc[i] = cosf(a); rs[i] = sinf(a); } }
    { bf16_t* WT = (bf16_t*)(F.ws + WS_WOUTCD); const float* pw = F.in[I_POOLW]; const float* ps = F.in[I_POOLS]; const float* wo = F.in[I_WOUTCD];
      for (int i = gt; i < 512 * 1024; i += NGT) { const int kk = i >> 10, d = i & 1023, g = kk >> 7; float s = 0.f;
          const float* pwr = pw + (size_t)kk * 128; const float* psr = ps + g * 128; const float* wor = wo + (size_t)(512 + g * 128) * 1024 + d;
#pragma unroll 8
          for (int dp = 0; dp < 128; ++dp) s += pwr[dp] * psr[dp] * wor[(size_t)dp * 1024];
          WT[(size_t)d * 1024 + 512 + kk] = (bf16_t)(pk2(s, 0.f) & 0xffffu); } }
    { bf16_t* WR = (bf16_t*)(F.ws + WS_WR);
      for (int i = gt; i < 2 * 48 * 1024; i += NGT) { const int l = i / (48 * 1024), o = (i / 1024) % 48, k = i & 1023; float w = 0.f;
          if (o < 4) w = F.in[I_RGW][(size_t)l * 4096 + k * 4 + o]; else if (o < 36) w = F.in[I_REW][(size_t)l * 32768 + k * 32 + (o - 4)];
          const unsigned hi = pk2(w, 0.f) & 0xffffu; const unsigned lo = pk2(w - bflo(hi), 0.f) & 0xffffu;
          WR[(size_t)(l * 2 + 0) * 48 * 1024 + o * 1024 + k] = (bf16_t)hi; WR[(size_t)(l * 2 + 1) * 48 * 1024 + o * 1024 + k] = (bf16_t)lo; } }
    LAS float* scr = (LAS float*)(F.lds + F.wave * 8448);
    constexpr int N_AB = 16 * 56, N_OAB = 16 * 32, N_CD = 16 * 40, N_OCD = 8 * 32, N_G = 64 * 256, N_U = 64 * 256, N_D = 64 * 256;
    constexpr int NITEMS = N_AB + N_OAB + N_CD + N_OCD + N_G + N_U + N_D;
    for (int it = gw; it < NITEMS; it += NGW) {
        int r = it;
        if (r < N_AB) { const int kb = r / 56, nb = r % 56, n0 = nb * 32; int d0;
            if (n0 < 768) d0 = n0; else if (n0 < 1280) { const int j = n0 - 768; d0 = 768 + (j >> 7) * 256 + (j & 127); } else { const int j = n0 - 1280; d0 = 768 + (j >> 7) * 256 + 128 + (j & 127); }
            transpose_item(F.in[I_WINAB], 1792, kb * 64, n0, (bf16_t*)(F.ws + WS_WINAB), 1024, d0, 0, scr, F.lane); continue; } r -= N_AB;
        if (r < N_OAB) { const int kb = r / 32, nb = r % 32; transpose_item(F.in[I_WOUTAB], 1024, kb * 64, nb * 32, (bf16_t*)(F.ws + WS_WOUTAB), 1024, nb * 32, 0, scr, F.lane); continue; } r -= N_OAB;
        if (r < N_CD) { const int kb = r / 40, nb = r % 40; transpose_item(F.in[I_WINCD], 1280, kb * 64, nb * 32, (bf16_t*)(F.ws + WS_WINCD), 1024, nb * 32, 0, scr, F.lane); continue; } r -= N_CD;
        if (r < N_OCD) { const int kb = r / 32, nb = r % 32; transpose_item(F.in[I_WOUTCD], 1024, kb * 64, nb * 32, (bf16_t*)(F.ws + WS_WOUTCD), 1024, nb * 32, 0, scr, F.lane); continue; } r -= N_OCD;
        if (r < N_G + N_U) { const bool up = r >= N_G; if (up) r -= N_G; const int le = r >> 8, q = r & 255, kb = q >> 4, nb = q & 15, n0 = nb * 32;
            const int d0 = (n0 >> 7) * 256 + (up ? 128 : 0) + (n0 & 127);
            transpose_item(F.in[up ? I_EXU : I_EXG] + (size_t)le * 1024 * 512, 512, kb * 64, n0, (bf16_t*)(F.ws + WS_WGU) + (size_t)le * 1024 * 1024, 1024, d0, 0, scr, F.lane); continue; } r -= N_G + N_U;
        { const int le = r >> 8, q = r & 255, kb = q >> 5, nb = q & 31;
            transpose_item(F.in[I_EXD] + (size_t)le * 512 * 1024, 1024, kb * 64, nb * 32, (bf16_t*)(F.ws + WS_WD) + (size_t)le * 1024 * 512, 512, nb * 32, 0, scr, F.lane); }
    }
}

__device__ __forceinline__ void norm_mod_row(const float* xrow, const float* g, const float* sh, const float* sc, int lane, f32x4 (&h)[4]) {
    f32x4 v[4]; float ss = 0.f;
#pragma unroll
    for (int j = 0; j < 4; ++j) { v[j] = *(const f32x4*)(xrow + 4 * lane + 256 * j); ss += (v[j][0] * v[j][0] + v[j][1] * v[j][1]) + (v[j][2] * v[j][2] + v[j][3] * v[j][3]); }
    const float rms = 1.0f / sqrtf(wave_sum(ss) * (1.f / 1024.f) + EPS);
#pragma unroll
    for (int j = 0; j < 4; ++j) { const int c = 4 * lane + 256 * j; const f32x4 gg = *(const f32x4*)(g + c), s1 = *(const f32x4*)(sc + c), s0 = *(const f32x4*)(sh + c);
        h[j] = (v[j] * rms * gg) * (1.f + s1) + s0; }
}
__device__ __forceinline__ void store_row_bf16(bf16_t* orow, int lane, const f32x4 (&h)[4]) {
#pragma unroll
    for (int j = 0; j < 4; ++j) { u32x2 o; o.x = pk2(h[j][0], h[j][1]); o.y = pk2(h[j][2], h[j][3]); *(u32x2*)(orow + 4 * lane + 256 * j) = o; }
}
__device__ __forceinline__ void p_norm1_l0(const Frame& F) {
    const int gw = F.vcu * NWAVES + F.wave, NGW = F.G * NWAVES;
    bf16_t* HX = (bf16_t*)(F.ws + WS_HX);
    for (int row = gw; row < TT; row += NGW) { const int r = modrow(row); f32x4 h[4];
        norm_mod_row(F.xin_row(row), F.in[I_LN1], F.mod(0, r, 0), F.mod(0, r, 1), F.lane, h);
        store_row_bf16(HX + (size_t)row * DM, F.lane, h); }
}

struct Unit { int pm, pn, e; };
struct SchedDense {
    const bf16_t* Bt; int K, nMa, nN, nMb, pnb, vcu, G;
    __device__ __forceinline__ bool next(int i, Unit& u) const { int L = i * G + vcu; const int na = nMa * nN; u.e = 0;
        if (L < na) { u.pm = L / nN; u.pn = L % nN; return true; } L -= na; if (L < nMb) { u.pm = nMa + L; u.pn = pnb; return true; } return false; }
    __device__ __forceinline__ int arow(const Unit& u, int r) const { return u.pm * 256 + r; }
    __device__ __forceinline__ const bf16_t* bbase(const Unit& u) const { return Bt + (size_t)u.pn * 256 * K; }
};
struct MoeTab { const LAS int* tile_e; const LAS int* tile0; const LAS int* cnt; int ntiles; };
struct SchedMoe {
    const bf16_t* Wt; size_t estride; int K; MoeTab tb; const unsigned* list; bool gather; int vcu, G;
    __device__ __forceinline__ bool next(int i, Unit& u) const { const int L = i * G + vcu; if (L >= tb.ntiles * 4) return false; u.pm = L >> 2; u.pn = L & 3; u.e = tb.tile_e[u.pm]; return true; }
    __device__ __forceinline__ int arow(const Unit& u, int r) const {
        if (!gather) return u.pm * 256 + r;
        int idx = (u.pm - tb.tile0[u.e]) * 256 + r; const int c = tb.cnt[u.e]; idx = idx < c ? idx : c - 1;
        return (int)list[(size_t)u.e * TT + idx]; }
    __device__ __forceinline__ const bf16_t* bbase(const Unit& u) const { return Wt + (size_t)u.e * estride + (size_t)u.pn * 256 * K; }
};
__device__ __forceinline__ MoeTab moe_tables(const Frame& F, int l) {
    LAS int* tile_e = (LAS int*)(F.lds + LDS_TAB); LAS int* tile0 = tile_e + NTILE_MAX; LAS int* cntl = tile0 + 33; LAS int* nt = cntl + 32;
    __syncthreads();
    if (F.tid == 0) { int t = 0; unsigned* cg = F.cnt(l);
        for (int e = 0; e < NE; ++e) { const int c = (int)__hip_atomic_load(cg + e * 64, __ATOMIC_RELAXED, __HIP_MEMORY_SCOPE_AGENT); const int n = (c + 255) >> 8; tile0[e] = t; cntl[e] = c;
            for (int j = 0; j < n; ++j) tile_e[t + j] = e; t += n; }
        tile0[32] = t; nt[0] = t; }
    __syncthreads();
    MoeTab tb; tb.tile_e = tile_e; tb.tile0 = tile0; tb.cnt = cntl; tb.ntiles = nt[0]; return tb;
}

template <class Sched, class Epi>
__device__ __forceinline__ void gemm_simple(const Frame& F, const bf16_t* A, int K, const Sched& S, const Epi& E) {
    const int wr = F.wave >> 2, wc = F.wave & 3, fr = F.lane & 15, fq = F.lane >> 4;
    Unit u;
    for (int i = 0; S.next(i, u); ++i) {
        f32x4 acc[2][2][4][2];
#pragma unroll
        for (int a = 0; a < 2; ++a)
#pragma unroll
            for (int b = 0; b < 2; ++b)
#pragma unroll
                for (int m = 0; m < 4; ++m)
#pragma unroll
                    for (int n = 0; n < 2; ++n) acc[a][b][m][n] = (f32x4){0.f, 0.f, 0.f, 0.f};
        unsigned aoff[2][4], boff[2][2];
#pragma unroll
        for (int a = 0; a < 2; ++a)
#pragma unroll
            for (int m = 0; m < 4; ++m) aoff[a][m] = (unsigned)S.arow(u, 128 * a + 64 * wr + 16 * m + fr) * (unsigned)K + 8u * fq;
        const bf16_t* bb = S.bbase(u);
#pragma unroll
        for (int b = 0; b < 2; ++b)
#pragma unroll
            for (int n = 0; n < 2; ++n) boff[b][n] = (unsigned)(128 * b + 32 * wc + 8 * (fr >> 2) + 4 * n + (fr & 3)) * (unsigned)K + 8u * fq;
#pragma unroll 1
        for (int k0 = 0; k0 < K; k0 += 32) {
            bf16x8 bf[2][2];
#pragma unroll
            for (int b = 0; b < 2; ++b)
#pragma unroll
                for (int n = 0; n < 2; ++n) bf[b][n] = *(const bf16x8*)(bb + boff[b][n] + k0);
#pragma unroll
            for (int a = 0; a < 2; ++a) {
                bf16x8 af[4];
#pragma unroll
                for (int m = 0; m < 4; ++m) af[m] = *(const bf16x8*)(A + aoff[a][m] + k0);
#pragma unroll
                for (int b = 0; b < 2; ++b)
#pragma unroll
                    for (int m = 0; m < 4; ++m)
#pragma unroll
                        for (int n = 0; n < 2; ++n) acc[a][b][m][n] = __builtin_amdgcn_mfma_f32_16x16x32_bf16(bf[b][n], af[m], acc[a][b][m][n], 0, 0, 0);
            }
        }
        E(acc, u, wr, wc, fr, fq);
    }
}

namespace pg8 {
constexpr int BM = 256, BK = 64, HALF = 128, HTB = HALF * BK * 2;
__device__ __forceinline__ int lds_byte(int r, int c) { const int st = (r >> 4) * 2 + (c >> 5), rr = r & 15, cc = c & 31, ob = rr * 64 + cc * 2; return st * 1024 + (ob ^ (((ob >> 9) & 1) << 5)); }
__device__ __forceinline__ void stage_rc(int b, int& R, int& C) { const int st = b / 1024, sb = b % 1024, swz = sb ^ (((sb >> 9) & 1) << 5); R = (st >> 1) * 16 + swz / 64; C = (st & 1) * 32 + (swz % 64) / 2; }
__device__ __forceinline__ int perm32(int rho) { const int n = rho >> 4, i = rho & 15; return 8 * (i >> 2) + 4 * n + (i & 3); }
}
template <class Sched, class Epi>
__device__ __forceinline__ void gemm_fast(const Frame& F, const bf16_t* A, int K, const Sched& S, const Epi& E) {
    using namespace pg8;
    LAS unsigned char* lds = F.lds;
    const int tid = F.tid, wid = F.wave, lane = F.lane, wr = wid >> 2, wc = wid & 3, fr = lane & 15, fq = lane >> 4;
    const int nt = K / BK;
    int RA[2], CA[2]; unsigned voffB[2];
#pragma unroll
    for (int i = 0; i < 2; ++i) { int R, C; stage_rc(tid * 16 + i * 8192, R, C); RA[i] = R; CA[i] = C; const int Rb = (R & ~31) + perm32(R & 31); voffB[i] = (unsigned)(Rb * K + C) * 2u; }
    const size_t kstep = (size_t)(BK * 2);
    const size_t hstep = (size_t)HALF * K * 2;
    const unsigned ldsw = (unsigned)wid * 1024u;
    const int aoff = lds_byte(wr * 64 + fr, fq * 8), boff = lds_byte(wc * 32 + fr, fq * 8);
    const char* Ab = (const char*)A;
#define PG8_SA(b, h) (((b) * 2 + (h)) * HTB)
#define PG8_SB(b, h) ((4 + (b) * 2 + (h)) * HTB)
#define PG8_STAGE(bufoff, gbase, voff) do { _Pragma("unroll") for (int _i = 0; _i < 2; ++_i) \
        __builtin_amdgcn_global_load_lds((const unsigned*)((const char*)(gbase) + (voff)[_i]), (LAS unsigned*)(lds + (bufoff) + ldsw + _i * 8192), 16, 0, 0); } while (0)
#define PG8_LDA(dst, b, h) do { _Pragma("unroll") for (int m = 0; m < 4; ++m) _Pragma("unroll") for (int k = 0; k < 2; ++k) dst[m][k] = *(const LAS bf16x8*)(lds + PG8_SA(b, h) + aoff + m * 2048 + k * 1024); } while (0)
#define PG8_LDB(dst, b, h) do { _Pragma("unroll") for (int n = 0; n < 2; ++n) _Pragma("unroll") for (int k = 0; k < 2; ++k) dst[n][k] = *(const LAS bf16x8*)(lds + PG8_SB(b, h) + boff + n * 2048 + k * 1024); } while (0)
#define PG8_MMA(ai, bj, At, Bt) do { __builtin_amdgcn_s_setprio(1); _Pragma("unroll") for (int m = 0; m < 4; ++m) _Pragma("unroll") for (int n = 0; n < 2; ++n) _Pragma("unroll") for (int k = 0; k < 2; ++k) \
        acc[ai][bj][m][n] = __builtin_amdgcn_mfma_f32_16x16x32_bf16(Bt[n][k], At[m][k], acc[ai][bj][m][n], 0, 0, 0); __builtin_amdgcn_s_setprio(0); } while (0)
#define PG8_WAIT_V(n) asm volatile("s_waitcnt vmcnt(" #n ")" ::: "memory")
#define PG8_WAIT_L(n) asm volatile("s_waitcnt lgkmcnt(" #n ")" ::: "memory")
#define PG8_BAR __builtin_amdgcn_s_barrier()
#define PG8_SCHED __builtin_amdgcn_sched_barrier(0)
#define PG8_VOFF(dst, u) do { _Pragma("unroll") for (int _h = 0; _h < 2; ++_h) _Pragma("unroll") for (int _i = 0; _i < 2; ++_i) \
        dst[_h][_i] = (unsigned)S.arow(u, 128 * _h + RA[_i]) * (unsigned)(K * 2) + (unsigned)(CA[_i] * 2); } while (0)
    Unit cur, nxt; int ui = 0;
    if (!S.next(0, cur)) return;
    f32x4 acc[2][2][4][2];
#pragma unroll
    for (int a = 0; a < 2; ++a)
#pragma unroll
        for (int b = 0; b < 2; ++b)
#pragma unroll
            for (int m = 0; m < 4; ++m)
#pragma unroll
                for (int n = 0; n < 2; ++n) acc[a][b][m][n] = (f32x4){0.f, 0.f, 0.f, 0.f};
    bf16x8 At[4][2], B0[2][2], B1[2][2];
    unsigned vC[2][2], vN[2][2];
    PG8_VOFF(vC, cur);
    const char* cB = (const char*)S.bbase(cur);
    PG8_STAGE(PG8_SB(0, 0), cB, voffB); PG8_STAGE(PG8_SB(0, 1), cB + hstep, voffB); PG8_STAGE(PG8_SA(0, 0), Ab, vC[0]); PG8_STAGE(PG8_SA(0, 1), Ab, vC[1]);
    if (wr == 1) PG8_BAR;
    PG8_WAIT_V(2); PG8_BAR;
    PG8_STAGE(PG8_SB(1, 0), cB + kstep, voffB); PG8_STAGE(PG8_SA(1, 0), Ab + kstep, vC[0]); PG8_STAGE(PG8_SB(1, 1), cB + hstep + kstep, voffB);
    PG8_WAIT_V(6); PG8_BAR;
    for (;;) {
        const bool has_next = S.next(ui + 1, nxt);
        const char* nB = cB;
        if (has_next) { PG8_VOFF(vN, nxt); nB = (const char*)S.bbase(nxt); }
        else {
#pragma unroll
            for (int h = 0; h < 2; ++h)
#pragma unroll
                for (int i = 0; i < 2; ++i) vN[h][i] = vC[h][i]; }
        for (int t = 0; t < nt; t += 2) {
            const bool last = (t == nt - 2);
            const char* a1 = Ab + (size_t)(t + 1) * kstep;
            const char* a2 = last ? Ab : Ab + (size_t)(t + 2) * kstep; const char* b2 = last ? nB : cB + (size_t)(t + 2) * kstep;
            const char* a3 = a2 + kstep; const char* b3 = b2 + kstep;
            unsigned v2[2][2];
#pragma unroll
            for (int h = 0; h < 2; ++h)
#pragma unroll
                for (int i = 0; i < 2; ++i) v2[h][i] = last ? vN[h][i] : vC[h][i];
            PG8_LDB(B0, 0, 0); PG8_LDB(B1, 0, 1); PG8_SCHED; PG8_LDA(At, 0, 0); PG8_STAGE(PG8_SA(1, 1), a1, vC[1]);
            PG8_WAIT_V(8); PG8_WAIT_L(0); PG8_BAR; PG8_MMA(0, 0, At, B0); PG8_MMA(0, 1, At, B1); PG8_BAR; PG8_SCHED;
            PG8_LDA(At, 0, 1); PG8_STAGE(PG8_SB(0, 0), b2, voffB); PG8_STAGE(PG8_SB(0, 1), b2 + hstep, voffB); PG8_STAGE(PG8_SA(0, 0), a2, v2[0]);
            PG8_WAIT_V(8); PG8_WAIT_L(0); PG8_BAR; PG8_MMA(1, 0, At, B0); PG8_MMA(1, 1, At, B1); PG8_BAR; PG8_SCHED;
            PG8_LDB(B0, 1, 0); PG8_LDB(B1, 1, 1); PG8_SCHED; PG8_LDA(At, 1, 0); PG8_STAGE(PG8_SA(0, 1), a2, v2[1]);
            PG8_WAIT_V(8); PG8_WAIT_L(0); PG8_BAR; PG8_MMA(0, 0, At, B0); PG8_MMA(0, 1, At, B1); PG8_BAR; PG8_SCHED;
            PG8_LDA(At, 1, 1); PG8_STAGE(PG8_SB(1, 0), b3, voffB); PG8_STAGE(PG8_SB(1, 1), b3 + hstep, voffB); PG8_STAGE(PG8_SA(1, 0), a3, v2[0]);
            PG8_WAIT_V(8); PG8_WAIT_L(0); PG8_BAR; PG8_MMA(1, 0, At, B0); PG8_MMA(1, 1, At, B1); PG8_BAR; PG8_SCHED;
        }
        if (wr == 0) PG8_BAR;
        E(acc, cur, wr, wc, fr, fq);
        if (!has_next) break;
#pragma unroll
        for (int a = 0; a < 2; ++a)
#pragma unroll
            for (int b = 0; b < 2; ++b)
#pragma unroll
                for (int m = 0; m < 4; ++m)
#pragma unroll
                    for (int n = 0; n < 2; ++n) acc[a][b][m][n] = (f32x4){0.f, 0.f, 0.f, 0.f};
        cur = nxt; cB = nB; ++ui;
#pragma unroll
        for (int h = 0; h < 2; ++h)
#pragma unroll
            for (int i = 0; i < 2; ++i) vC[h][i] = vN[h][i];
        if (wr == 1) PG8_BAR;
    }
    PG8_WAIT_V(0);
    PG8_BAR;
#undef PG8_SA
#undef PG8_SB
#undef PG8_STAGE
#undef PG8_LDA
#undef PG8_LDB
#undef PG8_MMA
#undef PG8_WAIT_V
#undef PG8_WAIT_L
#undef PG8_BAR
#undef PG8_SCHED
#undef PG8_VOFF
}
#ifndef GEMM_SIMPLE
#define GEMM gemm_fast
#else
#define GEMM gemm_simple
#endif

__device__ __forceinline__ u32x4 pack8(const f32x4& a, const f32x4& b) { u32x4 w; w.x = pk2(a[0], a[1]); w.y = pk2(a[2], a[3]); w.z = pk2(b[0], b[1]); w.w = pk2(b[2], b[3]); return w; }
template <bool GLU> struct EpiInProj {
    bf16_t* Q; bf16_t* KV; bf16_t* Gb;
    __device__ __forceinline__ void operator()(const f32x4 (&acc)[2][2][4][2], const Unit& u, int wr, int wc, int fr, int fq) const {
#pragma unroll
        for (int ai = 0; ai < 2; ++ai)
#pragma unroll
            for (int m = 0; m < 4; ++m) { const size_t row = (size_t)u.pm * 256 + 128 * ai + 64 * wr + 16 * m + fr; const int cl = 32 * wc + 8 * fq;
                if (u.pn < 2) { *(u32x4*)(Q + row * 512 + u.pn * 256 + cl) = pack8(acc[ai][0][m][0], acc[ai][0][m][1]); *(u32x4*)(Q + row * 512 + u.pn * 256 + 128 + cl) = pack8(acc[ai][1][m][0], acc[ai][1][m][1]); }
                else if (u.pn == 2) { *(u32x4*)(KV + row * 256 + cl) = pack8(acc[ai][0][m][0], acc[ai][0][m][1]); *(u32x4*)(KV + row * 256 + 128 + cl) = pack8(acc[ai][1][m][0], acc[ai][1][m][1]); }
                else if (GLU) { f32x4 g0, g1;
#pragma unroll
                    for (int j = 0; j < 4; ++j) { g0[j] = acc[ai][0][m][0][j] * sigmoidf_(acc[ai][1][m][0][j]); g1[j] = acc[ai][0][m][1][j] * sigmoidf_(acc[ai][1][m][1][j]); }
                    *(u32x4*)(Gb + row * 512 + (u.pn - 3) * 128 + cl) = pack8(g0, g1); }
                else { *(u32x4*)(Gb + row * 512 + (u.pn - 3) * 256 + cl) = pack8(acc[ai][0][m][0], acc[ai][0][m][1]); *(u32x4*)(Gb + row * 512 + (u.pn - 3) * 256 + 128 + cl) = pack8(acc[ai][1][m][0], acc[ai][1][m][1]); }
            }
    }
};
template <bool L0> struct EpiOutProj {
    Frame F; int l;
    __device__ __forceinline__ void operator()(const f32x4 (&acc)[2][2][4][2], const Unit& u, int wr, int wc, int fr, int fq) const {
        float* SS = (float*)(F.ws + WS_SS);
#pragma unroll
        for (int ai = 0; ai < 2; ++ai)
#pragma unroll
            for (int m = 0; m < 4; ++m) { const int row = u.pm * 256 + 128 * ai + 64 * wr + 16 * m + fr; const float* g1 = F.mod(l, modrow(row), 2);
                const float* src = L0 ? F.xin_row(row) : F.xr_row(row); float* dst = F.xr_row(row); float q = 0.f;
#pragma unroll
                for (int bj = 0; bj < 2; ++bj)
#pragma unroll
                    for (int n = 0; n < 2; ++n) { const int c = u.pn * 256 + 128 * bj + 32 * wc + 8 * fq + 4 * n;
                        const f32x4 xv = *(const f32x4*)(src + c), gv = *(const f32x4*)(g1 + c); const f32x4 v = xv + gv * acc[ai][bj][m][n]; *(f32x4*)(dst + c) = v;
                        q += (v[0] * v[0] + v[1] * v[1]) + (v[2] * v[2] + v[3] * v[3]); }
                q += __shfl_xor(q, 16); q += __shfl_xor(q, 32);
                if (fq == 0) SS[(size_t)row * 16 + u.pn * 4 + wc] = q; }
    }
};
struct EpiMoe1 {
    bf16_t* HID;
    __device__ __forceinline__ void operator()(const f32x4 (&acc)[2][2][4][2], const Unit& u, int wr, int wc, int fr, int fq) const {
#pragma unroll
        for (int ai = 0; ai < 2; ++ai)
#pragma unroll
            for (int m = 0; m < 4; ++m) { const size_t slot = (size_t)u.pm * 256 + 128 * ai + 64 * wr + 16 * m + fr; f32x4 h0, h1;
#pragma unroll
                for (int j = 0; j < 4; ++j) { const float a = acc[ai][0][m][0][j], b = acc[ai][0][m][1][j]; h0[j] = a * sigmoidf_(a) * acc[ai][1][m][0][j]; h1[j] = b * sigmoidf_(b) * acc[ai][1][m][1][j]; }
                *(u32x4*)(HID + slot * 512 + u.pn * 128 + 32 * wc + 8 * fq) = pack8(h0, h1); }
    }
};
struct EpiMoe2 {
    bf16_t* YB;
    __device__ __forceinline__ void operator()(const f32x4 (&acc)[2][2][4][2], const Unit& u, int wr, int wc, int fr, int fq) const {
#pragma unroll
        for (int ai = 0; ai < 2; ++ai)
#pragma unroll
            for (int m = 0; m < 4; ++m) { const size_t slot = (size_t)u.pm * 256 + 128 * ai + 64 * wr + 16 * m + fr;
#pragma unroll
                for (int bj = 0; bj < 2; ++bj) *(u32x4*)(YB + slot * 1024 + u.pn * 256 + 128 * bj + 32 * wc + 8 * fq) = pack8(acc[ai][bj][m][0], acc[ai][bj][m][1]); }
    }
};

__device__ __forceinline__ void p_qkv_post(const Frame& F, const float* qg, const float* kg, bool ctx_q) {
    const int gw = F.vcu * NWAVES + F.wave, NGW = F.G * NWAVES, lane = F.lane;
    bf16_t* Q = (bf16_t*)(F.ws + WS_Q); const bf16_t* KV = (const bf16_t*)(F.ws + WS_KV); bf16_t* Kn = (bf16_t*)(F.ws + WS_KN); bf16_t* Vn = (bf16_t*)(F.ws + WS_VN);
    const float* rc = (const float*)(F.ws + WS_ROPE); const float* rs = rc + SEQ * 32;
    const int i8 = lane & 7, dd0 = 8 * (i8 & 3);
    float gq[8], gk[8];
#pragma unroll
    for (int j = 0; j < 8; ++j) { gq[j] = qg[i8 * 8 + j]; gk[j] = kg[i8 * 8 + j]; }
    for (int row = gw; row < TT; row += NGW) {
        const bool isctx = row >= TX; const int b = isctx ? (row - TX) >> 8 : row >> 12, s = isctx ? (row - TX) & 255 : row & 4095;
        float cs[8], sn[8];
#pragma unroll
        for (int j = 0; j < 8; ++j) { cs[j] = 1.f; sn[j] = 0.f; }
        if (!isctx) {
#pragma unroll
            for (int j = 0; j < 8; ++j) { cs[j] = rc[s * 32 + dd0 + j]; sn[j] = rs[s * 32 + dd0 + j]; } }
        const float sgn = (i8 < 4) ? -1.f : 1.f;
        if (!isctx || ctx_q) {
            const u32x4 w = *(const u32x4*)(Q + (size_t)row * 512 + lane * 8);
            float x[8] = {bflo(w.x), bfhi(w.x), bflo(w.y), bfhi(w.y), bflo(w.z), bfhi(w.z), bflo(w.w), bfhi(w.w)};
            float ss = 0.f;
#pragma unroll
            for (int j = 0; j < 8; ++j) ss += x[j] * x[j];
            ss += __shfl_xor(ss, 1); ss += __shfl_xor(ss, 2); ss += __shfl_xor(ss, 4);
            const float rms = 1.0f / sqrtf(ss * (1.f / 64.f) + EPS);
            float y[8], o[8];
#pragma unroll
            for (int j = 0; j < 8; ++j) y[j] = x[j] * rms * gq[j];
#pragma unroll
            for (int j = 0; j < 8; ++j) { const float yp = __shfl_xor(y[j], 4); o[j] = (y[j] * cs[j] + sgn * yp * sn[j]) * C2; }
            u32x4 ow; ow.x = pk2(o[0], o[1]); ow.y = pk2(o[2], o[3]); ow.z = pk2(o[4], o[5]); ow.w = pk2(o[6], o[7]);
            *(u32x4*)(Q + (size_t)row * 512 + lane * 8) = ow;
        }
        {
            const int l32 = lane & 31;
            const u32x4 w = *(const u32x4*)(KV + (size_t)row * 256 + l32 * 8);
            float x[8] = {bflo(w.x), bfhi(w.x), bflo(w.y), bfhi(w.y), bflo(w.z), bfhi(w.z), bflo(w.w), bfhi(w.w)};
            float ss = 0.f;
#pragma unroll
            for (int j = 0; j < 8; ++j) ss += x[j] * x[j];
            ss += __shfl_xor(ss, 1); ss += __shfl_xor(ss, 2); ss += __shfl_xor(ss, 4);
            const float rms = 1.0f / sqrtf(ss * (1.f / 64.f) + EPS);
            float y[8], o[8];
#pragma unroll
            for (int j = 0; j < 8; ++j) y[j] = x[j] * rms * gk[j];
#pragma unroll
            for (int j = 0; j < 8; ++j) { const float yp = __shfl_xor(y[j], 4); o[j] = y[j] * cs[j] + sgn * yp * sn[j]; }
            const size_t kvrow = (size_t)b * KVS + (isctx ? s : CTXL + s);
            if (lane < 16) { u32x4 ow; ow.x = pk2(o[0], o[1]); ow.y = pk2(o[2], o[3]); ow.z = pk2(o[4], o[5]); ow.w = pk2(o[6], o[7]); *(u32x4*)(Kn + kvrow * 128 + lane * 8) = ow; }
            else if (lane < 32) { *(u32x4*)(Vn + kvrow * 128 + (lane - 16) * 8) = w; }
        }
    }
}
__device__ __forceinline__ void p_conv(const Frame& F) {
    const bf16_t* Gb = (const bf16_t*)(F.ws + WS_G); bf16_t* AO = (bf16_t*)(F.ws + WS_AO);
    LAS bf16_t* gl = (LAS bf16_t*)F.lds;
    LAS float* yl = (LAS float*)(F.lds + 65536);
    const int c = F.tid;
    float w[31];
#pragma unroll
    for (int j = 0; j < 31; ++j) w[j] = F.in[I_CONVW][j * 512 + c];
    const float bias = F.in[I_CONVB][c];
    for (int item = F.vcu; item < 1024 + 64; item += F.G) {
        int rowbase, t0, len;
        if (item < 1024) { rowbase = (item >> 7) * SEQ; t0 = (item & 127) * 32; len = SEQ; } else { const int it = item - 1024; rowbase = TX + (it >> 3) * CTXL; t0 = (it & 7) * 32; len = CTXL; }
        __syncthreads();
        for (int ch = F.tid; ch < 62 * 64; ch += NTHREADS) { const int r = ch >> 6, p = t0 - 15 + r; u32x4 v = (u32x4){0u, 0u, 0u, 0u};
            if (p >= 0 && p < len) v = *(const u32x4*)(Gb + (size_t)(rowbase + p) * 512 + (ch & 63) * 8);
            *(LAS u32x4*)(gl + r * 512 + (ch & 63) * 8) = v; }
        __syncthreads();
        float g[62];
#pragma unroll
        for (int r = 0; r < 62; ++r) g[r] = bf2f(gl[r * 512 + c]);
#pragma unroll
        for (int t = 0; t < 32; ++t) { float y = bias;
#pragma unroll
            for (int j = 0; j < 31; ++j) y += g[t + j] * w[j];
            yl[t * 512 + c] = y; }
        __syncthreads();
#pragma unroll
        for (int tt = 0; tt < 4; ++tt) { const int t = 4 * F.wave + tt; float v[8]; float s = 0.f;
#pragma unroll
            for (int j = 0; j < 8; ++j) { v[j] = yl[t * 512 + F.lane + 64 * j]; s += v[j]; }
            const float mean = wave_sum(s) * (1.f / 512.f); float q = 0.f;
#pragma unroll
            for (int j = 0; j < 8; ++j) { v[j] -= mean; q += v[j] * v[j]; }
            const float rstd = 1.0f / sqrtf(wave_sum(q) * (1.f / 512.f) + EPS);
            bf16_t* orow = AO + (size_t)(rowbase + t0 + t) * 1024 + 512;
#pragma unroll
            for (int j = 0; j < 8; ++j) { const int cc = F.lane + 64 * j; const float yn = v[j] * rstd * F.in[I_CLNG][cc] + F.in[I_CLNB][cc]; orow[cc] = (bf16_t)(pk2(yn * sigmoidf_(yn), 0.f) & 0xffffu); } }
    }
    __syncthreads();
}
__device__ __forceinline__ void p_pool(const Frame& F) {
    const int gw = F.vcu * NWAVES + F.wave, NGW = F.G * NWAVES, lane = F.lane;
    const bf16_t* U = (const bf16_t*)(F.ws + WS_G); bf16_t* AO = (bf16_t*)(F.ws + WS_AO);
    const int wdt = 2 << (lane >> 4);
    for (int row = gw; row < TX; row += NGW) {
        const int t = row & 4095, rb = row - t;
        int lo = t - (wdt >> 1), hi = lo + wdt; lo = lo < 0 ? 0 : lo; hi = hi > SEQ ? SEQ : hi;
        float s[8];
#pragma unroll
        for (int j = 0; j < 8; ++j) s[j] = 0.f;
        for (int i = 0; i < 16; ++i) { const int p = lo + i; if (p < hi) { const u32x4 w = *(const u32x4*)(U + (size_t)(rb + p) * 512 + lane * 8);
            s[0] += bflo(w.x); s[1] += bfhi(w.x); s[2] += bflo(w.y); s[3] += bfhi(w.y); s[4] += bflo(w.z); s[5] += bfhi(w.z); s[6] += bflo(w.w); s[7] += bfhi(w.w); } }
        const u32x4 w = *(const u32x4*)(U + (size_t)row * 512 + lane * 8); const float inv = 1.f / (float)(hi - lo);
        float o[8] = {s[0] * inv - bflo(w.x), s[1] * inv - bfhi(w.x), s[2] * inv - bflo(w.y), s[3] * inv - bfhi(w.y), s[4] * inv - bflo(w.z), s[5] * inv - bfhi(w.z), s[6] * inv - bflo(w.w), s[7] * inv - bfhi(w.w)};
        u32x4 ow; ow.x = pk2(o[0], o[1]); ow.y = pk2(o[2], o[3]); ow.z = pk2(o[4], o[5]); ow.w = pk2(o[6], o[7]);
        *(u32x4*)(AO + (size_t)row * 1024 + 512 + lane * 8) = ow;
    }
}

template <int LAYER> __device__ __forceinline__ void attn_simple(const Frame& F) {
    const bf16_t* Q = (const bf16_t*)(F.ws + WS_Q); const bf16_t* Kn = (const bf16_t*)(F.ws + WS_KN); const bf16_t* Vn = (const bf16_t*)(F.ws + WS_VN); bf16_t* AO = (bf16_t*)(F.ws + WS_AO);
    const int nunits = LAYER == 0 ? 512 + 64 : 512;
    for (int u = F.vcu; u < nunits; u += F.G) {
        int b, h, row, s; bool valid = true, isctx = false;
        if (u < 512) { b = u >> 6; h = (u >> 3) & 7; s = (u & 7) * 512 + F.tid; row = b * SEQ + s; }
        else { const int uc = u - 512; b = uc >> 3; h = uc & 7; s = F.tid; valid = F.tid < 256; row = TX + b * CTXL + (valid ? s : 0); isctx = true; }
        float q[64], o[64];
        { const u32x4* qp = (const u32x4*)(Q + (size_t)row * 512 + h * 64);
#pragma unroll
          for (int c = 0; c < 8; ++c) { const u32x4 w = qp[c]; q[8 * c] = bflo(w.x); q[8 * c + 1] = bfhi(w.x); q[8 * c + 2] = bflo(w.y); q[8 * c + 3] = bfhi(w.y); q[8 * c + 4] = bflo(w.z); q[8 * c + 5] = bfhi(w.z); q[8 * c + 6] = bflo(w.w); q[8 * c + 7] = bfhi(w.w); } }
#pragma unroll
        for (int d = 0; d < 64; ++d) o[d] = 0.f;
        float mx = -1e30f, l = 0.f;
        const bf16_t* Kb = Kn + (size_t)b * KVS * 128 + (h >> 2) * 64; const bf16_t* Vb = Vn + (size_t)b * KVS * 128 + (h >> 2) * 64;
        int k_lo2 = 0, k_hi2 = 0;
        const int k_hi1 = CTXL;
        if (LAYER == 0) { if (!isctx) { k_lo2 = CTXL; k_hi2 = KVS; } }
        else { const int s0 = (u & 7) * 512; int lo = s0 - 128, hi = s0 + 511 + 128 + 1; lo = lo < 0 ? 0 : lo; hi = hi > SEQ ? SEQ : hi; k_lo2 = CTXL + lo; k_hi2 = CTXL + hi; }
        for (int part = 0; part < 2; ++part) {
            const int kb = part == 0 ? 0 : k_lo2, ke = part == 0 ? k_hi1 : k_hi2;
            for (int key = kb; key < ke; ++key) {
                const u32x4* kp = (const u32x4*)(Kb + (size_t)key * 128); float sd = 0.f;
#pragma unroll
                for (int c = 0; c < 8; ++c) { const u32x4 w = kp[c];
                    sd += q[8 * c] * bflo(w.x) + q[8 * c + 1] * bfhi(w.x) + q[8 * c + 2] * bflo(w.y) + q[8 * c + 3] * bfhi(w.y) + q[8 * c + 4] * bflo(w.z) + q[8 * c + 5] * bfhi(w.z) + q[8 * c + 6] * bflo(w.w) + q[8 * c + 7] * bfhi(w.w); }
                bool use = valid;
                if (LAYER == 1 && part == 1) { const int j = key - CTXL; const int dlt = s - j; use = use && (dlt <= 128 && dlt >= -128); }
                const float mn = fmaxf(mx, sd); const float mnew = use ? mn : mx;
                const float alpha = exp2f(mx - mnew), p = use ? exp2f(sd - mnew) : 0.f;
                mx = mnew; l = l * alpha + p;
                const u32x4* vp = (const u32x4*)(Vb + (size_t)key * 128);
#pragma unroll
                for (int c = 0; c < 8; ++c) { const u32x4 w = vp[c];
                    o[8 * c] = o[8 * c] * alpha + p * bflo(w.x); o[8 * c + 1] = o[8 * c + 1] * alpha + p * bfhi(w.x); o[8 * c + 2] = o[8 * c + 2] * alpha + p * bflo(w.y); o[8 * c + 3] = o[8 * c + 3] * alpha + p * bfhi(w.y);
                    o[8 * c + 4] = o[8 * c + 4] * alpha + p * bflo(w.z); o[8 * c + 5] = o[8 * c + 5] * alpha + p * bfhi(w.z); o[8 * c + 6] = o[8 * c + 6] * alpha + p * bflo(w.w); o[8 * c + 7] = o[8 * c + 7] * alpha + p * bfhi(w.w); }
            }
        }
        if (LAYER == 1) l += exp2f(F.in[I_SINK][h] * LOG2E - mx);
        const float il = 1.f / l;
        if (valid) { u32x4* op = (u32x4*)(AO + (size_t)row * 1024 + h * 64);
#pragma unroll
            for (int c = 0; c < 8; ++c) { u32x4 w; w.x = pk2(o[8 * c] * il, o[8 * c + 1] * il); w.y = pk2(o[8 * c + 2] * il, o[8 * c + 3] * il); w.z = pk2(o[8 * c + 4] * il, o[8 * c + 5] * il); w.w = pk2(o[8 * c + 6] * il, o[8 * c + 7] * il); op[c] = w; } }
    }
}

#include <hip/hip_bf16.h>
namespace attn_body {
using bf16=__hip_bfloat16;
using s16x4=__attribute__((ext_vector_type(4)))short;
using f32x16=__attribute__((ext_vector_type(16)))float;
constexpr int NW=8,QBLK=32,QB=QBLK*NW,KVBLK=64;
constexpr int QP=512,KP=128,OP=1024;
__device__ __forceinline__ int crow(int r,int hi){return (r&3)+8*(r>>2)+4*hi;}
#define SBAR() __builtin_amdgcn_sched_barrier(0)
__device__ __forceinline__ void wmask(f32x16&p0,f32x16&p1,int dlt0,int hi){
  const float NEG=-INFINITY; const int kb=dlt0+4*hi;
  #pragma unroll
  for(int r=0;r<16;++r){const int d=kb+(r&3)+8*(r>>2); if(d>128||d<-128)p0[r]=NEG; if(d+32>128||d+32<-128)p1[r]=NEG;}
}

constexpr int NSLOT=3, SLOTB=8192;
constexpr int LDS_K=0, LDS_V=NSLOT*SLOTB, LDS_WS=2*NSLOT*SLOTB, LDS_OST=LDS_WS+NW*64*4, LDS_BYTES=LDS_OST+NW*4096;
__device__ __forceinline__ void glds16(const void*gsrc,unsigned lds_dst){unsigned keep;
  asm volatile("s_mov_b32 %0, m0\n\ts_mov_b32 m0, %2\n\ts_nop 0\n\tglobal_load_lds_dwordx4 %1, off\n\ts_mov_b32 m0, %0":"=&s"(keep):"v"(gsrc),"s"(lds_dst):"memory");}
__device__ __forceinline__ float max3f(float a,float b,float c){float r;asm("v_max3_f32 %0, %1, %2, %3":"=v"(r):"v"(a),"v"(b),"v"(c));return r;}
__device__ __forceinline__ float max2f(float a,float b){float r;asm("v_max_f32_e32 %0, %1, %2":"=v"(r):"v"(a),"v"(b));return r;}
__device__ __forceinline__ float fadd_s(float a,float b){float r;asm("v_add_f32_e32 %0, %1, %2":"=v"(r):"v"(a),"v"(b));return r;}
__device__ __forceinline__ float fsub_s(float a,float b){float r;asm("v_sub_f32_e32 %0, %1, %2":"=v"(r):"v"(a),"v"(b));return r;}
typedef float f32x2_t __attribute__((ext_vector_type(2))); typedef __bf16 bf16x2_t __attribute__((ext_vector_type(2)));
__device__ __forceinline__ unsigned cvtpk_s(float lo,float hi){f32x2_t v={lo,hi};bf16x2_t b=__builtin_convertvector(v,bf16x2_t);return __builtin_bit_cast(unsigned,b);}
#define WAIT_BAR(N) asm volatile("s_waitcnt vmcnt(" #N ") lgkmcnt(0)\n\ts_barrier":::"memory")

__device__ __forceinline__ void qkt(f32x16&p0,f32x16&p1,const char*Kslot,const bf16x8*qr,const f32x16&negm,int r32,int hi){
  const char*kb=Kslot+hi*1024+r32*16;
  #pragma unroll
  for(int d0=0;d0<4;++d0){
    const bf16x8 b0=*reinterpret_cast<const bf16x8*>(kb+d0*2048);
    const bf16x8 b1=*reinterpret_cast<const bf16x8*>(kb+d0*2048+512);
    if(d0==0){p0=__builtin_amdgcn_mfma_f32_32x32x16_bf16(b0,qr[0],negm,0,0,0);p1=__builtin_amdgcn_mfma_f32_32x32x16_bf16(b1,qr[0],negm,0,0,0);}
    else{p0=__builtin_amdgcn_mfma_f32_32x32x16_bf16(b0,qr[d0],p0,0,0,0);p1=__builtin_amdgcn_mfma_f32_32x32x16_bf16(b1,qr[d0],p1,0,0,0);}}
}
typedef __attribute__((address_space(3))) const char* lds_cptr;
typedef short v4i16_t __attribute__((ext_vector_type(4)));
__device__ __forceinline__ void kload8(bf16x8*kf,lds_cptr kp){
  kf[0]=*(const __attribute__((address_space(3))) bf16x8*)(kp);      kf[1]=*(const __attribute__((address_space(3))) bf16x8*)(kp+512);
  kf[2]=*(const __attribute__((address_space(3))) bf16x8*)(kp+2048); kf[3]=*(const __attribute__((address_space(3))) bf16x8*)(kp+2560);
  kf[4]=*(const __attribute__((address_space(3))) bf16x8*)(kp+4096); kf[5]=*(const __attribute__((address_space(3))) bf16x8*)(kp+4608);
  kf[6]=*(const __attribute__((address_space(3))) bf16x8*)(kp+6144); kf[7]=*(const __attribute__((address_space(3))) bf16x8*)(kp+6656);
}
__device__ __forceinline__ void kload2(bf16x8*kf,lds_cptr kp,int j){ kf[2*j]=*(const __attribute__((address_space(3))) bf16x8*)(kp+j*2048); kf[2*j+1]=*(const __attribute__((address_space(3))) bf16x8*)(kp+j*2048+512); }
__device__ __forceinline__ s16x4 vtr(lds_cptr p){ return __builtin_bit_cast(s16x4,__builtin_amdgcn_ds_read_tr16_b64_v4i16((__attribute__((address_space(3))) v4i16_t*)p)); }
__device__ __forceinline__ float rowmax(const f32x16&p0,const f32x16&p1){
  float a=max3f(p0[0],p0[1],p1[0]),b=max3f(p0[2],p0[3],p1[1]);a=max3f(a,p1[2],p1[3]);
  #pragma unroll
  for(int r=4;r<16;r+=4){a=max3f(a,p0[r],p0[r+1]);b=max3f(b,p0[r+2],p0[r+3]);a=max3f(a,p1[r],p1[r+1]);b=max3f(b,p1[r+2],p1[r+3]);}
  const float m=max2f(a,b);
  auto rr=__builtin_amdgcn_permlane32_swap(__float_as_uint(m),__float_as_uint(m),false,false);
  return max2f(__uint_as_float(rr[0]),__uint_as_float(rr[1]));
}
__device__ __forceinline__ void pv(f32x16*o,int vb,bf16x8 pa0,bf16x8 pa1,bf16x8 pa2,bf16x8 pa3){
  #pragma unroll
  for(int d0=0;d0<2;++d0){s16x4 lo[4],hi[4];
    #pragma unroll
    for(int ks=0;ks<4;++ks){
      asm volatile("ds_read_b64_tr_b16 %0,%1 offset:%c2":"=&v"(lo[ks]):"v"(vb),"i"(d0*4096+ks*1024):"memory");
      asm volatile("ds_read_b64_tr_b16 %0,%1 offset:%c2":"=&v"(hi[ks]):"v"(vb),"i"(d0*4096+ks*1024+512):"memory");}
    asm volatile("s_waitcnt lgkmcnt(0)":::"memory");SBAR();
    #define PK(k) (bf16x8){lo[k][0],lo[k][1],lo[k][2],lo[k][3],hi[k][0],hi[k][1],hi[k][2],hi[k][3]}
    o[d0]=__builtin_amdgcn_mfma_f32_32x32x16_bf16(pa0,PK(0),o[d0],0,0,0);
    o[d0]=__builtin_amdgcn_mfma_f32_32x32x16_bf16(pa1,PK(1),o[d0],0,0,0);
    o[d0]=__builtin_amdgcn_mfma_f32_32x32x16_bf16(pa2,PK(2),o[d0],0,0,0);
    o[d0]=__builtin_amdgcn_mfma_f32_32x32x16_bf16(pa3,PK(3),o[d0],0,0,0);
    #undef PK
  }
}

#ifndef ATTN_STORE16
#define ATTN_STORE16(p,v) (*(u32x4*)(p)=(v))
#endif
template<int MODE,int THRL> __device__ __forceinline__ void attn_unit(const bf16*Qu,const bf16*__restrict__ Kh,const bf16*__restrict__ Vh,bf16*Ou,const int NT,const int lat0,const int q0s,const float sinkl2,char*shm){
  const int tid=threadIdx.x,lane=tid&63,r32=lane&31,hi=lane>>5; const int wid=__builtin_amdgcn_readfirstlane(tid>>6);
  const bf16*Qw=Qu+(long)(wid*QBLK)*QP;
  const unsigned lds0=(unsigned)(uintptr_t)shm;
  float*wsf=(float*)(shm+LDS_WS)+wid*64;
  const bf16*ksrc=Kh+(long)lane*KP+wid*8;
  const bf16*vsrc=Vh+(long)(16*(wid&3)+(lane>>2))*KP+(wid>>2)*32+(lane&3)*8;
  const unsigned kdst=lds0+LDS_K+wid*1024, vdst=lds0+LDS_V+wid*1024;
  #define TROW(t) ((MODE==0||(t)<4)?(t)*KVBLK:lat0+((t)-4)*KVBLK)
  #define DMA_K(t,slot) glds16(ksrc+(long)TROW(t)*KP,(unsigned)__builtin_amdgcn_readfirstlane(kdst+(slot)))
  #define DMA_V(t,slot) glds16(vsrc+(long)TROW(t)*KP,(unsigned)__builtin_amdgcn_readfirstlane(vdst+(slot)))
  const int vb0=(int)(lds0+LDS_V)+((lane>>4)&1)*32+(lane&3)*8+(4*hi+((lane&15)>>2))*64;
  const char*Kbase=shm+LDS_K; bf16x8 kf[8];
  const lds_cptr shm3=(lds_cptr)shm; const lds_cptr kp0=shm3+LDS_K+hi*1024+r32*16; const lds_cptr vp0=shm3+LDS_V+((lane>>4)&1)*32+(lane&3)*8+(4*hi+((lane&15)>>2))*64;
  DMA_K(0,0);DMA_V(0,0);DMA_K(1,SLOTB);
  bf16x8 qr[4];
  #pragma unroll
  for(int d0=0;d0<4;++d0)qr[d0]=*reinterpret_cast<const bf16x8*>(&Qw[(long)r32*QP+d0*16+hi*8]);
  float mhat=0.f,l_reg=0.f;f32x16 o[2];o[0]=f32x16{};o[1]=f32x16{};f32x16 negm=f32x16{};asm volatile("":"+v"(negm));
  const int qpos=q0s+wid*QBLK+r32;
  #define CMASK(P0,P1,t) do{ if(MODE==1&&(t)>=4) wmask(P0,P1,(lat0-256)+((t)-4)*KVBLK-qpos,hi); }while(0)
  bool resc=false;
  #define START(P0,P1) do{ const float rm=rowmax(P0,P1); resc=false; \
    { const float dl=rm; mhat=fadd_s(mhat,dl); \
      _Pragma("unroll") for(int r=0;r<16;++r){P0[r]=fsub_s(P0[r],dl);P1[r]=fsub_s(P1[r],dl);} \
      _Pragma("unroll") for(int r=0;r<16;++r)negm[r]=-mhat; asm volatile("":"+v"(negm)); } \
    _Pragma("unroll") for(int r=0;r<16;++r)P0[r]=__builtin_amdgcn_exp2f(P0[r]); }while(0)
  #define RESC() do{ if(resc){ asm volatile("s_waitcnt lgkmcnt(0)":::"memory"); \
      _Pragma("unroll") for(int d_=0;d_<2;++d_) _Pragma("unroll") for(int r=0;r<16;++r)o[d_][r]*=wsf[crow(r,hi)]; } }while(0)
  f32x16 pA0,pA1,pB0,pB1;
  int sl_prev=0,sl_cur=0,sl_next=SLOTB;
  #define ROT() do{sl_prev=sl_cur;sl_cur=sl_next;sl_next=(sl_next==(NSLOT-1)*SLOTB)?0:sl_next+SLOTB;}while(0)
  DMA_K(2,2*SLOTB);
  WAIT_BAR(3);
  qkt(pA0,pA1,Kbase,qr,negm,r32,hi);asm volatile("s_nop 15\n\ts_nop 7":"+v"(pA0),"+v"(pA1));CMASK(pA0,pA1,0);
  START(pA0,pA1);
  _Pragma("unroll") for(int r=0;r<16;++r)pA1[r]=__builtin_amdgcn_exp2f(pA1[r]);
  WAIT_BAR(0);
  DMA_K(3,0);DMA_V(1,SLOTB);
  ROT();
  kload8(kf,kp0+sl_cur);
  WAIT_BAR(2);
  s16x4 vlo[8],vhi[8]; u32x4 pw0,pw1,pw2,pw3;
  #define PKW(P,B) cvtpk_s(P[B],P[B+1])
  #define PAF(k) __builtin_bit_cast(bf16x8,pw##k)
  #define VFR(i) (bf16x8){vlo[i][0],vlo[i][1],vlo[i][2],vlo[i][3],vhi[i][0],vhi[i][1],vhi[i][2],vhi[i][3]}
  #define PIN(x) asm volatile("":"+v"(x))
  #define MX3(a,b,c) __builtin_fmaxf(__builtin_fmaxf((a),(b)),(c))
  #define GAPA(MF,A0,A1,A2,A3,W0,W1,PW) do{ MF; sacc+=A0; sacc+=A1; sacc+=A2; sacc+=A3; PIN(sacc); W0; W1; PIN(PW); SBAR(); }while(0)
  #define EX(v) __builtin_amdgcn_exp2f(v)
  #define GAPB(MF,X,B) do{ MF; X[B]=EX(X[B]); X[B+1]=EX(X[B+1]); X[B+2]=EX(X[B+2]); X[B+3]=EX(X[B+3]); PIN(X); SBAR(); }while(0)
  #define VRD(i) do{ vlo[i]=vtr(vp_+(((i)>>2)*4096+((i)&3)*1024)); vhi[i]=vtr(vp_+(((i)>>2)*4096+((i)&3)*1024+512)); }while(0)
  #define KRD(G,j) do{ if(G){ kload2(kf,kp0+sl_next,j); SBAR(); } }while(0)
  #define STEP(C0,C1,P0,P1,t,GK,GV,GL) do{ SBAR(); \
    const lds_cptr vp_=vp0+sl_prev; \
    VRD(0); SBAR(); float sacc=(P0[0]+P0[1]); \
    GAPA(C0=__builtin_amdgcn_mfma_f32_32x32x16_bf16(kf[0],qr[0],negm,0,0,0), P0[2],P0[3],P0[4],P0[5],     pw0[0]=PKW(P0,0), pw0[1]=PKW(P0,2), pw0); \
    VRD(4); SBAR(); GAPA(C1=__builtin_amdgcn_mfma_f32_32x32x16_bf16(kf[1],qr[0],negm,0,0,0), P0[6],P0[7],P0[8],P0[9],     pw0[2]=PKW(P0,4), pw0[3]=PKW(P0,6), pw0); \
    VRD(1); SBAR(); GAPA(C0=__builtin_amdgcn_mfma_f32_32x32x16_bf16(kf[2],qr[1],C0,0,0,0),   P0[10],P0[11],P0[12],P0[13], pw1[0]=PKW(P0,8), pw1[1]=PKW(P0,10), pw1); \
    VRD(5); SBAR(); GAPA(C1=__builtin_amdgcn_mfma_f32_32x32x16_bf16(kf[3],qr[1],C1,0,0,0),   P0[14],P0[15],P1[0],P1[1],   pw1[2]=PKW(P0,12),pw1[3]=PKW(P0,14), pw1); \
    VRD(2); SBAR(); GAPA(C0=__builtin_amdgcn_mfma_f32_32x32x16_bf16(kf[4],qr[2],C0,0,0,0),   P1[2],P1[3],P1[4],P1[5],     pw2[0]=PKW(P1,0), pw2[1]=PKW(P1,2), pw2); \
    VRD(6); SBAR(); GAPA(C1=__builtin_amdgcn_mfma_f32_32x32x16_bf16(kf[5],qr[2],C1,0,0,0),   P1[6],P1[7],P1[8],P1[9],     pw2[2]=PKW(P1,4), pw2[3]=PKW(P1,6), pw2); \
    VRD(3); SBAR(); GAPA(C0=__builtin_amdgcn_mfma_f32_32x32x16_bf16(kf[6],qr[3],C0,0,0,0),   P1[10],P1[11],P1[12],P1[13], pw3[0]=PKW(P1,8), pw3[1]=PKW(P1,10), pw3); \
    VRD(7); SBAR(); GAPA(C1=__builtin_amdgcn_mfma_f32_32x32x16_bf16(kf[7],qr[3],C1,0,0,0),   P1[14],P1[15],0.f,0.f,       pw3[2]=PKW(P1,12),pw3[3]=PKW(P1,14), pw3); \
    l_reg+=sacc; \
    if(GK){DMA_K((t)+3,sl_cur);} if(GV){DMA_V((t)+1,sl_next);} \
    CMASK(C0,C1,t); \
    { float a=MX3(C0[0],C0[1],C1[0]),b=MX3(C0[2],C0[3],C1[1]); a=MX3(a,C1[2],C1[3]); \
      _Pragma("unroll") for(int r=4;r<16;r+=4){a=MX3(a,C0[r],C0[r+1]);b=MX3(b,C0[r+2],C0[r+3]);a=MX3(a,C1[r],C1[r+1]);b=MX3(b,C1[r+2],C1[r+3]);} \
      float rm=__builtin_fmaxf(a,b); { auto rr=__builtin_amdgcn_permlane32_swap(__float_as_uint(rm),__float_as_uint(rm),false,false); rm=__builtin_fmaxf(__uint_as_float(rr[0]),__uint_as_float(rr[1])); } \
      resc=false; \
      if(__builtin_expect(__any(rm>(float)THRL),0)){ const float dl=__builtin_fmaxf(rm,0.f); mhat+=dl; \
        _Pragma("unroll") for(int r=0;r<16;++r){C0[r]-=dl;C1[r]-=dl;} \
        _Pragma("unroll") for(int r=0;r<16;++r)negm[r]=-mhat; asm volatile("":"+v"(negm)); \
        const float f=__builtin_amdgcn_exp2f(-dl); l_reg*=f; if(hi==0)wsf[r32]=f; resc=true; } } \
    SBAR(); \
    GAPB(o[0]=__builtin_amdgcn_mfma_f32_32x32x16_bf16(PAF(0),VFR(0),o[0],0,0,0), C0,0); \
    GAPB(o[1]=__builtin_amdgcn_mfma_f32_32x32x16_bf16(PAF(0),VFR(4),o[1],0,0,0), C0,4); \
    KRD(GL,0); GAPB(o[0]=__builtin_amdgcn_mfma_f32_32x32x16_bf16(PAF(1),VFR(1),o[0],0,0,0), C0,8); \
    KRD(GL,1); GAPB(o[1]=__builtin_amdgcn_mfma_f32_32x32x16_bf16(PAF(1),VFR(5),o[1],0,0,0), C0,12); \
    KRD(GL,2); GAPB(o[0]=__builtin_amdgcn_mfma_f32_32x32x16_bf16(PAF(2),VFR(2),o[0],0,0,0), C1,0); \
    KRD(GL,3); GAPB(o[1]=__builtin_amdgcn_mfma_f32_32x32x16_bf16(PAF(2),VFR(6),o[1],0,0,0), C1,4); \
    GAPB(o[0]=__builtin_amdgcn_mfma_f32_32x32x16_bf16(PAF(3),VFR(3),o[0],0,0,0), C1,8); \
    GAPB(o[1]=__builtin_amdgcn_mfma_f32_32x32x16_bf16(PAF(3),VFR(7),o[1],0,0,0), C1,12); \
    }while(0)
  int t=1;
  for(;t+5<NT;t+=2){
    STEP(pB0,pB1,pA0,pA1,t,true,true,true);     WAIT_BAR(2); RESC(); ROT();
    STEP(pA0,pA1,pB0,pB1,t+1,true,true,true);   WAIT_BAR(2); RESC(); ROT();
  }
  #define ENDW(tt) do{ if((tt)+3<NT){WAIT_BAR(2);} else if((tt)+2<NT){WAIT_BAR(1);} else {WAIT_BAR(0);} }while(0)
  for(;t+1<NT;t+=2){
    STEP(pB0,pB1,pA0,pA1,t,(t+3<NT),(t+1<NT),(t+1<NT));       ENDW(t);   RESC(); ROT();
    STEP(pA0,pA1,pB0,pB1,t+1,(t+4<NT),(t+2<NT),(t+2<NT));     ENDW(t+1); RESC(); ROT();
  }
  STEP(pB0,pB1,pA0,pA1,NT-1,false,false,false); RESC();
  { float sacc=pB0[0]+pB0[1]; _Pragma("unroll") for(int r=2;r<16;++r)sacc+=pB0[r]; _Pragma("unroll") for(int r=0;r<16;++r)sacc+=pB1[r]; l_reg+=sacc;
    pw0=(u32x4){PKW(pB0,0),PKW(pB0,2),PKW(pB0,4),PKW(pB0,6)};pw1=(u32x4){PKW(pB0,8),PKW(pB0,10),PKW(pB0,12),PKW(pB0,14)};pw2=(u32x4){PKW(pB1,0),PKW(pB1,2),PKW(pB1,4),PKW(pB1,6)};pw3=(u32x4){PKW(pB1,8),PKW(pB1,10),PKW(pB1,12),PKW(pB1,14)};
    SBAR(); pv(o,vb0+sl_cur,PAF(0),PAF(1),PAF(2),PAF(3)); }
  #undef PKW
  #undef PAF
  #undef VFR
  #undef PIN
  #undef MX3
  #undef GAPA
  #undef GAPB
  #undef EX
  #undef VRD
  #undef KRD
  #undef STEP
  #undef ENDW
  {auto rr=__builtin_amdgcn_permlane32_swap(__float_as_uint(l_reg),__float_as_uint(l_reg),false,false);l_reg=__uint_as_float(rr[0])+__uint_as_float(rr[1]);}
  if(MODE==1)l_reg+=__builtin_amdgcn_exp2f(sinkl2-mhat);
  if(hi==0)wsf[32+r32]=l_reg;asm volatile("s_waitcnt lgkmcnt(0)":::"memory");
  float rli[16];
  #pragma unroll
  for(int r=0;r<16;++r)rli[r]=__builtin_amdgcn_rcpf(wsf[32+crow(r,hi)]);
  bf16*Ow=Ou+(long)(wid*QBLK)*OP;
  { bf16*stg=(bf16*)(shm+LDS_OST)+wid*2048;
    #pragma unroll
    for(int r=0;r<16;++r){const int orow=crow(r,hi);
      #pragma unroll
      for(int d0=0;d0<2;++d0)stg[orow*64+d0*32+r32]=__float2bfloat16(o[d0][r]*rli[r]);}
    asm volatile("s_waitcnt lgkmcnt(0)":::"memory");
    #pragma unroll
    for(int i=0;i<4;++i){const int row=i*8+(lane>>3),ch=lane&7; const u32x4 v=*(const u32x4*)(stg+row*64+ch*8); ATTN_STORE16(Ow+(long)row*OP+ch*8,v);} }
  asm volatile("s_waitcnt lgkmcnt(0)\n\ts_barrier":::"memory");
  #undef DMA_K
  #undef TROW
  #undef DMA_V
  #undef CMASK
  #undef START
  #undef RESC
  #undef ROT
}
#undef SBAR
#undef WAIT_BAR
}

template <int LAYER> __device__ __forceinline__ void attn_fast(const Frame& F, char* shm) {
    using attn_body::bf16;
    const bf16* Q = (const bf16*)(F.ws + WS_Q); const bf16* Kn = (const bf16*)(F.ws + WS_KN); const bf16* Vn = (const bf16*)(F.ws + WS_VN); bf16* AO = (bf16*)(F.ws + WS_AO);
    const int nunits = LAYER == 0 ? 1024 + 64 : 1024;
    for (int U = F.vcu; U < nunits; U += F.G) {
        int b, h, NT, lat0 = 0, q0 = 0; size_t row0;
        if (U < 1024) { b = U >> 7; h = ((U >> 6) & 1) * 4 + ((U >> 4) & 3); q0 = (U & 15) * 256; row0 = (size_t)b * SEQ + q0;
            if (LAYER == 0) NT = KVS / 64;
            else { int lo = q0 - 128, hi = q0 + 384; lo = lo < 0 ? 0 : lo; hi = hi > SEQ ? SEQ : hi; NT = 4 + (hi - lo) / 64; lat0 = CTXL + lo; } }
        else { const int uc = U - 1024; b = uc >> 3; h = uc & 7; row0 = (size_t)TX + (size_t)b * CTXL; NT = 4; }
        const bf16* Kh = Kn + (size_t)b * KVS * 128 + (h >> 2) * 64; const bf16* Vh = Vn + (size_t)b * KVS * 128 + (h >> 2) * 64;
        const float sinkl2 = LAYER == 1 ? F.in[I_SINK][h] * LOG2E : 0.f;
        attn_body::attn_unit<LAYER, 8>(Q + row0 * 512 + h * 64, Kh, Vh, AO + row0 * 1024 + h * 64, NT, lat0, q0, sinkl2, shm);
    }
}

__device__ __forceinline__ void p_router(const Frame& F, int l, int ntok) {
    const int gw = F.vcu * NWAVES + F.wave, NGW = F.G * NWAVES, lane = F.lane, tk = lane & 15, kq = lane >> 4;
    bf16_t* HX = (bf16_t*)(F.ws + WS_HX); const float* SS = (const float*)(F.ws + WS_SS);
    const bf16_t* Wh = (const bf16_t*)(F.ws + WS_WR) + (size_t)l * 2 * 48 * 1024; const bf16_t* Wl = Wh + 48 * 1024;
    const float* gb = F.in[I_RGB] + l * 4; const float* eb = F.in[I_REB] + l * 32; const float* g = F.in[I_LN2] + l * 1024;
    unsigned* tokslot = (unsigned*)(F.ws + WS_TOK); float* tokw = (float*)(F.ws + WS_TOK + 512 * 1024); unsigned* list = (unsigned*)(F.ws + WS_LIST);
    unsigned* cnt = F.cnt(l);
    LAS float* lgs = (LAS float*)(F.lds + F.wave * 3072);
    for (int grp = gw; grp < ntok / 16; grp += NGW) {
        const int row = grp * 16 + tk, r = modrow(grp * 16);
        const float* xr = F.xr_row(row); const float* sh = F.mod(l, r, 3); const float* sc = F.mod(l, r, 4);
        float ssum = 0.f;
#pragma unroll
        for (int i = 0; i < 4; ++i) { const f32x4 p = *(const f32x4*)(SS + (size_t)row * 16 + 4 * i); ssum += (p[0] + p[1]) + (p[2] + p[3]); }
        const float rms = 1.0f / sqrtf(ssum * (1.f / 1024.f) + EPS);
        f32x4 acc[3];
#pragma unroll
        for (int n = 0; n < 3; ++n) acc[n] = (f32x4){0.f, 0.f, 0.f, 0.f};
#pragma unroll 2
        for (int k0 = 0; k0 < 1024; k0 += 32) { const int kk = k0 + 8 * kq;
            const f32x4 x0 = *(const f32x4*)(xr + kk), x1 = *(const f32x4*)(xr + kk + 4), g0 = *(const f32x4*)(g + kk), g1 = *(const f32x4*)(g + kk + 4);
            const f32x4 c0 = *(const f32x4*)(sc + kk), c1 = *(const f32x4*)(sc + kk + 4), s0 = *(const f32x4*)(sh + kk), s1 = *(const f32x4*)(sh + kk + 4);
            const f32x4 h0 = (x0 * rms * g0) * (1.f + c0) + s0, h1 = (x1 * rms * g1) * (1.f + c1) + s1;
            u32x4 hh; hh.x = pk2(h0[0], h0[1]); hh.y = pk2(h0[2], h0[3]); hh.z = pk2(h1[0], h1[1]); hh.w = pk2(h1[2], h1[3]);
            *(u32x4*)(HX + (size_t)row * DM + kk) = hh;
            u32x4 hl; hl.x = pk2(h0[0] - bflo(hh.x), h0[1] - bfhi(hh.x)); hl.y = pk2(h0[2] - bflo(hh.y), h0[3] - bfhi(hh.y)); hl.z = pk2(h1[0] - bflo(hh.z), h1[1] - bfhi(hh.z)); hl.w = pk2(h1[2] - bflo(hh.w), h1[3] - bfhi(hh.w));
            const bf16x8 bh = __builtin_bit_cast(bf16x8, hh), bl = __builtin_bit_cast(bf16x8, hl);
#pragma unroll
            for (int n = 0; n < 3; ++n) { const bf16x8 wh = *(const bf16x8*)(Wh + (size_t)(16 * n + tk) * 1024 + kk), wl = *(const bf16x8*)(Wl + (size_t)(16 * n + tk) * 1024 + kk);
                acc[n] = __builtin_amdgcn_mfma_f32_16x16x32_bf16(wh, bh, acc[n], 0, 0, 0); acc[n] = __builtin_amdgcn_mfma_f32_16x16x32_bf16(wh, bl, acc[n], 0, 0, 0); acc[n] = __builtin_amdgcn_mfma_f32_16x16x32_bf16(wl, bh, acc[n], 0, 0, 0); } }
#pragma unroll
        for (int n = 0; n < 3; ++n) *(LAS f32x4*)(lgs + tk * 48 + 16 * n + 4 * kq) = acc[n];
        asm volatile("s_waitcnt lgkmcnt(0)" ::: "memory");
        if (lane < 16) {
            float lg[4], le[32];
            { const f32x4 t = *(const LAS f32x4*)(lgs + lane * 48);
#pragma unroll
              for (int o = 0; o < 4; ++o) lg[o] = t[o] + gb[o]; }
#pragma unroll
            for (int q = 0; q < 8; ++q) { const f32x4 t = *(const LAS f32x4*)(lgs + lane * 48 + 4 + 4 * q);
#pragma unroll
                for (int o = 0; o < 4; ++o) le[4 * q + o] = t[o] + eb[4 * q + o]; }
            int gs = 0; float gm = lg[0];
#pragma unroll
            for (int o = 1; o < 4; ++o) if (lg[o] > gm) { gm = lg[o]; gs = o; }
            float gden = 0.f;
#pragma unroll
            for (int o = 0; o < 4; ++o) gden += expf(lg[o] - gm);
            const float g_w = 1.f / gden;
            float el[8];
#pragma unroll
            for (int i = 0; i < 8; ++i) { el[i] = le[i];
#pragma unroll
                for (int gg = 1; gg < 4; ++gg) el[i] = (gs == gg) ? le[gg * 8 + i] : el[i]; }
            int i1 = 0; float m1 = el[0];
#pragma unroll
            for (int i = 1; i < 8; ++i) if (el[i] > m1) { m1 = el[i]; i1 = i; }
            int i2 = 0; float m2 = -3.0e38f;
#pragma unroll
            for (int i = 0; i < 8; ++i) if (i != i1 && el[i] > m2) { m2 = el[i]; i2 = i; }
            const float p2 = expf(m2 - m1); const float w1 = g_w / (1.f + p2), w2 = g_w * p2 / (1.f + p2);
            const int e1 = gs * 8 + i1, e2 = gs * 8 + i2;
            const unsigned pos1 = atomicAdd(cnt + e1 * 64, 1u), pos2 = atomicAdd(cnt + e2 * 64, 1u);
            list[(size_t)e1 * TT + pos1] = (unsigned)row; list[(size_t)e2 * TT + pos2] = (unsigned)row;
            tokslot[2 * row] = ((unsigned)e1 << 16) | pos1; tokslot[2 * row + 1] = ((unsigned)e2 << 16) | pos2; tokw[2 * row] = w1; tokw[2 * row + 1] = w2;
        }
        asm volatile("s_waitcnt lgkmcnt(0)" ::: "memory");
    }
}
template <bool LAST> __device__ __forceinline__ void p_combine(const Frame& F, int l, int ntok, const MoeTab& tb) {
    const int gw = F.vcu * NWAVES + F.wave, NGW = F.G * NWAVES, lane = F.lane;
    const bf16_t* YB = (const bf16_t*)(F.ws + WS_YB); bf16_t* HX = (bf16_t*)(F.ws + WS_HX);
    const unsigned* tokslot = (const unsigned*)(F.ws + WS_TOK); const float* tokw = (const float*)(F.ws + WS_TOK + 512 * 1024);
    for (int row = gw; row < ntok; row += NGW) {
        const unsigned sa = tokslot[2 * row], sb = tokslot[2 * row + 1]; const float wa = tokw[2 * row], wb = tokw[2 * row + 1];
        const size_t slota = (size_t)tb.tile0[sa >> 16] * 256 + (sa & 0xffffu), slotb = (size_t)tb.tile0[sb >> 16] * 256 + (sb & 0xffffu);
        const int r = modrow(row); const float* g2 = F.mod(l, r, 5); float* xr = F.xr_row(row);
        float ss = 0.f; f32x4 v[4];
#pragma unroll
        for (int j = 0; j < 4; ++j) { const int c = 4 * lane + 256 * j; const u32x2 ya = *(const u32x2*)(YB + slota * 1024 + c), yb = *(const u32x2*)(YB + slotb * 1024 + c);
            const f32x4 x1 = *(const f32x4*)(xr + c), gv = *(const f32x4*)(g2 + c);
            f32x4 y; y[0] = wa * bflo(ya.x) + wb * bflo(yb.x); y[1] = wa * bfhi(ya.x) + wb * bfhi(yb.x); y[2] = wa * bflo(ya.y) + wb * bflo(yb.y); y[3] = wa * bfhi(ya.y) + wb * bfhi(yb.y);
            v[j] = x1 + gv * y; *(f32x4*)(xr + c) = v[j];
            ss += (v[j][0] * v[j][0] + v[j][1] * v[j][1]) + (v[j][2] * v[j][2] + v[j][3] * v[j][3]); }
        if (!LAST) { const float rms = 1.0f / sqrtf(wave_sum(ss) * (1.f / 1024.f) + EPS); const float* g = F.in[I_LN1] + (l + 1) * 1024; const float* sh = F.mod(l + 1, r, 0); const float* sc = F.mod(l + 1, r, 1); f32x4 h[4];
#pragma unroll
            for (int j = 0; j < 4; ++j) { const int c = 4 * lane + 256 * j; h[j] = (v[j] * rms * *(const f32x4*)(g + c)) * (1.f + *(const f32x4*)(sc + c)) + *(const f32x4*)(sh + c); }
            store_row_bf16(HX + (size_t)row * DM, lane, h); }
    }
}

__global__ void __launch_bounds__(NTHREADS, 2) fwd_kernel(Params P) {
    extern __shared__ __attribute__((aligned(16))) unsigned char lds_raw[];
    Frame F;
    F.lds = (LAS unsigned char*)lds_raw; F.in = P.in; F.out = P.out; F.ws = P.ws;
    F.tid = threadIdx.x; F.lane = F.tid & 63; F.wave = __builtin_amdgcn_readfirstlane(F.tid >> 6);
    F.G = gridDim.x; { const int bx = blockIdx.x; F.vcu = (F.G % 8 == 0) ? (bx % 8) * (F.G / 8) + bx / 8 : bx; }
    volatile LAS unsigned* misc = (volatile LAS unsigned*)(F.lds + LDS_MISC);
    if (F.tid < 16) misc[F.tid] = 0u;
    __syncthreads();
#if ONE_LAUNCH
    XcdBarrier bar = xcd_barrier_post((unsigned*)(F.ws + WS_CTL) + CW_BAR, misc + 8);
#define GRID_BAR() do { xcd_barrier(bar); } while (0)
#else
#define GRID_BAR() do { } while (0)
#endif
    const int lo = P.ph_lo, hi = P.ph_hi;
#ifndef PHMASK
#define PHMASK 0xFFFFFFFFu
#endif
#define IN(k) (((PHMASK >> (k)) & 1u) && lo <= (k) && (k) < hi)
#define SEAM(k) do { if (IN((k) + 1)) GRID_BAR(); } while (0)
    bf16_t* HX = (bf16_t*)(F.ws + WS_HX); bf16_t* Qb = (bf16_t*)(F.ws + WS_Q); bf16_t* KVb = (bf16_t*)(F.ws + WS_KV); bf16_t* Gb = (bf16_t*)(F.ws + WS_G); bf16_t* AO = (bf16_t*)(F.ws + WS_AO);
    bf16_t* HID = (bf16_t*)(F.ws + WS_HID); bf16_t* YB = (bf16_t*)(F.ws + WS_YB);

    if (IN(0)) { Frame Fp = F; asm volatile("" : "+v"(Fp.tid), "+v"(Fp.lane)); p0_prologue(Fp); SEAM(0); }
    if (IN(1)) { Frame Fp = F; asm volatile("" : "+v"(Fp.tid), "+v"(Fp.lane)); p_norm1_l0(Fp); SEAM(1); }
    if (IN(2)) { Frame Fp = F; asm volatile("" : "+v"(Fp.tid), "+v"(Fp.lane)); SchedDense S{(const bf16_t*)(Fp.ws + WS_WINAB), 1024, TT / 256, 7, 0, 0, Fp.vcu, Fp.G}; EpiInProj<true> E{Qb, KVb, Gb}; GEMM(Fp, HX, 1024, S, E); SEAM(2); }
    if (IN(3)) { Frame Fp = F; asm volatile("" : "+v"(Fp.tid), "+v"(Fp.lane)); p_qkv_post(Fp, Fp.in[I_QNA], Fp.in[I_KNA], true); p_conv(Fp); SEAM(3); }
    if (IN(4)) { Frame Fp = F; asm volatile("" : "+v"(Fp.tid), "+v"(Fp.lane));
#ifdef ATTN_SIMPLE
        attn_simple<0>(Fp);
#else
        attn_fast<0>(Fp, (char*)lds_raw);
#endif
        SEAM(4); }
    if (IN(5)) { Frame Fp = F; asm volatile("" : "+v"(Fp.tid), "+v"(Fp.lane)); SchedDense S{(const bf16_t*)(Fp.ws + WS_WOUTAB), 1024, TT / 256, 4, 0, 0, Fp.vcu, Fp.G}; EpiOutProj<true> E{Fp, 0}; GEMM(Fp, AO, 1024, S, E); SEAM(5); }
    if (IN(6)) { Frame Fp = F; asm volatile("" : "+v"(Fp.tid), "+v"(Fp.lane)); p_router(Fp, 0, TT); SEAM(6); }
    if (IN(7)) { Frame Fp = F; asm volatile("" : "+v"(Fp.tid), "+v"(Fp.lane)); const MoeTab tb = moe_tables(Fp, 0); SchedMoe S{(const bf16_t*)(Fp.ws + WS_WGU), (size_t)1024 * 1024, 1024, tb, (const unsigned*)(Fp.ws + WS_LIST), true, Fp.vcu, Fp.G}; EpiMoe1 E{HID}; GEMM(Fp, HX, 1024, S, E); SEAM(7); }
    if (IN(8)) { Frame Fp = F; asm volatile("" : "+v"(Fp.tid), "+v"(Fp.lane)); const MoeTab tb = moe_tables(Fp, 0); SchedMoe S{(const bf16_t*)(Fp.ws + WS_WD), (size_t)1024 * 512, 512, tb, nullptr, false, Fp.vcu, Fp.G}; EpiMoe2 E{YB}; GEMM(Fp, HID, 512, S, E); SEAM(8); }
    if (IN(9)) { Frame Fp = F; asm volatile("" : "+v"(Fp.tid), "+v"(Fp.lane)); const MoeTab tb = moe_tables(Fp, 0); p_combine<false>(Fp, 0, TT, tb); SEAM(9); }
    if (IN(10)) { Frame Fp = F; asm volatile("" : "+v"(Fp.tid), "+v"(Fp.lane)); SchedDense S{(const bf16_t*)(Fp.ws + WS_WINCD), 1024, TX / 256, 5, TC / 256, 2, Fp.vcu, Fp.G}; EpiInProj<false> E{Qb, KVb, Gb}; GEMM(Fp, HX, 1024, S, E); SEAM(10); }
    if (IN(11)) { Frame Fp = F; asm volatile("" : "+v"(Fp.tid), "+v"(Fp.lane)); p_qkv_post(Fp, Fp.in[I_QNC], Fp.in[I_KNC], false); p_pool(Fp); SEAM(11); }
    if (IN(12)) { Frame Fp = F; asm volatile("" : "+v"(Fp.tid), "+v"(Fp.lane));
#ifdef ATTN_SIMPLE
        attn_simple<1>(Fp);
#else
        attn_fast<1>(Fp, (char*)lds_raw);
#endif
        SEAM(12); }
    if (IN(13)) { Frame Fp = F; asm volatile("" : "+v"(Fp.tid), "+v"(Fp.lane)); SchedDense S{(const bf16_t*)(Fp.ws + WS_WOUTCD), 1024, TX / 256, 4, 0, 0, Fp.vcu, Fp.G}; EpiOutProj<false> E{Fp, 1}; GEMM(Fp, AO, 1024, S, E); SEAM(13); }
    if (IN(14)) { Frame Fp = F; asm volatile("" : "+v"(Fp.tid), "+v"(Fp.lane)); p_router(Fp, 1, TX); SEAM(14); }
    if (IN(15)) { Frame Fp = F; asm volatile("" : "+v"(Fp.tid), "+v"(Fp.lane)); const MoeTab tb = moe_tables(Fp, 1); SchedMoe S{(const bf16_t*)(Fp.ws + WS_WGU) + (size_t)32 * 1024 * 1024, (size_t)1024 * 1024, 1024, tb, (const unsigned*)(Fp.ws + WS_LIST), true, Fp.vcu, Fp.G}; EpiMoe1 E{HID}; GEMM(Fp, HX, 1024, S, E); SEAM(15); }
    if (IN(16)) { Frame Fp = F; asm volatile("" : "+v"(Fp.tid), "+v"(Fp.lane)); const MoeTab tb = moe_tables(Fp, 1); SchedMoe S{(const bf16_t*)(Fp.ws + WS_WD) + (size_t)32 * 1024 * 512, (size_t)1024 * 512, 512, tb, nullptr, false, Fp.vcu, Fp.G}; EpiMoe2 E{YB}; GEMM(Fp, HID, 512, S, E); SEAM(16); }
    if (IN(17)) { Frame Fp = F; asm volatile("" : "+v"(Fp.tid), "+v"(Fp.lane)); const MoeTab tb = moe_tables(Fp, 1); p_combine<true>(Fp, 1, TX, tb); }
#undef IN
#undef SEAM
}

extern "C" void kernel_launch(void* const* d_in, const int* in_sizes, int n_in, void* d_out, int out_size, void* d_ws, size_t ws_size, hipStream_t stream) {
    static int grid = 0;
    if (grid == 0) {
        if (n_in != 30 || out_size != TX * DM || ws_size < WS_END) { fprintf(stderr, "kernel_launch: unexpected shapes (n_in %d out %d ws %zu)\n", n_in, out_size, ws_size); grid = -1; return; }
        int dev = 0, cus = 0;
        if (hipGetDevice(&dev) != hipSuccess || hipDeviceGetAttribute(&cus, hipDeviceAttributeMultiprocessorCount, dev) != hipSuccess) { grid = -1; return; }
        if (hipFuncSetAttribute((const void*)fwd_kernel, hipFuncAttributeMaxDynamicSharedMemorySize, LDS_BYTES) != hipSuccess) { fprintf(stderr, "kernel_launch: hipFuncSetAttribute failed\n"); grid = -1; return; }
        int per_cu = 0;
        if (hipOccupancyMaxActiveBlocksPerMultiprocessor(&per_cu, (const void*)fwd_kernel, NTHREADS, LDS_BYTES) != hipSuccess || per_cu < 1) { fprintf(stderr, "kernel_launch: occupancy query says %d\n", per_cu); }
        (void)hipGetLastError();
        grid = cus;
    }
    if (grid < 0) return;
    (void)hipMemsetAsync((char*)d_ws + WS_CTL, 0, CTL_ZERO_BYTES, stream);
    Params p{};
    for (int i = 0; i < 30; ++i) p.in[i] = (const float*)d_in[i];
    p.out = (float*)d_out; p.ws = (unsigned char*)d_ws;
#if ONE_LAUNCH
    p.ph_lo = 0; p.ph_hi = NPH;
    hipLaunchKernelGGL(fwd_kernel, dim3(grid), dim3(NTHREADS), LDS_BYTES, stream, p);
#else
    for (int ph = 0; ph < NPH; ++ph) { p.ph_lo = ph; p.ph_hi = ph + 1; hipLaunchKernelGGL(fwd_kernel, dim3(grid), dim3(NTHREADS), LDS_BYTES, stream, p); }
#endif
}
```

```cpp
#include <hip/hip_runtime.h>
#include <cstdio>
#include <cstdint>

#ifndef ONE_LAUNCH
#define ONE_LAUNCH 1
#endif

#define LAS __attribute__((address_space(3)))
#define GAS __attribute__((address_space(1)))
typedef unsigned short bf16_t;
typedef short bf16x8 __attribute__((ext_vector_type(8)));
typedef float f32x4 __attribute__((ext_vector_type(4)));
typedef float f32x2 __attribute__((ext_vector_type(2)));
typedef unsigned u32x4 __attribute__((ext_vector_type(4)));
typedef unsigned u32x2 __attribute__((ext_vector_type(2)));
typedef __bf16 bf16x2_t __attribute__((ext_vector_type(2)));

constexpr int NB = 8, SEQ = 4096, DM = 1024, CTXL = 256, HD = 64;
constexpr int TX = NB * SEQ, TC = NB * CTXL, TT = TX + TC;
constexpr int KVS = CTXL + SEQ;
constexpr int NE = 32;
constexpr int NTILE_MAX = 304, NSLOT = NTILE_MAX * 256;
constexpr float EPS = 1e-6f;
constexpr float LOG2E = 1.4426950408889634f;
constexpr float C2 = 0.125f * LOG2E;
constexpr int NWAVES = 8, NTHREADS = 512;
constexpr int NPH = 18;

enum { I_X = 0, I_C, I_CTX, I_CCTX, I_MODW, I_MODB, I_LN1, I_LN2, I_WINAB, I_WOUTAB, I_QNA, I_KNA, I_CONVW, I_CONVB, I_CLNG, I_CLNB,
       I_WINCD, I_WOUTCD, I_QNC, I_KNC, I_SINK, I_POOLW, I_POOLS, I_RGW, I_RGB, I_REW, I_REB, I_EXG, I_EXU, I_EXD };

constexpr size_t MiB = 1u << 20;
constexpr size_t WS_CTL = 0, CTL_ZERO_BYTES = 1 * MiB;
constexpr size_t WS_MOD = 1 * MiB;
constexpr size_t WS_ROPE = 2 * MiB;
constexpr size_t WS_TOK = 3 * MiB;
constexpr size_t WS_LIST = 4 * MiB;
constexpr size_t WS_WINAB = 10 * MiB;
constexpr size_t WS_WOUTAB = 14 * MiB;
constexpr size_t WS_WINCD = 16 * MiB;
constexpr size_t WS_WOUTCD = 19 * MiB;
constexpr size_t WS_XC = 21 * MiB;
constexpr size_t WS_KN = 30 * MiB;
constexpr size_t WS_VN = 39 * MiB;
constexpr size_t WS_WGU = 48 * MiB;
constexpr size_t WS_WD = 176 * MiB;
constexpr size_t WS_HX = 240 * MiB;
constexpr size_t WS_HID = 308 * MiB;
constexpr size_t WS_Q = 384 * MiB;
constexpr size_t WS_KV = 418 * MiB;
constexpr size_t WS_G = 435 * MiB;
constexpr size_t WS_AO = 469 * MiB;
constexpr size_t WS_YB = 384 * MiB;
constexpr size_t WS_SS = 537 * MiB;
constexpr size_t WS_WR = 9 * MiB;
constexpr size_t WS_GP = 3 * MiB + 896 * 1024;
constexpr size_t WS_END = 540 * MiB;
static_assert(WS_YB + (size_t)NSLOT * 1024 * 2 <= WS_END && WS_AO + (size_t)TT * 1024 * 2 <= WS_END, "ws map");
constexpr int CW_CNT = 256;
constexpr int CW_BAR = 16384;

constexpr int RING_BYTES = 131072;
constexpr int RW_BYTES = 73728;
constexpr int LDS_MISC = 2 * RW_BYTES;
constexpr int LDS_TAB = LDS_MISC + 256;
constexpr int LDS_BYTES = 163840;

__device__ __forceinline__ unsigned pk2(float lo, float hi) { f32x2 v = {lo, hi}; bf16x2_t b = __builtin_convertvector(v, bf16x2_t); return __builtin_bit_cast(unsigned, b); }
__device__ __forceinline__ float bflo(unsigned w) { return __uint_as_float(w << 16); }
__device__ __forceinline__ float bfhi(unsigned w) { return __uint_as_float(w & 0xffff0000u); }
__device__ __forceinline__ float bf2f(bf16_t h) { return __uint_as_float((unsigned)h << 16); }
__device__ __forceinline__ float wave_sum(float v) {
#pragma unroll
    for (int o = 1; o < 64; o <<= 1) v += __shfl_xor(v, o);
    return v;
}
__device__ __forceinline__ float sigmoidf_(float v) { return 1.f / (1.f + __expf(-v)); }

#define XB_TMO      128
#define XB_XCNT(j)  (256  + 64 * (j))
#define XB_XSUB(j)  (1280 + 64 * (j))
#define XB_XGEN(j)  (2304 + 64 * (j))
#define XB_TOP      3328
#define XB_TOPGEN   3392
#define XCD_BAR_WORDS 3456
#define XB_SPIN_CAP (1u << 18)
__device__ __forceinline__ unsigned xb_ld(unsigned* p)              { return __hip_atomic_load(p, __ATOMIC_RELAXED, __HIP_MEMORY_SCOPE_AGENT); }
__device__ __forceinline__ unsigned xb_add(unsigned* p, unsigned v) { return __hip_atomic_fetch_add(p, v, __ATOMIC_RELAXED, __HIP_MEMORY_SCOPE_AGENT); }
__device__ __forceinline__ unsigned xb_xcc_id() { return (unsigned)__builtin_amdgcn_s_getreg((3 << 11) | 20) & 0xFu; }
#define XB_SPIN(cond, bar) do { unsigned _sp = 0; while (cond) { __builtin_amdgcn_s_sleep(1); \
    if ((++_sp & 255u) == 0u) { if (xb_ld(&(bar)[XB_TMO])) break; if (_sp > XB_SPIN_CAP) { atomicAdd(&(bar)[XB_TMO], 1u); break; } } } } while (0)
struct XcdBarrier { unsigned* bar; unsigned x; volatile LAS unsigned* st; };
__device__ __forceinline__ XcdBarrier xcd_barrier_post(unsigned* bar, volatile LAS unsigned* st) {
    XcdBarrier b; b.bar = bar; b.x = xb_xcc_id(); b.st = st;
    if (threadIdx.x == 0) (void)xb_add(&bar[XB_XCNT(b.x)], 1u);
    return b;
}
__device__ __forceinline__ void xcd_barrier_complete(unsigned* bar, unsigned x, unsigned& nloc, unsigned& nx) {
    const unsigned G = gridDim.x * gridDim.y * gridDim.z;
    unsigned sum, cnt, mine, sp = 0u;
    for (;;) {
        sum = 0u; cnt = 0u; mine = 0u;
#pragma unroll
        for (unsigned j = 0; j < 16; ++j) { const unsigned c = xb_ld(&bar[XB_XCNT(j)]); sum += c; cnt += (c > 0u) ? 1u : 0u; mine = (j == x) ? c : mine; }
        if (sum == G) break;
        __builtin_amdgcn_s_sleep(1);
        if ((++sp & 255u) == 0u) { if (xb_ld(&bar[XB_TMO])) break; if (sp > XB_SPIN_CAP) { atomicAdd(&bar[XB_TMO], 1u); break; } }
    }
    nloc = mine > 0u ? mine : 1u; nx = cnt > 0u ? cnt : 1u;
}
__device__ __forceinline__ void xcd_barrier(const XcdBarrier& b) {
    asm volatile("s_waitcnt vmcnt(0)" ::: "memory");
    __syncthreads();
    if (threadIdx.x == 0) {
        unsigned* bar = b.bar;
        __builtin_amdgcn_s_waitcnt(0);
        unsigned nloc = b.st[0], nx = b.st[1];
        if (nloc == 0u) { xcd_barrier_complete(bar, b.x, nloc, nx); b.st[0] = nloc; b.st[1] = nx; }
        const unsigned old = xb_add(&bar[XB_XSUB(b.x)], 1u);
        const unsigned gen = old / nloc;
        if (old + 1u == (gen + 1u) * nloc) {
            __builtin_amdgcn_fence(__ATOMIC_RELEASE, "agent");
            asm volatile("s_waitcnt vmcnt(0)" ::: "memory");
            const unsigned og = xb_add(&bar[XB_TOP], 1u);
            const unsigned tg = og / nx;
            if (og + 1u == (tg + 1u) * nx) xb_add(&bar[XB_TOPGEN], 1u);
            else XB_SPIN(xb_ld(&bar[XB_TOPGEN]) == tg, bar);
            __builtin_amdgcn_fence(__ATOMIC_ACQUIRE, "agent");
            xb_add(&bar[XB_XGEN(b.x)], 1u);
            asm volatile("s_waitcnt vmcnt(0)" ::: "memory");
        } else {
            XB_SPIN(xb_ld(&bar[XB_XGEN(b.x)]) == gen, bar);
            __builtin_amdgcn_fence(__ATOMIC_ACQUIRE, "agent");
            asm volatile("s_waitcnt vmcnt(0)" ::: "memory");
        }
    }
    __syncthreads();
}

struct Params { const float* in[30]; float* out; unsigned char* ws; int ph_lo, ph_hi; };
struct Frame {
    LAS unsigned char* lds;
    const float* const* in;
    float* out; unsigned char* ws;
    int tid, lane, wave, vcu, G;
    __device__ __forceinline__ const float* mod(int l, int r, int chunk) const { return (const float*)(ws + WS_MOD) + ((size_t)(l * 9 + r) * 6144 + chunk * 1024); }
    __device__ __forceinline__ float* xr_row(int row) const { return row < TX ? out + (size_t)row * DM : (float*)(ws + WS_XC) + (size_t)(row - TX) * DM; }
    __device__ __forceinline__ const float* xin_row(int row) const { return row < TX ? in[I_X] + (size_t)row * DM : in[I_CTX] + (size_t)(row - TX) * DM; }
    __device__ __forceinline__ unsigned* cnt(int l) const { return (unsigned*)(ws + WS_CTL) + CW_CNT + l * 32 * 64; }
};
__device__ __forceinline__ int modrow(int row) { return row < TX ? (row >> 12) : 8; }

__device__ __forceinline__ void p0_mod_item(const Frame& F, int item) {
    const int l = item / 96, cg = item % 96;
    LAS float* sc = (LAS float*)F.lds;
    LAS float* red = sc + 9 * 1024;
    for (int i = F.tid; i < 9 * 1024; i += NTHREADS) { const int r = i >> 10, k = i & 1023; const float v = r < 8 ? F.in[I_C][r * 1024 + k] : F.in[I_CCTX][k]; sc[i] = v / (1.f + expf(-v)); }
    __syncthreads();
    const float* W = F.in[I_MODW] + (size_t)l * 1024 * 6144 + cg * 64 + F.lane;
    float acc[9];
#pragma unroll
    for (int r = 0; r < 9; ++r) acc[r] = 0.f;
    for (int kb = 0; kb < 128; kb += 32) { float w[32];
#pragma unroll
        for (int kk = 0; kk < 32; ++kk) w[kk] = W[(size_t)(F.wave * 128 + kb + kk) * 6144];
#pragma unroll
        for (int kk = 0; kk < 32; ++kk) { const int k = F.wave * 128 + kb + kk;
#pragma unroll
            for (int r = 0; r < 9; ++r) acc[r] += sc[r * 1024 + k] * w[kk]; } }
#pragma unroll
    for (int r = 0; r < 9; ++r) red[(F.wave * 9 + r) * 64 + F.lane] = acc[r];
    __syncthreads();
    for (int i = F.tid; i < 9 * 64; i += NTHREADS) { const int r = i >> 6, ln = i & 63; float s = 0.f;
#pragma unroll
        for (int w = 0; w < 8; ++w) s += red[(w * 9 + r) * 64 + ln];
        ((float*)(F.ws + WS_MOD))[(size_t)(l * 9 + r) * 6144 + cg * 64 + ln] = s + F.in[I_MODB][l * 6144 + cg * 64 + ln]; }
    __syncthreads();
}
struct TDesc { const float* src; bf16_t* dst; int ldw, ldt; };
__device__ __forceinline__ void t_load(const TDesc& d, f32x4 (&v)[8], int lane) {
    const int kr = lane >> 3, nq = lane & 7;
#pragma unroll
    for (int i = 0; i < 8; ++i) v[i] = *(const f32x4*)(d.src + (size_t)(8 * i + kr) * d.ldw + 4 * nq);
}
__device__ __forceinline__ void t_finish(const TDesc& d, const f32x4 (&v)[8], LAS float* scr, int lane) {
    const int kr = lane >> 3, nq = lane & 7;
#pragma unroll
    for (int i = 0; i < 8; ++i) { LAS float* s = scr + (8 * i + kr) * 33 + 4 * nq; s[0] = v[i][0]; s[1] = v[i][1]; s[2] = v[i][2]; s[3] = v[i][3]; }
    asm volatile("s_waitcnt lgkmcnt(0)" ::: "memory");
    const int c = lane & 7;
#pragma unroll
    for (int j = 0; j < 4; ++j) { const int n = (lane >> 3) + 8 * j; const LAS float* s = scr + (8 * c) * 33 + n;
        u32x4 o; o.x = pk2(s[0 * 33], s[1 * 33]); o.y = pk2(s[2 * 33], s[3 * 33]); o.z = pk2(s[4 * 33], s[5 * 33]); o.w = pk2(s[6 * 33], s[7 * 33]);
        *(u32x4*)(d.dst + (size_t)n * d.ldt + 8 * c) = o; }
    asm volatile("s_waitcnt lgkmcnt(0)" ::: "memory");
}
constexpr int TN_AB = 16 * 56, TN_OAB = 16 * 32, TN_CD = 16 * 40, TN_OCD = 8 * 32, TN_G = 64 * 256, TN_U = 64 * 256, TN_D = 64 * 256;
constexpr int TN_ITEMS = TN_AB + TN_OAB + TN_CD + TN_OCD + TN_G + TN_U + TN_D;
__device__ __forceinline__ TDesc t_decode(const Frame& F, int it) {
    TDesc d; int r = it;
    if (r < TN_AB) { const int kb = r / 56, nb = r % 56, n0 = nb * 32; int d0;
        if (n0 < 768) d0 = n0; else if (n0 < 1280) { const int j = n0 - 768; d0 = 768 + (j >> 7) * 256 + (j & 127); } else { const int j = n0 - 1280; d0 = 768 + (j >> 7) * 256 + 128 + (j & 127); }
        d.src = F.in[I_WINAB] + (size_t)kb * 64 * 1792 + n0; d.ldw = 1792; d.dst = (bf16_t*)(F.ws + WS_WINAB) + (size_t)d0 * 1024 + kb * 64; d.ldt = 1024; return d; } r -= TN_AB;
    if (r < TN_OAB) { const int kb = r / 32, nb = r % 32; d.src = F.in[I_WOUTAB] + (size_t)kb * 64 * 1024 + nb * 32; d.ldw = 1024; d.dst = (bf16_t*)(F.ws + WS_WOUTAB) + (size_t)nb * 32 * 1024 + kb * 64; d.ldt = 1024; return d; } r -= TN_OAB;
    if (r < TN_CD) { const int kb = r / 40, nb = r % 40; d.src = F.in[I_WINCD] + (size_t)kb * 64 * 1280 + nb * 32; d.ldw = 1280; d.dst = (bf16_t*)(F.ws + WS_WINCD) + (size_t)nb * 32 * 1024 + kb * 64; d.ldt = 1024; return d; } r -= TN_CD;
    if (r < TN_OCD) { const int kb = r / 32, nb = r % 32; d.src = F.in[I_WOUTCD] + (size_t)kb * 64 * 1024 + nb * 32; d.ldw = 1024; d.dst = (bf16_t*)(F.ws + WS_WOUTCD) + (size_t)nb * 32 * 1024 + kb * 64; d.ldt = 1024; return d; } r -= TN_OCD;
    if (r < TN_G + TN_U) { const bool up = r >= TN_G; if (up) r -= TN_G; const int le = r >> 8, q = r & 255, kb = q >> 4, nb = q & 15, n0 = nb * 32;
        const int d0 = (n0 >> 7) * 256 + (up ? 128 : 0) + (n0 & 127);
        d.src = F.in[up ? I_EXU : I_EXG] + (size_t)le * 1024 * 512 + (size_t)kb * 64 * 512 + n0; d.ldw = 512; d.dst = (bf16_t*)(F.ws + WS_WGU) + (size_t)le * 1024 * 1024 + (size_t)d0 * 1024 + kb * 64; d.ldt = 1024; return d; } r -= TN_G + TN_U;
    { const int le = r >> 8, q = r & 255, kb = q >> 5, nb = q & 31;
        d.src = F.in[I_EXD] + (size_t)le * 512 * 1024 + (size_t)kb * 64 * 1024 + nb * 32; d.ldw = 1024; d.dst = (bf16_t*)(F.ws + WS_WD) + (size_t)le * 1024 * 512 + (size_t)nb * 32 * 512 + kb * 64; d.ldt = 512; return d; }
}
__device__ __forceinline__ void p0_prologue(const Frame& F) {
    for (int it = F.vcu; it < 192; it += F.G) p0_mod_item(F, it);
    const int gw = F.vcu * NWAVES + F.wave, NGW = F.G * NWAVES;
    const int gt = gw * 64 + F.lane, NGT = NGW * 64;
    { float* rc = (float*)(F.ws + WS_ROPE); float* rs = rc + SEQ * 32;
      for (int i = gt; i < SEQ * 32; i += NGT) { const int s = i >> 5, d = i & 31, f = d & 15; const float pos = (float)(d < 16 ? (s >> 6) : (s & 63));
          const float inv = exp2f(-(float)f * (13.287712379549449f / 16.f)); const float a = pos * inv; rc[i] = cosf(a); rs[i] = sinf(a); } }
    { bf16_t* WT = (bf16_t*)(F.ws + WS_WOUTCD); const float* pw = F.in[I_POOLW]; const float* ps = F.in[I_POOLS]; const float* wo = F.in[I_WOUTCD];
      for (int i = gt; i < 512 * 1024; i += NGT) { const int kk = i >> 10, d = i & 1023, g = kk >> 7; float s = 0.f;
          const float* pwr = pw + (size_t)kk * 128; const float* psr = ps + g * 128; const float* wor = wo + (size_t)(512 + g * 128) * 1024 + d;
#pragma unroll 8
          for (int dp = 0; dp < 128; ++dp) s += pwr[dp] * psr[dp] * wor[(size_t)dp * 1024];
          WT[(size_t)d * 1024 + 512 + kk] = (bf16_t)(pk2(s, 0.f) & 0xffffu); } }
    { bf16_t* WR = (bf16_t*)(F.ws + WS_WR);
      for (int i = gt; i < 2 * 32 * 144 * 8; i += NGT) { const int j = i & 7, e16 = (i >> 3) % 144, s_ = (i / (8 * 144)) & 31, l = i / (8 * 144 * 32);
          int col; bool grp = false; int c;
          if (e16 < 128) { const int lane_ = e16 & 63, row = lane_ & 15; c = lane_ >> 4; col = 8 * (row >> 2) + (e16 < 64 ? 0 : 4) + (row & 3); }
          else { const int q = e16 - 128; c = q & 3; col = q >> 2; grp = true; }
          const int k = 32 * s_ + 8 * c + j;
          const float w = grp ? F.in[I_RGW][(size_t)l * 4096 + k * 4 + col] : F.in[I_REW][(size_t)l * 32768 + k * 32 + col];
          const unsigned hi = pk2(w, 0.f) & 0xffffu; const unsigned lo = pk2(w - bflo(hi), 0.f) & 0xffffu;
          const size_t o = (size_t)s_ * 1152 + (size_t)e16 * 8 + j;
          WR[(size_t)(l * 2 + 0) * 36864 + o] = (bf16_t)hi; WR[(size_t)(l * 2 + 1) * 36864 + o] = (bf16_t)lo; } }
    LAS float* scr = (LAS float*)(F.lds + F.wave * 8448);
    f32x4 va[8], vb[8]; TDesc da, db;
    if (gw < TN_ITEMS) { da = t_decode(F, gw); t_load(da, va, F.lane); }
    for (int it = gw; it < TN_ITEMS; it += 2 * NGW) {
        const int it2 = it + NGW, it3 = it + 2 * NGW;
        if (it2 < TN_ITEMS) { db = t_decode(F, it2); t_load(db, vb, F.lane); }
        t_finish(da, va, scr, F.lane);
        if (it3 < TN_ITEMS) { da = t_decode(F, it3); t_load(da, va, F.lane); }
        if (it2 < TN_ITEMS) t_finish(db, vb, scr, F.lane);
    }
}

__device__ __forceinline__ void norm_mod_row(const float* xrow, const float* g, const float* sh, const float* sc, int lane, f32x4 (&h)[4]) {
    f32x4 v[4]; float ss = 0.f;
#pragma unroll
    for (int j = 0; j < 4; ++j) { v[j] = *(const f32x4*)(xrow + 4 * lane + 256 * j); ss += (v[j][0] * v[j][0] + v[j][1] * v[j][1]) + (v[j][2] * v[j][2] + v[j][3] * v[j][3]); }
    const float rms = 1.0f / sqrtf(wave_sum(ss) * (1.f / 1024.f) + EPS);
#pragma unroll
    for (int j = 0; j < 4; ++j) { const int c = 4 * lane + 256 * j; const f32x4 gg = *(const f32x4*)(g + c), s1 = *(const f32x4*)(sc + c), s0 = *(const f32x4*)(sh + c);
        h[j] = (v[j] * rms * gg) * (1.f + s1) + s0; }
}
__device__ __forceinline__ void store_row_bf16(bf16_t* orow, int lane, const f32x4 (&h)[4]) {
#pragma unroll
    for (int j = 0; j < 4; ++j) { u32x2 o; o.x = pk2(h[j][0], h[j][1]); o.y = pk2(h[j][2], h[j][3]); *(u32x2*)(orow + 4 * lane + 256 * j) = o; }
}
struct RowBuf { f32x4 v[4]; };
__device__ __forceinline__ void row_load(RowBuf& b, const float* xrow, int lane) {
#pragma unroll
    for (int j = 0; j < 4; ++j) b.v[j] = *(const f32x4*)(xrow + 4 * lane + 256 * j);
}
__device__ __forceinline__ void row_norm_store(const RowBuf& b, const float* g, const float* sh, const float* sc, bf16_t* orow, int lane) {
    float ss = 0.f;
#pragma unroll
    for (int j = 0; j < 4; ++j) ss += (b.v[j][0] * b.v[j][0] + b.v[j][1] * b.v[j][1]) + (b.v[j][2] * b.v[j][2] + b.v[j][3] * b.v[j][3]);
    const float rms = 1.0f / sqrtf(wave_sum(ss) * (1.f / 1024.f) + EPS);
    f32x4 h[4];
#pragma unroll
    for (int j = 0; j < 4; ++j) { const int c = 4 * lane + 256 * j; h[j] = (b.v[j] * rms * *(const f32x4*)(g + c)) * (1.f + *(const f32x4*)(sc + c)) + *(const f32x4*)(sh + c); }
    store_row_bf16(orow, lane, h);
}
__device__ __forceinline__ void p_norm1_l0(const Frame& F) {
    const int gw = F.vcu * NWAVES + F.wave, NGW = F.G * NWAVES;
    { float* GP = (float*)(F.ws + WS_GP);
      for (int i = gw * 64 + F.lane; i < 2 * 9 * 1024; i += NGW * 64) { const int k = i & 1023, lr = i >> 10; GP[i] = F.in[I_LN2][(lr / 9) * 1024 + k] * (1.f + F.mod(lr / 9, lr % 9, 4)[k]); } }
    bf16_t* HX = (bf16_t*)(F.ws + WS_HX);
    RowBuf A, B;
    if (gw < TT) row_load(A, F.xin_row(gw), F.lane);
    for (int row = gw; row < TT; row += 2 * NGW) {
        const int row2 = row + NGW, row3 = row + 2 * NGW;
        if (row2 < TT) row_load(B, F.xin_row(row2), F.lane);
        { const int r = modrow(row); row_norm_store(A, F.in[I_LN1], F.mod(0, r, 0), F.mod(0, r, 1), HX + (size_t)row * DM, F.lane); }
        if (row3 < TT) row_load(A, F.xin_row(row3), F.lane);
        if (row2 < TT) { const int r = modrow(row2); row_norm_store(B, F.in[I_LN1], F.mod(0, r, 0), F.mod(0, r, 1), HX + (size_t)row2 * DM, F.lane); }
    }
}

struct Unit { int pm, pn, e; };
struct SchedDense {
    const bf16_t* Bt; int K, nMa, nN, nMb, pnb, vcu, G;
    __device__ __forceinline__ bool next(int i, Unit& u) const { int L = i * G + vcu; const int na = nMa * nN; u.e = 0;
        if (L < na) { u.pm = L / nN; u.pn = L % nN; return true; } L -= na; if (L < nMb) { u.pm = nMa + L; u.pn = pnb; return true; } return false; }
    __device__ __forceinline__ int arow(const Unit& u, int r) const { return u.pm * 256 + r; }
    __device__ __forceinline__ const bf16_t* bbase(const Unit& u) const { return Bt + (size_t)u.pn * 256 * K; }
};
struct MoeTab { const LAS int* tile_e; const LAS int* tile0; const LAS int* cnt; int ntiles; };
struct SchedMoe {
    const bf16_t* Wt; size_t estride; int K; MoeTab tb; const unsigned* list; bool gather; int vcu, G;
    __device__ __forceinline__ bool next(int i, Unit& u) const { const int L = i * G + vcu; if (L >= tb.ntiles * 4) return false; u.pm = L >> 2; u.pn = L & 3; u.e = tb.tile_e[u.pm]; return true; }
    __device__ __forceinline__ int arow(const Unit& u, int r) const {
        if (!gather) return u.pm * 256 + r;
        int idx = (u.pm - tb.tile0[u.e]) * 256 + r; const int c = tb.cnt[u.e]; idx = idx < c ? idx : c - 1;
        return (int)list[(size_t)u.e * TT + idx]; }
    __device__ __forceinline__ const bf16_t* bbase(const Unit& u) const { return Wt + (size_t)u.e * estride + (size_t)u.pn * 256 * K; }
};
__device__ __forceinline__ MoeTab moe_tables(const Frame& F, int l) {
    LAS int* tile_e = (LAS int*)(F.lds + LDS_TAB); LAS int* tile0 = tile_e + NTILE_MAX; LAS int* cntl = tile0 + 33; LAS int* nt = cntl + 32;
    __syncthreads();
    if (F.tid == 0) { int t = 0; unsigned* cg = F.cnt(l);
        for (int e = 0; e < NE; ++e) { const int c = (int)__hip_atomic_load(cg + e * 64, __ATOMIC_RELAXED, __HIP_MEMORY_SCOPE_AGENT); const int n = (c + 255) >> 8; tile0[e] = t; cntl[e] = c;
            for (int j = 0; j < n; ++j) tile_e[t + j] = e; t += n; }
        tile0[32] = t; nt[0] = t; }
    __syncthreads();
    MoeTab tb; tb.tile_e = tile_e; tb.tile0 = tile0; tb.cnt = cntl; tb.ntiles = nt[0]; return tb;
}

template <class Sched, class Epi>
__device__ __forceinline__ void gemm_simple(const Frame& F, const bf16_t* A, int K, const Sched& S, const Epi& E) {
    const int wr = F.wave >> 2, wc = F.wave & 3, fr = F.lane & 15, fq = F.lane >> 4;
    Unit u;
    for (int i = 0; S.next(i, u); ++i) {
        f32x4 acc[2][2][4][2];
#pragma unroll
        for (int a = 0; a < 2; ++a)
#pragma unroll
            for (int b = 0; b < 2; ++b)
#pragma unroll
                for (int m = 0; m < 4; ++m)
#pragma unroll
                    for (int n = 0; n < 2; ++n) acc[a][b][m][n] = (f32x4){0.f, 0.f, 0.f, 0.f};
        unsigned aoff[2][4], boff[2][2];
#pragma unroll
        for (int a = 0; a < 2; ++a)
#pragma unroll
            for (int m = 0; m < 4; ++m) aoff[a][m] = (unsigned)S.arow(u, 128 * a + 64 * wr + 16 * m + fr) * (unsigned)K + 8u * fq;
        const bf16_t* bb = S.bbase(u);
#pragma unroll
        for (int b = 0; b < 2; ++b)
#pragma unroll
            for (int n = 0; n < 2; ++n) boff[b][n] = (unsigned)(128 * b + 32 * wc + 8 * (fr >> 2) + 4 * n + (fr & 3)) * (unsigned)K + 8u * fq;
#pragma unroll 1
        for (int k0 = 0; k0 < K; k0 += 32) {
            bf16x8 bf[2][2];
#pragma unroll
            for (int b = 0; b < 2; ++b)
#pragma unroll
                for (int n = 0; n < 2; ++n) bf[b][n] = *(const bf16x8*)(bb + boff[b][n] + k0);
#pragma unroll
            for (int a = 0; a < 2; ++a) {
                bf16x8 af[4];
#pragma unroll
                for (int m = 0; m < 4; ++m) af[m] = *(const bf16x8*)(A + aoff[a][m] + k0);
#pragma unroll
                for (int b = 0; b < 2; ++b)
#pragma unroll
                    for (int m = 0; m < 4; ++m)
#pragma unroll
                        for (int n = 0; n < 2; ++n) acc[a][b][m][n] = __builtin_amdgcn_mfma_f32_16x16x32_bf16(bf[b][n], af[m], acc[a][b][m][n], 0, 0, 0);
            }
        }
        E(acc, u, wr, wc, fr, fq);
    }
}

namespace pg8 {
constexpr int BM = 256, BK = 64, HALF = 128, HTB = HALF * BK * 2;
__device__ __forceinline__ int lds_byte(int r, int c) { const int st = (r >> 4) * 2 + (c >> 5), rr = r & 15, cc = c & 31, ob = rr * 64 + cc * 2; return st * 1024 + (ob ^ (((ob >> 9) & 1) << 5)); }
__device__ __forceinline__ void stage_rc(int b, int& R, int& C) { const int st = b / 1024, sb = b % 1024, swz = sb ^ (((sb >> 9) & 1) << 5); R = (st >> 1) * 16 + swz / 64; C = (st & 1) * 32 + (swz % 64) / 2; }
__device__ __forceinline__ int perm32(int rho) { const int n = rho >> 4, i = rho & 15; return 8 * (i >> 2) + 4 * n + (i & 3); }
}
template <class Sched, class Epi>
__device__ __forceinline__ void gemm_fast(const Frame& F, const bf16_t* A, int K, const Sched& S, const Epi& E) {
    using namespace pg8;
    LAS unsigned char* lds = F.lds;
    const int tid = F.tid, wid = F.wave, lane = F.lane, wr = wid >> 2, wc = wid & 3, fr = lane & 15, fq = lane >> 4;
    const int nt = K / BK;
    int RA[2], CA[2]; unsigned voffB[2];
#pragma unroll
    for (int i = 0; i < 2; ++i) { int R, C; stage_rc(tid * 16 + i * 8192, R, C); RA[i] = R; CA[i] = C; const int Rb = (R & ~31) + perm32(R & 31); voffB[i] = (unsigned)(Rb * K + C) * 2u; }
    const size_t kstep = (size_t)(BK * 2);
    const size_t hstep = (size_t)HALF * K * 2;
    const unsigned ldsw = (unsigned)wid * 1024u;
    const int aoff = lds_byte(wr * 64 + fr, fq * 8), boff = lds_byte(wc * 32 + fr, fq * 8);
    const char* Ab = (const char*)A;
#define PG8_SA(b, h) (((b) * 2 + (h)) * HTB)
#define PG8_SB(b, h) ((4 + (b) * 2 + (h)) * HTB)
#define PG8_STAGE(bufoff, gbase, voff) do { _Pragma("unroll") for (int _i = 0; _i < 2; ++_i) \
        __builtin_amdgcn_global_load_lds((const unsigned*)((const char*)(gbase) + (voff)[_i]), (LAS unsigned*)(lds + (bufoff) + ldsw + _i * 8192), 16, 0, 0); } while (0)
#define PG8_LDA(dst, b, h) do { _Pragma("unroll") for (int m = 0; m < 4; ++m) _Pragma("unroll") for (int k = 0; k < 2; ++k) dst[m][k] = *(const LAS bf16x8*)(lds + PG8_SA(b, h) + aoff + m * 2048 + k * 1024); } while (0)
#define PG8_LDB(dst, b, h) do { _Pragma("unroll") for (int n = 0; n < 2; ++n) _Pragma("unroll") for (int k = 0; k < 2; ++k) dst[n][k] = *(const LAS bf16x8*)(lds + PG8_SB(b, h) + boff + n * 2048 + k * 1024); } while (0)
#define PG8_MMA(ai, bj, At, Bt) do { __builtin_amdgcn_s_setprio(1); _Pragma("unroll") for (int m = 0; m < 4; ++m) _Pragma("unroll") for (int n = 0; n < 2; ++n) _Pragma("unroll") for (int k = 0; k < 2; ++k) \
        acc[ai][bj][m][n] = __builtin_amdgcn_mfma_f32_16x16x32_bf16(Bt[n][k], At[m][k], acc[ai][bj][m][n], 0, 0, 0); __builtin_amdgcn_s_setprio(0); } while (0)
#define PG8_WAIT_V(n) asm volatile("s_waitcnt vmcnt(" #n ")" ::: "memory")
#define PG8_WAIT_L(n) asm volatile("s_waitcnt lgkmcnt(" #n ")" ::: "memory")
#define PG8_BAR __builtin_amdgcn_s_barrier()
#define PG8_SCHED __builtin_amdgcn_sched_barrier(0)
#define PG8_VOFF(dst, u) do { _Pragma("unroll") for (int _h = 0; _h < 2; ++_h) _Pragma("unroll") for (int _i = 0; _i < 2; ++_i) \
        dst[_h][_i] = (unsigned)S.arow(u, 128 * _h + RA[_i]) * (unsigned)(K * 2) + (unsigned)(CA[_i] * 2); } while (0)
    Unit cur, nxt; int ui = 0;
    if (!S.next(0, cur)) return;
    f32x4 acc[2][2][4][2];
#pragma unroll
    for (int a = 0; a < 2; ++a)
#pragma unroll
        for (int b = 0; b < 2; ++b)
#pragma unroll
            for (int m = 0; m < 4; ++m)
#pragma unroll
                for (int n = 0; n < 2; ++n) acc[a][b][m][n] = (f32x4){0.f, 0.f, 0.f, 0.f};
    bf16x8 At[4][2], B0[2][2], B1[2][2];
    unsigned vC[2][2], vN[2][2];
    PG8_VOFF(vC, cur);
    const char* cB = (const char*)S.bbase(cur);
    PG8_STAGE(PG8_SB(0, 0), cB, voffB); PG8_STAGE(PG8_SB(0, 1), cB + hstep, voffB); PG8_STAGE(PG8_SA(0, 0), Ab, vC[0]); PG8_STAGE(PG8_SA(0, 1), Ab, vC[1]);
    if (wr == 1) PG8_BAR;
    PG8_WAIT_V(2); PG8_BAR;
    PG8_STAGE(PG8_SB(1, 0), cB + kstep, voffB); PG8_STAGE(PG8_SA(1, 0), Ab + kstep, vC[0]); PG8_STAGE(PG8_SB(1, 1), cB + hstep + kstep, voffB);
    PG8_WAIT_V(6); PG8_BAR;
    for (;;) {
        const bool has_next = S.next(ui + 1, nxt);
        const char* nB = cB;
        if (has_next) { PG8_VOFF(vN, nxt); nB = (const char*)S.bbase(nxt); }
        else {
#pragma unroll
            for (int h = 0; h < 2; ++h)
#pragma unroll
                for (int i = 0; i < 2; ++i) vN[h][i] = vC[h][i]; }
        for (int t = 0; t < nt; t += 2) {
            const bool last = (t == nt - 2);
            const char* a1 = Ab + (size_t)(t + 1) * kstep;
            const char* a2 = last ? Ab : Ab + (size_t)(t + 2) * kstep; const char* b2 = last ? nB : cB + (size_t)(t + 2) * kstep;
            const char* a3 = a2 + kstep; const char* b3 = b2 + kstep;
            unsigned v2[2][2];
#pragma unroll
            for (int h = 0; h < 2; ++h)
#pragma unroll
                for (int i = 0; i < 2; ++i) v2[h][i] = last ? vN[h][i] : vC[h][i];
            PG8_LDB(B0, 0, 0); PG8_LDB(B1, 0, 1); PG8_SCHED; PG8_LDA(At, 0, 0); PG8_STAGE(PG8_SA(1, 1), a1, vC[1]);
            PG8_WAIT_V(8); PG8_WAIT_L(0); PG8_BAR; PG8_MMA(0, 0, At, B0); PG8_MMA(0, 1, At, B1); PG8_BAR; PG8_SCHED;
            PG8_LDA(At, 0, 1); PG8_STAGE(PG8_SB(0, 0), b2, voffB); PG8_STAGE(PG8_SB(0, 1), b2 + hstep, voffB); PG8_STAGE(PG8_SA(0, 0), a2, v2[0]);
            PG8_WAIT_V(8); PG8_WAIT_L(0); PG8_BAR; PG8_MMA(1, 0, At, B0); PG8_MMA(1, 1, At, B1); PG8_BAR; PG8_SCHED;
            PG8_LDB(B0, 1, 0); PG8_LDB(B1, 1, 1); PG8_SCHED; PG8_LDA(At, 1, 0); PG8_STAGE(PG8_SA(0, 1), a2, v2[1]);
            PG8_WAIT_V(8); PG8_WAIT_L(0); PG8_BAR; PG8_MMA(0, 0, At, B0); PG8_MMA(0, 1, At, B1); PG8_BAR; PG8_SCHED;
            PG8_LDA(At, 1, 1); PG8_STAGE(PG8_SB(1, 0), b3, voffB); PG8_STAGE(PG8_SB(1, 1), b3 + hstep, voffB); PG8_STAGE(PG8_SA(1, 0), a3, v2[0]);
            PG8_WAIT_V(8); PG8_WAIT_L(0); PG8_BAR; PG8_MMA(1, 0, At, B0); PG8_MMA(1, 1, At, B1); PG8_BAR; PG8_SCHED;
        }
        if (wr == 0) PG8_BAR;
        E(acc, cur, wr, wc, fr, fq);
        if (!has_next) break;
#pragma unroll
        for (int a = 0; a < 2; ++a)
#pragma unroll
            for (int b = 0; b < 2; ++b)
#pragma unroll
                for (int m = 0; m < 4; ++m)
#pragma unroll
                    for (int n = 0; n < 2; ++n) acc[a][b][m][n] = (f32x4){0.f, 0.f, 0.f, 0.f};
        cur = nxt; cB = nB; ++ui;
#pragma unroll
        for (int h = 0; h < 2; ++h)
#pragma unroll
            for (int i = 0; i < 2; ++i) vC[h][i] = vN[h][i];
        if (wr == 1) PG8_BAR;
    }
    PG8_WAIT_V(0);
    PG8_BAR;
#undef PG8_SA
#undef PG8_SB
#undef PG8_STAGE
#undef PG8_LDA
#undef PG8_LDB
#undef PG8_MMA
#undef PG8_WAIT_V
#undef PG8_WAIT_L
#undef PG8_BAR
#undef PG8_SCHED
#undef PG8_VOFF
}
#ifndef GEMM_SIMPLE
#define GEMM gemm_fast
#else
#define GEMM gemm_simple
#endif

__device__ __forceinline__ u32x4 pack8(const f32x4& a, const f32x4& b) { u32x4 w; w.x = pk2(a[0], a[1]); w.y = pk2(a[2], a[3]); w.z = pk2(b[0], b[1]); w.w = pk2(b[2], b[3]); return w; }
template <bool GLU> struct EpiInProj {
    bf16_t* Q; bf16_t* KR; bf16_t* Vn; bf16_t* Gb;
    __device__ __forceinline__ void operator()(const f32x4 (&acc)[2][2][4][2], const Unit& u, int wr, int wc, int fr, int fq) const {
#pragma unroll
        for (int ai = 0; ai < 2; ++ai)
#pragma unroll
            for (int m = 0; m < 4; ++m) { const int irow = u.pm * 256 + 128 * ai + 64 * wr + 16 * m + fr; const size_t row = (size_t)irow; const int cl = 32 * wc + 8 * fq;
                if (u.pn < 2) { *(u32x4*)(Q + row * 512 + u.pn * 256 + cl) = pack8(acc[ai][0][m][0], acc[ai][0][m][1]); *(u32x4*)(Q + row * 512 + u.pn * 256 + 128 + cl) = pack8(acc[ai][1][m][0], acc[ai][1][m][1]); }
                else if (u.pn == 2) { const size_t kvrow = irow < TX ? (size_t)(irow >> 12) * KVS + CTXL + (irow & 4095) : (size_t)((irow - TX) >> 8) * KVS + ((irow - TX) & 255);
                    *(u32x4*)(KR + kvrow * 128 + cl) = pack8(acc[ai][0][m][0], acc[ai][0][m][1]); *(u32x4*)(Vn + kvrow * 128 + cl) = pack8(acc[ai][1][m][0], acc[ai][1][m][1]); }
                else if (GLU) { f32x4 g0, g1;
#pragma unroll
                    for (int j = 0; j < 4; ++j) { g0[j] = acc[ai][0][m][0][j] * sigmoidf_(acc[ai][1][m][0][j]); g1[j] = acc[ai][0][m][1][j] * sigmoidf_(acc[ai][1][m][1][j]); }
                    *(u32x4*)(Gb + row * 512 + (u.pn - 3) * 128 + cl) = pack8(g0, g1); }
                else { *(u32x4*)(Gb + row * 512 + (u.pn - 3) * 256 + cl) = pack8(acc[ai][0][m][0], acc[ai][0][m][1]); *(u32x4*)(Gb + row * 512 + (u.pn - 3) * 256 + 128 + cl) = pack8(acc[ai][1][m][0], acc[ai][1][m][1]); }
            }
    }
};
template <bool L0, bool DRY = false> struct EpiOutProj {
    Frame F; int l;
    __device__ __forceinline__ void operator()(const f32x4 (&acc)[2][2][4][2], const Unit& u, int wr, int wc, int fr, int fq) const {
        float* SS = (float*)(F.ws + WS_SS);
#pragma unroll
        for (int ai = 0; ai < 2; ++ai)
#pragma unroll
            for (int m = 0; m < 4; ++m) { const int row = u.pm * 256 + 128 * ai + 64 * wr + 16 * m + fr; const float* g1 = F.mod(l, modrow(row), 2);
                const float* src = L0 ? F.xin_row(row) : F.xr_row(row); float* dst = F.xr_row(row); float q = 0.f;
#pragma unroll
                for (int bj = 0; bj < 2; ++bj)
#pragma unroll
                    for (int n = 0; n < 2; ++n) { const int c = u.pn * 256 + 128 * bj + 32 * wc + 8 * fq + 4 * n;
                        const f32x4 xv = *(const f32x4*)(src + c), gv = *(const f32x4*)(g1 + c); const f32x4 v = xv + gv * acc[ai][bj][m][n]; *(f32x4*)(dst + c) = DRY ? xv : v;
                        q += (v[0] * v[0] + v[1] * v[1]) + (v[2] * v[2] + v[3] * v[3]); }
                q += __shfl_xor(q, 16); q += __shfl_xor(q, 32);
                if (fq == 0) SS[(size_t)row * 16 + u.pn * 4 + wc] = q; }
    }
};
struct EpiMoe1 {
    bf16_t* HID;
    __device__ __forceinline__ void operator()(const f32x4 (&acc)[2][2][4][2], const Unit& u, int wr, int wc, int fr, int fq) const {
#pragma unroll
        for (int ai = 0; ai < 2; ++ai)
#pragma unroll
            for (int m = 0; m < 4; ++m) { const size_t slot = (size_t)u.pm * 256 + 128 * ai + 64 * wr + 16 * m + fr; f32x4 h0, h1;
#pragma unroll
                for (int j = 0; j < 4; ++j) { const float a = acc[ai][0][m][0][j], b = acc[ai][0][m][1][j]; h0[j] = a * sigmoidf_(a) * acc[ai][1][m][0][j]; h1[j] = b * sigmoidf_(b) * acc[ai][1][m][1][j]; }
                *(u32x4*)(HID + slot * 512 + u.pn * 128 + 32 * wc + 8 * fq) = pack8(h0, h1); }
    }
};
struct EpiMoe2 {
    bf16_t* YB;
    __device__ __forceinline__ void operator()(const f32x4 (&acc)[2][2][4][2], const Unit& u, int wr, int wc, int fr, int fq) const {
#pragma unroll
        for (int ai = 0; ai < 2; ++ai)
#pragma unroll
            for (int m = 0; m < 4; ++m) { const size_t slot = (size_t)u.pm * 256 + 128 * ai + 64 * wr + 16 * m + fr;
#pragma unroll
                for (int bj = 0; bj < 2; ++bj) *(u32x4*)(YB + slot * 1024 + u.pn * 256 + 128 * bj + 32 * wc + 8 * fq) = pack8(acc[ai][bj][m][0], acc[ai][bj][m][1]); }
    }
};

__device__ __forceinline__ void p_k_post(const Frame& F, const float* kg) {
    const int gw = F.vcu * NWAVES + F.wave, NGW = F.G * NWAVES, lane = F.lane;
    const bf16_t* KR = (const bf16_t*)(F.ws + WS_KV); bf16_t* Kn = (bf16_t*)(F.ws + WS_KN);
    const float* rc = (const float*)(F.ws + WS_ROPE); const float* rs = rc + SEQ * 32;
    const int c16 = lane & 15, i8 = c16 & 7, dd0 = 8 * (i8 & 3), sub = lane >> 4;
    float gk[8];
#pragma unroll
    for (int j = 0; j < 8; ++j) gk[j] = kg[i8 * 8 + j];
    const float sgn = (i8 < 4) ? -1.f : 1.f;
    for (int it = gw; it < NB * KVS / 16; it += NGW) {
        u32x4 w[4];
#pragma unroll
        for (int q = 0; q < 4; ++q) w[q] = *(const u32x4*)(KR + (size_t)(it * 16 + 4 * q + sub) * 128 + c16 * 8);
#pragma unroll
        for (int q = 0; q < 4; ++q) { const int kvrow = it * 16 + 4 * q + sub, pos = kvrow % KVS;
            float cs[8], sn[8];
#pragma unroll
            for (int j = 0; j < 8; ++j) { cs[j] = 1.f; sn[j] = 0.f; }
            if (pos >= CTXL) { const int sq = pos - CTXL; const f32x4 c0 = *(const f32x4*)(rc + sq * 32 + dd0), c1 = *(const f32x4*)(rc + sq * 32 + dd0 + 4), s0 = *(const f32x4*)(rs + sq * 32 + dd0), s1 = *(const f32x4*)(rs + sq * 32 + dd0 + 4);
#pragma unroll
                for (int j = 0; j < 4; ++j) { cs[j] = c0[j]; cs[4 + j] = c1[j]; sn[j] = s0[j]; sn[4 + j] = s1[j]; } }
            float x[8] = {bflo(w[q].x), bfhi(w[q].x), bflo(w[q].y), bfhi(w[q].y), bflo(w[q].z), bfhi(w[q].z), bflo(w[q].w), bfhi(w[q].w)};
            float ss = 0.f;
#pragma unroll
            for (int j = 0; j < 8; ++j) ss += x[j] * x[j];
            ss += __shfl_xor(ss, 1); ss += __shfl_xor(ss, 2); ss += __shfl_xor(ss, 4);
            const float rms = 1.0f / sqrtf(ss * (1.f / 64.f) + EPS);
            float y[8], o[8];
#pragma unroll
            for (int j = 0; j < 8; ++j) y[j] = x[j] * rms * gk[j];
#pragma unroll
            for (int j = 0; j < 8; ++j) { const float yp = __shfl_xor(y[j], 4); o[j] = y[j] * cs[j] + sgn * yp * sn[j]; }
            u32x4 ow; ow.x = pk2(o[0], o[1]); ow.y = pk2(o[2], o[3]); ow.z = pk2(o[4], o[5]); ow.w = pk2(o[6], o[7]);
            *(u32x4*)(Kn + (size_t)kvrow * 128 + c16 * 8) = ow; }
    }
}
__device__ __forceinline__ void p_conv(const Frame& F) {
    const bf16_t* Gb = (const bf16_t*)(F.ws + WS_G); bf16_t* AO = (bf16_t*)(F.ws + WS_AO);
    LAS bf16_t* gl = (LAS bf16_t*)F.lds;
    LAS float* yl = (LAS float*)(F.lds + 65536);
    const int c = F.tid;
    float w[31];
#pragma unroll
    for (int j = 0; j < 31; ++j) w[j] = F.in[I_CONVW][j * 512 + c];
    const float bias = F.in[I_CONVB][c];
    for (int item = F.vcu; item < 1024 + 64; item += F.G) {
        int rowbase, t0, len;
        if (item < 1024) { rowbase = (item >> 7) * SEQ; t0 = (item & 127) * 32; len = SEQ; } else { const int it = item - 1024; rowbase = TX + (it >> 3) * CTXL; t0 = (it & 7) * 32; len = CTXL; }
        __syncthreads();
        for (int ch = F.tid; ch < 62 * 64; ch += NTHREADS) { const int r = ch >> 6, p = t0 - 15 + r; u32x4 v = (u32x4){0u, 0u, 0u, 0u};
            if (p >= 0 && p < len) v = *(const u32x4*)(Gb + (size_t)(rowbase + p) * 512 + (ch & 63) * 8);
            *(LAS u32x4*)(gl + r * 512 + (ch & 63) * 8) = v; }
        __syncthreads();
        float g[62];
#pragma unroll
        for (int r = 0; r < 62; ++r) g[r] = bf2f(gl[r * 512 + c]);
#pragma unroll
        for (int t = 0; t < 32; ++t) { float y = bias;
#pragma unroll
            for (int j = 0; j < 31; ++j) y += g[t + j] * w[j];
            yl[t * 512 + c] = y; }
        __syncthreads();
#pragma unroll
        for (int tt = 0; tt < 4; ++tt) { const int t = 4 * F.wave + tt; float v[8]; float s = 0.f;
#pragma unroll
            for (int j = 0; j < 8; ++j) { v[j] = yl[t * 512 + F.lane + 64 * j]; s += v[j]; }
            const float mean = wave_sum(s) * (1.f / 512.f); float q = 0.f;
#pragma unroll
            for (int j = 0; j < 8; ++j) { v[j] -= mean; q += v[j] * v[j]; }
            const float rstd = 1.0f / sqrtf(wave_sum(q) * (1.f / 512.f) + EPS);
            bf16_t* orow = AO + (size_t)(rowbase + t0 + t) * 1024 + 512;
#pragma unroll
            for (int j = 0; j < 8; ++j) { const int cc = F.lane + 64 * j; const float yn = v[j] * rstd * F.in[I_CLNG][cc] + F.in[I_CLNB][cc]; orow[cc] = (bf16_t)(pk2(yn * sigmoidf_(yn), 0.f) & 0xffffu); } }
    }
    __syncthreads();
}
__device__ __forceinline__ void p_pool(const Frame& F) {
    const int gw = F.vcu * NWAVES + F.wave, NGW = F.G * NWAVES, lane = F.lane;
    const bf16_t* U = (const bf16_t*)(F.ws + WS_G); bf16_t* AO = (bf16_t*)(F.ws + WS_AO);
    const int hw = 1 << (lane >> 4);
    float wgt[16];
#pragma unroll
    for (int i = 0; i < 16; ++i) wgt[i] = (i >= 8 - hw && i < 8 + hw) ? 1.f : 0.f;
    for (int it = gw; it < TX / 8; it += NGW) {
        const int row0 = it * 8, t0 = row0 & 4095, rb = row0 - t0;
        u32x4 r[23];
#pragma unroll
        for (int j = 0; j < 23; ++j) { const int p = t0 - 8 + j; r[j] = (u32x4){0u, 0u, 0u, 0u}; if (p >= 0 && p < SEQ) r[j] = *(const u32x4*)(U + (size_t)(rb + p) * 512 + lane * 8); }
#pragma unroll
        for (int t = 0; t < 8; ++t) {
            float s[8];
#pragma unroll
            for (int j = 0; j < 8; ++j) s[j] = 0.f;
#pragma unroll
            for (int i = 0; i < 16; ++i) { const u32x4 w = r[t + i]; const float g = wgt[i];
                s[0] += g * bflo(w.x); s[1] += g * bfhi(w.x); s[2] += g * bflo(w.y); s[3] += g * bfhi(w.y); s[4] += g * bflo(w.z); s[5] += g * bfhi(w.z); s[6] += g * bflo(w.w); s[7] += g * bfhi(w.w); }
            const int tt = t0 + t; int lo = tt - hw, hi = tt + hw; lo = lo < 0 ? 0 : lo; hi = hi > SEQ ? SEQ : hi;
            const float inv = 1.f / (float)(hi - lo); const u32x4 w = r[t + 8];
            u32x4 ow; ow.x = pk2(s[0] * inv - bflo(w.x), s[1] * inv - bfhi(w.x)); ow.y = pk2(s[2] * inv - bflo(w.y), s[3] * inv - bfhi(w.y)); ow.z = pk2(s[4] * inv - bflo(w.z), s[5] * inv - bfhi(w.z)); ow.w = pk2(s[6] * inv - bflo(w.w), s[7] * inv - bfhi(w.w));
            *(u32x4*)(AO + (size_t)(row0 + t) * 1024 + 512 + lane * 8) = ow;
        }
    }
}

template <int LAYER> __device__ __forceinline__ void attn_simple(const Frame& F) {
    const bf16_t* Q = (const bf16_t*)(F.ws + WS_Q); const bf16_t* Kn = (const bf16_t*)(F.ws + WS_KN); const bf16_t* Vn = (const bf16_t*)(F.ws + WS_VN); bf16_t* AO = (bf16_t*)(F.ws + WS_AO);
    const int nunits = LAYER == 0 ? 512 + 64 : 512;
    for (int u = F.vcu; u < nunits; u += F.G) {
        int b, h, row, s; bool valid = true, isctx = false;
        if (u < 512) { b = u >> 6; h = (u >> 3) & 7; s = (u & 7) * 512 + F.tid; row = b * SEQ + s; }
        else { const int uc = u - 512; b = uc >> 3; h = uc & 7; s = F.tid; valid = F.tid < 256; row = TX + b * CTXL + (valid ? s : 0); isctx = true; }
        float q[64], o[64];
        { const u32x4* qp = (const u32x4*)(Q + (size_t)row * 512 + h * 64);
#pragma unroll
          for (int c = 0; c < 8; ++c) { const u32x4 w = qp[c]; q[8 * c] = bflo(w.x); q[8 * c + 1] = bfhi(w.x); q[8 * c + 2] = bflo(w.y); q[8 * c + 3] = bfhi(w.y); q[8 * c + 4] = bflo(w.z); q[8 * c + 5] = bfhi(w.z); q[8 * c + 6] = bflo(w.w); q[8 * c + 7] = bfhi(w.w); } }
#pragma unroll
        for (int d = 0; d < 64; ++d) o[d] = 0.f;
        float mx = -1e30f, l = 0.f;
        const bf16_t* Kb = Kn + (size_t)b * KVS * 128 + (h >> 2) * 64; const bf16_t* Vb = Vn + (size_t)b * KVS * 128 + (h >> 2) * 64;
        int k_lo2 = 0, k_hi2 = 0;
        const int k_hi1 = CTXL;
        if (LAYER == 0) { if (!isctx) { k_lo2 = CTXL; k_hi2 = KVS; } }
        else { const int s0 = (u & 7) * 512; int lo = s0 - 128, hi = s0 + 511 + 128 + 1; lo = lo < 0 ? 0 : lo; hi = hi > SEQ ? SEQ : hi; k_lo2 = CTXL + lo; k_hi2 = CTXL + hi; }
        for (int part = 0; part < 2; ++part) {
            const int kb = part == 0 ? 0 : k_lo2, ke = part == 0 ? k_hi1 : k_hi2;
            for (int key = kb; key < ke; ++key) {
                const u32x4* kp = (const u32x4*)(Kb + (size_t)key * 128); float sd = 0.f;
#pragma unroll
                for (int c = 0; c < 8; ++c) { const u32x4 w = kp[c];
                    sd += q[8 * c] * bflo(w.x) + q[8 * c + 1] * bfhi(w.x) + q[8 * c + 2] * bflo(w.y) + q[8 * c + 3] * bfhi(w.y) + q[8 * c + 4] * bflo(w.z) + q[8 * c + 5] * bfhi(w.z) + q[8 * c + 6] * bflo(w.w) + q[8 * c + 7] * bfhi(w.w); }
                bool use = valid;
                if (LAYER == 1 && part == 1) { const int j = key - CTXL; const int dlt = s - j; use = use && (dlt <= 128 && dlt >= -128); }
                const float mn = fmaxf(mx, sd); const float mnew = use ? mn : mx;
                const float alpha = exp2f(mx - mnew), p = use ? exp2f(sd - mnew) : 0.f;
                mx = mnew; l = l * alpha + p;
                const u32x4* vp = (const u32x4*)(Vb + (size_t)key * 128);
#pragma unroll
                for (int c = 0; c < 8; ++c) { const u32x4 w = vp[c];
                    o[8 * c] = o[8 * c] * alpha + p * bflo(w.x); o[8 * c + 1] = o[8 * c + 1] * alpha + p * bfhi(w.x); o[8 * c + 2] = o[8 * c + 2] * alpha + p * bflo(w.y); o[8 * c + 3] = o[8 * c + 3] * alpha + p * bfhi(w.y);
                    o[8 * c + 4] = o[8 * c + 4] * alpha + p * bflo(w.z); o[8 * c + 5] = o[8 * c + 5] * alpha + p * bfhi(w.z); o[8 * c + 6] = o[8 * c + 6] * alpha + p * bflo(w.w); o[8 * c + 7] = o[8 * c + 7] * alpha + p * bfhi(w.w); }
            }
        }
        if (LAYER == 1) l += exp2f(F.in[I_SINK][h] * LOG2E - mx);
        const float il = 1.f / l;
        if (valid) { u32x4* op = (u32x4*)(AO + (size_t)row * 1024 + h * 64);
#pragma unroll
            for (int c = 0; c < 8; ++c) { u32x4 w; w.x = pk2(o[8 * c] * il, o[8 * c + 1] * il); w.y = pk2(o[8 * c + 2] * il, o[8 * c + 3] * il); w.z = pk2(o[8 * c + 4] * il, o[8 * c + 5] * il); w.w = pk2(o[8 * c + 6] * il, o[8 * c + 7] * il); op[c] = w; } }
    }
}

#include <hip/hip_bf16.h>
namespace attn_body {
using bf16=__hip_bfloat16;
using s16x4=__attribute__((ext_vector_type(4)))short;
using f32x16=__attribute__((ext_vector_type(16)))float;
constexpr int NW=8,QBLK=32,QB=QBLK*NW,KVBLK=64;
constexpr int QP=512,KP=128,OP=1024;
__device__ __forceinline__ int crow(int r,int hi){return (r&3)+8*(r>>2)+4*hi;}
#define SBAR() __builtin_amdgcn_sched_barrier(0)
__device__ __forceinline__ void wmask(f32x16&p0,f32x16&p1,int dlt0,int hi){
  const float NEG=-INFINITY; const int kb=dlt0+4*hi;
  #pragma unroll
  for(int r=0;r<16;++r){const int d=kb+(r&3)+8*(r>>2); if(d>128||d<-128)p0[r]=NEG; if(d+32>128||d+32<-128)p1[r]=NEG;}
}

constexpr int NSLOT=3, SLOTB=8192;
constexpr int LDS_K=0, LDS_V=NSLOT*SLOTB, LDS_WS=2*NSLOT*SLOTB, LDS_OST=LDS_WS+NW*64*4, LDS_BYTES=LDS_OST+NW*4096;
__device__ __forceinline__ void glds16(const void*gsrc,unsigned lds_dst){unsigned keep;
  asm volatile("s_mov_b32 %0, m0\n\ts_mov_b32 m0, %2\n\ts_nop 0\n\tglobal_load_lds_dwordx4 %1, off\n\ts_mov_b32 m0, %0":"=&s"(keep):"v"(gsrc),"s"(lds_dst):"memory");}
__device__ __forceinline__ float max3f(float a,float b,float c){float r;asm("v_max3_f32 %0, %1, %2, %3":"=v"(r):"v"(a),"v"(b),"v"(c));return r;}
__device__ __forceinline__ float max2f(float a,float b){float r;asm("v_max_f32_e32 %0, %1, %2":"=v"(r):"v"(a),"v"(b));return r;}
__device__ __forceinline__ float fadd_s(float a,float b){float r;asm("v_add_f32_e32 %0, %1, %2":"=v"(r):"v"(a),"v"(b));return r;}
__device__ __forceinline__ float fsub_s(float a,float b){float r;asm("v_sub_f32_e32 %0, %1, %2":"=v"(r):"v"(a),"v"(b));return r;}
typedef float f32x2_t __attribute__((ext_vector_type(2))); typedef __bf16 bf16x2_t __attribute__((ext_vector_type(2)));
__device__ __forceinline__ unsigned cvtpk_s(float lo,float hi){f32x2_t v={lo,hi};bf16x2_t b=__builtin_convertvector(v,bf16x2_t);return __builtin_bit_cast(unsigned,b);}
#define WAIT_BAR(N) asm volatile("s_waitcnt vmcnt(" #N ") lgkmcnt(0)\n\ts_barrier":::"memory")

__device__ __forceinline__ void qkt(f32x16&p0,f32x16&p1,const char*Kslot,const bf16x8*qr,const f32x16&negm,int r32,int hi){
  const char*kb=Kslot+hi*1024+r32*16;
  #pragma unroll
  for(int d0=0;d0<4;++d0){
    const bf16x8 b0=*reinterpret_cast<const bf16x8*>(kb+d0*2048);
    const bf16x8 b1=*reinterpret_cast<const bf16x8*>(kb+d0*2048+512);
    if(d0==0){p0=__builtin_amdgcn_mfma_f32_32x32x16_bf16(b0,qr[0],negm,0,0,0);p1=__builtin_amdgcn_mfma_f32_32x32x16_bf16(b1,qr[0],negm,0,0,0);}
    else{p0=__builtin_amdgcn_mfma_f32_32x32x16_bf16(b0,qr[d0],p0,0,0,0);p1=__builtin_amdgcn_mfma_f32_32x32x16_bf16(b1,qr[d0],p1,0,0,0);}}
}
typedef __attribute__((address_space(3))) const char* lds_cptr;
typedef short v4i16_t __attribute__((ext_vector_type(4)));
__device__ __forceinline__ void kload8(bf16x8*kf,lds_cptr kp){
  kf[0]=*(const __attribute__((address_space(3))) bf16x8*)(kp);      kf[1]=*(const __attribute__((address_space(3))) bf16x8*)(kp+512);
  kf[2]=*(const __attribute__((address_space(3))) bf16x8*)(kp+2048); kf[3]=*(const __attribute__((address_space(3))) bf16x8*)(kp+2560);
  kf[4]=*(const __attribute__((address_space(3))) bf16x8*)(kp+4096); kf[5]=*(const __attribute__((address_space(3))) bf16x8*)(kp+4608);
  kf[6]=*(const __attribute__((address_space(3))) bf16x8*)(kp+6144); kf[7]=*(const __attribute__((address_space(3))) bf16x8*)(kp+6656);
}
__device__ __forceinline__ void kload2(bf16x8*kf,lds_cptr kp,int j){ kf[2*j]=*(const __attribute__((address_space(3))) bf16x8*)(kp+j*2048); kf[2*j+1]=*(const __attribute__((address_space(3))) bf16x8*)(kp+j*2048+512); }
__device__ __forceinline__ s16x4 vtr(lds_cptr p){ return __builtin_bit_cast(s16x4,__builtin_amdgcn_ds_read_tr16_b64_v4i16((__attribute__((address_space(3))) v4i16_t*)p)); }
__device__ __forceinline__ float rowmax(const f32x16&p0,const f32x16&p1){
  float a=max3f(p0[0],p0[1],p1[0]),b=max3f(p0[2],p0[3],p1[1]);a=max3f(a,p1[2],p1[3]);
  #pragma unroll
  for(int r=4;r<16;r+=4){a=max3f(a,p0[r],p0[r+1]);b=max3f(b,p0[r+2],p0[r+3]);a=max3f(a,p1[r],p1[r+1]);b=max3f(b,p1[r+2],p1[r+3]);}
  const float m=max2f(a,b);
  auto rr=__builtin_amdgcn_permlane32_swap(__float_as_uint(m),__float_as_uint(m),false,false);
  return max2f(__uint_as_float(rr[0]),__uint_as_float(rr[1]));
}
__device__ __forceinline__ void pv(f32x16*o,int vb,bf16x8 pa0,bf16x8 pa1,bf16x8 pa2,bf16x8 pa3){
  #pragma unroll
  for(int d0=0;d0<2;++d0){s16x4 lo[4],hi[4];
    #pragma unroll
    for(int ks=0;ks<4;++ks){
      asm volatile("ds_read_b64_tr_b16 %0,%1 offset:%c2":"=&v"(lo[ks]):"v"(vb),"i"(d0*4096+ks*1024):"memory");
      asm volatile("ds_read_b64_tr_b16 %0,%1 offset:%c2":"=&v"(hi[ks]):"v"(vb),"i"(d0*4096+ks*1024+512):"memory");}
    asm volatile("s_waitcnt lgkmcnt(0)":::"memory");SBAR();
    #define PK(k) (bf16x8){lo[k][0],lo[k][1],lo[k][2],lo[k][3],hi[k][0],hi[k][1],hi[k][2],hi[k][3]}
    o[d0]=__builtin_amdgcn_mfma_f32_32x32x16_bf16(pa0,PK(0),o[d0],0,0,0);
    o[d0]=__builtin_amdgcn_mfma_f32_32x32x16_bf16(pa1,PK(1),o[d0],0,0,0);
    o[d0]=__builtin_amdgcn_mfma_f32_32x32x16_bf16(pa2,PK(2),o[d0],0,0,0);
    o[d0]=__builtin_amdgcn_mfma_f32_32x32x16_bf16(pa3,PK(3),o[d0],0,0,0);
    #undef PK
  }
}

#ifndef ATTN_STORE16
#define ATTN_STORE16(p,v) (*(u32x4*)(p)=(v))
#endif
template<int MODE,int THRL> __device__ __forceinline__ void attn_unit(const bf16*Qu,const bf16*__restrict__ Kh,const bf16*__restrict__ Vh,bf16*Ou,const int NT,const int lat0,const int q0s,const float sinkl2,const float*qg,const float*ropec,const bool rope,char*shm){
  const int tid=threadIdx.x,lane=tid&63,r32=lane&31,hi=lane>>5; const int wid=__builtin_amdgcn_readfirstlane(tid>>6);
  const bf16*Qw=Qu+(long)(wid*QBLK)*QP;
  const unsigned lds0=(unsigned)(uintptr_t)shm;
  float*wsf=(float*)(shm+LDS_WS)+wid*64;
  const bf16*ksrc=Kh+(long)lane*KP+wid*8;
  const bf16*vsrc=Vh+(long)(16*(wid&3)+(lane>>2))*KP+(wid>>2)*32+(lane&3)*8;
  const unsigned kdst=lds0+LDS_K+wid*1024, vdst=lds0+LDS_V+wid*1024;
  #define TROW(t) ((MODE==0||(t)<4)?(t)*KVBLK:lat0+((t)-4)*KVBLK)
  #define DMA_K(t,slot) glds16(ksrc+(long)TROW(t)*KP,(unsigned)__builtin_amdgcn_readfirstlane(kdst+(slot)))
  #define DMA_V(t,slot) glds16(vsrc+(long)TROW(t)*KP,(unsigned)__builtin_amdgcn_readfirstlane(vdst+(slot)))
  const int vb0=(int)(lds0+LDS_V)+((lane>>4)&1)*32+(lane&3)*8+(4*hi+((lane&15)>>2))*64;
  const char*Kbase=shm+LDS_K; bf16x8 kf[8];
  const lds_cptr shm3=(lds_cptr)shm; const lds_cptr kp0=shm3+LDS_K+hi*1024+r32*16; const lds_cptr vp0=shm3+LDS_V+((lane>>4)&1)*32+(lane&3)*8+(4*hi+((lane&15)>>2))*64;
  DMA_K(0,0);DMA_V(0,0);DMA_K(1,SLOTB);
  bf16x8 qr[4];
  const int qpos=q0s+wid*QBLK+r32;
  {
    u32x4 qraw[4];
    #pragma unroll
    for(int d0=0;d0<4;++d0) qraw[d0]=*reinterpret_cast<const u32x4*>(&Qw[(long)r32*QP+d0*16+hi*8]);
    float x[4][8]; float ss=0.f;
    #pragma unroll
    for(int d0=0;d0<4;++d0){ x[d0][0]=bflo(qraw[d0].x);x[d0][1]=bfhi(qraw[d0].x);x[d0][2]=bflo(qraw[d0].y);x[d0][3]=bfhi(qraw[d0].y);x[d0][4]=bflo(qraw[d0].z);x[d0][5]=bfhi(qraw[d0].z);x[d0][6]=bflo(qraw[d0].w);x[d0][7]=bfhi(qraw[d0].w);
      #pragma unroll
      for(int j=0;j<8;++j)ss+=x[d0][j]*x[d0][j]; }
    {auto rr=__builtin_amdgcn_permlane32_swap(__float_as_uint(ss),__float_as_uint(ss),false,false);ss=__uint_as_float(rr[0])+__uint_as_float(rr[1]);}
    const float rms=C2/sqrtf(ss*(1.f/64.f)+EPS);
    SBAR();
    #pragma unroll
    for(int d0=0;d0<2;++d0){
      #pragma unroll
      for(int hf=0;hf<2;++hf){
        const f32x4 ga=*reinterpret_cast<const f32x4*>(qg+d0*16+hi*8+4*hf), gb=*reinterpret_cast<const f32x4*>(qg+(d0+2)*16+hi*8+4*hf);
        f32x4 cc=f32x4{1.f,1.f,1.f,1.f}, sn=f32x4{0.f,0.f,0.f,0.f};
        if(rope){ const float*pc=ropec+(long)qpos*32+d0*16+hi*8+4*hf; cc=*reinterpret_cast<const f32x4*>(pc); sn=*reinterpret_cast<const f32x4*>(pc+SEQ*32); }
        #pragma unroll
        for(int j=0;j<4;++j){ const float a=x[d0][4*hf+j]*rms*ga[j], b=x[d0+2][4*hf+j]*rms*gb[j]; x[d0][4*hf+j]=a*cc[j]-b*sn[j]; x[d0+2][4*hf+j]=b*cc[j]+a*sn[j]; }
        SBAR(); } }
    #pragma unroll
    for(int d0=0;d0<4;++d0){ u32x4 w; w.x=cvtpk_s(x[d0][0],x[d0][1]);w.y=cvtpk_s(x[d0][2],x[d0][3]);w.z=cvtpk_s(x[d0][4],x[d0][5]);w.w=cvtpk_s(x[d0][6],x[d0][7]); qr[d0]=__builtin_bit_cast(bf16x8,w); } }
  float mhat=0.f,l_reg=0.f;f32x16 o[2],negm; { float z_=0.f; asm volatile("":"+v"(z_));
    #pragma unroll
    for(int r=0;r<16;++r){o[0][r]=z_;o[1][r]=z_;negm[r]=z_;} } asm volatile("":"+v"(negm));
  #define CMASK(P0,P1,t) do{ if(MODE==1&&(t)>=4) wmask(P0,P1,(lat0-256)+((t)-4)*KVBLK-qpos,hi); }while(0)
  bool resc=false;
  #define START(P0,P1) do{ const float rm=rowmax(P0,P1); resc=false; \
    { const float dl=rm; mhat=fadd_s(mhat,dl); \
      _Pragma("unroll") for(int r=0;r<16;++r){P0[r]=fsub_s(P0[r],dl);P1[r]=fsub_s(P1[r],dl);} \
      _Pragma("unroll") for(int r=0;r<16;++r)negm[r]=-mhat; asm volatile("":"+v"(negm)); } \
    _Pragma("unroll") for(int r=0;r<16;++r)P0[r]=__builtin_amdgcn_exp2f(P0[r]); }while(0)
  #define RESC() do{ if(resc){ asm volatile("s_waitcnt lgkmcnt(0)":::"memory"); \
      _Pragma("unroll") for(int d_=0;d_<2;++d_) _Pragma("unroll") for(int r=0;r<16;++r)o[d_][r]*=wsf[crow(r,hi)]; } }while(0)
  f32x16 pA0,pA1,pB0,pB1;
  int sl_prev=0,sl_cur=0,sl_next=SLOTB;
  #define ROT() do{sl_prev=sl_cur;sl_cur=sl_next;sl_next=(sl_next==(NSLOT-1)*SLOTB)?0:sl_next+SLOTB;}while(0)
  DMA_K(2,2*SLOTB);
  WAIT_BAR(3);
  qkt(pA0,pA1,Kbase,qr,negm,r32,hi);asm volatile("s_nop 15\n\ts_nop 7":"+v"(pA0),"+v"(pA1));CMASK(pA0,pA1,0);
  START(pA0,pA1);
  _Pragma("unroll") for(int r=0;r<16;++r)pA1[r]=__builtin_amdgcn_exp2f(pA1[r]);
  WAIT_BAR(0);
  DMA_K(3,0);DMA_V(1,SLOTB);
  ROT();
  kload8(kf,kp0+sl_cur);
  WAIT_BAR(2);
  s16x4 vlo[8],vhi[8]; u32x4 pw0,pw1,pw2,pw3;
  #define PKW(P,B) cvtpk_s(P[B],P[B+1])
  #define PAF(k) __builtin_bit_cast(bf16x8,pw##k)
  #define VFR(i) (bf16x8){vlo[i][0],vlo[i][1],vlo[i][2],vlo[i][3],vhi[i][0],vhi[i][1],vhi[i][2],vhi[i][3]}
  #define PIN(x) asm volatile("":"+v"(x))
  #define MX3(a,b,c) __builtin_fmaxf(__builtin_fmaxf((a),(b)),(c))
  #define GAPA(MF,A0,A1,A2,A3,W0,W1,PW) do{ MF; sacc+=A0; sacc+=A1; sacc+=A2; sacc+=A3; PIN(sacc); W0; W1; PIN(PW); SBAR(); }while(0)
  #define EX(v) __builtin_amdgcn_exp2f(v)
  #define GAPB(MF,X,B) do{ MF; X[B]=EX(X[B]); X[B+1]=EX(X[B+1]); X[B+2]=EX(X[B+2]); X[B+3]=EX(X[B+3]); PIN(X); SBAR(); }while(0)
  #define VRD(i) do{ vlo[i]=vtr(vp_+(((i)>>2)*4096+((i)&3)*1024)); vhi[i]=vtr(vp_+(((i)>>2)*4096+((i)&3)*1024+512)); }while(0)
  #define KRD(G,j) do{ if(G){ kload2(kf,kp0+sl_next,j); SBAR(); } }while(0)
  #define STEP(C0,C1,P0,P1,t,GK,GV,GL) do{ SBAR(); \
    const lds_cptr vp_=vp0+sl_prev; \
    VRD(0); SBAR(); float sacc=(P0[0]+P0[1]); \
    GAPA(C0=__builtin_amdgcn_mfma_f32_32x32x16_bf16(kf[0],qr[0],negm,0,0,0), P0[2],P0[3],P0[4],P0[5],     pw0[0]=PKW(P0,0), pw0[1]=PKW(P0,2), pw0); \
    VRD(4); SBAR(); GAPA(C1=__builtin_amdgcn_mfma_f32_32x32x16_bf16(kf[1],qr[0],negm,0,0,0), P0[6],P0[7],P0[8],P0[9],     pw0[2]=PKW(P0,4), pw0[3]=PKW(P0,6), pw0); \
    VRD(1); SBAR(); GAPA(C0=__builtin_amdgcn_mfma_f32_32x32x16_bf16(kf[2],qr[1],C0,0,0,0),   P0[10],P0[11],P0[12],P0[13], pw1[0]=PKW(P0,8), pw1[1]=PKW(P0,10), pw1); \
    VRD(5); SBAR(); GAPA(C1=__builtin_amdgcn_mfma_f32_32x32x16_bf16(kf[3],qr[1],C1,0,0,0),   P0[14],P0[15],P1[0],P1[1],   pw1[2]=PKW(P0,12),pw1[3]=PKW(P0,14), pw1); \
    VRD(2); SBAR(); GAPA(C0=__builtin_amdgcn_mfma_f32_32x32x16_bf16(kf[4],qr[2],C0,0,0,0),   P1[2],P1[3],P1[4],P1[5],     pw2[0]=PKW(P1,0), pw2[1]=PKW(P1,2), pw2); \
    VRD(6); SBAR(); GAPA(C1=__builtin_amdgcn_mfma_f32_32x32x16_bf16(kf[5],qr[2],C1,0,0,0),   P1[6],P1[7],P1[8],P1[9],     pw2[2]=PKW(P1,4), pw2[3]=PKW(P1,6), pw2); \
    VRD(3); SBAR(); GAPA(C0=__builtin_amdgcn_mfma_f32_32x32x16_bf16(kf[6],qr[3],C0,0,0,0),   P1[10],P1[11],P1[12],P1[13], pw3[0]=PKW(P1,8), pw3[1]=PKW(P1,10), pw3); \
    VRD(7); SBAR(); GAPA(C1=__builtin_amdgcn_mfma_f32_32x32x16_bf16(kf[7],qr[3],C1,0,0,0),   P1[14],P1[15],0.f,0.f,       pw3[2]=PKW(P1,12),pw3[3]=PKW(P1,14), pw3); \
    l_reg+=sacc; \
    if(GK){DMA_K((t)+3,sl_cur);} if(GV){DMA_V((t)+1,sl_next);} \
    CMASK(C0,C1,t); \
    { float a=MX3(C0[0],C0[1],C1[0]),b=MX3(C0[2],C0[3],C1[1]); a=MX3(a,C1[2],C1[3]); \
      _Pragma("unroll") for(int r=4;r<16;r+=4){a=MX3(a,C0[r],C0[r+1]);b=MX3(b,C0[r+2],C0[r+3]);a=MX3(a,C1[r],C1[r+1]);b=MX3(b,C1[r+2],C1[r+3]);} \
      float rm=__builtin_fmaxf(a,b); { auto rr=__builtin_amdgcn_permlane32_swap(__float_as_uint(rm),__float_as_uint(rm),false,false); rm=__builtin_fmaxf(__uint_as_float(rr[0]),__uint_as_float(rr[1])); } \
      resc=false; \
      if(__builtin_expect(__any(rm>(float)THRL),0)){ const float dl=__builtin_fmaxf(rm,0.f); mhat+=dl; \
        _Pragma("unroll") for(int r=0;r<16;++r){C0[r]-=dl;C1[r]-=dl;} \
        _Pragma("unroll") for(int r=0;r<16;++r)negm[r]=-mhat; asm volatile("":"+v"(negm)); \
        const float f=__builtin_amdgcn_exp2f(-dl); l_reg*=f; if(hi==0)wsf[r32]=f; resc=true; } } \
    SBAR(); \
    GAPB(o[0]=__builtin_amdgcn_mfma_f32_32x32x16_bf16(PAF(0),VFR(0),o[0],0,0,0), C0,0); \
    GAPB(o[1]=__builtin_amdgcn_mfma_f32_32x32x16_bf16(PAF(0),VFR(4),o[1],0,0,0), C0,4); \
    KRD(GL,0); GAPB(o[0]=__builtin_amdgcn_mfma_f32_32x32x16_bf16(PAF(1),VFR(1),o[0],0,0,0), C0,8); \
    KRD(GL,1); GAPB(o[1]=__builtin_amdgcn_mfma_f32_32x32x16_bf16(PAF(1),VFR(5),o[1],0,0,0), C0,12); \
    KRD(GL,2); GAPB(o[0]=__builtin_amdgcn_mfma_f32_32x32x16_bf16(PAF(2),VFR(2),o[0],0,0,0), C1,0); \
    KRD(GL,3); GAPB(o[1]=__builtin_amdgcn_mfma_f32_32x32x16_bf16(PAF(2),VFR(6),o[1],0,0,0), C1,4); \
    GAPB(o[0]=__builtin_amdgcn_mfma_f32_32x32x16_bf16(PAF(3),VFR(3),o[0],0,0,0), C1,8); \
    GAPB(o[1]=__builtin_amdgcn_mfma_f32_32x32x16_bf16(PAF(3),VFR(7),o[1],0,0,0), C1,12); \
    }while(0)
  int t=1;
  for(;t+5<NT;t+=2){
    STEP(pB0,pB1,pA0,pA1,t,true,true,true);     WAIT_BAR(2); RESC(); ROT();
    STEP(pA0,pA1,pB0,pB1,t+1,true,true,true);   WAIT_BAR(2); RESC(); ROT();
  }
  #define ENDW(tt) do{ if((tt)+3<NT){WAIT_BAR(2);} else if((tt)+2<NT){WAIT_BAR(1);} else {WAIT_BAR(0);} }while(0)
  for(;t+1<NT;t+=2){
    STEP(pB0,pB1,pA0,pA1,t,(t+3<NT),(t+1<NT),(t+1<NT));       ENDW(t);   RESC(); ROT();
    STEP(pA0,pA1,pB0,pB1,t+1,(t+4<NT),(t+2<NT),(t+2<NT));     ENDW(t+1); RESC(); ROT();
  }
  STEP(pB0,pB1,pA0,pA1,NT-1,false,false,false); RESC();
  { float sacc=pB0[0]+pB0[1]; _Pragma("unroll") for(int r=2;r<16;++r)sacc+=pB0[r]; _Pragma("unroll") for(int r=0;r<16;++r)sacc+=pB1[r]; l_reg+=sacc;
    pw0=(u32x4){PKW(pB0,0),PKW(pB0,2),PKW(pB0,4),PKW(pB0,6)};pw1=(u32x4){PKW(pB0,8),PKW(pB0,10),PKW(pB0,12),PKW(pB0,14)};pw2=(u32x4){PKW(pB1,0),PKW(pB1,2),PKW(pB1,4),PKW(pB1,6)};pw3=(u32x4){PKW(pB1,8),PKW(pB1,10),PKW(pB1,12),PKW(pB1,14)};
    SBAR(); pv(o,vb0+sl_cur,PAF(0),PAF(1),PAF(2),PAF(3)); }
  #undef PKW
  #undef PAF
  #undef VFR
  #undef PIN
  #undef MX3
  #undef GAPA
  #undef GAPB
  #undef EX
  #undef VRD
  #undef KRD
  #undef STEP
  #undef ENDW
  {auto rr=__builtin_amdgcn_permlane32_swap(__float_as_uint(l_reg),__float_as_uint(l_reg),false,false);l_reg=__uint_as_float(rr[0])+__uint_as_float(rr[1]);}
  if(MODE==1)l_reg+=__builtin_amdgcn_exp2f(sinkl2-mhat);
  if(hi==0)wsf[32+r32]=l_reg;asm volatile("s_waitcnt lgkmcnt(0)":::"memory");
  float rli[16];
  #pragma unroll
  for(int r=0;r<16;++r)rli[r]=__builtin_amdgcn_rcpf(wsf[32+crow(r,hi)]);
  bf16*Ow=Ou+(long)(wid*QBLK)*OP;
  { bf16*stg=(bf16*)(shm+LDS_OST)+wid*2048;
    #pragma unroll
    for(int r=0;r<16;++r){const int orow=crow(r,hi);
      #pragma unroll
      for(int d0=0;d0<2;++d0)stg[orow*64+d0*32+r32]=__float2bfloat16(o[d0][r]*rli[r]);}
    asm volatile("s_waitcnt lgkmcnt(0)":::"memory");
    #pragma unroll
    for(int i=0;i<4;++i){const int row=i*8+(lane>>3),ch=lane&7; const u32x4 v=*(const u32x4*)(stg+row*64+ch*8); ATTN_STORE16(Ow+(long)row*OP+ch*8,v);} }
  asm volatile("s_waitcnt lgkmcnt(0)\n\ts_barrier":::"memory");
  #undef DMA_K
  #undef TROW
  #undef DMA_V
  #undef CMASK
  #undef START
  #undef RESC
  #undef ROT
}
#undef SBAR
#undef WAIT_BAR
}

template <int LAYER> __device__ __forceinline__ void attn_fast(const Frame& F, char* shm) {
    using attn_body::bf16;
    const bf16* Q = (const bf16*)(F.ws + WS_Q); const bf16* Kn = (const bf16*)(F.ws + WS_KN); const bf16* Vn = (const bf16*)(F.ws + WS_VN); bf16* AO = (bf16*)(F.ws + WS_AO);
    const int nunits = LAYER == 0 ? 1024 + 64 : 1024;
    for (int U = F.vcu; U < nunits; U += F.G) {
        int b, h, NT, lat0 = 0, q0 = 0; size_t row0;
        if (U < 1024) { b = U >> 7; h = ((U >> 6) & 1) * 4 + ((U >> 4) & 3); q0 = (U & 15) * 256; row0 = (size_t)b * SEQ + q0;
            if (LAYER == 0) NT = KVS / 64;
            else { int lo = q0 - 128, hi = q0 + 384; lo = lo < 0 ? 0 : lo; hi = hi > SEQ ? SEQ : hi; NT = 4 + (hi - lo) / 64; lat0 = CTXL + lo; } }
        else { const int uc = U - 1024; b = uc >> 3; h = uc & 7; row0 = (size_t)TX + (size_t)b * CTXL; NT = 4; }
        const bf16* Kh = Kn + (size_t)b * KVS * 128 + (h >> 2) * 64; const bf16* Vh = Vn + (size_t)b * KVS * 128 + (h >> 2) * 64;
        const float sinkl2 = LAYER == 1 ? F.in[I_SINK][h] * LOG2E : 0.f;
        attn_body::attn_unit<LAYER, 8>(Q + row0 * 512 + h * 64, Kh, Vh, AO + row0 * 1024 + h * 64, NT, lat0, q0, sinkl2, F.in[LAYER == 0 ? I_QNA : I_QNC], (const float*)(F.ws + WS_ROPE), U < 1024, shm);
    }
}

template <int DRY> __device__ __forceinline__ void p_router(const Frame& F, int l, int ntok) {
    const int gw = F.vcu * NWAVES + F.wave, NGW = F.G * NWAVES, lane = F.lane, tk = lane & 15, kq = lane >> 4;
    bf16_t* HX = (bf16_t*)(F.ws + WS_HX); const float* SS = (const float*)(F.ws + WS_SS);
    const float* gb = F.in[I_RGB] + l * 4; const float* eb = F.in[I_REB] + l * 32;
    unsigned* tokslot = (unsigned*)(F.ws + (DRY ? WS_HID : WS_TOK)); float* tokw = (float*)(F.ws + (DRY ? WS_HID : WS_TOK) + 512 * 1024); unsigned* list = (unsigned*)(F.ws + (DRY ? WS_HID + 2 * MiB : WS_LIST));
    unsigned* cnt = F.cnt(DRY ? l + 2 : l);
    {
        const u32x4* src = (const u32x4*)((const bf16_t*)(F.ws + WS_WR) + (size_t)l * 2 * 36864);
        __syncthreads();
        for (int i = F.tid; i < 2 * RW_BYTES / 16; i += NTHREADS) *(LAS u32x4*)(F.lds + i * 16) = src[i];
        __syncthreads();
    }
    const LAS unsigned char* wl0 = F.lds + lane * 16;
    const LAS unsigned char* wl2 = F.lds + 2048 + ((tk >> 2) * 4 + kq) * 16;
    for (int grp = gw; grp < ntok / 16; grp += NGW) {
        const int row = grp * 16 + tk, r = modrow(grp * 16);
        const float* xr = F.xr_row(row) + 8 * kq; const float* gp = (const float*)(F.ws + WS_GP) + (size_t)(l * 9 + r) * 1024 + 8 * kq; const float* sh = F.mod(l, r, 3) + 8 * kq;
        f32x4 x0[2], x1[2], x2[2], x3[2], x4[2], x5[2], x6[2], x7[2], ma[4], mb[4];
#define R_XLOAD(buf, st) do { const int s_ = (st) < 32 ? (st) : 31; buf[0] = *(const f32x4*)(xr + s_ * 32); buf[1] = *(const f32x4*)(xr + s_ * 32 + 4); } while (0)
#define R_MLOAD(buf, st) do { const int s_ = (st) < 32 ? (st) : 31; buf[0] = *(const f32x4*)(gp + s_ * 32); buf[1] = *(const f32x4*)(gp + s_ * 32 + 4); buf[2] = *(const f32x4*)(sh + s_ * 32); buf[3] = *(const f32x4*)(sh + s_ * 32 + 4); } while (0)
        R_XLOAD(x0, 0); R_XLOAD(x1, 1); R_XLOAD(x2, 2); R_XLOAD(x3, 3); R_XLOAD(x4, 4); R_XLOAD(x5, 5); R_XLOAD(x6, 6); R_XLOAD(x7, 7); R_MLOAD(ma, 0); R_MLOAD(mb, 1);
        float ssum = 0.f;
#pragma unroll
        for (int i = 0; i < 4; ++i) { const f32x4 p = *(const f32x4*)(SS + (size_t)row * 16 + 4 * i); ssum += (p[0] + p[1]) + (p[2] + p[3]); }
        const float rms = 1.0f / sqrtf(ssum * (1.f / 1024.f) + EPS);
        f32x4 acc[3];
#pragma unroll
        for (int n = 0; n < 3; ++n) acc[n] = (f32x4){0.f, 0.f, 0.f, 0.f};
        bf16_t* hxr = HX + (size_t)row * DM + 8 * kq;
#define R_STEP(xb_, mb_, st) do { \
            const f32x4 h0 = (xb_[0] * rms) * mb_[0] + mb_[2], h1 = (xb_[1] * rms) * mb_[1] + mb_[3]; \
            u32x4 hh; hh.x = pk2(h0[0], h0[1]); hh.y = pk2(h0[2], h0[3]); hh.z = pk2(h1[0], h1[1]); hh.w = pk2(h1[2], h1[3]); \
            *(u32x4*)(hxr + (st) * 32) = hh; \
            if (DRY < 3) { \
            u32x4 hl; hl.x = pk2(h0[0] - bflo(hh.x), h0[1] - bfhi(hh.x)); hl.y = pk2(h0[2] - bflo(hh.y), h0[3] - bfhi(hh.y)); hl.z = pk2(h1[0] - bflo(hh.z), h1[1] - bfhi(hh.z)); hl.w = pk2(h1[2] - bflo(hh.w), h1[3] - bfhi(hh.w)); \
            const bf16x8 bh = __builtin_bit_cast(bf16x8, hh), bl = __builtin_bit_cast(bf16x8, hl); \
            const bf16x8 w0h = *(const LAS bf16x8*)(wl0 + (st) * 2304), w1h = *(const LAS bf16x8*)(wl0 + (st) * 2304 + 1024), w2h = *(const LAS bf16x8*)(wl2 + (st) * 2304); \
            const bf16x8 w0l = *(const LAS bf16x8*)(wl0 + RW_BYTES + (st) * 2304), w1l = *(const LAS bf16x8*)(wl0 + RW_BYTES + (st) * 2304 + 1024), w2l = *(const LAS bf16x8*)(wl2 + RW_BYTES + (st) * 2304); \
            acc[0] = __builtin_amdgcn_mfma_f32_16x16x32_bf16(w0h, bh, acc[0], 0, 0, 0); acc[1] = __builtin_amdgcn_mfma_f32_16x16x32_bf16(w1h, bh, acc[1], 0, 0, 0); acc[2] = __builtin_amdgcn_mfma_f32_16x16x32_bf16(w2h, bh, acc[2], 0, 0, 0); \
            acc[0] = __builtin_amdgcn_mfma_f32_16x16x32_bf16(w0h, bl, acc[0], 0, 0, 0); acc[1] = __builtin_amdgcn_mfma_f32_16x16x32_bf16(w1h, bl, acc[1], 0, 0, 0); acc[2] = __builtin_amdgcn_mfma_f32_16x16x32_bf16(w2h, bl, acc[2], 0, 0, 0); \
            acc[0] = __builtin_amdgcn_mfma_f32_16x16x32_bf16(w0l, bh, acc[0], 0, 0, 0); acc[1] = __builtin_amdgcn_mfma_f32_16x16x32_bf16(w1l, bh, acc[1], 0, 0, 0); acc[2] = __builtin_amdgcn_mfma_f32_16x16x32_bf16(w2l, bh, acc[2], 0, 0, 0); } } while (0)
        for (int st = 0; st < 32; st += 8) {
            R_STEP(x0, ma, st);     R_XLOAD(x0, st + 8);  R_MLOAD(ma, st + 2);
            R_STEP(x1, mb, st + 1); R_XLOAD(x1, st + 9);  R_MLOAD(mb, st + 3);
            R_STEP(x2, ma, st + 2); R_XLOAD(x2, st + 10); R_MLOAD(ma, st + 4);
            R_STEP(x3, mb, st + 3); R_XLOAD(x3, st + 11); R_MLOAD(mb, st + 5);
            R_STEP(x4, ma, st + 4); R_XLOAD(x4, st + 12); R_MLOAD(ma, st + 6);
            R_STEP(x5, mb, st + 5); R_XLOAD(x5, st + 13); R_MLOAD(mb, st + 7);
            R_STEP(x6, ma, st + 6); R_XLOAD(x6, st + 14); R_MLOAD(ma, st + 8);
            R_STEP(x7, mb, st + 7); R_XLOAD(x7, st + 15); R_MLOAD(mb, st + 9);
        }
#undef R_XLOAD
#undef R_MLOAD
#undef R_STEP
        if (DRY < 2) {
            const float lgk = acc[2][0] + gb[kq];
            const float la = __shfl_xor(lgk, 16), lb = __shfl_xor(lgk, 32), lc = __shfl_xor(la, 32);
            const float gm = fmaxf(fmaxf(lgk, la), fmaxf(lb, lc));
            bool win = (lgk == gm);
            win = win && !(la == gm && (kq ^ 1) < kq) && !(lb == gm && (kq ^ 2) < kq) && !(lc == gm && (kq ^ 3) < kq);
            if (win) {
                const float g_w = 1.f / (expf(lgk - gm) + expf(la - gm) + expf(lb - gm) + expf(lc - gm));
                float el[8];
                { const f32x4 b0 = *(const f32x4*)(eb + 8 * kq), b1 = *(const f32x4*)(eb + 8 * kq + 4);
#pragma unroll
                  for (int i = 0; i < 4; ++i) { el[i] = acc[0][i] + b0[i]; el[4 + i] = acc[1][i] + b1[i]; } }
                int i1 = 0; float m1 = el[0];
#pragma unroll
                for (int i = 1; i < 8; ++i) if (el[i] > m1) { m1 = el[i]; i1 = i; }
                int i2 = 0; float m2 = -3.0e38f;
#pragma unroll
                for (int i = 0; i < 8; ++i) if (i != i1 && el[i] > m2) { m2 = el[i]; i2 = i; }
                const float p2 = expf(m2 - m1); const float w1 = g_w / (1.f + p2), w2 = g_w * p2 / (1.f + p2);
                const int e1 = kq * 8 + i1, e2 = kq * 8 + i2;
                const unsigned pos1 = atomicAdd(cnt + e1 * 64, 1u), pos2 = atomicAdd(cnt + e2 * 64, 1u);
                list[(size_t)e1 * TT + pos1] = (unsigned)row; list[(size_t)e2 * TT + pos2] = (unsigned)row;
                tokslot[2 * row] = ((unsigned)e1 << 16) | pos1; tokslot[2 * row + 1] = ((unsigned)e2 << 16) | pos2; tokw[2 * row] = w1; tokw[2 * row + 1] = w2;
            }
        }
    }
    __syncthreads();
}
struct CombBuf { f32x4 x[4]; u32x2 ya[4], yb[4]; };
__device__ __forceinline__ void comb_load(CombBuf& b, const float* xr, const bf16_t* ya, const bf16_t* yb, int lane) {
#pragma unroll
    for (int j = 0; j < 4; ++j) { const int c = 4 * lane + 256 * j; b.x[j] = *(const f32x4*)(xr + c); b.ya[j] = *(const u32x2*)(ya + c); b.yb[j] = *(const u32x2*)(yb + c); }
}
template <bool LAST, bool DRY> __device__ __forceinline__ void comb_finish(const Frame& F, const CombBuf& b, int l, int row, float wa, float wb, int lane) {
    const int r = modrow(row); const float* g2 = F.mod(l, r, 5); float* xr = F.xr_row(row);
    float ss = 0.f; f32x4 v[4];
#pragma unroll
    for (int j = 0; j < 4; ++j) { const int c = 4 * lane + 256 * j; const f32x4 gv = *(const f32x4*)(g2 + c);
        f32x4 y; y[0] = wa * bflo(b.ya[j].x) + wb * bflo(b.yb[j].x); y[1] = wa * bfhi(b.ya[j].x) + wb * bfhi(b.yb[j].x); y[2] = wa * bflo(b.ya[j].y) + wb * bflo(b.yb[j].y); y[3] = wa * bfhi(b.ya[j].y) + wb * bfhi(b.yb[j].y);
        v[j] = b.x[j] + gv * y; *(f32x4*)(xr + c) = DRY ? b.x[j] : v[j];
        ss += (v[j][0] * v[j][0] + v[j][1] * v[j][1]) + (v[j][2] * v[j][2] + v[j][3] * v[j][3]); }
    if (!LAST) { const float rms = 1.0f / sqrtf(wave_sum(ss) * (1.f / 1024.f) + EPS); const float* g = F.in[I_LN1] + (l + 1) * 1024; const float* sh = F.mod(l + 1, r, 0); const float* sc = F.mod(l + 1, r, 1); f32x4 h[4];
#pragma unroll
        for (int j = 0; j < 4; ++j) { const int c = 4 * lane + 256 * j; h[j] = (v[j] * rms * *(const f32x4*)(g + c)) * (1.f + *(const f32x4*)(sc + c)) + *(const f32x4*)(sh + c); }
        store_row_bf16((bf16_t*)(F.ws + WS_HX) + (size_t)row * DM, lane, h); }
}
template <bool LAST, bool DRY> __device__ __forceinline__ void p_combine(const Frame& F, int l, int ntok, const MoeTab& tb) {
    const int gw = F.vcu * NWAVES + F.wave, NGW = F.G * NWAVES, lane = F.lane;
    const bf16_t* YB = (const bf16_t*)(F.ws + WS_YB);
    const unsigned* tokslot = (const unsigned*)(F.ws + WS_TOK); const float* tokw = (const float*)(F.ws + WS_TOK + 512 * 1024);
    const int ntot = gw < ntok ? (ntok - gw + NGW - 1) / NGW : 0;
    for (int base = 0; base < ntot; base += 64) {
    const int n = ntot - base < 64 ? ntot - base : 64;
    unsigned my_sa = 0u, my_sb = 0u; float my_wa = 0.f, my_wb = 0.f;
    { const int mr = gw + (base + lane) * NGW;
      if (lane < n) { const unsigned sa = tokslot[2 * mr], sb = tokslot[2 * mr + 1]; my_wa = tokw[2 * mr]; my_wb = tokw[2 * mr + 1];
          my_sa = (unsigned)tb.tile0[sa >> 16] * 256u + (sa & 0xffffu); my_sb = (unsigned)tb.tile0[sb >> 16] * 256u + (sb & 0xffffu); } }
    CombBuf A, B;
#define COMB_LOAD(buf, i) do { const int row_ = gw + (base + (i)) * NGW; const unsigned sa_ = __builtin_amdgcn_readlane(my_sa, (i)), sb_ = __builtin_amdgcn_readlane(my_sb, (i)); \
        comb_load(buf, F.xr_row(row_), YB + (size_t)sa_ * 1024, YB + (size_t)sb_ * 1024, lane); } while (0)
#define COMB_FIN(buf, i) do { const float wa_ = __uint_as_float(__builtin_amdgcn_readlane(__float_as_uint(my_wa), (i))), wb_ = __uint_as_float(__builtin_amdgcn_readlane(__float_as_uint(my_wb), (i))); \
        comb_finish<LAST, DRY>(F, buf, l, gw + (base + (i)) * NGW, wa_, wb_, lane); } while (0)
    COMB_LOAD(A, 0);
    for (int i = 0; i < n; i += 2) {
        if (i + 1 < n) COMB_LOAD(B, i + 1);
        COMB_FIN(A, i);
        if (i + 2 < n) COMB_LOAD(A, i + 2);
        if (i + 1 < n) COMB_FIN(B, i + 1);
    }
    }
#undef COMB_LOAD
#undef COMB_FIN
}

__global__ void __launch_bounds__(NTHREADS, 2) fwd_kernel(Params P) {
    extern __shared__ __attribute__((aligned(16))) unsigned char lds_raw[];
    Frame F;
    F.lds = (LAS unsigned char*)lds_raw; F.in = P.in; F.out = P.out; F.ws = P.ws;
    F.tid = threadIdx.x; F.lane = F.tid & 63; F.wave = __builtin_amdgcn_readfirstlane(F.tid >> 6);
    F.G = gridDim.x; { const int bx = blockIdx.x; F.vcu = (F.G % 8 == 0) ? (bx % 8) * (F.G / 8) + bx / 8 : bx; }
    volatile LAS unsigned* misc = (volatile LAS unsigned*)(F.lds + LDS_MISC);
    if (F.tid < 16) misc[F.tid] = 0u;
    __syncthreads();
#if ONE_LAUNCH
    XcdBarrier bar = xcd_barrier_post((unsigned*)(F.ws + WS_CTL) + CW_BAR, misc + 8);
#define GRID_BAR() do { xcd_barrier(bar); } while (0)
#else
#define GRID_BAR() do { } while (0)
#endif
    const int lo = P.ph_lo, hi = P.ph_hi;
#ifndef DRYMASK
#define DRYMASK 0
#endif
#ifndef DRYV
#define DRYV 1
#endif
#ifndef PHMASK
#define PHMASK 0xFFFFFFFFu
#endif
#define IN(k) (((PHMASK >> (k)) & 1u) && lo <= (k) && (k) < hi)
#ifdef PROBE_PH
#define STAMP(k) do { if (blockIdx.x == 0 && F.tid == 0) { const unsigned long long t_ = __builtin_amdgcn_s_memrealtime(); \
        if ((k) == PROBE_PH - 1) { misc[0] = (unsigned)t_; misc[1] = (unsigned)(t_ >> 32); } if ((k) == PROBE_PH) { misc[2] = (unsigned)t_; misc[3] = (unsigned)(t_ >> 32); } } } while (0)
#else
#define STAMP(k) do { } while (0)
#endif
#define SEAM(k) do { if (IN((k) + 1)) GRID_BAR(); STAMP(k); } while (0)
    STAMP(-1);
    bf16_t* HX = (bf16_t*)(F.ws + WS_HX); bf16_t* Qb = (bf16_t*)(F.ws + WS_Q); bf16_t* KVb = (bf16_t*)(F.ws + WS_KV); bf16_t* Gb = (bf16_t*)(F.ws + WS_G); bf16_t* AO = (bf16_t*)(F.ws + WS_AO);
    bf16_t* HID = (bf16_t*)(F.ws + WS_HID); bf16_t* YB = (bf16_t*)(F.ws + WS_YB);

    if (IN(0)) { Frame Fp = F; asm volatile("" : "+v"(Fp.tid), "+v"(Fp.lane)); p0_prologue(Fp); SEAM(0); }
    if (IN(1)) { Frame Fp = F; asm volatile("" : "+v"(Fp.tid), "+v"(Fp.lane)); p_norm1_l0(Fp); SEAM(1); }
    if (IN(2)) { Frame Fp = F; asm volatile("" : "+v"(Fp.tid), "+v"(Fp.lane)); SchedDense S{(const bf16_t*)(Fp.ws + WS_WINAB), 1024, TT / 256, 7, 0, 0, Fp.vcu, Fp.G}; EpiInProj<true> E{Qb, KVb, (bf16_t*)(Fp.ws + WS_VN), Gb}; GEMM(Fp, HX, 1024, S, E); SEAM(2); }
    if (IN(3)) { Frame Fp = F; asm volatile("" : "+v"(Fp.tid), "+v"(Fp.lane)); p_k_post(Fp, Fp.in[I_KNA]); p_conv(Fp); SEAM(3); }
    if (IN(4)) { Frame Fp = F; asm volatile("" : "+v"(Fp.tid), "+v"(Fp.lane));
#ifdef ATTN_SIMPLE
        attn_simple<0>(Fp);
#else
        attn_fast<0>(Fp, (char*)lds_raw);
#endif
        SEAM(4); }
    if (IN(5)) { Frame Fp = F; asm volatile("" : "+v"(Fp.tid), "+v"(Fp.lane)); SchedDense S{(const bf16_t*)(Fp.ws + WS_WOUTAB), 1024, TT / 256, 4, 0, 0, Fp.vcu, Fp.G}; EpiOutProj<true> E{Fp, 0}; GEMM(Fp, AO, 1024, S, E); SEAM(5); }
    if (IN(6)) { Frame Fp = F; asm volatile("" : "+v"(Fp.tid), "+v"(Fp.lane));
#if (DRYMASK >> 6) & 1
        p_router<DRYV>(Fp, 0, TT); GRID_BAR();
#endif
        p_router<0>(Fp, 0, TT); SEAM(6); }
    if (IN(7)) { Frame Fp = F; asm volatile("" : "+v"(Fp.tid), "+v"(Fp.lane)); const MoeTab tb = moe_tables(Fp, 0); SchedMoe S{(const bf16_t*)(Fp.ws + WS_WGU), (size_t)1024 * 1024, 1024, tb, (const unsigned*)(Fp.ws + WS_LIST), true, Fp.vcu, Fp.G}; EpiMoe1 E{HID}; GEMM(Fp, HX, 1024, S, E); SEAM(7); }
    if (IN(8)) { Frame Fp = F; asm volatile("" : "+v"(Fp.tid), "+v"(Fp.lane)); const MoeTab tb = moe_tables(Fp, 0); SchedMoe S{(const bf16_t*)(Fp.ws + WS_WD), (size_t)1024 * 512, 512, tb, nullptr, false, Fp.vcu, Fp.G}; EpiMoe2 E{YB}; GEMM(Fp, HID, 512, S, E); SEAM(8); }
    if (IN(9)) { Frame Fp = F; asm volatile("" : "+v"(Fp.tid), "+v"(Fp.lane)); const MoeTab tb = moe_tables(Fp, 0);
#if (DRYMASK >> 9) & 1
        p_combine<false, true>(Fp, 0, TT, tb); GRID_BAR();
#endif
        p_combine<false, false>(Fp, 0, TT, tb); SEAM(9); }
    if (IN(10)) { Frame Fp = F; asm volatile("" : "+v"(Fp.tid), "+v"(Fp.lane)); SchedDense S{(const bf16_t*)(Fp.ws + WS_WINCD), 1024, TX / 256, 5, TC / 256, 2, Fp.vcu, Fp.G}; EpiInProj<false> E{Qb, KVb, (bf16_t*)(Fp.ws + WS_VN), Gb}; GEMM(Fp, HX, 1024, S, E); SEAM(10); }
    if (IN(11)) { Frame Fp = F; asm volatile("" : "+v"(Fp.tid), "+v"(Fp.lane)); p_k_post(Fp, Fp.in[I_KNC]); p_pool(Fp); SEAM(11); }
    if (IN(12)) { Frame Fp = F; asm volatile("" : "+v"(Fp.tid), "+v"(Fp.lane));
#ifdef ATTN_SIMPLE
        attn_simple<1>(Fp);
#else
        attn_fast<1>(Fp, (char*)lds_raw);
#endif
        SEAM(12); }
    if (IN(13)) { Frame Fp = F; asm volatile("" : "+v"(Fp.tid), "+v"(Fp.lane)); SchedDense S{(const bf16_t*)(Fp.ws + WS_WOUTCD), 1024, TX / 256, 4, 0, 0, Fp.vcu, Fp.G};
#if (DRYMASK >> 13) & 1
        { EpiOutProj<false, true> Ed{Fp, 1}; GEMM(Fp, AO, 1024, S, Ed); GRID_BAR(); }
#endif
        EpiOutProj<false> E{Fp, 1}; GEMM(Fp, AO, 1024, S, E); SEAM(13); }
    if (IN(14)) { Frame Fp = F; asm volatile("" : "+v"(Fp.tid), "+v"(Fp.lane));
#if (DRYMASK >> 14) & 1
        p_router<DRYV>(Fp, 1, TX); GRID_BAR();
#endif
        p_router<0>(Fp, 1, TX); SEAM(14); }
    if (IN(15)) { Frame Fp = F; asm volatile("" : "+v"(Fp.tid), "+v"(Fp.lane)); const MoeTab tb = moe_tables(Fp, 1); SchedMoe S{(const bf16_t*)(Fp.ws + WS_WGU) + (size_t)32 * 1024 * 1024, (size_t)1024 * 1024, 1024, tb, (const unsigned*)(Fp.ws + WS_LIST), true, Fp.vcu, Fp.G}; EpiMoe1 E{HID}; GEMM(Fp, HX, 1024, S, E); SEAM(15); }
    if (IN(16)) { Frame Fp = F; asm volatile("" : "+v"(Fp.tid), "+v"(Fp.lane)); const MoeTab tb = moe_tables(Fp, 1); SchedMoe S{(const bf16_t*)(Fp.ws + WS_WD) + (size_t)32 * 1024 * 512, (size_t)1024 * 512, 512, tb, nullptr, false, Fp.vcu, Fp.G}; EpiMoe2 E{YB}; GEMM(Fp, HID, 512, S, E); SEAM(16); }
    if (IN(17)) { Frame Fp = F; asm volatile("" : "+v"(Fp.tid), "+v"(Fp.lane)); const MoeTab tb = moe_tables(Fp, 1);
#if (DRYMASK >> 17) & 1
        p_combine<true, true>(Fp, 1, TX, tb); GRID_BAR();
#endif
        p_combine<true, false>(Fp, 1, TX, tb); }
#ifdef PROBE_PH
    STAMP(NPH - 1);
    if (blockIdx.x == 0 && F.tid == 0) { const unsigned long long t0 = ((unsigned long long)misc[1] << 32) | misc[0], t1 = ((unsigned long long)misc[3] << 32) | misc[2];
        const unsigned long long te = __builtin_amdgcn_s_memrealtime(), span = (t1 - t0) * 16ull;
        while (__builtin_amdgcn_s_memrealtime() - te < span) __builtin_amdgcn_s_sleep(32); }
#endif
#undef IN
#undef SEAM
}

extern "C" void kernel_launch(void* const* d_in, const int* in_sizes, int n_in, void* d_out, int out_size, void* d_ws, size_t ws_size, hipStream_t stream) {
    static int grid = 0;
    if (grid == 0) {
        if (n_in != 30 || out_size != TX * DM || ws_size < WS_END) { fprintf(stderr, "kernel_launch: unexpected shapes (n_in %d out %d ws %zu)\n", n_in, out_size, ws_size); grid = -1; return; }
        int dev = 0, cus = 0;
        if (hipGetDevice(&dev) != hipSuccess || hipDeviceGetAttribute(&cus, hipDeviceAttributeMultiprocessorCount, dev) != hipSuccess) { grid = -1; return; }
        if (hipFuncSetAttribute((const void*)fwd_kernel, hipFuncAttributeMaxDynamicSharedMemorySize, LDS_BYTES) != hipSuccess) { fprintf(stderr, "kernel_launch: hipFuncSetAttribute failed\n"); grid = -1; return; }
        int per_cu = 0;
        if (hipOccupancyMaxActiveBlocksPerMultiprocessor(&per_cu, (const void*)fwd_kernel, NTHREADS, LDS_BYTES) != hipSuccess || per_cu < 1) { fprintf(stderr, "kernel_launch: occupancy query says %d\n", per_cu); }
        (void)hipGetLastError();
        grid = cus;
    }
    if (grid < 0) return;
    (void)hipMemsetAsync((char*)d_ws + WS_CTL, 0, CTL_ZERO_BYTES, stream);
    Params p{};
    for (int i = 0; i < 30; ++i) p.in[i] = (const float*)d_in[i];
    p.out = (float*)d_out; p.ws = (unsigned char*)d_ws;
#if ONE_LAUNCH
    p.ph_lo = 0; p.ph_hi = NPH;
    hipLaunchKernelGGL(fwd_kernel, dim3(grid), dim3(NTHREADS), LDS_BYTES, stream, p);
#else
    for (int ph = 0; ph < NPH; ++ph) { p.ph_lo = ph; p.ph_hi = ph + 1; hipLaunchKernelGGL(fwd_kernel, dim3(grid), dim3(NTHREADS), LDS_BYTES, stream, p); }
#endif
}
```

```cpp
#include <hip/hip_runtime.h>
#include <cstdio>
#include <cstdint>

#ifndef ONE_LAUNCH
#define ONE_LAUNCH 1
#endif

#define LAS __attribute__((address_space(3)))
#define GAS __attribute__((address_space(1)))
typedef unsigned short bf16_t;
typedef short bf16x8 __attribute__((ext_vector_type(8)));
typedef float f32x4 __attribute__((ext_vector_type(4)));
typedef float f32x2 __attribute__((ext_vector_type(2)));
typedef unsigned u32x4 __attribute__((ext_vector_type(4)));
typedef unsigned u32x2 __attribute__((ext_vector_type(2)));
typedef __bf16 bf16x2_t __attribute__((ext_vector_type(2)));

constexpr int NB = 8, SEQ = 4096, DM = 1024, CTXL = 256, HD = 64;
constexpr int TX = NB * SEQ, TC = NB * CTXL, TT = TX + TC;
constexpr int KVS = CTXL + SEQ;
constexpr int NE = 32;
constexpr int NTILE_MAX = 304, NSLOT = NTILE_MAX * 256;
constexpr float EPS = 1e-6f;
constexpr float LOG2E = 1.4426950408889634f;
constexpr float C2 = 0.125f * LOG2E;
constexpr int NWAVES = 8, NTHREADS = 512;
constexpr int NPH = 18;

enum { I_X = 0, I_C, I_CTX, I_CCTX, I_MODW, I_MODB, I_LN1, I_LN2, I_WINAB, I_WOUTAB, I_QNA, I_KNA, I_CONVW, I_CONVB, I_CLNG, I_CLNB,
       I_WINCD, I_WOUTCD, I_QNC, I_KNC, I_SINK, I_POOLW, I_POOLS, I_RGW, I_RGB, I_REW, I_REB, I_EXG, I_EXU, I_EXD };

constexpr size_t MiB = 1u << 20;
constexpr size_t WS_CTL = 0, CTL_ZERO_BYTES = 1 * MiB;
constexpr size_t WS_MOD = 1 * MiB;
constexpr size_t WS_ROPE = 2 * MiB;
constexpr size_t WS_TOK = 3 * MiB;
constexpr size_t WS_LIST = 4 * MiB;
constexpr size_t WS_WINAB = 10 * MiB;
constexpr size_t WS_WOUTAB = 14 * MiB;
constexpr size_t WS_WINCD = 16 * MiB;
constexpr size_t WS_WOUTCD = 19 * MiB;
constexpr size_t WS_XC = 21 * MiB;
constexpr size_t WS_KN = 30 * MiB;
constexpr size_t WS_VN = 39 * MiB;
constexpr size_t WS_WGU = 48 * MiB;
constexpr size_t WS_WD = 176 * MiB;
constexpr size_t WS_XR = 240 * MiB;
constexpr size_t WS_HID = 308 * MiB;
constexpr size_t WS_Q = 384 * MiB;
constexpr size_t WS_KV = 418 * MiB;
constexpr size_t WS_G = 435 * MiB;
constexpr size_t WS_AO = 469 * MiB;
constexpr size_t WS_YB = 384 * MiB;
constexpr size_t WS_SS = 537 * MiB;
constexpr size_t WS_WR = 9 * MiB;
constexpr size_t WS_GP = 3 * MiB + 896 * 1024;
constexpr size_t WS_END = 540 * MiB;
static_assert(WS_YB + (size_t)NSLOT * 1024 * 2 <= WS_END && WS_AO + (size_t)TT * 1024 * 2 <= WS_END, "ws map");
constexpr int CW_CNT = 256;
constexpr int CW_BAR = 16384;

constexpr int RING_BYTES = 131072;
constexpr int RW_BYTES = 73728;
constexpr int LDS_MISC = 2 * RW_BYTES;
constexpr int LDS_TAB = LDS_MISC + 256;
constexpr int LDS_BYTES = 163840;

__device__ __forceinline__ unsigned pk2(float lo, float hi) { f32x2 v = {lo, hi}; bf16x2_t b = __builtin_convertvector(v, bf16x2_t); return __builtin_bit_cast(unsigned, b); }
__device__ __forceinline__ float bflo(unsigned w) { return __uint_as_float(w << 16); }
__device__ __forceinline__ float bfhi(unsigned w) { return __uint_as_float(w & 0xffff0000u); }
__device__ __forceinline__ float bf2f(bf16_t h) { return __uint_as_float((unsigned)h << 16); }
__device__ __forceinline__ float wave_sum(float v) {
#pragma unroll
    for (int o = 1; o < 64; o <<= 1) v += __shfl_xor(v, o);
    return v;
}
__device__ __forceinline__ float sigmoidf_(float v) { return 1.f / (1.f + __expf(-v)); }

#define XB_TMO      128
#define XB_XCNT(j)  (256  + 64 * (j))
#define XB_XSUB(j)  (1280 + 64 * (j))
#define XB_XGEN(j)  (2304 + 64 * (j))
#define XB_TOP      3328
#define XB_TOPGEN   3392
#define XCD_BAR_WORDS 3456
#define XB_SPIN_CAP (1u << 18)
__device__ __forceinline__ unsigned xb_ld(unsigned* p)              { return __hip_atomic_load(p, __ATOMIC_RELAXED, __HIP_MEMORY_SCOPE_AGENT); }
__device__ __forceinline__ unsigned xb_add(unsigned* p, unsigned v) { return __hip_atomic_fetch_add(p, v, __ATOMIC_RELAXED, __HIP_MEMORY_SCOPE_AGENT); }
__device__ __forceinline__ unsigned xb_xcc_id() { return (unsigned)__builtin_amdgcn_s_getreg((3 << 11) | 20) & 0xFu; }
#define XB_SPIN(cond, bar) do { unsigned _sp = 0; while (cond) { __builtin_amdgcn_s_sleep(1); \
    if ((++_sp & 255u) == 0u) { if (xb_ld(&(bar)[XB_TMO])) break; if (_sp > XB_SPIN_CAP) { atomicAdd(&(bar)[XB_TMO], 1u); break; } } } } while (0)
struct XcdBarrier { unsigned* bar; unsigned x; volatile LAS unsigned* st; };
__device__ __forceinline__ XcdBarrier xcd_barrier_post(unsigned* bar, volatile LAS unsigned* st) {
    XcdBarrier b; b.bar = bar; b.x = xb_xcc_id(); b.st = st;
    if (threadIdx.x == 0) (void)xb_add(&bar[XB_XCNT(b.x)], 1u);
    return b;
}
__device__ __forceinline__ void xcd_barrier_complete(unsigned* bar, unsigned x, unsigned& nloc, unsigned& nx) {
    const unsigned G = gridDim.x * gridDim.y * gridDim.z;
    unsigned sum, cnt, mine, sp = 0u;
    for (;;) {
        sum = 0u; cnt = 0u; mine = 0u;
#pragma unroll
        for (unsigned j = 0; j < 16; ++j) { const unsigned c = xb_ld(&bar[XB_XCNT(j)]); sum += c; cnt += (c > 0u) ? 1u : 0u; mine = (j == x) ? c : mine; }
        if (sum == G) break;
        __builtin_amdgcn_s_sleep(1);
        if ((++sp & 255u) == 0u) { if (xb_ld(&bar[XB_TMO])) break; if (sp > XB_SPIN_CAP) { atomicAdd(&bar[XB_TMO], 1u); break; } }
    }
    nloc = mine > 0u ? mine : 1u; nx = cnt > 0u ? cnt : 1u;
}
__device__ __forceinline__ void xcd_barrier(const XcdBarrier& b) {
    asm volatile("s_waitcnt vmcnt(0)" ::: "memory");
    __syncthreads();
    if (threadIdx.x == 0) {
        unsigned* bar = b.bar;
        __builtin_amdgcn_s_waitcnt(0);
        unsigned nloc = b.st[0], nx = b.st[1];
        if (nloc == 0u) { xcd_barrier_complete(bar, b.x, nloc, nx); b.st[0] = nloc; b.st[1] = nx; }
        const unsigned old = xb_add(&bar[XB_XSUB(b.x)], 1u);
        const unsigned gen = old / nloc;
        if (old + 1u == (gen + 1u) * nloc) {
            __builtin_amdgcn_fence(__ATOMIC_RELEASE, "agent");
            asm volatile("s_waitcnt vmcnt(0)" ::: "memory");
            const unsigned og = xb_add(&bar[XB_TOP], 1u);
            const unsigned tg = og / nx;
            if (og + 1u == (tg + 1u) * nx) xb_add(&bar[XB_TOPGEN], 1u);
            else XB_SPIN(xb_ld(&bar[XB_TOPGEN]) == tg, bar);
            __builtin_amdgcn_fence(__ATOMIC_ACQUIRE, "agent");
            xb_add(&bar[XB_XGEN(b.x)], 1u);
            asm volatile("s_waitcnt vmcnt(0)" ::: "memory");
        } else {
            XB_SPIN(xb_ld(&bar[XB_XGEN(b.x)]) == gen, bar);
            __builtin_amdgcn_fence(__ATOMIC_ACQUIRE, "agent");
            asm volatile("s_waitcnt vmcnt(0)" ::: "memory");
        }
    }
    __syncthreads();
}

struct Params { const float* in[30]; float* out; unsigned char* ws; int ph_lo, ph_hi; };
struct Frame {
    LAS unsigned char* lds;
    const float* const* in;
    float* out; unsigned char* ws;
    int tid, lane, wave, vcu, G;
    __device__ __forceinline__ const float* mod(int l, int r, int chunk) const { return (const float*)(ws + WS_MOD) + ((size_t)(l * 9 + r) * 6144 + chunk * 1024); }
    __device__ __forceinline__ bf16_t* xr_row(int row) const { return (bf16_t*)(ws + WS_XR) + (size_t)row * DM; }
    __device__ __forceinline__ bf16_t* hx() const { return (bf16_t*)out; }
    __device__ __forceinline__ const float* xin_row(int row) const { return row < TX ? in[I_X] + (size_t)row * DM : in[I_CTX] + (size_t)(row - TX) * DM; }
    __device__ __forceinline__ unsigned* cnt(int l) const { return (unsigned*)(ws + WS_CTL) + CW_CNT + l * 32 * 64; }
};
__device__ __forceinline__ int modrow(int row) { return row < TX ? (row >> 12) : 8; }

__device__ __forceinline__ void p0_mod_item(const Frame& F, int item) {
    const int l = item / 96, cg = item % 96;
    LAS float* sc = (LAS float*)F.lds;
    LAS float* red = sc + 9 * 1024;
    for (int i = F.tid; i < 9 * 1024; i += NTHREADS) { const int r = i >> 10, k = i & 1023; const float v = r < 8 ? F.in[I_C][r * 1024 + k] : F.in[I_CCTX][k]; sc[i] = v / (1.f + expf(-v)); }
    __syncthreads();
    const float* W = F.in[I_MODW] + (size_t)l * 1024 * 6144 + cg * 64 + F.lane;
    float acc[9];
#pragma unroll
    for (int r = 0; r < 9; ++r) acc[r] = 0.f;
    for (int kb = 0; kb < 128; kb += 32) { float w[32];
#pragma unroll
        for (int kk = 0; kk < 32; ++kk) w[kk] = W[(size_t)(F.wave * 128 + kb + kk) * 6144];
#pragma unroll
        for (int kk = 0; kk < 32; ++kk) { const int k = F.wave * 128 + kb + kk;
#pragma unroll
            for (int r = 0; r < 9; ++r) acc[r] += sc[r * 1024 + k] * w[kk]; } }
#pragma unroll
    for (int r = 0; r < 9; ++r) red[(F.wave * 9 + r) * 64 + F.lane] = acc[r];
    __syncthreads();
    for (int i = F.tid; i < 9 * 64; i += NTHREADS) { const int r = i >> 6, ln = i & 63; float s = 0.f;
#pragma unroll
        for (int w = 0; w < 8; ++w) s += red[(w * 9 + r) * 64 + ln];
        ((float*)(F.ws + WS_MOD))[(size_t)(l * 9 + r) * 6144 + cg * 64 + ln] = s + F.in[I_MODB][l * 6144 + cg * 64 + ln]; }
    __syncthreads();
}
struct TDesc { const float* src; bf16_t* dst; int ldw; };
__device__ __forceinline__ void t_load(const TDesc& d, f32x4 (&v)[16], int lane) {
    const int kr = lane >> 4, nq = lane & 15;
#pragma unroll
    for (int i = 0; i < 16; ++i) v[i] = *(const f32x4*)(d.src + (size_t)(4 * i + kr) * d.ldw + 4 * nq);
}
__device__ __forceinline__ void t_finish(const TDesc& d, const f32x4 (&v)[16], LAS float* scr, int lane) {
    const int kr = lane >> 4, nq = lane & 15;
#pragma unroll
    for (int i = 0; i < 16; ++i) { LAS float* s = scr + (4 * i + kr) * 65 + 4 * nq; s[0] = v[i][0]; s[1] = v[i][1]; s[2] = v[i][2]; s[3] = v[i][3]; }
    asm volatile("s_waitcnt lgkmcnt(0)" ::: "memory");
    const int c = lane & 7;
#pragma unroll
    for (int j = 0; j < 8; ++j) { const int n = (lane >> 3) + 8 * j; const LAS float* s = scr + (8 * c) * 65 + n;
        u32x4 o; o.x = pk2(s[0 * 65], s[1 * 65]); o.y = pk2(s[2 * 65], s[3 * 65]); o.z = pk2(s[4 * 65], s[5 * 65]); o.w = pk2(s[6 * 65], s[7 * 65]);
        *(u32x4*)(d.dst + (size_t)n * 64 + 8 * c) = o; }
    asm volatile("s_waitcnt lgkmcnt(0)" ::: "memory");
}
constexpr int TN_AB = 16 * 28, TN_OAB = 16 * 16, TN_CD = 16 * 20, TN_OCD = 8 * 16, TN_G = 64 * 128, TN_U = 64 * 128, TN_D = 64 * 128;
constexpr int TN_ITEMS = TN_AB + TN_OAB + TN_CD + TN_OCD + TN_G + TN_U + TN_D;
__device__ __forceinline__ TDesc t_decode(const Frame& F, int it) {
    TDesc d; int r = it;
    if (r < TN_AB) { const int kb = r / 28, nb = r % 28, n0 = nb * 64; int d0;
        if (n0 < 768) d0 = n0; else if (n0 < 1280) { const int j = n0 - 768; d0 = 768 + (j >> 7) * 256 + (j & 127); } else { const int j = n0 - 1280; d0 = 768 + (j >> 7) * 256 + 128 + (j & 127); }
        d.src = F.in[I_WINAB] + (size_t)kb * 64 * 1792 + n0; d.ldw = 1792; d.dst = (bf16_t*)(F.ws + WS_WINAB) + ((size_t)kb * 1792 + d0) * 64; return d; } r -= TN_AB;
    if (r < TN_OAB) { const int kb = r / 16, nb = r % 16; d.src = F.in[I_WOUTAB] + (size_t)kb * 64 * 1024 + nb * 64; d.ldw = 1024; d.dst = (bf16_t*)(F.ws + WS_WOUTAB) + ((size_t)kb * 1024 + nb * 64) * 64; return d; } r -= TN_OAB;
    if (r < TN_CD) { const int kb = r / 20, nb = r % 20; d.src = F.in[I_WINCD] + (size_t)kb * 64 * 1280 + nb * 64; d.ldw = 1280; d.dst = (bf16_t*)(F.ws + WS_WINCD) + ((size_t)kb * 1280 + nb * 64) * 64; return d; } r -= TN_CD;
    if (r < TN_OCD) { const int kb = r / 16, nb = r % 16; d.src = F.in[I_WOUTCD] + (size_t)kb * 64 * 1024 + nb * 64; d.ldw = 1024; d.dst = (bf16_t*)(F.ws + WS_WOUTCD) + ((size_t)kb * 1024 + nb * 64) * 64; return d; } r -= TN_OCD;
    if (r < TN_G + TN_U) { const bool up = r >= TN_G; if (up) r -= TN_G; const int le = r >> 7, q = r & 127, kb = q >> 3, nb = q & 7, n0 = nb * 64;
        const int d0 = (n0 >> 7) * 256 + (up ? 128 : 0) + (n0 & 127);
        d.src = F.in[up ? I_EXU : I_EXG] + (size_t)le * 1024 * 512 + (size_t)kb * 64 * 512 + n0; d.ldw = 512; d.dst = (bf16_t*)(F.ws + WS_WGU) + (size_t)le * 1024 * 1024 + ((size_t)kb * 1024 + d0) * 64; return d; } r -= TN_G + TN_U;
    { const int le = r >> 7, q = r & 127, kb = q >> 4, nb = q & 15;
        d.src = F.in[I_EXD] + (size_t)le * 512 * 1024 + (size_t)kb * 64 * 1024 + nb * 64; d.ldw = 1024; d.dst = (bf16_t*)(F.ws + WS_WD) + (size_t)le * 1024 * 512 + ((size_t)kb * 1024 + nb * 64) * 64; return d; }
}
__device__ __forceinline__ void p0_prologue(const Frame& F) {
    for (int it = F.vcu; it < 192; it += F.G) p0_mod_item(F, it);
    const int gw = F.vcu * NWAVES + F.wave, NGW = F.G * NWAVES;
    const int gt = gw * 64 + F.lane, NGT = NGW * 64;
    { float* rc = (float*)(F.ws + WS_ROPE); float* rs = rc + SEQ * 32;
      for (int i = gt; i < SEQ * 32; i += NGT) { const int s = i >> 5, d = i & 31, f = d & 15; const float pos = (float)(d < 16 ? (s >> 6) : (s & 63));
          const float inv = exp2f(-(float)f * (13.287712379549449f / 16.f)); const float a = pos * inv; rc[i] = cosf(a); rs[i] = sinf(a); } }
    { typedef float f32x16_t __attribute__((ext_vector_type(16)));
      bf16_t* WT = (bf16_t*)(F.ws + WS_WOUTCD); const int l31 = F.lane & 31, lh = F.lane >> 5;
      for (int it = gw; it < 4 * 32 * 4; it += NGW) { const int g = it >> 7, dt = (it >> 2) & 31, ct = it & 3;
          const float* wo = F.in[I_WOUTCD] + (size_t)(512 + g * 128 + lh) * 1024 + dt * 32 + l31;
          const float* pw = F.in[I_POOLW] + (size_t)(g * 128 + ct * 32 + l31) * 128 + lh; const float* ps = F.in[I_POOLS] + g * 128 + lh;
          f32x16_t acc;
#pragma unroll
          for (int r = 0; r < 16; ++r) acc[r] = 0.f;
          for (int dp0 = 0; dp0 < 128; dp0 += 16) { float av[8], bv[8];
#pragma unroll
              for (int u = 0; u < 8; ++u) { av[u] = wo[(size_t)(dp0 + 2 * u) * 1024]; bv[u] = pw[dp0 + 2 * u] * ps[dp0 + 2 * u]; }
#pragma unroll
              for (int u = 0; u < 8; ++u) acc = __builtin_amdgcn_mfma_f32_32x32x2f32(av[u], bv[u], acc, 0, 0, 0); }
#pragma unroll
          for (int r = 0; r < 16; ++r) { const int i = (r & 3) + 8 * (r >> 2) + 4 * lh; const int k_ = 512 + g * 128 + ct * 32 + l31; WT[((size_t)(k_ >> 6) * 1024 + dt * 32 + i) * 64 + (k_ & 63)] = (bf16_t)(pk2(acc[r], 0.f) & 0xffffu); } } }
    { bf16_t* WR = (bf16_t*)(F.ws + WS_WR);
      for (int i = gt; i < 2 * 32 * 144 * 8; i += NGT) { const int j = i & 7, e16 = (i >> 3) % 144, s_ = (i / (8 * 144)) & 31, l = i / (8 * 144 * 32);
          int col; bool grp = false; int c;
          if (e16 < 128) { const int lane_ = e16 & 63, row = lane_ & 15; c = lane_ >> 4; col = 8 * (row >> 2) + (e16 < 64 ? 0 : 4) + (row & 3); }
          else { const int q = e16 - 128; c = q & 3; col = q >> 2; grp = true; }
          const int k = 32 * s_ + 8 * c + j;
          const float w = grp ? F.in[I_RGW][(size_t)l * 4096 + k * 4 + col] : F.in[I_REW][(size_t)l * 32768 + k * 32 + col];
          const unsigned hi = pk2(w, 0.f) & 0xffffu; const unsigned lo = pk2(w - bflo(hi), 0.f) & 0xffffu;
          const size_t o = (size_t)s_ * 1152 + (size_t)e16 * 8 + j;
          WR[(size_t)(l * 2 + 0) * 36864 + o] = (bf16_t)hi; WR[(size_t)(l * 2 + 1) * 36864 + o] = (bf16_t)lo; } }
    LAS float* scr = (LAS float*)(F.lds + F.wave * 16640);
    f32x4 va[16], vb[16]; TDesc da, db;
    if (gw < TN_ITEMS) { da = t_decode(F, gw); t_load(da, va, F.lane); }
    for (int it = gw; it < TN_ITEMS; it += 2 * NGW) {
        const int it2 = it + NGW, it3 = it + 2 * NGW;
        if (it2 < TN_ITEMS) { db = t_decode(F, it2); t_load(db, vb, F.lane); }
        t_finish(da, va, scr, F.lane);
        if (it3 < TN_ITEMS) { da = t_decode(F, it3); t_load(da, va, F.lane); }
        if (it2 < TN_ITEMS) t_finish(db, vb, scr, F.lane);
    }
}

__device__ __forceinline__ void norm_mod_row(const float* xrow, const float* g, const float* sh, const float* sc, int lane, f32x4 (&h)[4]) {
    f32x4 v[4]; float ss = 0.f;
#pragma unroll
    for (int j = 0; j < 4; ++j) { v[j] = *(const f32x4*)(xrow + 4 * lane + 256 * j); ss += (v[j][0] * v[j][0] + v[j][1] * v[j][1]) + (v[j][2] * v[j][2] + v[j][3] * v[j][3]); }
    const float rms = 1.0f / sqrtf(wave_sum(ss) * (1.f / 1024.f) + EPS);
#pragma unroll
    for (int j = 0; j < 4; ++j) { const int c = 4 * lane + 256 * j; const f32x4 gg = *(const f32x4*)(g + c), s1 = *(const f32x4*)(sc + c), s0 = *(const f32x4*)(sh + c);
        h[j] = (v[j] * rms * gg) * (1.f + s1) + s0; }
}
__device__ __forceinline__ void store_row_bf16(bf16_t* orow, int lane, const f32x4 (&h)[4]) {
#pragma unroll
    for (int j = 0; j < 4; ++j) { u32x2 o; o.x = pk2(h[j][0], h[j][1]); o.y = pk2(h[j][2], h[j][3]); *(u32x2*)(orow + 4 * lane + 256 * j) = o; }
}
struct RowBuf { f32x4 v[4]; };
__device__ __forceinline__ void row_load(RowBuf& b, const float* xrow, int lane) {
#pragma unroll
    for (int j = 0; j < 4; ++j) b.v[j] = *(const f32x4*)(xrow + 4 * lane + 256 * j);
}
__device__ __forceinline__ void row_norm_store(const RowBuf& b, const float* g, const float* sh, const float* sc, bf16_t* orow, int lane) {
    float ss = 0.f;
#pragma unroll
    for (int j = 0; j < 4; ++j) ss += (b.v[j][0] * b.v[j][0] + b.v[j][1] * b.v[j][1]) + (b.v[j][2] * b.v[j][2] + b.v[j][3] * b.v[j][3]);
    const float rms = 1.0f / sqrtf(wave_sum(ss) * (1.f / 1024.f) + EPS);
    f32x4 h[4];
#pragma unroll
    for (int j = 0; j < 4; ++j) { const int c = 4 * lane + 256 * j; h[j] = (b.v[j] * rms * *(const f32x4*)(g + c)) * (1.f + *(const f32x4*)(sc + c)) + *(const f32x4*)(sh + c); }
    store_row_bf16(orow, lane, h);
}
__device__ __forceinline__ void p_norm1_l0(const Frame& F) {
    const int gw = F.vcu * NWAVES + F.wave, NGW = F.G * NWAVES;
    { float* GP = (float*)(F.ws + WS_GP);
      for (int i = gw * 64 + F.lane; i < 2 * 9 * 1024; i += NGW * 64) { const int k = i & 1023, lr = i >> 10; GP[i] = F.in[I_LN2][(lr / 9) * 1024 + k] * (1.f + F.mod(lr / 9, lr % 9, 4)[k]); } }
    bf16_t* HX = F.hx();
    RowBuf A, B;
    if (gw < TT) row_load(A, F.xin_row(gw), F.lane);
    for (int row = gw; row < TT; row += 2 * NGW) {
        const int row2 = row + NGW, row3 = row + 2 * NGW;
        if (row2 < TT) row_load(B, F.xin_row(row2), F.lane);
        { const int r = modrow(row); row_norm_store(A, F.in[I_LN1], F.mod(0, r, 0), F.mod(0, r, 1), HX + (size_t)row * DM, F.lane); }
        if (row3 < TT) row_load(A, F.xin_row(row3), F.lane);
        if (row2 < TT) { const int r = modrow(row2); row_norm_store(B, F.in[I_LN1], F.mod(0, r, 0), F.mod(0, r, 1), HX + (size_t)row2 * DM, F.lane); }
    }
}

struct Unit { int pm, pn, e; };
struct SchedDense {
    const bf16_t* Bt; int K, nMa, nN, nMb, pnb, vcu, G;
    __device__ __forceinline__ bool next(int i, Unit& u) const { int L = i * G + vcu; const int na = nMa * nN; u.e = 0;
        if (L < na) { u.pm = L / nN; u.pn = L % nN; return true; } L -= na; if (L < nMb) { u.pm = nMa + L; u.pn = pnb; return true; } return false; }
    __device__ __forceinline__ int arow(const Unit& u, int r) const { return u.pm * 256 + r; }
    __device__ __forceinline__ const bf16_t* bbase(const Unit& u) const { return Bt + (size_t)u.pn * 256 * 64; }
    __device__ __forceinline__ int brows() const { return nN * 256; }
};
struct MoeTab { const LAS int* tile_e; const LAS int* tile0; const LAS int* cnt; int ntiles; };
struct SchedMoe {
    const bf16_t* Wt; size_t estride; int K; MoeTab tb; const unsigned* list; bool gather; int vcu, G;
    __device__ __forceinline__ bool next(int i, Unit& u) const { const int L = i * G + vcu; if (L >= tb.ntiles * 4) return false; u.pm = L >> 2; u.pn = L & 3; u.e = tb.tile_e[u.pm]; return true; }
    __device__ __forceinline__ int arow(const Unit& u, int r) const {
        if (!gather) return u.pm * 256 + r;
        int idx = (u.pm - tb.tile0[u.e]) * 256 + r; const int c = tb.cnt[u.e]; idx = idx < c ? idx : c - 1;
        return (int)list[(size_t)u.e * TT + idx]; }
    __device__ __forceinline__ const bf16_t* bbase(const Unit& u) const { return Wt + (size_t)u.e * estride + (size_t)u.pn * 256 * 64; }
    __device__ __forceinline__ int brows() const { return 1024; }
};
__device__ __forceinline__ MoeTab moe_tables(const Frame& F, int l) {
    LAS int* tile_e = (LAS int*)(F.lds + LDS_TAB); LAS int* tile0 = tile_e + NTILE_MAX; LAS int* cntl = tile0 + 33; LAS int* nt = cntl + 32;
    __syncthreads();
    if (F.tid == 0) { int t = 0; unsigned* cg = F.cnt(l);
        for (int e = 0; e < NE; ++e) { const int c = (int)__hip_atomic_load(cg + e * 64, __ATOMIC_RELAXED, __HIP_MEMORY_SCOPE_AGENT); const int n = (c + 255) >> 8; tile0[e] = t; cntl[e] = c;
            for (int j = 0; j < n; ++j) tile_e[t + j] = e; t += n; }
        tile0[32] = t; nt[0] = t; }
    __syncthreads();
    MoeTab tb; tb.tile_e = tile_e; tb.tile0 = tile0; tb.cnt = cntl; tb.ntiles = nt[0]; return tb;
}

namespace pg8 {
constexpr int BM = 256, BK = 64, HALF = 128, HTB = HALF * BK * 2;
__device__ __forceinline__ int lds_byte(int r, int c) { const int st = (r >> 4) * 2 + (c >> 5), rr = r & 15, cc = c & 31, ob = rr * 64 + cc * 2; return st * 1024 + (ob ^ (((ob >> 9) & 1) << 5)); }
__device__ __forceinline__ void stage_rc(int b, int& R, int& C) { const int st = b / 1024, sb = b % 1024, swz = sb ^ (((sb >> 9) & 1) << 5); R = (st >> 1) * 16 + swz / 64; C = (st & 1) * 32 + (swz % 64) / 2; }
__device__ __forceinline__ int perm32(int rho) { const int n = rho >> 4, i = rho & 15; return 8 * (i >> 2) + 4 * n + (i & 3); }
}
template <class Sched, class Epi>
__device__ __forceinline__ void gemm_fast(const Frame& F, const bf16_t* A, int K, const Sched& S, const Epi& E) {
    using namespace pg8;
    LAS unsigned char* lds = F.lds;
    const int tid = F.tid, wid = F.wave, lane = F.lane, wr = wid >> 2, wc = wid & 3, fr = lane & 15, fq = lane >> 4;
    const int nt = K / BK;
    int RA[2], CA[2]; unsigned voffB[2];
#pragma unroll
    for (int i = 0; i < 2; ++i) { int R, C; stage_rc(tid * 16 + i * 8192, R, C); RA[i] = R; CA[i] = C; const int Rb = (R & ~31) + perm32(R & 31); voffB[i] = (unsigned)(Rb * 64 + C) * 2u; }
    const size_t kstep = (size_t)(BK * 2);
    const size_t kstepB = (size_t)S.brows() * BK * 2;
    const size_t hstep = (size_t)HALF * BK * 2;
    const unsigned ldsw = (unsigned)wid * 1024u;
    const int aoff = lds_byte(wr * 64 + fr, fq * 8), boff = lds_byte(wc * 32 + fr, fq * 8);
    const char* Ab = (const char*)A;
#define PG8_SA(b, h) (((b) * 2 + (h)) * HTB)
#define PG8_SB(b, h) ((4 + (b) * 2 + (h)) * HTB)
#define PG8_STAGE(bufoff, gbase, voff) do { _Pragma("unroll") for (int _i = 0; _i < 2; ++_i) \
        __builtin_amdgcn_global_load_lds((const unsigned*)((const char*)(gbase) + (voff)[_i]), (LAS unsigned*)(lds + (bufoff) + ldsw + _i * 8192), 16, 0, 0); } while (0)
#define PG8_LDA(dst, b, h) do { _Pragma("unroll") for (int m = 0; m < 4; ++m) _Pragma("unroll") for (int k = 0; k < 2; ++k) dst[m][k] = *(const LAS bf16x8*)(lds + PG8_SA(b, h) + aoff + m * 2048 + k * 1024); } while (0)
#define PG8_LDB(dst, b, h) do { _Pragma("unroll") for (int n = 0; n < 2; ++n) _Pragma("unroll") for (int k = 0; k < 2; ++k) dst[n][k] = *(const LAS bf16x8*)(lds + PG8_SB(b, h) + boff + n * 2048 + k * 1024); } while (0)
#define PG8_MMA(ai, bj, At, Bt) do { __builtin_amdgcn_s_setprio(1); _Pragma("unroll") for (int m = 0; m < 4; ++m) _Pragma("unroll") for (int n = 0; n < 2; ++n) _Pragma("unroll") for (int k = 0; k < 2; ++k) \
        acc[ai][bj][m][n] = __builtin_amdgcn_mfma_f32_16x16x32_bf16(Bt[n][k], At[m][k], acc[ai][bj][m][n], 0, 0, 0); __builtin_amdgcn_s_setprio(0); } while (0)
#define PG8_WAIT_V(n) asm volatile("s_waitcnt vmcnt(" #n ")" ::: "memory")
#define PG8_WAIT_L(n) asm volatile("s_waitcnt lgkmcnt(" #n ")" ::: "memory")
#define PG8_BAR __builtin_amdgcn_s_barrier()
#define PG8_SCHED __builtin_amdgcn_sched_barrier(0)
#define PG8_VOFF(dst, u) do { _Pragma("unroll") for (int _h = 0; _h < 2; ++_h) _Pragma("unroll") for (int _i = 0; _i < 2; ++_i) \
        dst[_h][_i] = (unsigned)S.arow(u, 128 * _h + RA[_i]) * (unsigned)(K * 2) + (unsigned)(CA[_i] * 2); } while (0)
    Unit cur, nxt; int ui = 0;
    if (!S.next(0, cur)) return;
    f32x4 acc[2][2][4][2];
#pragma unroll
    for (int a = 0; a < 2; ++a)
#pragma unroll
        for (int b = 0; b < 2; ++b)
#pragma unroll
            for (int m = 0; m < 4; ++m)
#pragma unroll
                for (int n = 0; n < 2; ++n) acc[a][b][m][n] = (f32x4){0.f, 0.f, 0.f, 0.f};
    bf16x8 At[4][2], B0[2][2], B1[2][2];
    unsigned vC[2][2], vN[2][2];
    PG8_VOFF(vC, cur);
    const char* cB = (const char*)S.bbase(cur);
    PG8_STAGE(PG8_SB(0, 0), cB, voffB); PG8_STAGE(PG8_SB(0, 1), cB + hstep, voffB); PG8_STAGE(PG8_SA(0, 0), Ab, vC[0]); PG8_STAGE(PG8_SA(0, 1), Ab, vC[1]);
    if (wr == 1) PG8_BAR;
    PG8_WAIT_V(2); PG8_BAR;
    PG8_STAGE(PG8_SB(1, 0), cB + kstepB, voffB); PG8_STAGE(PG8_SA(1, 0), Ab + kstep, vC[0]); PG8_STAGE(PG8_SB(1, 1), cB + hstep + kstepB, voffB);
    PG8_WAIT_V(6); PG8_BAR;
    for (;;) {
        const bool has_next = S.next(ui + 1, nxt);
        const char* nB = cB;
        if (has_next) { PG8_VOFF(vN, nxt); nB = (const char*)S.bbase(nxt); }
        else {
#pragma unroll
            for (int h = 0; h < 2; ++h)
#pragma unroll
                for (int i = 0; i < 2; ++i) vN[h][i] = vC[h][i]; }
        for (int t = 0; t < nt; t += 2) {
            const bool last = (t == nt - 2);
            const char* a1 = Ab + (size_t)(t + 1) * kstep;
            const char* a2 = last ? Ab : Ab + (size_t)(t + 2) * kstep; const char* b2 = last ? nB : cB + (size_t)(t + 2) * kstepB;
            const char* a3 = a2 + kstep; const char* b3 = b2 + kstepB;
            unsigned v2[2][2];
#pragma unroll
            for (int h = 0; h < 2; ++h)
#pragma unroll
                for (int i = 0; i < 2; ++i) v2[h][i] = last ? vN[h][i] : vC[h][i];
            PG8_LDB(B0, 0, 0); PG8_LDB(B1, 0, 1); PG8_SCHED; PG8_LDA(At, 0, 0); PG8_STAGE(PG8_SA(1, 1), a1, vC[1]);
            PG8_WAIT_V(8); PG8_WAIT_L(0); PG8_BAR; PG8_MMA(0, 0, At, B0); PG8_MMA(0, 1, At, B1); PG8_BAR; PG8_SCHED;
            PG8_LDA(At, 0, 1); PG8_STAGE(PG8_SB(0, 0), b2, voffB); PG8_STAGE(PG8_SB(0, 1), b2 + hstep, voffB); PG8_STAGE(PG8_SA(0, 0), a2, v2[0]);
            PG8_WAIT_V(8); PG8_WAIT_L(0); PG8_BAR; PG8_MMA(1, 0, At, B0); PG8_MMA(1, 1, At, B1); PG8_BAR; PG8_SCHED;
            PG8_LDB(B0, 1, 0); PG8_LDB(B1, 1, 1); PG8_SCHED; PG8_LDA(At, 1, 0); PG8_STAGE(PG8_SA(0, 1), a2, v2[1]);
            PG8_WAIT_V(8); PG8_WAIT_L(0); PG8_BAR; PG8_MMA(0, 0, At, B0); PG8_MMA(0, 1, At, B1); PG8_BAR; PG8_SCHED;
            PG8_LDA(At, 1, 1); PG8_STAGE(PG8_SB(1, 0), b3, voffB); PG8_STAGE(PG8_SB(1, 1), b3 + hstep, voffB); PG8_STAGE(PG8_SA(1, 0), a3, v2[0]);
            PG8_WAIT_V(8); PG8_WAIT_L(0); PG8_BAR; PG8_MMA(1, 0, At, B0); PG8_MMA(1, 1, At, B1); PG8_BAR; PG8_SCHED;
        }
        if (wr == 0) PG8_BAR;
        E(acc, cur, wr, wc, fr, fq);
        if (!has_next) break;
#pragma unroll
        for (int a = 0; a < 2; ++a)
#pragma unroll
            for (int b = 0; b < 2; ++b)
#pragma unroll
                for (int m = 0; m < 4; ++m)
#pragma unroll
                    for (int n = 0; n < 2; ++n) acc[a][b][m][n] = (f32x4){0.f, 0.f, 0.f, 0.f};
        cur = nxt; cB = nB; ++ui;
#pragma unroll
        for (int h = 0; h < 2; ++h)
#pragma unroll
            for (int i = 0; i < 2; ++i) vC[h][i] = vN[h][i];
        if (wr == 1) PG8_BAR;
    }
    PG8_WAIT_V(0);
    PG8_BAR;
#undef PG8_SA
#undef PG8_SB
#undef PG8_STAGE
#undef PG8_LDA
#undef PG8_LDB
#undef PG8_MMA
#undef PG8_WAIT_V
#undef PG8_WAIT_L
#undef PG8_BAR
#undef PG8_SCHED
#undef PG8_VOFF
}
#define GEMM gemm_fast

__device__ __forceinline__ u32x4 pack8(const f32x4& a, const f32x4& b) { u32x4 w; w.x = pk2(a[0], a[1]); w.y = pk2(a[2], a[3]); w.z = pk2(b[0], b[1]); w.w = pk2(b[2], b[3]); return w; }
template <bool GLU> struct EpiInProj {
    bf16_t* Q; bf16_t* KR; bf16_t* Vn; bf16_t* Gb;
    __device__ __forceinline__ void operator()(const f32x4 (&acc)[2][2][4][2], const Unit& u, int wr, int wc, int fr, int fq) const {
#pragma unroll
        for (int ai = 0; ai < 2; ++ai)
#pragma unroll
            for (int m = 0; m < 4; ++m) { const int irow = u.pm * 256 + 128 * ai + 64 * wr + 16 * m + fr; const size_t row = (size_t)irow; const int cl = 32 * wc + 8 * fq;
                if (u.pn < 2) { *(u32x4*)(Q + row * 512 + u.pn * 256 + cl) = pack8(acc[ai][0][m][0], acc[ai][0][m][1]); *(u32x4*)(Q + row * 512 + u.pn * 256 + 128 + cl) = pack8(acc[ai][1][m][0], acc[ai][1][m][1]); }
                else if (u.pn == 2) { const size_t kvrow = irow < TX ? (size_t)(irow >> 12) * KVS + CTXL + (irow & 4095) : (size_t)((irow - TX) >> 8) * KVS + ((irow - TX) & 255);
                    *(u32x4*)(KR + kvrow * 128 + cl) = pack8(acc[ai][0][m][0], acc[ai][0][m][1]); *(u32x4*)(Vn + kvrow * 128 + cl) = pack8(acc[ai][1][m][0], acc[ai][1][m][1]); }
                else if (GLU) { f32x4 g0, g1;
#pragma unroll
                    for (int j = 0; j < 4; ++j) { g0[j] = acc[ai][0][m][0][j] * sigmoidf_(acc[ai][1][m][0][j]); g1[j] = acc[ai][0][m][1][j] * sigmoidf_(acc[ai][1][m][1][j]); }
                    *(u32x4*)(Gb + row * 512 + (u.pn - 3) * 128 + cl) = pack8(g0, g1); }
                else { *(u32x4*)(Gb + row * 512 + (u.pn - 3) * 256 + cl) = pack8(acc[ai][0][m][0], acc[ai][0][m][1]); *(u32x4*)(Gb + row * 512 + (u.pn - 3) * 256 + 128 + cl) = pack8(acc[ai][1][m][0], acc[ai][1][m][1]); }
            }
    }
};
template <bool L0, bool DRY = false> struct EpiOutProj {
    Frame F; int l;
    __device__ __forceinline__ void operator()(const f32x4 (&acc)[2][2][4][2], const Unit& u, int wr, int wc, int fr, int fq) const {
        float* SS = (float*)(F.ws + WS_SS);
        const float* g1 = F.mod(l, modrow(u.pm * 256), 2) + u.pn * 256 + 32 * wc + 8 * fq;
        f32x4 gv[2][2];
#pragma unroll
        for (int bj = 0; bj < 2; ++bj)
#pragma unroll
            for (int n = 0; n < 2; ++n) gv[bj][n] = *(const f32x4*)(g1 + 128 * bj + 4 * n);
#pragma unroll
        for (int ai = 0; ai < 2; ++ai) {
            f32x4 xv[4][2][2];
#pragma unroll
            for (int m = 0; m < 4; ++m) { const int row = u.pm * 256 + 128 * ai + 64 * wr + 16 * m + fr; const int c0 = u.pn * 256 + 32 * wc + 8 * fq;
#pragma unroll
                for (int bj = 0; bj < 2; ++bj) {
                    if (L0) { const float* src = F.xin_row(row) + c0 + 128 * bj; xv[m][bj][0] = *(const f32x4*)(src); xv[m][bj][1] = *(const f32x4*)(src + 4); }
                    else { const u32x4 w = *(const u32x4*)(F.xr_row(row) + c0 + 128 * bj); xv[m][bj][0] = (f32x4){bflo(w.x), bfhi(w.x), bflo(w.y), bfhi(w.y)}; xv[m][bj][1] = (f32x4){bflo(w.z), bfhi(w.z), bflo(w.w), bfhi(w.w)}; } } }
#pragma unroll
            for (int m = 0; m < 4; ++m) { const int row = u.pm * 256 + 128 * ai + 64 * wr + 16 * m + fr; bf16_t* dst = F.xr_row(row) + u.pn * 256 + 32 * wc + 8 * fq; float q = 0.f;
#pragma unroll
                for (int bj = 0; bj < 2; ++bj) { const f32x4 v0 = xv[m][bj][0] + gv[bj][0] * acc[ai][bj][m][0], v1 = xv[m][bj][1] + gv[bj][1] * acc[ai][bj][m][1];
                    *(u32x4*)(dst + 128 * bj) = DRY ? pack8(xv[m][bj][0], xv[m][bj][1]) : pack8(v0, v1);
                    q += ((v0[0] * v0[0] + v0[1] * v0[1]) + (v0[2] * v0[2] + v0[3] * v0[3])) + ((v1[0] * v1[0] + v1[1] * v1[1]) + (v1[2] * v1[2] + v1[3] * v1[3])); }
                q += __shfl_xor(q, 16); q += __shfl_xor(q, 32);
                if (fq == 0) SS[(size_t)row * 16 + u.pn * 4 + wc] = q; }
        }
    }
};
struct EpiMoe1 {
    bf16_t* HID;
    __device__ __forceinline__ void operator()(const f32x4 (&acc)[2][2][4][2], const Unit& u, int wr, int wc, int fr, int fq) const {
#pragma unroll
        for (int ai = 0; ai < 2; ++ai)
#pragma unroll
            for (int m = 0; m < 4; ++m) { const size_t slot = (size_t)u.pm * 256 + 128 * ai + 64 * wr + 16 * m + fr; f32x4 h0, h1;
#pragma unroll
                for (int j = 0; j < 4; ++j) { const float a = acc[ai][0][m][0][j], b = acc[ai][0][m][1][j]; h0[j] = a * sigmoidf_(a) * acc[ai][1][m][0][j]; h1[j] = b * sigmoidf_(b) * acc[ai][1][m][1][j]; }
                *(u32x4*)(HID + slot * 512 + u.pn * 128 + 32 * wc + 8 * fq) = pack8(h0, h1); }
    }
};
struct EpiMoe2 {
    bf16_t* YB;
    __device__ __forceinline__ void operator()(const f32x4 (&acc)[2][2][4][2], const Unit& u, int wr, int wc, int fr, int fq) const {
#pragma unroll
        for (int ai = 0; ai < 2; ++ai)
#pragma unroll
            for (int m = 0; m < 4; ++m) { const size_t slot = (size_t)u.pm * 256 + 128 * ai + 64 * wr + 16 * m + fr;
#pragma unroll
                for (int bj = 0; bj < 2; ++bj) *(u32x4*)(YB + slot * 1024 + u.pn * 256 + 128 * bj + 32 * wc + 8 * fq) = pack8(acc[ai][bj][m][0], acc[ai][bj][m][1]); }
    }
};

__device__ __forceinline__ void p_k_post(const Frame& F, const float* kg) {
    const int gw = F.vcu * NWAVES + F.wave, NGW = F.G * NWAVES, lane = F.lane;
    const bf16_t* KR = (const bf16_t*)(F.ws + WS_KV); bf16_t* Kn = (bf16_t*)(F.ws + WS_KN);
    const float* rc = (const float*)(F.ws + WS_ROPE); const float* rs = rc + SEQ * 32;
    const int c16 = lane & 15, i8 = c16 & 7, dd0 = 8 * (i8 & 3), sub = lane >> 4;
    float gk[8];
#pragma unroll
    for (int j = 0; j < 8; ++j) gk[j] = kg[i8 * 8 + j];
    const float sgn = (i8 < 4) ? -1.f : 1.f;
    for (int it = gw; it < NB * KVS / 16; it += NGW) {
        u32x4 w[4];
#pragma unroll
        for (int q = 0; q < 4; ++q) w[q] = *(const u32x4*)(KR + (size_t)(it * 16 + 4 * q + sub) * 128 + c16 * 8);
#pragma unroll
        for (int q = 0; q < 4; ++q) { const int kvrow = it * 16 + 4 * q + sub, pos = kvrow % KVS;
            float cs[8], sn[8];
#pragma unroll
            for (int j = 0; j < 8; ++j) { cs[j] = 1.f; sn[j] = 0.f; }
            if (pos >= CTXL) { const int sq = pos - CTXL; const f32x4 c0 = *(const f32x4*)(rc + sq * 32 + dd0), c1 = *(const f32x4*)(rc + sq * 32 + dd0 + 4), s0 = *(const f32x4*)(rs + sq * 32 + dd0), s1 = *(const f32x4*)(rs + sq * 32 + dd0 + 4);
#pragma unroll
                for (int j = 0; j < 4; ++j) { cs[j] = c0[j]; cs[4 + j] = c1[j]; sn[j] = s0[j]; sn[4 + j] = s1[j]; } }
            float x[8] = {bflo(w[q].x), bfhi(w[q].x), bflo(w[q].y), bfhi(w[q].y), bflo(w[q].z), bfhi(w[q].z), bflo(w[q].w), bfhi(w[q].w)};
            float ss = 0.f;
#pragma unroll
            for (int j = 0; j < 8; ++j) ss += x[j] * x[j];
            ss += __shfl_xor(ss, 1); ss += __shfl_xor(ss, 2); ss += __shfl_xor(ss, 4);
            const float rms = 1.0f / sqrtf(ss * (1.f / 64.f) + EPS);
            float y[8], o[8];
#pragma unroll
            for (int j = 0; j < 8; ++j) y[j] = x[j] * rms * gk[j];
#pragma unroll
            for (int j = 0; j < 8; ++j) { const float yp = __shfl_xor(y[j], 4); o[j] = y[j] * cs[j] + sgn * yp * sn[j]; }
            u32x4 ow; ow.x = pk2(o[0], o[1]); ow.y = pk2(o[2], o[3]); ow.z = pk2(o[4], o[5]); ow.w = pk2(o[6], o[7]);
            *(u32x4*)(Kn + (size_t)kvrow * 128 + c16 * 8) = ow; }
    }
}
__device__ __forceinline__ void p_conv(const Frame& F) {
    const bf16_t* Gb = (const bf16_t*)(F.ws + WS_G); bf16_t* AO = (bf16_t*)(F.ws + WS_AO);
    LAS bf16_t* gl = (LAS bf16_t*)F.lds;
    LAS float* yl = (LAS float*)(F.lds + 65536);
    const int c = F.tid;
    float w[31];
#pragma unroll
    for (int j = 0; j < 31; ++j) w[j] = F.in[I_CONVW][j * 512 + c];
    const float bias = F.in[I_CONVB][c];
    for (int item = F.vcu; item < 1024 + 64; item += F.G) {
        int rowbase, t0, len;
        if (item < 1024) { rowbase = (item >> 7) * SEQ; t0 = (item & 127) * 32; len = SEQ; } else { const int it = item - 1024; rowbase = TX + (it >> 3) * CTXL; t0 = (it & 7) * 32; len = CTXL; }
        __syncthreads();
        for (int ch = F.tid; ch < 62 * 64; ch += NTHREADS) { const int r = ch >> 6, p = t0 - 15 + r; u32x4 v = (u32x4){0u, 0u, 0u, 0u};
            if (p >= 0 && p < len) v = *(const u32x4*)(Gb + (size_t)(rowbase + p) * 512 + (ch & 63) * 8);
            *(LAS u32x4*)(gl + r * 512 + (ch & 63) * 8) = v; }
        __syncthreads();
        float g[62];
#pragma unroll
        for (int r = 0; r < 62; ++r) g[r] = bf2f(gl[r * 512 + c]);
#pragma unroll
        for (int t = 0; t < 32; ++t) { float y = bias;
#pragma unroll
            for (int j = 0; j < 31; ++j) y += g[t + j] * w[j];
            yl[t * 512 + c] = y; }
        __syncthreads();
#pragma unroll
        for (int tt = 0; tt < 4; ++tt) { const int t = 4 * F.wave + tt; float v[8]; float s = 0.f;
#pragma unroll
            for (int j = 0; j < 8; ++j) { v[j] = yl[t * 512 + F.lane + 64 * j]; s += v[j]; }
            const float mean = wave_sum(s) * (1.f / 512.f); float q = 0.f;
#pragma unroll
            for (int j = 0; j < 8; ++j) { v[j] -= mean; q += v[j] * v[j]; }
            const float rstd = 1.0f / sqrtf(wave_sum(q) * (1.f / 512.f) + EPS);
            bf16_t* orow = AO + (size_t)(rowbase + t0 + t) * 1024 + 512;
#pragma unroll
            for (int j = 0; j < 8; ++j) { const int cc = F.lane + 64 * j; const float yn = v[j] * rstd * F.in[I_CLNG][cc] + F.in[I_CLNB][cc]; orow[cc] = (bf16_t)(pk2(yn * sigmoidf_(yn), 0.f) & 0xffffu); } }
    }
    __syncthreads();
}
__device__ __forceinline__ void p_pool(const Frame& F) {
    const int gw = F.vcu * NWAVES + F.wave, NGW = F.G * NWAVES, lane = F.lane;
    const bf16_t* U = (const bf16_t*)(F.ws + WS_G); bf16_t* AO = (bf16_t*)(F.ws + WS_AO);
    const int hw = 1 << (lane >> 4);
    float wgt[16];
#pragma unroll
    for (int i = 0; i < 16; ++i) wgt[i] = (i >= 8 - hw && i < 8 + hw) ? 1.f : 0.f;
    for (int it = gw; it < TX / 8; it += NGW) {
        const int row0 = it * 8, t0 = row0 & 4095, rb = row0 - t0;
        u32x4 r[23];
#pragma unroll
        for (int j = 0; j < 23; ++j) { const int p = t0 - 8 + j; r[j] = (u32x4){0u, 0u, 0u, 0u}; if (p >= 0 && p < SEQ) r[j] = *(const u32x4*)(U + (size_t)(rb + p) * 512 + lane * 8); }
#pragma unroll
        for (int t = 0; t < 8; ++t) {
            float s[8];
#pragma unroll
            for (int j = 0; j < 8; ++j) s[j] = 0.f;
#pragma unroll
            for (int i = 0; i < 16; ++i) { const u32x4 w = r[t + i]; const float g = wgt[i];
                s[0] += g * bflo(w.x); s[1] += g * bfhi(w.x); s[2] += g * bflo(w.y); s[3] += g * bfhi(w.y); s[4] += g * bflo(w.z); s[5] += g * bfhi(w.z); s[6] += g * bflo(w.w); s[7] += g * bfhi(w.w); }
            const int tt = t0 + t; int lo = tt - hw, hi = tt + hw; lo = lo < 0 ? 0 : lo; hi = hi > SEQ ? SEQ : hi;
            const float inv = 1.f / (float)(hi - lo); const u32x4 w = r[t + 8];
            u32x4 ow; ow.x = pk2(s[0] * inv - bflo(w.x), s[1] * inv - bfhi(w.x)); ow.y = pk2(s[2] * inv - bflo(w.y), s[3] * inv - bfhi(w.y)); ow.z = pk2(s[4] * inv - bflo(w.z), s[5] * inv - bfhi(w.z)); ow.w = pk2(s[6] * inv - bflo(w.w), s[7] * inv - bfhi(w.w));
            *(u32x4*)(AO + (size_t)(row0 + t) * 1024 + 512 + lane * 8) = ow;
        }
    }
}

template <int LAYER> __device__ __forceinline__ void attn_simple(const Frame& F) {
    const bf16_t* Q = (const bf16_t*)(F.ws + WS_Q); const bf16_t* Kn = (const bf16_t*)(F.ws + WS_KN); const bf16_t* Vn = (const bf16_t*)(F.ws + WS_VN); bf16_t* AO = (bf16_t*)(F.ws + WS_AO);
    const int nunits = LAYER == 0 ? 512 + 64 : 512;
    for (int u = F.vcu; u < nunits; u += F.G) {
        int b, h, row, s; bool valid = true, isctx = false;
        if (u < 512) { b = u >> 6; h = (u >> 3) & 7; s = (u & 7) * 512 + F.tid; row = b * SEQ + s; }
        else { const int uc = u - 512; b = uc >> 3; h = uc & 7; s = F.tid; valid = F.tid < 256; row = TX + b * CTXL + (valid ? s : 0); isctx = true; }
        float q[64], o[64];
        { const u32x4* qp = (const u32x4*)(Q + (size_t)row * 512 + h * 64);
#pragma unroll
          for (int c = 0; c < 8; ++c) { const u32x4 w = qp[c]; q[8 * c] = bflo(w.x); q[8 * c + 1] = bfhi(w.x); q[8 * c + 2] = bflo(w.y); q[8 * c + 3] = bfhi(w.y); q[8 * c + 4] = bflo(w.z); q[8 * c + 5] = bfhi(w.z); q[8 * c + 6] = bflo(w.w); q[8 * c + 7] = bfhi(w.w); } }
#pragma unroll
        for (int d = 0; d < 64; ++d) o[d] = 0.f;
        float mx = -1e30f, l = 0.f;
        const bf16_t* Kb = Kn + (size_t)b * KVS * 128 + (h >> 2) * 64; const bf16_t* Vb = Vn + (size_t)b * KVS * 128 + (h >> 2) * 64;
        int k_lo2 = 0, k_hi2 = 0;
        const int k_hi1 = CTXL;
        if (LAYER == 0) { if (!isctx) { k_lo2 = CTXL; k_hi2 = KVS; } }
        else { const int s0 = (u & 7) * 512; int lo = s0 - 128, hi = s0 + 511 + 128 + 1; lo = lo < 0 ? 0 : lo; hi = hi > SEQ ? SEQ : hi; k_lo2 = CTXL + lo; k_hi2 = CTXL + hi; }
        for (int part = 0; part < 2; ++part) {
            const int kb = part == 0 ? 0 : k_lo2, ke = part == 0 ? k_hi1 : k_hi2;
            for (int key = kb; key < ke; ++key) {
                const u32x4* kp = (const u32x4*)(Kb + (size_t)key * 128); float sd = 0.f;
#pragma unroll
                for (int c = 0; c < 8; ++c) { const u32x4 w = kp[c];
                    sd += q[8 * c] * bflo(w.x) + q[8 * c + 1] * bfhi(w.x) + q[8 * c + 2] * bflo(w.y) + q[8 * c + 3] * bfhi(w.y) + q[8 * c + 4] * bflo(w.z) + q[8 * c + 5] * bfhi(w.z) + q[8 * c + 6] * bflo(w.w) + q[8 * c + 7] * bfhi(w.w); }
                bool use = valid;
                if (LAYER == 1 && part == 1) { const int j = key - CTXL; const int dlt = s - j; use = use && (dlt <= 128 && dlt >= -128); }
                const float mn = fmaxf(mx, sd); const float mnew = use ? mn : mx;
                const float alpha = exp2f(mx - mnew), p = use ? exp2f(sd - mnew) : 0.f;
                mx = mnew; l = l * alpha + p;
                const u32x4* vp = (const u32x4*)(Vb + (size_t)key * 128);
#pragma unroll
                for (int c = 0; c < 8; ++c) { const u32x4 w = vp[c];
                    o[8 * c] = o[8 * c] * alpha + p * bflo(w.x); o[8 * c + 1] = o[8 * c + 1] * alpha + p * bfhi(w.x); o[8 * c + 2] = o[8 * c + 2] * alpha + p * bflo(w.y); o[8 * c + 3] = o[8 * c + 3] * alpha + p * bfhi(w.y);
                    o[8 * c + 4] = o[8 * c + 4] * alpha + p * bflo(w.z); o[8 * c + 5] = o[8 * c + 5] * alpha + p * bfhi(w.z); o[8 * c + 6] = o[8 * c + 6] * alpha + p * bflo(w.w); o[8 * c + 7] = o[8 * c + 7] * alpha + p * bfhi(w.w); }
            }
        }
        if (LAYER == 1) l += exp2f(F.in[I_SINK][h] * LOG2E - mx);
        const float il = 1.f / l;
        if (valid) { u32x4* op = (u32x4*)(AO + (size_t)row * 1024 + h * 64);
#pragma unroll
            for (int c = 0; c < 8; ++c) { u32x4 w; w.x = pk2(o[8 * c] * il, o[8 * c + 1] * il); w.y = pk2(o[8 * c + 2] * il, o[8 * c + 3] * il); w.z = pk2(o[8 * c + 4] * il, o[8 * c + 5] * il); w.w = pk2(o[8 * c + 6] * il, o[8 * c + 7] * il); op[c] = w; } }
    }
}

#include <hip/hip_bf16.h>
namespace attn_body {
using bf16=__hip_bfloat16;
using s16x4=__attribute__((ext_vector_type(4)))short;
using f32x16=__attribute__((ext_vector_type(16)))float;
constexpr int NW=8,QBLK=32,QB=QBLK*NW,KVBLK=64;
constexpr int QP=512,KP=128,OP=1024;
__device__ __forceinline__ int crow(int r,int hi){return (r&3)+8*(r>>2)+4*hi;}
#define SBAR() __builtin_amdgcn_sched_barrier(0)
__device__ __forceinline__ void wmask(f32x16&p0,f32x16&p1,int dlt0,int hi){
  const float NEG=-INFINITY; const int kb=dlt0+4*hi;
  #pragma unroll
  for(int r=0;r<16;++r){const int d=kb+(r&3)+8*(r>>2); if(d>128||d<-128)p0[r]=NEG; if(d+32>128||d+32<-128)p1[r]=NEG;}
}

constexpr int NSLOT=3, SLOTB=8192;
constexpr int LDS_K=0, LDS_V=NSLOT*SLOTB, LDS_WS=2*NSLOT*SLOTB, LDS_OST=LDS_WS+NW*64*4, LDS_BYTES=LDS_OST+NW*4096;
__device__ __forceinline__ void glds16(const void*gsrc,unsigned lds_dst){unsigned keep;
  asm volatile("s_mov_b32 %0, m0\n\ts_mov_b32 m0, %2\n\ts_nop 0\n\tglobal_load_lds_dwordx4 %1, off\n\ts_mov_b32 m0, %0":"=&s"(keep):"v"(gsrc),"s"(lds_dst):"memory");}
__device__ __forceinline__ float max3f(float a,float b,float c){float r;asm("v_max3_f32 %0, %1, %2, %3":"=v"(r):"v"(a),"v"(b),"v"(c));return r;}
__device__ __forceinline__ float max2f(float a,float b){float r;asm("v_max_f32_e32 %0, %1, %2":"=v"(r):"v"(a),"v"(b));return r;}
__device__ __forceinline__ float fadd_s(float a,float b){float r;asm("v_add_f32_e32 %0, %1, %2":"=v"(r):"v"(a),"v"(b));return r;}
__device__ __forceinline__ float fsub_s(float a,float b){float r;asm("v_sub_f32_e32 %0, %1, %2":"=v"(r):"v"(a),"v"(b));return r;}
typedef float f32x2_t __attribute__((ext_vector_type(2))); typedef __bf16 bf16x2_t __attribute__((ext_vector_type(2)));
__device__ __forceinline__ unsigned cvtpk_s(float lo,float hi){f32x2_t v={lo,hi};bf16x2_t b=__builtin_convertvector(v,bf16x2_t);return __builtin_bit_cast(unsigned,b);}
#define WAIT_BAR(N) asm volatile("s_waitcnt vmcnt(" #N ") lgkmcnt(0)\n\ts_barrier":::"memory")

__device__ __forceinline__ void qkt(f32x16&p0,f32x16&p1,const char*Kslot,const bf16x8*qr,const f32x16&negm,int r32,int hi){
  const char*kb=Kslot+hi*1024+r32*16;
  #pragma unroll
  for(int d0=0;d0<4;++d0){
    const bf16x8 b0=*reinterpret_cast<const bf16x8*>(kb+d0*2048);
    const bf16x8 b1=*reinterpret_cast<const bf16x8*>(kb+d0*2048+512);
    if(d0==0){p0=__builtin_amdgcn_mfma_f32_32x32x16_bf16(b0,qr[0],negm,0,0,0);p1=__builtin_amdgcn_mfma_f32_32x32x16_bf16(b1,qr[0],negm,0,0,0);}
    else{p0=__builtin_amdgcn_mfma_f32_32x32x16_bf16(b0,qr[d0],p0,0,0,0);p1=__builtin_amdgcn_mfma_f32_32x32x16_bf16(b1,qr[d0],p1,0,0,0);}}
}
typedef __attribute__((address_space(3))) const char* lds_cptr;
typedef short v4i16_t __attribute__((ext_vector_type(4)));
__device__ __forceinline__ void kload8(bf16x8*kf,lds_cptr kp){
  kf[0]=*(const __attribute__((address_space(3))) bf16x8*)(kp);      kf[1]=*(const __attribute__((address_space(3))) bf16x8*)(kp+512);
  kf[2]=*(const __attribute__((address_space(3))) bf16x8*)(kp+2048); kf[3]=*(const __attribute__((address_space(3))) bf16x8*)(kp+2560);
  kf[4]=*(const __attribute__((address_space(3))) bf16x8*)(kp+4096); kf[5]=*(const __attribute__((address_space(3))) bf16x8*)(kp+4608);
  kf[6]=*(const __attribute__((address_space(3))) bf16x8*)(kp+6144); kf[7]=*(const __attribute__((address_space(3))) bf16x8*)(kp+6656);
}
__device__ __forceinline__ void kload2(bf16x8*kf,lds_cptr kp,int j){ kf[2*j]=*(const __attribute__((address_space(3))) bf16x8*)(kp+j*2048); kf[2*j+1]=*(const __attribute__((address_space(3))) bf16x8*)(kp+j*2048+512); }
__device__ __forceinline__ s16x4 vtr(lds_cptr p){ return __builtin_bit_cast(s16x4,__builtin_amdgcn_ds_read_tr16_b64_v4i16((__attribute__((address_space(3))) v4i16_t*)p)); }
__device__ __forceinline__ float rowmax(const f32x16&p0,const f32x16&p1){
  float a=max3f(p0[0],p0[1],p1[0]),b=max3f(p0[2],p0[3],p1[1]);a=max3f(a,p1[2],p1[3]);
  #pragma unroll
  for(int r=4;r<16;r+=4){a=max3f(a,p0[r],p0[r+1]);b=max3f(b,p0[r+2],p0[r+3]);a=max3f(a,p1[r],p1[r+1]);b=max3f(b,p1[r+2],p1[r+3]);}
  const float m=max2f(a,b);
  auto rr=__builtin_amdgcn_permlane32_swap(__float_as_uint(m),__float_as_uint(m),false,false);
  return max2f(__uint_as_float(rr[0]),__uint_as_float(rr[1]));
}
__device__ __forceinline__ void pv(f32x16*o,int vb,bf16x8 pa0,bf16x8 pa1,bf16x8 pa2,bf16x8 pa3){
  #pragma unroll
  for(int d0=0;d0<2;++d0){s16x4 lo[4],hi[4];
    #pragma unroll
    for(int ks=0;ks<4;++ks){
      asm volatile("ds_read_b64_tr_b16 %0,%1 offset:%c2":"=&v"(lo[ks]):"v"(vb),"i"(d0*4096+ks*1024):"memory");
      asm volatile("ds_read_b64_tr_b16 %0,%1 offset:%c2":"=&v"(hi[ks]):"v"(vb),"i"(d0*4096+ks*1024+512):"memory");}
    asm volatile("s_waitcnt lgkmcnt(0)":::"memory");SBAR();
    #define PK(k) (bf16x8){lo[k][0],lo[k][1],lo[k][2],lo[k][3],hi[k][0],hi[k][1],hi[k][2],hi[k][3]}
    o[d0]=__builtin_amdgcn_mfma_f32_32x32x16_bf16(pa0,PK(0),o[d0],0,0,0);
    o[d0]=__builtin_amdgcn_mfma_f32_32x32x16_bf16(pa1,PK(1),o[d0],0,0,0);
    o[d0]=__builtin_amdgcn_mfma_f32_32x32x16_bf16(pa2,PK(2),o[d0],0,0,0);
    o[d0]=__builtin_amdgcn_mfma_f32_32x32x16_bf16(pa3,PK(3),o[d0],0,0,0);
    #undef PK
  }
}

#ifndef ATTN_STORE16
#define ATTN_STORE16(p,v) (*(u32x4*)(p)=(v))
#endif
template<int MODE,int THRL> __device__ __forceinline__ void attn_unit(const bf16*Qu,const bf16*__restrict__ Kh,const bf16*__restrict__ Vh,bf16*Ou,const int NT,const int lat0,const int q0s,const float sinkl2,const float*qg,const float*ropec,const bool rope,char*shm){
  const int tid=threadIdx.x,lane=tid&63,r32=lane&31,hi=lane>>5; const int wid=__builtin_amdgcn_readfirstlane(tid>>6);
  const bf16*Qw=Qu+(long)(wid*QBLK)*QP;
  const unsigned lds0=(unsigned)(uintptr_t)shm;
  float*wsf=(float*)(shm+LDS_WS)+wid*64;
  const bf16*ksrc=Kh+(long)lane*KP+wid*8;
  const bf16*vsrc=Vh+(long)(16*(wid&3)+(lane>>2))*KP+(wid>>2)*32+(lane&3)*8;
  const unsigned kdst=lds0+LDS_K+wid*1024, vdst=lds0+LDS_V+wid*1024;
  #define TROW(t) ((MODE==0||(t)<4)?(t)*KVBLK:lat0+((t)-4)*KVBLK)
  #define DMA_K(t,slot) glds16(ksrc+(long)TROW(t)*KP,(unsigned)__builtin_amdgcn_readfirstlane(kdst+(slot)))
  #define DMA_V(t,slot) glds16(vsrc+(long)TROW(t)*KP,(unsigned)__builtin_amdgcn_readfirstlane(vdst+(slot)))
  const int vb0=(int)(lds0+LDS_V)+((lane>>4)&1)*32+(lane&3)*8+(4*hi+((lane&15)>>2))*64;
  const char*Kbase=shm+LDS_K; bf16x8 kf[8];
  const lds_cptr shm3=(lds_cptr)shm; const lds_cptr kp0=shm3+LDS_K+hi*1024+r32*16; const lds_cptr vp0=shm3+LDS_V+((lane>>4)&1)*32+(lane&3)*8+(4*hi+((lane&15)>>2))*64;
  DMA_K(0,0);DMA_V(0,0);DMA_K(1,SLOTB);
  bf16x8 qr[4];
  const int qpos=q0s+wid*QBLK+r32;
  {
    u32x4 qraw[4];
    #pragma unroll
    for(int d0=0;d0<4;++d0) qraw[d0]=*reinterpret_cast<const u32x4*>(&Qw[(long)r32*QP+d0*16+hi*8]);
    float x[4][8]; float ss=0.f;
    #pragma unroll
    for(int d0=0;d0<4;++d0){ x[d0][0]=bflo(qraw[d0].x);x[d0][1]=bfhi(qraw[d0].x);x[d0][2]=bflo(qraw[d0].y);x[d0][3]=bfhi(qraw[d0].y);x[d0][4]=bflo(qraw[d0].z);x[d0][5]=bfhi(qraw[d0].z);x[d0][6]=bflo(qraw[d0].w);x[d0][7]=bfhi(qraw[d0].w);
      #pragma unroll
      for(int j=0;j<8;++j)ss+=x[d0][j]*x[d0][j]; }
    {auto rr=__builtin_amdgcn_permlane32_swap(__float_as_uint(ss),__float_as_uint(ss),false,false);ss=__uint_as_float(rr[0])+__uint_as_float(rr[1]);}
    const float rms=C2/sqrtf(ss*(1.f/64.f)+EPS);
    SBAR();
    #pragma unroll
    for(int d0=0;d0<2;++d0){
      #pragma unroll
      for(int hf=0;hf<2;++hf){
        const f32x4 ga=*reinterpret_cast<const f32x4*>(qg+d0*16+hi*8+4*hf), gb=*reinterpret_cast<const f32x4*>(qg+(d0+2)*16+hi*8+4*hf);
        f32x4 cc=f32x4{1.f,1.f,1.f,1.f}, sn=f32x4{0.f,0.f,0.f,0.f};
        if(rope){ const float*pc=ropec+(long)qpos*32+d0*16+hi*8+4*hf; cc=*reinterpret_cast<const f32x4*>(pc); sn=*reinterpret_cast<const f32x4*>(pc+SEQ*32); }
        #pragma unroll
        for(int j=0;j<4;++j){ const float a=x[d0][4*hf+j]*rms*ga[j], b=x[d0+2][4*hf+j]*rms*gb[j]; x[d0][4*hf+j]=a*cc[j]-b*sn[j]; x[d0+2][4*hf+j]=b*cc[j]+a*sn[j]; }
        SBAR(); } }
    #pragma unroll
    for(int d0=0;d0<4;++d0){ u32x4 w; w.x=cvtpk_s(x[d0][0],x[d0][1]);w.y=cvtpk_s(x[d0][2],x[d0][3]);w.z=cvtpk_s(x[d0][4],x[d0][5]);w.w=cvtpk_s(x[d0][6],x[d0][7]); qr[d0]=__builtin_bit_cast(bf16x8,w); } }
  float mhat=0.f,l_reg=0.f;f32x16 o[2],negm; { float z_=0.f; asm volatile("":"+v"(z_));
    #pragma unroll
    for(int r=0;r<16;++r){o[0][r]=z_;o[1][r]=z_;negm[r]=z_;} } asm volatile("":"+v"(negm));
  #define CMASK(P0,P1,t) do{ if(MODE==1&&(t)>=4) wmask(P0,P1,(lat0-256)+((t)-4)*KVBLK-qpos,hi); }while(0)
  bool resc=false;
  #define START(P0,P1) do{ const float rm=rowmax(P0,P1); resc=false; \
    { const float dl=rm; mhat=fadd_s(mhat,dl); \
      _Pragma("unroll") for(int r=0;r<16;++r){P0[r]=fsub_s(P0[r],dl);P1[r]=fsub_s(P1[r],dl);} \
      _Pragma("unroll") for(int r=0;r<16;++r)negm[r]=-mhat; asm volatile("":"+v"(negm)); } \
    _Pragma("unroll") for(int r=0;r<16;++r)P0[r]=__builtin_amdgcn_exp2f(P0[r]); }while(0)
  #define RESC() do{ if(resc){ asm volatile("s_waitcnt lgkmcnt(0)":::"memory"); \
      _Pragma("unroll") for(int d_=0;d_<2;++d_) _Pragma("unroll") for(int r=0;r<16;++r)o[d_][r]*=wsf[crow(r,hi)]; } }while(0)
  f32x16 pA0,pA1,pB0,pB1;
  int sl_prev=0,sl_cur=0,sl_next=SLOTB;
  #define ROT() do{sl_prev=sl_cur;sl_cur=sl_next;sl_next=(sl_next==(NSLOT-1)*SLOTB)?0:sl_next+SLOTB;}while(0)
  DMA_K(2,2*SLOTB);
  WAIT_BAR(3);
  qkt(pA0,pA1,Kbase,qr,negm,r32,hi);asm volatile("s_nop 15\n\ts_nop 7":"+v"(pA0),"+v"(pA1));CMASK(pA0,pA1,0);
  START(pA0,pA1);
  _Pragma("unroll") for(int r=0;r<16;++r)pA1[r]=__builtin_amdgcn_exp2f(pA1[r]);
  WAIT_BAR(0);
  DMA_K(3,0);DMA_V(1,SLOTB);
  ROT();
  kload8(kf,kp0+sl_cur);
  WAIT_BAR(2);
  s16x4 vlo[8],vhi[8]; u32x4 pw0,pw1,pw2,pw3;
  #define PKW(P,B) cvtpk_s(P[B],P[B+1])
  #define PAF(k) __builtin_bit_cast(bf16x8,pw##k)
  #define VFR(i) (bf16x8){vlo[i][0],vlo[i][1],vlo[i][2],vlo[i][3],vhi[i][0],vhi[i][1],vhi[i][2],vhi[i][3]}
  #define PIN(x) asm volatile("":"+v"(x))
  #define MX3(a,b,c) __builtin_fmaxf(__builtin_fmaxf((a),(b)),(c))
  #define GAPA(MF,A0,A1,A2,A3,W0,W1,PW) do{ MF; sacc+=A0; sacc+=A1; sacc+=A2; sacc+=A3; PIN(sacc); W0; W1; PIN(PW); SBAR(); }while(0)
  #define EX(v) __builtin_amdgcn_exp2f(v)
  #define GAPB(MF,X,B) do{ MF; X[B]=EX(X[B]); X[B+1]=EX(X[B+1]); X[B+2]=EX(X[B+2]); X[B+3]=EX(X[B+3]); PIN(X); SBAR(); }while(0)
  #define VRD(i) do{ vlo[i]=vtr(vp_+(((i)>>2)*4096+((i)&3)*1024)); vhi[i]=vtr(vp_+(((i)>>2)*4096+((i)&3)*1024+512)); }while(0)
  #define KRD(G,j) do{ if(G){ kload2(kf,kp0+sl_next,j); SBAR(); } }while(0)
  #define STEP(C0,C1,P0,P1,t,GK,GV,GL) do{ SBAR(); \
    const lds_cptr vp_=vp0+sl_prev; \
    VRD(0); SBAR(); float sacc=(P0[0]+P0[1]); \
    GAPA(C0=__builtin_amdgcn_mfma_f32_32x32x16_bf16(kf[0],qr[0],negm,0,0,0), P0[2],P0[3],P0[4],P0[5],     pw0[0]=PKW(P0,0), pw0[1]=PKW(P0,2), pw0); \
    VRD(4); SBAR(); GAPA(C1=__builtin_amdgcn_mfma_f32_32x32x16_bf16(kf[1],qr[0],negm,0,0,0), P0[6],P0[7],P0[8],P0[9],     pw0[2]=PKW(P0,4), pw0[3]=PKW(P0,6), pw0); \
    VRD(1); SBAR(); GAPA(C0=__builtin_amdgcn_mfma_f32_32x32x16_bf16(kf[2],qr[1],C0,0,0,0),   P0[10],P0[11],P0[12],P0[13], pw1[0]=PKW(P0,8), pw1[1]=PKW(P0,10), pw1); \
    VRD(5); SBAR(); GAPA(C1=__builtin_amdgcn_mfma_f32_32x32x16_bf16(kf[3],qr[1],C1,0,0,0),   P0[14],P0[15],P1[0],P1[1],   pw1[2]=PKW(P0,12),pw1[3]=PKW(P0,14), pw1); \
    VRD(2); SBAR(); GAPA(C0=__builtin_amdgcn_mfma_f32_32x32x16_bf16(kf[4],qr[2],C0,0,0,0),   P1[2],P1[3],P1[4],P1[5],     pw2[0]=PKW(P1,0), pw2[1]=PKW(P1,2), pw2); \
    VRD(6); SBAR(); GAPA(C1=__builtin_amdgcn_mfma_f32_32x32x16_bf16(kf[5],qr[2],C1,0,0,0),   P1[6],P1[7],P1[8],P1[9],     pw2[2]=PKW(P1,4), pw2[3]=PKW(P1,6), pw2); \
    VRD(3); SBAR(); GAPA(C0=__builtin_amdgcn_mfma_f32_32x32x16_bf16(kf[6],qr[3],C0,0,0,0),   P1[10],P1[11],P1[12],P1[13], pw3[0]=PKW(P1,8), pw3[1]=PKW(P1,10), pw3); \
    VRD(7); SBAR(); GAPA(C1=__builtin_amdgcn_mfma_f32_32x32x16_bf16(kf[7],qr[3],C1,0,0,0),   P1[14],P1[15],0.f,0.f,       pw3[2]=PKW(P1,12),pw3[3]=PKW(P1,14), pw3); \
    l_reg+=sacc; \
    if(GK){DMA_K((t)+3,sl_cur);} if(GV){DMA_V((t)+1,sl_next);} \
    CMASK(C0,C1,t); \
    { float a=MX3(C0[0],C0[1],C1[0]),b=MX3(C0[2],C0[3],C1[1]); a=MX3(a,C1[2],C1[3]); \
      _Pragma("unroll") for(int r=4;r<16;r+=4){a=MX3(a,C0[r],C0[r+1]);b=MX3(b,C0[r+2],C0[r+3]);a=MX3(a,C1[r],C1[r+1]);b=MX3(b,C1[r+2],C1[r+3]);} \
      float rm=__builtin_fmaxf(a,b); { auto rr=__builtin_amdgcn_permlane32_swap(__float_as_uint(rm),__float_as_uint(rm),false,false); rm=__builtin_fmaxf(__uint_as_float(rr[0]),__uint_as_float(rr[1])); } \
      resc=false; \
      if(__builtin_expect(__any(rm>(float)THRL),0)){ const float dl=__builtin_fmaxf(rm,0.f); mhat+=dl; \
        _Pragma("unroll") for(int r=0;r<16;++r){C0[r]-=dl;C1[r]-=dl;} \
        _Pragma("unroll") for(int r=0;r<16;++r)negm[r]=-mhat; asm volatile("":"+v"(negm)); \
        const float f=__builtin_amdgcn_exp2f(-dl); l_reg*=f; if(hi==0)wsf[r32]=f; resc=true; } } \
    SBAR(); \
    GAPB(o[0]=__builtin_amdgcn_mfma_f32_32x32x16_bf16(PAF(0),VFR(0),o[0],0,0,0), C0,0); \
    GAPB(o[1]=__builtin_amdgcn_mfma_f32_32x32x16_bf16(PAF(0),VFR(4),o[1],0,0,0), C0,4); \
    KRD(GL,0); GAPB(o[0]=__builtin_amdgcn_mfma_f32_32x32x16_bf16(PAF(1),VFR(1),o[0],0,0,0), C0,8); \
    KRD(GL,1); GAPB(o[1]=__builtin_amdgcn_mfma_f32_32x32x16_bf16(PAF(1),VFR(5),o[1],0,0,0), C0,12); \
    KRD(GL,2); GAPB(o[0]=__builtin_amdgcn_mfma_f32_32x32x16_bf16(PAF(2),VFR(2),o[0],0,0,0), C1,0); \
    KRD(GL,3); GAPB(o[1]=__builtin_amdgcn_mfma_f32_32x32x16_bf16(PAF(2),VFR(6),o[1],0,0,0), C1,4); \
    GAPB(o[0]=__builtin_amdgcn_mfma_f32_32x32x16_bf16(PAF(3),VFR(3),o[0],0,0,0), C1,8); \
    GAPB(o[1]=__builtin_amdgcn_mfma_f32_32x32x16_bf16(PAF(3),VFR(7),o[1],0,0,0), C1,12); \
    }while(0)
  int t=1;
  for(;t+5<NT;t+=2){
    STEP(pB0,pB1,pA0,pA1,t,true,true,true);     WAIT_BAR(2); RESC(); ROT();
    STEP(pA0,pA1,pB0,pB1,t+1,true,true,true);   WAIT_BAR(2); RESC(); ROT();
  }
  #define ENDW(tt) do{ if((tt)+3<NT){WAIT_BAR(2);} else if((tt)+2<NT){WAIT_BAR(1);} else {WAIT_BAR(0);} }while(0)
  for(;t+1<NT;t+=2){
    STEP(pB0,pB1,pA0,pA1,t,(t+3<NT),(t+1<NT),(t+1<NT));       ENDW(t);   RESC(); ROT();
    STEP(pA0,pA1,pB0,pB1,t+1,(t+4<NT),(t+2<NT),(t+2<NT));     ENDW(t+1); RESC(); ROT();
  }
  STEP(pB0,pB1,pA0,pA1,NT-1,false,false,false); RESC();
  { float sacc=pB0[0]+pB0[1]; _Pragma("unroll") for(int r=2;r<16;++r)sacc+=pB0[r]; _Pragma("unroll") for(int r=0;r<16;++r)sacc+=pB1[r]; l_reg+=sacc;
    pw0=(u32x4){PKW(pB0,0),PKW(pB0,2),PKW(pB0,4),PKW(pB0,6)};pw1=(u32x4){PKW(pB0,8),PKW(pB0,10),PKW(pB0,12),PKW(pB0,14)};pw2=(u32x4){PKW(pB1,0),PKW(pB1,2),PKW(pB1,4),PKW(pB1,6)};pw3=(u32x4){PKW(pB1,8),PKW(pB1,10),PKW(pB1,12),PKW(pB1,14)};
    SBAR(); pv(o,vb0+sl_cur,PAF(0),PAF(1),PAF(2),PAF(3)); }
  #undef PKW
  #undef PAF
  #undef VFR
  #undef PIN
  #undef MX3
  #undef GAPA
  #undef GAPB
  #undef EX
  #undef VRD
  #undef KRD
  #undef STEP
  #undef ENDW
  {auto rr=__builtin_amdgcn_permlane32_swap(__float_as_uint(l_reg),__float_as_uint(l_reg),false,false);l_reg=__uint_as_float(rr[0])+__uint_as_float(rr[1]);}
  if(MODE==1)l_reg+=__builtin_amdgcn_exp2f(sinkl2-mhat);
  if(hi==0)wsf[32+r32]=l_reg;asm volatile("s_waitcnt lgkmcnt(0)":::"memory");
  float rli[16];
  #pragma unroll
  for(int r=0;r<16;++r)rli[r]=__builtin_amdgcn_rcpf(wsf[32+crow(r,hi)]);
  bf16*Ow=Ou+(long)(wid*QBLK)*OP;
  { bf16*stg=(bf16*)(shm+LDS_OST)+wid*2048;
    #pragma unroll
    for(int r=0;r<16;++r){const int orow=crow(r,hi);
      #pragma unroll
      for(int d0=0;d0<2;++d0)stg[orow*64+d0*32+r32]=__float2bfloat16(o[d0][r]*rli[r]);}
    asm volatile("s_waitcnt lgkmcnt(0)":::"memory");
    #pragma unroll
    for(int i=0;i<4;++i){const int row=i*8+(lane>>3),ch=lane&7; const u32x4 v=*(const u32x4*)(stg+row*64+ch*8); ATTN_STORE16(Ow+(long)row*OP+ch*8,v);} }
  asm volatile("s_waitcnt lgkmcnt(0)\n\ts_barrier":::"memory");
  #undef DMA_K
  #undef TROW
  #undef DMA_V
  #undef CMASK
  #undef START
  #undef RESC
  #undef ROT
}
#undef SBAR
#undef WAIT_BAR
}

template <int LAYER> __device__ __forceinline__ void attn_fast(const Frame& F, char* shm) {
    using attn_body::bf16;
    const bf16* Q = (const bf16*)(F.ws + WS_Q); const bf16* Kn = (const bf16*)(F.ws + WS_KN); const bf16* Vn = (const bf16*)(F.ws + WS_VN); bf16* AO = (bf16*)(F.ws + WS_AO);
    const int nunits = LAYER == 0 ? 1024 + 64 : 1024;
    for (int U = F.vcu; U < nunits; U += F.G) {
        int b, h, NT, lat0 = 0, q0 = 0; size_t row0;
        if (U < 1024) { b = U >> 7; h = ((U >> 6) & 1) * 4 + ((U >> 4) & 3); q0 = (U & 15) * 256; row0 = (size_t)b * SEQ + q0;
            if (LAYER == 0) NT = KVS / 64;
            else { int lo = q0 - 128, hi = q0 + 384; lo = lo < 0 ? 0 : lo; hi = hi > SEQ ? SEQ : hi; NT = 4 + (hi - lo) / 64; lat0 = CTXL + lo; } }
        else { const int uc = U - 1024; b = uc >> 3; h = uc & 7; row0 = (size_t)TX + (size_t)b * CTXL; NT = 4; }
        const bf16* Kh = Kn + (size_t)b * KVS * 128 + (h >> 2) * 64; const bf16* Vh = Vn + (size_t)b * KVS * 128 + (h >> 2) * 64;
        const float sinkl2 = LAYER == 1 ? F.in[I_SINK][h] * LOG2E : 0.f;
        attn_body::attn_unit<LAYER, 8>(Q + row0 * 512 + h * 64, Kh, Vh, AO + row0 * 1024 + h * 64, NT, lat0, q0, sinkl2, F.in[LAYER == 0 ? I_QNA : I_QNC], (const float*)(F.ws + WS_ROPE), U < 1024, shm);
    }
}

template <int DRY> __device__ __forceinline__ void p_router(const Frame& F, int l, int ntok) {
    const int gw = F.vcu * NWAVES + F.wave, NGW = F.G * NWAVES, lane = F.lane, tk = lane & 15, kq = lane >> 4;
    bf16_t* HX = F.hx(); const float* SS = (const float*)(F.ws + WS_SS);
    const float* gb = F.in[I_RGB] + l * 4; const float* eb = F.in[I_REB] + l * 32;
    unsigned* tokslot = (unsigned*)(F.ws + (DRY ? WS_HID : WS_TOK)); float* tokw = (float*)(F.ws + (DRY ? WS_HID : WS_TOK) + 512 * 1024); unsigned* list = (unsigned*)(F.ws + (DRY ? WS_HID + 2 * MiB : WS_LIST));
    unsigned* cnt = F.cnt(DRY ? l + 2 : l);
    {
        const u32x4* src = (const u32x4*)((const bf16_t*)(F.ws + WS_WR) + (size_t)l * 2 * 36864);
        __syncthreads();
        for (int i = F.tid; i < 2 * RW_BYTES / 16; i += NTHREADS) *(LAS u32x4*)(F.lds + i * 16) = src[i];
        __syncthreads();
    }
    const LAS unsigned char* wl0 = F.lds + lane * 16;
    const LAS unsigned char* wl2 = F.lds + 2048 + ((tk >> 2) * 4 + kq) * 16;
    for (int grp = gw; grp < ntok / 16; grp += NGW) {
        const int row = grp * 16 + tk, r = modrow(grp * 16);
        const bf16_t* xr = F.xr_row(row) + 8 * kq; const float* gp = (const float*)(F.ws + WS_GP) + (size_t)(l * 9 + r) * 1024 + 8 * kq; const float* sh = F.mod(l, r, 3) + 8 * kq;
        u32x4 x0, x1, x2, x3, x4, x5, x6, x7; f32x4 ma[4], mb[4];
#define R_XLOAD(buf, st) do { const int s_ = (st) < 32 ? (st) : 31; buf = *(const u32x4*)(xr + s_ * 32); } while (0)
#define R_MLOAD(buf, st) do { const int s_ = (st) < 32 ? (st) : 31; buf[0] = *(const f32x4*)(gp + s_ * 32); buf[1] = *(const f32x4*)(gp + s_ * 32 + 4); buf[2] = *(const f32x4*)(sh + s_ * 32); buf[3] = *(const f32x4*)(sh + s_ * 32 + 4); } while (0)
        R_XLOAD(x0, 0); R_XLOAD(x1, 1); R_XLOAD(x2, 2); R_XLOAD(x3, 3); R_XLOAD(x4, 4); R_XLOAD(x5, 5); R_XLOAD(x6, 6); R_XLOAD(x7, 7); R_MLOAD(ma, 0); R_MLOAD(mb, 1);
        float ssum = 0.f;
#pragma unroll
        for (int i = 0; i < 4; ++i) { const f32x4 p = *(const f32x4*)(SS + (size_t)row * 16 + 4 * i); ssum += (p[0] + p[1]) + (p[2] + p[3]); }
        const float rms = 1.0f / sqrtf(ssum * (1.f / 1024.f) + EPS);
        f32x4 acc[3];
#pragma unroll
        for (int n = 0; n < 3; ++n) acc[n] = (f32x4){0.f, 0.f, 0.f, 0.f};
        bf16_t* hxr = HX + (size_t)row * DM + 8 * kq;
#define R_STEP(xb_, mb_, st) do { \
            const f32x4 xf0 = (f32x4){bflo(xb_.x), bfhi(xb_.x), bflo(xb_.y), bfhi(xb_.y)}, xf1 = (f32x4){bflo(xb_.z), bfhi(xb_.z), bflo(xb_.w), bfhi(xb_.w)}; \
            const f32x4 h0 = (xf0 * rms) * mb_[0] + mb_[2], h1 = (xf1 * rms) * mb_[1] + mb_[3]; \
            u32x4 hh; hh.x = pk2(h0[0], h0[1]); hh.y = pk2(h0[2], h0[3]); hh.z = pk2(h1[0], h1[1]); hh.w = pk2(h1[2], h1[3]); \
            *(u32x4*)(hxr + (st) * 32) = hh; \
            if (DRY < 3) { \
            u32x4 hl; hl.x = pk2(h0[0] - bflo(hh.x), h0[1] - bfhi(hh.x)); hl.y = pk2(h0[2] - bflo(hh.y), h0[3] - bfhi(hh.y)); hl.z = pk2(h1[0] - bflo(hh.z), h1[1] - bfhi(hh.z)); hl.w = pk2(h1[2] - bflo(hh.w), h1[3] - bfhi(hh.w)); \
            const bf16x8 bh = __builtin_bit_cast(bf16x8, hh), bl = __builtin_bit_cast(bf16x8, hl); \
            const bf16x8 w0h = *(const LAS bf16x8*)(wl0 + (st) * 2304), w1h = *(const LAS bf16x8*)(wl0 + (st) * 2304 + 1024), w2h = *(const LAS bf16x8*)(wl2 + (st) * 2304); \
            const bf16x8 w0l = *(const LAS bf16x8*)(wl0 + RW_BYTES + (st) * 2304), w1l = *(const LAS bf16x8*)(wl0 + RW_BYTES + (st) * 2304 + 1024), w2l = *(const LAS bf16x8*)(wl2 + RW_BYTES + (st) * 2304); \
            acc[0] = __builtin_amdgcn_mfma_f32_16x16x32_bf16(w0h, bh, acc[0], 0, 0, 0); acc[1] = __builtin_amdgcn_mfma_f32_16x16x32_bf16(w1h, bh, acc[1], 0, 0, 0); acc[2] = __builtin_amdgcn_mfma_f32_16x16x32_bf16(w2h, bh, acc[2], 0, 0, 0); \
            acc[0] = __builtin_amdgcn_mfma_f32_16x16x32_bf16(w0h, bl, acc[0], 0, 0, 0); acc[1] = __builtin_amdgcn_mfma_f32_16x16x32_bf16(w1h, bl, acc[1], 0, 0, 0); acc[2] = __builtin_amdgcn_mfma_f32_16x16x32_bf16(w2h, bl, acc[2], 0, 0, 0); \
            acc[0] = __builtin_amdgcn_mfma_f32_16x16x32_bf16(w0l, bh, acc[0], 0, 0, 0); acc[1] = __builtin_amdgcn_mfma_f32_16x16x32_bf16(w1l, bh, acc[1], 0, 0, 0); acc[2] = __builtin_amdgcn_mfma_f32_16x16x32_bf16(w2l, bh, acc[2], 0, 0, 0); } } while (0)
        for (int st = 0; st < 32; st += 8) {
            R_STEP(x0, ma, st);     R_XLOAD(x0, st + 8);  R_MLOAD(ma, st + 2);
            R_STEP(x1, mb, st + 1); R_XLOAD(x1, st + 9);  R_MLOAD(mb, st + 3);
            R_STEP(x2, ma, st + 2); R_XLOAD(x2, st + 10); R_MLOAD(ma, st + 4);
            R_STEP(x3, mb, st + 3); R_XLOAD(x3, st + 11); R_MLOAD(mb, st + 5);
            R_STEP(x4, ma, st + 4); R_XLOAD(x4, st + 12); R_MLOAD(ma, st + 6);
            R_STEP(x5, mb, st + 5); R_XLOAD(x5, st + 13); R_MLOAD(mb, st + 7);
            R_STEP(x6, ma, st + 6); R_XLOAD(x6, st + 14); R_MLOAD(ma, st + 8);
            R_STEP(x7, mb, st + 7); R_XLOAD(x7, st + 15); R_MLOAD(mb, st + 9);
        }
#undef R_XLOAD
#undef R_MLOAD
#undef R_STEP
        if (DRY < 2) {
            const float lgk = acc[2][0] + gb[kq];
            const float la = __shfl_xor(lgk, 16), lb = __shfl_xor(lgk, 32), lc = __shfl_xor(la, 32);
            const float gm = fmaxf(fmaxf(lgk, la), fmaxf(lb, lc));
            bool win = (lgk == gm);
            win = win && !(la == gm && (kq ^ 1) < kq) && !(lb == gm && (kq ^ 2) < kq) && !(lc == gm && (kq ^ 3) < kq);
            if (win) {
                const float g_w = 1.f / (expf(lgk - gm) + expf(la - gm) + expf(lb - gm) + expf(lc - gm));
                float el[8];
                { const f32x4 b0 = *(const f32x4*)(eb + 8 * kq), b1 = *(const f32x4*)(eb + 8 * kq + 4);
#pragma unroll
                  for (int i = 0; i < 4; ++i) { el[i] = acc[0][i] + b0[i]; el[4 + i] = acc[1][i] + b1[i]; } }
                int i1 = 0; float m1 = el[0];
#pragma unroll
                for (int i = 1; i < 8; ++i) if (el[i] > m1) { m1 = el[i]; i1 = i; }
                int i2 = 0; float m2 = -3.0e38f;
#pragma unroll
                for (int i = 0; i < 8; ++i) if (i != i1 && el[i] > m2) { m2 = el[i]; i2 = i; }
                const float p2 = expf(m2 - m1); const float w1 = g_w / (1.f + p2), w2 = g_w * p2 / (1.f + p2);
                const int e1 = kq * 8 + i1, e2 = kq * 8 + i2;
                const unsigned pos1 = atomicAdd(cnt + e1 * 64, 1u), pos2 = atomicAdd(cnt + e2 * 64, 1u);
                list[(size_t)e1 * TT + pos1] = (unsigned)row; list[(size_t)e2 * TT + pos2] = (unsigned)row;
                tokslot[2 * row] = ((unsigned)e1 << 16) | pos1; tokslot[2 * row + 1] = ((unsigned)e2 << 16) | pos2; tokw[2 * row] = w1; tokw[2 * row + 1] = w2;
            }
        }
    }
    __syncthreads();
}
struct CombBuf { u32x2 x[4], ya[4], yb[4]; };
__device__ __forceinline__ void comb_load(CombBuf& b, const bf16_t* xr, const bf16_t* ya, const bf16_t* yb, int lane) {
#pragma unroll
    for (int j = 0; j < 4; ++j) { const int c = 4 * lane + 256 * j; b.x[j] = *(const u32x2*)(xr + c); b.ya[j] = *(const u32x2*)(ya + c); b.yb[j] = *(const u32x2*)(yb + c); }
}
template <bool LAST, bool DRY> __device__ __forceinline__ void comb_finish(const Frame& F, const CombBuf& b, int l, int row, float wa, float wb, int lane) {
    const int r = modrow(row); const float* g2 = F.mod(l, r, 5); bf16_t* xr = F.xr_row(row);
    float ss = 0.f; f32x4 v[4];
#pragma unroll
    for (int j = 0; j < 4; ++j) { const int c = 4 * lane + 256 * j; const f32x4 gv = *(const f32x4*)(g2 + c);
        f32x4 y; y[0] = wa * bflo(b.ya[j].x) + wb * bflo(b.yb[j].x); y[1] = wa * bfhi(b.ya[j].x) + wb * bfhi(b.yb[j].x); y[2] = wa * bflo(b.ya[j].y) + wb * bflo(b.yb[j].y); y[3] = wa * bfhi(b.ya[j].y) + wb * bfhi(b.yb[j].y);
        const f32x4 x1 = (f32x4){bflo(b.x[j].x), bfhi(b.x[j].x), bflo(b.x[j].y), bfhi(b.x[j].y)};
        v[j] = x1 + gv * y;
        if (LAST) { if (!DRY) *(f32x4*)(F.out + (size_t)row * DM + c) = v[j]; }
        else { u32x2 o; o.x = pk2(v[j][0], v[j][1]); o.y = pk2(v[j][2], v[j][3]); *(u32x2*)(xr + c) = DRY ? b.x[j] : o; }
        ss += (v[j][0] * v[j][0] + v[j][1] * v[j][1]) + (v[j][2] * v[j][2] + v[j][3] * v[j][3]); }
    if (!LAST) { const float rms = 1.0f / sqrtf(wave_sum(ss) * (1.f / 1024.f) + EPS); const float* g = F.in[I_LN1] + (l + 1) * 1024; const float* sh = F.mod(l + 1, r, 0); const float* sc = F.mod(l + 1, r, 1); f32x4 h[4];
#pragma unroll
        for (int j = 0; j < 4; ++j) { const int c = 4 * lane + 256 * j; h[j] = (v[j] * rms * *(const f32x4*)(g + c)) * (1.f + *(const f32x4*)(sc + c)) + *(const f32x4*)(sh + c); }
        store_row_bf16(F.hx() + (size_t)row * DM, lane, h); }
}
template <bool LAST, bool DRY> __device__ __forceinline__ void p_combine(const Frame& F, int l, int ntok, const MoeTab& tb) {
    const int gw = F.vcu * NWAVES + F.wave, NGW = F.G * NWAVES, lane = F.lane;
    const bf16_t* YB = (const bf16_t*)(F.ws + WS_YB);
    const unsigned* tokslot = (const unsigned*)(F.ws + WS_TOK); const float* tokw = (const float*)(F.ws + WS_TOK + 512 * 1024);
    const int ntot = gw < ntok ? (ntok - gw + NGW - 1) / NGW : 0;
    for (int base = 0; base < ntot; base += 64) {
    const int n = ntot - base < 64 ? ntot - base : 64;
    unsigned my_sa = 0u, my_sb = 0u; float my_wa = 0.f, my_wb = 0.f;
    { const int mr = gw + (base + lane) * NGW;
      if (lane < n) { const unsigned sa = tokslot[2 * mr], sb = tokslot[2 * mr + 1]; my_wa = tokw[2 * mr]; my_wb = tokw[2 * mr + 1];
          my_sa = (unsigned)tb.tile0[sa >> 16] * 256u + (sa & 0xffffu); my_sb = (unsigned)tb.tile0[sb >> 16] * 256u + (sb & 0xffffu); } }
    CombBuf A, B;
#define COMB_LOAD(buf, i) do { const int row_ = gw + (base + (i)) * NGW; const unsigned sa_ = __builtin_amdgcn_readlane(my_sa, (i)), sb_ = __builtin_amdgcn_readlane(my_sb, (i)); \
        comb_load(buf, F.xr_row(row_), YB + (size_t)sa_ * 1024, YB + (size_t)sb_ * 1024, lane); } while (0)
#define COMB_FIN(buf, i) do { const float wa_ = __uint_as_float(__builtin_amdgcn_readlane(__float_as_uint(my_wa), (i))), wb_ = __uint_as_float(__builtin_amdgcn_readlane(__float_as_uint(my_wb), (i))); \
        comb_finish<LAST, DRY>(F, buf, l, gw + (base + (i)) * NGW, wa_, wb_, lane); } while (0)
    COMB_LOAD(A, 0);
    for (int i = 0; i < n; i += 2) {
        if (i + 1 < n) COMB_LOAD(B, i + 1);
        COMB_FIN(A, i);
        if (i + 2 < n) COMB_LOAD(A, i + 2);
        if (i + 1 < n) COMB_FIN(B, i + 1);
    }
    }
#undef COMB_LOAD
#undef COMB_FIN
}

__global__ void __launch_bounds__(NTHREADS, 2) fwd_kernel(Params P) {
    extern __shared__ __attribute__((aligned(16))) unsigned char lds_raw[];
    Frame F;
    F.lds = (LAS unsigned char*)lds_raw; F.in = P.in; F.out = P.out; F.ws = P.ws;
    F.tid = threadIdx.x; F.lane = F.tid & 63; F.wave = __builtin_amdgcn_readfirstlane(F.tid >> 6);
    F.G = gridDim.x; { const int bx = blockIdx.x; F.vcu = (F.G % 8 == 0) ? (bx % 8) * (F.G / 8) + bx / 8 : bx; }
    volatile LAS unsigned* misc = (volatile LAS unsigned*)(F.lds + LDS_MISC);
    if (F.tid < 16) misc[F.tid] = 0u;
    __syncthreads();
#if ONE_LAUNCH
    XcdBarrier bar = xcd_barrier_post((unsigned*)(F.ws + WS_CTL) + CW_BAR, misc + 8);
#define GRID_BAR() do { xcd_barrier(bar); } while (0)
#else
#define GRID_BAR() do { } while (0)
#endif
    const int lo = P.ph_lo, hi = P.ph_hi;
#ifndef DRYMASK
#define DRYMASK 0
#endif
#ifndef DRYV
#define DRYV 1
#endif
#ifndef PHMASK
#define PHMASK 0xFFFFFFFFu
#endif
#define IN(k) (((PHMASK >> (k)) & 1u) && lo <= (k) && (k) < hi)
#ifdef PROBE_PH
#define STAMP(k) do { if (blockIdx.x == 0 && F.tid == 0) { const unsigned long long t_ = __builtin_amdgcn_s_memrealtime(); \
        if ((k) == PROBE_PH - 1) { misc[0] = (unsigned)t_; misc[1] = (unsigned)(t_ >> 32); } if ((k) == PROBE_PH) { misc[2] = (unsigned)t_; misc[3] = (unsigned)(t_ >> 32); } } } while (0)
#else
#define STAMP(k) do { } while (0)
#endif
#define SEAM(k) do { if (IN((k) + 1)) GRID_BAR(); STAMP(k); } while (0)
    STAMP(-1);
    bf16_t* HX = F.hx(); bf16_t* Qb = (bf16_t*)(F.ws + WS_Q); bf16_t* KVb = (bf16_t*)(F.ws + WS_KV); bf16_t* Gb = (bf16_t*)(F.ws + WS_G); bf16_t* AO = (bf16_t*)(F.ws + WS_AO);
    bf16_t* HID = (bf16_t*)(F.ws + WS_HID); bf16_t* YB = (bf16_t*)(F.ws + WS_YB);

    if (IN(0)) { Frame Fp = F; asm volatile("" : "+v"(Fp.tid), "+v"(Fp.lane)); p0_prologue(Fp); SEAM(0); }
    if (IN(1)) { Frame Fp = F; asm volatile("" : "+v"(Fp.tid), "+v"(Fp.lane)); p_norm1_l0(Fp); SEAM(1); }
    if (IN(2)) { Frame Fp = F; asm volatile("" : "+v"(Fp.tid), "+v"(Fp.lane)); SchedDense S{(const bf16_t*)(Fp.ws + WS_WINAB), 1024, TT / 256, 7, 0, 0, Fp.vcu, Fp.G}; EpiInProj<true> E{Qb, KVb, (bf16_t*)(Fp.ws + WS_VN), Gb}; GEMM(Fp, HX, 1024, S, E); SEAM(2); }
    if (IN(3)) { Frame Fp = F; asm volatile("" : "+v"(Fp.tid), "+v"(Fp.lane)); p_k_post(Fp, Fp.in[I_KNA]); p_conv(Fp); SEAM(3); }
    if (IN(4)) { Frame Fp = F; asm volatile("" : "+v"(Fp.tid), "+v"(Fp.lane));
#ifdef ATTN_SIMPLE
        attn_simple<0>(Fp);
#else
        attn_fast<0>(Fp, (char*)lds_raw);
#endif
        SEAM(4); }
    if (IN(5)) { Frame Fp = F; asm volatile("" : "+v"(Fp.tid), "+v"(Fp.lane)); SchedDense S{(const bf16_t*)(Fp.ws + WS_WOUTAB), 1024, TT / 256, 4, 0, 0, Fp.vcu, Fp.G}; EpiOutProj<true> E{Fp, 0}; GEMM(Fp, AO, 1024, S, E); SEAM(5); }
    if (IN(6)) { Frame Fp = F; asm volatile("" : "+v"(Fp.tid), "+v"(Fp.lane));
#if (DRYMASK >> 6) & 1
        p_router<DRYV>(Fp, 0, TT); GRID_BAR();
#endif
        p_router<0>(Fp, 0, TT); SEAM(6); }
    if (IN(7)) { Frame Fp = F; asm volatile("" : "+v"(Fp.tid), "+v"(Fp.lane)); const MoeTab tb = moe_tables(Fp, 0); SchedMoe S{(const bf16_t*)(Fp.ws + WS_WGU), (size_t)1024 * 1024, 1024, tb, (const unsigned*)(Fp.ws + WS_LIST), true, Fp.vcu, Fp.G}; EpiMoe1 E{HID}; GEMM(Fp, HX, 1024, S, E); SEAM(7); }
    if (IN(8)) { Frame Fp = F; asm volatile("" : "+v"(Fp.tid), "+v"(Fp.lane)); const MoeTab tb = moe_tables(Fp, 0); SchedMoe S{(const bf16_t*)(Fp.ws + WS_WD), (size_t)1024 * 512, 512, tb, nullptr, false, Fp.vcu, Fp.G}; EpiMoe2 E{YB}; GEMM(Fp, HID, 512, S, E); SEAM(8); }
    if (IN(9)) { Frame Fp = F; asm volatile("" : "+v"(Fp.tid), "+v"(Fp.lane)); const MoeTab tb = moe_tables(Fp, 0);
#if (DRYMASK >> 9) & 1
        p_combine<false, true>(Fp, 0, TT, tb); GRID_BAR();
#endif
        p_combine<false, false>(Fp, 0, TT, tb); SEAM(9); }
    if (IN(10)) { Frame Fp = F; asm volatile("" : "+v"(Fp.tid), "+v"(Fp.lane)); SchedDense S{(const bf16_t*)(Fp.ws + WS_WINCD), 1024, TX / 256, 5, TC / 256, 2, Fp.vcu, Fp.G}; EpiInProj<false> E{Qb, KVb, (bf16_t*)(Fp.ws + WS_VN), Gb}; GEMM(Fp, HX, 1024, S, E); SEAM(10); }
    if (IN(11)) { Frame Fp = F; asm volatile("" : "+v"(Fp.tid), "+v"(Fp.lane)); p_k_post(Fp, Fp.in[I_KNC]); p_pool(Fp); SEAM(11); }
    if (IN(12)) { Frame Fp = F; asm volatile("" : "+v"(Fp.tid), "+v"(Fp.lane));
#ifdef ATTN_SIMPLE
        attn_simple<1>(Fp);
#else
        attn_fast<1>(Fp, (char*)lds_raw);
#endif
        SEAM(12); }
    if (IN(13)) { Frame Fp = F; asm volatile("" : "+v"(Fp.tid), "+v"(Fp.lane)); SchedDense S{(const bf16_t*)(Fp.ws + WS_WOUTCD), 1024, TX / 256, 4, 0, 0, Fp.vcu, Fp.G};
#if (DRYMASK >> 13) & 1
        { EpiOutProj<false, true> Ed{Fp, 1}; GEMM(Fp, AO, 1024, S, Ed); GRID_BAR(); }
#endif
        EpiOutProj<false> E{Fp, 1}; GEMM(Fp, AO, 1024, S, E); SEAM(13); }
    if (IN(14)) { Frame Fp = F; asm volatile("" : "+v"(Fp.tid), "+v"(Fp.lane));
#if (DRYMASK >> 14) & 1
        p_router<DRYV>(Fp, 1, TX); GRID_BAR();
#endif
        p_router<0>(Fp, 1, TX); SEAM(14); }
    if (IN(15)) { Frame Fp = F; asm volatile("" : "+v"(Fp.tid), "+v"(Fp.lane)); const MoeTab tb = moe_tables(Fp, 1); SchedMoe S{(const bf16_t*)(Fp.ws + WS_WGU) + (size_t)32 * 1024 * 1024, (size_t)1024 * 1024, 1024, tb, (const unsigned*)(Fp.ws + WS_LIST), true, Fp.vcu, Fp.G}; EpiMoe1 E{HID}; GEMM(Fp, HX, 1024, S, E); SEAM(15); }
    if (IN(16)) { Frame Fp = F; asm volatile("" : "+v"(Fp.tid), "+v"(Fp.lane)); const MoeTab tb = moe_tables(Fp, 1); SchedMoe S{(const bf16_t*)(Fp.ws + WS_WD) + (size_t)32 * 1024 * 512, (size_t)1024 * 512, 512, tb, nullptr, false, Fp.vcu, Fp.G}; EpiMoe2 E{YB}; GEMM(Fp, HID, 512, S, E); SEAM(16); }
    if (IN(17)) { Frame Fp = F; asm volatile("" : "+v"(Fp.tid), "+v"(Fp.lane)); const MoeTab tb = moe_tables(Fp, 1);
#if (DRYMASK >> 17) & 1
        p_combine<true, true>(Fp, 1, TX, tb); GRID_BAR();
#endif
        p_combine<true, false>(Fp, 1, TX, tb); }
#ifdef PROBE_PH
    STAMP(NPH - 1);
    if (blockIdx.x == 0 && F.tid == 0) { const unsigned long long t0 = ((unsigned long long)misc[1] << 32) | misc[0], t1 = ((unsigned long long)misc[3] << 32) | misc[2];
        const unsigned long long te = __builtin_amdgcn_s_memrealtime(), span = (t1 - t0) * 16ull;
        while (__builtin_amdgcn_s_memrealtime() - te < span) __builtin_amdgcn_s_sleep(32); }
#endif
#undef IN
#undef SEAM
}

extern "C" void kernel_launch(void* const* d_in, const int* in_sizes, int n_in, void* d_out, int out_size, void* d_ws, size_t ws_size, hipStream_t stream) {
    static int grid = 0;
    if (grid == 0) {
        if (n_in != 30 || out_size != TX * DM || ws_size < WS_END) { fprintf(stderr, "kernel_launch: unexpected shapes (n_in %d out %d ws %zu)\n", n_in, out_size, ws_size); grid = -1; return; }
        int dev = 0, cus = 0;
        if (hipGetDevice(&dev) != hipSuccess || hipDeviceGetAttribute(&cus, hipDeviceAttributeMultiprocessorCount, dev) != hipSuccess) { grid = -1; return; }
        if (hipFuncSetAttribute((const void*)fwd_kernel, hipFuncAttributeMaxDynamicSharedMemorySize, LDS_BYTES) != hipSuccess) { fprintf(stderr, "kernel_launch: hipFuncSetAttribute failed\n"); grid = -1; return; }
        int per_cu = 0;
        if (hipOccupancyMaxActiveBlocksPerMultiprocessor(&per_cu, (const void*)fwd_kernel, NTHREADS, LDS_BYTES) != hipSuccess || per_cu < 1) { fprintf(stderr, "kernel_launch: occupancy query says %d\n", per_cu); }
        (void)hipGetLastError();
        grid = cus;
    }
    if (grid < 0) return;
    (void)hipMemsetAsync((char*)d_ws + WS_CTL, 0, CTL_ZERO_BYTES, stream);
    Params p{};
    for (int i = 0; i < 30; ++i) p.in[i] = (const float*)d_in[i];
    p.out = (float*)d_out; p.ws = (unsigned char*)d_ws;
#if ONE_LAUNCH
    p.ph_lo = 0; p.ph_hi = NPH;
    hipLaunchKernelGGL(fwd_kernel, dim3(grid), dim3(NTHREADS), LDS_BYTES, stream, p);
#else
    for (int ph = 0; ph < NPH; ++ph) { p.ph_lo = ph; p.ph_hi = ph + 1; hipLaunchKernelGGL(fwd_kernel, dim3(grid), dim3(NTHREADS), LDS_BYTES, stream, p); }
#endif
}
```

```cpp
#include <hip/hip_runtime.h>
#include <cstdio>
#include <cstdint>

#ifndef ONE_LAUNCH
#define ONE_LAUNCH 1
#endif

#define LAS __attribute__((address_space(3)))
#define GAS __attribute__((address_space(1)))
typedef unsigned short bf16_t;
typedef short bf16x8 __attribute__((ext_vector_type(8)));
typedef float f32x4 __attribute__((ext_vector_type(4)));
typedef float f32x2 __attribute__((ext_vector_type(2)));
typedef unsigned u32x4 __attribute__((ext_vector_type(4)));
typedef unsigned u32x2 __attribute__((ext_vector_type(2)));
typedef __bf16 bf16x2_t __attribute__((ext_vector_type(2)));

constexpr int NB = 8, SEQ = 4096, DM = 1024, CTXL = 256, HD = 64;
constexpr int TX = NB * SEQ, TC = NB * CTXL, TT = TX + TC;
constexpr int KVS = CTXL + SEQ;
constexpr int NE = 32;
constexpr int NTILE_MAX = 304, NSLOT = NTILE_MAX * 256;
constexpr float EPS = 1e-6f;
constexpr float LOG2E = 1.4426950408889634f;
constexpr float C2 = 0.125f * LOG2E;
constexpr int NWAVES = 8, NTHREADS = 512;
constexpr int NPH = 18;

enum { I_X = 0, I_C, I_CTX, I_CCTX, I_MODW, I_MODB, I_LN1, I_LN2, I_WINAB, I_WOUTAB, I_QNA, I_KNA, I_CONVW, I_CONVB, I_CLNG, I_CLNB,
       I_WINCD, I_WOUTCD, I_QNC, I_KNC, I_SINK, I_POOLW, I_POOLS, I_RGW, I_RGB, I_REW, I_REB, I_EXG, I_EXU, I_EXD };

constexpr size_t MiB = 1u << 20;
constexpr size_t WS_CTL = 0, CTL_ZERO_BYTES = 1 * MiB;
constexpr size_t WS_MOD = 1 * MiB;
constexpr size_t WS_ROPE = 2 * MiB;
constexpr size_t WS_TOK = 3 * MiB;
constexpr size_t WS_LIST = 4 * MiB;
constexpr size_t WS_WINAB = 10 * MiB;
constexpr size_t WS_WOUTAB = 14 * MiB;
constexpr size_t WS_WINCD = 16 * MiB;
constexpr size_t WS_WOUTCD = 19 * MiB;
constexpr size_t WS_XC = 21 * MiB;
constexpr size_t WS_KN = 30 * MiB;
constexpr size_t WS_VN = 39 * MiB;
constexpr size_t WS_WGU = 48 * MiB;
constexpr size_t WS_WD = 176 * MiB;
constexpr size_t WS_XR = 240 * MiB;
constexpr size_t WS_HID = 308 * MiB;
constexpr size_t WS_Q = 384 * MiB;
constexpr size_t WS_KV = 418 * MiB;
constexpr size_t WS_G = 435 * MiB;
constexpr size_t WS_AO = 469 * MiB;
constexpr size_t WS_YB = 384 * MiB;
constexpr size_t WS_SS = 537 * MiB;
constexpr size_t WS_WR = 9 * MiB;
constexpr size_t WS_GP = 3 * MiB + 896 * 1024;
constexpr size_t WS_END = 540 * MiB;
static_assert(WS_YB + (size_t)NSLOT * 1024 * 2 <= WS_END && WS_AO + (size_t)TT * 1024 * 2 <= WS_END, "ws map");
constexpr int CW_CNT = 256;
constexpr int CW_BAR = 16384;

constexpr int RING_BYTES = 131072;
constexpr int RW_BYTES = 73728;
constexpr int LDS_MISC = 2 * RW_BYTES;
constexpr int LDS_TAB = LDS_MISC + 256;
constexpr int LDS_BYTES = 163840;

__device__ __forceinline__ unsigned pk2(float lo, float hi) { f32x2 v = {lo, hi}; bf16x2_t b = __builtin_convertvector(v, bf16x2_t); return __builtin_bit_cast(unsigned, b); }
__device__ __forceinline__ float bflo(unsigned w) { return __uint_as_float(w << 16); }
__device__ __forceinline__ float bfhi(unsigned w) { return __uint_as_float(w & 0xffff0000u); }
__device__ __forceinline__ float bf2f(bf16_t h) { return __uint_as_float((unsigned)h << 16); }
__device__ __forceinline__ float wave_sum(float v) {
#pragma unroll
    for (int o = 1; o < 64; o <<= 1) v += __shfl_xor(v, o);
    return v;
}
__device__ __forceinline__ float sigmoidf_(float v) { return 1.f / (1.f + __expf(-v)); }

#define XB_TMO      128
#define XB_XCNT(j)  (256  + 64 * (j))
#define XB_XSUB(j)  (1280 + 64 * (j))
#define XB_XGEN(j)  (2304 + 64 * (j))
#define XB_TOP      3328
#define XB_TOPGEN   3392
#define XCD_BAR_WORDS 3456
#define XB_SPIN_CAP (1u << 18)
__device__ __forceinline__ unsigned xb_ld(unsigned* p)              { return __hip_atomic_load(p, __ATOMIC_RELAXED, __HIP_MEMORY_SCOPE_AGENT); }
__device__ __forceinline__ unsigned xb_add(unsigned* p, unsigned v) { return __hip_atomic_fetch_add(p, v, __ATOMIC_RELAXED, __HIP_MEMORY_SCOPE_AGENT); }
__device__ __forceinline__ unsigned xb_xcc_id() { return (unsigned)__builtin_amdgcn_s_getreg((3 << 11) | 20) & 0xFu; }
#define XB_SPIN(cond, bar) do { unsigned _sp = 0; while (cond) { __builtin_amdgcn_s_sleep(1); \
    if ((++_sp & 255u) == 0u) { if (xb_ld(&(bar)[XB_TMO])) break; if (_sp > XB_SPIN_CAP) { atomicAdd(&(bar)[XB_TMO], 1u); break; } } } } while (0)
struct XcdBarrier { unsigned* bar; unsigned x; volatile LAS unsigned* st; };
__device__ __forceinline__ XcdBarrier xcd_barrier_post(unsigned* bar, volatile LAS unsigned* st) {
    XcdBarrier b; b.bar = bar; b.x = xb_xcc_id(); b.st = st;
    if (threadIdx.x == 0) (void)xb_add(&bar[XB_XCNT(b.x)], 1u);
    return b;
}
__device__ __forceinline__ void xcd_barrier_complete(unsigned* bar, unsigned x, unsigned& nloc, unsigned& nx) {
    const unsigned G = gridDim.x * gridDim.y * gridDim.z;
    unsigned sum, cnt, mine, sp = 0u;
    for (;;) {
        sum = 0u; cnt = 0u; mine = 0u;
#pragma unroll
        for (unsigned j = 0; j < 16; ++j) { const unsigned c = xb_ld(&bar[XB_XCNT(j)]); sum += c; cnt += (c > 0u) ? 1u : 0u; mine = (j == x) ? c : mine; }
        if (sum == G) break;
        __builtin_amdgcn_s_sleep(1);
        if ((++sp & 255u) == 0u) { if (xb_ld(&bar[XB_TMO])) break; if (sp > XB_SPIN_CAP) { atomicAdd(&bar[XB_TMO], 1u); break; } }
    }
    nloc = mine > 0u ? mine : 1u; nx = cnt > 0u ? cnt : 1u;
}
__device__ __forceinline__ void xcd_barrier(const XcdBarrier& b) {
    asm volatile("s_waitcnt vmcnt(0)" ::: "memory");
    __syncthreads();
    if (threadIdx.x == 0) {
        unsigned* bar = b.bar;
        __builtin_amdgcn_s_waitcnt(0);
        unsigned nloc = b.st[0], nx = b.st[1];
        if (nloc == 0u) { xcd_barrier_complete(bar, b.x, nloc, nx); b.st[0] = nloc; b.st[1] = nx; }
        const unsigned old = xb_add(&bar[XB_XSUB(b.x)], 1u);
        const unsigned gen = old / nloc;
        if (old + 1u == (gen + 1u) * nloc) {
            __builtin_amdgcn_fence(__ATOMIC_RELEASE, "agent");
            asm volatile("s_waitcnt vmcnt(0)" ::: "memory");
            const unsigned og = xb_add(&bar[XB_TOP], 1u);
            const unsigned tg = og / nx;
            if (og + 1u == (tg + 1u) * nx) xb_add(&bar[XB_TOPGEN], 1u);
            else XB_SPIN(xb_ld(&bar[XB_TOPGEN]) == tg, bar);
            __builtin_amdgcn_fence(__ATOMIC_ACQUIRE, "agent");
            xb_add(&bar[XB_XGEN(b.x)], 1u);
            asm volatile("s_waitcnt vmcnt(0)" ::: "memory");
        } else {
            XB_SPIN(xb_ld(&bar[XB_XGEN(b.x)]) == gen, bar);
            __builtin_amdgcn_fence(__ATOMIC_ACQUIRE, "agent");
            asm volatile("s_waitcnt vmcnt(0)" ::: "memory");
        }
    }
    __syncthreads();
}

struct Params { const float* in[30]; float* out; unsigned char* ws; int ph_lo, ph_hi; };
struct Frame {
    LAS unsigned char* lds;
    const float* const* in;
    float* out; unsigned char* ws;
    int tid, lane, wave, vcu, G;
    __device__ __forceinline__ const float* mod(int l, int r, int chunk) const { return (const float*)(ws + WS_MOD) + ((size_t)(l * 9 + r) * 6144 + chunk * 1024); }
    __device__ __forceinline__ bf16_t* xr_row(int row) const { return (bf16_t*)(ws + WS_XR) + (size_t)row * DM; }
    __device__ __forceinline__ bf16_t* hx() const { return (bf16_t*)out; }
    __device__ __forceinline__ const float* xin_row(int row) const { return row < TX ? in[I_X] + (size_t)row * DM : in[I_CTX] + (size_t)(row - TX) * DM; }
    __device__ __forceinline__ unsigned* cnt(int l) const { return (unsigned*)(ws + WS_CTL) + CW_CNT + l * 32 * 64; }
};
__device__ __forceinline__ int modrow(int row) { return row < TX ? (row >> 12) : 8; }

__device__ __forceinline__ void p0_mod_item(const Frame& F, int item) {
    const int l = item / 96, cg = item % 96;
    LAS float* sc = (LAS float*)F.lds;
    LAS float* red = sc + 9 * 1024;
    for (int i = F.tid; i < 9 * 1024; i += NTHREADS) { const int r = i >> 10, k = i & 1023; const float v = r < 8 ? F.in[I_C][r * 1024 + k] : F.in[I_CCTX][k]; sc[i] = v / (1.f + expf(-v)); }
    __syncthreads();
    const float* W = F.in[I_MODW] + (size_t)l * 1024 * 6144 + cg * 64 + F.lane;
    float acc[9];
#pragma unroll
    for (int r = 0; r < 9; ++r) acc[r] = 0.f;
    for (int kb = 0; kb < 128; kb += 32) { float w[32];
#pragma unroll
        for (int kk = 0; kk < 32; ++kk) w[kk] = W[(size_t)(F.wave * 128 + kb + kk) * 6144];
#pragma unroll
        for (int kk = 0; kk < 32; ++kk) { const int k = F.wave * 128 + kb + kk;
#pragma unroll
            for (int r = 0; r < 9; ++r) acc[r] += sc[r * 1024 + k] * w[kk]; } }
#pragma unroll
    for (int r = 0; r < 9; ++r) red[(F.wave * 9 + r) * 64 + F.lane] = acc[r];
    __syncthreads();
    for (int i = F.tid; i < 9 * 64; i += NTHREADS) { const int r = i >> 6, ln = i & 63; float s = 0.f;
#pragma unroll
        for (int w = 0; w < 8; ++w) s += red[(w * 9 + r) * 64 + ln];
        ((float*)(F.ws + WS_MOD))[(size_t)(l * 9 + r) * 6144 + cg * 64 + ln] = s + F.in[I_MODB][l * 6144 + cg * 64 + ln]; }
    __syncthreads();
}
struct TDesc { const float* src; bf16_t* dst; int ldw; };
__device__ __forceinline__ void t_load(const TDesc& d, f32x4 (&v)[16], int lane) {
    const int kr = lane >> 4, nq = lane & 15;
#pragma unroll
    for (int i = 0; i < 16; ++i) v[i] = *(const f32x4*)(d.src + (size_t)(4 * i + kr) * d.ldw + 4 * nq);
}
__device__ __forceinline__ void t_finish(const TDesc& d, const f32x4 (&v)[16], LAS float* scr, int lane) {
    const int kr = lane >> 4, nq = lane & 15;
#pragma unroll
    for (int i = 0; i < 16; ++i) { LAS float* s = scr + (4 * i + kr) * 65 + 4 * nq; s[0] = v[i][0]; s[1] = v[i][1]; s[2] = v[i][2]; s[3] = v[i][3]; }
    asm volatile("s_waitcnt lgkmcnt(0)" ::: "memory");
    const int c = lane & 7;
#pragma unroll
    for (int j = 0; j < 8; ++j) { const int n = (lane >> 3) + 8 * j; const LAS float* s = scr + (8 * c) * 65 + n;
        u32x4 o; o.x = pk2(s[0 * 65], s[1 * 65]); o.y = pk2(s[2 * 65], s[3 * 65]); o.z = pk2(s[4 * 65], s[5 * 65]); o.w = pk2(s[6 * 65], s[7 * 65]);
        *(u32x4*)(d.dst + (size_t)n * 64 + 8 * c) = o; }
    asm volatile("s_waitcnt lgkmcnt(0)" ::: "memory");
}
constexpr int TN_AB = 16 * 28, TN_OAB = 16 * 16, TN_CD = 16 * 20, TN_OCD = 8 * 16, TN_G = 64 * 128, TN_U = 64 * 128, TN_D = 64 * 128;
constexpr int TN_ITEMS = TN_AB + TN_OAB + TN_CD + TN_OCD + TN_G + TN_U + TN_D;
__device__ __forceinline__ TDesc t_decode(const Frame& F, int it) {
    TDesc d; int r = it;
    if (r < TN_AB) { const int kb = r / 28, nb = r % 28, n0 = nb * 64; int d0;
        if (n0 < 768) d0 = n0; else if (n0 < 1280) { const int j = n0 - 768; d0 = 768 + (j >> 7) * 256 + (j & 127); } else { const int j = n0 - 1280; d0 = 768 + (j >> 7) * 256 + 128 + (j & 127); }
        d.src = F.in[I_WINAB] + (size_t)kb * 64 * 1792 + n0; d.ldw = 1792; d.dst = (bf16_t*)(F.ws + WS_WINAB) + ((size_t)kb * 1792 + d0) * 64; return d; } r -= TN_AB;
    if (r < TN_OAB) { const int kb = r / 16, nb = r % 16; d.src = F.in[I_WOUTAB] + (size_t)kb * 64 * 1024 + nb * 64; d.ldw = 1024; d.dst = (bf16_t*)(F.ws + WS_WOUTAB) + ((size_t)kb * 1024 + nb * 64) * 64; return d; } r -= TN_OAB;
    if (r < TN_CD) { const int kb = r / 20, nb = r % 20; d.src = F.in[I_WINCD] + (size_t)kb * 64 * 1280 + nb * 64; d.ldw = 1280; d.dst = (bf16_t*)(F.ws + WS_WINCD) + ((size_t)kb * 1280 + nb * 64) * 64; return d; } r -= TN_CD;
    if (r < TN_OCD) { const int kb = r / 16, nb = r % 16; d.src = F.in[I_WOUTCD] + (size_t)kb * 64 * 1024 + nb * 64; d.ldw = 1024; d.dst = (bf16_t*)(F.ws + WS_WOUTCD) + ((size_t)kb * 1024 + nb * 64) * 64; return d; } r -= TN_OCD;
    if (r < TN_G + TN_U) { const bool up = r >= TN_G; if (up) r -= TN_G; const int le = r >> 7, q = r & 127, kb = q >> 3, nb = q & 7, n0 = nb * 64;
        const int d0 = (n0 >> 7) * 256 + (up ? 128 : 0) + (n0 & 127);
        d.src = F.in[up ? I_EXU : I_EXG] + (size_t)le * 1024 * 512 + (size_t)kb * 64 * 512 + n0; d.ldw = 512; d.dst = (bf16_t*)(F.ws + WS_WGU) + (size_t)le * 1024 * 1024 + ((size_t)kb * 1024 + d0) * 64; return d; } r -= TN_G + TN_U;
    { const int le = r >> 7, q = r & 127, kb = q >> 4, nb = q & 15;
        d.src = F.in[I_EXD] + (size_t)le * 512 * 1024 + (size_t)kb * 64 * 1024 + nb * 64; d.ldw = 1024; d.dst = (bf16_t*)(F.ws + WS_WD) + (size_t)le * 1024 * 512 + ((size_t)kb * 1024 + nb * 64) * 64; return d; }
}
constexpr int TN_DENSE = TN_AB + TN_OAB + TN_CD + TN_OCD;
__device__ __forceinline__ void transpose_range(const Frame& F, int lo, int hi, int w, int nw) {
    LAS float* scr = (LAS float*)(F.lds + F.wave * 16640);
    f32x4 va[16], vb[16]; TDesc da, db;
    const int first = lo + w;
    if (first < hi) { da = t_decode(F, first); t_load(da, va, F.lane); }
    for (int it = first; it < hi; it += 2 * nw) {
        const int it2 = it + nw, it3 = it + 2 * nw;
        if (it2 < hi) { db = t_decode(F, it2); t_load(db, vb, F.lane); }
        t_finish(da, va, scr, F.lane);
        if (it3 < hi) { da = t_decode(F, it3); t_load(da, va, F.lane); }
        if (it2 < hi) t_finish(db, vb, scr, F.lane);
    }
}
__device__ __forceinline__ void p0_prologue(const Frame& F) {
    for (int it = F.vcu; it < 192; it += F.G) p0_mod_item(F, it);
    const int gw = F.vcu * NWAVES + F.wave, NGW = F.G * NWAVES;
    const int gt = gw * 64 + F.lane, NGT = NGW * 64;
    { float* rc = (float*)(F.ws + WS_ROPE); float* rs = rc + SEQ * 32;
      for (int i = gt; i < SEQ * 32; i += NGT) { const int s = i >> 5, d = i & 31, f = d & 15; const float pos = (float)(d < 16 ? (s >> 6) : (s & 63));
          const float inv = exp2f(-(float)f * (13.287712379549449f / 16.f)); const float a = pos * inv; rc[i] = cosf(a); rs[i] = sinf(a); } }
    { typedef float f32x16_t __attribute__((ext_vector_type(16)));
      bf16_t* WT = (bf16_t*)(F.ws + WS_WOUTCD); const int l31 = F.lane & 31, lh = F.lane >> 5;
      for (int it = gw; it < 4 * 32 * 4; it += NGW) { const int g = it >> 7, dt = (it >> 2) & 31, ct = it & 3;
          const float* wo = F.in[I_WOUTCD] + (size_t)(512 + g * 128 + lh) * 1024 + dt * 32 + l31;
          const float* pw = F.in[I_POOLW] + (size_t)(g * 128 + ct * 32 + l31) * 128 + lh; const float* ps = F.in[I_POOLS] + g * 128 + lh;
          f32x16_t acc;
#pragma unroll
          for (int r = 0; r < 16; ++r) acc[r] = 0.f;
          for (int dp0 = 0; dp0 < 128; dp0 += 16) { float av[8], bv[8];
#pragma unroll
              for (int u = 0; u < 8; ++u) { av[u] = wo[(size_t)(dp0 + 2 * u) * 1024]; bv[u] = pw[dp0 + 2 * u] * ps[dp0 + 2 * u]; }
#pragma unroll
              for (int u = 0; u < 8; ++u) acc = __builtin_amdgcn_mfma_f32_32x32x2f32(av[u], bv[u], acc, 0, 0, 0); }
#pragma unroll
          for (int r = 0; r < 16; ++r) { const int i = (r & 3) + 8 * (r >> 2) + 4 * lh; const int k_ = 512 + g * 128 + ct * 32 + l31; WT[((size_t)(k_ >> 6) * 1024 + dt * 32 + i) * 64 + (k_ & 63)] = (bf16_t)(pk2(acc[r], 0.f) & 0xffffu); } } }
    { bf16_t* WR = (bf16_t*)(F.ws + WS_WR);
      for (int i = gt; i < 2 * 32 * 144 * 8; i += NGT) { const int j = i & 7, e16 = (i >> 3) % 144, s_ = (i / (8 * 144)) & 31, l = i / (8 * 144 * 32);
          int col; bool grp = false; int c;
          if (e16 < 128) { const int lane_ = e16 & 63, row = lane_ & 15; c = lane_ >> 4; col = 8 * (row >> 2) + (e16 < 64 ? 0 : 4) + (row & 3); }
          else { const int q = e16 - 128; c = q & 3; col = q >> 2; grp = true; }
          const int k = 32 * s_ + 8 * c + j;
          const float w = grp ? F.in[I_RGW][(size_t)l * 4096 + k * 4 + col] : F.in[I_REW][(size_t)l * 32768 + k * 32 + col];
          const unsigned hi = pk2(w, 0.f) & 0xffffu; const unsigned lo = pk2(w - bflo(hi), 0.f) & 0xffffu;
          const size_t o = (size_t)s_ * 1152 + (size_t)e16 * 8 + j;
          WR[(size_t)(l * 2 + 0) * 36864 + o] = (bf16_t)hi; WR[(size_t)(l * 2 + 1) * 36864 + o] = (bf16_t)lo; } }
    transpose_range(F, 0, TN_DENSE, gw, NGW);
}

__device__ __forceinline__ void norm_mod_row(const float* xrow, const float* g, const float* sh, const float* sc, int lane, f32x4 (&h)[4]) {
    f32x4 v[4]; float ss = 0.f;
#pragma unroll
    for (int j = 0; j < 4; ++j) { v[j] = *(const f32x4*)(xrow + 4 * lane + 256 * j); ss += (v[j][0] * v[j][0] + v[j][1] * v[j][1]) + (v[j][2] * v[j][2] + v[j][3] * v[j][3]); }
    const float rms = 1.0f / sqrtf(wave_sum(ss) * (1.f / 1024.f) + EPS);
#pragma unroll
    for (int j = 0; j < 4; ++j) { const int c = 4 * lane + 256 * j; const f32x4 gg = *(const f32x4*)(g + c), s1 = *(const f32x4*)(sc + c), s0 = *(const f32x4*)(sh + c);
        h[j] = (v[j] * rms * gg) * (1.f + s1) + s0; }
}
__device__ __forceinline__ void store_row_bf16(bf16_t* orow, int lane, const f32x4 (&h)[4]) {
#pragma unroll
    for (int j = 0; j < 4; ++j) { u32x2 o; o.x = pk2(h[j][0], h[j][1]); o.y = pk2(h[j][2], h[j][3]); *(u32x2*)(orow + 4 * lane + 256 * j) = o; }
}
struct RowBuf { f32x4 v[4]; };
__device__ __forceinline__ void row_load(RowBuf& b, const float* xrow, int lane) {
#pragma unroll
    for (int j = 0; j < 4; ++j) b.v[j] = *(const f32x4*)(xrow + 4 * lane + 256 * j);
}
__device__ __forceinline__ void row_norm_store(const RowBuf& b, const float* g, const float* sh, const float* sc, bf16_t* orow, int lane) {
    float ss = 0.f;
#pragma unroll
    for (int j = 0; j < 4; ++j) ss += (b.v[j][0] * b.v[j][0] + b.v[j][1] * b.v[j][1]) + (b.v[j][2] * b.v[j][2] + b.v[j][3] * b.v[j][3]);
    const float rms = 1.0f / sqrtf(wave_sum(ss) * (1.f / 1024.f) + EPS);
    f32x4 h[4];
#pragma unroll
    for (int j = 0; j < 4; ++j) { const int c = 4 * lane + 256 * j; h[j] = (b.v[j] * rms * *(const f32x4*)(g + c)) * (1.f + *(const f32x4*)(sc + c)) + *(const f32x4*)(sh + c); }
    store_row_bf16(orow, lane, h);
}
__device__ __forceinline__ void p_norm1_l0(const Frame& F) {
    const int gw = F.vcu * NWAVES + F.wave, NGW = F.G * NWAVES;
    { float* GP = (float*)(F.ws + WS_GP);
      for (int i = gw * 64 + F.lane; i < 2 * 9 * 1024; i += NGW * 64) { const int k = i & 1023, lr = i >> 10; GP[i] = F.in[I_LN2][(lr / 9) * 1024 + k] * (1.f + F.mod(lr / 9, lr % 9, 4)[k]); } }
    bf16_t* HX = F.hx();
    RowBuf A, B;
    if (gw < TT) row_load(A, F.xin_row(gw), F.lane);
    for (int row = gw; row < TT; row += 2 * NGW) {
        const int row2 = row + NGW, row3 = row + 2 * NGW;
        if (row2 < TT) row_load(B, F.xin_row(row2), F.lane);
        { const int r = modrow(row); row_norm_store(A, F.in[I_LN1], F.mod(0, r, 0), F.mod(0, r, 1), HX + (size_t)row * DM, F.lane); }
        if (row3 < TT) row_load(A, F.xin_row(row3), F.lane);
        if (row2 < TT) { const int r = modrow(row2); row_norm_store(B, F.in[I_LN1], F.mod(0, r, 0), F.mod(0, r, 1), HX + (size_t)row2 * DM, F.lane); }
    }
}

struct Unit { int pm, pn, e; };
struct SchedDense {
    const bf16_t* Bt; int K, nMa, nN, nMb, pnb, vcu, G;
    __device__ __forceinline__ bool next(int i, Unit& u) const { int L = i * G + vcu; const int na = nMa * nN; u.e = 0;
        if (L < na) { u.pm = L / nN; u.pn = L % nN; return true; } L -= na; if (L < nMb) { u.pm = nMa + L; u.pn = pnb; return true; } return false; }
    __device__ __forceinline__ int arow(const Unit& u, int r) const { return u.pm * 256 + r; }
    __device__ __forceinline__ const bf16_t* bbase(const Unit& u) const { return Bt + (size_t)u.pn * 256 * 64; }
    __device__ __forceinline__ int brows() const { return nN * 256; }
};
struct MoeTab { const LAS int* tile_e; const LAS int* tile0; const LAS int* cnt; int ntiles; };
struct SchedMoe {
    const bf16_t* Wt; size_t estride; int K; MoeTab tb; const unsigned* list; bool gather; int vcu, G;
    __device__ __forceinline__ bool next(int i, Unit& u) const { const int L = i * G + vcu; if (L >= tb.ntiles * 4) return false; u.pm = L >> 2; u.pn = L & 3; u.e = tb.tile_e[u.pm]; return true; }
    __device__ __forceinline__ int arow(const Unit& u, int r) const {
        if (!gather) return u.pm * 256 + r;
        int idx = (u.pm - tb.tile0[u.e]) * 256 + r; const int c = tb.cnt[u.e]; idx = idx < c ? idx : c - 1;
        return (int)list[(size_t)u.e * TT + idx]; }
    __device__ __forceinline__ const bf16_t* bbase(const Unit& u) const { return Wt + (size_t)u.e * estride + (size_t)u.pn * 256 * 64; }
    __device__ __forceinline__ int brows() const { return 1024; }
};
__device__ __forceinline__ MoeTab moe_tables(const Frame& F, int l) {
    LAS int* tile_e = (LAS int*)(F.lds + LDS_TAB); LAS int* tile0 = tile_e + NTILE_MAX; LAS int* cntl = tile0 + 33; LAS int* nt = cntl + 32;
    __syncthreads();
    if (F.tid == 0) { int t = 0; unsigned* cg = F.cnt(l);
        for (int e = 0; e < NE; ++e) { const int c = (int)__hip_atomic_load(cg + e * 64, __ATOMIC_RELAXED, __HIP_MEMORY_SCOPE_AGENT); const int n = (c + 255) >> 8; tile0[e] = t; cntl[e] = c;
            for (int j = 0; j < n; ++j) tile_e[t + j] = e; t += n; }
        tile0[32] = t; nt[0] = t; }
    __syncthreads();
    MoeTab tb; tb.tile_e = tile_e; tb.tile0 = tile0; tb.cnt = cntl; tb.ntiles = nt[0]; return tb;
}

namespace pg8 {
constexpr int BM = 256, BK = 64, HALF = 128, HTB = HALF * BK * 2;
__device__ __forceinline__ int lds_byte(int r, int c) { const int st = (r >> 4) * 2 + (c >> 5), rr = r & 15, cc = c & 31, ob = rr * 64 + cc * 2; return st * 1024 + (ob ^ (((ob >> 9) & 1) << 5)); }
__device__ __forceinline__ void stage_rc(int b, int& R, int& C) { const int st = b / 1024, sb = b % 1024, swz = sb ^ (((sb >> 9) & 1) << 5); R = (st >> 1) * 16 + swz / 64; C = (st & 1) * 32 + (swz % 64) / 2; }
__device__ __forceinline__ int perm32(int rho) { const int n = rho >> 4, i = rho & 15; return 8 * (i >> 2) + 4 * n + (i & 3); }
}
template <bool ALIGN_EPI, class Sched, class Epi>
__device__ __forceinline__ void gemm_fast(const Frame& F, const bf16_t* A, int K, const Sched& S, const Epi& E) {
    using namespace pg8;
    LAS unsigned char* lds = F.lds;
    const int tid = F.tid, wid = F.wave, lane = F.lane, wr = wid >> 2, wc = wid & 3, fr = lane & 15, fq = lane >> 4;
    const int nt = K / BK;
    int RA[2], CA[2]; unsigned voffB[2];
#pragma unroll
    for (int i = 0; i < 2; ++i) { int R, C; stage_rc(tid * 16 + i * 8192, R, C); RA[i] = R; CA[i] = C; const int Rb = (R & ~31) + perm32(R & 31); voffB[i] = (unsigned)(Rb * 64 + C) * 2u; }
    const size_t kstep = (size_t)(BK * 2);
    const size_t kstepB = (size_t)S.brows() * BK * 2;
    const size_t hstep = (size_t)HALF * BK * 2;
    const unsigned ldsw = (unsigned)wid * 1024u;
    const int aoff = lds_byte(wr * 64 + fr, fq * 8), boff = lds_byte(wc * 32 + fr, fq * 8);
    const char* Ab = (const char*)A;
#define PG8_SA(b, h) (((b) * 2 + (h)) * HTB)
#define PG8_SB(b, h) ((4 + (b) * 2 + (h)) * HTB)
#define PG8_STAGE(bufoff, gbase, voff) do { _Pragma("unroll") for (int _i = 0; _i < 2; ++_i) \
        __builtin_amdgcn_global_load_lds((const unsigned*)((const char*)(gbase) + (voff)[_i]), (LAS unsigned*)(lds + (bufoff) + ldsw + _i * 8192), 16, 0, 0); } while (0)
#define PG8_LDA(dst, b, h) do { _Pragma("unroll") for (int m = 0; m < 4; ++m) _Pragma("unroll") for (int k = 0; k < 2; ++k) dst[m][k] = *(const LAS bf16x8*)(lds + PG8_SA(b, h) + aoff + m * 2048 + k * 1024); } while (0)
#define PG8_LDB(dst, b, h) do { _Pragma("unroll") for (int n = 0; n < 2; ++n) _Pragma("unroll") for (int k = 0; k < 2; ++k) dst[n][k] = *(const LAS bf16x8*)(lds + PG8_SB(b, h) + boff + n * 2048 + k * 1024); } while (0)
#define PG8_MMA(ai, bj, At, Bt) do { __builtin_amdgcn_s_setprio(1); _Pragma("unroll") for (int m = 0; m < 4; ++m) _Pragma("unroll") for (int n = 0; n < 2; ++n) _Pragma("unroll") for (int k = 0; k < 2; ++k) \
        acc[ai][bj][m][n] = __builtin_amdgcn_mfma_f32_16x16x32_bf16(Bt[n][k], At[m][k], acc[ai][bj][m][n], 0, 0, 0); __builtin_amdgcn_s_setprio(0); } while (0)
#define PG8_WAIT_V(n) asm volatile("s_waitcnt vmcnt(" #n ")" ::: "memory")
#define PG8_WAIT_L(n) asm volatile("s_waitcnt lgkmcnt(" #n ")" ::: "memory")
#define PG8_BAR __builtin_amdgcn_s_barrier()
#define PG8_SCHED __builtin_amdgcn_sched_barrier(0)
#define PG8_VOFF(dst, u) do { _Pragma("unroll") for (int _h = 0; _h < 2; ++_h) _Pragma("unroll") for (int _i = 0; _i < 2; ++_i) \
        dst[_h][_i] = (unsigned)S.arow(u, 128 * _h + RA[_i]) * (unsigned)(K * 2) + (unsigned)(CA[_i] * 2); } while (0)
    Unit cur, nxt; int ui = 0;
    if (!S.next(0, cur)) return;
    f32x4 acc[2][2][4][2];
#pragma unroll
    for (int a = 0; a < 2; ++a)
#pragma unroll
        for (int b = 0; b < 2; ++b)
#pragma unroll
            for (int m = 0; m < 4; ++m)
#pragma unroll
                for (int n = 0; n < 2; ++n) acc[a][b][m][n] = (f32x4){0.f, 0.f, 0.f, 0.f};
    bf16x8 At[4][2], B0[2][2], B1[2][2];
    unsigned vC[2][2], vN[2][2];
    PG8_VOFF(vC, cur);
    const char* cB = (const char*)S.bbase(cur);
    PG8_STAGE(PG8_SB(0, 0), cB, voffB); PG8_STAGE(PG8_SB(0, 1), cB + hstep, voffB); PG8_STAGE(PG8_SA(0, 0), Ab, vC[0]); PG8_STAGE(PG8_SA(0, 1), Ab, vC[1]);
    if (wr == 1) PG8_BAR;
    PG8_WAIT_V(2); PG8_BAR;
    PG8_STAGE(PG8_SB(1, 0), cB + kstepB, voffB); PG8_STAGE(PG8_SA(1, 0), Ab + kstep, vC[0]); PG8_STAGE(PG8_SB(1, 1), cB + hstep + kstepB, voffB);
    PG8_WAIT_V(6); PG8_BAR;
    for (;;) {
        const bool has_next = S.next(ui + 1, nxt);
        const char* nB = cB;
        if (has_next) { PG8_VOFF(vN, nxt); nB = (const char*)S.bbase(nxt); }
        else {
#pragma unroll
            for (int h = 0; h < 2; ++h)
#pragma unroll
                for (int i = 0; i < 2; ++i) vN[h][i] = vC[h][i]; }
        for (int t = 0; t < nt; t += 2) {
            const bool last = (t == nt - 2);
            const char* a1 = Ab + (size_t)(t + 1) * kstep;
            const char* a2 = last ? Ab : Ab + (size_t)(t + 2) * kstep; const char* b2 = last ? nB : cB + (size_t)(t + 2) * kstepB;
            const char* a3 = a2 + kstep; const char* b3 = b2 + kstepB;
            unsigned v2[2][2];
#pragma unroll
            for (int h = 0; h < 2; ++h)
#pragma unroll
                for (int i = 0; i < 2; ++i) v2[h][i] = last ? vN[h][i] : vC[h][i];
            PG8_LDB(B0, 0, 0); PG8_LDB(B1, 0, 1); PG8_SCHED; PG8_LDA(At, 0, 0); PG8_STAGE(PG8_SA(1, 1), a1, vC[1]);
            PG8_WAIT_V(8); PG8_WAIT_L(0); PG8_BAR; PG8_MMA(0, 0, At, B0); PG8_MMA(0, 1, At, B1); PG8_BAR; PG8_SCHED;
            PG8_LDA(At, 0, 1); PG8_STAGE(PG8_SB(0, 0), b2, voffB); PG8_STAGE(PG8_SB(0, 1), b2 + hstep, voffB); PG8_STAGE(PG8_SA(0, 0), a2, v2[0]);
            PG8_WAIT_V(8); PG8_WAIT_L(0); PG8_BAR; PG8_MMA(1, 0, At, B0); PG8_MMA(1, 1, At, B1); PG8_BAR; PG8_SCHED;
            PG8_LDB(B0, 1, 0); PG8_LDB(B1, 1, 1); PG8_SCHED; PG8_LDA(At, 1, 0); PG8_STAGE(PG8_SA(0, 1), a2, v2[1]);
            PG8_WAIT_V(8); PG8_WAIT_L(0); PG8_BAR; PG8_MMA(0, 0, At, B0); PG8_MMA(0, 1, At, B1); PG8_BAR; PG8_SCHED;
            PG8_LDA(At, 1, 1); PG8_STAGE(PG8_SB(1, 0), b3, voffB); PG8_STAGE(PG8_SB(1, 1), b3 + hstep, voffB); PG8_STAGE(PG8_SA(1, 0), a3, v2[0]);
            PG8_WAIT_V(8); PG8_WAIT_L(0); PG8_BAR; PG8_MMA(1, 0, At, B0); PG8_MMA(1, 1, At, B1); PG8_BAR; PG8_SCHED;
        }
        if (ALIGN_EPI) { if (wr == 0) PG8_BAR; }
        E(acc, cur, wr, wc, fr, fq);
        if (!has_next) break;
#pragma unroll
        for (int a = 0; a < 2; ++a)
#pragma unroll
            for (int b = 0; b < 2; ++b)
#pragma unroll
                for (int m = 0; m < 4; ++m)
#pragma unroll
                    for (int n = 0; n < 2; ++n) acc[a][b][m][n] = (f32x4){0.f, 0.f, 0.f, 0.f};
        cur = nxt; cB = nB; ++ui;
#pragma unroll
        for (int h = 0; h < 2; ++h)
#pragma unroll
            for (int i = 0; i < 2; ++i) vC[h][i] = vN[h][i];
        if (ALIGN_EPI) { if (wr == 1) PG8_BAR; }
    }
    PG8_WAIT_V(0);
    if (!ALIGN_EPI) { if (wr == 0) PG8_BAR; }
    PG8_BAR;
#undef PG8_SA
#undef PG8_SB
#undef PG8_STAGE
#undef PG8_LDA
#undef PG8_LDB
#undef PG8_MMA
#undef PG8_WAIT_V
#undef PG8_WAIT_L
#undef PG8_BAR
#undef PG8_SCHED
#undef PG8_VOFF
}
#ifndef ALIGN_G2
#define ALIGN_G2 false
#endif
#define GEMM gemm_fast<true>
#define GEMM2 gemm_fast<ALIGN_G2>

__device__ __forceinline__ u32x4 pack8(const f32x4& a, const f32x4& b) { u32x4 w; w.x = pk2(a[0], a[1]); w.y = pk2(a[2], a[3]); w.z = pk2(b[0], b[1]); w.w = pk2(b[2], b[3]); return w; }
template <bool GLU> struct EpiInProj {
    bf16_t* Q; bf16_t* KR; bf16_t* Vn; bf16_t* Gb;
    __device__ __forceinline__ void operator()(const f32x4 (&acc)[2][2][4][2], const Unit& u, int wr, int wc, int fr, int fq) const {
#pragma unroll
        for (int ai = 0; ai < 2; ++ai)
#pragma unroll
            for (int m = 0; m < 4; ++m) { const int irow = u.pm * 256 + 128 * ai + 64 * wr + 16 * m + fr; const size_t row = (size_t)irow; const int cl = 32 * wc + 8 * fq;
                if (u.pn < 2) { *(u32x4*)(Q + row * 512 + u.pn * 256 + cl) = pack8(acc[ai][0][m][0], acc[ai][0][m][1]); *(u32x4*)(Q + row * 512 + u.pn * 256 + 128 + cl) = pack8(acc[ai][1][m][0], acc[ai][1][m][1]); }
                else if (u.pn == 2) { const size_t kvrow = irow < TX ? (size_t)(irow >> 12) * KVS + CTXL + (irow & 4095) : (size_t)((irow - TX) >> 8) * KVS + ((irow - TX) & 255);
                    *(u32x4*)(KR + kvrow * 128 + cl) = pack8(acc[ai][0][m][0], acc[ai][0][m][1]); *(u32x4*)(Vn + kvrow * 128 + cl) = pack8(acc[ai][1][m][0], acc[ai][1][m][1]); }
                else if (GLU) { f32x4 g0, g1;
#pragma unroll
                    for (int j = 0; j < 4; ++j) { g0[j] = acc[ai][0][m][0][j] * sigmoidf_(acc[ai][1][m][0][j]); g1[j] = acc[ai][0][m][1][j] * sigmoidf_(acc[ai][1][m][1][j]); }
                    *(u32x4*)(Gb + row * 512 + (u.pn - 3) * 128 + cl) = pack8(g0, g1); }
                else { *(u32x4*)(Gb + row * 512 + (u.pn - 3) * 256 + cl) = pack8(acc[ai][0][m][0], acc[ai][0][m][1]); *(u32x4*)(Gb + row * 512 + (u.pn - 3) * 256 + 128 + cl) = pack8(acc[ai][1][m][0], acc[ai][1][m][1]); }
            }
    }
};
template <bool L0, bool DRY = false> struct EpiOutProj {
    Frame F; int l;
    __device__ __forceinline__ void operator()(const f32x4 (&acc)[2][2][4][2], const Unit& u, int wr, int wc, int fr, int fq) const {
        float* SS = (float*)(F.ws + WS_SS);
        const float* g1 = F.mod(l, modrow(u.pm * 256), 2) + u.pn * 256 + 32 * wc + 8 * fq;
        f32x4 gv[2][2];
#pragma unroll
        for (int bj = 0; bj < 2; ++bj)
#pragma unroll
            for (int n = 0; n < 2; ++n) gv[bj][n] = *(const f32x4*)(g1 + 128 * bj + 4 * n);
#pragma unroll
        for (int ai = 0; ai < 2; ++ai) {
            f32x4 xv[4][2][2];
#pragma unroll
            for (int m = 0; m < 4; ++m) { const int row = u.pm * 256 + 128 * ai + 64 * wr + 16 * m + fr; const int c0 = u.pn * 256 + 32 * wc + 8 * fq;
#pragma unroll
                for (int bj = 0; bj < 2; ++bj) {
                    if (L0) { const float* src = F.xin_row(row) + c0 + 128 * bj; xv[m][bj][0] = *(const f32x4*)(src); xv[m][bj][1] = *(const f32x4*)(src + 4); }
                    else { const u32x4 w = *(const u32x4*)(F.xr_row(row) + c0 + 128 * bj); xv[m][bj][0] = (f32x4){bflo(w.x), bfhi(w.x), bflo(w.y), bfhi(w.y)}; xv[m][bj][1] = (f32x4){bflo(w.z), bfhi(w.z), bflo(w.w), bfhi(w.w)}; } } }
#pragma unroll
            for (int m = 0; m < 4; ++m) { const int row = u.pm * 256 + 128 * ai + 64 * wr + 16 * m + fr; bf16_t* dst = F.xr_row(row) + u.pn * 256 + 32 * wc + 8 * fq; float q = 0.f;
#pragma unroll
                for (int bj = 0; bj < 2; ++bj) { const f32x4 v0 = xv[m][bj][0] + gv[bj][0] * acc[ai][bj][m][0], v1 = xv[m][bj][1] + gv[bj][1] * acc[ai][bj][m][1];
                    *(u32x4*)(dst + 128 * bj) = DRY ? pack8(xv[m][bj][0], xv[m][bj][1]) : pack8(v0, v1);
                    q += ((v0[0] * v0[0] + v0[1] * v0[1]) + (v0[2] * v0[2] + v0[3] * v0[3])) + ((v1[0] * v1[0] + v1[1] * v1[1]) + (v1[2] * v1[2] + v1[3] * v1[3])); }
                q += __shfl_xor(q, 16); q += __shfl_xor(q, 32);
                if (fq == 0) SS[(size_t)row * 16 + u.pn * 4 + wc] = q; }
        }
    }
};
struct EpiMoe1 {
    bf16_t* HID;
    __device__ __forceinline__ void operator()(const f32x4 (&acc)[2][2][4][2], const Unit& u, int wr, int wc, int fr, int fq) const {
#pragma unroll
        for (int ai = 0; ai < 2; ++ai)
#pragma unroll
            for (int m = 0; m < 4; ++m) { const size_t slot = (size_t)u.pm * 256 + 128 * ai + 64 * wr + 16 * m + fr; f32x4 h0, h1;
#pragma unroll
                for (int j = 0; j < 4; ++j) { const float a = acc[ai][0][m][0][j], b = acc[ai][0][m][1][j]; h0[j] = a * sigmoidf_(a) * acc[ai][1][m][0][j]; h1[j] = b * sigmoidf_(b) * acc[ai][1][m][1][j]; }
                *(u32x4*)(HID + slot * 512 + u.pn * 128 + 32 * wc + 8 * fq) = pack8(h0, h1); }
    }
};
struct EpiMoe2 {
    bf16_t* YB;
    __device__ __forceinline__ void operator()(const f32x4 (&acc)[2][2][4][2], const Unit& u, int wr, int wc, int fr, int fq) const {
#pragma unroll
        for (int ai = 0; ai < 2; ++ai)
#pragma unroll
            for (int m = 0; m < 4; ++m) { const size_t slot = (size_t)u.pm * 256 + 128 * ai + 64 * wr + 16 * m + fr;
#pragma unroll
                for (int bj = 0; bj < 2; ++bj) *(u32x4*)(YB + slot * 1024 + u.pn * 256 + 128 * bj + 32 * wc + 8 * fq) = pack8(acc[ai][bj][m][0], acc[ai][bj][m][1]); }
    }
};

__device__ __forceinline__ void p_k_post(const Frame& F, const float* kg) {
    const int gw = F.vcu * NWAVES + F.wave, NGW = F.G * NWAVES, lane = F.lane;
    const bf16_t* KR = (const bf16_t*)(F.ws + WS_KV); bf16_t* Kn = (bf16_t*)(F.ws + WS_KN);
    const float* rc = (const float*)(F.ws + WS_ROPE); const float* rs = rc + SEQ * 32;
    const int c16 = lane & 15, i8 = c16 & 7, dd0 = 8 * (i8 & 3), sub = lane >> 4;
    float gk[8];
#pragma unroll
    for (int j = 0; j < 8; ++j) gk[j] = kg[i8 * 8 + j];
    const float sgn = (i8 < 4) ? -1.f : 1.f;
    for (int it = gw; it < NB * KVS / 16; it += NGW) {
        u32x4 w[4];
#pragma unroll
        for (int q = 0; q < 4; ++q) w[q] = *(const u32x4*)(KR + (size_t)(it * 16 + 4 * q + sub) * 128 + c16 * 8);
#pragma unroll
        for (int q = 0; q < 4; ++q) { const int kvrow = it * 16 + 4 * q + sub, pos = kvrow % KVS;
            float cs[8], sn[8];
#pragma unroll
            for (int j = 0; j < 8; ++j) { cs[j] = 1.f; sn[j] = 0.f; }
            if (pos >= CTXL) { const int sq = pos - CTXL; const f32x4 c0 = *(const f32x4*)(rc + sq * 32 + dd0), c1 = *(const f32x4*)(rc + sq * 32 + dd0 + 4), s0 = *(const f32x4*)(rs + sq * 32 + dd0), s1 = *(const f32x4*)(rs + sq * 32 + dd0 + 4);
#pragma unroll
                for (int j = 0; j < 4; ++j) { cs[j] = c0[j]; cs[4 + j] = c1[j]; sn[j] = s0[j]; sn[4 + j] = s1[j]; } }
            float x[8] = {bflo(w[q].x), bfhi(w[q].x), bflo(w[q].y), bfhi(w[q].y), bflo(w[q].z), bfhi(w[q].z), bflo(w[q].w), bfhi(w[q].w)};
            float ss = 0.f;
#pragma unroll
            for (int j = 0; j < 8; ++j) ss += x[j] * x[j];
            ss += __shfl_xor(ss, 1); ss += __shfl_xor(ss, 2); ss += __shfl_xor(ss, 4);
            const float rms = 1.0f / sqrtf(ss * (1.f / 64.f) + EPS);
            float y[8], o[8];
#pragma unroll
            for (int j = 0; j < 8; ++j) y[j] = x[j] * rms * gk[j];
#pragma unroll
            for (int j = 0; j < 8; ++j) { const float yp = __shfl_xor(y[j], 4); o[j] = y[j] * cs[j] + sgn * yp * sn[j]; }
            u32x4 ow; ow.x = pk2(o[0], o[1]); ow.y = pk2(o[2], o[3]); ow.z = pk2(o[4], o[5]); ow.w = pk2(o[6], o[7]);
            *(u32x4*)(Kn + (size_t)kvrow * 128 + c16 * 8) = ow; }
    }
}
__device__ __forceinline__ void p_conv(const Frame& F) {
    const bf16_t* Gb = (const bf16_t*)(F.ws + WS_G); bf16_t* AO = (bf16_t*)(F.ws + WS_AO);
    LAS bf16_t* gl = (LAS bf16_t*)F.lds;
    LAS float* yl = (LAS float*)(F.lds + 65536);
    const int c = F.tid;
    float w[31];
#pragma unroll
    for (int j = 0; j < 31; ++j) w[j] = F.in[I_CONVW][j * 512 + c];
    const float bias = F.in[I_CONVB][c];
    for (int item = F.vcu; item < 1024 + 64; item += F.G) {
        int rowbase, t0, len;
        if (item < 1024) { rowbase = (item >> 7) * SEQ; t0 = (item & 127) * 32; len = SEQ; } else { const int it = item - 1024; rowbase = TX + (it >> 3) * CTXL; t0 = (it & 7) * 32; len = CTXL; }
        __syncthreads();
        for (int ch = F.tid; ch < 62 * 64; ch += NTHREADS) { const int r = ch >> 6, p = t0 - 15 + r; u32x4 v = (u32x4){0u, 0u, 0u, 0u};
            if (p >= 0 && p < len) v = *(const u32x4*)(Gb + (size_t)(rowbase + p) * 512 + (ch & 63) * 8);
            *(LAS u32x4*)(gl + r * 512 + (ch & 63) * 8) = v; }
        __syncthreads();
        float g[62];
#pragma unroll
        for (int r = 0; r < 62; ++r) g[r] = bf2f(gl[r * 512 + c]);
#pragma unroll
        for (int t = 0; t < 32; ++t) { float y = bias;
#pragma unroll
            for (int j = 0; j < 31; ++j) y += g[t + j] * w[j];
            yl[t * 512 + c] = y; }
        __syncthreads();
#pragma unroll
        for (int tt = 0; tt < 4; ++tt) { const int t = 4 * F.wave + tt; float v[8]; float s = 0.f;
#pragma unroll
            for (int j = 0; j < 8; ++j) { v[j] = yl[t * 512 + F.lane + 64 * j]; s += v[j]; }
            const float mean = wave_sum(s) * (1.f / 512.f); float q = 0.f;
#pragma unroll
            for (int j = 0; j < 8; ++j) { v[j] -= mean; q += v[j] * v[j]; }
            const float rstd = 1.0f / sqrtf(wave_sum(q) * (1.f / 512.f) + EPS);
            bf16_t* orow = AO + (size_t)(rowbase + t0 + t) * 1024 + 512;
#pragma unroll
            for (int j = 0; j < 8; ++j) { const int cc = F.lane + 64 * j; const float yn = v[j] * rstd * F.in[I_CLNG][cc] + F.in[I_CLNB][cc]; orow[cc] = (bf16_t)(pk2(yn * sigmoidf_(yn), 0.f) & 0xffffu); } }
    }
    __syncthreads();
}
__device__ __forceinline__ void p_pool(const Frame& F) {
    const int gw = F.vcu * NWAVES + F.wave, NGW = F.G * NWAVES, lane = F.lane;
    const bf16_t* U = (const bf16_t*)(F.ws + WS_G); bf16_t* AO = (bf16_t*)(F.ws + WS_AO);
    const int hw = 1 << (lane >> 4);
    float wgt[16];
#pragma unroll
    for (int i = 0; i < 16; ++i) wgt[i] = (i >= 8 - hw && i < 8 + hw) ? 1.f : 0.f;
    for (int it = gw; it < TX / 8; it += NGW) {
        const int row0 = it * 8, t0 = row0 & 4095, rb = row0 - t0;
        u32x4 r[23];
#pragma unroll
        for (int j = 0; j < 23; ++j) { const int p = t0 - 8 + j; r[j] = (u32x4){0u, 0u, 0u, 0u}; if (p >= 0 && p < SEQ) r[j] = *(const u32x4*)(U + (size_t)(rb + p) * 512 + lane * 8); }
#pragma unroll
        for (int t = 0; t < 8; ++t) {
            float s[8];
#pragma unroll
            for (int j = 0; j < 8; ++j) s[j] = 0.f;
#pragma unroll
            for (int i = 0; i < 16; ++i) { const u32x4 w = r[t + i]; const float g = wgt[i];
                s[0] += g * bflo(w.x); s[1] += g * bfhi(w.x); s[2] += g * bflo(w.y); s[3] += g * bfhi(w.y); s[4] += g * bflo(w.z); s[5] += g * bfhi(w.z); s[6] += g * bflo(w.w); s[7] += g * bfhi(w.w); }
            const int tt = t0 + t; int lo = tt - hw, hi = tt + hw; lo = lo < 0 ? 0 : lo; hi = hi > SEQ ? SEQ : hi;
            const float inv = 1.f / (float)(hi - lo); const u32x4 w = r[t + 8];
            u32x4 ow; ow.x = pk2(s[0] * inv - bflo(w.x), s[1] * inv - bfhi(w.x)); ow.y = pk2(s[2] * inv - bflo(w.y), s[3] * inv - bfhi(w.y)); ow.z = pk2(s[4] * inv - bflo(w.z), s[5] * inv - bfhi(w.z)); ow.w = pk2(s[6] * inv - bflo(w.w), s[7] * inv - bfhi(w.w));
            *(u32x4*)(AO + (size_t)(row0 + t) * 1024 + 512 + lane * 8) = ow;
        }
    }
}

template <int LAYER> __device__ __forceinline__ void attn_simple(const Frame& F) {
    const bf16_t* Q = (const bf16_t*)(F.ws + WS_Q); const bf16_t* Kn = (const bf16_t*)(F.ws + WS_KN); const bf16_t* Vn = (const bf16_t*)(F.ws + WS_VN); bf16_t* AO = (bf16_t*)(F.ws + WS_AO);
    const int nunits = LAYER == 0 ? 512 + 64 : 512;
    for (int u = F.vcu; u < nunits; u += F.G) {
        int b, h, row, s; bool valid = true, isctx = false;
        if (u < 512) { b = u >> 6; h = (u >> 3) & 7; s = (u & 7) * 512 + F.tid; row = b * SEQ + s; }
        else { const int uc = u - 512; b = uc >> 3; h = uc & 7; s = F.tid; valid = F.tid < 256; row = TX + b * CTXL + (valid ? s : 0); isctx = true; }
        float q[64], o[64];
        { const u32x4* qp = (const u32x4*)(Q + (size_t)row * 512 + h * 64);
#pragma unroll
          for (int c = 0; c < 8; ++c) { const u32x4 w = qp[c]; q[8 * c] = bflo(w.x); q[8 * c + 1] = bfhi(w.x); q[8 * c + 2] = bflo(w.y); q[8 * c + 3] = bfhi(w.y); q[8 * c + 4] = bflo(w.z); q[8 * c + 5] = bfhi(w.z); q[8 * c + 6] = bflo(w.w); q[8 * c + 7] = bfhi(w.w); } }
#pragma unroll
        for (int d = 0; d < 64; ++d) o[d] = 0.f;
        float mx = -1e30f, l = 0.f;
        const bf16_t* Kb = Kn + (size_t)b * KVS * 128 + (h >> 2) * 64; const bf16_t* Vb = Vn + (size_t)b * KVS * 128 + (h >> 2) * 64;
        int k_lo2 = 0, k_hi2 = 0;
        const int k_hi1 = CTXL;
        if (LAYER == 0) { if (!isctx) { k_lo2 = CTXL; k_hi2 = KVS; } }
        else { const int s0 = (u & 7) * 512; int lo = s0 - 128, hi = s0 + 511 + 128 + 1; lo = lo < 0 ? 0 : lo; hi = hi > SEQ ? SEQ : hi; k_lo2 = CTXL + lo; k_hi2 = CTXL + hi; }
        for (int part = 0; part < 2; ++part) {
            const int kb = part == 0 ? 0 : k_lo2, ke = part == 0 ? k_hi1 : k_hi2;
            for (int key = kb; key < ke; ++key) {
                const u32x4* kp = (const u32x4*)(Kb + (size_t)key * 128); float sd = 0.f;
#pragma unroll
                for (int c = 0; c < 8; ++c) { const u32x4 w = kp[c];
                    sd += q[8 * c] * bflo(w.x) + q[8 * c + 1] * bfhi(w.x) + q[8 * c + 2] * bflo(w.y) + q[8 * c + 3] * bfhi(w.y) + q[8 * c + 4] * bflo(w.z) + q[8 * c + 5] * bfhi(w.z) + q[8 * c + 6] * bflo(w.w) + q[8 * c + 7] * bfhi(w.w); }
                bool use = valid;
                if (LAYER == 1 && part == 1) { const int j = key - CTXL; const int dlt = s - j; use = use && (dlt <= 128 && dlt >= -128); }
                const float mn = fmaxf(mx, sd); const float mnew = use ? mn : mx;
                const float alpha = exp2f(mx - mnew), p = use ? exp2f(sd - mnew) : 0.f;
                mx = mnew; l = l * alpha + p;
                const u32x4* vp = (const u32x4*)(Vb + (size_t)key * 128);
#pragma unroll
                for (int c = 0; c < 8; ++c) { const u32x4 w = vp[c];
                    o[8 * c] = o[8 * c] * alpha + p * bflo(w.x); o[8 * c + 1] = o[8 * c + 1] * alpha + p * bfhi(w.x); o[8 * c + 2] = o[8 * c + 2] * alpha + p * bflo(w.y); o[8 * c + 3] = o[8 * c + 3] * alpha + p * bfhi(w.y);
                    o[8 * c + 4] = o[8 * c + 4] * alpha + p * bflo(w.z); o[8 * c + 5] = o[8 * c + 5] * alpha + p * bfhi(w.z); o[8 * c + 6] = o[8 * c + 6] * alpha + p * bflo(w.w); o[8 * c + 7] = o[8 * c + 7] * alpha + p * bfhi(w.w); }
            }
        }
        if (LAYER == 1) l += exp2f(F.in[I_SINK][h] * LOG2E - mx);
        const float il = 1.f / l;
        if (valid) { u32x4* op = (u32x4*)(AO + (size_t)row * 1024 + h * 64);
#pragma unroll
            for (int c = 0; c < 8; ++c) { u32x4 w; w.x = pk2(o[8 * c] * il, o[8 * c + 1] * il); w.y = pk2(o[8 * c + 2] * il, o[8 * c + 3] * il); w.z = pk2(o[8 * c + 4] * il, o[8 * c + 5] * il); w.w = pk2(o[8 * c + 6] * il, o[8 * c + 7] * il); op[c] = w; } }
    }
}

#include <hip/hip_bf16.h>
namespace attn_body {
using bf16=__hip_bfloat16;
using s16x4=__attribute__((ext_vector_type(4)))short;
using f32x16=__attribute__((ext_vector_type(16)))float;
constexpr int NW=8,QBLK=32,QB=QBLK*NW,KVBLK=64;
constexpr int QP=512,KP=128,OP=1024;
__device__ __forceinline__ int crow(int r,int hi){return (r&3)+8*(r>>2)+4*hi;}
#define SBAR() __builtin_amdgcn_sched_barrier(0)
__device__ __forceinline__ void wmask(f32x16&p0,f32x16&p1,int dlt0,int hi){
  const float NEG=-INFINITY; const int kb=dlt0+4*hi;
  #pragma unroll
  for(int r=0;r<16;++r){const int d=kb+(r&3)+8*(r>>2); if(d>128||d<-128)p0[r]=NEG; if(d+32>128||d+32<-128)p1[r]=NEG;}
}

constexpr int NSLOT=3, SLOTB=8192;
constexpr int LDS_K=0, LDS_V=NSLOT*SLOTB, LDS_WS=2*NSLOT*SLOTB, LDS_OST=LDS_WS+NW*64*4, LDS_BYTES=LDS_OST+NW*4096;
__device__ __forceinline__ void glds16(const void*gsrc,unsigned lds_dst){unsigned keep;
  asm volatile("s_mov_b32 %0, m0\n\ts_mov_b32 m0, %2\n\ts_nop 0\n\tglobal_load_lds_dwordx4 %1, off\n\ts_mov_b32 m0, %0":"=&s"(keep):"v"(gsrc),"s"(lds_dst):"memory");}
__device__ __forceinline__ float max3f(float a,float b,float c){float r;asm("v_max3_f32 %0, %1, %2, %3":"=v"(r):"v"(a),"v"(b),"v"(c));return r;}
__device__ __forceinline__ float max2f(float a,float b){float r;asm("v_max_f32_e32 %0, %1, %2":"=v"(r):"v"(a),"v"(b));return r;}
__device__ __forceinline__ float fadd_s(float a,float b){float r;asm("v_add_f32_e32 %0, %1, %2":"=v"(r):"v"(a),"v"(b));return r;}
__device__ __forceinline__ float fsub_s(float a,float b){float r;asm("v_sub_f32_e32 %0, %1, %2":"=v"(r):"v"(a),"v"(b));return r;}
typedef float f32x2_t __attribute__((ext_vector_type(2))); typedef __bf16 bf16x2_t __attribute__((ext_vector_type(2)));
__device__ __forceinline__ unsigned cvtpk_s(float lo,float hi){f32x2_t v={lo,hi};bf16x2_t b=__builtin_convertvector(v,bf16x2_t);return __builtin_bit_cast(unsigned,b);}
#define WAIT_BAR(N) asm volatile("s_waitcnt vmcnt(" #N ") lgkmcnt(0)\n\ts_barrier":::"memory")

__device__ __forceinline__ void qkt(f32x16&p0,f32x16&p1,const char*Kslot,const bf16x8*qr,const f32x16&negm,int r32,int hi){
  const char*kb=Kslot+hi*1024+r32*16;
  #pragma unroll
  for(int d0=0;d0<4;++d0){
    const bf16x8 b0=*reinterpret_cast<const bf16x8*>(kb+d0*2048);
    const bf16x8 b1=*reinterpret_cast<const bf16x8*>(kb+d0*2048+512);
    if(d0==0){p0=__builtin_amdgcn_mfma_f32_32x32x16_bf16(b0,qr[0],negm,0,0,0);p1=__builtin_amdgcn_mfma_f32_32x32x16_bf16(b1,qr[0],negm,0,0,0);}
    else{p0=__builtin_amdgcn_mfma_f32_32x32x16_bf16(b0,qr[d0],p0,0,0,0);p1=__builtin_amdgcn_mfma_f32_32x32x16_bf16(b1,qr[d0],p1,0,0,0);}}
}
typedef __attribute__((address_space(3))) const char* lds_cptr;
typedef short v4i16_t __attribute__((ext_vector_type(4)));
__device__ __forceinline__ void kload8(bf16x8*kf,lds_cptr kp){
  kf[0]=*(const __attribute__((address_space(3))) bf16x8*)(kp);      kf[1]=*(const __attribute__((address_space(3))) bf16x8*)(kp+512);
  kf[2]=*(const __attribute__((address_space(3))) bf16x8*)(kp+2048); kf[3]=*(const __attribute__((address_space(3))) bf16x8*)(kp+2560);
  kf[4]=*(const __attribute__((address_space(3))) bf16x8*)(kp+4096); kf[5]=*(const __attribute__((address_space(3))) bf16x8*)(kp+4608);
  kf[6]=*(const __attribute__((address_space(3))) bf16x8*)(kp+6144); kf[7]=*(const __attribute__((address_space(3))) bf16x8*)(kp+6656);
}
__device__ __forceinline__ void kload2(bf16x8*kf,lds_cptr kp,int j){ kf[2*j]=*(const __attribute__((address_space(3))) bf16x8*)(kp+j*2048); kf[2*j+1]=*(const __attribute__((address_space(3))) bf16x8*)(kp+j*2048+512); }
__device__ __forceinline__ s16x4 vtr(lds_cptr p){ return __builtin_bit_cast(s16x4,__builtin_amdgcn_ds_read_tr16_b64_v4i16((__attribute__((address_space(3))) v4i16_t*)p)); }
__device__ __forceinline__ float rowmax(const f32x16&p0,const f32x16&p1){
  float a=max3f(p0[0],p0[1],p1[0]),b=max3f(p0[2],p0[3],p1[1]);a=max3f(a,p1[2],p1[3]);
  #pragma unroll
  for(int r=4;r<16;r+=4){a=max3f(a,p0[r],p0[r+1]);b=max3f(b,p0[r+2],p0[r+3]);a=max3f(a,p1[r],p1[r+1]);b=max3f(b,p1[r+2],p1[r+3]);}
  const float m=max2f(a,b);
  auto rr=__builtin_amdgcn_permlane32_swap(__float_as_uint(m),__float_as_uint(m),false,false);
  return max2f(__uint_as_float(rr[0]),__uint_as_float(rr[1]));
}
__device__ __forceinline__ void pv(f32x16*o,int vb,bf16x8 pa0,bf16x8 pa1,bf16x8 pa2,bf16x8 pa3){
  #pragma unroll
  for(int d0=0;d0<2;++d0){s16x4 lo[4],hi[4];
    #pragma unroll
    for(int ks=0;ks<4;++ks){
      asm volatile("ds_read_b64_tr_b16 %0,%1 offset:%c2":"=&v"(lo[ks]):"v"(vb),"i"(d0*4096+ks*1024):"memory");
      asm volatile("ds_read_b64_tr_b16 %0,%1 offset:%c2":"=&v"(hi[ks]):"v"(vb),"i"(d0*4096+ks*1024+512):"memory");}
    asm volatile("s_waitcnt lgkmcnt(0)":::"memory");SBAR();
    #define PK(k) (bf16x8){lo[k][0],lo[k][1],lo[k][2],lo[k][3],hi[k][0],hi[k][1],hi[k][2],hi[k][3]}
    o[d0]=__builtin_amdgcn_mfma_f32_32x32x16_bf16(pa0,PK(0),o[d0],0,0,0);
    o[d0]=__builtin_amdgcn_mfma_f32_32x32x16_bf16(pa1,PK(1),o[d0],0,0,0);
    o[d0]=__builtin_amdgcn_mfma_f32_32x32x16_bf16(pa2,PK(2),o[d0],0,0,0);
    o[d0]=__builtin_amdgcn_mfma_f32_32x32x16_bf16(pa3,PK(3),o[d0],0,0,0);
    #undef PK
  }
}

#ifndef ATTN_STORE16
#define ATTN_STORE16(p,v) (*(u32x4*)(p)=(v))
#endif
template<int MODE,int THRL> __device__ __forceinline__ void attn_unit(const bf16*Qu,const bf16*__restrict__ Kh,const bf16*__restrict__ Vh,bf16*Ou,const int NT,const int lat0,const int q0s,const float sinkl2,const float*qg,const float*ropec,const bool rope,char*shm){
  int tid_=threadIdx.x; asm volatile("":"+v"(tid_));
  const int tid=tid_,lane=tid&63,r32=lane&31,hi=lane>>5; const int wid=__builtin_amdgcn_readfirstlane(tid>>6);
  const bf16*Qw=Qu+(long)(wid*QBLK)*QP;
  const unsigned lds0=(unsigned)(uintptr_t)shm;
  float*wsf=(float*)(shm+LDS_WS)+wid*64;
  const bf16*ksrc=Kh+(long)lane*KP+wid*8;
  const bf16*vsrc=Vh+(long)(16*(wid&3)+(lane>>2))*KP+(wid>>2)*32+(lane&3)*8;
  const unsigned kdst=lds0+LDS_K+wid*1024, vdst=lds0+LDS_V+wid*1024;
  #define TROW(t) ((MODE==0||(t)<4)?(t)*KVBLK:lat0+((t)-4)*KVBLK)
  #define DMA_K(t,slot) glds16(ksrc+(long)TROW(t)*KP,(unsigned)__builtin_amdgcn_readfirstlane(kdst+(slot)))
  #define DMA_V(t,slot) glds16(vsrc+(long)TROW(t)*KP,(unsigned)__builtin_amdgcn_readfirstlane(vdst+(slot)))
  const int vb0=(int)(lds0+LDS_V)+((lane>>4)&1)*32+(lane&3)*8+(4*hi+((lane&15)>>2))*64;
  const char*Kbase=shm+LDS_K; bf16x8 kf[8];
  const lds_cptr shm3=(lds_cptr)shm; const lds_cptr kp0=shm3+LDS_K+hi*1024+r32*16; const lds_cptr vp0=shm3+LDS_V+((lane>>4)&1)*32+(lane&3)*8+(4*hi+((lane&15)>>2))*64;
  DMA_K(0,0);DMA_V(0,0);DMA_K(1,SLOTB);
  bf16x8 qr[4];
  const int qpos=q0s+wid*QBLK+r32;
  {
    u32x4 qraw[4];
    #pragma unroll
    for(int d0=0;d0<4;++d0) qraw[d0]=*reinterpret_cast<const u32x4*>(&Qw[(long)r32*QP+d0*16+hi*8]);
    float x[4][8]; float ss=0.f;
    #pragma unroll
    for(int d0=0;d0<4;++d0){ x[d0][0]=bflo(qraw[d0].x);x[d0][1]=bfhi(qraw[d0].x);x[d0][2]=bflo(qraw[d0].y);x[d0][3]=bfhi(qraw[d0].y);x[d0][4]=bflo(qraw[d0].z);x[d0][5]=bfhi(qraw[d0].z);x[d0][6]=bflo(qraw[d0].w);x[d0][7]=bfhi(qraw[d0].w);
      #pragma unroll
      for(int j=0;j<8;++j)ss+=x[d0][j]*x[d0][j]; }
    {auto rr=__builtin_amdgcn_permlane32_swap(__float_as_uint(ss),__float_as_uint(ss),false,false);ss=__uint_as_float(rr[0])+__uint_as_float(rr[1]);}
    const float rms=C2/sqrtf(ss*(1.f/64.f)+EPS);
    SBAR();
    #pragma unroll
    for(int d0=0;d0<2;++d0){
      #pragma unroll
      for(int hf=0;hf<2;++hf){
        const f32x4 ga=*reinterpret_cast<const f32x4*>(qg+d0*16+hi*8+4*hf), gb=*reinterpret_cast<const f32x4*>(qg+(d0+2)*16+hi*8+4*hf);
        f32x4 cc=f32x4{1.f,1.f,1.f,1.f}, sn=f32x4{0.f,0.f,0.f,0.f};
        if(rope){ const float*pc=ropec+(long)qpos*32+d0*16+hi*8+4*hf; cc=*reinterpret_cast<const f32x4*>(pc); sn=*reinterpret_cast<const f32x4*>(pc+SEQ*32); }
        #pragma unroll
        for(int j=0;j<4;++j){ const float a=x[d0][4*hf+j]*rms*ga[j], b=x[d0+2][4*hf+j]*rms*gb[j]; x[d0][4*hf+j]=a*cc[j]-b*sn[j]; x[d0+2][4*hf+j]=b*cc[j]+a*sn[j]; }
        SBAR(); } }
    #pragma unroll
    for(int d0=0;d0<4;++d0){ u32x4 w; w.x=cvtpk_s(x[d0][0],x[d0][1]);w.y=cvtpk_s(x[d0][2],x[d0][3]);w.z=cvtpk_s(x[d0][4],x[d0][5]);w.w=cvtpk_s(x[d0][6],x[d0][7]); qr[d0]=__builtin_bit_cast(bf16x8,w); } }
  float mhat=0.f,l_reg=0.f;f32x16 o[2],negm; { float z_=0.f; asm volatile("":"+v"(z_));
    #pragma unroll
    for(int r=0;r<16;++r){o[0][r]=z_;o[1][r]=z_;negm[r]=z_;} } asm volatile("":"+v"(negm));
  #define CMASK(P0,P1,t) do{ if(MODE==1&&(t)>=4) wmask(P0,P1,(lat0-256)+((t)-4)*KVBLK-qpos,hi); }while(0)
  bool resc=false;
  #define START(P0,P1) do{ const float rm=rowmax(P0,P1); resc=false; \
    { const float dl=rm; mhat=fadd_s(mhat,dl); \
      _Pragma("unroll") for(int r=0;r<16;++r){P0[r]=fsub_s(P0[r],dl);P1[r]=fsub_s(P1[r],dl);} \
      _Pragma("unroll") for(int r=0;r<16;++r)negm[r]=-mhat; asm volatile("":"+v"(negm)); } \
    _Pragma("unroll") for(int r=0;r<16;++r)P0[r]=__builtin_amdgcn_exp2f(P0[r]); }while(0)
  #define RESC() do{ if(resc){ asm volatile("s_waitcnt lgkmcnt(0)":::"memory"); \
      _Pragma("unroll") for(int d_=0;d_<2;++d_) _Pragma("unroll") for(int r=0;r<16;++r)o[d_][r]*=wsf[crow(r,hi)]; } }while(0)
  f32x16 pA0,pA1,pB0,pB1;
  int sl_prev=0,sl_cur=0,sl_next=SLOTB;
  #define ROT() do{sl_prev=sl_cur;sl_cur=sl_next;sl_next=(sl_next==(NSLOT-1)*SLOTB)?0:sl_next+SLOTB;}while(0)
  DMA_K(2,2*SLOTB);
  WAIT_BAR(3);
  qkt(pA0,pA1,Kbase,qr,negm,r32,hi);asm volatile("s_nop 15\n\ts_nop 7":"+v"(pA0),"+v"(pA1));CMASK(pA0,pA1,0);
  START(pA0,pA1);
  _Pragma("unroll") for(int r=0;r<16;++r)pA1[r]=__builtin_amdgcn_exp2f(pA1[r]);
  WAIT_BAR(0);
  DMA_K(3,0);DMA_V(1,SLOTB);
  ROT();
  kload8(kf,kp0+sl_cur);
  WAIT_BAR(2);
  s16x4 vlo[8],vhi[8]; u32x4 pw0,pw1,pw2,pw3;
  #define PKW(P,B) cvtpk_s(P[B],P[B+1])
  #define PAF(k) __builtin_bit_cast(bf16x8,pw##k)
  #define VFR(i) (bf16x8){vlo[i][0],vlo[i][1],vlo[i][2],vlo[i][3],vhi[i][0],vhi[i][1],vhi[i][2],vhi[i][3]}
  #define PIN(x) asm volatile("":"+v"(x))
  #define MX3(a,b,c) __builtin_fmaxf(__builtin_fmaxf((a),(b)),(c))
  #define GAPA(MF,A0,A1,A2,A3,W0,W1,PW) do{ MF; sacc+=A0; sacc+=A1; sacc+=A2; sacc+=A3; PIN(sacc); W0; W1; PIN(PW); SBAR(); }while(0)
  #define EX(v) __builtin_amdgcn_exp2f(v)
  #define GAPB(MF,X,B) do{ MF; X[B]=EX(X[B]); X[B+1]=EX(X[B+1]); X[B+2]=EX(X[B+2]); X[B+3]=EX(X[B+3]); PIN(X); SBAR(); }while(0)
  #define VRD(i) do{ vlo[i]=vtr(vp_+(((i)>>2)*4096+((i)&3)*1024)); vhi[i]=vtr(vp_+(((i)>>2)*4096+((i)&3)*1024+512)); }while(0)
  #define KRD(G,j) do{ if(G){ kload2(kf,kp0+sl_next,j); SBAR(); } }while(0)
  #define STEP(C0,C1,P0,P1,t,GK,GV,GL) do{ SBAR(); \
    const lds_cptr vp_=vp0+sl_prev; \
    VRD(0); SBAR(); float sacc=(P0[0]+P0[1]); \
    GAPA(C0=__builtin_amdgcn_mfma_f32_32x32x16_bf16(kf[0],qr[0],negm,0,0,0), P0[2],P0[3],P0[4],P0[5],     pw0[0]=PKW(P0,0), pw0[1]=PKW(P0,2), pw0); \
    VRD(4); SBAR(); GAPA(C1=__builtin_amdgcn_mfma_f32_32x32x16_bf16(kf[1],qr[0],negm,0,0,0), P0[6],P0[7],P0[8],P0[9],     pw0[2]=PKW(P0,4), pw0[3]=PKW(P0,6), pw0); \
    VRD(1); SBAR(); GAPA(C0=__builtin_amdgcn_mfma_f32_32x32x16_bf16(kf[2],qr[1],C0,0,0,0),   P0[10],P0[11],P0[12],P0[13], pw1[0]=PKW(P0,8), pw1[1]=PKW(P0,10), pw1); \
    VRD(5); SBAR(); GAPA(C1=__builtin_amdgcn_mfma_f32_32x32x16_bf16(kf[3],qr[1],C1,0,0,0),   P0[14],P0[15],P1[0],P1[1],   pw1[2]=PKW(P0,12),pw1[3]=PKW(P0,14), pw1); \
    VRD(2); SBAR(); GAPA(C0=__builtin_amdgcn_mfma_f32_32x32x16_bf16(kf[4],qr[2],C0,0,0,0),   P1[2],P1[3],P1[4],P1[5],     pw2[0]=PKW(P1,0), pw2[1]=PKW(P1,2), pw2); \
    VRD(6); SBAR(); GAPA(C1=__builtin_amdgcn_mfma_f32_32x32x16_bf16(kf[5],qr[2],C1,0,0,0),   P1[6],P1[7],P1[8],P1[9],     pw2[2]=PKW(P1,4), pw2[3]=PKW(P1,6), pw2); \
    VRD(3); SBAR(); GAPA(C0=__builtin_amdgcn_mfma_f32_32x32x16_bf16(kf[6],qr[3],C0,0,0,0),   P1[10],P1[11],P1[12],P1[13], pw3[0]=PKW(P1,8), pw3[1]=PKW(P1,10), pw3); \
    VRD(7); SBAR(); GAPA(C1=__builtin_amdgcn_mfma_f32_32x32x16_bf16(kf[7],qr[3],C1,0,0,0),   P1[14],P1[15],0.f,0.f,       pw3[2]=PKW(P1,12),pw3[3]=PKW(P1,14), pw3); \
    l_reg+=sacc; \
    if(GK){DMA_K((t)+3,sl_cur);} if(GV){DMA_V((t)+1,sl_next);} \
    CMASK(C0,C1,t); \
    { float a=MX3(C0[0],C0[1],C1[0]),b=MX3(C0[2],C0[3],C1[1]); a=MX3(a,C1[2],C1[3]); \
      _Pragma("unroll") for(int r=4;r<16;r+=4){a=MX3(a,C0[r],C0[r+1]);b=MX3(b,C0[r+2],C0[r+3]);a=MX3(a,C1[r],C1[r+1]);b=MX3(b,C1[r+2],C1[r+3]);} \
      float rm=__builtin_fmaxf(a,b); { auto rr=__builtin_amdgcn_permlane32_swap(__float_as_uint(rm),__float_as_uint(rm),false,false); rm=__builtin_fmaxf(__uint_as_float(rr[0]),__uint_as_float(rr[1])); } \
      resc=false; \
      if(__builtin_expect(__any(rm>(float)THRL),0)){ const float dl=__builtin_fmaxf(rm,0.f); mhat+=dl; \
        _Pragma("unroll") for(int r=0;r<16;++r){C0[r]-=dl;C1[r]-=dl;} \
        _Pragma("unroll") for(int r=0;r<16;++r)negm[r]=-mhat; asm volatile("":"+v"(negm)); \
        const float f=__builtin_amdgcn_exp2f(-dl); l_reg*=f; if(hi==0)wsf[r32]=f; resc=true; } } \
    SBAR(); \
    GAPB(o[0]=__builtin_amdgcn_mfma_f32_32x32x16_bf16(PAF(0),VFR(0),o[0],0,0,0), C0,0); \
    GAPB(o[1]=__builtin_amdgcn_mfma_f32_32x32x16_bf16(PAF(0),VFR(4),o[1],0,0,0), C0,4); \
    KRD(GL,0); GAPB(o[0]=__builtin_amdgcn_mfma_f32_32x32x16_bf16(PAF(1),VFR(1),o[0],0,0,0), C0,8); \
    KRD(GL,1); GAPB(o[1]=__builtin_amdgcn_mfma_f32_32x32x16_bf16(PAF(1),VFR(5),o[1],0,0,0), C0,12); \
    KRD(GL,2); GAPB(o[0]=__builtin_amdgcn_mfma_f32_32x32x16_bf16(PAF(2),VFR(2),o[0],0,0,0), C1,0); \
    KRD(GL,3); GAPB(o[1]=__builtin_amdgcn_mfma_f32_32x32x16_bf16(PAF(2),VFR(6),o[1],0,0,0), C1,4); \
    GAPB(o[0]=__builtin_amdgcn_mfma_f32_32x32x16_bf16(PAF(3),VFR(3),o[0],0,0,0), C1,8); \
    GAPB(o[1]=__builtin_amdgcn_mfma_f32_32x32x16_bf16(PAF(3),VFR(7),o[1],0,0,0), C1,12); \
    }while(0)
  int t=1;
  for(;t+5<NT;t+=2){
    STEP(pB0,pB1,pA0,pA1,t,true,true,true);     WAIT_BAR(2); RESC(); ROT();
    STEP(pA0,pA1,pB0,pB1,t+1,true,true,true);   WAIT_BAR(2); RESC(); ROT();
  }
  #define ENDW(tt) do{ if((tt)+3<NT){WAIT_BAR(2);} else if((tt)+2<NT){WAIT_BAR(1);} else {WAIT_BAR(0);} }while(0)
  for(;t+1<NT;t+=2){
    STEP(pB0,pB1,pA0,pA1,t,(t+3<NT),(t+1<NT),(t+1<NT));       ENDW(t);   RESC(); ROT();
    STEP(pA0,pA1,pB0,pB1,t+1,(t+4<NT),(t+2<NT),(t+2<NT));     ENDW(t+1); RESC(); ROT();
  }
  STEP(pB0,pB1,pA0,pA1,NT-1,false,false,false); RESC();
  { float sacc=pB0[0]+pB0[1]; _Pragma("unroll") for(int r=2;r<16;++r)sacc+=pB0[r]; _Pragma("unroll") for(int r=0;r<16;++r)sacc+=pB1[r]; l_reg+=sacc;
    pw0=(u32x4){PKW(pB0,0),PKW(pB0,2),PKW(pB0,4),PKW(pB0,6)};pw1=(u32x4){PKW(pB0,8),PKW(pB0,10),PKW(pB0,12),PKW(pB0,14)};pw2=(u32x4){PKW(pB1,0),PKW(pB1,2),PKW(pB1,4),PKW(pB1,6)};pw3=(u32x4){PKW(pB1,8),PKW(pB1,10),PKW(pB1,12),PKW(pB1,14)};
    SBAR(); pv(o,vb0+sl_cur,PAF(0),PAF(1),PAF(2),PAF(3)); }
  #undef PKW
  #undef PAF
  #undef VFR
  #undef PIN
  #undef MX3
  #undef GAPA
  #undef GAPB
  #undef EX
  #undef VRD
  #undef KRD
  #undef STEP
  #undef ENDW
  {auto rr=__builtin_amdgcn_permlane32_swap(__float_as_uint(l_reg),__float_as_uint(l_reg),false,false);l_reg=__uint_as_float(rr[0])+__uint_as_float(rr[1]);}
  if(MODE==1)l_reg+=__builtin_amdgcn_exp2f(sinkl2-mhat);
  if(hi==0)wsf[32+r32]=l_reg;asm volatile("s_waitcnt lgkmcnt(0)":::"memory");
  float rli[16];
  #pragma unroll
  for(int r=0;r<16;++r)rli[r]=__builtin_amdgcn_rcpf(wsf[32+crow(r,hi)]);
  bf16*Ow=Ou+(long)(wid*QBLK)*OP;
  { bf16*stg=(bf16*)(shm+LDS_OST)+wid*2048;
    #pragma unroll
    for(int r=0;r<16;++r){const int orow=crow(r,hi);
      #pragma unroll
      for(int d0=0;d0<2;++d0)stg[orow*64+d0*32+r32]=__float2bfloat16(o[d0][r]*rli[r]);}
    asm volatile("s_waitcnt lgkmcnt(0)":::"memory");
    #pragma unroll
    for(int i=0;i<4;++i){const int row=i*8+(lane>>3),ch=lane&7; const u32x4 v=*(const u32x4*)(stg+row*64+ch*8); ATTN_STORE16(Ow+(long)row*OP+ch*8,v);} }
  asm volatile("s_waitcnt lgkmcnt(0)\n\ts_barrier":::"memory");
  #undef DMA_K
  #undef TROW
  #undef DMA_V
  #undef CMASK
  #undef START
  #undef RESC
  #undef ROT
}
#undef SBAR
#undef WAIT_BAR
}

template <int LAYER> __device__ __forceinline__ void attn_fast(const Frame& F, char* shm) {
    using attn_body::bf16;
    const bf16* Q = (const bf16*)(F.ws + WS_Q); const bf16* Kn = (const bf16*)(F.ws + WS_KN); const bf16* Vn = (const bf16*)(F.ws + WS_VN); bf16* AO = (bf16*)(F.ws + WS_AO);
    const int nunits = LAYER == 0 ? 1024 + 64 : 1024;
    for (int U = F.vcu; U < nunits; U += F.G) {
        int b, h, NT, lat0 = 0, q0 = 0; size_t row0;
        if (U < 1024) { b = U >> 7; h = ((U >> 6) & 1) * 4 + ((U >> 4) & 3); q0 = (U & 15) * 256; row0 = (size_t)b * SEQ + q0;
            if (LAYER == 0) NT = KVS / 64;
            else { int lo = q0 - 128, hi = q0 + 384; lo = lo < 0 ? 0 : lo; hi = hi > SEQ ? SEQ : hi; NT = 4 + (hi - lo) / 64; lat0 = CTXL + lo; } }
        else { const int uc = U - 1024; b = uc >> 3; h = uc & 7; row0 = (size_t)TX + (size_t)b * CTXL; NT = 4; }
        const bf16* Kh = Kn + (size_t)b * KVS * 128 + (h >> 2) * 64; const bf16* Vh = Vn + (size_t)b * KVS * 128 + (h >> 2) * 64;
        const float sinkl2 = LAYER == 1 ? F.in[I_SINK][h] * LOG2E : 0.f;
        attn_body::attn_unit<LAYER, 8>(Q + row0 * 512 + h * 64, Kh, Vh, AO + row0 * 1024 + h * 64, NT, lat0, q0, sinkl2, F.in[LAYER == 0 ? I_QNA : I_QNC], (const float*)(F.ws + WS_ROPE), U < 1024, shm);
        if (LAYER == 0 && U < 1024) {
            const int per = (TN_ITEMS - TN_DENSE + 1023) / 1024, lo = TN_DENSE + U * per; int hi = lo + per; hi = hi > TN_ITEMS ? TN_ITEMS : hi;
            Frame Fc = F; asm volatile("" : "+v"(Fc.lane), "+v"(Fc.tid));
            transpose_range(Fc, lo, hi, Fc.wave, NWAVES);
            __syncthreads(); }
    }
}

template <int DRY> __device__ __forceinline__ void p_router(const Frame& F, int l, int ntok) {
    const int gw = F.vcu * NWAVES + F.wave, NGW = F.G * NWAVES, lane = F.lane, tk = lane & 15, kq = lane >> 4;
    bf16_t* HX = F.hx(); const float* SS = (const float*)(F.ws + WS_SS);
    const float* gb = F.in[I_RGB] + l * 4; const float* eb = F.in[I_REB] + l * 32;
    unsigned* tokslot = (unsigned*)(F.ws + (DRY ? WS_HID : WS_TOK)); float* tokw = (float*)(F.ws + (DRY ? WS_HID : WS_TOK) + 512 * 1024); unsigned* list = (unsigned*)(F.ws + (DRY ? WS_HID + 2 * MiB : WS_LIST));
    unsigned* cnt = F.cnt(DRY ? l + 2 : l);
    {
        const u32x4* src = (const u32x4*)((const bf16_t*)(F.ws + WS_WR) + (size_t)l * 2 * 36864);
        u32x4 t[18];
#pragma unroll
        for (int i = 0; i < 18; ++i) t[i] = src[F.tid + i * NTHREADS];
        __syncthreads();
#pragma unroll
        for (int i = 0; i < 18; ++i) *(LAS u32x4*)(F.lds + (F.tid + i * NTHREADS) * 16) = t[i];
    }
    const LAS unsigned char* wl0 = F.lds + lane * 16;
    const LAS unsigned char* wl2 = F.lds + 2048 + ((tk >> 2) * 4 + kq) * 16;
    LAS unsigned* lcnt = (LAS unsigned*)(F.lds + LDS_TAB + 2048 + 8192); LAS unsigned* lbase = lcnt + 32;
    LAS float* gps = (LAS float*)(F.lds + LDS_TAB + 2048);
    const int nrounds = (ntok / 16 + NGW - 1) / NGW;
    for (int rd = 0; rd < nrounds; ++rd) {
        const int grp0 = F.vcu * NWAVES + rd * NGW, grp = grp0 + F.wave;
        __syncthreads();
        if (F.tid < 32) lcnt[F.tid] = 0u;
        if (grp0 < ntok / 16) { const int r0 = modrow(grp0 * 16); const float* gpg = (const float*)(F.ws + WS_GP) + (size_t)(l * 9 + r0) * 1024; const float* shg = F.mod(l, r0, 3);
            *(LAS f32x4*)(gps + 4 * F.tid) = F.tid < 256 ? *(const f32x4*)(gpg + 4 * F.tid) : *(const f32x4*)(shg + 4 * (F.tid - 256)); }
        __syncthreads();
        const bool active = grp < ntok / 16;
        const int row = (active ? grp : 0) * 16 + tk;
        bool win = false; int e1 = 0, e2 = 0; float w1 = 0.f, w2 = 0.f; unsigned p1 = 0u, p2 = 0u;
        if (active) {
        const bf16_t* xr = F.xr_row(row) + 8 * kq;
        u32x4 xq[16];
#define R_XLOAD(i, st) do { const int s_ = (st) < 32 ? (st) : 31; if (DRY != 5) xq[i] = *(const u32x4*)(xr + s_ * 32); else xq[i] = (u32x4){(unsigned)s_, 1u, 2u, 3u}; } while (0)
#pragma unroll
        for (int i = 0; i < 16; ++i) R_XLOAD(i, i);
        float ssum = 0.f;
#pragma unroll
        for (int i = 0; i < 4; ++i) { const f32x4 p = *(const f32x4*)(SS + (size_t)row * 16 + 4 * i); ssum += (p[0] + p[1]) + (p[2] + p[3]); }
        const float rms = 1.0f / sqrtf(ssum * (1.f / 1024.f) + EPS);
        f32x4 acc[3];
#pragma unroll
        for (int n = 0; n < 3; ++n) acc[n] = (f32x4){0.f, 0.f, 0.f, 0.f};
        bf16_t* hxr = HX + (size_t)row * DM + 8 * kq;
        const LAS float* gpl = gps + 8 * kq;
#define R_STEP(i, st) do { const u32x4 xb_ = xq[i]; \
            const f32x4 m0 = *(const LAS f32x4*)(gpl + (st) * 32), m1 = *(const LAS f32x4*)(gpl + (st) * 32 + 4), m2 = *(const LAS f32x4*)(gpl + 1024 + (st) * 32), m3 = *(const LAS f32x4*)(gpl + 1024 + (st) * 32 + 4); \
            const f32x4 xf0 = (f32x4){bflo(xb_.x), bfhi(xb_.x), bflo(xb_.y), bfhi(xb_.y)}, xf1 = (f32x4){bflo(xb_.z), bfhi(xb_.z), bflo(xb_.w), bfhi(xb_.w)}; \
            const f32x4 h0 = (xf0 * rms) * m0 + m2, h1 = (xf1 * rms) * m1 + m3; \
            u32x4 hh; hh.x = pk2(h0[0], h0[1]); hh.y = pk2(h0[2], h0[3]); hh.z = pk2(h1[0], h1[1]); hh.w = pk2(h1[2], h1[3]); \
            if (DRY != 4) *(u32x4*)(hxr + (st) * 32) = hh; else if (hh.x == 0x12345678u) *(u32x4*)(hxr + (st) * 32) = hh; \
            if (DRY < 3 || DRY >= 6) { \
            u32x4 hl; hl.x = pk2(h0[0] - bflo(hh.x), h0[1] - bfhi(hh.x)); hl.y = pk2(h0[2] - bflo(hh.y), h0[3] - bfhi(hh.y)); hl.z = pk2(h1[0] - bflo(hh.z), h1[1] - bfhi(hh.z)); hl.w = pk2(h1[2] - bflo(hh.w), h1[3] - bfhi(hh.w)); \
            const bf16x8 bh = __builtin_bit_cast(bf16x8, hh), bl = __builtin_bit_cast(bf16x8, hl); \
            bf16x8 w0h, w1h, w2h, w0l, w1l, w2l; if (DRY == 6) { w0h = w1h = w2h = w0l = w1l = w2l = bh; } else { w0h = *(const LAS bf16x8*)(wl0 + (st) * 2304); w1h = *(const LAS bf16x8*)(wl0 + (st) * 2304 + 1024); w2h = *(const LAS bf16x8*)(wl2 + (st) * 2304); \
            w0l = *(const LAS bf16x8*)(wl0 + RW_BYTES + (st) * 2304); w1l = *(const LAS bf16x8*)(wl0 + RW_BYTES + (st) * 2304 + 1024); w2l = *(const LAS bf16x8*)(wl2 + RW_BYTES + (st) * 2304); } \
            if (DRY == 7) { const bf16x8 sx = w0h ^ w1h ^ w2h ^ w0l ^ w1l ^ w2l ^ bl; acc[0][0] += (float)sx[0]; } else \
            acc[0] = __builtin_amdgcn_mfma_f32_16x16x32_bf16(w0h, bh, acc[0], 0, 0, 0); acc[1] = __builtin_amdgcn_mfma_f32_16x16x32_bf16(w1h, bh, acc[1], 0, 0, 0); acc[2] = __builtin_amdgcn_mfma_f32_16x16x32_bf16(w2h, bh, acc[2], 0, 0, 0); \
            acc[0] = __builtin_amdgcn_mfma_f32_16x16x32_bf16(w0h, bl, acc[0], 0, 0, 0); acc[1] = __builtin_amdgcn_mfma_f32_16x16x32_bf16(w1h, bl, acc[1], 0, 0, 0); acc[2] = __builtin_amdgcn_mfma_f32_16x16x32_bf16(w2h, bl, acc[2], 0, 0, 0); \
            acc[0] = __builtin_amdgcn_mfma_f32_16x16x32_bf16(w0l, bh, acc[0], 0, 0, 0); acc[1] = __builtin_amdgcn_mfma_f32_16x16x32_bf16(w1l, bh, acc[1], 0, 0, 0); acc[2] = __builtin_amdgcn_mfma_f32_16x16x32_bf16(w2l, bh, acc[2], 0, 0, 0); } } while (0)
        for (int st = 0; st < 32; st += 16) {
#pragma unroll
            for (int i = 0; i < 16; ++i) { R_STEP(i, st + i); R_XLOAD(i, st + i + 16); }
        }
#undef R_XLOAD
#undef R_STEP
        if (DRY >= 6 && acc[0][0] + acc[1][1] + acc[2][2] == 123.456f) tokw[row] = 1.f;
        if (DRY < 2) {
            const float lgk = acc[2][0] + gb[kq];
            const float la = __shfl_xor(lgk, 16), lb = __shfl_xor(lgk, 32), lc = __shfl_xor(la, 32);
            const float gm = fmaxf(fmaxf(lgk, la), fmaxf(lb, lc));
            win = (lgk == gm);
            win = win && !(la == gm && (kq ^ 1) < kq) && !(lb == gm && (kq ^ 2) < kq) && !(lc == gm && (kq ^ 3) < kq);
            if (win) {
                const float g_w = 1.f / (expf(lgk - gm) + expf(la - gm) + expf(lb - gm) + expf(lc - gm));
                float el[8];
                { const f32x4 b0 = *(const f32x4*)(eb + 8 * kq), b1 = *(const f32x4*)(eb + 8 * kq + 4);
#pragma unroll
                  for (int i = 0; i < 4; ++i) { el[i] = acc[0][i] + b0[i]; el[4 + i] = acc[1][i] + b1[i]; } }
                int i1 = 0; float m1 = el[0];
#pragma unroll
                for (int i = 1; i < 8; ++i) if (el[i] > m1) { m1 = el[i]; i1 = i; }
                int i2 = 0; float m2 = -3.0e38f;
#pragma unroll
                for (int i = 0; i < 8; ++i) if (i != i1 && el[i] > m2) { m2 = el[i]; i2 = i; }
                const float pp = expf(m2 - m1); w1 = g_w / (1.f + pp); w2 = g_w * pp / (1.f + pp);
                e1 = kq * 8 + i1; e2 = kq * 8 + i2;
                p1 = __hip_atomic_fetch_add(lcnt + e1, 1u, __ATOMIC_RELAXED, __HIP_MEMORY_SCOPE_WORKGROUP); p2 = __hip_atomic_fetch_add(lcnt + e2, 1u, __ATOMIC_RELAXED, __HIP_MEMORY_SCOPE_WORKGROUP);
            }
        }
        }
        __syncthreads();
        if (DRY < 2 && F.tid < 32) { const unsigned n = lcnt[F.tid]; lbase[F.tid] = n ? atomicAdd(cnt + F.tid * 64, n) : 0u; }
        __syncthreads();
        if (win) { const unsigned pos1 = lbase[e1] + p1, pos2 = lbase[e2] + p2;
            list[(size_t)e1 * TT + pos1] = (unsigned)row; list[(size_t)e2 * TT + pos2] = (unsigned)row;
            tokslot[2 * row] = ((unsigned)e1 << 16) | pos1; tokslot[2 * row + 1] = ((unsigned)e2 << 16) | pos2; tokw[2 * row] = w1; tokw[2 * row + 1] = w2; }
    }
    __syncthreads();
}
struct CombBuf { u32x2 x[4], ya[4], yb[4]; };
__device__ __forceinline__ void comb_load(CombBuf& b, const bf16_t* xr, const bf16_t* ya, const bf16_t* yb, int lane) {
#pragma unroll
    for (int j = 0; j < 4; ++j) { const int c = 4 * lane + 256 * j; b.x[j] = *(const u32x2*)(xr + c); b.ya[j] = *(const u32x2*)(ya + c); b.yb[j] = *(const u32x2*)(yb + c); }
}
template <bool LAST, bool DRY> __device__ __forceinline__ void comb_finish(const Frame& F, const CombBuf& b, int l, int row, float wa, float wb, int lane) {
    const int r = modrow(row); const float* g2 = F.mod(l, r, 5); bf16_t* xr = F.xr_row(row);
    float ss = 0.f; f32x4 v[4];
#pragma unroll
    for (int j = 0; j < 4; ++j) { const int c = 4 * lane + 256 * j; const f32x4 gv = *(const f32x4*)(g2 + c);
        f32x4 y; y[0] = wa * bflo(b.ya[j].x) + wb * bflo(b.yb[j].x); y[1] = wa * bfhi(b.ya[j].x) + wb * bfhi(b.yb[j].x); y[2] = wa * bflo(b.ya[j].y) + wb * bflo(b.yb[j].y); y[3] = wa * bfhi(b.ya[j].y) + wb * bfhi(b.yb[j].y);
        const f32x4 x1 = (f32x4){bflo(b.x[j].x), bfhi(b.x[j].x), bflo(b.x[j].y), bfhi(b.x[j].y)};
        v[j] = x1 + gv * y;
        if (LAST) { if (!DRY) *(f32x4*)(F.out + (size_t)row * DM + c) = v[j]; }
        else { u32x2 o; o.x = pk2(v[j][0], v[j][1]); o.y = pk2(v[j][2], v[j][3]); *(u32x2*)(xr + c) = DRY ? b.x[j] : o; }
        ss += (v[j][0] * v[j][0] + v[j][1] * v[j][1]) + (v[j][2] * v[j][2] + v[j][3] * v[j][3]); }
    if (!LAST) { const float rms = 1.0f / sqrtf(wave_sum(ss) * (1.f / 1024.f) + EPS); const float* g = F.in[I_LN1] + (l + 1) * 1024; const float* sh = F.mod(l + 1, r, 0); const float* sc = F.mod(l + 1, r, 1); f32x4 h[4];
#pragma unroll
        for (int j = 0; j < 4; ++j) { const int c = 4 * lane + 256 * j; h[j] = (v[j] * rms * *(const f32x4*)(g + c)) * (1.f + *(const f32x4*)(sc + c)) + *(const f32x4*)(sh + c); }
        store_row_bf16(F.hx() + (size_t)row * DM, lane, h); }
}
template <bool LAST, bool DRY> __device__ __forceinline__ void p_combine(const Frame& F, int l, int ntok, const MoeTab& tb) {
    const int gw = F.vcu * NWAVES + F.wave, NGW = F.G * NWAVES, lane = F.lane;
    const bf16_t* YB = (const bf16_t*)(F.ws + WS_YB);
    const unsigned* tokslot = (const unsigned*)(F.ws + WS_TOK); const float* tokw = (const float*)(F.ws + WS_TOK + 512 * 1024);
    const int ntot = gw < ntok ? (ntok - gw + NGW - 1) / NGW : 0;
    for (int base = 0; base < ntot; base += 64) {
    const int n = ntot - base < 64 ? ntot - base : 64;
    unsigned my_sa = 0u, my_sb = 0u; float my_wa = 0.f, my_wb = 0.f;
    { const int mr = gw + (base + lane) * NGW;
      if (lane < n) { const unsigned sa = tokslot[2 * mr], sb = tokslot[2 * mr + 1]; my_wa = tokw[2 * mr]; my_wb = tokw[2 * mr + 1];
          my_sa = (unsigned)tb.tile0[sa >> 16] * 256u + (sa & 0xffffu); my_sb = (unsigned)tb.tile0[sb >> 16] * 256u + (sb & 0xffffu); } }
    CombBuf A, B;
#define COMB_LOAD(buf, i) do { const int row_ = gw + (base + (i)) * NGW; const unsigned sa_ = __builtin_amdgcn_readlane(my_sa, (i)), sb_ = __builtin_amdgcn_readlane(my_sb, (i)); \
        comb_load(buf, F.xr_row(row_), YB + (size_t)sa_ * 1024, YB + (size_t)sb_ * 1024, lane); } while (0)
#define COMB_FIN(buf, i) do { const float wa_ = __uint_as_float(__builtin_amdgcn_readlane(__float_as_uint(my_wa), (i))), wb_ = __uint_as_float(__builtin_amdgcn_readlane(__float_as_uint(my_wb), (i))); \
        comb_finish<LAST, DRY>(F, buf, l, gw + (base + (i)) * NGW, wa_, wb_, lane); } while (0)
    COMB_LOAD(A, 0);
    for (int i = 0; i < n; i += 2) {
        if (i + 1 < n) COMB_LOAD(B, i + 1);
        COMB_FIN(A, i);
        if (i + 2 < n) COMB_LOAD(A, i + 2);
        if (i + 1 < n) COMB_FIN(B, i + 1);
    }
    }
#undef COMB_LOAD
#undef COMB_FIN
}

__global__ void __launch_bounds__(NTHREADS, 2) fwd_kernel(Params P) {
    extern __shared__ __attribute__((aligned(16))) unsigned char lds_raw[];
    Frame F;
    F.lds = (LAS unsigned char*)lds_raw; F.in = P.in; F.out = P.out; F.ws = P.ws;
    F.tid = threadIdx.x; F.lane = F.tid & 63; F.wave = __builtin_amdgcn_readfirstlane(F.tid >> 6);
    F.G = gridDim.x; { const int bx = blockIdx.x; F.vcu = (F.G % 8 == 0) ? (bx % 8) * (F.G / 8) + bx / 8 : bx; }
    volatile LAS unsigned* misc = (volatile LAS unsigned*)(F.lds + LDS_MISC);
    if (F.tid < 16) misc[F.tid] = 0u;
    __syncthreads();
#if ONE_LAUNCH
    XcdBarrier bar = xcd_barrier_post((unsigned*)(F.ws + WS_CTL) + CW_BAR, misc + 8);
#define GRID_BAR() do { xcd_barrier(bar); } while (0)
#else
#define GRID_BAR() do { } while (0)
#endif
    const int lo = P.ph_lo, hi = P.ph_hi;
#ifndef DRYMASK
#define DRYMASK 0x4000
#endif
#ifndef DRYV
#define DRYV 7
#endif
#ifndef PHMASK
#define PHMASK 0xFFFFFFFFu
#endif
#define IN(k) (((PHMASK >> (k)) & 1u) && lo <= (k) && (k) < hi)
#ifdef PROBE_PH
#define STAMP(k) do { if (blockIdx.x == 0 && F.tid == 0) { const unsigned long long t_ = __builtin_amdgcn_s_memrealtime(); \
        if ((k) == PROBE_PH - 1) { misc[0] = (unsigned)t_; misc[1] = (unsigned)(t_ >> 32); } if ((k) == PROBE_PH) { misc[2] = (unsigned)t_; misc[3] = (unsigned)(t_ >> 32); } } } while (0)
#else
#define STAMP(k) do { } while (0)
#endif
#define SEAM(k) do { if (IN((k) + 1)) GRID_BAR(); STAMP(k); } while (0)
    STAMP(-1);
    bf16_t* HX = F.hx(); bf16_t* Qb = (bf16_t*)(F.ws + WS_Q); bf16_t* KVb = (bf16_t*)(F.ws + WS_KV); bf16_t* Gb = (bf16_t*)(F.ws + WS_G); bf16_t* AO = (bf16_t*)(F.ws + WS_AO);
    bf16_t* HID = (bf16_t*)(F.ws + WS_HID); bf16_t* YB = (bf16_t*)(F.ws + WS_YB);

    if (IN(0)) { Frame Fp = F; asm volatile("" : "+v"(Fp.tid), "+v"(Fp.lane)); p0_prologue(Fp); SEAM(0); }
    if (IN(1)) { Frame Fp = F; asm volatile("" : "+v"(Fp.tid), "+v"(Fp.lane)); p_norm1_l0(Fp); SEAM(1); }
    if (IN(2)) { Frame Fp = F; asm volatile("" : "+v"(Fp.tid), "+v"(Fp.lane)); SchedDense S{(const bf16_t*)(Fp.ws + WS_WINAB), 1024, TT / 256, 7, 0, 0, Fp.vcu, Fp.G}; EpiInProj<true> E{Qb, KVb, (bf16_t*)(Fp.ws + WS_VN), Gb}; GEMM(Fp, HX, 1024, S, E); SEAM(2); }
    if (IN(3)) { Frame Fp = F; asm volatile("" : "+v"(Fp.tid), "+v"(Fp.lane)); p_k_post(Fp, Fp.in[I_KNA]); p_conv(Fp); SEAM(3); }
    if (IN(4)) { Frame Fp = F; asm volatile("" : "+v"(Fp.tid), "+v"(Fp.lane));
#ifdef ATTN_SIMPLE
        attn_simple<0>(Fp);
#else
        attn_fast<0>(Fp, (char*)lds_raw);
#endif
        SEAM(4); }
    if (IN(5)) { Frame Fp = F; asm volatile("" : "+v"(Fp.tid), "+v"(Fp.lane)); SchedDense S{(const bf16_t*)(Fp.ws + WS_WOUTAB), 1024, TT / 256, 4, 0, 0, Fp.vcu, Fp.G}; EpiOutProj<true> E{Fp, 0}; GEMM(Fp, AO, 1024, S, E);
        SEAM(5); }
    if (IN(6)) { Frame Fp = F; asm volatile("" : "+v"(Fp.tid), "+v"(Fp.lane));
#if (DRYMASK >> 6) & 1
        p_router<DRYV>(Fp, 0, TT); GRID_BAR();
#endif
        p_router<0>(Fp, 0, TT); SEAM(6); }
    if (IN(7)) { Frame Fp = F; asm volatile("" : "+v"(Fp.tid), "+v"(Fp.lane)); const MoeTab tb = moe_tables(Fp, 0); SchedMoe S{(const bf16_t*)(Fp.ws + WS_WGU), (size_t)1024 * 1024, 1024, tb, (const unsigned*)(Fp.ws + WS_LIST), true, Fp.vcu, Fp.G}; EpiMoe1 E{HID}; GEMM(Fp, HX, 1024, S, E); SEAM(7); }
    if (IN(8)) { Frame Fp = F; asm volatile("" : "+v"(Fp.tid), "+v"(Fp.lane)); const MoeTab tb = moe_tables(Fp, 0); SchedMoe S{(const bf16_t*)(Fp.ws + WS_WD), (size_t)1024 * 512, 512, tb, nullptr, false, Fp.vcu, Fp.G}; EpiMoe2 E{YB}; GEMM2(Fp, HID, 512, S, E); SEAM(8); }
    if (IN(9)) { Frame Fp = F; asm volatile("" : "+v"(Fp.tid), "+v"(Fp.lane)); const MoeTab tb = moe_tables(Fp, 0);
#if (DRYMASK >> 9) & 1
        p_combine<false, true>(Fp, 0, TT, tb); GRID_BAR();
#endif
        p_combine<false, false>(Fp, 0, TT, tb); SEAM(9); }
    if (IN(10)) { Frame Fp = F; asm volatile("" : "+v"(Fp.tid), "+v"(Fp.lane)); SchedDense S{(const bf16_t*)(Fp.ws + WS_WINCD), 1024, TX / 256, 5, TC / 256, 2, Fp.vcu, Fp.G}; EpiInProj<false> E{Qb, KVb, (bf16_t*)(Fp.ws + WS_VN), Gb}; GEMM(Fp, HX, 1024, S, E); SEAM(10); }
    if (IN(11)) { Frame Fp = F; asm volatile("" : "+v"(Fp.tid), "+v"(Fp.lane)); p_k_post(Fp, Fp.in[I_KNC]); p_pool(Fp); SEAM(11); }
    if (IN(12)) { Frame Fp = F; asm volatile("" : "+v"(Fp.tid), "+v"(Fp.lane));
#ifdef ATTN_SIMPLE
        attn_simple<1>(Fp);
#else
        attn_fast<1>(Fp, (char*)lds_raw);
#endif
        SEAM(12); }
    if (IN(13)) { Frame Fp = F; asm volatile("" : "+v"(Fp.tid), "+v"(Fp.lane)); SchedDense S{(const bf16_t*)(Fp.ws + WS_WOUTCD), 1024, TX / 256, 4, 0, 0, Fp.vcu, Fp.G};
#if (DRYMASK >> 13) & 1
        { EpiOutProj<false, true> Ed{Fp, 1}; GEMM(Fp, AO, 1024, S, Ed); GRID_BAR(); }
#endif
        EpiOutProj<false> E{Fp, 1}; GEMM(Fp, AO, 1024, S, E); SEAM(13); }
    if (IN(14)) { Frame Fp = F; asm volatile("" : "+v"(Fp.tid), "+v"(Fp.lane));
#if (DRYMASK >> 14) & 1
        p_router<DRYV>(Fp, 1, TX); GRID_BAR();
#endif
        p_router<0>(Fp, 1, TX); SEAM(14); }
    if (IN(15)) { Frame Fp = F; asm volatile("" : "+v"(Fp.tid), "+v"(Fp.lane)); const MoeTab tb = moe_tables(Fp, 1); SchedMoe S{(const bf16_t*)(Fp.ws + WS_WGU) + (size_t)32 * 1024 * 1024, (size_t)1024 * 1024, 1024, tb, (const unsigned*)(Fp.ws + WS_LIST), true, Fp.vcu, Fp.G}; EpiMoe1 E{HID}; GEMM(Fp, HX, 1024, S, E); SEAM(15); }
    if (IN(16)) { Frame Fp = F; asm volatile("" : "+v"(Fp.tid), "+v"(Fp.lane)); const MoeTab tb = moe_tables(Fp, 1); SchedMoe S{(const bf16_t*)(Fp.ws + WS_WD) + (size_t)32 * 1024 * 512, (size_t)1024 * 512, 512, tb, nullptr, false, Fp.vcu, Fp.G}; EpiMoe2 E{YB}; GEMM2(Fp, HID, 512, S, E); SEAM(16); }
    if (IN(17)) { Frame Fp = F; asm volatile("" : "+v"(Fp.tid), "+v"(Fp.lane)); const MoeTab tb = moe_tables(Fp, 1);
#if (DRYMASK >> 17) & 1
        p_combine<true, true>(Fp, 1, TX, tb); GRID_BAR();
#endif
        p_combine<true, false>(Fp, 1, TX, tb); }
#ifdef PROBE_PH
    STAMP(NPH - 1);
    if (blockIdx.x == 0 && F.tid == 0) { const unsigned long long t0 = ((unsigned long long)misc[1] << 32) | misc[0], t1 = ((unsigned long long)misc[3] << 32) | misc[2];
        const unsigned long long te = __builtin_amdgcn_s_memrealtime(), span = (t1 - t0) * 16ull;
        while (__builtin_amdgcn_s_memrealtime() - te < span) __builtin_amdgcn_s_sleep(32); }
#endif
#undef IN
#undef SEAM
}

extern "C" void kernel_launch(void* const* d_in, const int* in_sizes, int n_in, void* d_out, int out_size, void* d_ws, size_t ws_size, hipStream_t stream) {
    static int grid = 0;
    if (grid == 0) {
        if (n_in != 30 || out_size != TX * DM || ws_size < WS_END) { fprintf(stderr, "kernel_launch: unexpected shapes (n_in %d out %d ws %zu)\n", n_in, out_size, ws_size); grid = -1; return; }
        int dev = 0, cus = 0;
        if (hipGetDevice(&dev) != hipSuccess || hipDeviceGetAttribute(&cus, hipDeviceAttributeMultiprocessorCount, dev) != hipSuccess) { grid = -1; return; }
        if (hipFuncSetAttribute((const void*)fwd_kernel, hipFuncAttributeMaxDynamicSharedMemorySize, LDS_BYTES) != hipSuccess) { fprintf(stderr, "kernel_launch: hipFuncSetAttribute failed\n"); grid = -1; return; }
        int per_cu = 0;
        if (hipOccupancyMaxActiveBlocksPerMultiprocessor(&per_cu, (const void*)fwd_kernel, NTHREADS, LDS_BYTES) != hipSuccess || per_cu < 1) { fprintf(stderr, "kernel_launch: occupancy query says %d\n", per_cu); }
        (void)hipGetLastError();
        grid = cus;
    }
    if (grid < 0) return;
    (void)hipMemsetAsync((char*)d_ws + WS_CTL, 0, CTL_ZERO_BYTES, stream);
    Params p{};
    for (int i = 0; i < 30; ++i) p.in[i] = (const float*)d_in[i];
    p.out = (float*)d_out; p.ws = (unsigned char*)d_ws;
#if ONE_LAUNCH
    p.ph_lo = 0; p.ph_hi = NPH;
    hipLaunchKernelGGL(fwd_kernel, dim3(grid), dim3(NTHREADS), LDS_BYTES, stream, p);
#else
    for (int ph = 0; ph < NPH; ++ph) { p.ph_lo = ph; p.ph_hi = ph + 1; hipLaunchKernelGGL(fwd_kernel, dim3(grid), dim3(NTHREADS), LDS_BYTES, stream, p); }
#endif
}
```

```cpp
#include <hip/hip_runtime.h>
#include <cstdio>
#include <cstdint>

#ifndef ONE_LAUNCH
#define ONE_LAUNCH 1
#endif

#define LAS __attribute__((address_space(3)))
#define GAS __attribute__((address_space(1)))
typedef unsigned short bf16_t;
typedef short bf16x8 __attribute__((ext_vector_type(8)));
typedef float f32x4 __attribute__((ext_vector_type(4)));
typedef float f32x2 __attribute__((ext_vector_type(2)));
typedef unsigned u32x4 __attribute__((ext_vector_type(4)));
typedef unsigned u32x2 __attribute__((ext_vector_type(2)));
typedef __bf16 bf16x2_t __attribute__((ext_vector_type(2)));

constexpr int NB = 8, SEQ = 4096, DM = 1024, CTXL = 256, HD = 64;
constexpr int TX = NB * SEQ, TC = NB * CTXL, TT = TX + TC;
constexpr int KVS = CTXL + SEQ;
constexpr int NE = 32;
constexpr int NTILE_MAX = 304, NSLOT = NTILE_MAX * 256;
constexpr float EPS = 1e-6f;
constexpr float LOG2E = 1.4426950408889634f;
constexpr float C2 = 0.125f * LOG2E;
constexpr int NWAVES = 8, NTHREADS = 512;
constexpr int NPH = 18;

enum { I_X = 0, I_C, I_CTX, I_CCTX, I_MODW, I_MODB, I_LN1, I_LN2, I_WINAB, I_WOUTAB, I_QNA, I_KNA, I_CONVW, I_CONVB, I_CLNG, I_CLNB,
       I_WINCD, I_WOUTCD, I_QNC, I_KNC, I_SINK, I_POOLW, I_POOLS, I_RGW, I_RGB, I_REW, I_REB, I_EXG, I_EXU, I_EXD };

constexpr size_t MiB = 1u << 20;
constexpr size_t WS_CTL = 0, CTL_ZERO_BYTES = 1 * MiB;
constexpr size_t WS_MOD = 1 * MiB;
constexpr size_t WS_ROPE = 2 * MiB;
constexpr size_t WS_TOK = 3 * MiB;
constexpr size_t WS_LIST = 4 * MiB;
constexpr size_t WS_WINAB = 10 * MiB;
constexpr size_t WS_WOUTAB = 14 * MiB;
constexpr size_t WS_WINCD = 16 * MiB;
constexpr size_t WS_WOUTCD = 19 * MiB;
constexpr size_t WS_XC = 21 * MiB;
constexpr size_t WS_KN = 30 * MiB;
constexpr size_t WS_VN = 39 * MiB;
constexpr size_t WS_WGU = 48 * MiB;
constexpr size_t WS_WD = 176 * MiB;
constexpr size_t WS_XR = 240 * MiB;
constexpr size_t WS_HID = 308 * MiB;
constexpr size_t WS_Q = 384 * MiB;
constexpr size_t WS_KV = 418 * MiB;
constexpr size_t WS_G = 435 * MiB;
constexpr size_t WS_AO = 469 * MiB;
constexpr size_t WS_YB = 384 * MiB;
constexpr size_t WS_SS = 537 * MiB;
constexpr size_t WS_WR = 9 * MiB;
constexpr size_t WS_GP = 3 * MiB + 896 * 1024;
constexpr size_t WS_END = 540 * MiB;
static_assert(WS_YB + (size_t)NSLOT * 1024 * 2 <= WS_END && WS_AO + (size_t)TT * 1024 * 2 <= WS_END, "ws map");
constexpr int CW_CNT = 256;
constexpr int CW_BAR = 16384;

constexpr int RING_BYTES = 131072;
constexpr int RW_BYTES = 73728;
constexpr int LDS_MISC = 2 * RW_BYTES;
constexpr int LDS_TAB = LDS_MISC + 256;
constexpr int LDS_BYTES = 163840;

__device__ __forceinline__ unsigned pk2(float lo, float hi) { f32x2 v = {lo, hi}; bf16x2_t b = __builtin_convertvector(v, bf16x2_t); return __builtin_bit_cast(unsigned, b); }
__device__ __forceinline__ float bflo(unsigned w) { return __uint_as_float(w << 16); }
__device__ __forceinline__ float bfhi(unsigned w) { return __uint_as_float(w & 0xffff0000u); }
__device__ __forceinline__ float bf2f(bf16_t h) { return __uint_as_float((unsigned)h << 16); }
__device__ __forceinline__ float wave_sum(float v) {
#pragma unroll
    for (int o = 1; o < 64; o <<= 1) v += __shfl_xor(v, o);
    return v;
}
__device__ __forceinline__ float sigmoidf_(float v) { return 1.f / (1.f + __expf(-v)); }

#define XB_TMO      128
#define XB_XCNT(j)  (256  + 64 * (j))
#define XB_XSUB(j)  (1280 + 64 * (j))
#define XB_XGEN(j)  (2304 + 64 * (j))
#define XB_TOP      3328
#define XB_TOPGEN   3392
#define XCD_BAR_WORDS 3456
#define XB_SPIN_CAP (1u << 18)
__device__ __forceinline__ unsigned xb_ld(unsigned* p)              { return __hip_atomic_load(p, __ATOMIC_RELAXED, __HIP_MEMORY_SCOPE_AGENT); }
__device__ __forceinline__ unsigned xb_add(unsigned* p, unsigned v) { return __hip_atomic_fetch_add(p, v, __ATOMIC_RELAXED, __HIP_MEMORY_SCOPE_AGENT); }
__device__ __forceinline__ unsigned xb_xcc_id() { return (unsigned)__builtin_amdgcn_s_getreg((3 << 11) | 20) & 0xFu; }
#define XB_SPIN(cond, bar) do { unsigned _sp = 0; while (cond) { __builtin_amdgcn_s_sleep(1); \
    if ((++_sp & 255u) == 0u) { if (xb_ld(&(bar)[XB_TMO])) break; if (_sp > XB_SPIN_CAP) { atomicAdd(&(bar)[XB_TMO], 1u); break; } } } } while (0)
struct XcdBarrier { unsigned* bar; unsigned x; volatile LAS unsigned* st; };
__device__ __forceinline__ XcdBarrier xcd_barrier_post(unsigned* bar, volatile LAS unsigned* st) {
    XcdBarrier b; b.bar = bar; b.x = xb_xcc_id(); b.st = st;
    if (threadIdx.x == 0) (void)xb_add(&bar[XB_XCNT(b.x)], 1u);
    return b;
}
__device__ __forceinline__ void xcd_barrier_complete(unsigned* bar, unsigned x, unsigned& nloc, unsigned& nx) {
    const unsigned G = gridDim.x * gridDim.y * gridDim.z;
    unsigned sum, cnt, mine, sp = 0u;
    for (;;) {
        sum = 0u; cnt = 0u; mine = 0u;
#pragma unroll
        for (unsigned j = 0; j < 16; ++j) { const unsigned c = xb_ld(&bar[XB_XCNT(j)]); sum += c; cnt += (c > 0u) ? 1u : 0u; mine = (j == x) ? c : mine; }
        if (sum == G) break;
        __builtin_amdgcn_s_sleep(1);
        if ((++sp & 255u) == 0u) { if (xb_ld(&bar[XB_TMO])) break; if (sp > XB_SPIN_CAP) { atomicAdd(&bar[XB_TMO], 1u); break; } }
    }
    nloc = mine > 0u ? mine : 1u; nx = cnt > 0u ? cnt : 1u;
}
__device__ __forceinline__ void xcd_barrier(const XcdBarrier& b) {
    asm volatile("s_waitcnt vmcnt(0)" ::: "memory");
    __syncthreads();
    if (threadIdx.x == 0) {
        unsigned* bar = b.bar;
        __builtin_amdgcn_s_waitcnt(0);
        unsigned nloc = b.st[0], nx = b.st[1];
        if (nloc == 0u) { xcd_barrier_complete(bar, b.x, nloc, nx); b.st[0] = nloc; b.st[1] = nx; }
        const unsigned old = xb_add(&bar[XB_XSUB(b.x)], 1u);
        const unsigned gen = old / nloc;
        if (old + 1u == (gen + 1u) * nloc) {
            __builtin_amdgcn_fence(__ATOMIC_RELEASE, "agent");
            asm volatile("s_waitcnt vmcnt(0)" ::: "memory");
            const unsigned og = xb_add(&bar[XB_TOP], 1u);
            const unsigned tg = og / nx;
            if (og + 1u == (tg + 1u) * nx) xb_add(&bar[XB_TOPGEN], 1u);
            else XB_SPIN(xb_ld(&bar[XB_TOPGEN]) == tg, bar);
            __builtin_amdgcn_fence(__ATOMIC_ACQUIRE, "agent");
            xb_add(&bar[XB_XGEN(b.x)], 1u);
            asm volatile("s_waitcnt vmcnt(0)" ::: "memory");
        } else {
            XB_SPIN(xb_ld(&bar[XB_XGEN(b.x)]) == gen, bar);
            __builtin_amdgcn_fence(__ATOMIC_ACQUIRE, "agent");
            asm volatile("s_waitcnt vmcnt(0)" ::: "memory");
        }
    }
    __syncthreads();
}

struct Params { const float* in[30]; float* out; unsigned char* ws; int ph_lo, ph_hi; };
struct Frame {
    LAS unsigned char* lds;
    const float* const* in;
    float* out; unsigned char* ws;
    int tid, lane, wave, vcu, G;
    __device__ __forceinline__ const float* mod(int l, int r, int chunk) const { return (const float*)(ws + WS_MOD) + ((size_t)(l * 9 + r) * 6144 + chunk * 1024); }
    __device__ __forceinline__ bf16_t* xr_row(int row) const { return (bf16_t*)(ws + WS_XR) + (size_t)row * DM; }
    __device__ __forceinline__ bf16_t* hx() const { return (bf16_t*)out; }
    __device__ __forceinline__ const float* xin_row(int row) const { return row < TX ? in[I_X] + (size_t)row * DM : in[I_CTX] + (size_t)(row - TX) * DM; }
    __device__ __forceinline__ unsigned* cnt(int l) const { return (unsigned*)(ws + WS_CTL) + CW_CNT + l * 32 * 64; }
};
__device__ __forceinline__ int modrow(int row) { return row < TX ? (row >> 12) : 8; }

__device__ __forceinline__ void p0_mod_item(const Frame& F, int item) {
    const int l = item / 96, cg = item % 96;
    LAS float* sc = (LAS float*)F.lds;
    LAS float* red = sc + 9 * 1024;
    for (int i = F.tid; i < 9 * 1024; i += NTHREADS) { const int r = i >> 10, k = i & 1023; const float v = r < 8 ? F.in[I_C][r * 1024 + k] : F.in[I_CCTX][k]; sc[i] = v / (1.f + expf(-v)); }
    __syncthreads();
    const float* W = F.in[I_MODW] + (size_t)l * 1024 * 6144 + cg * 64 + F.lane;
    float acc[9];
#pragma unroll
    for (int r = 0; r < 9; ++r) acc[r] = 0.f;
    for (int kb = 0; kb < 128; kb += 32) { float w[32];
#pragma unroll
        for (int kk = 0; kk < 32; ++kk) w[kk] = W[(size_t)(F.wave * 128 + kb + kk) * 6144];
#pragma unroll
        for (int kk = 0; kk < 32; ++kk) { const int k = F.wave * 128 + kb + kk;
#pragma unroll
            for (int r = 0; r < 9; ++r) acc[r] += sc[r * 1024 + k] * w[kk]; } }
#pragma unroll
    for (int r = 0; r < 9; ++r) red[(F.wave * 9 + r) * 64 + F.lane] = acc[r];
    __syncthreads();
    for (int i = F.tid; i < 9 * 64; i += NTHREADS) { const int r = i >> 6, ln = i & 63; float s = 0.f;
#pragma unroll
        for (int w = 0; w < 8; ++w) s += red[(w * 9 + r) * 64 + ln];
        ((float*)(F.ws + WS_MOD))[(size_t)(l * 9 + r) * 6144 + cg * 64 + ln] = s + F.in[I_MODB][l * 6144 + cg * 64 + ln]; }
    __syncthreads();
}
struct TDesc { const float* src; bf16_t* dst; int ldw; };
__device__ __forceinline__ void t_load(const TDesc& d, f32x4 (&v)[16], int lane) {
    const int kr = lane >> 4, nq = lane & 15;
#pragma unroll
    for (int i = 0; i < 16; ++i) v[i] = *(const f32x4*)(d.src + (size_t)(4 * i + kr) * d.ldw + 4 * nq);
}
__device__ __forceinline__ void t_finish(const TDesc& d, const f32x4 (&v)[16], LAS float* scr, int lane) {
    const int kr = lane >> 4, nq = lane & 15;
#pragma unroll
    for (int i = 0; i < 16; ++i) { LAS float* s = scr + (4 * i + kr) * 65 + 4 * nq; s[0] = v[i][0]; s[1] = v[i][1]; s[2] = v[i][2]; s[3] = v[i][3]; }
    asm volatile("s_waitcnt lgkmcnt(0)" ::: "memory");
    const int c = lane & 7;
#pragma unroll
    for (int j = 0; j < 8; ++j) { const int n = (lane >> 3) + 8 * j; const LAS float* s = scr + (8 * c) * 65 + n;
        u32x4 o; o.x = pk2(s[0 * 65], s[1 * 65]); o.y = pk2(s[2 * 65], s[3 * 65]); o.z = pk2(s[4 * 65], s[5 * 65]); o.w = pk2(s[6 * 65], s[7 * 65]);
        *(u32x4*)(d.dst + (size_t)n * 64 + 8 * c) = o; }
    asm volatile("s_waitcnt lgkmcnt(0)" ::: "memory");
}
constexpr int TN_AB = 16 * 28, TN_OAB = 16 * 16, TN_CD = 16 * 20, TN_OCD = 8 * 16, TN_G = 64 * 128, TN_U = 64 * 128, TN_D = 64 * 128;
constexpr int TN_ITEMS = TN_AB + TN_OAB + TN_CD + TN_OCD + TN_G + TN_U + TN_D;
__device__ __forceinline__ TDesc t_decode(const Frame& F, int it) {
    TDesc d; int r = it;
    if (r < TN_AB) { const int kb = r / 28, nb = r % 28, n0 = nb * 64; int d0;
        if (n0 < 768) d0 = n0; else if (n0 < 1280) { const int j = n0 - 768; d0 = 768 + (j >> 7) * 256 + (j & 127); } else { const int j = n0 - 1280; d0 = 768 + (j >> 7) * 256 + 128 + (j & 127); }
        d.src = F.in[I_WINAB] + (size_t)kb * 64 * 1792 + n0; d.ldw = 1792; d.dst = (bf16_t*)(F.ws + WS_WINAB) + ((size_t)kb * 1792 + d0) * 64; return d; } r -= TN_AB;
    if (r < TN_OAB) { const int kb = r / 16, nb = r % 16; d.src = F.in[I_WOUTAB] + (size_t)kb * 64 * 1024 + nb * 64; d.ldw = 1024; d.dst = (bf16_t*)(F.ws + WS_WOUTAB) + ((size_t)kb * 1024 + nb * 64) * 64; return d; } r -= TN_OAB;
    if (r < TN_CD) { const int kb = r / 20, nb = r % 20; d.src = F.in[I_WINCD] + (size_t)kb * 64 * 1280 + nb * 64; d.ldw = 1280; d.dst = (bf16_t*)(F.ws + WS_WINCD) + ((size_t)kb * 1280 + nb * 64) * 64; return d; } r -= TN_CD;
    if (r < TN_OCD) { const int kb = r / 16, nb = r % 16; d.src = F.in[I_WOUTCD] + (size_t)kb * 64 * 1024 + nb * 64; d.ldw = 1024; d.dst = (bf16_t*)(F.ws + WS_WOUTCD) + ((size_t)kb * 1024 + nb * 64) * 64; return d; } r -= TN_OCD;
    if (r < TN_G + TN_U) { const bool up = r >= TN_G; if (up) r -= TN_G; const int le = r >> 7, q = r & 127, kb = q >> 3, nb = q & 7, n0 = nb * 64;
        const int d0 = (n0 >> 7) * 256 + (up ? 128 : 0) + (n0 & 127);
        d.src = F.in[up ? I_EXU : I_EXG] + (size_t)le * 1024 * 512 + (size_t)kb * 64 * 512 + n0; d.ldw = 512; d.dst = (bf16_t*)(F.ws + WS_WGU) + (size_t)le * 1024 * 1024 + ((size_t)kb * 1024 + d0) * 64; return d; } r -= TN_G + TN_U;
    { const int le = r >> 7, q = r & 127, kb = q >> 4, nb = q & 15;
        d.src = F.in[I_EXD] + (size_t)le * 512 * 1024 + (size_t)kb * 64 * 1024 + nb * 64; d.ldw = 1024; d.dst = (bf16_t*)(F.ws + WS_WD) + (size_t)le * 1024 * 512 + ((size_t)kb * 1024 + nb * 64) * 64; return d; }
}
constexpr int TN_DENSE = TN_AB + TN_OAB + TN_CD + TN_OCD;
__device__ __forceinline__ void transpose_range(const Frame& F, int lo, int hi, int w, int nw) {
    LAS float* scr = (LAS float*)(F.lds + F.wave * 16640);
    f32x4 va[16], vb[16]; TDesc da, db;
    const int first = lo + w;
    if (first < hi) { da = t_decode(F, first); t_load(da, va, F.lane); }
    for (int it = first; it < hi; it += 2 * nw) {
        const int it2 = it + nw, it3 = it + 2 * nw;
        if (it2 < hi) { db = t_decode(F, it2); t_load(db, vb, F.lane); }
        t_finish(da, va, scr, F.lane);
        if (it3 < hi) { da = t_decode(F, it3); t_load(da, va, F.lane); }
        if (it2 < hi) t_finish(db, vb, scr, F.lane);
    }
}
__device__ __forceinline__ void p0_prologue(const Frame& F) { for (int it = F.vcu; it < 192; it += F.G) p0_mod_item(F, it); }
__device__ __forceinline__ void p0_misc(const Frame& F) {
    const int gw = F.vcu * NWAVES + F.wave, NGW = F.G * NWAVES;
    const int gt = gw * 64 + F.lane, NGT = NGW * 64;
    { float* rc = (float*)(F.ws + WS_ROPE); float* rs = rc + SEQ * 32;
      for (int i = gt; i < SEQ * 32; i += NGT) { const int s = i >> 5, d = i & 31, f = d & 15; const float pos = (float)(d < 16 ? (s >> 6) : (s & 63));
          const float inv = exp2f(-(float)f * (13.287712379549449f / 16.f)); const float a = pos * inv; rc[i] = cosf(a); rs[i] = sinf(a); } }
    { typedef float f32x16_t __attribute__((ext_vector_type(16)));
      bf16_t* WT = (bf16_t*)(F.ws + WS_WOUTCD); const int l31 = F.lane & 31, lh = F.lane >> 5;
      for (int it = gw; it < 4 * 32 * 4; it += NGW) { const int g = it >> 7, dt = (it >> 2) & 31, ct = it & 3;
          const float* wo = F.in[I_WOUTCD] + (size_t)(512 + g * 128 + lh) * 1024 + dt * 32 + l31;
          const float* pw = F.in[I_POOLW] + (size_t)(g * 128 + ct * 32 + l31) * 128 + lh; const float* ps = F.in[I_POOLS] + g * 128 + lh;
          f32x16_t acc;
#pragma unroll
          for (int r = 0; r < 16; ++r) acc[r] = 0.f;
          for (int dp0 = 0; dp0 < 128; dp0 += 16) { float av[8], bv[8];
#pragma unroll
              for (int u = 0; u < 8; ++u) { av[u] = wo[(size_t)(dp0 + 2 * u) * 1024]; bv[u] = pw[dp0 + 2 * u] * ps[dp0 + 2 * u]; }
#pragma unroll
              for (int u = 0; u < 8; ++u) acc = __builtin_amdgcn_mfma_f32_32x32x2f32(av[u], bv[u], acc, 0, 0, 0); }
#pragma unroll
          for (int r = 0; r < 16; ++r) { const int i = (r & 3) + 8 * (r >> 2) + 4 * lh; const int k_ = 512 + g * 128 + ct * 32 + l31; WT[((size_t)(k_ >> 6) * 1024 + dt * 32 + i) * 64 + (k_ & 63)] = (bf16_t)(pk2(acc[r], 0.f) & 0xffffu); } } }
    { bf16_t* WR = (bf16_t*)(F.ws + WS_WR);
      for (int i = gt; i < 2 * 32 * 144 * 8; i += NGT) { const int j = i & 7, e16 = (i >> 3) % 144, s_ = (i / (8 * 144)) & 31, l = i / (8 * 144 * 32);
          int col; bool grp = false; int c;
          if (e16 < 128) { const int lane_ = e16 & 63, row = lane_ & 15; c = lane_ >> 4; col = 8 * (row >> 2) + (e16 < 64 ? 0 : 4) + (row & 3); }
          else { const int q = e16 - 128; c = q & 3; col = q >> 2; grp = true; }
          const int k = 32 * s_ + 8 * c + j;
          const float w = grp ? F.in[I_RGW][(size_t)l * 4096 + k * 4 + col] : F.in[I_REW][(size_t)l * 32768 + k * 32 + col];
          const unsigned hi = pk2(w, 0.f) & 0xffffu; const unsigned lo = pk2(w - bflo(hi), 0.f) & 0xffffu;
          const size_t o = (size_t)s_ * 1152 + (size_t)e16 * 8 + j;
          WR[(size_t)(l * 2 + 0) * 36864 + o] = (bf16_t)hi; WR[(size_t)(l * 2 + 1) * 36864 + o] = (bf16_t)lo; } }
    transpose_range(F, 0, F.G == 256 ? TN_DENSE : TN_ITEMS, gw, NGW);
}

__device__ __forceinline__ void norm_mod_row(const float* xrow, const float* g, const float* sh, const float* sc, int lane, f32x4 (&h)[4]) {
    f32x4 v[4]; float ss = 0.f;
#pragma unroll
    for (int j = 0; j < 4; ++j) { v[j] = *(const f32x4*)(xrow + 4 * lane + 256 * j); ss += (v[j][0] * v[j][0] + v[j][1] * v[j][1]) + (v[j][2] * v[j][2] + v[j][3] * v[j][3]); }
    const float rms = 1.0f / sqrtf(wave_sum(ss) * (1.f / 1024.f) + EPS);
#pragma unroll
    for (int j = 0; j < 4; ++j) { const int c = 4 * lane + 256 * j; const f32x4 gg = *(const f32x4*)(g + c), s1 = *(const f32x4*)(sc + c), s0 = *(const f32x4*)(sh + c);
        h[j] = (v[j] * rms * gg) * (1.f + s1) + s0; }
}
__device__ __forceinline__ void store_row_bf16(bf16_t* orow, int lane, const f32x4 (&h)[4]) {
#pragma unroll
    for (int j = 0; j < 4; ++j) { u32x2 o; o.x = pk2(h[j][0], h[j][1]); o.y = pk2(h[j][2], h[j][3]); *(u32x2*)(orow + 4 * lane + 256 * j) = o; }
}
struct RowBuf { f32x4 v[4]; };
__device__ __forceinline__ void row_load(RowBuf& b, const float* xrow, int lane) {
#pragma unroll
    for (int j = 0; j < 4; ++j) b.v[j] = *(const f32x4*)(xrow + 4 * lane + 256 * j);
}
__device__ __forceinline__ void row_norm_store(const RowBuf& b, const float* g, const float* sh, const float* sc, bf16_t* orow, int lane) {
    float ss = 0.f;
#pragma unroll
    for (int j = 0; j < 4; ++j) ss += (b.v[j][0] * b.v[j][0] + b.v[j][1] * b.v[j][1]) + (b.v[j][2] * b.v[j][2] + b.v[j][3] * b.v[j][3]);
    const float rms = 1.0f / sqrtf(wave_sum(ss) * (1.f / 1024.f) + EPS);
    f32x4 h[4];
#pragma unroll
    for (int j = 0; j < 4; ++j) { const int c = 4 * lane + 256 * j; h[j] = (b.v[j] * rms * *(const f32x4*)(g + c)) * (1.f + *(const f32x4*)(sc + c)) + *(const f32x4*)(sh + c); }
    store_row_bf16(orow, lane, h);
}
__device__ __forceinline__ void p_norm1_l0(const Frame& F) {
    const int gw = F.vcu * NWAVES + F.wave, NGW = F.G * NWAVES;
    { float* GP = (float*)(F.ws + WS_GP);
      for (int i = gw * 64 + F.lane; i < 2 * 9 * 1024; i += NGW * 64) { const int k = i & 1023, lr = i >> 10; GP[i] = F.in[I_LN2][(lr / 9) * 1024 + k] * (1.f + F.mod(lr / 9, lr % 9, 4)[k]); } }
    bf16_t* HX = F.hx();
    RowBuf A, B;
    if (gw < TT) row_load(A, F.xin_row(gw), F.lane);
    for (int row = gw; row < TT; row += 2 * NGW) {
        const int row2 = row + NGW, row3 = row + 2 * NGW;
        if (row2 < TT) row_load(B, F.xin_row(row2), F.lane);
        { const int r = modrow(row); row_norm_store(A, F.in[I_LN1], F.mod(0, r, 0), F.mod(0, r, 1), HX + (size_t)row * DM, F.lane); }
        if (row3 < TT) row_load(A, F.xin_row(row3), F.lane);
        if (row2 < TT) { const int r = modrow(row2); row_norm_store(B, F.in[I_LN1], F.mod(0, r, 0), F.mod(0, r, 1), HX + (size_t)row2 * DM, F.lane); }
    }
}

struct Unit { int pm, pn, e; };
struct SchedDense {
    const bf16_t* Bt; int K, nMa, nN, nMb, pnb, vcu, G;
    __device__ __forceinline__ bool next(int i, Unit& u) const { int L = i * G + vcu; const int na = nMa * nN; u.e = 0;
        if (L < na) { u.pm = L / nN; u.pn = L % nN; return true; } L -= na; if (L < nMb) { u.pm = nMa + L; u.pn = pnb; return true; } return false; }
    __device__ __forceinline__ int arow(const Unit& u, int r) const { return u.pm * 256 + r; }
    __device__ __forceinline__ const bf16_t* bbase(const Unit& u) const { return Bt + (size_t)u.pn * 256 * 64; }
    __device__ __forceinline__ int brows() const { return nN * 256; }
};
struct MoeTab { const LAS int* tile_e; const LAS int* tile0; const LAS int* cnt; int ntiles; };
struct SchedMoe {
    const bf16_t* Wt; size_t estride; int K; MoeTab tb; const unsigned* list; bool gather; int vcu, G;
    __device__ __forceinline__ bool next(int i, Unit& u) const { const int L = i * G + vcu; if (L >= tb.ntiles * 4) return false; u.pm = L >> 2; u.pn = L & 3; u.e = tb.tile_e[u.pm]; return true; }
    __device__ __forceinline__ int arow(const Unit& u, int r) const {
        if (!gather) return u.pm * 256 + r;
        int idx = (u.pm - tb.tile0[u.e]) * 256 + r; const int c = tb.cnt[u.e]; idx = idx < c ? idx : c - 1;
        return (int)list[(size_t)u.e * TT + idx]; }
    __device__ __forceinline__ const bf16_t* bbase(const Unit& u) const { return Wt + (size_t)u.e * estride + (size_t)u.pn * 256 * 64; }
    __device__ __forceinline__ int brows() const { return 1024; }
};
__device__ __forceinline__ MoeTab moe_tables(const Frame& F, int l) {
    LAS int* tile_e = (LAS int*)(F.lds + LDS_TAB); LAS int* tile0 = tile_e + NTILE_MAX; LAS int* cntl = tile0 + 33; LAS int* nt = cntl + 32;
    __syncthreads();
    if (F.tid == 0) { int t = 0; unsigned* cg = F.cnt(l);
        for (int e = 0; e < NE; ++e) { const int c = (int)__hip_atomic_load(cg + e * 64, __ATOMIC_RELAXED, __HIP_MEMORY_SCOPE_AGENT); const int n = (c + 255) >> 8; tile0[e] = t; cntl[e] = c;
            for (int j = 0; j < n; ++j) tile_e[t + j] = e; t += n; }
        tile0[32] = t; nt[0] = t; }
    __syncthreads();
    MoeTab tb; tb.tile_e = tile_e; tb.tile0 = tile0; tb.cnt = cntl; tb.ntiles = nt[0]; return tb;
}

namespace pg8 {
constexpr int BM = 256, BK = 64, HALF = 128, HTB = HALF * BK * 2;
__device__ __forceinline__ int lds_byte(int r, int c) { const int st = (r >> 4) * 2 + (c >> 5), rr = r & 15, cc = c & 31, ob = rr * 64 + cc * 2; return st * 1024 + (ob ^ (((ob >> 9) & 1) << 5)); }
__device__ __forceinline__ void stage_rc(int b, int& R, int& C) { const int st = b / 1024, sb = b % 1024, swz = sb ^ (((sb >> 9) & 1) << 5); R = (st >> 1) * 16 + swz / 64; C = (st & 1) * 32 + (swz % 64) / 2; }
__device__ __forceinline__ int perm32(int rho) { const int n = rho >> 4, i = rho & 15; return 8 * (i >> 2) + 4 * n + (i & 3); }
}
template <bool ALIGN_EPI, class Sched, class Epi>
__device__ __forceinline__ void gemm_fast(const Frame& F, const bf16_t* A, int K, const Sched& S, const Epi& E) {
    using namespace pg8;
    LAS unsigned char* lds = F.lds;
    const int tid = F.tid, wid = F.wave, lane = F.lane, wr = wid >> 2, wc = wid & 3, fr = lane & 15, fq = lane >> 4;
    const int nt = K / BK;
    int RA[2], CA[2]; unsigned voffB[2];
#pragma unroll
    for (int i = 0; i < 2; ++i) { int R, C; stage_rc(tid * 16 + i * 8192, R, C); RA[i] = R; CA[i] = C; const int Rb = (R & ~31) + perm32(R & 31); voffB[i] = (unsigned)(Rb * 64 + C) * 2u; }
    const size_t kstep = (size_t)(BK * 2);
    const size_t kstepB = (size_t)S.brows() * BK * 2;
    const size_t hstep = (size_t)HALF * BK * 2;
    const unsigned ldsw = (unsigned)wid * 1024u;
    const int aoff = lds_byte(wr * 64 + fr, fq * 8), boff = lds_byte(wc * 32 + fr, fq * 8);
    const char* Ab = (const char*)A;
#define PG8_SA(b, h) (((b) * 2 + (h)) * HTB)
#define PG8_SB(b, h) ((4 + (b) * 2 + (h)) * HTB)
#define PG8_STAGE(bufoff, gbase, voff) do { _Pragma("unroll") for (int _i = 0; _i < 2; ++_i) \
        __builtin_amdgcn_global_load_lds((const unsigned*)((const char*)(gbase) + (voff)[_i]), (LAS unsigned*)(lds + (bufoff) + ldsw + _i * 8192), 16, 0, 0); } while (0)
#define PG8_LDA(dst, b, h) do { _Pragma("unroll") for (int m = 0; m < 4; ++m) _Pragma("unroll") for (int k = 0; k < 2; ++k) dst[m][k] = *(const LAS bf16x8*)(lds + PG8_SA(b, h) + aoff + m * 2048 + k * 1024); } while (0)
#define PG8_LDB(dst, b, h) do { _Pragma("unroll") for (int n = 0; n < 2; ++n) _Pragma("unroll") for (int k = 0; k < 2; ++k) dst[n][k] = *(const LAS bf16x8*)(lds + PG8_SB(b, h) + boff + n * 2048 + k * 1024); } while (0)
#define PG8_MMA(ai, bj, At, Bt) do { __builtin_amdgcn_s_setprio(1); _Pragma("unroll") for (int m = 0; m < 4; ++m) _Pragma("unroll") for (int n = 0; n < 2; ++n) _Pragma("unroll") for (int k = 0; k < 2; ++k) \
        acc[ai][bj][m][n] = __builtin_amdgcn_mfma_f32_16x16x32_bf16(Bt[n][k], At[m][k], acc[ai][bj][m][n], 0, 0, 0); __builtin_amdgcn_s_setprio(0); } while (0)
#define PG8_WAIT_V(n) asm volatile("s_waitcnt vmcnt(" #n ")" ::: "memory")
#define PG8_WAIT_L(n) asm volatile("s_waitcnt lgkmcnt(" #n ")" ::: "memory")
#define PG8_BAR __builtin_amdgcn_s_barrier()
#define PG8_SCHED __builtin_amdgcn_sched_barrier(0)
#define PG8_VOFF(dst, u) do { _Pragma("unroll") for (int _h = 0; _h < 2; ++_h) _Pragma("unroll") for (int _i = 0; _i < 2; ++_i) \
        dst[_h][_i] = (unsigned)S.arow(u, 128 * _h + RA[_i]) * (unsigned)(K * 2) + (unsigned)(CA[_i] * 2); } while (0)
    Unit cur, nxt; int ui = 0;
    if (!S.next(0, cur)) return;
    f32x4 acc[2][2][4][2];
#pragma unroll
    for (int a = 0; a < 2; ++a)
#pragma unroll
        for (int b = 0; b < 2; ++b)
#pragma unroll
            for (int m = 0; m < 4; ++m)
#pragma unroll
                for (int n = 0; n < 2; ++n) acc[a][b][m][n] = (f32x4){0.f, 0.f, 0.f, 0.f};
    bf16x8 At[4][2], B0[2][2], B1[2][2];
    unsigned vC[2][2], vN[2][2];
    PG8_VOFF(vC, cur);
    const char* cB = (const char*)S.bbase(cur);
    PG8_STAGE(PG8_SB(0, 0), cB, voffB); PG8_STAGE(PG8_SB(0, 1), cB + hstep, voffB); PG8_STAGE(PG8_SA(0, 0), Ab, vC[0]); PG8_STAGE(PG8_SA(0, 1), Ab, vC[1]);
    if (wr == 1) PG8_BAR;
    PG8_WAIT_V(2); PG8_BAR;
    PG8_STAGE(PG8_SB(1, 0), cB + kstepB, voffB); PG8_STAGE(PG8_SA(1, 0), Ab + kstep, vC[0]); PG8_STAGE(PG8_SB(1, 1), cB + hstep + kstepB, voffB);
    PG8_WAIT_V(6); PG8_BAR;
    for (;;) {
        const bool has_next = S.next(ui + 1, nxt);
        const char* nB = cB;
        if (has_next) { PG8_VOFF(vN, nxt); nB = (const char*)S.bbase(nxt); }
        else {
#pragma unroll
            for (int h = 0; h < 2; ++h)
#pragma unroll
                for (int i = 0; i < 2; ++i) vN[h][i] = vC[h][i]; }
        for (int t = 0; t < nt; t += 2) {
            const bool last = (t == nt - 2);
            const char* a1 = Ab + (size_t)(t + 1) * kstep;
            const char* a2 = last ? Ab : Ab + (size_t)(t + 2) * kstep; const char* b2 = last ? nB : cB + (size_t)(t + 2) * kstepB;
            const char* a3 = a2 + kstep; const char* b3 = b2 + kstepB;
            unsigned v2[2][2];
#pragma unroll
            for (int h = 0; h < 2; ++h)
#pragma unroll
                for (int i = 0; i < 2; ++i) v2[h][i] = last ? vN[h][i] : vC[h][i];
            PG8_LDB(B0, 0, 0); PG8_LDB(B1, 0, 1); PG8_SCHED; PG8_LDA(At, 0, 0); PG8_STAGE(PG8_SA(1, 1), a1, vC[1]);
            PG8_WAIT_V(8); PG8_WAIT_L(0); PG8_BAR; PG8_MMA(0, 0, At, B0); PG8_MMA(0, 1, At, B1); PG8_BAR; PG8_SCHED;
            PG8_LDA(At, 0, 1); PG8_STAGE(PG8_SB(0, 0), b2, voffB); PG8_STAGE(PG8_SB(0, 1), b2 + hstep, voffB); PG8_STAGE(PG8_SA(0, 0), a2, v2[0]);
            PG8_WAIT_V(8); PG8_WAIT_L(0); PG8_BAR; PG8_MMA(1, 0, At, B0); PG8_MMA(1, 1, At, B1); PG8_BAR; PG8_SCHED;
            PG8_LDB(B0, 1, 0); PG8_LDB(B1, 1, 1); PG8_SCHED; PG8_LDA(At, 1, 0); PG8_STAGE(PG8_SA(0, 1), a2, v2[1]);
            PG8_WAIT_V(8); PG8_WAIT_L(0); PG8_BAR; PG8_MMA(0, 0, At, B0); PG8_MMA(0, 1, At, B1); PG8_BAR; PG8_SCHED;
            PG8_LDA(At, 1, 1); PG8_STAGE(PG8_SB(1, 0), b3, voffB); PG8_STAGE(PG8_SB(1, 1), b3 + hstep, voffB); PG8_STAGE(PG8_SA(1, 0), a3, v2[0]);
            PG8_WAIT_V(8); PG8_WAIT_L(0); PG8_BAR; PG8_MMA(1, 0, At, B0); PG8_MMA(1, 1, At, B1); PG8_BAR; PG8_SCHED;
        }
        if (ALIGN_EPI) { if (wr == 0) PG8_BAR; }
        E(acc, cur, wr, wc, fr, fq);
        if (!has_next) break;
#pragma unroll
        for (int a = 0; a < 2; ++a)
#pragma unroll
            for (int b = 0; b < 2; ++b)
#pragma unroll
                for (int m = 0; m < 4; ++m)
#pragma unroll
                    for (int n = 0; n < 2; ++n) acc[a][b][m][n] = (f32x4){0.f, 0.f, 0.f, 0.f};
        cur = nxt; cB = nB; ++ui;
#pragma unroll
        for (int h = 0; h < 2; ++h)
#pragma unroll
            for (int i = 0; i < 2; ++i) vC[h][i] = vN[h][i];
        if (ALIGN_EPI) { if (wr == 1) PG8_BAR; }
    }
    PG8_WAIT_V(0);
    if (!ALIGN_EPI) { if (wr == 0) PG8_BAR; }
    PG8_BAR;
#undef PG8_SA
#undef PG8_SB
#undef PG8_STAGE
#undef PG8_LDA
#undef PG8_LDB
#undef PG8_MMA
#undef PG8_WAIT_V
#undef PG8_WAIT_L
#undef PG8_BAR
#undef PG8_SCHED
#undef PG8_VOFF
}
#ifndef ALIGN_G2
#define ALIGN_G2 false
#endif
#define GEMM gemm_fast<true>
#define GEMM2 gemm_fast<ALIGN_G2>

__device__ __forceinline__ u32x4 pack8(const f32x4& a, const f32x4& b) { u32x4 w; w.x = pk2(a[0], a[1]); w.y = pk2(a[2], a[3]); w.z = pk2(b[0], b[1]); w.w = pk2(b[2], b[3]); return w; }
template <bool GLU> struct EpiInProj {
    bf16_t* Q; bf16_t* KR; bf16_t* Vn; bf16_t* Gb;
    __device__ __forceinline__ void operator()(const f32x4 (&acc)[2][2][4][2], const Unit& u, int wr, int wc, int fr, int fq) const {
#pragma unroll
        for (int ai = 0; ai < 2; ++ai)
#pragma unroll
            for (int m = 0; m < 4; ++m) { const int irow = u.pm * 256 + 128 * ai + 64 * wr + 16 * m + fr; const size_t row = (size_t)irow; const int cl = 32 * wc + 8 * fq;
                if (u.pn < 2) { *(u32x4*)(Q + row * 512 + u.pn * 256 + cl) = pack8(acc[ai][0][m][0], acc[ai][0][m][1]); *(u32x4*)(Q + row * 512 + u.pn * 256 + 128 + cl) = pack8(acc[ai][1][m][0], acc[ai][1][m][1]); }
                else if (u.pn == 2) { const size_t kvrow = irow < TX ? (size_t)(irow >> 12) * KVS + CTXL + (irow & 4095) : (size_t)((irow - TX) >> 8) * KVS + ((irow - TX) & 255);
                    *(u32x4*)(KR + kvrow * 128 + cl) = pack8(acc[ai][0][m][0], acc[ai][0][m][1]); *(u32x4*)(Vn + kvrow * 128 + cl) = pack8(acc[ai][1][m][0], acc[ai][1][m][1]); }
                else if (GLU) { f32x4 g0, g1;
#pragma unroll
                    for (int j = 0; j < 4; ++j) { g0[j] = acc[ai][0][m][0][j] * sigmoidf_(acc[ai][1][m][0][j]); g1[j] = acc[ai][0][m][1][j] * sigmoidf_(acc[ai][1][m][1][j]); }
                    *(u32x4*)(Gb + row * 512 + (u.pn - 3) * 128 + cl) = pack8(g0, g1); }
                else { *(u32x4*)(Gb + row * 512 + (u.pn - 3) * 256 + cl) = pack8(acc[ai][0][m][0], acc[ai][0][m][1]); *(u32x4*)(Gb + row * 512 + (u.pn - 3) * 256 + 128 + cl) = pack8(acc[ai][1][m][0], acc[ai][1][m][1]); }
            }
    }
};
template <bool L0, bool DRY = false> struct EpiOutProj {
    Frame F; int l;
    __device__ __forceinline__ void operator()(const f32x4 (&acc)[2][2][4][2], const Unit& u, int wr, int wc, int fr, int fq) const {
        float* SS = (float*)(F.ws + WS_SS);
        const float* g1 = F.mod(l, modrow(u.pm * 256), 2) + u.pn * 256 + 32 * wc + 8 * fq;
        f32x4 gv[2][2];
#pragma unroll
        for (int bj = 0; bj < 2; ++bj)
#pragma unroll
            for (int n = 0; n < 2; ++n) gv[bj][n] = *(const f32x4*)(g1 + 128 * bj + 4 * n);
#pragma unroll
        for (int ai = 0; ai < 2; ++ai) {
            f32x4 xv[4][2][2];
#pragma unroll
            for (int m = 0; m < 4; ++m) { const int row = u.pm * 256 + 128 * ai + 64 * wr + 16 * m + fr; const int c0 = u.pn * 256 + 32 * wc + 8 * fq;
#pragma unroll
                for (int bj = 0; bj < 2; ++bj) {
                    if (L0) { const float* src = F.xin_row(row) + c0 + 128 * bj; xv[m][bj][0] = *(const f32x4*)(src); xv[m][bj][1] = *(const f32x4*)(src + 4); }
                    else { const u32x4 w = *(const u32x4*)(F.xr_row(row) + c0 + 128 * bj); xv[m][bj][0] = (f32x4){bflo(w.x), bfhi(w.x), bflo(w.y), bfhi(w.y)}; xv[m][bj][1] = (f32x4){bflo(w.z), bfhi(w.z), bflo(w.w), bfhi(w.w)}; } } }
#pragma unroll
            for (int m = 0; m < 4; ++m) { const int row = u.pm * 256 + 128 * ai + 64 * wr + 16 * m + fr; bf16_t* dst = F.xr_row(row) + u.pn * 256 + 32 * wc + 8 * fq; float q = 0.f;
#pragma unroll
                for (int bj = 0; bj < 2; ++bj) { const f32x4 v0 = xv[m][bj][0] + gv[bj][0] * acc[ai][bj][m][0], v1 = xv[m][bj][1] + gv[bj][1] * acc[ai][bj][m][1];
                    *(u32x4*)(dst + 128 * bj) = DRY ? pack8(xv[m][bj][0], xv[m][bj][1]) : pack8(v0, v1);
                    q += ((v0[0] * v0[0] + v0[1] * v0[1]) + (v0[2] * v0[2] + v0[3] * v0[3])) + ((v1[0] * v1[0] + v1[1] * v1[1]) + (v1[2] * v1[2] + v1[3] * v1[3])); }
                q += __shfl_xor(q, 16); q += __shfl_xor(q, 32);
                if (fq == 0) SS[(size_t)row * 16 + u.pn * 4 + wc] = q; }
        }
    }
};
struct EpiMoe1 {
    bf16_t* HID;
    __device__ __forceinline__ void operator()(const f32x4 (&acc)[2][2][4][2], const Unit& u, int wr, int wc, int fr, int fq) const {
#pragma unroll
        for (int ai = 0; ai < 2; ++ai)
#pragma unroll
            for (int m = 0; m < 4; ++m) { const size_t slot = (size_t)u.pm * 256 + 128 * ai + 64 * wr + 16 * m + fr; f32x4 h0, h1;
#pragma unroll
                for (int j = 0; j < 4; ++j) { const float a = acc[ai][0][m][0][j], b = acc[ai][0][m][1][j]; h0[j] = a * sigmoidf_(a) * acc[ai][1][m][0][j]; h1[j] = b * sigmoidf_(b) * acc[ai][1][m][1][j]; }
                *(u32x4*)(HID + slot * 512 + u.pn * 128 + 32 * wc + 8 * fq) = pack8(h0, h1); }
    }
};
struct EpiMoe2 {
    bf16_t* YB;
    __device__ __forceinline__ void operator()(const f32x4 (&acc)[2][2][4][2], const Unit& u, int wr, int wc, int fr, int fq) const {
#pragma unroll
        for (int ai = 0; ai < 2; ++ai)
#pragma unroll
            for (int m = 0; m < 4; ++m) { const size_t slot = (size_t)u.pm * 256 + 128 * ai + 64 * wr + 16 * m + fr;
#pragma unroll
                for (int bj = 0; bj < 2; ++bj) *(u32x4*)(YB + slot * 1024 + u.pn * 256 + 128 * bj + 32 * wc + 8 * fq) = pack8(acc[ai][bj][m][0], acc[ai][bj][m][1]); }
    }
};

__device__ __forceinline__ void p_k_post(const Frame& F, const float* kg) {
    const int gw = F.vcu * NWAVES + F.wave, NGW = F.G * NWAVES, lane = F.lane;
    const bf16_t* KR = (const bf16_t*)(F.ws + WS_KV); bf16_t* Kn = (bf16_t*)(F.ws + WS_KN);
    const float* rc = (const float*)(F.ws + WS_ROPE); const float* rs = rc + SEQ * 32;
    const int c16 = lane & 15, i8 = c16 & 7, dd0 = 8 * (i8 & 3), sub = lane >> 4;
    float gk[8];
#pragma unroll
    for (int j = 0; j < 8; ++j) gk[j] = kg[i8 * 8 + j];
    const float sgn = (i8 < 4) ? -1.f : 1.f;
    for (int it = gw; it < NB * KVS / 16; it += NGW) {
        u32x4 w[4];
#pragma unroll
        for (int q = 0; q < 4; ++q) w[q] = *(const u32x4*)(KR + (size_t)(it * 16 + 4 * q + sub) * 128 + c16 * 8);
#pragma unroll
        for (int q = 0; q < 4; ++q) { const int kvrow = it * 16 + 4 * q + sub, pos = kvrow % KVS;
            float cs[8], sn[8];
#pragma unroll
            for (int j = 0; j < 8; ++j) { cs[j] = 1.f; sn[j] = 0.f; }
            if (pos >= CTXL) { const int sq = pos - CTXL; const f32x4 c0 = *(const f32x4*)(rc + sq * 32 + dd0), c1 = *(const f32x4*)(rc + sq * 32 + dd0 + 4), s0 = *(const f32x4*)(rs + sq * 32 + dd0), s1 = *(const f32x4*)(rs + sq * 32 + dd0 + 4);
#pragma unroll
                for (int j = 0; j < 4; ++j) { cs[j] = c0[j]; cs[4 + j] = c1[j]; sn[j] = s0[j]; sn[4 + j] = s1[j]; } }
            float x[8] = {bflo(w[q].x), bfhi(w[q].x), bflo(w[q].y), bfhi(w[q].y), bflo(w[q].z), bfhi(w[q].z), bflo(w[q].w), bfhi(w[q].w)};
            float ss = 0.f;
#pragma unroll
            for (int j = 0; j < 8; ++j) ss += x[j] * x[j];
            ss += __shfl_xor(ss, 1); ss += __shfl_xor(ss, 2); ss += __shfl_xor(ss, 4);
            const float rms = 1.0f / sqrtf(ss * (1.f / 64.f) + EPS);
            float y[8], o[8];
#pragma unroll
            for (int j = 0; j < 8; ++j) y[j] = x[j] * rms * gk[j];
#pragma unroll
            for (int j = 0; j < 8; ++j) { const float yp = __shfl_xor(y[j], 4); o[j] = y[j] * cs[j] + sgn * yp * sn[j]; }
            u32x4 ow; ow.x = pk2(o[0], o[1]); ow.y = pk2(o[2], o[3]); ow.z = pk2(o[4], o[5]); ow.w = pk2(o[6], o[7]);
            *(u32x4*)(Kn + (size_t)kvrow * 128 + c16 * 8) = ow; }
    }
}
__device__ __forceinline__ void p_conv(const Frame& F) {
    const bf16_t* Gb = (const bf16_t*)(F.ws + WS_G); bf16_t* AO = (bf16_t*)(F.ws + WS_AO);
    LAS bf16_t* gl = (LAS bf16_t*)F.lds;
    LAS float* yl = (LAS float*)(F.lds + 65536);
    const int c = F.tid;
    float w[31];
#pragma unroll
    for (int j = 0; j < 31; ++j) w[j] = F.in[I_CONVW][j * 512 + c];
    const float bias = F.in[I_CONVB][c];
    u32x4 pre[8];
#define CONV_ITEM(item, rowbase, t0, len) do { if ((item) < 1024) { rowbase = ((item) >> 7) * SEQ; t0 = ((item) & 127) * 32; len = SEQ; } else { const int it_ = (item) - 1024; rowbase = TX + (it_ >> 3) * CTXL; t0 = (it_ & 7) * 32; len = CTXL; } } while (0)
#define CONV_LOAD(item) do { int rb_, t0_, len_; CONV_ITEM(item, rb_, t0_, len_); _Pragma("unroll") for (int q = 0; q < 8; ++q) { const int ch = F.tid + q * NTHREADS, r = ch >> 6, p = t0_ - 15 + r; pre[q] = (u32x4){0u, 0u, 0u, 0u}; \
        if (ch < 62 * 64 && p >= 0 && p < len_) pre[q] = *(const u32x4*)(Gb + (size_t)(rb_ + p) * 512 + (ch & 63) * 8); } } while (0)
    if (F.vcu < 1024 + 64) CONV_LOAD(F.vcu);
    for (int item = F.vcu; item < 1024 + 64; item += F.G) {
        int rowbase, t0, len; CONV_ITEM(item, rowbase, t0, len);
        __syncthreads();
#pragma unroll
        for (int q = 0; q < 8; ++q) { const int ch = F.tid + q * NTHREADS; if (ch < 62 * 64) *(LAS u32x4*)(gl + (ch >> 6) * 512 + (ch & 63) * 8) = pre[q]; }
        __syncthreads();
        if (item + F.G < 1024 + 64) CONV_LOAD(item + F.G);
        float g[62];
#pragma unroll
        for (int r = 0; r < 62; ++r) g[r] = bf2f(gl[r * 512 + c]);
#pragma unroll
        for (int t = 0; t < 32; ++t) { float y = bias;
#pragma unroll
            for (int j = 0; j < 31; ++j) y += g[t + j] * w[j];
            yl[t * 512 + c] = y; }
        __syncthreads();
#pragma unroll
        for (int tt = 0; tt < 4; ++tt) { const int t = 4 * F.wave + tt; float v[8]; float sm = 0.f;
#pragma unroll
            for (int j = 0; j < 8; ++j) { v[j] = yl[t * 512 + F.lane + 64 * j]; sm += v[j]; }
            const float mean = wave_sum(sm) * (1.f / 512.f); float q = 0.f;
#pragma unroll
            for (int j = 0; j < 8; ++j) { v[j] -= mean; q += v[j] * v[j]; }
            const float rstd = 1.0f / sqrtf(wave_sum(q) * (1.f / 512.f) + EPS);
            bf16_t* orow = AO + (size_t)(rowbase + t0 + t) * 1024 + 512;
#pragma unroll
            for (int j = 0; j < 8; ++j) { const int cc = F.lane + 64 * j; const float yn = v[j] * rstd * F.in[I_CLNG][cc] + F.in[I_CLNB][cc]; orow[cc] = (bf16_t)(pk2(yn * sigmoidf_(yn), 0.f) & 0xffffu); } }
    }
#undef CONV_ITEM
#undef CONV_LOAD
    __syncthreads();
}
__device__ __forceinline__ void p_pool(const Frame& F) {
    const int gw = F.vcu * NWAVES + F.wave, NGW = F.G * NWAVES, lane = F.lane;
    const bf16_t* U = (const bf16_t*)(F.ws + WS_G); bf16_t* AO = (bf16_t*)(F.ws + WS_AO);
    const int hw = 1 << (lane >> 4);
    float wgt[16];
#pragma unroll
    for (int i = 0; i < 16; ++i) wgt[i] = (i >= 8 - hw && i < 8 + hw) ? 1.f : 0.f;
    for (int it = gw; it < TX / 8; it += NGW) {
        const int row0 = it * 8, t0 = row0 & 4095, rb = row0 - t0;
        u32x4 r[23];
#pragma unroll
        for (int j = 0; j < 23; ++j) { const int p = t0 - 8 + j; r[j] = (u32x4){0u, 0u, 0u, 0u}; if (p >= 0 && p < SEQ) r[j] = *(const u32x4*)(U + (size_t)(rb + p) * 512 + lane * 8); }
#pragma unroll
        for (int t = 0; t < 8; ++t) {
            float s[8];
#pragma unroll
            for (int j = 0; j < 8; ++j) s[j] = 0.f;
#pragma unroll
            for (int i = 0; i < 16; ++i) { const u32x4 w = r[t + i]; const float g = wgt[i];
                s[0] += g * bflo(w.x); s[1] += g * bfhi(w.x); s[2] += g * bflo(w.y); s[3] += g * bfhi(w.y); s[4] += g * bflo(w.z); s[5] += g * bfhi(w.z); s[6] += g * bflo(w.w); s[7] += g * bfhi(w.w); }
            const int tt = t0 + t; int lo = tt - hw, hi = tt + hw; lo = lo < 0 ? 0 : lo; hi = hi > SEQ ? SEQ : hi;
            const float inv = 1.f / (float)(hi - lo); const u32x4 w = r[t + 8];
            u32x4 ow; ow.x = pk2(s[0] * inv - bflo(w.x), s[1] * inv - bfhi(w.x)); ow.y = pk2(s[2] * inv - bflo(w.y), s[3] * inv - bfhi(w.y)); ow.z = pk2(s[4] * inv - bflo(w.z), s[5] * inv - bfhi(w.z)); ow.w = pk2(s[6] * inv - bflo(w.w), s[7] * inv - bfhi(w.w));
            *(u32x4*)(AO + (size_t)(row0 + t) * 1024 + 512 + lane * 8) = ow;
        }
    }
}

template <int LAYER> __device__ __forceinline__ void attn_simple(const Frame& F) {
    const bf16_t* Q = (const bf16_t*)(F.ws + WS_Q); const bf16_t* Kn = (const bf16_t*)(F.ws + WS_KN); const bf16_t* Vn = (const bf16_t*)(F.ws + WS_VN); bf16_t* AO = (bf16_t*)(F.ws + WS_AO);
    const int nunits = LAYER == 0 ? 512 + 64 : 512;
    for (int u = F.vcu; u < nunits; u += F.G) {
        int b, h, row, s; bool valid = true, isctx = false;
        if (u < 512) { b = u >> 6; h = (u >> 3) & 7; s = (u & 7) * 512 + F.tid; row = b * SEQ + s; }
        else { const int uc = u - 512; b = uc >> 3; h = uc & 7; s = F.tid; valid = F.tid < 256; row = TX + b * CTXL + (valid ? s : 0); isctx = true; }
        float q[64], o[64];
        { const u32x4* qp = (const u32x4*)(Q + (size_t)row * 512 + h * 64);
#pragma unroll
          for (int c = 0; c < 8; ++c) { const u32x4 w = qp[c]; q[8 * c] = bflo(w.x); q[8 * c + 1] = bfhi(w.x); q[8 * c + 2] = bflo(w.y); q[8 * c + 3] = bfhi(w.y); q[8 * c + 4] = bflo(w.z); q[8 * c + 5] = bfhi(w.z); q[8 * c + 6] = bflo(w.w); q[8 * c + 7] = bfhi(w.w); } }
#pragma unroll
        for (int d = 0; d < 64; ++d) o[d] = 0.f;
        float mx = -1e30f, l = 0.f;
        const bf16_t* Kb = Kn + (size_t)b * KVS * 128 + (h >> 2) * 64; const bf16_t* Vb = Vn + (size_t)b * KVS * 128 + (h >> 2) * 64;
        int k_lo2 = 0, k_hi2 = 0;
        const int k_hi1 = CTXL;
        if (LAYER == 0) { if (!isctx) { k_lo2 = CTXL; k_hi2 = KVS; } }
        else { const int s0 = (u & 7) * 512; int lo = s0 - 128, hi = s0 + 511 + 128 + 1; lo = lo < 0 ? 0 : lo; hi = hi > SEQ ? SEQ : hi; k_lo2 = CTXL + lo; k_hi2 = CTXL + hi; }
        for (int part = 0; part < 2; ++part) {
            const int kb = part == 0 ? 0 : k_lo2, ke = part == 0 ? k_hi1 : k_hi2;
            for (int key = kb; key < ke; ++key) {
                const u32x4* kp = (const u32x4*)(Kb + (size_t)key * 128); float sd = 0.f;
#pragma unroll
                for (int c = 0; c < 8; ++c) { const u32x4 w = kp[c];
                    sd += q[8 * c] * bflo(w.x) + q[8 * c + 1] * bfhi(w.x) + q[8 * c + 2] * bflo(w.y) + q[8 * c + 3] * bfhi(w.y) + q[8 * c + 4] * bflo(w.z) + q[8 * c + 5] * bfhi(w.z) + q[8 * c + 6] * bflo(w.w) + q[8 * c + 7] * bfhi(w.w); }
                bool use = valid;
                if (LAYER == 1 && part == 1) { const int j = key - CTXL; const int dlt = s - j; use = use && (dlt <= 128 && dlt >= -128); }
                const float mn = fmaxf(mx, sd); const float mnew = use ? mn : mx;
                const float alpha = exp2f(mx - mnew), p = use ? exp2f(sd - mnew) : 0.f;
                mx = mnew; l = l * alpha + p;
                const u32x4* vp = (const u32x4*)(Vb + (size_t)key * 128);
#pragma unroll
                for (int c = 0; c < 8; ++c) { const u32x4 w = vp[c];
                    o[8 * c] = o[8 * c] * alpha + p * bflo(w.x); o[8 * c + 1] = o[8 * c + 1] * alpha + p * bfhi(w.x); o[8 * c + 2] = o[8 * c + 2] * alpha + p * bflo(w.y); o[8 * c + 3] = o[8 * c + 3] * alpha + p * bfhi(w.y);
                    o[8 * c + 4] = o[8 * c + 4] * alpha + p * bflo(w.z); o[8 * c + 5] = o[8 * c + 5] * alpha + p * bfhi(w.z); o[8 * c + 6] = o[8 * c + 6] * alpha + p * bflo(w.w); o[8 * c + 7] = o[8 * c + 7] * alpha + p * bfhi(w.w); }
            }
        }
        if (LAYER == 1) l += exp2f(F.in[I_SINK][h] * LOG2E - mx);
        const float il = 1.f / l;
        if (valid) { u32x4* op = (u32x4*)(AO + (size_t)row * 1024 + h * 64);
#pragma unroll
            for (int c = 0; c < 8; ++c) { u32x4 w; w.x = pk2(o[8 * c] * il, o[8 * c + 1] * il); w.y = pk2(o[8 * c + 2] * il, o[8 * c + 3] * il); w.z = pk2(o[8 * c + 4] * il, o[8 * c + 5] * il); w.w = pk2(o[8 * c + 6] * il, o[8 * c + 7] * il); op[c] = w; } }
    }
}

#include <hip/hip_bf16.h>
namespace attn_body {
using bf16=__hip_bfloat16;
using s16x4=__attribute__((ext_vector_type(4)))short;
using f32x16=__attribute__((ext_vector_type(16)))float;
constexpr int NW=8,QBLK=32,QB=QBLK*NW,KVBLK=64;
constexpr int QP=512,KP=128,OP=1024;
__device__ __forceinline__ int crow(int r,int hi){return (r&3)+8*(r>>2)+4*hi;}
#define SBAR() __builtin_amdgcn_sched_barrier(0)
__device__ __forceinline__ void wmask(f32x16&p0,f32x16&p1,int dlt0,int hi){
  const float NEG=-INFINITY; const int kb=dlt0+4*hi;
  #pragma unroll
  for(int r=0;r<16;++r){const int d=kb+(r&3)+8*(r>>2); if(d>128||d<-128)p0[r]=NEG; if(d+32>128||d+32<-128)p1[r]=NEG;}
}

constexpr int NSLOT=3, SLOTB=8192;
constexpr int LDS_K=0, LDS_V=NSLOT*SLOTB, LDS_WS=2*NSLOT*SLOTB, LDS_OST=LDS_WS+NW*64*4, LDS_BYTES=LDS_OST+NW*4096;
__device__ __forceinline__ void glds16(const void*gsrc,unsigned lds_dst){unsigned keep;
  asm volatile("s_mov_b32 %0, m0\n\ts_mov_b32 m0, %2\n\ts_nop 0\n\tglobal_load_lds_dwordx4 %1, off\n\ts_mov_b32 m0, %0":"=&s"(keep):"v"(gsrc),"s"(lds_dst):"memory");}
__device__ __forceinline__ float max3f(float a,float b,float c){float r;asm("v_max3_f32 %0, %1, %2, %3":"=v"(r):"v"(a),"v"(b),"v"(c));return r;}
__device__ __forceinline__ float max2f(float a,float b){float r;asm("v_max_f32_e32 %0, %1, %2":"=v"(r):"v"(a),"v"(b));return r;}
__device__ __forceinline__ float fadd_s(float a,float b){float r;asm("v_add_f32_e32 %0, %1, %2":"=v"(r):"v"(a),"v"(b));return r;}
__device__ __forceinline__ float fsub_s(float a,float b){float r;asm("v_sub_f32_e32 %0, %1, %2":"=v"(r):"v"(a),"v"(b));return r;}
typedef float f32x2_t __attribute__((ext_vector_type(2))); typedef __bf16 bf16x2_t __attribute__((ext_vector_type(2)));
__device__ __forceinline__ unsigned cvtpk_s(float lo,float hi){f32x2_t v={lo,hi};bf16x2_t b=__builtin_convertvector(v,bf16x2_t);return __builtin_bit_cast(unsigned,b);}
#define WAIT_BAR(N) asm volatile("s_waitcnt vmcnt(" #N ") lgkmcnt(0)\n\ts_barrier":::"memory")

__device__ __forceinline__ void qkt(f32x16&p0,f32x16&p1,const char*Kslot,const bf16x8*qr,const f32x16&negm,int r32,int hi){
  const char*kb=Kslot+hi*1024+r32*16;
  #pragma unroll
  for(int d0=0;d0<4;++d0){
    const bf16x8 b0=*reinterpret_cast<const bf16x8*>(kb+d0*2048);
    const bf16x8 b1=*reinterpret_cast<const bf16x8*>(kb+d0*2048+512);
    if(d0==0){p0=__builtin_amdgcn_mfma_f32_32x32x16_bf16(b0,qr[0],negm,0,0,0);p1=__builtin_amdgcn_mfma_f32_32x32x16_bf16(b1,qr[0],negm,0,0,0);}
    else{p0=__builtin_amdgcn_mfma_f32_32x32x16_bf16(b0,qr[d0],p0,0,0,0);p1=__builtin_amdgcn_mfma_f32_32x32x16_bf16(b1,qr[d0],p1,0,0,0);}}
}
typedef __attribute__((address_space(3))) const char* lds_cptr;
typedef short v4i16_t __attribute__((ext_vector_type(4)));
__device__ __forceinline__ void kload8(bf16x8*kf,lds_cptr kp){
  kf[0]=*(const __attribute__((address_space(3))) bf16x8*)(kp);      kf[1]=*(const __attribute__((address_space(3))) bf16x8*)(kp+512);
  kf[2]=*(const __attribute__((address_space(3))) bf16x8*)(kp+2048); kf[3]=*(const __attribute__((address_space(3))) bf16x8*)(kp+2560);
  kf[4]=*(const __attribute__((address_space(3))) bf16x8*)(kp+4096); kf[5]=*(const __attribute__((address_space(3))) bf16x8*)(kp+4608);
  kf[6]=*(const __attribute__((address_space(3))) bf16x8*)(kp+6144); kf[7]=*(const __attribute__((address_space(3))) bf16x8*)(kp+6656);
}
__device__ __forceinline__ void kload2(bf16x8*kf,lds_cptr kp,int j){ kf[2*j]=*(const __attribute__((address_space(3))) bf16x8*)(kp+j*2048); kf[2*j+1]=*(const __attribute__((address_space(3))) bf16x8*)(kp+j*2048+512); }
__device__ __forceinline__ s16x4 vtr(lds_cptr p){ return __builtin_bit_cast(s16x4,__builtin_amdgcn_ds_read_tr16_b64_v4i16((__attribute__((address_space(3))) v4i16_t*)p)); }
__device__ __forceinline__ float rowmax(const f32x16&p0,const f32x16&p1){
  float a=max3f(p0[0],p0[1],p1[0]),b=max3f(p0[2],p0[3],p1[1]);a=max3f(a,p1[2],p1[3]);
  #pragma unroll
  for(int r=4;r<16;r+=4){a=max3f(a,p0[r],p0[r+1]);b=max3f(b,p0[r+2],p0[r+3]);a=max3f(a,p1[r],p1[r+1]);b=max3f(b,p1[r+2],p1[r+3]);}
  const float m=max2f(a,b);
  auto rr=__builtin_amdgcn_permlane32_swap(__float_as_uint(m),__float_as_uint(m),false,false);
  return max2f(__uint_as_float(rr[0]),__uint_as_float(rr[1]));
}
__device__ __forceinline__ void pv(f32x16*o,int vb,bf16x8 pa0,bf16x8 pa1,bf16x8 pa2,bf16x8 pa3){
  #pragma unroll
  for(int d0=0;d0<2;++d0){s16x4 lo[4],hi[4];
    #pragma unroll
    for(int ks=0;ks<4;++ks){
      asm volatile("ds_read_b64_tr_b16 %0,%1 offset:%c2":"=&v"(lo[ks]):"v"(vb),"i"(d0*4096+ks*1024):"memory");
      asm volatile("ds_read_b64_tr_b16 %0,%1 offset:%c2":"=&v"(hi[ks]):"v"(vb),"i"(d0*4096+ks*1024+512):"memory");}
    asm volatile("s_waitcnt lgkmcnt(0)":::"memory");SBAR();
    #define PK(k) (bf16x8){lo[k][0],lo[k][1],lo[k][2],lo[k][3],hi[k][0],hi[k][1],hi[k][2],hi[k][3]}
    o[d0]=__builtin_amdgcn_mfma_f32_32x32x16_bf16(pa0,PK(0),o[d0],0,0,0);
    o[d0]=__builtin_amdgcn_mfma_f32_32x32x16_bf16(pa1,PK(1),o[d0],0,0,0);
    o[d0]=__builtin_amdgcn_mfma_f32_32x32x16_bf16(pa2,PK(2),o[d0],0,0,0);
    o[d0]=__builtin_amdgcn_mfma_f32_32x32x16_bf16(pa3,PK(3),o[d0],0,0,0);
    #undef PK
  }
}

#ifndef ATTN_STORE16
#define ATTN_STORE16(p,v) (*(u32x4*)(p)=(v))
#endif
template<int MODE,int THRL> __device__ __forceinline__ void attn_unit(const bf16*Qu,const bf16*__restrict__ Kh,const bf16*__restrict__ Vh,bf16*Ou,const int NT,const int lat0,const int q0s,const float sinkl2,const float*qg,const float*ropec,const bool rope,char*shm){
  int tid_=threadIdx.x; asm volatile("":"+v"(tid_));
  const int tid=tid_,lane=tid&63,r32=lane&31,hi=lane>>5; const int wid=__builtin_amdgcn_readfirstlane(tid>>6);
  const bf16*Qw=Qu+(long)(wid*QBLK)*QP;
  const unsigned lds0=(unsigned)(uintptr_t)shm;
  float*wsf=(float*)(shm+LDS_WS)+wid*64;
  const bf16*ksrc=Kh+(long)lane*KP+wid*8;
  const bf16*vsrc=Vh+(long)(16*(wid&3)+(lane>>2))*KP+(wid>>2)*32+(lane&3)*8;
  const unsigned kdst=lds0+LDS_K+wid*1024, vdst=lds0+LDS_V+wid*1024;
  #define TROW(t) ((MODE==0||(t)<4)?(t)*KVBLK:lat0+((t)-4)*KVBLK)
  #define DMA_K(t,slot) glds16(ksrc+(long)TROW(t)*KP,(unsigned)__builtin_amdgcn_readfirstlane(kdst+(slot)))
  #define DMA_V(t,slot) glds16(vsrc+(long)TROW(t)*KP,(unsigned)__builtin_amdgcn_readfirstlane(vdst+(slot)))
  const int vb0=(int)(lds0+LDS_V)+((lane>>4)&1)*32+(lane&3)*8+(4*hi+((lane&15)>>2))*64;
  const char*Kbase=shm+LDS_K; bf16x8 kf[8];
  const lds_cptr shm3=(lds_cptr)shm; const lds_cptr kp0=shm3+LDS_K+hi*1024+r32*16; const lds_cptr vp0=shm3+LDS_V+((lane>>4)&1)*32+(lane&3)*8+(4*hi+((lane&15)>>2))*64;
  DMA_K(0,0);DMA_V(0,0);DMA_K(1,SLOTB);
  bf16x8 qr[4];
  const int qpos=q0s+wid*QBLK+r32;
  {
    u32x4 qraw[4];
    #pragma unroll
    for(int d0=0;d0<4;++d0) qraw[d0]=*reinterpret_cast<const u32x4*>(&Qw[(long)r32*QP+d0*16+hi*8]);
    float x[4][8]; float ss=0.f;
    #pragma unroll
    for(int d0=0;d0<4;++d0){ x[d0][0]=bflo(qraw[d0].x);x[d0][1]=bfhi(qraw[d0].x);x[d0][2]=bflo(qraw[d0].y);x[d0][3]=bfhi(qraw[d0].y);x[d0][4]=bflo(qraw[d0].z);x[d0][5]=bfhi(qraw[d0].z);x[d0][6]=bflo(qraw[d0].w);x[d0][7]=bfhi(qraw[d0].w);
      #pragma unroll
      for(int j=0;j<8;++j)ss+=x[d0][j]*x[d0][j]; }
    {auto rr=__builtin_amdgcn_permlane32_swap(__float_as_uint(ss),__float_as_uint(ss),false,false);ss=__uint_as_float(rr[0])+__uint_as_float(rr[1]);}
    const float rms=C2/sqrtf(ss*(1.f/64.f)+EPS);
    SBAR();
    #pragma unroll
    for(int d0=0;d0<2;++d0){
      #pragma unroll
      for(int hf=0;hf<2;++hf){
        const f32x4 ga=*reinterpret_cast<const f32x4*>(qg+d0*16+hi*8+4*hf), gb=*reinterpret_cast<const f32x4*>(qg+(d0+2)*16+hi*8+4*hf);
        f32x4 cc=f32x4{1.f,1.f,1.f,1.f}, sn=f32x4{0.f,0.f,0.f,0.f};
        if(rope){ const float*pc=ropec+(long)qpos*32+d0*16+hi*8+4*hf; cc=*reinterpret_cast<const f32x4*>(pc); sn=*reinterpret_cast<const f32x4*>(pc+SEQ*32); }
        #pragma unroll
        for(int j=0;j<4;++j){ const float a=x[d0][4*hf+j]*rms*ga[j], b=x[d0+2][4*hf+j]*rms*gb[j]; x[d0][4*hf+j]=a*cc[j]-b*sn[j]; x[d0+2][4*hf+j]=b*cc[j]+a*sn[j]; }
        SBAR(); } }
    #pragma unroll
    for(int d0=0;d0<4;++d0){ u32x4 w; w.x=cvtpk_s(x[d0][0],x[d0][1]);w.y=cvtpk_s(x[d0][2],x[d0][3]);w.z=cvtpk_s(x[d0][4],x[d0][5]);w.w=cvtpk_s(x[d0][6],x[d0][7]); qr[d0]=__builtin_bit_cast(bf16x8,w); } }
  float mhat=0.f,l_reg=0.f;f32x16 o[2],negm; { float z_=0.f; asm volatile("":"+v"(z_));
    #pragma unroll
    for(int r=0;r<16;++r){o[0][r]=z_;o[1][r]=z_;negm[r]=z_;} } asm volatile("":"+v"(negm));
  #define CMASK(P0,P1,t) do{ if(MODE==1&&(t)>=4) wmask(P0,P1,(lat0-256)+((t)-4)*KVBLK-qpos,hi); }while(0)
  bool resc=false;
  #define START(P0,P1) do{ const float rm=rowmax(P0,P1); resc=false; \
    { const float dl=rm; mhat=fadd_s(mhat,dl); \
      _Pragma("unroll") for(int r=0;r<16;++r){P0[r]=fsub_s(P0[r],dl);P1[r]=fsub_s(P1[r],dl);} \
      _Pragma("unroll") for(int r=0;r<16;++r)negm[r]=-mhat; asm volatile("":"+v"(negm)); } \
    _Pragma("unroll") for(int r=0;r<16;++r)P0[r]=__builtin_amdgcn_exp2f(P0[r]); }while(0)
  #define RESC() do{ if(resc){ asm volatile("s_waitcnt lgkmcnt(0)":::"memory"); \
      _Pragma("unroll") for(int d_=0;d_<2;++d_) _Pragma("unroll") for(int r=0;r<16;++r)o[d_][r]*=wsf[crow(r,hi)]; } }while(0)
  f32x16 pA0,pA1,pB0,pB1;
  int sl_prev=0,sl_cur=0,sl_next=SLOTB;
  #define ROT() do{sl_prev=sl_cur;sl_cur=sl_next;sl_next=(sl_next==(NSLOT-1)*SLOTB)?0:sl_next+SLOTB;}while(0)
  DMA_K(2,2*SLOTB);
  WAIT_BAR(3);
  qkt(pA0,pA1,Kbase,qr,negm,r32,hi);asm volatile("s_nop 15\n\ts_nop 7":"+v"(pA0),"+v"(pA1));CMASK(pA0,pA1,0);
  START(pA0,pA1);
  _Pragma("unroll") for(int r=0;r<16;++r)pA1[r]=__builtin_amdgcn_exp2f(pA1[r]);
  WAIT_BAR(0);
  DMA_K(3,0);DMA_V(1,SLOTB);
  ROT();
  kload8(kf,kp0+sl_cur);
  WAIT_BAR(2);
  s16x4 vlo[8],vhi[8]; u32x4 pw0,pw1,pw2,pw3;
  #define PKW(P,B) cvtpk_s(P[B],P[B+1])
  #define PAF(k) __builtin_bit_cast(bf16x8,pw##k)
  #define VFR(i) (bf16x8){vlo[i][0],vlo[i][1],vlo[i][2],vlo[i][3],vhi[i][0],vhi[i][1],vhi[i][2],vhi[i][3]}
  #define PIN(x) asm volatile("":"+v"(x))
  #define MX3(a,b,c) __builtin_fmaxf(__builtin_fmaxf((a),(b)),(c))
  #define GAPA(MF,A0,A1,A2,A3,W0,W1,PW) do{ MF; sacc+=A0; sacc+=A1; sacc+=A2; sacc+=A3; PIN(sacc); W0; W1; PIN(PW); SBAR(); }while(0)
  #define EX(v) __builtin_amdgcn_exp2f(v)
  #define GAPB(MF,X,B) do{ MF; X[B]=EX(X[B]); X[B+1]=EX(X[B+1]); X[B+2]=EX(X[B+2]); X[B+3]=EX(X[B+3]); PIN(X); SBAR(); }while(0)
  #define VRD(i) do{ vlo[i]=vtr(vp_+(((i)>>2)*4096+((i)&3)*1024)); vhi[i]=vtr(vp_+(((i)>>2)*4096+((i)&3)*1024+512)); }while(0)
  #define KRD(G,j) do{ if(G){ kload2(kf,kp0+sl_next,j); SBAR(); } }while(0)
  #define STEP(C0,C1,P0,P1,t,GK,GV,GL) do{ SBAR(); \
    const lds_cptr vp_=vp0+sl_prev; \
    VRD(0); SBAR(); float sacc=(P0[0]+P0[1]); \
    GAPA(C0=__builtin_amdgcn_mfma_f32_32x32x16_bf16(kf[0],qr[0],negm,0,0,0), P0[2],P0[3],P0[4],P0[5],     pw0[0]=PKW(P0,0), pw0[1]=PKW(P0,2), pw0); \
    VRD(4); SBAR(); GAPA(C1=__builtin_amdgcn_mfma_f32_32x32x16_bf16(kf[1],qr[0],negm,0,0,0), P0[6],P0[7],P0[8],P0[9],     pw0[2]=PKW(P0,4), pw0[3]=PKW(P0,6), pw0); \
    VRD(1); SBAR(); GAPA(C0=__builtin_amdgcn_mfma_f32_32x32x16_bf16(kf[2],qr[1],C0,0,0,0),   P0[10],P0[11],P0[12],P0[13], pw1[0]=PKW(P0,8), pw1[1]=PKW(P0,10), pw1); \
    VRD(5); SBAR(); GAPA(C1=__builtin_amdgcn_mfma_f32_32x32x16_bf16(kf[3],qr[1],C1,0,0,0),   P0[14],P0[15],P1[0],P1[1],   pw1[2]=PKW(P0,12),pw1[3]=PKW(P0,14), pw1); \
    VRD(2); SBAR(); GAPA(C0=__builtin_amdgcn_mfma_f32_32x32x16_bf16(kf[4],qr[2],C0,0,0,0),   P1[2],P1[3],P1[4],P1[5],     pw2[0]=PKW(P1,0), pw2[1]=PKW(P1,2), pw2); \
    VRD(6); SBAR(); GAPA(C1=__builtin_amdgcn_mfma_f32_32x32x16_bf16(kf[5],qr[2],C1,0,0,0),   P1[6],P1[7],P1[8],P1[9],     pw2[2]=PKW(P1,4), pw2[3]=PKW(P1,6), pw2); \
    VRD(3); SBAR(); GAPA(C0=__builtin_amdgcn_mfma_f32_32x32x16_bf16(kf[6],qr[3],C0,0,0,0),   P1[10],P1[11],P1[12],P1[13], pw3[0]=PKW(P1,8), pw3[1]=PKW(P1,10), pw3); \
    VRD(7); SBAR(); GAPA(C1=__builtin_amdgcn_mfma_f32_32x32x16_bf16(kf[7],qr[3],C1,0,0,0),   P1[14],P1[15],0.f,0.f,       pw3[2]=PKW(P1,12),pw3[3]=PKW(P1,14), pw3); \
    l_reg+=sacc; \
    if(GK){DMA_K((t)+3,sl_cur);} if(GV){DMA_V((t)+1,sl_next);} \
    CMASK(C0,C1,t); \
    { float a=MX3(C0[0],C0[1],C1[0]),b=MX3(C0[2],C0[3],C1[1]); a=MX3(a,C1[2],C1[3]); \
      _Pragma("unroll") for(int r=4;r<16;r+=4){a=MX3(a,C0[r],C0[r+1]);b=MX3(b,C0[r+2],C0[r+3]);a=MX3(a,C1[r],C1[r+1]);b=MX3(b,C1[r+2],C1[r+3]);} \
      float rm=__builtin_fmaxf(a,b); { auto rr=__builtin_amdgcn_permlane32_swap(__float_as_uint(rm),__float_as_uint(rm),false,false); rm=__builtin_fmaxf(__uint_as_float(rr[0]),__uint_as_float(rr[1])); } \
      resc=false; \
      if(__builtin_expect(__any(rm>(float)THRL),0)){ const float dl=__builtin_fmaxf(rm,0.f); mhat+=dl; \
        _Pragma("unroll") for(int r=0;r<16;++r){C0[r]-=dl;C1[r]-=dl;} \
        _Pragma("unroll") for(int r=0;r<16;++r)negm[r]=-mhat; asm volatile("":"+v"(negm)); \
        const float f=__builtin_amdgcn_exp2f(-dl); l_reg*=f; if(hi==0)wsf[r32]=f; resc=true; } } \
    SBAR(); \
    GAPB(o[0]=__builtin_amdgcn_mfma_f32_32x32x16_bf16(PAF(0),VFR(0),o[0],0,0,0), C0,0); \
    GAPB(o[1]=__builtin_amdgcn_mfma_f32_32x32x16_bf16(PAF(0),VFR(4),o[1],0,0,0), C0,4); \
    KRD(GL,0); GAPB(o[0]=__builtin_amdgcn_mfma_f32_32x32x16_bf16(PAF(1),VFR(1),o[0],0,0,0), C0,8); \
    KRD(GL,1); GAPB(o[1]=__builtin_amdgcn_mfma_f32_32x32x16_bf16(PAF(1),VFR(5),o[1],0,0,0), C0,12); \
    KRD(GL,2); GAPB(o[0]=__builtin_amdgcn_mfma_f32_32x32x16_bf16(PAF(2),VFR(2),o[0],0,0,0), C1,0); \
    KRD(GL,3); GAPB(o[1]=__builtin_amdgcn_mfma_f32_32x32x16_bf16(PAF(2),VFR(6),o[1],0,0,0), C1,4); \
    GAPB(o[0]=__builtin_amdgcn_mfma_f32_32x32x16_bf16(PAF(3),VFR(3),o[0],0,0,0), C1,8); \
    GAPB(o[1]=__builtin_amdgcn_mfma_f32_32x32x16_bf16(PAF(3),VFR(7),o[1],0,0,0), C1,12); \
    }while(0)
  int t=1;
  for(;t+5<NT;t+=2){
    STEP(pB0,pB1,pA0,pA1,t,true,true,true);     WAIT_BAR(2); RESC(); ROT();
    STEP(pA0,pA1,pB0,pB1,t+1,true,true,true);   WAIT_BAR(2); RESC(); ROT();
  }
  #define ENDW(tt) do{ if((tt)+3<NT){WAIT_BAR(2);} else if((tt)+2<NT){WAIT_BAR(1);} else {WAIT_BAR(0);} }while(0)
  for(;t+1<NT;t+=2){
    STEP(pB0,pB1,pA0,pA1,t,(t+3<NT),(t+1<NT),(t+1<NT));       ENDW(t);   RESC(); ROT();
    STEP(pA0,pA1,pB0,pB1,t+1,(t+4<NT),(t+2<NT),(t+2<NT));     ENDW(t+1); RESC(); ROT();
  }
  STEP(pB0,pB1,pA0,pA1,NT-1,false,false,false); RESC();
  { float sacc=pB0[0]+pB0[1]; _Pragma("unroll") for(int r=2;r<16;++r)sacc+=pB0[r]; _Pragma("unroll") for(int r=0;r<16;++r)sacc+=pB1[r]; l_reg+=sacc;
    pw0=(u32x4){PKW(pB0,0),PKW(pB0,2),PKW(pB0,4),PKW(pB0,6)};pw1=(u32x4){PKW(pB0,8),PKW(pB0,10),PKW(pB0,12),PKW(pB0,14)};pw2=(u32x4){PKW(pB1,0),PKW(pB1,2),PKW(pB1,4),PKW(pB1,6)};pw3=(u32x4){PKW(pB1,8),PKW(pB1,10),PKW(pB1,12),PKW(pB1,14)};
    SBAR(); pv(o,vb0+sl_cur,PAF(0),PAF(1),PAF(2),PAF(3)); }
  #undef PKW
  #undef PAF
  #undef VFR
  #undef PIN
  #undef MX3
  #undef GAPA
  #undef GAPB
  #undef EX
  #undef VRD
  #undef KRD
  #undef STEP
  #undef ENDW
  {auto rr=__builtin_amdgcn_permlane32_swap(__float_as_uint(l_reg),__float_as_uint(l_reg),false,false);l_reg=__uint_as_float(rr[0])+__uint_as_float(rr[1]);}
  if(MODE==1)l_reg+=__builtin_amdgcn_exp2f(sinkl2-mhat);
  if(hi==0)wsf[32+r32]=l_reg;asm volatile("s_waitcnt lgkmcnt(0)":::"memory");
  float rli[16];
  #pragma unroll
  for(int r=0;r<16;++r)rli[r]=__builtin_amdgcn_rcpf(wsf[32+crow(r,hi)]);
  bf16*Ow=Ou+(long)(wid*QBLK)*OP;
  { bf16*stg=(bf16*)(shm+LDS_OST)+wid*2048;
    #pragma unroll
    for(int r=0;r<16;++r){const int orow=crow(r,hi);
      #pragma unroll
      for(int d0=0;d0<2;++d0)stg[orow*64+d0*32+r32]=__float2bfloat16(o[d0][r]*rli[r]);}
    asm volatile("s_waitcnt lgkmcnt(0)":::"memory");
    #pragma unroll
    for(int i=0;i<4;++i){const int row=i*8+(lane>>3),ch=lane&7; const u32x4 v=*(const u32x4*)(stg+row*64+ch*8); ATTN_STORE16(Ow+(long)row*OP+ch*8,v);} }
  asm volatile("s_waitcnt lgkmcnt(0)\n\ts_barrier":::"memory");
  #undef DMA_K
  #undef TROW
  #undef DMA_V
  #undef CMASK
  #undef START
  #undef RESC
  #undef ROT
}
#undef SBAR
#undef WAIT_BAR
}

template <int LAYER> __device__ __forceinline__ void attn_fast(const Frame& F, char* shm) {
    using attn_body::bf16;
    const bf16* Q = (const bf16*)(F.ws + WS_Q); const bf16* Kn = (const bf16*)(F.ws + WS_KN); const bf16* Vn = (const bf16*)(F.ws + WS_VN); bf16* AO = (bf16*)(F.ws + WS_AO);
    const int nunits = LAYER == 0 ? 1024 + 64 : 1024;
    for (int U = F.vcu; U < nunits; U += F.G) {
        int b, h, NT, lat0 = 0, q0 = 0; size_t row0;
        if (U < 1024) { b = U >> 7; h = ((U >> 6) & 1) * 4 + ((U >> 4) & 3); q0 = (U & 15) * 256; row0 = (size_t)b * SEQ + q0;
            if (LAYER == 0) NT = KVS / 64;
            else { int lo = q0 - 128, hi = q0 + 384; lo = lo < 0 ? 0 : lo; hi = hi > SEQ ? SEQ : hi; NT = 4 + (hi - lo) / 64; lat0 = CTXL + lo; } }
        else { const int uc = U - 1024; b = uc >> 3; h = uc & 7; row0 = (size_t)TX + (size_t)b * CTXL; NT = 4; }
        const bf16* Kh = Kn + (size_t)b * KVS * 128 + (h >> 2) * 64; const bf16* Vh = Vn + (size_t)b * KVS * 128 + (h >> 2) * 64;
        const float sinkl2 = LAYER == 1 ? F.in[I_SINK][h] * LOG2E : 0.f;
        if (LAYER == 0 && F.G == 256 && U < 1024 && (U >> 8) == (F.vcu & 3)) {
            const int per = (TN_ITEMS - TN_DENSE + 255) / 256, lo = TN_DENSE + F.vcu * per; int hi = lo + per; hi = hi > TN_ITEMS ? TN_ITEMS : hi;
            Frame Fc = F; asm volatile("" : "+v"(Fc.lane), "+v"(Fc.tid));
            transpose_range(Fc, lo, hi, Fc.wave, NWAVES);
            __syncthreads(); }
        attn_body::attn_unit<LAYER, 8>(Q + row0 * 512 + h * 64, Kh, Vh, AO + row0 * 1024 + h * 64, NT, lat0, q0, sinkl2, F.in[LAYER == 0 ? I_QNA : I_QNC], (const float*)(F.ws + WS_ROPE), U < 1024, shm);
    }
}

template <int DRY> __device__ __forceinline__ void p_router(const Frame& F, int l, int ntok) {
    const int gw = F.vcu * NWAVES + F.wave, NGW = F.G * NWAVES, lane = F.lane, tk = lane & 15, kq = lane >> 4;
    bf16_t* HX = F.hx(); const float* SS = (const float*)(F.ws + WS_SS);
    const float* gb = F.in[I_RGB] + l * 4; const float* eb = F.in[I_REB] + l * 32;
    unsigned* tokslot = (unsigned*)(F.ws + (DRY ? WS_HID : WS_TOK)); float* tokw = (float*)(F.ws + (DRY ? WS_HID : WS_TOK) + 512 * 1024); unsigned* list = (unsigned*)(F.ws + (DRY ? WS_HID + 2 * MiB : WS_LIST));
    unsigned* cnt = F.cnt(DRY ? l + 2 : l);
    {
        const u32x4* src = (const u32x4*)((const bf16_t*)(F.ws + WS_WR) + (size_t)l * 2 * 36864);
        u32x4 t[18];
#pragma unroll
        for (int i = 0; i < 18; ++i) t[i] = src[F.tid + i * NTHREADS];
        __syncthreads();
#pragma unroll
        for (int i = 0; i < 18; ++i) *(LAS u32x4*)(F.lds + (F.tid + i * NTHREADS) * 16) = t[i];
    }
    const LAS unsigned char* wl0 = F.lds + lane * 16;
    const LAS unsigned char* wl2 = F.lds + 2048 + ((tk >> 2) * 4 + kq) * 16;
    LAS unsigned* lcnt = (LAS unsigned*)(F.lds + LDS_TAB + 2048 + 8192); LAS unsigned* lbase = lcnt + 32;
    LAS float* gps = (LAS float*)(F.lds + LDS_TAB + 2048);
    const int nrounds = (ntok / 16 + NGW - 1) / NGW;
    for (int rd = 0; rd < nrounds; ++rd) {
        const int grp0 = F.vcu * NWAVES + rd * NGW, grp = grp0 + F.wave;
        __syncthreads();
        if (F.tid < 32) lcnt[F.tid] = 0u;
        if (grp0 < ntok / 16) { const int r0 = modrow(grp0 * 16); const float* gpg = (const float*)(F.ws + WS_GP) + (size_t)(l * 9 + r0) * 1024; const float* shg = F.mod(l, r0, 3);
            *(LAS f32x4*)(gps + 4 * F.tid) = F.tid < 256 ? *(const f32x4*)(gpg + 4 * F.tid) : *(const f32x4*)(shg + 4 * (F.tid - 256)); }
        __syncthreads();
        const bool active = grp < ntok / 16;
        const int row = (active ? grp : 0) * 16 + tk;
        bool win = false; int e1 = 0, e2 = 0; float w1 = 0.f, w2 = 0.f; unsigned p1 = 0u, p2 = 0u;
        if (active) {
        const bf16_t* xr = F.xr_row(row) + 8 * kq;
        u32x4 xq[16];
#define R_XLOAD(i, st) do { const int s_ = (st) < 32 ? (st) : 31; if (DRY != 5) xq[i] = *(const u32x4*)(xr + s_ * 32); else xq[i] = (u32x4){(unsigned)s_, 1u, 2u, 3u}; } while (0)
#pragma unroll
        for (int i = 0; i < 16; ++i) R_XLOAD(i, i);
        float ssum = 0.f;
#pragma unroll
        for (int i = 0; i < 4; ++i) { const f32x4 p = *(const f32x4*)(SS + (size_t)row * 16 + 4 * i); ssum += (p[0] + p[1]) + (p[2] + p[3]); }
        const float rms = 1.0f / sqrtf(ssum * (1.f / 1024.f) + EPS);
        f32x4 acc[3];
#pragma unroll
        for (int n = 0; n < 3; ++n) acc[n] = (f32x4){0.f, 0.f, 0.f, 0.f};
        bf16_t* hxr = HX + (size_t)row * DM + 8 * kq;
        const LAS float* gpl = gps + 8 * kq;
#define R_STEP(i, st) do { const u32x4 xb_ = xq[i]; \
            const f32x4 m0 = *(const LAS f32x4*)(gpl + (st) * 32), m1 = *(const LAS f32x4*)(gpl + (st) * 32 + 4), m2 = *(const LAS f32x4*)(gpl + 1024 + (st) * 32), m3 = *(const LAS f32x4*)(gpl + 1024 + (st) * 32 + 4); \
            const f32x4 xf0 = (f32x4){bflo(xb_.x), bfhi(xb_.x), bflo(xb_.y), bfhi(xb_.y)}, xf1 = (f32x4){bflo(xb_.z), bfhi(xb_.z), bflo(xb_.w), bfhi(xb_.w)}; \
            const f32x4 h0 = (xf0 * rms) * m0 + m2, h1 = (xf1 * rms) * m1 + m3; \
            u32x4 hh; hh.x = pk2(h0[0], h0[1]); hh.y = pk2(h0[2], h0[3]); hh.z = pk2(h1[0], h1[1]); hh.w = pk2(h1[2], h1[3]); \
            if (DRY != 4) *(u32x4*)(hxr + (st) * 32) = hh; else if (hh.x == 0x12345678u) *(u32x4*)(hxr + (st) * 32) = hh; \
            if (DRY < 3 || DRY >= 6) { \
            u32x4 hl; hl.x = pk2(h0[0] - bflo(hh.x), h0[1] - bfhi(hh.x)); hl.y = pk2(h0[2] - bflo(hh.y), h0[3] - bfhi(hh.y)); hl.z = pk2(h1[0] - bflo(hh.z), h1[1] - bfhi(hh.z)); hl.w = pk2(h1[2] - bflo(hh.w), h1[3] - bfhi(hh.w)); \
            const bf16x8 bh = __builtin_bit_cast(bf16x8, hh), bl = __builtin_bit_cast(bf16x8, hl); \
            bf16x8 w0h, w1h, w2h, w0l, w1l, w2l; if (DRY == 6) { w0h = w1h = w2h = w0l = w1l = w2l = bh; } else { w0h = *(const LAS bf16x8*)(wl0 + (st) * 2304); w1h = *(const LAS bf16x8*)(wl0 + (st) * 2304 + 1024); w2h = *(const LAS bf16x8*)(wl2 + (st) * 2304); \
            w0l = *(const LAS bf16x8*)(wl0 + RW_BYTES + (st) * 2304); w1l = *(const LAS bf16x8*)(wl0 + RW_BYTES + (st) * 2304 + 1024); w2l = *(const LAS bf16x8*)(wl2 + RW_BYTES + (st) * 2304); } \
            if (DRY == 7) { const bf16x8 sx = w0h ^ w1h ^ w2h ^ w0l ^ w1l ^ w2l ^ bl; acc[0][0] += (float)sx[0]; } else \
            acc[0] = __builtin_amdgcn_mfma_f32_16x16x32_bf16(w0h, bh, acc[0], 0, 0, 0); acc[1] = __builtin_amdgcn_mfma_f32_16x16x32_bf16(w1h, bh, acc[1], 0, 0, 0); acc[2] = __builtin_amdgcn_mfma_f32_16x16x32_bf16(w2h, bh, acc[2], 0, 0, 0); \
            acc[0] = __builtin_amdgcn_mfma_f32_16x16x32_bf16(w0h, bl, acc[0], 0, 0, 0); acc[1] = __builtin_amdgcn_mfma_f32_16x16x32_bf16(w1h, bl, acc[1], 0, 0, 0); acc[2] = __builtin_amdgcn_mfma_f32_16x16x32_bf16(w2h, bl, acc[2], 0, 0, 0); \
            acc[0] = __builtin_amdgcn_mfma_f32_16x16x32_bf16(w0l, bh, acc[0], 0, 0, 0); acc[1] = __builtin_amdgcn_mfma_f32_16x16x32_bf16(w1l, bh, acc[1], 0, 0, 0); acc[2] = __builtin_amdgcn_mfma_f32_16x16x32_bf16(w2l, bh, acc[2], 0, 0, 0); } } while (0)
        for (int st = 0; st < 32; st += 16) {
#pragma unroll
            for (int i = 0; i < 16; ++i) { R_STEP(i, st + i); R_XLOAD(i, st + i + 16); }
        }
#undef R_XLOAD
#undef R_STEP
        if (DRY >= 6 && acc[0][0] + acc[1][1] + acc[2][2] == 123.456f) tokw[row] = 1.f;
        if (DRY < 2) {
            const float lgk = acc[2][0] + gb[kq];
            const float la = __shfl_xor(lgk, 16), lb = __shfl_xor(lgk, 32), lc = __shfl_xor(la, 32);
            const float gm = fmaxf(fmaxf(lgk, la), fmaxf(lb, lc));
            win = (lgk == gm);
            win = win && !(la == gm && (kq ^ 1) < kq) && !(lb == gm && (kq ^ 2) < kq) && !(lc == gm && (kq ^ 3) < kq);
            if (win) {
                const float g_w = 1.f / (expf(lgk - gm) + expf(la - gm) + expf(lb - gm) + expf(lc - gm));
                float el[8];
                { const f32x4 b0 = *(const f32x4*)(eb + 8 * kq), b1 = *(const f32x4*)(eb + 8 * kq + 4);
#pragma unroll
                  for (int i = 0; i < 4; ++i) { el[i] = acc[0][i] + b0[i]; el[4 + i] = acc[1][i] + b1[i]; } }
                int i1 = 0; float m1 = el[0];
#pragma unroll
                for (int i = 1; i < 8; ++i) if (el[i] > m1) { m1 = el[i]; i1 = i; }
                int i2 = 0; float m2 = -3.0e38f;
#pragma unroll
                for (int i = 0; i < 8; ++i) if (i != i1 && el[i] > m2) { m2 = el[i]; i2 = i; }
                const float pp = expf(m2 - m1); w1 = g_w / (1.f + pp); w2 = g_w * pp / (1.f + pp);
                e1 = kq * 8 + i1; e2 = kq * 8 + i2;
                p1 = __hip_atomic_fetch_add(lcnt + e1, 1u, __ATOMIC_RELAXED, __HIP_MEMORY_SCOPE_WORKGROUP); p2 = __hip_atomic_fetch_add(lcnt + e2, 1u, __ATOMIC_RELAXED, __HIP_MEMORY_SCOPE_WORKGROUP);
            }
        }
        }
        __syncthreads();
        if (DRY < 2 && F.tid < 32) { const unsigned n = lcnt[F.tid]; lbase[F.tid] = n ? atomicAdd(cnt + F.tid * 64, n) : 0u; }
        __syncthreads();
        if (win) { const unsigned pos1 = lbase[e1] + p1, pos2 = lbase[e2] + p2;
            list[(size_t)e1 * TT + pos1] = (unsigned)row; list[(size_t)e2 * TT + pos2] = (unsigned)row;
            tokslot[2 * row] = ((unsigned)e1 << 16) | pos1; tokslot[2 * row + 1] = ((unsigned)e2 << 16) | pos2; tokw[2 * row] = w1; tokw[2 * row + 1] = w2; }
    }
    __syncthreads();
}
struct CombBuf { u32x2 x[4], ya[4], yb[4]; };
__device__ __forceinline__ void comb_load(CombBuf& b, const bf16_t* xr, const bf16_t* ya, const bf16_t* yb, int lane) {
#pragma unroll
    for (int j = 0; j < 4; ++j) { const int c = 4 * lane + 256 * j; b.x[j] = *(const u32x2*)(xr + c); b.ya[j] = *(const u32x2*)(ya + c); b.yb[j] = *(const u32x2*)(yb + c); }
}
template <bool LAST, bool DRY> __device__ __forceinline__ void comb_finish(const Frame& F, const CombBuf& b, int l, int row, float wa, float wb, int lane) {
    const int r = modrow(row); const float* g2 = F.mod(l, r, 5); bf16_t* xr = F.xr_row(row);
    float ss = 0.f; f32x4 v[4];
#pragma unroll
    for (int j = 0; j < 4; ++j) { const int c = 4 * lane + 256 * j; const f32x4 gv = *(const f32x4*)(g2 + c);
        f32x4 y; y[0] = wa * bflo(b.ya[j].x) + wb * bflo(b.yb[j].x); y[1] = wa * bfhi(b.ya[j].x) + wb * bfhi(b.yb[j].x); y[2] = wa * bflo(b.ya[j].y) + wb * bflo(b.yb[j].y); y[3] = wa * bfhi(b.ya[j].y) + wb * bfhi(b.yb[j].y);
        const f32x4 x1 = (f32x4){bflo(b.x[j].x), bfhi(b.x[j].x), bflo(b.x[j].y), bfhi(b.x[j].y)};
        v[j] = x1 + gv * y;
        if (LAST) { if (!DRY) *(f32x4*)(F.out + (size_t)row * DM + c) = v[j]; }
        else { u32x2 o; o.x = pk2(v[j][0], v[j][1]); o.y = pk2(v[j][2], v[j][3]); *(u32x2*)(xr + c) = DRY ? b.x[j] : o; }
        ss += (v[j][0] * v[j][0] + v[j][1] * v[j][1]) + (v[j][2] * v[j][2] + v[j][3] * v[j][3]); }
    if (!LAST) { const float rms = 1.0f / sqrtf(wave_sum(ss) * (1.f / 1024.f) + EPS); const float* g = F.in[I_LN1] + (l + 1) * 1024; const float* sh = F.mod(l + 1, r, 0); const float* sc = F.mod(l + 1, r, 1); f32x4 h[4];
#pragma unroll
        for (int j = 0; j < 4; ++j) { const int c = 4 * lane + 256 * j; h[j] = (v[j] * rms * *(const f32x4*)(g + c)) * (1.f + *(const f32x4*)(sc + c)) + *(const f32x4*)(sh + c); }
        store_row_bf16(F.hx() + (size_t)row * DM, lane, h); }
}
template <bool LAST, bool DRY> __device__ __forceinline__ void p_combine(const Frame& F, int l, int ntok, const MoeTab& tb) {
    const int gw = F.vcu * NWAVES + F.wave, NGW = F.G * NWAVES, lane = F.lane;
    const bf16_t* YB = (const bf16_t*)(F.ws + WS_YB);
    const unsigned* tokslot = (const unsigned*)(F.ws + WS_TOK); const float* tokw = (const float*)(F.ws + WS_TOK + 512 * 1024);
    const int ntot = gw < ntok ? (ntok - gw + NGW - 1) / NGW : 0;
    for (int base = 0; base < ntot; base += 64) {
    const int n = ntot - base < 64 ? ntot - base : 64;
    unsigned my_sa = 0u, my_sb = 0u; float my_wa = 0.f, my_wb = 0.f;
    { const int mr = gw + (base + lane) * NGW;
      if (lane < n) { const unsigned sa = tokslot[2 * mr], sb = tokslot[2 * mr + 1]; my_wa = tokw[2 * mr]; my_wb = tokw[2 * mr + 1];
          my_sa = (unsigned)tb.tile0[sa >> 16] * 256u + (sa & 0xffffu); my_sb = (unsigned)tb.tile0[sb >> 16] * 256u + (sb & 0xffffu); } }
    CombBuf A, B;
#define COMB_LOAD(buf, i) do { const int row_ = gw + (base + (i)) * NGW; const unsigned sa_ = __builtin_amdgcn_readlane(my_sa, (i)), sb_ = __builtin_amdgcn_readlane(my_sb, (i)); \
        comb_load(buf, F.xr_row(row_), YB + (size_t)sa_ * 1024, YB + (size_t)sb_ * 1024, lane); } while (0)
#define COMB_FIN(buf, i) do { const float wa_ = __uint_as_float(__builtin_amdgcn_readlane(__float_as_uint(my_wa), (i))), wb_ = __uint_as_float(__builtin_amdgcn_readlane(__float_as_uint(my_wb), (i))); \
        comb_finish<LAST, DRY>(F, buf, l, gw + (base + (i)) * NGW, wa_, wb_, lane); } while (0)
    COMB_LOAD(A, 0);
    for (int i = 0; i < n; i += 2) {
        if (i + 1 < n) COMB_LOAD(B, i + 1);
        COMB_FIN(A, i);
        if (i + 2 < n) COMB_LOAD(A, i + 2);
        if (i + 1 < n) COMB_FIN(B, i + 1);
    }
    }
#undef COMB_LOAD
#undef COMB_FIN
}

__global__ void __launch_bounds__(NTHREADS, 2) fwd_kernel(Params P) {
    extern __shared__ __attribute__((aligned(16))) unsigned char lds_raw[];
    Frame F;
    F.lds = (LAS unsigned char*)lds_raw; F.in = P.in; F.out = P.out; F.ws = P.ws;
    F.tid = threadIdx.x; F.lane = F.tid & 63; F.wave = __builtin_amdgcn_readfirstlane(F.tid >> 6);
    F.G = gridDim.x; { const int bx = blockIdx.x; F.vcu = (F.G % 8 == 0) ? (bx % 8) * (F.G / 8) + bx / 8 : bx; }
    volatile LAS unsigned* misc = (volatile LAS unsigned*)(F.lds + LDS_MISC);
    if (F.tid < 16) misc[F.tid] = 0u;
    __syncthreads();
#if ONE_LAUNCH
    XcdBarrier bar = xcd_barrier_post((unsigned*)(F.ws + WS_CTL) + CW_BAR, misc + 8);
#define GRID_BAR() do { xcd_barrier(bar); } while (0)
#else
#define GRID_BAR() do { } while (0)
#endif
    const int lo = P.ph_lo, hi = P.ph_hi;
#ifndef DRYMASK
#define DRYMASK 0x4000
#endif
#ifndef DRYV
#define DRYV 7
#endif
#ifndef PHMASK
#define PHMASK 0xFFFFFFFFu
#endif
#define IN(k) (((PHMASK >> (k)) & 1u) && lo <= (k) && (k) < hi)
#ifdef PROBE_PH
#define STAMP(k) do { if (blockIdx.x == 0 && F.tid == 0) { const unsigned long long t_ = __builtin_amdgcn_s_memrealtime(); \
        if ((k) == PROBE_PH - 1) { misc[0] = (unsigned)t_; misc[1] = (unsigned)(t_ >> 32); } if ((k) == PROBE_PH) { misc[2] = (unsigned)t_; misc[3] = (unsigned)(t_ >> 32); } } } while (0)
#else
#define STAMP(k) do { } while (0)
#endif
#define SEAM(k) do { if (IN((k) + 1)) GRID_BAR(); STAMP(k); } while (0)
    STAMP(-1);
    bf16_t* HX = F.hx(); bf16_t* Qb = (bf16_t*)(F.ws + WS_Q); bf16_t* KVb = (bf16_t*)(F.ws + WS_KV); bf16_t* Gb = (bf16_t*)(F.ws + WS_G); bf16_t* AO = (bf16_t*)(F.ws + WS_AO);
    bf16_t* HID = (bf16_t*)(F.ws + WS_HID); bf16_t* YB = (bf16_t*)(F.ws + WS_YB);

    if (IN(0)) { Frame Fp = F; asm volatile("" : "+v"(Fp.tid), "+v"(Fp.lane)); p0_prologue(Fp); SEAM(0); }
    if (IN(1)) { Frame Fp = F; asm volatile("" : "+v"(Fp.tid), "+v"(Fp.lane)); p0_misc(Fp); p_norm1_l0(Fp); SEAM(1); }
    if (IN(2)) { Frame Fp = F; asm volatile("" : "+v"(Fp.tid), "+v"(Fp.lane)); SchedDense S{(const bf16_t*)(Fp.ws + WS_WINAB), 1024, TT / 256, 7, 0, 0, Fp.vcu, Fp.G}; EpiInProj<true> E{Qb, KVb, (bf16_t*)(Fp.ws + WS_VN), Gb}; GEMM(Fp, HX, 1024, S, E); SEAM(2); }
    if (IN(3)) { Frame Fp = F; asm volatile("" : "+v"(Fp.tid), "+v"(Fp.lane)); p_k_post(Fp, Fp.in[I_KNA]); p_conv(Fp); SEAM(3); }
    if (IN(4)) { Frame Fp = F; asm volatile("" : "+v"(Fp.tid), "+v"(Fp.lane));
#ifdef ATTN_SIMPLE
        attn_simple<0>(Fp);
#else
        attn_fast<0>(Fp, (char*)lds_raw);
#endif
        SEAM(4); }
    if (IN(5)) { Frame Fp = F; asm volatile("" : "+v"(Fp.tid), "+v"(Fp.lane)); SchedDense S{(const bf16_t*)(Fp.ws + WS_WOUTAB), 1024, TT / 256, 4, 0, 0, Fp.vcu, Fp.G}; EpiOutProj<true> E{Fp, 0}; GEMM(Fp, AO, 1024, S, E);
        SEAM(5); }
    if (IN(6)) { Frame Fp = F; asm volatile("" : "+v"(Fp.tid), "+v"(Fp.lane));
#if (DRYMASK >> 6) & 1
        p_router<DRYV>(Fp, 0, TT); GRID_BAR();
#endif
        p_router<0>(Fp, 0, TT); SEAM(6); }
    if (IN(7)) { Frame Fp = F; asm volatile("" : "+v"(Fp.tid), "+v"(Fp.lane)); const MoeTab tb = moe_tables(Fp, 0); SchedMoe S{(const bf16_t*)(Fp.ws + WS_WGU), (size_t)1024 * 1024, 1024, tb, (const unsigned*)(Fp.ws + WS_LIST), true, Fp.vcu, Fp.G}; EpiMoe1 E{HID}; GEMM(Fp, HX, 1024, S, E); SEAM(7); }
    if (IN(8)) { Frame Fp = F; asm volatile("" : "+v"(Fp.tid), "+v"(Fp.lane)); const MoeTab tb = moe_tables(Fp, 0); SchedMoe S{(const bf16_t*)(Fp.ws + WS_WD), (size_t)1024 * 512, 512, tb, nullptr, false, Fp.vcu, Fp.G}; EpiMoe2 E{YB}; GEMM2(Fp, HID, 512, S, E); SEAM(8); }
    if (IN(9)) { Frame Fp = F; asm volatile("" : "+v"(Fp.tid), "+v"(Fp.lane)); const MoeTab tb = moe_tables(Fp, 0);
#if (DRYMASK >> 9) & 1
        p_combine<false, true>(Fp, 0, TT, tb); GRID_BAR();
#endif
        p_combine<false, false>(Fp, 0, TT, tb); SEAM(9); }
    if (IN(10)) { Frame Fp = F; asm volatile("" : "+v"(Fp.tid), "+v"(Fp.lane)); SchedDense S{(const bf16_t*)(Fp.ws + WS_WINCD), 1024, TX / 256, 5, TC / 256, 2, Fp.vcu, Fp.G}; EpiInProj<false> E{Qb, KVb, (bf16_t*)(Fp.ws + WS_VN), Gb}; GEMM(Fp, HX, 1024, S, E); SEAM(10); }
    if (IN(11)) { Frame Fp = F; asm volatile("" : "+v"(Fp.tid), "+v"(Fp.lane)); p_k_post(Fp, Fp.in[I_KNC]); p_pool(Fp); SEAM(11); }
    if (IN(12)) { Frame Fp = F; asm volatile("" : "+v"(Fp.tid), "+v"(Fp.lane));
#ifdef ATTN_SIMPLE
        attn_simple<1>(Fp);
#else
        attn_fast<1>(Fp, (char*)lds_raw);
#endif
        SEAM(12); }
    if (IN(13)) { Frame Fp = F; asm volatile("" : "+v"(Fp.tid), "+v"(Fp.lane)); SchedDense S{(const bf16_t*)(Fp.ws + WS_WOUTCD), 1024, TX / 256, 4, 0, 0, Fp.vcu, Fp.G};
#if (DRYMASK >> 13) & 1
        { EpiOutProj<false, true> Ed{Fp, 1}; GEMM(Fp, AO, 1024, S, Ed); GRID_BAR(); }
#endif
        EpiOutProj<false> E{Fp, 1}; GEMM(Fp, AO, 1024, S, E); SEAM(13); }
    if (IN(14)) { Frame Fp = F; asm volatile("" : "+v"(Fp.tid), "+v"(Fp.lane));
#if (DRYMASK >> 14) & 1
        p_router<DRYV>(Fp, 1, TX); GRID_BAR();
#endif
        p_router<0>(Fp, 1, TX); SEAM(14); }
    if (IN(15)) { Frame Fp = F; asm volatile("" : "+v"(Fp.tid), "+v"(Fp.lane)); const MoeTab tb = moe_tables(Fp, 1); SchedMoe S{(const bf16_t*)(Fp.ws + WS_WGU) + (size_t)32 * 1024 * 1024, (size_t)1024 * 1024, 1024, tb, (const unsigned*)(Fp.ws + WS_LIST), true, Fp.vcu, Fp.G}; EpiMoe1 E{HID}; GEMM(Fp, HX, 1024, S, E); SEAM(15); }
    if (IN(16)) { Frame Fp = F; asm volatile("" : "+v"(Fp.tid), "+v"(Fp.lane)); const MoeTab tb = moe_tables(Fp, 1); SchedMoe S{(const bf16_t*)(Fp.ws + WS_WD) + (size_t)32 * 1024 * 512, (size_t)1024 * 512, 512, tb, nullptr, false, Fp.vcu, Fp.G}; EpiMoe2 E{YB}; GEMM2(Fp, HID, 512, S, E); SEAM(16); }
    if (IN(17)) { Frame Fp = F; asm volatile("" : "+v"(Fp.tid), "+v"(Fp.lane)); const MoeTab tb = moe_tables(Fp, 1);
#if (DRYMASK >> 17) & 1
        p_combine<true, true>(Fp, 1, TX, tb); GRID_BAR();
#endif
        p_combine<true, false>(Fp, 1, TX, tb); }
#ifdef PROBE_PH
    STAMP(NPH - 1);
    if (blockIdx.x == 0 && F.tid == 0) { const unsigned long long t0 = ((unsigned long long)misc[1] << 32) | misc[0], t1 = ((unsigned long long)misc[3] << 32) | misc[2];
        const unsigned long long te = __builtin_amdgcn_s_memrealtime(), span = (t1 - t0) * 16ull;
        while (__builtin_amdgcn_s_memrealtime() - te < span) __builtin_amdgcn_s_sleep(32); }
#endif
#undef IN
#undef SEAM
}

extern "C" void kernel_launch(void* const* d_in, const int* in_sizes, int n_in, void* d_out, int out_size, void* d_ws, size_t ws_size, hipStream_t stream) {
    static int grid = 0;
    if (grid == 0) {
        if (n_in != 30 || out_size != TX * DM || ws_size < WS_END) { fprintf(stderr, "kernel_launch: unexpected shapes (n_in %d out %d ws %zu)\n", n_in, out_size, ws_size); grid = -1; return; }
        int dev = 0, cus = 0;
        if (hipGetDevice(&dev) != hipSuccess || hipDeviceGetAttribute(&cus, hipDeviceAttributeMultiprocessorCount, dev) != hipSuccess) { grid = -1; return; }
        if (hipFuncSetAttribute((const void*)fwd_kernel, hipFuncAttributeMaxDynamicSharedMemorySize, LDS_BYTES) != hipSuccess) { fprintf(stderr, "kernel_launch: hipFuncSetAttribute failed\n"); grid = -1; return; }
        int per_cu = 0;
        if (hipOccupancyMaxActiveBlocksPerMultiprocessor(&per_cu, (const void*)fwd_kernel, NTHREADS, LDS_BYTES) != hipSuccess || per_cu < 1) { fprintf(stderr, "kernel_launch: occupancy query says %d\n", per_cu); }
        (void)hipGetLastError();
        grid = cus;
    }
    if (grid < 0) return;
    (void)hipMemsetAsync((char*)d_ws + WS_CTL, 0, CTL_ZERO_BYTES, stream);
    Params p{};
    for (int i = 0; i < 30; ++i) p.in[i] = (const float*)d_in[i];
    p.out = (float*)d_out; p.ws = (unsigned char*)d_ws;
#if ONE_LAUNCH
    p.ph_lo = 0; p.ph_hi = NPH;
    hipLaunchKernelGGL(fwd_kernel, dim3(grid), dim3(NTHREADS), LDS_BYTES, stream, p);
#else
    for (int ph = 0; ph < NPH; ++ph) { p.ph_lo = ph; p.ph_hi = ph + 1; hipLaunchKernelGGL(fwd_kernel, dim3(grid), dim3(NTHREADS), LDS_BYTES, stream, p); }
#endif
}
```

```cpp
#include <hip/hip_runtime.h>
#include <cstdio>
#include <cstdint>

#ifndef ONE_LAUNCH
#define ONE_LAUNCH 1
#endif

#define LAS __attribute__((address_space(3)))
#define GAS __attribute__((address_space(1)))
typedef unsigned short bf16_t;
typedef short bf16x8 __attribute__((ext_vector_type(8)));
typedef float f32x4 __attribute__((ext_vector_type(4)));
typedef float f32x2 __attribute__((ext_vector_type(2)));
typedef unsigned u32x4 __attribute__((ext_vector_type(4)));
typedef unsigned u32x2 __attribute__((ext_vector_type(2)));
typedef __bf16 bf16x2_t __attribute__((ext_vector_type(2)));

constexpr int NB = 8, SEQ = 4096, DM = 1024, CTXL = 256, HD = 64;
constexpr int TX = NB * SEQ, TC = NB * CTXL, TT = TX + TC;
constexpr int KVS = CTXL + SEQ;
constexpr int NE = 32;
constexpr int NTILE_MAX = 304, NSLOT = NTILE_MAX * 256;
constexpr float EPS = 1e-6f;
constexpr float LOG2E = 1.4426950408889634f;
constexpr float C2 = 0.125f * LOG2E;
constexpr int NWAVES = 8, NTHREADS = 512;
constexpr int NPH = 18;

enum { I_X = 0, I_C, I_CTX, I_CCTX, I_MODW, I_MODB, I_LN1, I_LN2, I_WINAB, I_WOUTAB, I_QNA, I_KNA, I_CONVW, I_CONVB, I_CLNG, I_CLNB,
       I_WINCD, I_WOUTCD, I_QNC, I_KNC, I_SINK, I_POOLW, I_POOLS, I_RGW, I_RGB, I_REW, I_REB, I_EXG, I_EXU, I_EXD };

constexpr size_t MiB = 1u << 20;
constexpr size_t WS_CTL = 0, CTL_ZERO_BYTES = 1 * MiB;
constexpr size_t WS_MOD = 1 * MiB;
constexpr size_t WS_ROPE = 2 * MiB;
constexpr size_t WS_TOK = 3 * MiB;
constexpr size_t WS_LIST = 4 * MiB;
constexpr size_t WS_WINAB = 10 * MiB;
constexpr size_t WS_WOUTAB = 14 * MiB;
constexpr size_t WS_WINCD = 16 * MiB;
constexpr size_t WS_WOUTCD = 19 * MiB;
constexpr size_t WS_XC = 21 * MiB;
constexpr size_t WS_KN = 30 * MiB;
constexpr size_t WS_VN = 39 * MiB;
constexpr size_t WS_WGU = 48 * MiB;
constexpr size_t WS_WD = 176 * MiB;
constexpr size_t WS_XR = 240 * MiB;
constexpr size_t WS_HID = 308 * MiB;
constexpr size_t WS_Q = 384 * MiB;
constexpr size_t WS_KV = 418 * MiB;
constexpr size_t WS_G = 435 * MiB;
constexpr size_t WS_AO = 469 * MiB;
constexpr size_t WS_YB = 384 * MiB;
constexpr size_t WS_SS = 537 * MiB;
constexpr size_t WS_WR = 9 * MiB;
constexpr size_t WS_GP = 3 * MiB + 896 * 1024;
constexpr size_t WS_END = 540 * MiB;
static_assert(WS_YB + (size_t)NSLOT * 1024 * 2 <= WS_END && WS_AO + (size_t)TT * 1024 * 2 <= WS_END, "ws map");
constexpr int CW_CNT = 256;
constexpr int CW_BAR = 16384;

constexpr int RING_BYTES = 131072;
constexpr int RW_BYTES = 73728;
constexpr int LDS_MISC = 2 * RW_BYTES;
constexpr int LDS_TAB = LDS_MISC + 256;
constexpr int LDS_BYTES = 163840;

__device__ __forceinline__ unsigned pk2(float lo, float hi) { f32x2 v = {lo, hi}; bf16x2_t b = __builtin_convertvector(v, bf16x2_t); return __builtin_bit_cast(unsigned, b); }
__device__ __forceinline__ float bflo(unsigned w) { return __uint_as_float(w << 16); }
__device__ __forceinline__ float bfhi(unsigned w) { return __uint_as_float(w & 0xffff0000u); }
__device__ __forceinline__ float bf2f(bf16_t h) { return __uint_as_float((unsigned)h << 16); }
__device__ __forceinline__ float wave_sum(float v) {
#pragma unroll
    for (int o = 1; o < 64; o <<= 1) v += __shfl_xor(v, o);
    return v;
}
__device__ __forceinline__ float sigmoidf_(float v) { return 1.f / (1.f + __expf(-v)); }

#define XB_TMO      128
#define XB_XCNT(j)  (256  + 64 * (j))
#define XB_XSUB(j)  (1280 + 64 * (j))
#define XB_XGEN(j)  (2304 + 64 * (j))
#define XB_TOP      3328
#define XB_TOPGEN   3392
#define XCD_BAR_WORDS 3456
#define XB_SPIN_CAP (1u << 18)
__device__ __forceinline__ unsigned xb_ld(unsigned* p)              { return __hip_atomic_load(p, __ATOMIC_RELAXED, __HIP_MEMORY_SCOPE_AGENT); }
__device__ __forceinline__ unsigned xb_add(unsigned* p, unsigned v) { return __hip_atomic_fetch_add(p, v, __ATOMIC_RELAXED, __HIP_MEMORY_SCOPE_AGENT); }
__device__ __forceinline__ unsigned xb_xcc_id() { return (unsigned)__builtin_amdgcn_s_getreg((3 << 11) | 20) & 0xFu; }
#define XB_SPIN(cond, bar) do { unsigned _sp = 0; while (cond) { __builtin_amdgcn_s_sleep(1); \
    if ((++_sp & 255u) == 0u) { if (xb_ld(&(bar)[XB_TMO])) break; if (_sp > XB_SPIN_CAP) { atomicAdd(&(bar)[XB_TMO], 1u); break; } } } } while (0)
struct XcdBarrier { unsigned* bar; unsigned x; volatile LAS unsigned* st; };
__device__ __forceinline__ XcdBarrier xcd_barrier_post(unsigned* bar, volatile LAS unsigned* st) {
    XcdBarrier b; b.bar = bar; b.x = xb_xcc_id(); b.st = st;
    if (threadIdx.x == 0) (void)xb_add(&bar[XB_XCNT(b.x)], 1u);
    return b;
}
__device__ __forceinline__ void xcd_barrier_complete(unsigned* bar, unsigned x, unsigned& nloc, unsigned& nx) {
    const unsigned G = gridDim.x * gridDim.y * gridDim.z;
    unsigned sum, cnt, mine, sp = 0u;
    for (;;) {
        sum = 0u; cnt = 0u; mine = 0u;
#pragma unroll
        for (unsigned j = 0; j < 16; ++j) { const unsigned c = xb_ld(&bar[XB_XCNT(j)]); sum += c; cnt += (c > 0u) ? 1u : 0u; mine = (j == x) ? c : mine; }
        if (sum == G) break;
        __builtin_amdgcn_s_sleep(1);
        if ((++sp & 255u) == 0u) { if (xb_ld(&bar[XB_TMO])) break; if (sp > XB_SPIN_CAP) { atomicAdd(&bar[XB_TMO], 1u); break; } }
    }
    nloc = mine > 0u ? mine : 1u; nx = cnt > 0u ? cnt : 1u;
}
__device__ __forceinline__ void xcd_barrier(const XcdBarrier& b) {
    asm volatile("s_waitcnt vmcnt(0)" ::: "memory");
    __syncthreads();
    if (threadIdx.x == 0) {
        unsigned* bar = b.bar;
        __builtin_amdgcn_s_waitcnt(0);
        unsigned nloc = b.st[0], nx = b.st[1];
        if (nloc == 0u) { xcd_barrier_complete(bar, b.x, nloc, nx); b.st[0] = nloc; b.st[1] = nx; }
        const unsigned old = xb_add(&bar[XB_XSUB(b.x)], 1u);
        const unsigned gen = old / nloc;
        if (old + 1u == (gen + 1u) * nloc) {
            __builtin_amdgcn_fence(__ATOMIC_RELEASE, "agent");
            asm volatile("s_waitcnt vmcnt(0)" ::: "memory");
            const unsigned og = xb_add(&bar[XB_TOP], 1u);
            const unsigned tg = og / nx;
            if (og + 1u == (tg + 1u) * nx) xb_add(&bar[XB_TOPGEN], 1u);
            else XB_SPIN(xb_ld(&bar[XB_TOPGEN]) == tg, bar);
            __builtin_amdgcn_fence(__ATOMIC_ACQUIRE, "agent");
            xb_add(&bar[XB_XGEN(b.x)], 1u);
            asm volatile("s_waitcnt vmcnt(0)" ::: "memory");
        } else {
            XB_SPIN(xb_ld(&bar[XB_XGEN(b.x)]) == gen, bar);
            __builtin_amdgcn_fence(__ATOMIC_ACQUIRE, "agent");
            asm volatile("s_waitcnt vmcnt(0)" ::: "memory");
        }
    }
    __syncthreads();
}

struct Params { const float* in[30]; float* out; unsigned char* ws; int ph_lo, ph_hi; };
struct Frame {
    LAS unsigned char* lds;
    const float* const* in;
    float* out; unsigned char* ws;
    int tid, lane, wave, vcu, G;
    __device__ __forceinline__ const float* mod(int l, int r, int chunk) const { return (const float*)(ws + WS_MOD) + ((size_t)(l * 9 + r) * 6144 + chunk * 1024); }
    __device__ __forceinline__ bf16_t* xr_row(int row) const { return (bf16_t*)(ws + WS_XR) + (size_t)row * DM; }
    __device__ __forceinline__ bf16_t* hx() const { return (bf16_t*)out; }
    __device__ __forceinline__ const float* xin_row(int row) const { return row < TX ? in[I_X] + (size_t)row * DM : in[I_CTX] + (size_t)(row - TX) * DM; }
    __device__ __forceinline__ unsigned* cnt(int l) const { return (unsigned*)(ws + WS_CTL) + CW_CNT + l * 32 * 64; }
};
__device__ __forceinline__ int modrow(int row) { return row < TX ? (row >> 12) : 8; }

__device__ __forceinline__ void p0_mod_item(const Frame& F, int item) {
    const int l = item / 96, cg = item % 96;
    LAS float* sc = (LAS float*)F.lds;
    LAS float* red = sc + 9 * 1024;
    for (int i = F.tid; i < 9 * 1024; i += NTHREADS) { const int r = i >> 10, k = i & 1023; const float v = r < 8 ? F.in[I_C][r * 1024 + k] : F.in[I_CCTX][k]; sc[i] = v / (1.f + expf(-v)); }
    __syncthreads();
    const float* W = F.in[I_MODW] + (size_t)l * 1024 * 6144 + cg * 64 + F.lane;
    float acc[9];
#pragma unroll
    for (int r = 0; r < 9; ++r) acc[r] = 0.f;
    for (int kb = 0; kb < 128; kb += 32) { float w[32];
#pragma unroll
        for (int kk = 0; kk < 32; ++kk) w[kk] = W[(size_t)(F.wave * 128 + kb + kk) * 6144];
#pragma unroll
        for (int kk = 0; kk < 32; ++kk) { const int k = F.wave * 128 + kb + kk;
#pragma unroll
            for (int r = 0; r < 9; ++r) acc[r] += sc[r * 1024 + k] * w[kk]; } }
#pragma unroll
    for (int r = 0; r < 9; ++r) red[(F.wave * 9 + r) * 64 + F.lane] = acc[r];
    __syncthreads();
    for (int i = F.tid; i < 9 * 64; i += NTHREADS) { const int r = i >> 6, ln = i & 63; float s = 0.f;
#pragma unroll
        for (int w = 0; w < 8; ++w) s += red[(w * 9 + r) * 64 + ln];
        ((float*)(F.ws + WS_MOD))[(size_t)(l * 9 + r) * 6144 + cg * 64 + ln] = s + F.in[I_MODB][l * 6144 + cg * 64 + ln]; }
    __syncthreads();
}
struct TDesc { const float* src; bf16_t* dst; int ldw; };
__device__ __forceinline__ void t_load(const TDesc& d, f32x4 (&v)[16], int lane) {
    const int kr = lane >> 4, nq = lane & 15;
#pragma unroll
    for (int i = 0; i < 16; ++i) v[i] = *(const f32x4*)(d.src + (size_t)(4 * i + kr) * d.ldw + 4 * nq);
}
__device__ __forceinline__ void t_finish(const TDesc& d, const f32x4 (&v)[16], LAS float* scr, int lane) {
    const int kr = lane >> 4, nq = lane & 15;
#pragma unroll
    for (int i = 0; i < 16; ++i) { LAS float* s = scr + (4 * i + kr) * 65 + 4 * nq; s[0] = v[i][0]; s[1] = v[i][1]; s[2] = v[i][2]; s[3] = v[i][3]; }
    asm volatile("s_waitcnt lgkmcnt(0)" ::: "memory");
    const int c = lane & 7;
#pragma unroll
    for (int j = 0; j < 8; ++j) { const int n = (lane >> 3) + 8 * j; const LAS float* s = scr + (8 * c) * 65 + n;
        u32x4 o; o.x = pk2(s[0 * 65], s[1 * 65]); o.y = pk2(s[2 * 65], s[3 * 65]); o.z = pk2(s[4 * 65], s[5 * 65]); o.w = pk2(s[6 * 65], s[7 * 65]);
        *(u32x4*)(d.dst + (size_t)n * 64 + 8 * c) = o; }
    asm volatile("s_waitcnt lgkmcnt(0)" ::: "memory");
}
constexpr int TN_AB = 16 * 28, TN_OAB = 16 * 16, TN_CD = 16 * 20, TN_OCD = 8 * 16, TN_G = 64 * 128, TN_U = 64 * 128, TN_D = 64 * 128;
constexpr int TN_ITEMS = TN_AB + TN_OAB + TN_CD + TN_OCD + TN_G + TN_U + TN_D;
__device__ __forceinline__ TDesc t_decode(const Frame& F, int it) {
    TDesc d; int r = it;
    if (r < TN_AB) { const int kb = r / 28, nb = r % 28, n0 = nb * 64; int d0;
        if (n0 < 768) d0 = n0; else if (n0 < 1280) { const int j = n0 - 768; d0 = 768 + (j >> 7) * 256 + (j & 127); } else { const int j = n0 - 1280; d0 = 768 + (j >> 7) * 256 + 128 + (j & 127); }
        d.src = F.in[I_WINAB] + (size_t)kb * 64 * 1792 + n0; d.ldw = 1792; d.dst = (bf16_t*)(F.ws + WS_WINAB) + ((size_t)kb * 1792 + d0) * 64; return d; } r -= TN_AB;
    if (r < TN_OAB) { const int kb = r / 16, nb = r % 16; d.src = F.in[I_WOUTAB] + (size_t)kb * 64 * 1024 + nb * 64; d.ldw = 1024; d.dst = (bf16_t*)(F.ws + WS_WOUTAB) + ((size_t)kb * 1024 + nb * 64) * 64; return d; } r -= TN_OAB;
    if (r < TN_CD) { const int kb = r / 20, nb = r % 20; d.src = F.in[I_WINCD] + (size_t)kb * 64 * 1280 + nb * 64; d.ldw = 1280; d.dst = (bf16_t*)(F.ws + WS_WINCD) + ((size_t)kb * 1280 + nb * 64) * 64; return d; } r -= TN_CD;
    if (r < TN_OCD) { const int kb = r / 16, nb = r % 16; d.src = F.in[I_WOUTCD] + (size_t)kb * 64 * 1024 + nb * 64; d.ldw = 1024; d.dst = (bf16_t*)(F.ws + WS_WOUTCD) + ((size_t)kb * 1024 + nb * 64) * 64; return d; } r -= TN_OCD;
    if (r < TN_G + TN_U) { const bool up = r >= TN_G; if (up) r -= TN_G; const int le = r >> 7, q = r & 127, kb = q >> 3, nb = q & 7, n0 = nb * 64;
        const int d0 = (n0 >> 7) * 256 + (up ? 128 : 0) + (n0 & 127);
        d.src = F.in[up ? I_EXU : I_EXG] + (size_t)le * 1024 * 512 + (size_t)kb * 64 * 512 + n0; d.ldw = 512; d.dst = (bf16_t*)(F.ws + WS_WGU) + (size_t)le * 1024 * 1024 + ((size_t)kb * 1024 + d0) * 64; return d; } r -= TN_G + TN_U;
    { const int le = r >> 7, q = r & 127, kb = q >> 4, nb = q & 15;
        d.src = F.in[I_EXD] + (size_t)le * 512 * 1024 + (size_t)kb * 64 * 1024 + nb * 64; d.ldw = 1024; d.dst = (bf16_t*)(F.ws + WS_WD) + (size_t)le * 1024 * 512 + ((size_t)kb * 1024 + nb * 64) * 64; return d; }
}
constexpr int TN_DENSE = TN_AB + TN_OAB + TN_CD + TN_OCD;
template <int MODE> __device__ __forceinline__ int t_map(int j) { return MODE < 0 ? j : TN_DENSE + (j >> 12) * 8192 + MODE * 4096 + (j & 4095); }
template <int MODE> __device__ __forceinline__ void transpose_range(const Frame& F, int lo, int hi, int w, int nw) {
    LAS float* scr = (LAS float*)(F.lds + F.wave * 16640);
    f32x4 va[16], vb[16]; TDesc da, db;
    const int first = lo + w;
    if (first < hi) { da = t_decode(F, t_map<MODE>(first)); t_load(da, va, F.lane); }
    for (int it = first; it < hi; it += 2 * nw) {
        const int it2 = it + nw, it3 = it + 2 * nw;
        if (it2 < hi) { db = t_decode(F, t_map<MODE>(it2)); t_load(db, vb, F.lane); }
        t_finish(da, va, scr, F.lane);
        if (it3 < hi) { da = t_decode(F, t_map<MODE>(it3)); t_load(da, va, F.lane); }
        if (it2 < hi) t_finish(db, vb, scr, F.lane);
    }
}
constexpr int TL_ITEMS = 12288, TL_A = 4915, TL_B = 7987;
template <int MODE> __device__ __forceinline__ void transpose_tail(const Frame& F, int units, int lo, int hi) {
    if (F.G != 256) return;
    const int R = units % F.G, J = R == 0 ? F.G : F.G - R, j = R == 0 ? F.vcu : F.vcu - R;
    if (j >= 0) { Frame Fc = F; asm volatile("" : "+v"(Fc.lane), "+v"(Fc.tid)); transpose_range<MODE>(Fc, lo, hi, j * NWAVES + Fc.wave, J * NWAVES); }
}
__device__ __forceinline__ void p0_prologue(const Frame& F) { for (int it = F.vcu; it < 192; it += F.G) p0_mod_item(F, it); }
__device__ __forceinline__ void p0_misc(const Frame& F) {
    const int gw = F.vcu * NWAVES + F.wave, NGW = F.G * NWAVES;
    const int gt = gw * 64 + F.lane, NGT = NGW * 64;
    { float* rc = (float*)(F.ws + WS_ROPE); float* rs = rc + SEQ * 32;
      for (int i = gt; i < SEQ * 32; i += NGT) { const int s = i >> 5, d = i & 31, f = d & 15; const float pos = (float)(d < 16 ? (s >> 6) : (s & 63));
          const float inv = exp2f(-(float)f * (13.287712379549449f / 16.f)); const float a = pos * inv; rc[i] = cosf(a); rs[i] = sinf(a); } }
    { typedef float f32x16_t __attribute__((ext_vector_type(16)));
      bf16_t* WT = (bf16_t*)(F.ws + WS_WOUTCD); const int l31 = F.lane & 31, lh = F.lane >> 5;
      for (int it = gw; it < 4 * 32 * 4; it += NGW) { const int g = it >> 7, dt = (it >> 2) & 31, ct = it & 3;
          const float* wo = F.in[I_WOUTCD] + (size_t)(512 + g * 128 + lh) * 1024 + dt * 32 + l31;
          const float* pw = F.in[I_POOLW] + (size_t)(g * 128 + ct * 32 + l31) * 128 + lh; const float* ps = F.in[I_POOLS] + g * 128 + lh;
          f32x16_t acc;
#pragma unroll
          for (int r = 0; r < 16; ++r) acc[r] = 0.f;
          for (int dp0 = 0; dp0 < 128; dp0 += 16) { float av[8], bv[8];
#pragma unroll
              for (int u = 0; u < 8; ++u) { av[u] = wo[(size_t)(dp0 + 2 * u) * 1024]; bv[u] = pw[dp0 + 2 * u] * ps[dp0 + 2 * u]; }
#pragma unroll
              for (int u = 0; u < 8; ++u) acc = __builtin_amdgcn_mfma_f32_32x32x2f32(av[u], bv[u], acc, 0, 0, 0); }
#pragma unroll
          for (int r = 0; r < 16; ++r) { const int i = (r & 3) + 8 * (r >> 2) + 4 * lh; const int k_ = 512 + g * 128 + ct * 32 + l31; WT[((size_t)(k_ >> 6) * 1024 + dt * 32 + i) * 64 + (k_ & 63)] = (bf16_t)(pk2(acc[r], 0.f) & 0xffffu); } } }
    { bf16_t* WR = (bf16_t*)(F.ws + WS_WR);
      for (int i = gt; i < 2 * 32 * 144 * 8; i += NGT) { const int j = i & 7, e16 = (i >> 3) % 144, s_ = (i / (8 * 144)) & 31, l = i / (8 * 144 * 32);
          int col; bool grp = false; int c;
          if (e16 < 128) { const int lane_ = e16 & 63, row = lane_ & 15; c = lane_ >> 4; col = 8 * (row >> 2) + (e16 < 64 ? 0 : 4) + (row & 3); }
          else { const int q = e16 - 128; c = q & 3; col = q >> 2; grp = true; }
          const int k = 32 * s_ + 8 * c + j;
          const float w = grp ? F.in[I_RGW][(size_t)l * 4096 + k * 4 + col] : F.in[I_REW][(size_t)l * 32768 + k * 32 + col];
          const unsigned hi = pk2(w, 0.f) & 0xffffu; const unsigned lo = pk2(w - bflo(hi), 0.f) & 0xffffu;
          const size_t o = (size_t)s_ * 1152 + (size_t)e16 * 8 + j;
          WR[(size_t)(l * 2 + 0) * 36864 + o] = (bf16_t)hi; WR[(size_t)(l * 2 + 1) * 36864 + o] = (bf16_t)lo; } }
    transpose_range<-1>(F, 0, F.G == 256 ? TN_DENSE : TN_ITEMS, gw, NGW);
}

__device__ __forceinline__ void norm_mod_row(const float* xrow, const float* g, const float* sh, const float* sc, int lane, f32x4 (&h)[4]) {
    f32x4 v[4]; float ss = 0.f;
#pragma unroll
    for (int j = 0; j < 4; ++j) { v[j] = *(const f32x4*)(xrow + 4 * lane + 256 * j); ss += (v[j][0] * v[j][0] + v[j][1] * v[j][1]) + (v[j][2] * v[j][2] + v[j][3] * v[j][3]); }
    const float rms = 1.0f / sqrtf(wave_sum(ss) * (1.f / 1024.f) + EPS);
#pragma unroll
    for (int j = 0; j < 4; ++j) { const int c = 4 * lane + 256 * j; const f32x4 gg = *(const f32x4*)(g + c), s1 = *(const f32x4*)(sc + c), s0 = *(const f32x4*)(sh + c);
        h[j] = (v[j] * rms * gg) * (1.f + s1) + s0; }
}
__device__ __forceinline__ void store_row_bf16(bf16_t* orow, int lane, const f32x4 (&h)[4]) {
#pragma unroll
    for (int j = 0; j < 4; ++j) { u32x2 o; o.x = pk2(h[j][0], h[j][1]); o.y = pk2(h[j][2], h[j][3]); *(u32x2*)(orow + 4 * lane + 256 * j) = o; }
}
struct RowBuf { f32x4 v[4]; };
__device__ __forceinline__ void row_load(RowBuf& b, const float* xrow, int lane) {
#pragma unroll
    for (int j = 0; j < 4; ++j) b.v[j] = *(const f32x4*)(xrow + 4 * lane + 256 * j);
}
__device__ __forceinline__ void row_norm_store(const RowBuf& b, const float* g, const float* sh, const float* sc, bf16_t* orow, int lane) {
    float ss = 0.f;
#pragma unroll
    for (int j = 0; j < 4; ++j) ss += (b.v[j][0] * b.v[j][0] + b.v[j][1] * b.v[j][1]) + (b.v[j][2] * b.v[j][2] + b.v[j][3] * b.v[j][3]);
    const float rms = 1.0f / sqrtf(wave_sum(ss) * (1.f / 1024.f) + EPS);
    f32x4 h[4];
#pragma unroll
    for (int j = 0; j < 4; ++j) { const int c = 4 * lane + 256 * j; h[j] = (b.v[j] * rms * *(const f32x4*)(g + c)) * (1.f + *(const f32x4*)(sc + c)) + *(const f32x4*)(sh + c); }
    store_row_bf16(orow, lane, h);
}
__device__ __forceinline__ void p_norm1_l0(const Frame& F) {
    const int gw = F.vcu * NWAVES + F.wave, NGW = F.G * NWAVES;
    { float* GP = (float*)(F.ws + WS_GP);
      for (int i = gw * 64 + F.lane; i < 2 * 9 * 1024; i += NGW * 64) { const int k = i & 1023, lr = i >> 10; GP[i] = F.in[I_LN2][(lr / 9) * 1024 + k] * (1.f + F.mod(lr / 9, lr % 9, 4)[k]); } }
    bf16_t* HX = F.hx();
    RowBuf A, B;
    if (gw < TT) row_load(A, F.xin_row(gw), F.lane);
    for (int row = gw; row < TT; row += 2 * NGW) {
        const int row2 = row + NGW, row3 = row + 2 * NGW;
        if (row2 < TT) row_load(B, F.xin_row(row2), F.lane);
        { const int r = modrow(row); row_norm_store(A, F.in[I_LN1], F.mod(0, r, 0), F.mod(0, r, 1), HX + (size_t)row * DM, F.lane); }
        if (row3 < TT) row_load(A, F.xin_row(row3), F.lane);
        if (row2 < TT) { const int r = modrow(row2); row_norm_store(B, F.in[I_LN1], F.mod(0, r, 0), F.mod(0, r, 1), HX + (size_t)row2 * DM, F.lane); }
    }
}

struct Unit { int pm, pn, e; };
struct SchedDense {
    const bf16_t* Bt; int K, nMa, nN, nMb, pnb, vcu, G;
    __device__ __forceinline__ bool next(int i, Unit& u) const { int L = i * G + vcu; const int na = nMa * nN; u.e = 0;
        if (L < na) { u.pm = L / nN; u.pn = L % nN; return true; } L -= na; if (L < nMb) { u.pm = nMa + L; u.pn = pnb; return true; } return false; }
    __device__ __forceinline__ int arow(const Unit& u, int r) const { return u.pm * 256 + r; }
    __device__ __forceinline__ const bf16_t* bbase(const Unit& u) const { return Bt + (size_t)u.pn * 256 * 64; }
    __device__ __forceinline__ int brows() const { return nN * 256; }
};
struct MoeTab { const LAS int* tile_e; const LAS int* tile0; const LAS int* cnt; int ntiles; };
struct SchedMoe {
    const bf16_t* Wt; size_t estride; int K; MoeTab tb; const unsigned* list; bool gather; int vcu, G;
    __device__ __forceinline__ bool next(int i, Unit& u) const { const int L = i * G + vcu; if (L >= tb.ntiles * 4) return false; u.pm = L >> 2; u.pn = L & 3; u.e = tb.tile_e[u.pm]; return true; }
    __device__ __forceinline__ int arow(const Unit& u, int r) const {
        if (!gather) return u.pm * 256 + r;
        int idx = (u.pm - tb.tile0[u.e]) * 256 + r; const int c = tb.cnt[u.e]; idx = idx < c ? idx : c - 1;
        return (int)list[(size_t)u.e * TT + idx]; }
    __device__ __forceinline__ const bf16_t* bbase(const Unit& u) const { return Wt + (size_t)u.e * estride + (size_t)u.pn * 256 * 64; }
    __device__ __forceinline__ int brows() const { return 1024; }
};
__device__ __forceinline__ MoeTab moe_tables(const Frame& F, int l) {
    LAS int* tile_e = (LAS int*)(F.lds + LDS_TAB); LAS int* tile0 = tile_e + NTILE_MAX; LAS int* cntl = tile0 + 33; LAS int* nt = cntl + 32;
    __syncthreads();
    if (F.tid == 0) { int t = 0; unsigned* cg = F.cnt(l);
        for (int e = 0; e < NE; ++e) { const int c = (int)__hip_atomic_load(cg + e * 64, __ATOMIC_RELAXED, __HIP_MEMORY_SCOPE_AGENT); const int n = (c + 255) >> 8; tile0[e] = t; cntl[e] = c;
            for (int j = 0; j < n; ++j) tile_e[t + j] = e; t += n; }
        tile0[32] = t; nt[0] = t; }
    __syncthreads();
    MoeTab tb; tb.tile_e = tile_e; tb.tile0 = tile0; tb.cnt = cntl; tb.ntiles = nt[0]; return tb;
}

namespace pg8 {
constexpr int BM = 256, BK = 64, HALF = 128, HTB = HALF * BK * 2;
__device__ __forceinline__ int lds_byte(int r, int c) { const int st = (r >> 4) * 2 + (c >> 5), rr = r & 15, cc = c & 31, ob = rr * 64 + cc * 2; return st * 1024 + (ob ^ (((ob >> 9) & 1) << 5)); }
__device__ __forceinline__ void stage_rc(int b, int& R, int& C) { const int st = b / 1024, sb = b % 1024, swz = sb ^ (((sb >> 9) & 1) << 5); R = (st >> 1) * 16 + swz / 64; C = (st & 1) * 32 + (swz % 64) / 2; }
__device__ __forceinline__ int perm32(int rho) { const int n = rho >> 4, i = rho & 15; return 8 * (i >> 2) + 4 * n + (i & 3); }
}
template <bool ALIGN_EPI, class Sched, class Epi>
__device__ __forceinline__ void gemm_fast(const Frame& F, const bf16_t* A, int K, const Sched& S, const Epi& E) {
    using namespace pg8;
    LAS unsigned char* lds = F.lds;
    const int tid = F.tid, wid = F.wave, lane = F.lane, wr = wid >> 2, wc = wid & 3, fr = lane & 15, fq = lane >> 4;
    const int nt = K / BK;
    int RA[2], CA[2]; unsigned voffB[2];
#pragma unroll
    for (int i = 0; i < 2; ++i) { int R, C; stage_rc(tid * 16 + i * 8192, R, C); RA[i] = R; CA[i] = C; const int Rb = (R & ~31) + perm32(R & 31); voffB[i] = (unsigned)(Rb * 64 + C) * 2u; }
    const size_t kstep = (size_t)(BK * 2);
    const size_t kstepB = (size_t)S.brows() * BK * 2;
    const size_t hstep = (size_t)HALF * BK * 2;
    const unsigned ldsw = (unsigned)wid * 1024u;
    const int aoff = lds_byte(wr * 64 + fr, fq * 8), boff = lds_byte(wc * 32 + fr, fq * 8);
    const char* Ab = (const char*)A;
#define PG8_SA(b, h) (((b) * 2 + (h)) * HTB)
#define PG8_SB(b, h) ((4 + (b) * 2 + (h)) * HTB)
#define PG8_STAGE(bufoff, gbase, voff) do { _Pragma("unroll") for (int _i = 0; _i < 2; ++_i) \
        __builtin_amdgcn_global_load_lds((const unsigned*)((const char*)(gbase) + (voff)[_i]), (LAS unsigned*)(lds + (bufoff) + ldsw + _i * 8192), 16, 0, 0); } while (0)
#define PG8_LDA(dst, b, h) do { _Pragma("unroll") for (int m = 0; m < 4; ++m) _Pragma("unroll") for (int k = 0; k < 2; ++k) dst[m][k] = *(const LAS bf16x8*)(lds + PG8_SA(b, h) + aoff + m * 2048 + k * 1024); } while (0)
#define PG8_LDB(dst, b, h) do { _Pragma("unroll") for (int n = 0; n < 2; ++n) _Pragma("unroll") for (int k = 0; k < 2; ++k) dst[n][k] = *(const LAS bf16x8*)(lds + PG8_SB(b, h) + boff + n * 2048 + k * 1024); } while (0)
#define PG8_MMA(ai, bj, At, Bt) do { __builtin_amdgcn_s_setprio(1); _Pragma("unroll") for (int m = 0; m < 4; ++m) _Pragma("unroll") for (int n = 0; n < 2; ++n) _Pragma("unroll") for (int k = 0; k < 2; ++k) \
        acc[ai][bj][m][n] = __builtin_amdgcn_mfma_f32_16x16x32_bf16(Bt[n][k], At[m][k], acc[ai][bj][m][n], 0, 0, 0); __builtin_amdgcn_s_setprio(0); } while (0)
#define PG8_WAIT_V(n) asm volatile("s_waitcnt vmcnt(" #n ")" ::: "memory")
#define PG8_WAIT_L(n) asm volatile("s_waitcnt lgkmcnt(" #n ")" ::: "memory")
#define PG8_BAR __builtin_amdgcn_s_barrier()
#define PG8_SCHED __builtin_amdgcn_sched_barrier(0)
#define PG8_VOFF(dst, u) do { _Pragma("unroll") for (int _h = 0; _h < 2; ++_h) _Pragma("unroll") for (int _i = 0; _i < 2; ++_i) \
        dst[_h][_i] = (unsigned)S.arow(u, 128 * _h + RA[_i]) * (unsigned)(K * 2) + (unsigned)(CA[_i] * 2); } while (0)
    Unit cur, nxt; int ui = 0;
    if (!S.next(0, cur)) return;
    f32x4 acc[2][2][4][2];
#pragma unroll
    for (int a = 0; a < 2; ++a)
#pragma unroll
        for (int b = 0; b < 2; ++b)
#pragma unroll
            for (int m = 0; m < 4; ++m)
#pragma unroll
                for (int n = 0; n < 2; ++n) acc[a][b][m][n] = (f32x4){0.f, 0.f, 0.f, 0.f};
    bf16x8 At[4][2], B0[2][2], B1[2][2];
    unsigned vC[2][2], vN[2][2];
    PG8_VOFF(vC, cur);
    const char* cB = (const char*)S.bbase(cur);
    PG8_STAGE(PG8_SB(0, 0), cB, voffB); PG8_STAGE(PG8_SB(0, 1), cB + hstep, voffB); PG8_STAGE(PG8_SA(0, 0), Ab, vC[0]); PG8_STAGE(PG8_SA(0, 1), Ab, vC[1]);
    if (wr == 1) PG8_BAR;
    PG8_WAIT_V(2); PG8_BAR;
    PG8_STAGE(PG8_SB(1, 0), cB + kstepB, voffB); PG8_STAGE(PG8_SA(1, 0), Ab + kstep, vC[0]); PG8_STAGE(PG8_SB(1, 1), cB + hstep + kstepB, voffB);
    PG8_WAIT_V(6); PG8_BAR;
    for (;;) {
        const bool has_next = S.next(ui + 1, nxt);
        const char* nB = cB;
        if (has_next) { PG8_VOFF(vN, nxt); nB = (const char*)S.bbase(nxt); }
        else {
#pragma unroll
            for (int h = 0; h < 2; ++h)
#pragma unroll
                for (int i = 0; i < 2; ++i) vN[h][i] = vC[h][i]; }
        for (int t = 0; t < nt; t += 2) {
            const bool last = (t == nt - 2);
            const char* a1 = Ab + (size_t)(t + 1) * kstep;
            const char* a2 = last ? Ab : Ab + (size_t)(t + 2) * kstep; const char* b2 = last ? nB : cB + (size_t)(t + 2) * kstepB;
            const char* a3 = a2 + kstep; const char* b3 = b2 + kstepB;
            unsigned v2[2][2];
#pragma unroll
            for (int h = 0; h < 2; ++h)
#pragma unroll
                for (int i = 0; i < 2; ++i) v2[h][i] = last ? vN[h][i] : vC[h][i];
            PG8_LDB(B0, 0, 0); PG8_LDB(B1, 0, 1); PG8_SCHED; PG8_LDA(At, 0, 0); PG8_STAGE(PG8_SA(1, 1), a1, vC[1]);
            PG8_WAIT_V(8); PG8_WAIT_L(0); PG8_BAR; PG8_MMA(0, 0, At, B0); PG8_MMA(0, 1, At, B1); PG8_BAR; PG8_SCHED;
            PG8_LDA(At, 0, 1); PG8_STAGE(PG8_SB(0, 0), b2, voffB); PG8_STAGE(PG8_SB(0, 1), b2 + hstep, voffB); PG8_STAGE(PG8_SA(0, 0), a2, v2[0]);
            PG8_WAIT_V(8); PG8_WAIT_L(0); PG8_BAR; PG8_MMA(1, 0, At, B0); PG8_MMA(1, 1, At, B1); PG8_BAR; PG8_SCHED;
            PG8_LDB(B0, 1, 0); PG8_LDB(B1, 1, 1); PG8_SCHED; PG8_LDA(At, 1, 0); PG8_STAGE(PG8_SA(0, 1), a2, v2[1]);
            PG8_WAIT_V(8); PG8_WAIT_L(0); PG8_BAR; PG8_MMA(0, 0, At, B0); PG8_MMA(0, 1, At, B1); PG8_BAR; PG8_SCHED;
            PG8_LDA(At, 1, 1); PG8_STAGE(PG8_SB(1, 0), b3, voffB); PG8_STAGE(PG8_SB(1, 1), b3 + hstep, voffB); PG8_STAGE(PG8_SA(1, 0), a3, v2[0]);
            PG8_WAIT_V(8); PG8_WAIT_L(0); PG8_BAR; PG8_MMA(1, 0, At, B0); PG8_MMA(1, 1, At, B1); PG8_BAR; PG8_SCHED;
        }
        if (ALIGN_EPI) { if (wr == 0) PG8_BAR; }
        E(acc, cur, wr, wc, fr, fq);
        if (!has_next) break;
#pragma unroll
        for (int a = 0; a < 2; ++a)
#pragma unroll
            for (int b = 0; b < 2; ++b)
#pragma unroll
                for (int m = 0; m < 4; ++m)
#pragma unroll
                    for (int n = 0; n < 2; ++n) acc[a][b][m][n] = (f32x4){0.f, 0.f, 0.f, 0.f};
        cur = nxt; cB = nB; ++ui;
#pragma unroll
        for (int h = 0; h < 2; ++h)
#pragma unroll
            for (int i = 0; i < 2; ++i) vC[h][i] = vN[h][i];
        if (ALIGN_EPI) { if (wr == 1) PG8_BAR; }
    }
    PG8_WAIT_V(0);
    if (!ALIGN_EPI) { if (wr == 0) PG8_BAR; }
    PG8_BAR;
#undef PG8_SA
#undef PG8_SB
#undef PG8_STAGE
#undef PG8_LDA
#undef PG8_LDB
#undef PG8_MMA
#undef PG8_WAIT_V
#undef PG8_WAIT_L
#undef PG8_BAR
#undef PG8_SCHED
#undef PG8_VOFF
}
#ifndef ALIGN_G2
#define ALIGN_G2 false
#endif
#define GEMM gemm_fast<true>
#define GEMM2 gemm_fast<ALIGN_G2>

__device__ __forceinline__ u32x4 pack8(const f32x4& a, const f32x4& b) { u32x4 w; w.x = pk2(a[0], a[1]); w.y = pk2(a[2], a[3]); w.z = pk2(b[0], b[1]); w.w = pk2(b[2], b[3]); return w; }
template <bool GLU> struct EpiInProj {
    bf16_t* Q; bf16_t* KR; bf16_t* Vn; bf16_t* Gb;
    __device__ __forceinline__ void operator()(const f32x4 (&acc)[2][2][4][2], const Unit& u, int wr, int wc, int fr, int fq) const {
#pragma unroll
        for (int ai = 0; ai < 2; ++ai)
#pragma unroll
            for (int m = 0; m < 4; ++m) { const int irow = u.pm * 256 + 128 * ai + 64 * wr + 16 * m + fr; const size_t row = (size_t)irow; const int cl = 32 * wc + 8 * fq;
                if (u.pn < 2) { *(u32x4*)(Q + row * 512 + u.pn * 256 + cl) = pack8(acc[ai][0][m][0], acc[ai][0][m][1]); *(u32x4*)(Q + row * 512 + u.pn * 256 + 128 + cl) = pack8(acc[ai][1][m][0], acc[ai][1][m][1]); }
                else if (u.pn == 2) { const size_t kvrow = irow < TX ? (size_t)(irow >> 12) * KVS + CTXL + (irow & 4095) : (size_t)((irow - TX) >> 8) * KVS + ((irow - TX) & 255);
                    *(u32x4*)(KR + kvrow * 128 + cl) = pack8(acc[ai][0][m][0], acc[ai][0][m][1]); *(u32x4*)(Vn + kvrow * 128 + cl) = pack8(acc[ai][1][m][0], acc[ai][1][m][1]); }
                else if (GLU) { f32x4 g0, g1;
#pragma unroll
                    for (int j = 0; j < 4; ++j) { g0[j] = acc[ai][0][m][0][j] * sigmoidf_(acc[ai][1][m][0][j]); g1[j] = acc[ai][0][m][1][j] * sigmoidf_(acc[ai][1][m][1][j]); }
                    *(u32x4*)(Gb + row * 512 + (u.pn - 3) * 128 + cl) = pack8(g0, g1); }
                else { *(u32x4*)(Gb + row * 512 + (u.pn - 3) * 256 + cl) = pack8(acc[ai][0][m][0], acc[ai][0][m][1]); *(u32x4*)(Gb + row * 512 + (u.pn - 3) * 256 + 128 + cl) = pack8(acc[ai][1][m][0], acc[ai][1][m][1]); }
            }
    }
};
template <bool L0, bool DRY = false> struct EpiOutProj {
    Frame F; int l;
    __device__ __forceinline__ void operator()(const f32x4 (&acc)[2][2][4][2], const Unit& u, int wr, int wc, int fr, int fq) const {
        float* SS = (float*)(F.ws + WS_SS);
        const float* g1 = F.mod(l, modrow(u.pm * 256), 2) + u.pn * 256 + 32 * wc + 8 * fq;
        f32x4 gv[2][2];
#pragma unroll
        for (int bj = 0; bj < 2; ++bj)
#pragma unroll
            for (int n = 0; n < 2; ++n) gv[bj][n] = *(const f32x4*)(g1 + 128 * bj + 4 * n);
#pragma unroll
        for (int ai = 0; ai < 2; ++ai) {
            f32x4 xv[4][2][2];
#pragma unroll
            for (int m = 0; m < 4; ++m) { const int row = u.pm * 256 + 128 * ai + 64 * wr + 16 * m + fr; const int c0 = u.pn * 256 + 32 * wc + 8 * fq;
#pragma unroll
                for (int bj = 0; bj < 2; ++bj) {
                    if (L0) { const float* src = F.xin_row(row) + c0 + 128 * bj; xv[m][bj][0] = *(const f32x4*)(src); xv[m][bj][1] = *(const f32x4*)(src + 4); }
                    else { const u32x4 w = *(const u32x4*)(F.xr_row(row) + c0 + 128 * bj); xv[m][bj][0] = (f32x4){bflo(w.x), bfhi(w.x), bflo(w.y), bfhi(w.y)}; xv[m][bj][1] = (f32x4){bflo(w.z), bfhi(w.z), bflo(w.w), bfhi(w.w)}; } } }
#pragma unroll
            for (int m = 0; m < 4; ++m) { const int row = u.pm * 256 + 128 * ai + 64 * wr + 16 * m + fr; bf16_t* dst = F.xr_row(row) + u.pn * 256 + 32 * wc + 8 * fq; float q = 0.f;
#pragma unroll
                for (int bj = 0; bj < 2; ++bj) { const f32x4 v0 = xv[m][bj][0] + gv[bj][0] * acc[ai][bj][m][0], v1 = xv[m][bj][1] + gv[bj][1] * acc[ai][bj][m][1];
                    *(u32x4*)(dst + 128 * bj) = DRY ? pack8(xv[m][bj][0], xv[m][bj][1]) : pack8(v0, v1);
                    q += ((v0[0] * v0[0] + v0[1] * v0[1]) + (v0[2] * v0[2] + v0[3] * v0[3])) + ((v1[0] * v1[0] + v1[1] * v1[1]) + (v1[2] * v1[2] + v1[3] * v1[3])); }
                q += __shfl_xor(q, 16); q += __shfl_xor(q, 32);
                if (fq == 0) SS[(size_t)row * 16 + u.pn * 4 + wc] = q; }
        }
    }
};
struct EpiMoe1 {
    bf16_t* HID;
    __device__ __forceinline__ void operator()(const f32x4 (&acc)[2][2][4][2], const Unit& u, int wr, int wc, int fr, int fq) const {
#pragma unroll
        for (int ai = 0; ai < 2; ++ai)
#pragma unroll
            for (int m = 0; m < 4; ++m) { const size_t slot = (size_t)u.pm * 256 + 128 * ai + 64 * wr + 16 * m + fr; f32x4 h0, h1;
#pragma unroll
                for (int j = 0; j < 4; ++j) { const float a = acc[ai][0][m][0][j], b = acc[ai][0][m][1][j]; h0[j] = a * sigmoidf_(a) * acc[ai][1][m][0][j]; h1[j] = b * sigmoidf_(b) * acc[ai][1][m][1][j]; }
                *(u32x4*)(HID + slot * 512 + u.pn * 128 + 32 * wc + 8 * fq) = pack8(h0, h1); }
    }
};
struct EpiMoe2 {
    bf16_t* YB;
    __device__ __forceinline__ void operator()(const f32x4 (&acc)[2][2][4][2], const Unit& u, int wr, int wc, int fr, int fq) const {
#pragma unroll
        for (int ai = 0; ai < 2; ++ai)
#pragma unroll
            for (int m = 0; m < 4; ++m) { const size_t slot = (size_t)u.pm * 256 + 128 * ai + 64 * wr + 16 * m + fr;
#pragma unroll
                for (int bj = 0; bj < 2; ++bj) *(u32x4*)(YB + slot * 1024 + u.pn * 256 + 128 * bj + 32 * wc + 8 * fq) = pack8(acc[ai][bj][m][0], acc[ai][bj][m][1]); }
    }
};

__device__ __forceinline__ void p_k_post(const Frame& F, const float* kg) {
    const int gw = F.vcu * NWAVES + F.wave, NGW = F.G * NWAVES, lane = F.lane;
    const bf16_t* KR = (const bf16_t*)(F.ws + WS_KV); bf16_t* Kn = (bf16_t*)(F.ws + WS_KN);
    const float* rc = (const float*)(F.ws + WS_ROPE); const float* rs = rc + SEQ * 32;
    const int c16 = lane & 15, i8 = c16 & 7, dd0 = 8 * (i8 & 3), sub = lane >> 4;
    float gk[8];
#pragma unroll
    for (int j = 0; j < 8; ++j) gk[j] = kg[i8 * 8 + j];
    const float sgn = (i8 < 4) ? -1.f : 1.f;
    for (int it = gw; it < NB * KVS / 16; it += NGW) {
        u32x4 w[4];
#pragma unroll
        for (int q = 0; q < 4; ++q) w[q] = *(const u32x4*)(KR + (size_t)(it * 16 + 4 * q + sub) * 128 + c16 * 8);
#pragma unroll
        for (int q = 0; q < 4; ++q) { const int kvrow = it * 16 + 4 * q + sub, pos = kvrow % KVS;
            float cs[8], sn[8];
#pragma unroll
            for (int j = 0; j < 8; ++j) { cs[j] = 1.f; sn[j] = 0.f; }
            if (pos >= CTXL) { const int sq = pos - CTXL; const f32x4 c0 = *(const f32x4*)(rc + sq * 32 + dd0), c1 = *(const f32x4*)(rc + sq * 32 + dd0 + 4), s0 = *(const f32x4*)(rs + sq * 32 + dd0), s1 = *(const f32x4*)(rs + sq * 32 + dd0 + 4);
#pragma unroll
                for (int j = 0; j < 4; ++j) { cs[j] = c0[j]; cs[4 + j] = c1[j]; sn[j] = s0[j]; sn[4 + j] = s1[j]; } }
            float x[8] = {bflo(w[q].x), bfhi(w[q].x), bflo(w[q].y), bfhi(w[q].y), bflo(w[q].z), bfhi(w[q].z), bflo(w[q].w), bfhi(w[q].w)};
            float ss = 0.f;
#pragma unroll
            for (int j = 0; j < 8; ++j) ss += x[j] * x[j];
            ss += __shfl_xor(ss, 1); ss += __shfl_xor(ss, 2); ss += __shfl_xor(ss, 4);
            const float rms = 1.0f / sqrtf(ss * (1.f / 64.f) + EPS);
            float y[8], o[8];
#pragma unroll
            for (int j = 0; j < 8; ++j) y[j] = x[j] * rms * gk[j];
#pragma unroll
            for (int j = 0; j < 8; ++j) { const float yp = __shfl_xor(y[j], 4); o[j] = y[j] * cs[j] + sgn * yp * sn[j]; }
            u32x4 ow; ow.x = pk2(o[0], o[1]); ow.y = pk2(o[2], o[3]); ow.z = pk2(o[4], o[5]); ow.w = pk2(o[6], o[7]);
            *(u32x4*)(Kn + (size_t)kvrow * 128 + c16 * 8) = ow; }
    }
}
__device__ __forceinline__ void p_conv(const Frame& F) {
    const bf16_t* Gb = (const bf16_t*)(F.ws + WS_G); bf16_t* AO = (bf16_t*)(F.ws + WS_AO);
    LAS bf16_t* gl = (LAS bf16_t*)F.lds;
    LAS float* yl = (LAS float*)(F.lds + 65536);
    const int c = F.tid;
    float w[31];
#pragma unroll
    for (int j = 0; j < 31; ++j) w[j] = F.in[I_CONVW][j * 512 + c];
    const float bias = F.in[I_CONVB][c];
    u32x4 pre[8];
#define CONV_ITEM(item, rowbase, t0, len) do { if ((item) < 1024) { rowbase = ((item) >> 7) * SEQ; t0 = ((item) & 127) * 32; len = SEQ; } else { const int it_ = (item) - 1024; rowbase = TX + (it_ >> 3) * CTXL; t0 = (it_ & 7) * 32; len = CTXL; } } while (0)
#define CONV_LOAD(item) do { int rb_, t0_, len_; CONV_ITEM(item, rb_, t0_, len_); _Pragma("unroll") for (int q = 0; q < 8; ++q) { const int ch = F.tid + q * NTHREADS, r = ch >> 6, p = t0_ - 15 + r; pre[q] = (u32x4){0u, 0u, 0u, 0u}; \
        if (ch < 62 * 64 && p >= 0 && p < len_) pre[q] = *(const u32x4*)(Gb + (size_t)(rb_ + p) * 512 + (ch & 63) * 8); } } while (0)
    if (F.vcu < 1024 + 64) CONV_LOAD(F.vcu);
    for (int item = F.vcu; item < 1024 + 64; item += F.G) {
        int rowbase, t0, len; CONV_ITEM(item, rowbase, t0, len);
        __syncthreads();
#pragma unroll
        for (int q = 0; q < 8; ++q) { const int ch = F.tid + q * NTHREADS; if (ch < 62 * 64) *(LAS u32x4*)(gl + (ch >> 6) * 512 + (ch & 63) * 8) = pre[q]; }
        __syncthreads();
        if (item + F.G < 1024 + 64) CONV_LOAD(item + F.G);
        float g[62];
#pragma unroll
        for (int r = 0; r < 62; ++r) g[r] = bf2f(gl[r * 512 + c]);
#pragma unroll
        for (int t = 0; t < 32; ++t) { float y = bias;
#pragma unroll
            for (int j = 0; j < 31; ++j) y += g[t + j] * w[j];
            yl[t * 512 + c] = y; }
        __syncthreads();
#pragma unroll
        for (int tt = 0; tt < 4; ++tt) { const int t = 4 * F.wave + tt; float v[8]; float sm = 0.f;
#pragma unroll
            for (int j = 0; j < 8; ++j) { v[j] = yl[t * 512 + F.lane + 64 * j]; sm += v[j]; }
            const float mean = wave_sum(sm) * (1.f / 512.f); float q = 0.f;
#pragma unroll
            for (int j = 0; j < 8; ++j) { v[j] -= mean; q += v[j] * v[j]; }
            const float rstd = 1.0f / sqrtf(wave_sum(q) * (1.f / 512.f) + EPS);
            bf16_t* orow = AO + (size_t)(rowbase + t0 + t) * 1024 + 512;
#pragma unroll
            for (int j = 0; j < 8; ++j) { const int cc = F.lane + 64 * j; const float yn = v[j] * rstd * F.in[I_CLNG][cc] + F.in[I_CLNB][cc]; orow[cc] = (bf16_t)(pk2(yn * sigmoidf_(yn), 0.f) & 0xffffu); } }
    }
#undef CONV_ITEM
#undef CONV_LOAD
    __syncthreads();
}
__device__ __forceinline__ void p_pool(const Frame& F) {
    const int gw = F.vcu * NWAVES + F.wave, NGW = F.G * NWAVES, lane = F.lane;
    const bf16_t* U = (const bf16_t*)(F.ws + WS_G); bf16_t* AO = (bf16_t*)(F.ws + WS_AO);
    const int hw = 1 << (lane >> 4);
    float wgt[16];
#pragma unroll
    for (int i = 0; i < 16; ++i) wgt[i] = (i >= 8 - hw && i < 8 + hw) ? 1.f : 0.f;
    for (int it = gw; it < TX / 8; it += NGW) {
        const int row0 = it * 8, t0 = row0 & 4095, rb = row0 - t0;
        u32x4 r[23];
#pragma unroll
        for (int j = 0; j < 23; ++j) { const int p = t0 - 8 + j; r[j] = (u32x4){0u, 0u, 0u, 0u}; if (p >= 0 && p < SEQ) r[j] = *(const u32x4*)(U + (size_t)(rb + p) * 512 + lane * 8); }
#pragma unroll
        for (int t = 0; t < 8; ++t) {
            float s[8];
#pragma unroll
            for (int j = 0; j < 8; ++j) s[j] = 0.f;
#pragma unroll
            for (int i = 0; i < 16; ++i) { const u32x4 w = r[t + i]; const float g = wgt[i];
                s[0] += g * bflo(w.x); s[1] += g * bfhi(w.x); s[2] += g * bflo(w.y); s[3] += g * bfhi(w.y); s[4] += g * bflo(w.z); s[5] += g * bfhi(w.z); s[6] += g * bflo(w.w); s[7] += g * bfhi(w.w); }
            const int tt = t0 + t; int lo = tt - hw, hi = tt + hw; lo = lo < 0 ? 0 : lo; hi = hi > SEQ ? SEQ : hi;
            const float inv = 1.f / (float)(hi - lo); const u32x4 w = r[t + 8];
            u32x4 ow; ow.x = pk2(s[0] * inv - bflo(w.x), s[1] * inv - bfhi(w.x)); ow.y = pk2(s[2] * inv - bflo(w.y), s[3] * inv - bfhi(w.y)); ow.z = pk2(s[4] * inv - bflo(w.z), s[5] * inv - bfhi(w.z)); ow.w = pk2(s[6] * inv - bflo(w.w), s[7] * inv - bfhi(w.w));
            *(u32x4*)(AO + (size_t)(row0 + t) * 1024 + 512 + lane * 8) = ow;
        }
    }
}

template <int LAYER> __device__ __forceinline__ void attn_simple(const Frame& F) {
    const bf16_t* Q = (const bf16_t*)(F.ws + WS_Q); const bf16_t* Kn = (const bf16_t*)(F.ws + WS_KN); const bf16_t* Vn = (const bf16_t*)(F.ws + WS_VN); bf16_t* AO = (bf16_t*)(F.ws + WS_AO);
    const int nunits = LAYER == 0 ? 512 + 64 : 512;
    for (int u = F.vcu; u < nunits; u += F.G) {
        int b, h, row, s; bool valid = true, isctx = false;
        if (u < 512) { b = u >> 6; h = (u >> 3) & 7; s = (u & 7) * 512 + F.tid; row = b * SEQ + s; }
        else { const int uc = u - 512; b = uc >> 3; h = uc & 7; s = F.tid; valid = F.tid < 256; row = TX + b * CTXL + (valid ? s : 0); isctx = true; }
        float q[64], o[64];
        { const u32x4* qp = (const u32x4*)(Q + (size_t)row * 512 + h * 64);
#pragma unroll
          for (int c = 0; c < 8; ++c) { const u32x4 w = qp[c]; q[8 * c] = bflo(w.x); q[8 * c + 1] = bfhi(w.x); q[8 * c + 2] = bflo(w.y); q[8 * c + 3] = bfhi(w.y); q[8 * c + 4] = bflo(w.z); q[8 * c + 5] = bfhi(w.z); q[8 * c + 6] = bflo(w.w); q[8 * c + 7] = bfhi(w.w); } }
#pragma unroll
        for (int d = 0; d < 64; ++d) o[d] = 0.f;
        float mx = -1e30f, l = 0.f;
        const bf16_t* Kb = Kn + (size_t)b * KVS * 128 + (h >> 2) * 64; const bf16_t* Vb = Vn + (size_t)b * KVS * 128 + (h >> 2) * 64;
        int k_lo2 = 0, k_hi2 = 0;
        const int k_hi1 = CTXL;
        if (LAYER == 0) { if (!isctx) { k_lo2 = CTXL; k_hi2 = KVS; } }
        else { const int s0 = (u & 7) * 512; int lo = s0 - 128, hi = s0 + 511 + 128 + 1; lo = lo < 0 ? 0 : lo; hi = hi > SEQ ? SEQ : hi; k_lo2 = CTXL + lo; k_hi2 = CTXL + hi; }
        for (int part = 0; part < 2; ++part) {
            const int kb = part == 0 ? 0 : k_lo2, ke = part == 0 ? k_hi1 : k_hi2;
            for (int key = kb; key < ke; ++key) {
                const u32x4* kp = (const u32x4*)(Kb + (size_t)key * 128); float sd = 0.f;
#pragma unroll
                for (int c = 0; c < 8; ++c) { const u32x4 w = kp[c];
                    sd += q[8 * c] * bflo(w.x) + q[8 * c + 1] * bfhi(w.x) + q[8 * c + 2] * bflo(w.y) + q[8 * c + 3] * bfhi(w.y) + q[8 * c + 4] * bflo(w.z) + q[8 * c + 5] * bfhi(w.z) + q[8 * c + 6] * bflo(w.w) + q[8 * c + 7] * bfhi(w.w); }
                bool use = valid;
                if (LAYER == 1 && part == 1) { const int j = key - CTXL; const int dlt = s - j; use = use && (dlt <= 128 && dlt >= -128); }
                const float mn = fmaxf(mx, sd); const float mnew = use ? mn : mx;
                const float alpha = exp2f(mx - mnew), p = use ? exp2f(sd - mnew) : 0.f;
                mx = mnew; l = l * alpha + p;
                const u32x4* vp = (const u32x4*)(Vb + (size_t)key * 128);
#pragma unroll
                for (int c = 0; c < 8; ++c) { const u32x4 w = vp[c];
                    o[8 * c] = o[8 * c] * alpha + p * bflo(w.x); o[8 * c + 1] = o[8 * c + 1] * alpha + p * bfhi(w.x); o[8 * c + 2] = o[8 * c + 2] * alpha + p * bflo(w.y); o[8 * c + 3] = o[8 * c + 3] * alpha + p * bfhi(w.y);
                    o[8 * c + 4] = o[8 * c + 4] * alpha + p * bflo(w.z); o[8 * c + 5] = o[8 * c + 5] * alpha + p * bfhi(w.z); o[8 * c + 6] = o[8 * c + 6] * alpha + p * bflo(w.w); o[8 * c + 7] = o[8 * c + 7] * alpha + p * bfhi(w.w); }
            }
        }
        if (LAYER == 1) l += exp2f(F.in[I_SINK][h] * LOG2E - mx);
        const float il = 1.f / l;
        if (valid) { u32x4* op = (u32x4*)(AO + (size_t)row * 1024 + h * 64);
#pragma unroll
            for (int c = 0; c < 8; ++c) { u32x4 w; w.x = pk2(o[8 * c] * il, o[8 * c + 1] * il); w.y = pk2(o[8 * c + 2] * il, o[8 * c + 3] * il); w.z = pk2(o[8 * c + 4] * il, o[8 * c + 5] * il); w.w = pk2(o[8 * c + 6] * il, o[8 * c + 7] * il); op[c] = w; } }
    }
}

#include <hip/hip_bf16.h>
namespace attn_body {
using bf16=__hip_bfloat16;
using s16x4=__attribute__((ext_vector_type(4)))short;
using f32x16=__attribute__((ext_vector_type(16)))float;
constexpr int NW=8,QBLK=32,QB=QBLK*NW,KVBLK=64;
constexpr int QP=512,KP=128,OP=1024;
__device__ __forceinline__ int crow(int r,int hi){return (r&3)+8*(r>>2)+4*hi;}
#define SBAR() __builtin_amdgcn_sched_barrier(0)
__device__ __forceinline__ void wmask(f32x16&p0,f32x16&p1,int dlt0,int hi){
  const float NEG=-INFINITY; const int kb=dlt0+4*hi;
  #pragma unroll
  for(int r=0;r<16;++r){const int d=kb+(r&3)+8*(r>>2); if(d>128||d<-128)p0[r]=NEG; if(d+32>128||d+32<-128)p1[r]=NEG;}
}

constexpr int NSLOT=3, SLOTB=8192;
constexpr int LDS_K=0, LDS_V=NSLOT*SLOTB, LDS_WS=2*NSLOT*SLOTB, LDS_OST=LDS_WS+NW*64*4, LDS_BYTES=LDS_OST+NW*4096;
__device__ __forceinline__ void glds16(const void*gsrc,unsigned lds_dst){unsigned keep;
  asm volatile("s_mov_b32 %0, m0\n\ts_mov_b32 m0, %2\n\ts_nop 0\n\tglobal_load_lds_dwordx4 %1, off\n\ts_mov_b32 m0, %0":"=&s"(keep):"v"(gsrc),"s"(lds_dst):"memory");}
__device__ __forceinline__ float max3f(float a,float b,float c){float r;asm("v_max3_f32 %0, %1, %2, %3":"=v"(r):"v"(a),"v"(b),"v"(c));return r;}
__device__ __forceinline__ float max2f(float a,float b){float r;asm("v_max_f32_e32 %0, %1, %2":"=v"(r):"v"(a),"v"(b));return r;}
__device__ __forceinline__ float fadd_s(float a,float b){float r;asm("v_add_f32_e32 %0, %1, %2":"=v"(r):"v"(a),"v"(b));return r;}
__device__ __forceinline__ float fsub_s(float a,float b){float r;asm("v_sub_f32_e32 %0, %1, %2":"=v"(r):"v"(a),"v"(b));return r;}
typedef float f32x2_t __attribute__((ext_vector_type(2))); typedef __bf16 bf16x2_t __attribute__((ext_vector_type(2)));
__device__ __forceinline__ unsigned cvtpk_s(float lo,float hi){f32x2_t v={lo,hi};bf16x2_t b=__builtin_convertvector(v,bf16x2_t);return __builtin_bit_cast(unsigned,b);}
#define WAIT_BAR(N) asm volatile("s_waitcnt vmcnt(" #N ") lgkmcnt(0)\n\ts_barrier":::"memory")

__device__ __forceinline__ void qkt(f32x16&p0,f32x16&p1,const char*Kslot,const bf16x8*qr,const f32x16&negm,int r32,int hi){
  const char*kb=Kslot+hi*1024+r32*16;
  #pragma unroll
  for(int d0=0;d0<4;++d0){
    const bf16x8 b0=*reinterpret_cast<const bf16x8*>(kb+d0*2048);
    const bf16x8 b1=*reinterpret_cast<const bf16x8*>(kb+d0*2048+512);
    if(d0==0){p0=__builtin_amdgcn_mfma_f32_32x32x16_bf16(b0,qr[0],negm,0,0,0);p1=__builtin_amdgcn_mfma_f32_32x32x16_bf16(b1,qr[0],negm,0,0,0);}
    else{p0=__builtin_amdgcn_mfma_f32_32x32x16_bf16(b0,qr[d0],p0,0,0,0);p1=__builtin_amdgcn_mfma_f32_32x32x16_bf16(b1,qr[d0],p1,0,0,0);}}
}
typedef __attribute__((address_space(3))) const char* lds_cptr;
typedef short v4i16_t __attribute__((ext_vector_type(4)));
__device__ __forceinline__ void kload8(bf16x8*kf,lds_cptr kp){
  kf[0]=*(const __attribute__((address_space(3))) bf16x8*)(kp);      kf[1]=*(const __attribute__((address_space(3))) bf16x8*)(kp+512);
  kf[2]=*(const __attribute__((address_space(3))) bf16x8*)(kp+2048); kf[3]=*(const __attribute__((address_space(3))) bf16x8*)(kp+2560);
  kf[4]=*(const __attribute__((address_space(3))) bf16x8*)(kp+4096); kf[5]=*(const __attribute__((address_space(3))) bf16x8*)(kp+4608);
  kf[6]=*(const __attribute__((address_space(3))) bf16x8*)(kp+6144); kf[7]=*(const __attribute__((address_space(3))) bf16x8*)(kp+6656);
}
__device__ __forceinline__ void kload2(bf16x8*kf,lds_cptr kp,int j){ kf[2*j]=*(const __attribute__((address_space(3))) bf16x8*)(kp+j*2048); kf[2*j+1]=*(const __attribute__((address_space(3))) bf16x8*)(kp+j*2048+512); }
__device__ __forceinline__ s16x4 vtr(lds_cptr p){ return __builtin_bit_cast(s16x4,__builtin_amdgcn_ds_read_tr16_b64_v4i16((__attribute__((address_space(3))) v4i16_t*)p)); }
__device__ __forceinline__ float rowmax(const f32x16&p0,const f32x16&p1){
  float a=max3f(p0[0],p0[1],p1[0]),b=max3f(p0[2],p0[3],p1[1]);a=max3f(a,p1[2],p1[3]);
  #pragma unroll
  for(int r=4;r<16;r+=4){a=max3f(a,p0[r],p0[r+1]);b=max3f(b,p0[r+2],p0[r+3]);a=max3f(a,p1[r],p1[r+1]);b=max3f(b,p1[r+2],p1[r+3]);}
  const float m=max2f(a,b);
  auto rr=__builtin_amdgcn_permlane32_swap(__float_as_uint(m),__float_as_uint(m),false,false);
  return max2f(__uint_as_float(rr[0]),__uint_as_float(rr[1]));
}
__device__ __forceinline__ void pv(f32x16*o,int vb,bf16x8 pa0,bf16x8 pa1,bf16x8 pa2,bf16x8 pa3){
  #pragma unroll
  for(int d0=0;d0<2;++d0){s16x4 lo[4],hi[4];
    #pragma unroll
    for(int ks=0;ks<4;++ks){
      asm volatile("ds_read_b64_tr_b16 %0,%1 offset:%c2":"=&v"(lo[ks]):"v"(vb),"i"(d0*4096+ks*1024):"memory");
      asm volatile("ds_read_b64_tr_b16 %0,%1 offset:%c2":"=&v"(hi[ks]):"v"(vb),"i"(d0*4096+ks*1024+512):"memory");}
    asm volatile("s_waitcnt lgkmcnt(0)":::"memory");SBAR();
    #define PK(k) (bf16x8){lo[k][0],lo[k][1],lo[k][2],lo[k][3],hi[k][0],hi[k][1],hi[k][2],hi[k][3]}
    o[d0]=__builtin_amdgcn_mfma_f32_32x32x16_bf16(pa0,PK(0),o[d0],0,0,0);
    o[d0]=__builtin_amdgcn_mfma_f32_32x32x16_bf16(pa1,PK(1),o[d0],0,0,0);
    o[d0]=__builtin_amdgcn_mfma_f32_32x32x16_bf16(pa2,PK(2),o[d0],0,0,0);
    o[d0]=__builtin_amdgcn_mfma_f32_32x32x16_bf16(pa3,PK(3),o[d0],0,0,0);
    #undef PK
  }
}

#ifndef ATTN_STORE16
#define ATTN_STORE16(p,v) (*(u32x4*)(p)=(v))
#endif
template<int MODE,int THRL> __device__ __forceinline__ void attn_unit(const bf16*Qu,const bf16*__restrict__ Kh,const bf16*__restrict__ Vh,bf16*Ou,const int NT,const int lat0,const int q0s,const float sinkl2,const float*qg,const float*ropec,const bool rope,char*shm){
  int tid_=threadIdx.x; asm volatile("":"+v"(tid_));
  const int tid=tid_,lane=tid&63,r32=lane&31,hi=lane>>5; const int wid=__builtin_amdgcn_readfirstlane(tid>>6);
  const bf16*Qw=Qu+(long)(wid*QBLK)*QP;
  const unsigned lds0=(unsigned)(uintptr_t)shm;
  float*wsf=(float*)(shm+LDS_WS)+wid*64;
  const bf16*ksrc=Kh+(long)lane*KP+wid*8;
  const bf16*vsrc=Vh+(long)(16*(wid&3)+(lane>>2))*KP+(wid>>2)*32+(lane&3)*8;
  const unsigned kdst=lds0+LDS_K+wid*1024, vdst=lds0+LDS_V+wid*1024;
  #define TROW(t) ((MODE==0||(t)<4)?(t)*KVBLK:lat0+((t)-4)*KVBLK)
  #define DMA_K(t,slot) glds16(ksrc+(long)TROW(t)*KP,(unsigned)__builtin_amdgcn_readfirstlane(kdst+(slot)))
  #define DMA_V(t,slot) glds16(vsrc+(long)TROW(t)*KP,(unsigned)__builtin_amdgcn_readfirstlane(vdst+(slot)))
  const int vb0=(int)(lds0+LDS_V)+((lane>>4)&1)*32+(lane&3)*8+(4*hi+((lane&15)>>2))*64;
  const char*Kbase=shm+LDS_K; bf16x8 kf[8];
  const lds_cptr shm3=(lds_cptr)shm; const lds_cptr kp0=shm3+LDS_K+hi*1024+r32*16; const lds_cptr vp0=shm3+LDS_V+((lane>>4)&1)*32+(lane&3)*8+(4*hi+((lane&15)>>2))*64;
  DMA_K(0,0);DMA_V(0,0);DMA_K(1,SLOTB);
  bf16x8 qr[4];
  const int qpos=q0s+wid*QBLK+r32;
  {
    u32x4 qraw[4];
    #pragma unroll
    for(int d0=0;d0<4;++d0) qraw[d0]=*reinterpret_cast<const u32x4*>(&Qw[(long)r32*QP+d0*16+hi*8]);
    float x[4][8]; float ss=0.f;
    #pragma unroll
    for(int d0=0;d0<4;++d0){ x[d0][0]=bflo(qraw[d0].x);x[d0][1]=bfhi(qraw[d0].x);x[d0][2]=bflo(qraw[d0].y);x[d0][3]=bfhi(qraw[d0].y);x[d0][4]=bflo(qraw[d0].z);x[d0][5]=bfhi(qraw[d0].z);x[d0][6]=bflo(qraw[d0].w);x[d0][7]=bfhi(qraw[d0].w);
      #pragma unroll
      for(int j=0;j<8;++j)ss+=x[d0][j]*x[d0][j]; }
    {auto rr=__builtin_amdgcn_permlane32_swap(__float_as_uint(ss),__float_as_uint(ss),false,false);ss=__uint_as_float(rr[0])+__uint_as_float(rr[1]);}
    const float rms=C2/sqrtf(ss*(1.f/64.f)+EPS);
    SBAR();
    #pragma unroll
    for(int d0=0;d0<2;++d0){
      #pragma unroll
      for(int hf=0;hf<2;++hf){
        const f32x4 ga=*reinterpret_cast<const f32x4*>(qg+d0*16+hi*8+4*hf), gb=*reinterpret_cast<const f32x4*>(qg+(d0+2)*16+hi*8+4*hf);
        f32x4 cc=f32x4{1.f,1.f,1.f,1.f}, sn=f32x4{0.f,0.f,0.f,0.f};
        if(rope){ const float*pc=ropec+(long)qpos*32+d0*16+hi*8+4*hf; cc=*reinterpret_cast<const f32x4*>(pc); sn=*reinterpret_cast<const f32x4*>(pc+SEQ*32); }
        #pragma unroll
        for(int j=0;j<4;++j){ const float a=x[d0][4*hf+j]*rms*ga[j], b=x[d0+2][4*hf+j]*rms*gb[j]; x[d0][4*hf+j]=a*cc[j]-b*sn[j]; x[d0+2][4*hf+j]=b*cc[j]+a*sn[j]; }
        SBAR(); } }
    #pragma unroll
    for(int d0=0;d0<4;++d0){ u32x4 w; w.x=cvtpk_s(x[d0][0],x[d0][1]);w.y=cvtpk_s(x[d0][2],x[d0][3]);w.z=cvtpk_s(x[d0][4],x[d0][5]);w.w=cvtpk_s(x[d0][6],x[d0][7]); qr[d0]=__builtin_bit_cast(bf16x8,w); } }
  float mhat=0.f,l_reg=0.f;f32x16 o[2],negm; { float z_=0.f; asm volatile("":"+v"(z_));
    #pragma unroll
    for(int r=0;r<16;++r){o[0][r]=z_;o[1][r]=z_;negm[r]=z_;} } asm volatile("":"+v"(negm));
  #define CMASK(P0,P1,t) do{ if(MODE==1&&(t)>=4) wmask(P0,P1,(lat0-256)+((t)-4)*KVBLK-qpos,hi); }while(0)
  bool resc=false;
  #define START(P0,P1) do{ const float rm=rowmax(P0,P1); resc=false; \
    { const float dl=rm; mhat=fadd_s(mhat,dl); \
      _Pragma("unroll") for(int r=0;r<16;++r){P0[r]=fsub_s(P0[r],dl);P1[r]=fsub_s(P1[r],dl);} \
      _Pragma("unroll") for(int r=0;r<16;++r)negm[r]=-mhat; asm volatile("":"+v"(negm)); } \
    _Pragma("unroll") for(int r=0;r<16;++r)P0[r]=__builtin_amdgcn_exp2f(P0[r]); }while(0)
  #define RESC() do{ if(resc){ asm volatile("s_waitcnt lgkmcnt(0)":::"memory"); \
      _Pragma("unroll") for(int d_=0;d_<2;++d_) _Pragma("unroll") for(int r=0;r<16;++r)o[d_][r]*=wsf[crow(r,hi)]; } }while(0)
  f32x16 pA0,pA1,pB0,pB1;
  int sl_prev=0,sl_cur=0,sl_next=SLOTB;
  #define ROT() do{sl_prev=sl_cur;sl_cur=sl_next;sl_next=(sl_next==(NSLOT-1)*SLOTB)?0:sl_next+SLOTB;}while(0)
  DMA_K(2,2*SLOTB);
  WAIT_BAR(3);
  qkt(pA0,pA1,Kbase,qr,negm,r32,hi);asm volatile("s_nop 15\n\ts_nop 7":"+v"(pA0),"+v"(pA1));CMASK(pA0,pA1,0);
  START(pA0,pA1);
  _Pragma("unroll") for(int r=0;r<16;++r)pA1[r]=__builtin_amdgcn_exp2f(pA1[r]);
  WAIT_BAR(0);
  DMA_K(3,0);DMA_V(1,SLOTB);
  ROT();
  kload8(kf,kp0+sl_cur);
  WAIT_BAR(2);
  s16x4 vlo[8],vhi[8]; u32x4 pw0,pw1,pw2,pw3;
  #define PKW(P,B) cvtpk_s(P[B],P[B+1])
  #define PAF(k) __builtin_bit_cast(bf16x8,pw##k)
  #define VFR(i) (bf16x8){vlo[i][0],vlo[i][1],vlo[i][2],vlo[i][3],vhi[i][0],vhi[i][1],vhi[i][2],vhi[i][3]}
  #define PIN(x) asm volatile("":"+v"(x))
  #define MX3(a,b,c) __builtin_fmaxf(__builtin_fmaxf((a),(b)),(c))
  #define GAPA(MF,A0,A1,A2,A3,W0,W1,PW) do{ MF; sacc+=A0; sacc+=A1; sacc+=A2; sacc+=A3; PIN(sacc); W0; W1; PIN(PW); SBAR(); }while(0)
  #define EX(v) __builtin_amdgcn_exp2f(v)
  #define GAPB(MF,X,B) do{ MF; X[B]=EX(X[B]); X[B+1]=EX(X[B+1]); X[B+2]=EX(X[B+2]); X[B+3]=EX(X[B+3]); PIN(X); SBAR(); }while(0)
  #define VRD(i) do{ vlo[i]=vtr(vp_+(((i)>>2)*4096+((i)&3)*1024)); vhi[i]=vtr(vp_+(((i)>>2)*4096+((i)&3)*1024+512)); }while(0)
  #define KRD(G,j) do{ if(G){ kload2(kf,kp0+sl_next,j); SBAR(); } }while(0)
  #define STEP(C0,C1,P0,P1,t,GK,GV,GL) do{ SBAR(); \
    const lds_cptr vp_=vp0+sl_prev; \
    VRD(0); SBAR(); float sacc=(P0[0]+P0[1]); \
    GAPA(C0=__builtin_amdgcn_mfma_f32_32x32x16_bf16(kf[0],qr[0],negm,0,0,0), P0[2],P0[3],P0[4],P0[5],     pw0[0]=PKW(P0,0), pw0[1]=PKW(P0,2), pw0); \
    VRD(4); SBAR(); GAPA(C1=__builtin_amdgcn_mfma_f32_32x32x16_bf16(kf[1],qr[0],negm,0,0,0), P0[6],P0[7],P0[8],P0[9],     pw0[2]=PKW(P0,4), pw0[3]=PKW(P0,6), pw0); \
    VRD(1); SBAR(); GAPA(C0=__builtin_amdgcn_mfma_f32_32x32x16_bf16(kf[2],qr[1],C0,0,0,0),   P0[10],P0[11],P0[12],P0[13], pw1[0]=PKW(P0,8), pw1[1]=PKW(P0,10), pw1); \
    VRD(5); SBAR(); GAPA(C1=__builtin_amdgcn_mfma_f32_32x32x16_bf16(kf[3],qr[1],C1,0,0,0),   P0[14],P0[15],P1[0],P1[1],   pw1[2]=PKW(P0,12),pw1[3]=PKW(P0,14), pw1); \
    VRD(2); SBAR(); GAPA(C0=__builtin_amdgcn_mfma_f32_32x32x16_bf16(kf[4],qr[2],C0,0,0,0),   P1[2],P1[3],P1[4],P1[5],     pw2[0]=PKW(P1,0), pw2[1]=PKW(P1,2), pw2); \
    VRD(6); SBAR(); GAPA(C1=__builtin_amdgcn_mfma_f32_32x32x16_bf16(kf[5],qr[2],C1,0,0,0),   P1[6],P1[7],P1[8],P1[9],     pw2[2]=PKW(P1,4), pw2[3]=PKW(P1,6), pw2); \
    VRD(3); SBAR(); GAPA(C0=__builtin_amdgcn_mfma_f32_32x32x16_bf16(kf[6],qr[3],C0,0,0,0),   P1[10],P1[11],P1[12],P1[13], pw3[0]=PKW(P1,8), pw3[1]=PKW(P1,10), pw3); \
    VRD(7); SBAR(); GAPA(C1=__builtin_amdgcn_mfma_f32_32x32x16_bf16(kf[7],qr[3],C1,0,0,0),   P1[14],P1[15],0.f,0.f,       pw3[2]=PKW(P1,12),pw3[3]=PKW(P1,14), pw3); \
    l_reg+=sacc; \
    if(GK){DMA_K((t)+3,sl_cur);} if(GV){DMA_V((t)+1,sl_next);} \
    CMASK(C0,C1,t); \
    { float a=MX3(C0[0],C0[1],C1[0]),b=MX3(C0[2],C0[3],C1[1]); a=MX3(a,C1[2],C1[3]); \
      _Pragma("unroll") for(int r=4;r<16;r+=4){a=MX3(a,C0[r],C0[r+1]);b=MX3(b,C0[r+2],C0[r+3]);a=MX3(a,C1[r],C1[r+1]);b=MX3(b,C1[r+2],C1[r+3]);} \
      float rm=__builtin_fmaxf(a,b); { auto rr=__builtin_amdgcn_permlane32_swap(__float_as_uint(rm),__float_as_uint(rm),false,false); rm=__builtin_fmaxf(__uint_as_float(rr[0]),__uint_as_float(rr[1])); } \
      resc=false; \
      if(__builtin_expect(__any(rm>(float)THRL),0)){ const float dl=__builtin_fmaxf(rm,0.f); mhat+=dl; \
        _Pragma("unroll") for(int r=0;r<16;++r){C0[r]-=dl;C1[r]-=dl;} \
        _Pragma("unroll") for(int r=0;r<16;++r)negm[r]=-mhat; asm volatile("":"+v"(negm)); \
        const float f=__builtin_amdgcn_exp2f(-dl); l_reg*=f; if(hi==0)wsf[r32]=f; resc=true; } } \
    SBAR(); \
    GAPB(o[0]=__builtin_amdgcn_mfma_f32_32x32x16_bf16(PAF(0),VFR(0),o[0],0,0,0), C0,0); \
    GAPB(o[1]=__builtin_amdgcn_mfma_f32_32x32x16_bf16(PAF(0),VFR(4),o[1],0,0,0), C0,4); \
    KRD(GL,0); GAPB(o[0]=__builtin_amdgcn_mfma_f32_32x32x16_bf16(PAF(1),VFR(1),o[0],0,0,0), C0,8); \
    KRD(GL,1); GAPB(o[1]=__builtin_amdgcn_mfma_f32_32x32x16_bf16(PAF(1),VFR(5),o[1],0,0,0), C0,12); \
    KRD(GL,2); GAPB(o[0]=__builtin_amdgcn_mfma_f32_32x32x16_bf16(PAF(2),VFR(2),o[0],0,0,0), C1,0); \
    KRD(GL,3); GAPB(o[1]=__builtin_amdgcn_mfma_f32_32x32x16_bf16(PAF(2),VFR(6),o[1],0,0,0), C1,4); \
    GAPB(o[0]=__builtin_amdgcn_mfma_f32_32x32x16_bf16(PAF(3),VFR(3),o[0],0,0,0), C1,8); \
    GAPB(o[1]=__builtin_amdgcn_mfma_f32_32x32x16_bf16(PAF(3),VFR(7),o[1],0,0,0), C1,12); \
    }while(0)
  int t=1;
  for(;t+5<NT;t+=2){
    STEP(pB0,pB1,pA0,pA1,t,true,true,true);     WAIT_BAR(2); RESC(); ROT();
    STEP(pA0,pA1,pB0,pB1,t+1,true,true,true);   WAIT_BAR(2); RESC(); ROT();
  }
  #define ENDW(tt) do{ if((tt)+3<NT){WAIT_BAR(2);} else if((tt)+2<NT){WAIT_BAR(1);} else {WAIT_BAR(0);} }while(0)
  for(;t+1<NT;t+=2){
    STEP(pB0,pB1,pA0,pA1,t,(t+3<NT),(t+1<NT),(t+1<NT));       ENDW(t);   RESC(); ROT();
    STEP(pA0,pA1,pB0,pB1,t+1,(t+4<NT),(t+2<NT),(t+2<NT));     ENDW(t+1); RESC(); ROT();
  }
  STEP(pB0,pB1,pA0,pA1,NT-1,false,false,false); RESC();
  { float sacc=pB0[0]+pB0[1]; _Pragma("unroll") for(int r=2;r<16;++r)sacc+=pB0[r]; _Pragma("unroll") for(int r=0;r<16;++r)sacc+=pB1[r]; l_reg+=sacc;
    pw0=(u32x4){PKW(pB0,0),PKW(pB0,2),PKW(pB0,4),PKW(pB0,6)};pw1=(u32x4){PKW(pB0,8),PKW(pB0,10),PKW(pB0,12),PKW(pB0,14)};pw2=(u32x4){PKW(pB1,0),PKW(pB1,2),PKW(pB1,4),PKW(pB1,6)};pw3=(u32x4){PKW(pB1,8),PKW(pB1,10),PKW(pB1,12),PKW(pB1,14)};
    SBAR(); pv(o,vb0+sl_cur,PAF(0),PAF(1),PAF(2),PAF(3)); }
  #undef PKW
  #undef PAF
  #undef VFR
  #undef PIN
  #undef MX3
  #undef GAPA
  #undef GAPB
  #undef EX
  #undef VRD
  #undef KRD
  #undef STEP
  #undef ENDW
  {auto rr=__builtin_amdgcn_permlane32_swap(__float_as_uint(l_reg),__float_as_uint(l_reg),false,false);l_reg=__uint_as_float(rr[0])+__uint_as_float(rr[1]);}
  if(MODE==1)l_reg+=__builtin_amdgcn_exp2f(sinkl2-mhat);
  if(hi==0)wsf[32+r32]=l_reg;asm volatile("s_waitcnt lgkmcnt(0)":::"memory");
  float rli[16];
  #pragma unroll
  for(int r=0;r<16;++r)rli[r]=__builtin_amdgcn_rcpf(wsf[32+crow(r,hi)]);
  bf16*Ow=Ou+(long)(wid*QBLK)*OP;
  { bf16*stg=(bf16*)(shm+LDS_OST)+wid*2048;
    #pragma unroll
    for(int r=0;r<16;++r){const int orow=crow(r,hi);
      #pragma unroll
      for(int d0=0;d0<2;++d0)stg[orow*64+d0*32+r32]=__float2bfloat16(o[d0][r]*rli[r]);}
    asm volatile("s_waitcnt lgkmcnt(0)":::"memory");
    #pragma unroll
    for(int i=0;i<4;++i){const int row=i*8+(lane>>3),ch=lane&7; const u32x4 v=*(const u32x4*)(stg+row*64+ch*8); ATTN_STORE16(Ow+(long)row*OP+ch*8,v);} }
  asm volatile("s_waitcnt lgkmcnt(0)\n\ts_barrier":::"memory");
  #undef DMA_K
  #undef TROW
  #undef DMA_V
  #undef CMASK
  #undef START
  #undef RESC
  #undef ROT
}
#undef SBAR
#undef WAIT_BAR
}

template <int LAYER> __device__ __forceinline__ void attn_fast(const Frame& F, char* shm) {
    using attn_body::bf16;
    const bf16* Q = (const bf16*)(F.ws + WS_Q); const bf16* Kn = (const bf16*)(F.ws + WS_KN); const bf16* Vn = (const bf16*)(F.ws + WS_VN); bf16* AO = (bf16*)(F.ws + WS_AO);
    const int nunits = LAYER == 0 ? 1024 + 64 : 1024;
    for (int U = F.vcu; U < nunits; U += F.G) {
        int b, h, NT, lat0 = 0, q0 = 0; size_t row0;
        if (U < 1024) { b = U >> 7; h = ((U >> 6) & 1) * 4 + ((U >> 4) & 3); q0 = (U & 15) * 256; row0 = (size_t)b * SEQ + q0;
            if (LAYER == 0) NT = KVS / 64;
            else { int lo = q0 - 128, hi = q0 + 384; lo = lo < 0 ? 0 : lo; hi = hi > SEQ ? SEQ : hi; NT = 4 + (hi - lo) / 64; lat0 = CTXL + lo; } }
        else { const int uc = U - 1024; b = uc >> 3; h = uc & 7; row0 = (size_t)TX + (size_t)b * CTXL; NT = 4; }
        const bf16* Kh = Kn + (size_t)b * KVS * 128 + (h >> 2) * 64; const bf16* Vh = Vn + (size_t)b * KVS * 128 + (h >> 2) * 64;
        const float sinkl2 = LAYER == 1 ? F.in[I_SINK][h] * LOG2E : 0.f;
        if (LAYER == 0 && F.G == 256 && U < 1024 && (U >> 8) == (F.vcu & 3)) {
            const int per = (TL_ITEMS + 255) / 256, lo = F.vcu * per; int hi = lo + per; hi = hi > TL_ITEMS ? TL_ITEMS : hi;
            Frame Fc = F; asm volatile("" : "+v"(Fc.lane), "+v"(Fc.tid));
            transpose_range<0>(Fc, lo, hi, Fc.wave, NWAVES);
            __syncthreads(); }
        attn_body::attn_unit<LAYER, 8>(Q + row0 * 512 + h * 64, Kh, Vh, AO + row0 * 1024 + h * 64, NT, lat0, q0, sinkl2, F.in[LAYER == 0 ? I_QNA : I_QNC], (const float*)(F.ws + WS_ROPE), U < 1024, shm);
    }
}

template <int DRY> __device__ __forceinline__ void p_router(const Frame& F, int l, int ntok) {
    const int gw = F.vcu * NWAVES + F.wave, NGW = F.G * NWAVES, lane = F.lane, tk = lane & 15, kq = lane >> 4;
    bf16_t* HX = F.hx(); const float* SS = (const float*)(F.ws + WS_SS);
    const float* gb = F.in[I_RGB] + l * 4; const float* eb = F.in[I_REB] + l * 32;
    unsigned* tokslot = (unsigned*)(F.ws + (DRY ? WS_HID : WS_TOK)); float* tokw = (float*)(F.ws + (DRY ? WS_HID : WS_TOK) + 512 * 1024); unsigned* list = (unsigned*)(F.ws + (DRY ? WS_HID + 2 * MiB : WS_LIST));
    unsigned* cnt = F.cnt(DRY ? l + 2 : l);
    {
        const u32x4* src = (const u32x4*)((const bf16_t*)(F.ws + WS_WR) + (size_t)l * 2 * 36864);
        u32x4 t[18];
#pragma unroll
        for (int i = 0; i < 18; ++i) t[i] = src[F.tid + i * NTHREADS];
        __syncthreads();
#pragma unroll
        for (int i = 0; i < 18; ++i) *(LAS u32x4*)(F.lds + (F.tid + i * NTHREADS) * 16) = t[i];
    }
    const LAS unsigned char* wl0 = F.lds + lane * 16;
    const LAS unsigned char* wl2 = F.lds + 2048 + ((tk >> 2) * 4 + kq) * 16;
    LAS unsigned* lcnt = (LAS unsigned*)(F.lds + LDS_TAB + 2048 + 8192); LAS unsigned* lbase = lcnt + 32;
    LAS float* gps = (LAS float*)(F.lds + LDS_TAB + 2048);
    const int nrounds = (ntok / 16 + NGW - 1) / NGW;
    for (int rd = 0; rd < nrounds; ++rd) {
        const int grp0 = F.vcu * NWAVES + rd * NGW, grp = grp0 + F.wave;
        __syncthreads();
        if (F.tid < 32) lcnt[F.tid] = 0u;
        if (grp0 < ntok / 16) { const int r0 = modrow(grp0 * 16); const float* gpg = (const float*)(F.ws + WS_GP) + (size_t)(l * 9 + r0) * 1024; const float* shg = F.mod(l, r0, 3);
            *(LAS f32x4*)(gps + 4 * F.tid) = F.tid < 256 ? *(const f32x4*)(gpg + 4 * F.tid) : *(const f32x4*)(shg + 4 * (F.tid - 256)); }
        __syncthreads();
        const bool active = grp < ntok / 16;
        const int row = (active ? grp : 0) * 16 + tk;
        bool win = false; int e1 = 0, e2 = 0; float w1 = 0.f, w2 = 0.f; unsigned p1 = 0u, p2 = 0u;
        if (active) {
        const bf16_t* xr = F.xr_row(row) + 8 * kq;
        u32x4 xq[16];
#define R_XLOAD(i, st) do { const int s_ = (st) < 32 ? (st) : 31; if (DRY != 5) xq[i] = *(const u32x4*)(xr + s_ * 32); else xq[i] = (u32x4){(unsigned)s_, 1u, 2u, 3u}; } while (0)
#pragma unroll
        for (int i = 0; i < 16; ++i) R_XLOAD(i, i);
        float ssum = 0.f;
#pragma unroll
        for (int i = 0; i < 4; ++i) { const f32x4 p = *(const f32x4*)(SS + (size_t)row * 16 + 4 * i); ssum += (p[0] + p[1]) + (p[2] + p[3]); }
        const float rms = 1.0f / sqrtf(ssum * (1.f / 1024.f) + EPS);
        f32x4 acc[3];
#pragma unroll
        for (int n = 0; n < 3; ++n) acc[n] = (f32x4){0.f, 0.f, 0.f, 0.f};
        bf16_t* hxr = HX + (size_t)row * DM + 8 * kq;
        const LAS float* gpl = gps + 8 * kq;
#define R_STEP(i, st) do { const u32x4 xb_ = xq[i]; \
            const f32x4 m0 = *(const LAS f32x4*)(gpl + (st) * 32), m1 = *(const LAS f32x4*)(gpl + (st) * 32 + 4), m2 = *(const LAS f32x4*)(gpl + 1024 + (st) * 32), m3 = *(const LAS f32x4*)(gpl + 1024 + (st) * 32 + 4); \
            const f32x4 xf0 = (f32x4){bflo(xb_.x), bfhi(xb_.x), bflo(xb_.y), bfhi(xb_.y)}, xf1 = (f32x4){bflo(xb_.z), bfhi(xb_.z), bflo(xb_.w), bfhi(xb_.w)}; \
            const f32x4 h0 = (xf0 * rms) * m0 + m2, h1 = (xf1 * rms) * m1 + m3; \
            u32x4 hh; hh.x = pk2(h0[0], h0[1]); hh.y = pk2(h0[2], h0[3]); hh.z = pk2(h1[0], h1[1]); hh.w = pk2(h1[2], h1[3]); \
            if (DRY != 4) *(u32x4*)(hxr + (st) * 32) = hh; else if (hh.x == 0x12345678u) *(u32x4*)(hxr + (st) * 32) = hh; \
            if (DRY < 3 || DRY >= 6) { \
            u32x4 hl; hl.x = pk2(h0[0] - bflo(hh.x), h0[1] - bfhi(hh.x)); hl.y = pk2(h0[2] - bflo(hh.y), h0[3] - bfhi(hh.y)); hl.z = pk2(h1[0] - bflo(hh.z), h1[1] - bfhi(hh.z)); hl.w = pk2(h1[2] - bflo(hh.w), h1[3] - bfhi(hh.w)); \
            const bf16x8 bh = __builtin_bit_cast(bf16x8, hh), bl = __builtin_bit_cast(bf16x8, hl); \
            bf16x8 w0h, w1h, w2h, w0l, w1l, w2l; if (DRY == 6) { w0h = w1h = w2h = w0l = w1l = w2l = bh; } else { w0h = *(const LAS bf16x8*)(wl0 + (st) * 2304); w1h = *(const LAS bf16x8*)(wl0 + (st) * 2304 + 1024); w2h = *(const LAS bf16x8*)(wl2 + (st) * 2304); \
            w0l = *(const LAS bf16x8*)(wl0 + RW_BYTES + (st) * 2304); w1l = *(const LAS bf16x8*)(wl0 + RW_BYTES + (st) * 2304 + 1024); w2l = *(const LAS bf16x8*)(wl2 + RW_BYTES + (st) * 2304); } \
            if (DRY == 7) { const bf16x8 sx = w0h ^ w1h ^ w2h ^ w0l ^ w1l ^ w2l ^ bl; acc[0][0] += (float)sx[0]; } else \
            acc[0] = __builtin_amdgcn_mfma_f32_16x16x32_bf16(w0h, bh, acc[0], 0, 0, 0); acc[1] = __builtin_amdgcn_mfma_f32_16x16x32_bf16(w1h, bh, acc[1], 0, 0, 0); acc[2] = __builtin_amdgcn_mfma_f32_16x16x32_bf16(w2h, bh, acc[2], 0, 0, 0); \
            acc[0] = __builtin_amdgcn_mfma_f32_16x16x32_bf16(w0h, bl, acc[0], 0, 0, 0); acc[1] = __builtin_amdgcn_mfma_f32_16x16x32_bf16(w1h, bl, acc[1], 0, 0, 0); acc[2] = __builtin_amdgcn_mfma_f32_16x16x32_bf16(w2h, bl, acc[2], 0, 0, 0); \
            acc[0] = __builtin_amdgcn_mfma_f32_16x16x32_bf16(w0l, bh, acc[0], 0, 0, 0); acc[1] = __builtin_amdgcn_mfma_f32_16x16x32_bf16(w1l, bh, acc[1], 0, 0, 0); acc[2] = __builtin_amdgcn_mfma_f32_16x16x32_bf16(w2l, bh, acc[2], 0, 0, 0); } } while (0)
        for (int st = 0; st < 32; st += 16) {
#pragma unroll
            for (int i = 0; i < 16; ++i) { R_STEP(i, st + i); R_XLOAD(i, st + i + 16); }
        }
#undef R_XLOAD
#undef R_STEP
        if (DRY >= 6 && acc[0][0] + acc[1][1] + acc[2][2] == 123.456f) tokw[row] = 1.f;
        if (DRY < 2) {
            const float lgk = acc[2][0] + gb[kq];
            const float la = __shfl_xor(lgk, 16), lb = __shfl_xor(lgk, 32), lc = __shfl_xor(la, 32);
            const float gm = fmaxf(fmaxf(lgk, la), fmaxf(lb, lc));
            win = (lgk == gm);
            win = win && !(la == gm && (kq ^ 1) < kq) && !(lb == gm && (kq ^ 2) < kq) && !(lc == gm && (kq ^ 3) < kq);
            if (win) {
                const float g_w = 1.f / (expf(lgk - gm) + expf(la - gm) + expf(lb - gm) + expf(lc - gm));
                float el[8];
                { const f32x4 b0 = *(const f32x4*)(eb + 8 * kq), b1 = *(const f32x4*)(eb + 8 * kq + 4);
#pragma unroll
                  for (int i = 0; i < 4; ++i) { el[i] = acc[0][i] + b0[i]; el[4 + i] = acc[1][i] + b1[i]; } }
                int i1 = 0; float m1 = el[0];
#pragma unroll
                for (int i = 1; i < 8; ++i) if (el[i] > m1) { m1 = el[i]; i1 = i; }
                int i2 = 0; float m2 = -3.0e38f;
#pragma unroll
                for (int i = 0; i < 8; ++i) if (i != i1 && el[i] > m2) { m2 = el[i]; i2 = i; }
                const float pp = expf(m2 - m1); w1 = g_w / (1.f + pp); w2 = g_w * pp / (1.f + pp);
                e1 = kq * 8 + i1; e2 = kq * 8 + i2;
                p1 = __hip_atomic_fetch_add(lcnt + e1, 1u, __ATOMIC_RELAXED, __HIP_MEMORY_SCOPE_WORKGROUP); p2 = __hip_atomic_fetch_add(lcnt + e2, 1u, __ATOMIC_RELAXED, __HIP_MEMORY_SCOPE_WORKGROUP);
            }
        }
        }
        __syncthreads();
        if (DRY < 2 && F.tid < 32) { const unsigned n = lcnt[F.tid]; lbase[F.tid] = n ? atomicAdd(cnt + F.tid * 64, n) : 0u; }
        __syncthreads();
        if (win) { const unsigned pos1 = lbase[e1] + p1, pos2 = lbase[e2] + p2;
            list[(size_t)e1 * TT + pos1] = (unsigned)row; list[(size_t)e2 * TT + pos2] = (unsigned)row;
            tokslot[2 * row] = ((unsigned)e1 << 16) | pos1; tokslot[2 * row + 1] = ((unsigned)e2 << 16) | pos2; tokw[2 * row] = w1; tokw[2 * row + 1] = w2; }
    }
    __syncthreads();
}
struct CombBuf { u32x2 x[4], ya[4], yb[4]; };
__device__ __forceinline__ void comb_load(CombBuf& b, const bf16_t* xr, const bf16_t* ya, const bf16_t* yb, int lane) {
#pragma unroll
    for (int j = 0; j < 4; ++j) { const int c = 4 * lane + 256 * j; b.x[j] = *(const u32x2*)(xr + c); b.ya[j] = *(const u32x2*)(ya + c); b.yb[j] = *(const u32x2*)(yb + c); }
}
template <bool LAST, bool DRY> __device__ __forceinline__ void comb_finish(const Frame& F, const CombBuf& b, int l, int row, float wa, float wb, int lane) {
    const int r = modrow(row); const float* g2 = F.mod(l, r, 5); bf16_t* xr = F.xr_row(row);
    float ss = 0.f; f32x4 v[4];
#pragma unroll
    for (int j = 0; j < 4; ++j) { const int c = 4 * lane + 256 * j; const f32x4 gv = *(const f32x4*)(g2 + c);
        f32x4 y; y[0] = wa * bflo(b.ya[j].x) + wb * bflo(b.yb[j].x); y[1] = wa * bfhi(b.ya[j].x) + wb * bfhi(b.yb[j].x); y[2] = wa * bflo(b.ya[j].y) + wb * bflo(b.yb[j].y); y[3] = wa * bfhi(b.ya[j].y) + wb * bfhi(b.yb[j].y);
        const f32x4 x1 = (f32x4){bflo(b.x[j].x), bfhi(b.x[j].x), bflo(b.x[j].y), bfhi(b.x[j].y)};
        v[j] = x1 + gv * y;
        if (LAST) { if (!DRY) *(f32x4*)(F.out + (size_t)row * DM + c) = v[j]; }
        else { u32x2 o; o.x = pk2(v[j][0], v[j][1]); o.y = pk2(v[j][2], v[j][3]); *(u32x2*)(xr + c) = DRY ? b.x[j] : o; }
        ss += (v[j][0] * v[j][0] + v[j][1] * v[j][1]) + (v[j][2] * v[j][2] + v[j][3] * v[j][3]); }
    if (!LAST) { const float rms = 1.0f / sqrtf(wave_sum(ss) * (1.f / 1024.f) + EPS); const float* g = F.in[I_LN1] + (l + 1) * 1024; const float* sh = F.mod(l + 1, r, 0); const float* sc = F.mod(l + 1, r, 1); f32x4 h[4];
#pragma unroll
        for (int j = 0; j < 4; ++j) { const int c = 4 * lane + 256 * j; h[j] = (v[j] * rms * *(const f32x4*)(g + c)) * (1.f + *(const f32x4*)(sc + c)) + *(const f32x4*)(sh + c); }
        store_row_bf16(F.hx() + (size_t)row * DM, lane, h); }
}
template <bool LAST, bool DRY> __device__ __forceinline__ void p_combine(const Frame& F, int l, int ntok, const MoeTab& tb) {
    const int gw = F.vcu * NWAVES + F.wave, NGW = F.G * NWAVES, lane = F.lane;
    const bf16_t* YB = (const bf16_t*)(F.ws + WS_YB);
    const unsigned* tokslot = (const unsigned*)(F.ws + WS_TOK); const float* tokw = (const float*)(F.ws + WS_TOK + 512 * 1024);
    const int ntot = gw < ntok ? (ntok - gw + NGW - 1) / NGW : 0;
    for (int base = 0; base < ntot; base += 64) {
    const int n = ntot - base < 64 ? ntot - base : 64;
    unsigned my_sa = 0u, my_sb = 0u; float my_wa = 0.f, my_wb = 0.f;
    { const int mr = gw + (base + lane) * NGW;
      if (lane < n) { const unsigned sa = tokslot[2 * mr], sb = tokslot[2 * mr + 1]; my_wa = tokw[2 * mr]; my_wb = tokw[2 * mr + 1];
          my_sa = (unsigned)tb.tile0[sa >> 16] * 256u + (sa & 0xffffu); my_sb = (unsigned)tb.tile0[sb >> 16] * 256u + (sb & 0xffffu); } }
    CombBuf A, B;
#define COMB_LOAD(buf, i) do { const int row_ = gw + (base + (i)) * NGW; const unsigned sa_ = __builtin_amdgcn_readlane(my_sa, (i)), sb_ = __builtin_amdgcn_readlane(my_sb, (i)); \
        comb_load(buf, F.xr_row(row_), YB + (size_t)sa_ * 1024, YB + (size_t)sb_ * 1024, lane); } while (0)
#define COMB_FIN(buf, i) do { const float wa_ = __uint_as_float(__builtin_amdgcn_readlane(__float_as_uint(my_wa), (i))), wb_ = __uint_as_float(__builtin_amdgcn_readlane(__float_as_uint(my_wb), (i))); \
        comb_finish<LAST, DRY>(F, buf, l, gw + (base + (i)) * NGW, wa_, wb_, lane); } while (0)
    COMB_LOAD(A, 0);
    for (int i = 0; i < n; i += 2) {
        if (i + 1 < n) COMB_LOAD(B, i + 1);
        COMB_FIN(A, i);
        if (i + 2 < n) COMB_LOAD(A, i + 2);
        if (i + 1 < n) COMB_FIN(B, i + 1);
    }
    }
#undef COMB_LOAD
#undef COMB_FIN
}

__global__ void __launch_bounds__(NTHREADS, 2) fwd_kernel(Params P) {
    extern __shared__ __attribute__((aligned(16))) unsigned char lds_raw[];
    Frame F;
    F.lds = (LAS unsigned char*)lds_raw; F.in = P.in; F.out = P.out; F.ws = P.ws;
    F.tid = threadIdx.x; F.lane = F.tid & 63; F.wave = __builtin_amdgcn_readfirstlane(F.tid >> 6);
    F.G = gridDim.x; { const int bx = blockIdx.x; F.vcu = (F.G % 8 == 0) ? (bx % 8) * (F.G / 8) + bx / 8 : bx; }
    volatile LAS unsigned* misc = (volatile LAS unsigned*)(F.lds + LDS_MISC);
    if (F.tid < 16) misc[F.tid] = 0u;
    __syncthreads();
#if ONE_LAUNCH
    XcdBarrier bar = xcd_barrier_post((unsigned*)(F.ws + WS_CTL) + CW_BAR, misc + 8);
#define GRID_BAR() do { xcd_barrier(bar); } while (0)
#else
#define GRID_BAR() do { } while (0)
#endif
    const int lo = P.ph_lo, hi = P.ph_hi;
#ifndef DRYMASK
#define DRYMASK 0x4000
#endif
#ifndef DRYV
#define DRYV 7
#endif
#ifndef PHMASK
#define PHMASK 0xFFFFFFFFu
#endif
#define IN(k) (((PHMASK >> (k)) & 1u) && lo <= (k) && (k) < hi)
#ifdef PROBE_PH
#define STAMP(k) do { if (blockIdx.x == 0 && F.tid == 0) { const unsigned long long t_ = __builtin_amdgcn_s_memrealtime(); \
        if ((k) == PROBE_PH - 1) { misc[0] = (unsigned)t_; misc[1] = (unsigned)(t_ >> 32); } if ((k) == PROBE_PH) { misc[2] = (unsigned)t_; misc[3] = (unsigned)(t_ >> 32); } } } while (0)
#else
#define STAMP(k) do { } while (0)
#endif
#define SEAM(k) do { if (IN((k) + 1)) GRID_BAR(); STAMP(k); } while (0)
    STAMP(-1);
    bf16_t* HX = F.hx(); bf16_t* Qb = (bf16_t*)(F.ws + WS_Q); bf16_t* KVb = (bf16_t*)(F.ws + WS_KV); bf16_t* Gb = (bf16_t*)(F.ws + WS_G); bf16_t* AO = (bf16_t*)(F.ws + WS_AO);
    bf16_t* HID = (bf16_t*)(F.ws + WS_HID); bf16_t* YB = (bf16_t*)(F.ws + WS_YB);

    if (IN(0)) { Frame Fp = F; asm volatile("" : "+v"(Fp.tid), "+v"(Fp.lane)); p0_prologue(Fp); SEAM(0); }
    if (IN(1)) { Frame Fp = F; asm volatile("" : "+v"(Fp.tid), "+v"(Fp.lane)); p0_misc(Fp); p_norm1_l0(Fp); SEAM(1); }
    if (IN(2)) { Frame Fp = F; asm volatile("" : "+v"(Fp.tid), "+v"(Fp.lane)); SchedDense S{(const bf16_t*)(Fp.ws + WS_WINAB), 1024, TT / 256, 7, 0, 0, Fp.vcu, Fp.G}; EpiInProj<true> E{Qb, KVb, (bf16_t*)(Fp.ws + WS_VN), Gb}; GEMM(Fp, HX, 1024, S, E); SEAM(2); }
    if (IN(3)) { Frame Fp = F; asm volatile("" : "+v"(Fp.tid), "+v"(Fp.lane)); p_k_post(Fp, Fp.in[I_KNA]); p_conv(Fp); SEAM(3); }
    if (IN(4)) { Frame Fp = F; asm volatile("" : "+v"(Fp.tid), "+v"(Fp.lane));
#ifdef ATTN_SIMPLE
        attn_simple<0>(Fp);
#else
        attn_fast<0>(Fp, (char*)lds_raw);
#endif
        SEAM(4); }
    if (IN(5)) { Frame Fp = F; asm volatile("" : "+v"(Fp.tid), "+v"(Fp.lane)); SchedDense S{(const bf16_t*)(Fp.ws + WS_WOUTAB), 1024, TT / 256, 4, 0, 0, Fp.vcu, Fp.G}; EpiOutProj<true> E{Fp, 0}; GEMM(Fp, AO, 1024, S, E);
        SEAM(5); }
    if (IN(6)) { Frame Fp = F; asm volatile("" : "+v"(Fp.tid), "+v"(Fp.lane));
#if (DRYMASK >> 6) & 1
        p_router<DRYV>(Fp, 0, TT); GRID_BAR();
#endif
        p_router<0>(Fp, 0, TT); SEAM(6); }
    if (IN(7)) { Frame Fp = F; asm volatile("" : "+v"(Fp.tid), "+v"(Fp.lane)); const MoeTab tb = moe_tables(Fp, 0); SchedMoe S{(const bf16_t*)(Fp.ws + WS_WGU), (size_t)1024 * 1024, 1024, tb, (const unsigned*)(Fp.ws + WS_LIST), true, Fp.vcu, Fp.G}; EpiMoe1 E{HID}; GEMM(Fp, HX, 1024, S, E); transpose_tail<1>(Fp, tb.ntiles * 4, 0, TL_A); SEAM(7); }
    if (IN(8)) { Frame Fp = F; asm volatile("" : "+v"(Fp.tid), "+v"(Fp.lane)); const MoeTab tb = moe_tables(Fp, 0); SchedMoe S{(const bf16_t*)(Fp.ws + WS_WD), (size_t)1024 * 512, 512, tb, nullptr, false, Fp.vcu, Fp.G}; EpiMoe2 E{YB}; GEMM2(Fp, HID, 512, S, E); transpose_tail<1>(Fp, tb.ntiles * 4, TL_A, TL_B); SEAM(8); }
    if (IN(9)) { Frame Fp = F; asm volatile("" : "+v"(Fp.tid), "+v"(Fp.lane)); const MoeTab tb = moe_tables(Fp, 0);
#if (DRYMASK >> 9) & 1
        p_combine<false, true>(Fp, 0, TT, tb); GRID_BAR();
#endif
        p_combine<false, false>(Fp, 0, TT, tb); SEAM(9); }
    if (IN(10)) { Frame Fp = F; asm volatile("" : "+v"(Fp.tid), "+v"(Fp.lane)); SchedDense S{(const bf16_t*)(Fp.ws + WS_WINCD), 1024, TX / 256, 5, TC / 256, 2, Fp.vcu, Fp.G}; EpiInProj<false> E{Qb, KVb, (bf16_t*)(Fp.ws + WS_VN), Gb}; GEMM(Fp, HX, 1024, S, E); transpose_tail<1>(Fp, (TX / 256) * 5 + TC / 256, TL_B, TL_ITEMS); SEAM(10); }
    if (IN(11)) { Frame Fp = F; asm volatile("" : "+v"(Fp.tid), "+v"(Fp.lane)); p_k_post(Fp, Fp.in[I_KNC]); p_pool(Fp); SEAM(11); }
    if (IN(12)) { Frame Fp = F; asm volatile("" : "+v"(Fp.tid), "+v"(Fp.lane));
#ifdef ATTN_SIMPLE
        attn_simple<1>(Fp);
#else
        attn_fast<1>(Fp, (char*)lds_raw);
#endif
        SEAM(12); }
    if (IN(13)) { Frame Fp = F; asm volatile("" : "+v"(Fp.tid), "+v"(Fp.lane)); SchedDense S{(const bf16_t*)(Fp.ws + WS_WOUTCD), 1024, TX / 256, 4, 0, 0, Fp.vcu, Fp.G};
#if (DRYMASK >> 13) & 1
        { EpiOutProj<false, true> Ed{Fp, 1}; GEMM(Fp, AO, 1024, S, Ed); GRID_BAR(); }
#endif
        EpiOutProj<false> E{Fp, 1}; GEMM(Fp, AO, 1024, S, E); SEAM(13); }
    if (IN(14)) { Frame Fp = F; asm volatile("" : "+v"(Fp.tid), "+v"(Fp.lane));
#if (DRYMASK >> 14) & 1
        p_router<DRYV>(Fp, 1, TX); GRID_BAR();
#endif
        p_router<0>(Fp, 1, TX); SEAM(14); }
    if (IN(15)) { Frame Fp = F; asm volatile("" : "+v"(Fp.tid), "+v"(Fp.lane)); const MoeTab tb = moe_tables(Fp, 1); SchedMoe S{(const bf16_t*)(Fp.ws + WS_WGU) + (size_t)32 * 1024 * 1024, (size_t)1024 * 1024, 1024, tb, (const unsigned*)(Fp.ws + WS_LIST), true, Fp.vcu, Fp.G}; EpiMoe1 E{HID}; GEMM(Fp, HX, 1024, S, E); SEAM(15); }
    if (IN(16)) { Frame Fp = F; asm volatile("" : "+v"(Fp.tid), "+v"(Fp.lane)); const MoeTab tb = moe_tables(Fp, 1); SchedMoe S{(const bf16_t*)(Fp.ws + WS_WD) + (size_t)32 * 1024 * 512, (size_t)1024 * 512, 512, tb, nullptr, false, Fp.vcu, Fp.G}; EpiMoe2 E{YB}; GEMM2(Fp, HID, 512, S, E); SEAM(16); }
    if (IN(17)) { Frame Fp = F; asm volatile("" : "+v"(Fp.tid), "+v"(Fp.lane)); const MoeTab tb = moe_tables(Fp, 1);
#if (DRYMASK >> 17) & 1
        p_combine<true, true>(Fp, 1, TX, tb); GRID_BAR();
#endif
        p_combine<true, false>(Fp, 1, TX, tb); }
#ifdef PROBE_PH
    STAMP(NPH - 1);
    if (blockIdx.x == 0 && F.tid == 0) { const unsigned long long t0 = ((unsigned long long)misc[1] << 32) | misc[0], t1 = ((unsigned long long)misc[3] << 32) | misc[2];
        const unsigned long long te = __builtin_amdgcn_s_memrealtime(), span = (t1 - t0) * 16ull;
        while (__builtin_amdgcn_s_memrealtime() - te < span) __builtin_amdgcn_s_sleep(32); }
#endif
#undef IN
#undef SEAM
}

extern "C" void kernel_launch(void* const* d_in, const int* in_sizes, int n_in, void* d_out, int out_size, void* d_ws, size_t ws_size, hipStream_t stream) {
    static int grid = 0;
    if (grid == 0) {
        if (n_in != 30 || out_size != TX * DM || ws_size < WS_END) { fprintf(stderr, "kernel_launch: unexpected shapes (n_in %d out %d ws %zu)\n", n_in, out_size, ws_size); grid = -1; return; }
        int dev = 0, cus = 0;
        if (hipGetDevice(&dev) != hipSuccess || hipDeviceGetAttribute(&cus, hipDeviceAttributeMultiprocessorCount, dev) != hipSuccess) { grid = -1; return; }
        if (hipFuncSetAttribute((const void*)fwd_kernel, hipFuncAttributeMaxDynamicSharedMemorySize, LDS_BYTES) != hipSuccess) { fprintf(stderr, "kernel_launch: hipFuncSetAttribute failed\n"); grid = -1; return; }
        int per_cu = 0;
        if (hipOccupancyMaxActiveBlocksPerMultiprocessor(&per_cu, (const void*)fwd_kernel, NTHREADS, LDS_BYTES) != hipSuccess || per_cu < 1) { fprintf(stderr, "kernel_launch: occupancy query says %d\n", per_cu); }
        (void)hipGetLastError();
        grid = cus;
    }
    if (grid < 0) return;
    (void)hipMemsetAsync((char*)d_ws + WS_CTL, 0, CTL_ZERO_BYTES, stream);
    Params p{};
    for (int i = 0; i < 30; ++i) p.in[i] = (const float*)d_in[i];
    p.out = (float*)d_out; p.ws = (unsigned char*)d_ws;
#if ONE_LAUNCH
    p.ph_lo = 0; p.ph_hi = NPH;
    hipLaunchKernelGGL(fwd_kernel, dim3(grid), dim3(NTHREADS), LDS_BYTES, stream, p);
#else
    for (int ph = 0; ph < NPH; ++ph) { p.ph_lo = ph; p.ph_hi = ph + 1; hipLaunchKernelGGL(fwd_kernel, dim3(grid), dim3(NTHREADS), LDS_BYTES, stream, p); }
#endif
}
```

```cpp
#include <hip/hip_runtime.h>
#include <cstdio>
#include <cstdint>

#ifndef ONE_LAUNCH
#define ONE_LAUNCH 1
#endif

#define LAS __attribute__((address_space(3)))
#define GAS __attribute__((address_space(1)))
typedef unsigned short bf16_t;
typedef short bf16x8 __attribute__((ext_vector_type(8)));
typedef float f32x4 __attribute__((ext_vector_type(4)));
typedef float f32x2 __attribute__((ext_vector_type(2)));
typedef unsigned u32x4 __attribute__((ext_vector_type(4)));
typedef unsigned u32x2 __attribute__((ext_vector_type(2)));
typedef __bf16 bf16x2_t __attribute__((ext_vector_type(2)));

constexpr int NB = 8, SEQ = 4096, DM = 1024, CTXL = 256, HD = 64;
constexpr int TX = NB * SEQ, TC = NB * CTXL, TT = TX + TC;
constexpr int KVS = CTXL + SEQ;
constexpr int NE = 32;
constexpr int NTILE_MAX = 304, NSLOT = NTILE_MAX * 256;
constexpr float EPS = 1e-6f;
constexpr float LOG2E = 1.4426950408889634f;
constexpr float C2 = 0.125f * LOG2E;
constexpr int NWAVES = 8, NTHREADS = 512;
constexpr int NPH = 18;

enum { I_X = 0, I_C, I_CTX, I_CCTX, I_MODW, I_MODB, I_LN1, I_LN2, I_WINAB, I_WOUTAB, I_QNA, I_KNA, I_CONVW, I_CONVB, I_CLNG, I_CLNB,
       I_WINCD, I_WOUTCD, I_QNC, I_KNC, I_SINK, I_POOLW, I_POOLS, I_RGW, I_RGB, I_REW, I_REB, I_EXG, I_EXU, I_EXD };

constexpr size_t MiB = 1u << 20;
constexpr size_t WS_CTL = 0, CTL_ZERO_BYTES = 1 * MiB;
constexpr size_t WS_MOD = 1 * MiB;
constexpr size_t WS_ROPE = 2 * MiB;
constexpr size_t WS_TOK = 3 * MiB;
constexpr size_t WS_LIST = 4 * MiB;
constexpr size_t WS_WINAB = 10 * MiB;
constexpr size_t WS_WOUTAB = 14 * MiB;
constexpr size_t WS_WINCD = 16 * MiB;
constexpr size_t WS_WOUTCD = 19 * MiB;
constexpr size_t WS_XC = 21 * MiB;
constexpr size_t WS_KN = 30 * MiB;
constexpr size_t WS_VN = 39 * MiB;
constexpr size_t WS_WGU = 48 * MiB;
constexpr size_t WS_WD = 176 * MiB;
constexpr size_t WS_XR = 240 * MiB;
constexpr size_t WS_HID = 308 * MiB;
constexpr size_t WS_Q = 384 * MiB;
constexpr size_t WS_KV = 418 * MiB;
constexpr size_t WS_G = 435 * MiB;
constexpr size_t WS_AO = 469 * MiB;
constexpr size_t WS_YB = 384 * MiB;
constexpr size_t WS_SS = 537 * MiB;
constexpr size_t WS_WR = 9 * MiB;
constexpr size_t WS_GP = 3 * MiB + 896 * 1024;
constexpr size_t WS_END = 540 * MiB;
static_assert(WS_YB + (size_t)NSLOT * 1024 * 2 <= WS_END && WS_AO + (size_t)TT * 1024 * 2 <= WS_END, "ws map");
constexpr int CW_CNT = 256;
constexpr int CW_BAR = 16384;

constexpr int RING_BYTES = 131072;
constexpr int RW_BYTES = 73728;
constexpr int LDS_MISC = 2 * RW_BYTES;
constexpr int LDS_TAB = LDS_MISC + 256;
constexpr int LDS_BYTES = 163840;

__device__ __forceinline__ unsigned pk2(float lo, float hi) { f32x2 v = {lo, hi}; bf16x2_t b = __builtin_convertvector(v, bf16x2_t); return __builtin_bit_cast(unsigned, b); }
__device__ __forceinline__ float bflo(unsigned w) { return __uint_as_float(w << 16); }
__device__ __forceinline__ float bfhi(unsigned w) { return __uint_as_float(w & 0xffff0000u); }
__device__ __forceinline__ float bf2f(bf16_t h) { return __uint_as_float((unsigned)h << 16); }
__device__ __forceinline__ float wave_sum(float v) {
#pragma unroll
    for (int o = 1; o < 64; o <<= 1) v += __shfl_xor(v, o);
    return v;
}
__device__ __forceinline__ float sigmoidf_(float v) { return 1.f / (1.f + __expf(-v)); }

#define XB_TMO      128
#define XB_XCNT(j)  (256  + 64 * (j))
#define XB_XSUB(j)  (1280 + 64 * (j))
#define XB_XGEN(j)  (2304 + 64 * (j))
#define XB_TOP      3328
#define XB_TOPGEN   3392
#define XCD_BAR_WORDS 3456
#define XB_SPIN_CAP (1u << 18)
__device__ __forceinline__ unsigned xb_ld(unsigned* p)              { return __hip_atomic_load(p, __ATOMIC_RELAXED, __HIP_MEMORY_SCOPE_AGENT); }
__device__ __forceinline__ unsigned xb_add(unsigned* p, unsigned v) { return __hip_atomic_fetch_add(p, v, __ATOMIC_RELAXED, __HIP_MEMORY_SCOPE_AGENT); }
__device__ __forceinline__ unsigned xb_xcc_id() { return (unsigned)__builtin_amdgcn_s_getreg((3 << 11) | 20) & 0xFu; }
#define XB_SPIN(cond, bar) do { unsigned _sp = 0; while (cond) { __builtin_amdgcn_s_sleep(1); \
    if ((++_sp & 255u) == 0u) { if (xb_ld(&(bar)[XB_TMO])) break; if (_sp > XB_SPIN_CAP) { atomicAdd(&(bar)[XB_TMO], 1u); break; } } } } while (0)
struct XcdBarrier { unsigned* bar; unsigned x; volatile LAS unsigned* st; };
__device__ __forceinline__ XcdBarrier xcd_barrier_post(unsigned* bar, volatile LAS unsigned* st) {
    XcdBarrier b; b.bar = bar; b.x = xb_xcc_id(); b.st = st;
    if (threadIdx.x == 0) (void)xb_add(&bar[XB_XCNT(b.x)], 1u);
    return b;
}
__device__ __forceinline__ void xcd_barrier_complete(unsigned* bar, unsigned x, unsigned& nloc, unsigned& nx) {
    const unsigned G = gridDim.x * gridDim.y * gridDim.z;
    unsigned sum, cnt, mine, sp = 0u;
    for (;;) {
        sum = 0u; cnt = 0u; mine = 0u;
#pragma unroll
        for (unsigned j = 0; j < 16; ++j) { const unsigned c = xb_ld(&bar[XB_XCNT(j)]); sum += c; cnt += (c > 0u) ? 1u : 0u; mine = (j == x) ? c : mine; }
        if (sum == G) break;
        __builtin_amdgcn_s_sleep(1);
        if ((++sp & 255u) == 0u) { if (xb_ld(&bar[XB_TMO])) break; if (sp > XB_SPIN_CAP) { atomicAdd(&bar[XB_TMO], 1u); break; } }
    }
    nloc = mine > 0u ? mine : 1u; nx = cnt > 0u ? cnt : 1u;
}
__device__ __forceinline__ void xcd_barrier(const XcdBarrier& b) {
    asm volatile("s_waitcnt vmcnt(0)" ::: "memory");
    __syncthreads();
    if (threadIdx.x == 0) {
        unsigned* bar = b.bar;
        __builtin_amdgcn_s_waitcnt(0);
        unsigned nloc = b.st[0], nx = b.st[1];
        if (nloc == 0u) { xcd_barrier_complete(bar, b.x, nloc, nx); b.st[0] = nloc; b.st[1] = nx; }
        const unsigned old = xb_add(&bar[XB_XSUB(b.x)], 1u);
        const unsigned gen = old / nloc;
        if (old + 1u == (gen + 1u) * nloc) {
            __builtin_amdgcn_fence(__ATOMIC_RELEASE, "agent");
            asm volatile("s_waitcnt vmcnt(0)" ::: "memory");
            const unsigned og = xb_add(&bar[XB_TOP], 1u);
            const unsigned tg = og / nx;
            if (og + 1u == (tg + 1u) * nx) xb_add(&bar[XB_TOPGEN], 1u);
            else XB_SPIN(xb_ld(&bar[XB_TOPGEN]) == tg, bar);
            __builtin_amdgcn_fence(__ATOMIC_ACQUIRE, "agent");
            xb_add(&bar[XB_XGEN(b.x)], 1u);
            asm volatile("s_waitcnt vmcnt(0)" ::: "memory");
        } else {
            XB_SPIN(xb_ld(&bar[XB_XGEN(b.x)]) == gen, bar);
            __builtin_amdgcn_fence(__ATOMIC_ACQUIRE, "agent");
            asm volatile("s_waitcnt vmcnt(0)" ::: "memory");
        }
    }
    __syncthreads();
}

struct Params { const float* in[30]; float* out; unsigned char* ws; int ph_lo, ph_hi; };
struct Frame {
    LAS unsigned char* lds;
    const float* const* in;
    float* out; unsigned char* ws;
    int tid, lane, wave, vcu, G;
    __device__ __forceinline__ const float* mod(int l, int r, int chunk) const { return (const float*)(ws + WS_MOD) + ((size_t)(l * 9 + r) * 6144 + chunk * 1024); }
    __device__ __forceinline__ bf16_t* xr_row(int row) const { return (bf16_t*)(ws + WS_XR) + (size_t)row * DM; }
    __device__ __forceinline__ bf16_t* hx() const { return (bf16_t*)out; }
    __device__ __forceinline__ const float* xin_row(int row) const { return row < TX ? in[I_X] + (size_t)row * DM : in[I_CTX] + (size_t)(row - TX) * DM; }
    __device__ __forceinline__ unsigned* cnt(int l) const { return (unsigned*)(ws + WS_CTL) + CW_CNT + l * 32 * 64; }
};
__device__ __forceinline__ int modrow(int row) { return row < TX ? (row >> 12) : 8; }

__device__ __forceinline__ void p0_mod_item(const Frame& F, int item) {
    const int l = item / 96, cg = item % 96;
    LAS float* sc = (LAS float*)F.lds;
    LAS float* red = sc + 9 * 1024;
    for (int i = F.tid; i < 9 * 1024; i += NTHREADS) { const int r = i >> 10, k = i & 1023; const float v = r < 8 ? F.in[I_C][r * 1024 + k] : F.in[I_CCTX][k]; sc[i] = v / (1.f + expf(-v)); }
    __syncthreads();
    const float* W = F.in[I_MODW] + (size_t)l * 1024 * 6144 + cg * 64 + F.lane;
    float acc[9];
#pragma unroll
    for (int r = 0; r < 9; ++r) acc[r] = 0.f;
    for (int kb = 0; kb < 128; kb += 32) { float w[32];
#pragma unroll
        for (int kk = 0; kk < 32; ++kk) w[kk] = W[(size_t)(F.wave * 128 + kb + kk) * 6144];
#pragma unroll
        for (int kk = 0; kk < 32; ++kk) { const int k = F.wave * 128 + kb + kk;
#pragma unroll
            for (int r = 0; r < 9; ++r) acc[r] += sc[r * 1024 + k] * w[kk]; } }
#pragma unroll
    for (int r = 0; r < 9; ++r) red[(F.wave * 9 + r) * 64 + F.lane] = acc[r];
    __syncthreads();
    for (int i = F.tid; i < 9 * 64; i += NTHREADS) { const int r = i >> 6, ln = i & 63; float s = 0.f;
#pragma unroll
        for (int w = 0; w < 8; ++w) s += red[(w * 9 + r) * 64 + ln];
        ((float*)(F.ws + WS_MOD))[(size_t)(l * 9 + r) * 6144 + cg * 64 + ln] = s + F.in[I_MODB][l * 6144 + cg * 64 + ln]; }
    __syncthreads();
}
struct TDesc { const float* src; bf16_t* dst; int ldw; };
__device__ __forceinline__ void t_load(const TDesc& d, f32x4 (&v)[16], int lane) {
    const int kr = lane >> 4, nq = lane & 15;
#pragma unroll
    for (int i = 0; i < 16; ++i) v[i] = *(const f32x4*)(d.src + (size_t)(4 * i + kr) * d.ldw + 4 * nq);
}
__device__ __forceinline__ void t_finish(const TDesc& d, const f32x4 (&v)[16], LAS float* scr, int lane) {
    const int kr = lane >> 4, nq = lane & 15;
#pragma unroll
    for (int i = 0; i < 16; ++i) { LAS float* s = scr + (4 * i + kr) * 65 + 4 * nq; s[0] = v[i][0]; s[1] = v[i][1]; s[2] = v[i][2]; s[3] = v[i][3]; }
    asm volatile("s_waitcnt lgkmcnt(0)" ::: "memory");
    const int c = lane & 7;
#pragma unroll
    for (int j = 0; j < 8; ++j) { const int n = (lane >> 3) + 8 * j; const LAS float* s = scr + (8 * c) * 65 + n;
        u32x4 o; o.x = pk2(s[0 * 65], s[1 * 65]); o.y = pk2(s[2 * 65], s[3 * 65]); o.z = pk2(s[4 * 65], s[5 * 65]); o.w = pk2(s[6 * 65], s[7 * 65]);
        *(u32x4*)(d.dst + (size_t)n * 64 + 8 * c) = o; }
    asm volatile("s_waitcnt lgkmcnt(0)" ::: "memory");
}
constexpr int TN_AB = 16 * 28, TN_OAB = 16 * 16, TN_CD = 16 * 20, TN_OCD = 8 * 16, TN_G = 64 * 128, TN_U = 64 * 128, TN_D = 64 * 128;
constexpr int TN_ITEMS = TN_AB + TN_OAB + TN_CD + TN_OCD + TN_G + TN_U + TN_D;
__device__ __forceinline__ TDesc t_decode(const Frame& F, int it) {
    TDesc d; int r = it;
    if (r < TN_AB) { const int kb = r / 28, nb = r % 28, n0 = nb * 64; int d0;
        if (n0 < 768) d0 = n0; else if (n0 < 1280) { const int j = n0 - 768; d0 = 768 + (j >> 7) * 256 + (j & 127); } else { const int j = n0 - 1280; d0 = 768 + (j >> 7) * 256 + 128 + (j & 127); }
        d.src = F.in[I_WINAB] + (size_t)kb * 64 * 1792 + n0; d.ldw = 1792; d.dst = (bf16_t*)(F.ws + WS_WINAB) + ((size_t)kb * 1792 + d0) * 64; return d; } r -= TN_AB;
    if (r < TN_OAB) { const int kb = r / 16, nb = r % 16; d.src = F.in[I_WOUTAB] + (size_t)kb * 64 * 1024 + nb * 64; d.ldw = 1024; d.dst = (bf16_t*)(F.ws + WS_WOUTAB) + ((size_t)kb * 1024 + nb * 64) * 64; return d; } r -= TN_OAB;
    if (r < TN_CD) { const int kb = r / 20, nb = r % 20; d.src = F.in[I_WINCD] + (size_t)kb * 64 * 1280 + nb * 64; d.ldw = 1280; d.dst = (bf16_t*)(F.ws + WS_WINCD) + ((size_t)kb * 1280 + nb * 64) * 64; return d; } r -= TN_CD;
    if (r < TN_OCD) { const int kb = r / 16, nb = r % 16; d.src = F.in[I_WOUTCD] + (size_t)kb * 64 * 1024 + nb * 64; d.ldw = 1024; d.dst = (bf16_t*)(F.ws + WS_WOUTCD) + ((size_t)kb * 1024 + nb * 64) * 64; return d; } r -= TN_OCD;
    if (r < TN_G + TN_U) { const bool up = r >= TN_G; if (up) r -= TN_G; const int le = r >> 7, q = r & 127, kb = q >> 3, nb = q & 7, n0 = nb * 64;
        const int d0 = (n0 >> 7) * 256 + (up ? 128 : 0) + (n0 & 127);
        d.src = F.in[up ? I_EXU : I_EXG] + (size_t)le * 1024 * 512 + (size_t)kb * 64 * 512 + n0; d.ldw = 512; d.dst = (bf16_t*)(F.ws + WS_WGU) + (size_t)le * 1024 * 1024 + ((size_t)kb * 1024 + d0) * 64; return d; } r -= TN_G + TN_U;
    { const int le = r >> 7, q = r & 127, kb = q >> 4, nb = q & 15;
        d.src = F.in[I_EXD] + (size_t)le * 512 * 1024 + (size_t)kb * 64 * 1024 + nb * 64; d.ldw = 1024; d.dst = (bf16_t*)(F.ws + WS_WD) + (size_t)le * 1024 * 512 + ((size_t)kb * 1024 + nb * 64) * 64; return d; }
}
constexpr int TN_DENSE = TN_AB + TN_OAB + TN_CD + TN_OCD;
__device__ __forceinline__ void transpose_range(const Frame& F, int lo, int hi, int w, int nw) {
    LAS float* scr = (LAS float*)(F.lds + F.wave * 16640);
    f32x4 va[16], vb[16]; TDesc da, db;
    const int first = lo + w;
    if (first < hi) { da = t_decode(F, first); t_load(da, va, F.lane); }
    for (int it = first; it < hi; it += 2 * nw) {
        const int it2 = it + nw, it3 = it + 2 * nw;
        if (it2 < hi) { db = t_decode(F, it2); t_load(db, vb, F.lane); }
        t_finish(da, va, scr, F.lane);
        if (it3 < hi) { da = t_decode(F, it3); t_load(da, va, F.lane); }
        if (it2 < hi) t_finish(db, vb, scr, F.lane);
    }
}
__device__ __forceinline__ void p0_prologue(const Frame& F) { for (int it = F.vcu; it < 192; it += F.G) p0_mod_item(F, it); }
__device__ __forceinline__ void p0_misc(const Frame& F) {
    const int gw = F.vcu * NWAVES + F.wave, NGW = F.G * NWAVES;
    const int gt = gw * 64 + F.lane, NGT = NGW * 64;
    { float* rc = (float*)(F.ws + WS_ROPE); float* rs = rc + SEQ * 32;
      for (int i = gt; i < SEQ * 32; i += NGT) { const int s = i >> 5, d = i & 31, f = d & 15; const float pos = (float)(d < 16 ? (s >> 6) : (s & 63));
          const float inv = exp2f(-(float)f * (13.287712379549449f / 16.f)); const float a = pos * inv; rc[i] = cosf(a); rs[i] = sinf(a); } }
    { typedef float f32x16_t __attribute__((ext_vector_type(16)));
      bf16_t* WT = (bf16_t*)(F.ws + WS_WOUTCD); const int l31 = F.lane & 31, lh = F.lane >> 5;
      for (int it = gw; it < 4 * 32 * 4; it += NGW) { const int g = it >> 7, dt = (it >> 2) & 31, ct = it & 3;
          const float* wo = F.in[I_WOUTCD] + (size_t)(512 + g * 128 + lh) * 1024 + dt * 32 + l31;
          const float* pw = F.in[I_POOLW] + (size_t)(g * 128 + ct * 32 + l31) * 128 + lh; const float* ps = F.in[I_POOLS] + g * 128 + lh;
          f32x16_t acc;
#pragma unroll
          for (int r = 0; r < 16; ++r) acc[r] = 0.f;
          for (int dp0 = 0; dp0 < 128; dp0 += 16) { float av[8], bv[8];
#pragma unroll
              for (int u = 0; u < 8; ++u) { av[u] = wo[(size_t)(dp0 + 2 * u) * 1024]; bv[u] = pw[dp0 + 2 * u] * ps[dp0 + 2 * u]; }
#pragma unroll
              for (int u = 0; u < 8; ++u) acc = __builtin_amdgcn_mfma_f32_32x32x2f32(av[u], bv[u], acc, 0, 0, 0); }
#pragma unroll
          for (int r = 0; r < 16; ++r) { const int i = (r & 3) + 8 * (r >> 2) + 4 * lh; const int k_ = 512 + g * 128 + ct * 32 + l31; WT[((size_t)(k_ >> 6) * 1024 + dt * 32 + i) * 64 + (k_ & 63)] = (bf16_t)(pk2(acc[r], 0.f) & 0xffffu); } } }
    { bf16_t* WR = (bf16_t*)(F.ws + WS_WR);
      for (int i = gt; i < 2 * 32 * 144 * 8; i += NGT) { const int j = i & 7, e16 = (i >> 3) % 144, s_ = (i / (8 * 144)) & 31, l = i / (8 * 144 * 32);
          int col; bool grp = false; int c;
          if (e16 < 128) { const int lane_ = e16 & 63, row = lane_ & 15; c = lane_ >> 4; col = 8 * (row >> 2) + (e16 < 64 ? 0 : 4) + (row & 3); }
          else { const int q = e16 - 128; c = q & 3; col = q >> 2; grp = true; }
          const int k = 32 * s_ + 8 * c + j;
          const float w = grp ? F.in[I_RGW][(size_t)l * 4096 + k * 4 + col] : F.in[I_REW][(size_t)l * 32768 + k * 32 + col];
          const unsigned hi = pk2(w, 0.f) & 0xffffu; const unsigned lo = pk2(w - bflo(hi), 0.f) & 0xffffu;
          const size_t o = (size_t)s_ * 1152 + (size_t)e16 * 8 + j;
          WR[(size_t)(l * 2 + 0) * 36864 + o] = (bf16_t)hi; WR[(size_t)(l * 2 + 1) * 36864 + o] = (bf16_t)lo; } }
    transpose_range(F, 0, F.G == 256 ? TN_DENSE : TN_ITEMS, gw, NGW);
}

__device__ __forceinline__ void norm_mod_row(const float* xrow, const float* g, const float* sh, const float* sc, int lane, f32x4 (&h)[4]) {
    f32x4 v[4]; float ss = 0.f;
#pragma unroll
    for (int j = 0; j < 4; ++j) { v[j] = *(const f32x4*)(xrow + 4 * lane + 256 * j); ss += (v[j][0] * v[j][0] + v[j][1] * v[j][1]) + (v[j][2] * v[j][2] + v[j][3] * v[j][3]); }
    const float rms = 1.0f / sqrtf(wave_sum(ss) * (1.f / 1024.f) + EPS);
#pragma unroll
    for (int j = 0; j < 4; ++j) { const int c = 4 * lane + 256 * j; const f32x4 gg = *(const f32x4*)(g + c), s1 = *(const f32x4*)(sc + c), s0 = *(const f32x4*)(sh + c);
        h[j] = (v[j] * rms * gg) * (1.f + s1) + s0; }
}
__device__ __forceinline__ void store_row_bf16(bf16_t* orow, int lane, const f32x4 (&h)[4]) {
#pragma unroll
    for (int j = 0; j < 4; ++j) { u32x2 o; o.x = pk2(h[j][0], h[j][1]); o.y = pk2(h[j][2], h[j][3]); *(u32x2*)(orow + 4 * lane + 256 * j) = o; }
}
struct RowBuf { f32x4 v[4]; };
__device__ __forceinline__ void row_load(RowBuf& b, const float* xrow, int lane) {
#pragma unroll
    for (int j = 0; j < 4; ++j) b.v[j] = *(const f32x4*)(xrow + 4 * lane + 256 * j);
}
__device__ __forceinline__ void row_norm_store(const RowBuf& b, const float* g, const float* sh, const float* sc, bf16_t* orow, int lane) {
    float ss = 0.f;
#pragma unroll
    for (int j = 0; j < 4; ++j) ss += (b.v[j][0] * b.v[j][0] + b.v[j][1] * b.v[j][1]) + (b.v[j][2] * b.v[j][2] + b.v[j][3] * b.v[j][3]);
    const float rms = 1.0f / sqrtf(wave_sum(ss) * (1.f / 1024.f) + EPS);
    f32x4 h[4];
#pragma unroll
    for (int j = 0; j < 4; ++j) { const int c = 4 * lane + 256 * j; h[j] = (b.v[j] * rms * *(const f32x4*)(g + c)) * (1.f + *(const f32x4*)(sc + c)) + *(const f32x4*)(sh + c); }
    store_row_bf16(orow, lane, h);
}
__device__ __forceinline__ void p_norm1_l0(const Frame& F) {
    const int gw = F.vcu * NWAVES + F.wave, NGW = F.G * NWAVES;
    { float* GP = (float*)(F.ws + WS_GP);
      for (int i = gw * 64 + F.lane; i < 2 * 9 * 1024; i += NGW * 64) { const int k = i & 1023, lr = i >> 10; GP[i] = F.in[I_LN2][(lr / 9) * 1024 + k] * (1.f + F.mod(lr / 9, lr % 9, 4)[k]); } }
    bf16_t* HX = F.hx();
    RowBuf A, B;
    if (gw < TT) row_load(A, F.xin_row(gw), F.lane);
    for (int row = gw; row < TT; row += 2 * NGW) {
        const int row2 = row + NGW, row3 = row + 2 * NGW;
        if (row2 < TT) row_load(B, F.xin_row(row2), F.lane);
        { const int r = modrow(row); row_norm_store(A, F.in[I_LN1], F.mod(0, r, 0), F.mod(0, r, 1), HX + (size_t)row * DM, F.lane); }
        if (row3 < TT) row_load(A, F.xin_row(row3), F.lane);
        if (row2 < TT) { const int r = modrow(row2); row_norm_store(B, F.in[I_LN1], F.mod(0, r, 0), F.mod(0, r, 1), HX + (size_t)row2 * DM, F.lane); }
    }
}

struct Unit { int pm, pn, e; };
struct SchedDense {
    const bf16_t* Bt; int K, nMa, nN, nMb, pnb, vcu, G;
    __device__ __forceinline__ bool next(int i, Unit& u) const { int L = i * G + vcu; const int na = nMa * nN; u.e = 0;
        if (L < na) { u.pm = L / nN; u.pn = L % nN; return true; } L -= na; if (L < nMb) { u.pm = nMa + L; u.pn = pnb; return true; } return false; }
    __device__ __forceinline__ int arow(const Unit& u, int r) const { return u.pm * 256 + r; }
    __device__ __forceinline__ const bf16_t* bbase(const Unit& u) const { return Bt + (size_t)u.pn * 256 * 64; }
    __device__ __forceinline__ int brows() const { return nN * 256; }
};
struct MoeTab { const LAS int* tile_e; const LAS int* tile0; const LAS int* cnt; int ntiles; };
struct SchedMoe {
    const bf16_t* Wt; size_t estride; int K; MoeTab tb; const unsigned* list; bool gather; int vcu, G;
    __device__ __forceinline__ bool next(int i, Unit& u) const { const int L = i * G + vcu; if (L >= tb.ntiles * 4) return false; u.pm = L >> 2; u.pn = L & 3; u.e = tb.tile_e[u.pm]; return true; }
    __device__ __forceinline__ int arow(const Unit& u, int r) const {
        if (!gather) return u.pm * 256 + r;
        int idx = (u.pm - tb.tile0[u.e]) * 256 + r; const int c = tb.cnt[u.e]; idx = idx < c ? idx : c - 1;
        return (int)list[(size_t)u.e * TT + idx]; }
    __device__ __forceinline__ const bf16_t* bbase(const Unit& u) const { return Wt + (size_t)u.e * estride + (size_t)u.pn * 256 * 64; }
    __device__ __forceinline__ int brows() const { return 1024; }
};
__device__ __forceinline__ MoeTab moe_tables(const Frame& F, int l) {
    LAS int* tile_e = (LAS int*)(F.lds + LDS_TAB); LAS int* tile0 = tile_e + NTILE_MAX; LAS int* cntl = tile0 + 33; LAS int* nt = cntl + 32;
    __syncthreads();
    if (F.tid == 0) { int t = 0; unsigned* cg = F.cnt(l);
        for (int e = 0; e < NE; ++e) { const int c = (int)__hip_atomic_load(cg + e * 64, __ATOMIC_RELAXED, __HIP_MEMORY_SCOPE_AGENT); const int n = (c + 255) >> 8; tile0[e] = t; cntl[e] = c;
            for (int j = 0; j < n; ++j) tile_e[t + j] = e; t += n; }
        tile0[32] = t; nt[0] = t; }
    __syncthreads();
    MoeTab tb; tb.tile_e = tile_e; tb.tile0 = tile0; tb.cnt = cntl; tb.ntiles = nt[0]; return tb;
}

namespace pg8 {
constexpr int BM = 256, BK = 64, HALF = 128, HTB = HALF * BK * 2;
__device__ __forceinline__ int lds_byte(int r, int c) { const int st = (r >> 4) * 2 + (c >> 5), rr = r & 15, cc = c & 31, ob = rr * 64 + cc * 2; return st * 1024 + (ob ^ (((ob >> 9) & 1) << 5)); }
__device__ __forceinline__ void stage_rc(int b, int& R, int& C) { const int st = b / 1024, sb = b % 1024, swz = sb ^ (((sb >> 9) & 1) << 5); R = (st >> 1) * 16 + swz / 64; C = (st & 1) * 32 + (swz % 64) / 2; }
__device__ __forceinline__ int perm32(int rho) { const int n = rho >> 4, i = rho & 15; return 8 * (i >> 2) + 4 * n + (i & 3); }
}
template <bool ALIGN_EPI, class Sched, class Epi>
__device__ __forceinline__ void gemm_fast(const Frame& F, const bf16_t* A, int K, const Sched& S, const Epi& E) {
    using namespace pg8;
    LAS unsigned char* lds = F.lds;
    const int tid = F.tid, wid = F.wave, lane = F.lane, wr = wid >> 2, wc = wid & 3, fr = lane & 15, fq = lane >> 4;
    const int nt = K / BK;
    int RA[2], CA[2]; unsigned voffB[2];
#pragma unroll
    for (int i = 0; i < 2; ++i) { int R, C; stage_rc(tid * 16 + i * 8192, R, C); RA[i] = R; CA[i] = C; const int Rb = (R & ~31) + perm32(R & 31); voffB[i] = (unsigned)(Rb * 64 + C) * 2u; }
    const size_t kstep = (size_t)(BK * 2);
    const size_t kstepB = (size_t)S.brows() * BK * 2;
    const size_t hstep = (size_t)HALF * BK * 2;
    const unsigned ldsw = (unsigned)wid * 1024u;
    const int aoff = lds_byte(wr * 64 + fr, fq * 8), boff = lds_byte(wc * 32 + fr, fq * 8);
    const char* Ab = (const char*)A;
#define PG8_SA(b, h) (((b) * 2 + (h)) * HTB)
#define PG8_SB(b, h) ((4 + (b) * 2 + (h)) * HTB)
#define PG8_STAGE(bufoff, gbase, voff) do { _Pragma("unroll") for (int _i = 0; _i < 2; ++_i) \
        __builtin_amdgcn_global_load_lds((const unsigned*)((const char*)(gbase) + (voff)[_i]), (LAS unsigned*)(lds + (bufoff) + ldsw + _i * 8192), 16, 0, 0); } while (0)
#define PG8_LDA(dst, b, h) do { _Pragma("unroll") for (int m = 0; m < 4; ++m) _Pragma("unroll") for (int k = 0; k < 2; ++k) dst[m][k] = *(const LAS bf16x8*)(lds + PG8_SA(b, h) + aoff + m * 2048 + k * 1024); } while (0)
#define PG8_LDB(dst, b, h) do { _Pragma("unroll") for (int n = 0; n < 2; ++n) _Pragma("unroll") for (int k = 0; k < 2; ++k) dst[n][k] = *(const LAS bf16x8*)(lds + PG8_SB(b, h) + boff + n * 2048 + k * 1024); } while (0)
#define PG8_MMA(ai, bj, At, Bt) do { __builtin_amdgcn_s_setprio(1); _Pragma("unroll") for (int m = 0; m < 4; ++m) _Pragma("unroll") for (int n = 0; n < 2; ++n) _Pragma("unroll") for (int k = 0; k < 2; ++k) \
        acc[ai][bj][m][n] = __builtin_amdgcn_mfma_f32_16x16x32_bf16(Bt[n][k], At[m][k], acc[ai][bj][m][n], 0, 0, 0); __builtin_amdgcn_s_setprio(0); } while (0)
#define PG8_WAIT_V(n) asm volatile("s_waitcnt vmcnt(" #n ")" ::: "memory")
#define PG8_WAIT_L(n) asm volatile("s_waitcnt lgkmcnt(" #n ")" ::: "memory")
#define PG8_BAR __builtin_amdgcn_s_barrier()
#define PG8_SCHED __builtin_amdgcn_sched_barrier(0)
#define PG8_VOFF(dst, u) do { _Pragma("unroll") for (int _h = 0; _h < 2; ++_h) _Pragma("unroll") for (int _i = 0; _i < 2; ++_i) \
        dst[_h][_i] = (unsigned)S.arow(u, 128 * _h + RA[_i]) * (unsigned)(K * 2) + (unsigned)(CA[_i] * 2); } while (0)
    Unit cur, nxt; int ui = 0;
    if (!S.next(0, cur)) return;
    f32x4 acc[2][2][4][2];
#pragma unroll
    for (int a = 0; a < 2; ++a)
#pragma unroll
        for (int b = 0; b < 2; ++b)
#pragma unroll
            for (int m = 0; m < 4; ++m)
#pragma unroll
                for (int n = 0; n < 2; ++n) acc[a][b][m][n] = (f32x4){0.f, 0.f, 0.f, 0.f};
    bf16x8 At[4][2], B0[2][2], B1[2][2];
    unsigned vC[2][2], vN[2][2];
    PG8_VOFF(vC, cur);
    const char* cB = (const char*)S.bbase(cur);
    PG8_STAGE(PG8_SB(0, 0), cB, voffB); PG8_STAGE(PG8_SB(0, 1), cB + hstep, voffB); PG8_STAGE(PG8_SA(0, 0), Ab, vC[0]); PG8_STAGE(PG8_SA(0, 1), Ab, vC[1]);
    if (wr == 1) PG8_BAR;
    PG8_WAIT_V(2); PG8_BAR;
    PG8_STAGE(PG8_SB(1, 0), cB + kstepB, voffB); PG8_STAGE(PG8_SA(1, 0), Ab + kstep, vC[0]); PG8_STAGE(PG8_SB(1, 1), cB + hstep + kstepB, voffB);
    PG8_WAIT_V(6); PG8_BAR;
    for (;;) {
        const bool has_next = S.next(ui + 1, nxt);
        const char* nB = cB;
        if (has_next) { PG8_VOFF(vN, nxt); nB = (const char*)S.bbase(nxt); }
        else {
#pragma unroll
            for (int h = 0; h < 2; ++h)
#pragma unroll
                for (int i = 0; i < 2; ++i) vN[h][i] = vC[h][i]; }
        for (int t = 0; t < nt; t += 2) {
            const bool last = (t == nt - 2);
            const char* a1 = Ab + (size_t)(t + 1) * kstep;
            const char* a2 = last ? Ab : Ab + (size_t)(t + 2) * kstep; const char* b2 = last ? nB : cB + (size_t)(t + 2) * kstepB;
            const char* a3 = a2 + kstep; const char* b3 = b2 + kstepB;
            unsigned v2[2][2];
#pragma unroll
            for (int h = 0; h < 2; ++h)
#pragma unroll
                for (int i = 0; i < 2; ++i) v2[h][i] = last ? vN[h][i] : vC[h][i];
            PG8_LDB(B0, 0, 0); PG8_LDB(B1, 0, 1); PG8_SCHED; PG8_LDA(At, 0, 0); PG8_STAGE(PG8_SA(1, 1), a1, vC[1]);
            PG8_WAIT_V(8); PG8_WAIT_L(0); PG8_BAR; PG8_MMA(0, 0, At, B0); PG8_MMA(0, 1, At, B1); PG8_BAR; PG8_SCHED;
            PG8_LDA(At, 0, 1); PG8_STAGE(PG8_SB(0, 0), b2, voffB); PG8_STAGE(PG8_SB(0, 1), b2 + hstep, voffB); PG8_STAGE(PG8_SA(0, 0), a2, v2[0]);
            PG8_WAIT_V(8); PG8_WAIT_L(0); PG8_BAR; PG8_MMA(1, 0, At, B0); PG8_MMA(1, 1, At, B1); PG8_BAR; PG8_SCHED;
            PG8_LDB(B0, 1, 0); PG8_LDB(B1, 1, 1); PG8_SCHED; PG8_LDA(At, 1, 0); PG8_STAGE(PG8_SA(0, 1), a2, v2[1]);
            PG8_WAIT_V(8); PG8_WAIT_L(0); PG8_BAR; PG8_MMA(0, 0, At, B0); PG8_MMA(0, 1, At, B1); PG8_BAR; PG8_SCHED;
            PG8_LDA(At, 1, 1); PG8_STAGE(PG8_SB(1, 0), b3, voffB); PG8_STAGE(PG8_SB(1, 1), b3 + hstep, voffB); PG8_STAGE(PG8_SA(1, 0), a3, v2[0]);
            PG8_WAIT_V(8); PG8_WAIT_L(0); PG8_BAR; PG8_MMA(1, 0, At, B0); PG8_MMA(1, 1, At, B1); PG8_BAR; PG8_SCHED;
        }
        if (ALIGN_EPI) { if (wr == 0) PG8_BAR; }
        E(acc, cur, wr, wc, fr, fq);
        if (!has_next) break;
#pragma unroll
        for (int a = 0; a < 2; ++a)
#pragma unroll
            for (int b = 0; b < 2; ++b)
#pragma unroll
                for (int m = 0; m < 4; ++m)
#pragma unroll
                    for (int n = 0; n < 2; ++n) acc[a][b][m][n] = (f32x4){0.f, 0.f, 0.f, 0.f};
        cur = nxt; cB = nB; ++ui;
#pragma unroll
        for (int h = 0; h < 2; ++h)
#pragma unroll
            for (int i = 0; i < 2; ++i) vC[h][i] = vN[h][i];
        if (ALIGN_EPI) { if (wr == 1) PG8_BAR; }
    }
    PG8_WAIT_V(0);
    if (!ALIGN_EPI) { if (wr == 0) PG8_BAR; }
    PG8_BAR;
#undef PG8_SA
#undef PG8_SB
#undef PG8_STAGE
#undef PG8_LDA
#undef PG8_LDB
#undef PG8_MMA
#undef PG8_WAIT_V
#undef PG8_WAIT_L
#undef PG8_BAR
#undef PG8_SCHED
#undef PG8_VOFF
}
#ifndef ALIGN_G2
#define ALIGN_G2 false
#endif
#define GEMM gemm_fast<true>
#define GEMM2 gemm_fast<ALIGN_G2>

__device__ __forceinline__ u32x4 pack8(const f32x4& a, const f32x4& b) { u32x4 w; w.x = pk2(a[0], a[1]); w.y = pk2(a[2], a[3]); w.z = pk2(b[0], b[1]); w.w = pk2(b[2], b[3]); return w; }
template <bool GLU> struct EpiInProj {
    bf16_t* Q; bf16_t* KR; bf16_t* Vn; bf16_t* Gb;
    __device__ __forceinline__ void operator()(const f32x4 (&acc)[2][2][4][2], const Unit& u, int wr, int wc, int fr, int fq) const {
#pragma unroll
        for (int ai = 0; ai < 2; ++ai)
#pragma unroll
            for (int m = 0; m < 4; ++m) { const int irow = u.pm * 256 + 128 * ai + 64 * wr + 16 * m + fr; const size_t row = (size_t)irow; const int cl = 32 * wc + 8 * fq;
                if (u.pn < 2) { *(u32x4*)(Q + row * 512 + u.pn * 256 + cl) = pack8(acc[ai][0][m][0], acc[ai][0][m][1]); *(u32x4*)(Q + row * 512 + u.pn * 256 + 128 + cl) = pack8(acc[ai][1][m][0], acc[ai][1][m][1]); }
                else if (u.pn == 2) { const size_t kvrow = irow < TX ? (size_t)(irow >> 12) * KVS + CTXL + (irow & 4095) : (size_t)((irow - TX) >> 8) * KVS + ((irow - TX) & 255);
                    *(u32x4*)(KR + kvrow * 128 + cl) = pack8(acc[ai][0][m][0], acc[ai][0][m][1]); *(u32x4*)(Vn + kvrow * 128 + cl) = pack8(acc[ai][1][m][0], acc[ai][1][m][1]); }
                else if (GLU) { f32x4 g0, g1;
#pragma unroll
                    for (int j = 0; j < 4; ++j) { g0[j] = acc[ai][0][m][0][j] * sigmoidf_(acc[ai][1][m][0][j]); g1[j] = acc[ai][0][m][1][j] * sigmoidf_(acc[ai][1][m][1][j]); }
                    *(u32x4*)(Gb + row * 512 + (u.pn - 3) * 128 + cl) = pack8(g0, g1); }
                else { *(u32x4*)(Gb + row * 512 + (u.pn - 3) * 256 + cl) = pack8(acc[ai][0][m][0], acc[ai][0][m][1]); *(u32x4*)(Gb + row * 512 + (u.pn - 3) * 256 + 128 + cl) = pack8(acc[ai][1][m][0], acc[ai][1][m][1]); }
            }
    }
};
template <bool L0, bool DRY = false> struct EpiOutProj {
    Frame F; int l;
    __device__ __forceinline__ void operator()(const f32x4 (&acc)[2][2][4][2], const Unit& u, int wr, int wc, int fr, int fq) const {
        float* SS = (float*)(F.ws + WS_SS);
        const float* g1 = F.mod(l, modrow(u.pm * 256), 2) + u.pn * 256 + 32 * wc + 8 * fq;
        f32x4 gv[2][2];
#pragma unroll
        for (int bj = 0; bj < 2; ++bj)
#pragma unroll
            for (int n = 0; n < 2; ++n) gv[bj][n] = *(const f32x4*)(g1 + 128 * bj + 4 * n);
#pragma unroll
        for (int ai = 0; ai < 2; ++ai) {
            f32x4 xv[4][2][2];
#pragma unroll
            for (int m = 0; m < 4; ++m) { const int row = u.pm * 256 + 128 * ai + 64 * wr + 16 * m + fr; const int c0 = u.pn * 256 + 32 * wc + 8 * fq;
#pragma unroll
                for (int bj = 0; bj < 2; ++bj) {
                    if (L0) { const float* src = F.xin_row(row) + c0 + 128 * bj; xv[m][bj][0] = *(const f32x4*)(src); xv[m][bj][1] = *(const f32x4*)(src + 4); }
                    else { const u32x4 w = *(const u32x4*)(F.xr_row(row) + c0 + 128 * bj); xv[m][bj][0] = (f32x4){bflo(w.x), bfhi(w.x), bflo(w.y), bfhi(w.y)}; xv[m][bj][1] = (f32x4){bflo(w.z), bfhi(w.z), bflo(w.w), bfhi(w.w)}; } } }
#pragma unroll
            for (int m = 0; m < 4; ++m) { const int row = u.pm * 256 + 128 * ai + 64 * wr + 16 * m + fr; bf16_t* dst = F.xr_row(row) + u.pn * 256 + 32 * wc + 8 * fq; float q = 0.f;
#pragma unroll
                for (int bj = 0; bj < 2; ++bj) { const f32x4 v0 = xv[m][bj][0] + gv[bj][0] * acc[ai][bj][m][0], v1 = xv[m][bj][1] + gv[bj][1] * acc[ai][bj][m][1];
                    *(u32x4*)(dst + 128 * bj) = DRY ? pack8(xv[m][bj][0], xv[m][bj][1]) : pack8(v0, v1);
                    q += ((v0[0] * v0[0] + v0[1] * v0[1]) + (v0[2] * v0[2] + v0[3] * v0[3])) + ((v1[0] * v1[0] + v1[1] * v1[1]) + (v1[2] * v1[2] + v1[3] * v1[3])); }
                q += __shfl_xor(q, 16); q += __shfl_xor(q, 32);
                if (fq == 0) SS[(size_t)row * 16 + u.pn * 4 + wc] = q; }
        }
    }
};
struct EpiMoe1 {
    bf16_t* HID;
    __device__ __forceinline__ void operator()(const f32x4 (&acc)[2][2][4][2], const Unit& u, int wr, int wc, int fr, int fq) const {
#pragma unroll
        for (int ai = 0; ai < 2; ++ai)
#pragma unroll
            for (int m = 0; m < 4; ++m) { const size_t slot = (size_t)u.pm * 256 + 128 * ai + 64 * wr + 16 * m + fr; f32x4 h0, h1;
#pragma unroll
                for (int j = 0; j < 4; ++j) { const float a = acc[ai][0][m][0][j], b = acc[ai][0][m][1][j]; h0[j] = a * sigmoidf_(a) * acc[ai][1][m][0][j]; h1[j] = b * sigmoidf_(b) * acc[ai][1][m][1][j]; }
                *(u32x4*)(HID + slot * 512 + u.pn * 128 + 32 * wc + 8 * fq) = pack8(h0, h1); }
    }
};
struct EpiMoe2 {
    bf16_t* YB;
    __device__ __forceinline__ void operator()(const f32x4 (&acc)[2][2][4][2], const Unit& u, int wr, int wc, int fr, int fq) const {
#pragma unroll
        for (int ai = 0; ai < 2; ++ai)
#pragma unroll
            for (int m = 0; m < 4; ++m) { const size_t slot = (size_t)u.pm * 256 + 128 * ai + 64 * wr + 16 * m + fr;
#pragma unroll
                for (int bj = 0; bj < 2; ++bj) *(u32x4*)(YB + slot * 1024 + u.pn * 256 + 128 * bj + 32 * wc + 8 * fq) = pack8(acc[ai][bj][m][0], acc[ai][bj][m][1]); }
    }
};

__device__ __forceinline__ void p_k_post(const Frame& F, const float* kg) {
    const int gw = F.vcu * NWAVES + F.wave, NGW = F.G * NWAVES, lane = F.lane;
    const bf16_t* KR = (const bf16_t*)(F.ws + WS_KV); bf16_t* Kn = (bf16_t*)(F.ws + WS_KN);
    const float* rc = (const float*)(F.ws + WS_ROPE); const float* rs = rc + SEQ * 32;
    const int c16 = lane & 15, i8 = c16 & 7, dd0 = 8 * (i8 & 3), sub = lane >> 4;
    float gk[8];
#pragma unroll
    for (int j = 0; j < 8; ++j) gk[j] = kg[i8 * 8 + j];
    const float sgn = (i8 < 4) ? -1.f : 1.f;
    for (int it = gw; it < NB * KVS / 16; it += NGW) {
        u32x4 w[4];
#pragma unroll
        for (int q = 0; q < 4; ++q) w[q] = *(const u32x4*)(KR + (size_t)(it * 16 + 4 * q + sub) * 128 + c16 * 8);
#pragma unroll
        for (int q = 0; q < 4; ++q) { const int kvrow = it * 16 + 4 * q + sub, pos = kvrow % KVS;
            float cs[8], sn[8];
#pragma unroll
            for (int j = 0; j < 8; ++j) { cs[j] = 1.f; sn[j] = 0.f; }
            if (pos >= CTXL) { const int sq = pos - CTXL; const f32x4 c0 = *(const f32x4*)(rc + sq * 32 + dd0), c1 = *(const f32x4*)(rc + sq * 32 + dd0 + 4), s0 = *(const f32x4*)(rs + sq * 32 + dd0), s1 = *(const f32x4*)(rs + sq * 32 + dd0 + 4);
#pragma unroll
                for (int j = 0; j < 4; ++j) { cs[j] = c0[j]; cs[4 + j] = c1[j]; sn[j] = s0[j]; sn[4 + j] = s1[j]; } }
            float x[8] = {bflo(w[q].x), bfhi(w[q].x), bflo(w[q].y), bfhi(w[q].y), bflo(w[q].z), bfhi(w[q].z), bflo(w[q].w), bfhi(w[q].w)};
            float ss = 0.f;
#pragma unroll
            for (int j = 0; j < 8; ++j) ss += x[j] * x[j];
            ss += __shfl_xor(ss, 1); ss += __shfl_xor(ss, 2); ss += __shfl_xor(ss, 4);
            const float rms = 1.0f / sqrtf(ss * (1.f / 64.f) + EPS);
            float y[8], o[8];
#pragma unroll
            for (int j = 0; j < 8; ++j) y[j] = x[j] * rms * gk[j];
#pragma unroll
            for (int j = 0; j < 8; ++j) { const float yp = __shfl_xor(y[j], 4); o[j] = y[j] * cs[j] + sgn * yp * sn[j]; }
            u32x4 ow; ow.x = pk2(o[0], o[1]); ow.y = pk2(o[2], o[3]); ow.z = pk2(o[4], o[5]); ow.w = pk2(o[6], o[7]);
            *(u32x4*)(Kn + (size_t)kvrow * 128 + c16 * 8) = ow; }
    }
}
__device__ __forceinline__ void p_conv(const Frame& F) {
    const bf16_t* Gb = (const bf16_t*)(F.ws + WS_G); bf16_t* AO = (bf16_t*)(F.ws + WS_AO);
    LAS bf16_t* gl = (LAS bf16_t*)F.lds;
    LAS float* yl = (LAS float*)(F.lds + 65536);
    const int c = F.tid;
    float w[31];
#pragma unroll
    for (int j = 0; j < 31; ++j) w[j] = F.in[I_CONVW][j * 512 + c];
    const float bias = F.in[I_CONVB][c];
    u32x4 pre[8];
#define CONV_ITEM(item, rowbase, t0, len) do { if ((item) < 1024) { rowbase = ((item) >> 7) * SEQ; t0 = ((item) & 127) * 32; len = SEQ; } else { const int it_ = (item) - 1024; rowbase = TX + (it_ >> 3) * CTXL; t0 = (it_ & 7) * 32; len = CTXL; } } while (0)
#define CONV_LOAD(item) do { int rb_, t0_, len_; CONV_ITEM(item, rb_, t0_, len_); _Pragma("unroll") for (int q = 0; q < 8; ++q) { const int ch = F.tid + q * NTHREADS, r = ch >> 6, p = t0_ - 15 + r; pre[q] = (u32x4){0u, 0u, 0u, 0u}; \
        if (ch < 62 * 64 && p >= 0 && p < len_) pre[q] = *(const u32x4*)(Gb + (size_t)(rb_ + p) * 512 + (ch & 63) * 8); } } while (0)
    if (F.vcu < 1024 + 64) CONV_LOAD(F.vcu);
    for (int item = F.vcu; item < 1024 + 64; item += F.G) {
        int rowbase, t0, len; CONV_ITEM(item, rowbase, t0, len);
        __syncthreads();
#pragma unroll
        for (int q = 0; q < 8; ++q) { const int ch = F.tid + q * NTHREADS; if (ch < 62 * 64) *(LAS u32x4*)(gl + (ch >> 6) * 512 + (ch & 63) * 8) = pre[q]; }
        __syncthreads();
        if (item + F.G < 1024 + 64) CONV_LOAD(item + F.G);
        float g[62];
#pragma unroll
        for (int r = 0; r < 62; ++r) g[r] = bf2f(gl[r * 512 + c]);
#pragma unroll
        for (int t = 0; t < 32; ++t) { float y = bias;
#pragma unroll
            for (int j = 0; j < 31; ++j) y += g[t + j] * w[j];
            yl[t * 512 + c] = y; }
        __syncthreads();
#pragma unroll
        for (int tt = 0; tt < 4; ++tt) { const int t = 4 * F.wave + tt; float v[8]; float sm = 0.f;
#pragma unroll
            for (int j = 0; j < 8; ++j) { v[j] = yl[t * 512 + F.lane + 64 * j]; sm += v[j]; }
            const float mean = wave_sum(sm) * (1.f / 512.f); float q = 0.f;
#pragma unroll
            for (int j = 0; j < 8; ++j) { v[j] -= mean; q += v[j] * v[j]; }
            const float rstd = 1.0f / sqrtf(wave_sum(q) * (1.f / 512.f) + EPS);
            bf16_t* orow = AO + (size_t)(rowbase + t0 + t) * 1024 + 512;
#pragma unroll
            for (int j = 0; j < 8; ++j) { const int cc = F.lane + 64 * j; const float yn = v[j] * rstd * F.in[I_CLNG][cc] + F.in[I_CLNB][cc]; orow[cc] = (bf16_t)(pk2(yn * sigmoidf_(yn), 0.f) & 0xffffu); } }
    }
#undef CONV_ITEM
#undef CONV_LOAD
    __syncthreads();
}
__device__ __forceinline__ void p_pool(const Frame& F) {
    const int gw = F.vcu * NWAVES + F.wave, NGW = F.G * NWAVES, lane = F.lane;
    const bf16_t* U = (const bf16_t*)(F.ws + WS_G); bf16_t* AO = (bf16_t*)(F.ws + WS_AO);
    const int hw = 1 << (lane >> 4);
    float wgt[16];
#pragma unroll
    for (int i = 0; i < 16; ++i) wgt[i] = (i >= 8 - hw && i < 8 + hw) ? 1.f : 0.f;
    for (int it = gw; it < TX / 8; it += NGW) {
        const int row0 = it * 8, t0 = row0 & 4095, rb = row0 - t0;
        u32x4 r[23];
#pragma unroll
        for (int j = 0; j < 23; ++j) { const int p = t0 - 8 + j; r[j] = (u32x4){0u, 0u, 0u, 0u}; if (p >= 0 && p < SEQ) r[j] = *(const u32x4*)(U + (size_t)(rb + p) * 512 + lane * 8); }
#pragma unroll
        for (int t = 0; t < 8; ++t) {
            float s[8];
#pragma unroll
            for (int j = 0; j < 8; ++j) s[j] = 0.f;
#pragma unroll
            for (int i = 0; i < 16; ++i) { const u32x4 w = r[t + i]; const float g = wgt[i];
                s[0] += g * bflo(w.x); s[1] += g * bfhi(w.x); s[2] += g * bflo(w.y); s[3] += g * bfhi(w.y); s[4] += g * bflo(w.z); s[5] += g * bfhi(w.z); s[6] += g * bflo(w.w); s[7] += g * bfhi(w.w); }
            const int tt = t0 + t; int lo = tt - hw, hi = tt + hw; lo = lo < 0 ? 0 : lo; hi = hi > SEQ ? SEQ : hi;
            const float inv = 1.f / (float)(hi - lo); const u32x4 w = r[t + 8];
            u32x4 ow; ow.x = pk2(s[0] * inv - bflo(w.x), s[1] * inv - bfhi(w.x)); ow.y = pk2(s[2] * inv - bflo(w.y), s[3] * inv - bfhi(w.y)); ow.z = pk2(s[4] * inv - bflo(w.z), s[5] * inv - bfhi(w.z)); ow.w = pk2(s[6] * inv - bflo(w.w), s[7] * inv - bfhi(w.w));
            *(u32x4*)(AO + (size_t)(row0 + t) * 1024 + 512 + lane * 8) = ow;
        }
    }
}

template <int LAYER> __device__ __forceinline__ void attn_simple(const Frame& F) {
    const bf16_t* Q = (const bf16_t*)(F.ws + WS_Q); const bf16_t* Kn = (const bf16_t*)(F.ws + WS_KN); const bf16_t* Vn = (const bf16_t*)(F.ws + WS_VN); bf16_t* AO = (bf16_t*)(F.ws + WS_AO);
    const int nunits = LAYER == 0 ? 512 + 64 : 512;
    for (int u = F.vcu; u < nunits; u += F.G) {
        int b, h, row, s; bool valid = true, isctx = false;
        if (u < 512) { b = u >> 6; h = (u >> 3) & 7; s = (u & 7) * 512 + F.tid; row = b * SEQ + s; }
        else { const int uc = u - 512; b = uc >> 3; h = uc & 7; s = F.tid; valid = F.tid < 256; row = TX + b * CTXL + (valid ? s : 0); isctx = true; }
        float q[64], o[64];
        { const u32x4* qp = (const u32x4*)(Q + (size_t)row * 512 + h * 64);
#pragma unroll
          for (int c = 0; c < 8; ++c) { const u32x4 w = qp[c]; q[8 * c] = bflo(w.x); q[8 * c + 1] = bfhi(w.x); q[8 * c + 2] = bflo(w.y); q[8 * c + 3] = bfhi(w.y); q[8 * c + 4] = bflo(w.z); q[8 * c + 5] = bfhi(w.z); q[8 * c + 6] = bflo(w.w); q[8 * c + 7] = bfhi(w.w); } }
#pragma unroll
        for (int d = 0; d < 64; ++d) o[d] = 0.f;
        float mx = -1e30f, l = 0.f;
        const bf16_t* Kb = Kn + (size_t)b * KVS * 128 + (h >> 2) * 64; const bf16_t* Vb = Vn + (size_t)b * KVS * 128 + (h >> 2) * 64;
        int k_lo2 = 0, k_hi2 = 0;
        const int k_hi1 = CTXL;
        if (LAYER == 0) { if (!isctx) { k_lo2 = CTXL; k_hi2 = KVS; } }
        else { const int s0 = (u & 7) * 512; int lo = s0 - 128, hi = s0 + 511 + 128 + 1; lo = lo < 0 ? 0 : lo; hi = hi > SEQ ? SEQ : hi; k_lo2 = CTXL + lo; k_hi2 = CTXL + hi; }
        for (int part = 0; part < 2; ++part) {
            const int kb = part == 0 ? 0 : k_lo2, ke = part == 0 ? k_hi1 : k_hi2;
            for (int key = kb; key < ke; ++key) {
                const u32x4* kp = (const u32x4*)(Kb + (size_t)key * 128); float sd = 0.f;
#pragma unroll
                for (int c = 0; c < 8; ++c) { const u32x4 w = kp[c];
                    sd += q[8 * c] * bflo(w.x) + q[8 * c + 1] * bfhi(w.x) + q[8 * c + 2] * bflo(w.y) + q[8 * c + 3] * bfhi(w.y) + q[8 * c + 4] * bflo(w.z) + q[8 * c + 5] * bfhi(w.z) + q[8 * c + 6] * bflo(w.w) + q[8 * c + 7] * bfhi(w.w); }
                bool use = valid;
                if (LAYER == 1 && part == 1) { const int j = key - CTXL; const int dlt = s - j; use = use && (dlt <= 128 && dlt >= -128); }
                const float mn = fmaxf(mx, sd); const float mnew = use ? mn : mx;
                const float alpha = exp2f(mx - mnew), p = use ? exp2f(sd - mnew) : 0.f;
                mx = mnew; l = l * alpha + p;
                const u32x4* vp = (const u32x4*)(Vb + (size_t)key * 128);
#pragma unroll
                for (int c = 0; c < 8; ++c) { const u32x4 w = vp[c];
                    o[8 * c] = o[8 * c] * alpha + p * bflo(w.x); o[8 * c + 1] = o[8 * c + 1] * alpha + p * bfhi(w.x); o[8 * c + 2] = o[8 * c + 2] * alpha + p * bflo(w.y); o[8 * c + 3] = o[8 * c + 3] * alpha + p * bfhi(w.y);
                    o[8 * c + 4] = o[8 * c + 4] * alpha + p * bflo(w.z); o[8 * c + 5] = o[8 * c + 5] * alpha + p * bfhi(w.z); o[8 * c + 6] = o[8 * c + 6] * alpha + p * bflo(w.w); o[8 * c + 7] = o[8 * c + 7] * alpha + p * bfhi(w.w); }
            }
        }
        if (LAYER == 1) l += exp2f(F.in[I_SINK][h] * LOG2E - mx);
        const float il = 1.f / l;
        if (valid) { u32x4* op = (u32x4*)(AO + (size_t)row * 1024 + h * 64);
#pragma unroll
            for (int c = 0; c < 8; ++c) { u32x4 w; w.x = pk2(o[8 * c] * il, o[8 * c + 1] * il); w.y = pk2(o[8 * c + 2] * il, o[8 * c + 3] * il); w.z = pk2(o[8 * c + 4] * il, o[8 * c + 5] * il); w.w = pk2(o[8 * c + 6] * il, o[8 * c + 7] * il); op[c] = w; } }
    }
}

#include <hip/hip_bf16.h>
namespace attn_body {
using bf16=__hip_bfloat16;
using s16x4=__attribute__((ext_vector_type(4)))short;
using f32x16=__attribute__((ext_vector_type(16)))float;
constexpr int NW=8,QBLK=32,QB=QBLK*NW,KVBLK=64;
constexpr int QP=512,KP=128,OP=1024;
__device__ __forceinline__ int crow(int r,int hi){return (r&3)+8*(r>>2)+4*hi;}
#define SBAR() __builtin_amdgcn_sched_barrier(0)
__device__ __forceinline__ void wmask(f32x16&p0,f32x16&p1,int dlt0,int hi){
  const float NEG=-INFINITY; const int kb=dlt0+4*hi;
  #pragma unroll
  for(int r=0;r<16;++r){const int d=kb+(r&3)+8*(r>>2); if(d>128||d<-128)p0[r]=NEG; if(d+32>128||d+32<-128)p1[r]=NEG;}
}

constexpr int NSLOT=3, SLOTB=8192;
constexpr int LDS_K=0, LDS_V=NSLOT*SLOTB, LDS_WS=2*NSLOT*SLOTB, LDS_OST=LDS_WS+NW*64*4, LDS_BYTES=LDS_OST+NW*4096;
__device__ __forceinline__ void glds16(const void*gsrc,unsigned lds_dst){unsigned keep;
  asm volatile("s_mov_b32 %0, m0\n\ts_mov_b32 m0, %2\n\ts_nop 0\n\tglobal_load_lds_dwordx4 %1, off\n\ts_mov_b32 m0, %0":"=&s"(keep):"v"(gsrc),"s"(lds_dst):"memory");}
__device__ __forceinline__ float max3f(float a,float b,float c){float r;asm("v_max3_f32 %0, %1, %2, %3":"=v"(r):"v"(a),"v"(b),"v"(c));return r;}
__device__ __forceinline__ float max2f(float a,float b){float r;asm("v_max_f32_e32 %0, %1, %2":"=v"(r):"v"(a),"v"(b));return r;}
__device__ __forceinline__ float fadd_s(float a,float b){float r;asm("v_add_f32_e32 %0, %1, %2":"=v"(r):"v"(a),"v"(b));return r;}
__device__ __forceinline__ float fsub_s(float a,float b){float r;asm("v_sub_f32_e32 %0, %1, %2":"=v"(r):"v"(a),"v"(b));return r;}
typedef float f32x2_t __attribute__((ext_vector_type(2))); typedef __bf16 bf16x2_t __attribute__((ext_vector_type(2)));
__device__ __forceinline__ unsigned cvtpk_s(float lo,float hi){f32x2_t v={lo,hi};bf16x2_t b=__builtin_convertvector(v,bf16x2_t);return __builtin_bit_cast(unsigned,b);}
#define WAIT_BAR(N) asm volatile("s_waitcnt vmcnt(" #N ") lgkmcnt(0)\n\ts_barrier":::"memory")

__device__ __forceinline__ void qkt(f32x16&p0,f32x16&p1,const char*Kslot,const bf16x8*qr,const f32x16&negm,int r32,int hi){
  const char*kb=Kslot+hi*1024+r32*16;
  #pragma unroll
  for(int d0=0;d0<4;++d0){
    const bf16x8 b0=*reinterpret_cast<const bf16x8*>(kb+d0*2048);
    const bf16x8 b1=*reinterpret_cast<const bf16x8*>(kb+d0*2048+512);
    if(d0==0){p0=__builtin_amdgcn_mfma_f32_32x32x16_bf16(b0,qr[0],negm,0,0,0);p1=__builtin_amdgcn_mfma_f32_32x32x16_bf16(b1,qr[0],negm,0,0,0);}
    else{p0=__builtin_amdgcn_mfma_f32_32x32x16_bf16(b0,qr[d0],p0,0,0,0);p1=__builtin_amdgcn_mfma_f32_32x32x16_bf16(b1,qr[d0],p1,0,0,0);}}
}
typedef __attribute__((address_space(3))) const char* lds_cptr;
typedef short v4i16_t __attribute__((ext_vector_type(4)));
__device__ __forceinline__ void kload8(bf16x8*kf,lds_cptr kp){
  kf[0]=*(const __attribute__((address_space(3))) bf16x8*)(kp);      kf[1]=*(const __attribute__((address_space(3))) bf16x8*)(kp+512);
  kf[2]=*(const __attribute__((address_space(3))) bf16x8*)(kp+2048); kf[3]=*(const __attribute__((address_space(3))) bf16x8*)(kp+2560);
  kf[4]=*(const __attribute__((address_space(3))) bf16x8*)(kp+4096); kf[5]=*(const __attribute__((address_space(3))) bf16x8*)(kp+4608);
  kf[6]=*(const __attribute__((address_space(3))) bf16x8*)(kp+6144); kf[7]=*(const __attribute__((address_space(3))) bf16x8*)(kp+6656);
}
__device__ __forceinline__ void kload2(bf16x8*kf,lds_cptr kp,int j){ kf[2*j]=*(const __attribute__((address_space(3))) bf16x8*)(kp+j*2048); kf[2*j+1]=*(const __attribute__((address_space(3))) bf16x8*)(kp+j*2048+512); }
__device__ __forceinline__ s16x4 vtr(lds_cptr p){ return __builtin_bit_cast(s16x4,__builtin_amdgcn_ds_read_tr16_b64_v4i16((__attribute__((address_space(3))) v4i16_t*)p)); }
__device__ __forceinline__ float rowmax(const f32x16&p0,const f32x16&p1){
  float a=max3f(p0[0],p0[1],p1[0]),b=max3f(p0[2],p0[3],p1[1]);a=max3f(a,p1[2],p1[3]);
  #pragma unroll
  for(int r=4;r<16;r+=4){a=max3f(a,p0[r],p0[r+1]);b=max3f(b,p0[r+2],p0[r+3]);a=max3f(a,p1[r],p1[r+1]);b=max3f(b,p1[r+2],p1[r+3]);}
  const float m=max2f(a,b);
  auto rr=__builtin_amdgcn_permlane32_swap(__float_as_uint(m),__float_as_uint(m),false,false);
  return max2f(__uint_as_float(rr[0]),__uint_as_float(rr[1]));
}
__device__ __forceinline__ void pv(f32x16*o,int vb,bf16x8 pa0,bf16x8 pa1,bf16x8 pa2,bf16x8 pa3){
  #pragma unroll
  for(int d0=0;d0<2;++d0){s16x4 lo[4],hi[4];
    #pragma unroll
    for(int ks=0;ks<4;++ks){
      asm volatile("ds_read_b64_tr_b16 %0,%1 offset:%c2":"=&v"(lo[ks]):"v"(vb),"i"(d0*4096+ks*1024):"memory");
      asm volatile("ds_read_b64_tr_b16 %0,%1 offset:%c2":"=&v"(hi[ks]):"v"(vb),"i"(d0*4096+ks*1024+512):"memory");}
    asm volatile("s_waitcnt lgkmcnt(0)":::"memory");SBAR();
    #define PK(k) (bf16x8){lo[k][0],lo[k][1],lo[k][2],lo[k][3],hi[k][0],hi[k][1],hi[k][2],hi[k][3]}
    o[d0]=__builtin_amdgcn_mfma_f32_32x32x16_bf16(pa0,PK(0),o[d0],0,0,0);
    o[d0]=__builtin_amdgcn_mfma_f32_32x32x16_bf16(pa1,PK(1),o[d0],0,0,0);
    o[d0]=__builtin_amdgcn_mfma_f32_32x32x16_bf16(pa2,PK(2),o[d0],0,0,0);
    o[d0]=__builtin_amdgcn_mfma_f32_32x32x16_bf16(pa3,PK(3),o[d0],0,0,0);
    #undef PK
  }
}

#ifndef ATTN_STORE16
#define ATTN_STORE16(p,v) (*(u32x4*)(p)=(v))
#endif
template<int MODE,int THRL> __device__ __forceinline__ void attn_unit(const bf16*Qu,const bf16*__restrict__ Kh,const bf16*__restrict__ Vh,bf16*Ou,const int NT,const int lat0,const int q0s,const float sinkl2,const float*qg,const float*ropec,const bool rope,char*shm){
  int tid_=threadIdx.x; asm volatile("":"+v"(tid_));
  const int tid=tid_,lane=tid&63,r32=lane&31,hi=lane>>5; const int wid=__builtin_amdgcn_readfirstlane(tid>>6);
  const bf16*Qw=Qu+(long)(wid*QBLK)*QP;
  const unsigned lds0=(unsigned)(uintptr_t)shm;
  float*wsf=(float*)(shm+LDS_WS)+wid*64;
  const bf16*ksrc=Kh+(long)lane*KP+wid*8;
  const bf16*vsrc=Vh+(long)(16*(wid&3)+(lane>>2))*KP+(wid>>2)*32+(lane&3)*8;
  const unsigned kdst=lds0+LDS_K+wid*1024, vdst=lds0+LDS_V+wid*1024;
  #define TROW(t) ((MODE==0||(t)<4)?(t)*KVBLK:lat0+((t)-4)*KVBLK)
  #define DMA_K(t,slot) glds16(ksrc+(long)TROW(t)*KP,(unsigned)__builtin_amdgcn_readfirstlane(kdst+(slot)))
  #define DMA_V(t,slot) glds16(vsrc+(long)TROW(t)*KP,(unsigned)__builtin_amdgcn_readfirstlane(vdst+(slot)))
  const int vb0=(int)(lds0+LDS_V)+((lane>>4)&1)*32+(lane&3)*8+(4*hi+((lane&15)>>2))*64;
  const char*Kbase=shm+LDS_K; bf16x8 kf[8];
  const lds_cptr shm3=(lds_cptr)shm; const lds_cptr kp0=shm3+LDS_K+hi*1024+r32*16; const lds_cptr vp0=shm3+LDS_V+((lane>>4)&1)*32+(lane&3)*8+(4*hi+((lane&15)>>2))*64;
  DMA_K(0,0);DMA_V(0,0);DMA_K(1,SLOTB);
  bf16x8 qr[4];
  const int qpos=q0s+wid*QBLK+r32;
  {
    u32x4 qraw[4];
    #pragma unroll
    for(int d0=0;d0<4;++d0) qraw[d0]=*reinterpret_cast<const u32x4*>(&Qw[(long)r32*QP+d0*16+hi*8]);
    float x[4][8]; float ss=0.f;
    #pragma unroll
    for(int d0=0;d0<4;++d0){ x[d0][0]=bflo(qraw[d0].x);x[d0][1]=bfhi(qraw[d0].x);x[d0][2]=bflo(qraw[d0].y);x[d0][3]=bfhi(qraw[d0].y);x[d0][4]=bflo(qraw[d0].z);x[d0][5]=bfhi(qraw[d0].z);x[d0][6]=bflo(qraw[d0].w);x[d0][7]=bfhi(qraw[d0].w);
      #pragma unroll
      for(int j=0;j<8;++j)ss+=x[d0][j]*x[d0][j]; }
    {auto rr=__builtin_amdgcn_permlane32_swap(__float_as_uint(ss),__float_as_uint(ss),false,false);ss=__uint_as_float(rr[0])+__uint_as_float(rr[1]);}
    const float rms=C2/sqrtf(ss*(1.f/64.f)+EPS);
    SBAR();
    #pragma unroll
    for(int d0=0;d0<2;++d0){
      #pragma unroll
      for(int hf=0;hf<2;++hf){
        const f32x4 ga=*reinterpret_cast<const f32x4*>(qg+d0*16+hi*8+4*hf), gb=*reinterpret_cast<const f32x4*>(qg+(d0+2)*16+hi*8+4*hf);
        f32x4 cc=f32x4{1.f,1.f,1.f,1.f}, sn=f32x4{0.f,0.f,0.f,0.f};
        if(rope){ const float*pc=ropec+(long)qpos*32+d0*16+hi*8+4*hf; cc=*reinterpret_cast<const f32x4*>(pc); sn=*reinterpret_cast<const f32x4*>(pc+SEQ*32); }
        #pragma unroll
        for(int j=0;j<4;++j){ const float a=x[d0][4*hf+j]*rms*ga[j], b=x[d0+2][4*hf+j]*rms*gb[j]; x[d0][4*hf+j]=a*cc[j]-b*sn[j]; x[d0+2][4*hf+j]=b*cc[j]+a*sn[j]; }
        SBAR(); } }
    #pragma unroll
    for(int d0=0;d0<4;++d0){ u32x4 w; w.x=cvtpk_s(x[d0][0],x[d0][1]);w.y=cvtpk_s(x[d0][2],x[d0][3]);w.z=cvtpk_s(x[d0][4],x[d0][5]);w.w=cvtpk_s(x[d0][6],x[d0][7]); qr[d0]=__builtin_bit_cast(bf16x8,w); } }
  float mhat=0.f,l_reg=0.f;f32x16 o[2],negm; { float z_=0.f; asm volatile("":"+v"(z_));
    #pragma unroll
    for(int r=0;r<16;++r){o[0][r]=z_;o[1][r]=z_;negm[r]=z_;} } asm volatile("":"+v"(negm));
  #define CMASK(P0,P1,t) do{ if(MODE==1&&(t)>=4) wmask(P0,P1,(lat0-256)+((t)-4)*KVBLK-qpos,hi); }while(0)
  bool resc=false;
  #define START(P0,P1) do{ const float rm=rowmax(P0,P1); resc=false; \
    { const float dl=rm; mhat=fadd_s(mhat,dl); \
      _Pragma("unroll") for(int r=0;r<16;++r){P0[r]=fsub_s(P0[r],dl);P1[r]=fsub_s(P1[r],dl);} \
      _Pragma("unroll") for(int r=0;r<16;++r)negm[r]=-mhat; asm volatile("":"+v"(negm)); } \
    _Pragma("unroll") for(int r=0;r<16;++r)P0[r]=__builtin_amdgcn_exp2f(P0[r]); }while(0)
  #define RESC() do{ if(resc){ asm volatile("s_waitcnt lgkmcnt(0)":::"memory"); \
      _Pragma("unroll") for(int d_=0;d_<2;++d_) _Pragma("unroll") for(int r=0;r<16;++r)o[d_][r]*=wsf[crow(r,hi)]; } }while(0)
  f32x16 pA0,pA1,pB0,pB1;
  int sl_prev=0,sl_cur=0,sl_next=SLOTB;
  #define ROT() do{sl_prev=sl_cur;sl_cur=sl_next;sl_next=(sl_next==(NSLOT-1)*SLOTB)?0:sl_next+SLOTB;}while(0)
  DMA_K(2,2*SLOTB);
  WAIT_BAR(3);
  qkt(pA0,pA1,Kbase,qr,negm,r32,hi);asm volatile("s_nop 15\n\ts_nop 7":"+v"(pA0),"+v"(pA1));CMASK(pA0,pA1,0);
  START(pA0,pA1);
  _Pragma("unroll") for(int r=0;r<16;++r)pA1[r]=__builtin_amdgcn_exp2f(pA1[r]);
  WAIT_BAR(0);
  DMA_K(3,0);DMA_V(1,SLOTB);
  ROT();
  kload8(kf,kp0+sl_cur);
  WAIT_BAR(2);
  s16x4 vlo[8],vhi[8]; u32x4 pw0,pw1,pw2,pw3;
  #define PKW(P,B) cvtpk_s(P[B],P[B+1])
  #define PAF(k) __builtin_bit_cast(bf16x8,pw##k)
  #define VFR(i) (bf16x8){vlo[i][0],vlo[i][1],vlo[i][2],vlo[i][3],vhi[i][0],vhi[i][1],vhi[i][2],vhi[i][3]}
  #define PIN(x) asm volatile("":"+v"(x))
  #define MX3(a,b,c) __builtin_fmaxf(__builtin_fmaxf((a),(b)),(c))
  #define GAPA(MF,A0,A1,A2,A3,W0,W1,PW) do{ MF; sacc+=A0; sacc+=A1; sacc+=A2; sacc+=A3; PIN(sacc); W0; W1; PIN(PW); SBAR(); }while(0)
  #define EX(v) __builtin_amdgcn_exp2f(v)
  #define GAPB(MF,X,B) do{ MF; X[B]=EX(X[B]); X[B+1]=EX(X[B+1]); X[B+2]=EX(X[B+2]); X[B+3]=EX(X[B+3]); PIN(X); SBAR(); }while(0)
  #define VRD(i) do{ vlo[i]=vtr(vp_+(((i)>>2)*4096+((i)&3)*1024)); vhi[i]=vtr(vp_+(((i)>>2)*4096+((i)&3)*1024+512)); }while(0)
  #define KRD(G,j) do{ if(G){ kload2(kf,kp0+sl_next,j); SBAR(); } }while(0)
  #define STEP(C0,C1,P0,P1,t,GK,GV,GL) do{ SBAR(); \
    const lds_cptr vp_=vp0+sl_prev; \
    VRD(0); SBAR(); float sacc=(P0[0]+P0[1]); \
    GAPA(C0=__builtin_amdgcn_mfma_f32_32x32x16_bf16(kf[0],qr[0],negm,0,0,0), P0[2],P0[3],P0[4],P0[5],     pw0[0]=PKW(P0,0), pw0[1]=PKW(P0,2), pw0); \
    VRD(4); SBAR(); GAPA(C1=__builtin_amdgcn_mfma_f32_32x32x16_bf16(kf[1],qr[0],negm,0,0,0), P0[6],P0[7],P0[8],P0[9],     pw0[2]=PKW(P0,4), pw0[3]=PKW(P0,6), pw0); \
    VRD(1); SBAR(); GAPA(C0=__builtin_amdgcn_mfma_f32_32x32x16_bf16(kf[2],qr[1],C0,0,0,0),   P0[10],P0[11],P0[12],P0[13], pw1[0]=PKW(P0,8), pw1[1]=PKW(P0,10), pw1); \
    VRD(5); SBAR(); GAPA(C1=__builtin_amdgcn_mfma_f32_32x32x16_bf16(kf[3],qr[1],C1,0,0,0),   P0[14],P0[15],P1[0],P1[1],   pw1[2]=PKW(P0,12),pw1[3]=PKW(P0,14), pw1); \
    VRD(2); SBAR(); GAPA(C0=__builtin_amdgcn_mfma_f32_32x32x16_bf16(kf[4],qr[2],C0,0,0,0),   P1[2],P1[3],P1[4],P1[5],     pw2[0]=PKW(P1,0), pw2[1]=PKW(P1,2), pw2); \
    VRD(6); SBAR(); GAPA(C1=__builtin_amdgcn_mfma_f32_32x32x16_bf16(kf[5],qr[2],C1,0,0,0),   P1[6],P1[7],P1[8],P1[9],     pw2[2]=PKW(P1,4), pw2[3]=PKW(P1,6), pw2); \
    VRD(3); SBAR(); GAPA(C0=__builtin_amdgcn_mfma_f32_32x32x16_bf16(kf[6],qr[3],C0,0,0,0),   P1[10],P1[11],P1[12],P1[13], pw3[0]=PKW(P1,8), pw3[1]=PKW(P1,10), pw3); \
    VRD(7); SBAR(); GAPA(C1=__builtin_amdgcn_mfma_f32_32x32x16_bf16(kf[7],qr[3],C1,0,0,0),   P1[14],P1[15],0.f,0.f,       pw3[2]=PKW(P1,12),pw3[3]=PKW(P1,14), pw3); \
    l_reg+=sacc; \
    if(GK){DMA_K((t)+3,sl_cur);} if(GV){DMA_V((t)+1,sl_next);} \
    CMASK(C0,C1,t); \
    { float a=MX3(C0[0],C0[1],C1[0]),b=MX3(C0[2],C0[3],C1[1]); a=MX3(a,C1[2],C1[3]); \
      _Pragma("unroll") for(int r=4;r<16;r+=4){a=MX3(a,C0[r],C0[r+1]);b=MX3(b,C0[r+2],C0[r+3]);a=MX3(a,C1[r],C1[r+1]);b=MX3(b,C1[r+2],C1[r+3]);} \
      float rm=__builtin_fmaxf(a,b); { auto rr=__builtin_amdgcn_permlane32_swap(__float_as_uint(rm),__float_as_uint(rm),false,false); rm=__builtin_fmaxf(__uint_as_float(rr[0]),__uint_as_float(rr[1])); } \
      resc=false; \
      if(__builtin_expect(__any(rm>(float)THRL),0)){ const float dl=__builtin_fmaxf(rm,0.f); mhat+=dl; \
        _Pragma("unroll") for(int r=0;r<16;++r){C0[r]-=dl;C1[r]-=dl;} \
        _Pragma("unroll") for(int r=0;r<16;++r)negm[r]=-mhat; asm volatile("":"+v"(negm)); \
        const float f=__builtin_amdgcn_exp2f(-dl); l_reg*=f; if(hi==0)wsf[r32]=f; resc=true; } } \
    SBAR(); \
    GAPB(o[0]=__builtin_amdgcn_mfma_f32_32x32x16_bf16(PAF(0),VFR(0),o[0],0,0,0), C0,0); \
    GAPB(o[1]=__builtin_amdgcn_mfma_f32_32x32x16_bf16(PAF(0),VFR(4),o[1],0,0,0), C0,4); \
    KRD(GL,0); GAPB(o[0]=__builtin_amdgcn_mfma_f32_32x32x16_bf16(PAF(1),VFR(1),o[0],0,0,0), C0,8); \
    KRD(GL,1); GAPB(o[1]=__builtin_amdgcn_mfma_f32_32x32x16_bf16(PAF(1),VFR(5),o[1],0,0,0), C0,12); \
    KRD(GL,2); GAPB(o[0]=__builtin_amdgcn_mfma_f32_32x32x16_bf16(PAF(2),VFR(2),o[0],0,0,0), C1,0); \
    KRD(GL,3); GAPB(o[1]=__builtin_amdgcn_mfma_f32_32x32x16_bf16(PAF(2),VFR(6),o[1],0,0,0), C1,4); \
    GAPB(o[0]=__builtin_amdgcn_mfma_f32_32x32x16_bf16(PAF(3),VFR(3),o[0],0,0,0), C1,8); \
    GAPB(o[1]=__builtin_amdgcn_mfma_f32_32x32x16_bf16(PAF(3),VFR(7),o[1],0,0,0), C1,12); \
    }while(0)
  int t=1;
  for(;t+5<NT;t+=2){
    STEP(pB0,pB1,pA0,pA1,t,true,true,true);     WAIT_BAR(2); RESC(); ROT();
    STEP(pA0,pA1,pB0,pB1,t+1,true,true,true);   WAIT_BAR(2); RESC(); ROT();
  }
  #define ENDW(tt) do{ if((tt)+3<NT){WAIT_BAR(2);} else if((tt)+2<NT){WAIT_BAR(1);} else {WAIT_BAR(0);} }while(0)
  for(;t+1<NT;t+=2){
    STEP(pB0,pB1,pA0,pA1,t,(t+3<NT),(t+1<NT),(t+1<NT));       ENDW(t);   RESC(); ROT();
    STEP(pA0,pA1,pB0,pB1,t+1,(t+4<NT),(t+2<NT),(t+2<NT));     ENDW(t+1); RESC(); ROT();
  }
  STEP(pB0,pB1,pA0,pA1,NT-1,false,false,false); RESC();
  { float sacc=pB0[0]+pB0[1]; _Pragma("unroll") for(int r=2;r<16;++r)sacc+=pB0[r]; _Pragma("unroll") for(int r=0;r<16;++r)sacc+=pB1[r]; l_reg+=sacc;
    pw0=(u32x4){PKW(pB0,0),PKW(pB0,2),PKW(pB0,4),PKW(pB0,6)};pw1=(u32x4){PKW(pB0,8),PKW(pB0,10),PKW(pB0,12),PKW(pB0,14)};pw2=(u32x4){PKW(pB1,0),PKW(pB1,2),PKW(pB1,4),PKW(pB1,6)};pw3=(u32x4){PKW(pB1,8),PKW(pB1,10),PKW(pB1,12),PKW(pB1,14)};
    SBAR(); pv(o,vb0+sl_cur,PAF(0),PAF(1),PAF(2),PAF(3)); }
  #undef PKW
  #undef PAF
  #undef VFR
  #undef PIN
  #undef MX3
  #undef GAPA
  #undef GAPB
  #undef EX
  #undef VRD
  #undef KRD
  #undef STEP
  #undef ENDW
  {auto rr=__builtin_amdgcn_permlane32_swap(__float_as_uint(l_reg),__float_as_uint(l_reg),false,false);l_reg=__uint_as_float(rr[0])+__uint_as_float(rr[1]);}
  if(MODE==1)l_reg+=__builtin_amdgcn_exp2f(sinkl2-mhat);
  if(hi==0)wsf[32+r32]=l_reg;asm volatile("s_waitcnt lgkmcnt(0)":::"memory");
  float rli[16];
  #pragma unroll
  for(int r=0;r<16;++r)rli[r]=__builtin_amdgcn_rcpf(wsf[32+crow(r,hi)]);
  bf16*Ow=Ou+(long)(wid*QBLK)*OP;
  { bf16*stg=(bf16*)(shm+LDS_OST)+wid*2048;
    #pragma unroll
    for(int r=0;r<16;++r){const int orow=crow(r,hi);
      #pragma unroll
      for(int d0=0;d0<2;++d0)stg[orow*64+d0*32+r32]=__float2bfloat16(o[d0][r]*rli[r]);}
    asm volatile("s_waitcnt lgkmcnt(0)":::"memory");
    #pragma unroll
    for(int i=0;i<4;++i){const int row=i*8+(lane>>3),ch=lane&7; const u32x4 v=*(const u32x4*)(stg+row*64+ch*8); ATTN_STORE16(Ow+(long)row*OP+ch*8,v);} }
  asm volatile("s_waitcnt lgkmcnt(0)\n\ts_barrier":::"memory");
  #undef DMA_K
  #undef TROW
  #undef DMA_V
  #undef CMASK
  #undef START
  #undef RESC
  #undef ROT
}
#undef SBAR
#undef WAIT_BAR
}

template <int LAYER> __device__ __forceinline__ void attn_fast(const Frame& F, char* shm) {
    using attn_body::bf16;
    const bf16* Q = (const bf16*)(F.ws + WS_Q); const bf16* Kn = (const bf16*)(F.ws + WS_KN); const bf16* Vn = (const bf16*)(F.ws + WS_VN); bf16* AO = (bf16*)(F.ws + WS_AO);
    const int nunits = LAYER == 0 ? 1024 + 64 : 1024;
    for (int U = F.vcu; U < nunits; U += F.G) {
        int b, h, NT, lat0 = 0, q0 = 0; size_t row0;
        if (U < 1024) { b = U >> 7; h = ((U >> 6) & 1) * 4 + ((U >> 4) & 3); q0 = (U & 15) * 256; row0 = (size_t)b * SEQ + q0;
            if (LAYER == 0) NT = KVS / 64;
            else { int lo = q0 - 128, hi = q0 + 384; lo = lo < 0 ? 0 : lo; hi = hi > SEQ ? SEQ : hi; NT = 4 + (hi - lo) / 64; lat0 = CTXL + lo; } }
        else { const int uc = U - 1024; b = uc >> 3; h = uc & 7; row0 = (size_t)TX + (size_t)b * CTXL; NT = 4; }
        const bf16* Kh = Kn + (size_t)b * KVS * 128 + (h >> 2) * 64; const bf16* Vh = Vn + (size_t)b * KVS * 128 + (h >> 2) * 64;
        const float sinkl2 = LAYER == 1 ? F.in[I_SINK][h] * LOG2E : 0.f;
        if (LAYER == 0 && F.G == 256 && U < 1024 && (U >> 8) == (F.vcu & 3)) {
            const int lo = TN_DENSE + (F.vcu < 64 ? F.vcu * 72 : 64 * 72 + (F.vcu - 64) * 104); int hi = lo + (F.vcu < 64 ? 72 : 104); hi = hi > TN_ITEMS ? TN_ITEMS : hi;
            Frame Fc = F; asm volatile("" : "+v"(Fc.lane), "+v"(Fc.tid));
            transpose_range(Fc, lo, hi, Fc.wave, NWAVES);
            __syncthreads(); }
        attn_body::attn_unit<LAYER, 8>(Q + row0 * 512 + h * 64, Kh, Vh, AO + row0 * 1024 + h * 64, NT, lat0, q0, sinkl2, F.in[LAYER == 0 ? I_QNA : I_QNC], (const float*)(F.ws + WS_ROPE), U < 1024, shm);
    }
}

template <int DRY> __device__ __forceinline__ void p_router(const Frame& F, int l, int ntok) {
    const int gw = F.vcu * NWAVES + F.wave, NGW = F.G * NWAVES, lane = F.lane, tk = lane & 15, kq = lane >> 4;
    bf16_t* HX = F.hx(); const float* SS = (const float*)(F.ws + WS_SS);
    const float* gb = F.in[I_RGB] + l * 4; const float* eb = F.in[I_REB] + l * 32;
    unsigned* tokslot = (unsigned*)(F.ws + (DRY ? WS_HID : WS_TOK)); float* tokw = (float*)(F.ws + (DRY ? WS_HID : WS_TOK) + 512 * 1024); unsigned* list = (unsigned*)(F.ws + (DRY ? WS_HID + 2 * MiB : WS_LIST));
    unsigned* cnt = F.cnt(DRY ? l + 2 : l);
    {
        const u32x4* src = (const u32x4*)((const bf16_t*)(F.ws + WS_WR) + (size_t)l * 2 * 36864);
        u32x4 t[18];
#pragma unroll
        for (int i = 0; i < 18; ++i) t[i] = src[F.tid + i * NTHREADS];
        __syncthreads();
#pragma unroll
        for (int i = 0; i < 18; ++i) *(LAS u32x4*)(F.lds + (F.tid + i * NTHREADS) * 16) = t[i];
    }
    const LAS unsigned char* wl0 = F.lds + lane * 16;
    const LAS unsigned char* wl2 = F.lds + 2048 + ((tk >> 2) * 4 + kq) * 16;
    LAS unsigned* lcnt = (LAS unsigned*)(F.lds + LDS_TAB + 2048 + 8192); LAS unsigned* lbase = lcnt + 32;
    LAS float* gps = (LAS float*)(F.lds + LDS_TAB + 2048);
    const int nrounds = (ntok / 16 + NGW - 1) / NGW;
    for (int rd = 0; rd < nrounds; ++rd) {
        const int grp0 = F.vcu * NWAVES + rd * NGW, grp = grp0 + F.wave;
        __syncthreads();
        if (F.tid < 32) lcnt[F.tid] = 0u;
        if (grp0 < ntok / 16) { const int r0 = modrow(grp0 * 16); const float* gpg = (const float*)(F.ws + WS_GP) + (size_t)(l * 9 + r0) * 1024; const float* shg = F.mod(l, r0, 3);
            *(LAS f32x4*)(gps + 4 * F.tid) = F.tid < 256 ? *(const f32x4*)(gpg + 4 * F.tid) : *(const f32x4*)(shg + 4 * (F.tid - 256)); }
        __syncthreads();
        const bool active = grp < ntok / 16;
        const int row = (active ? grp : 0) * 16 + tk;
        bool win = false; int e1 = 0, e2 = 0; float w1 = 0.f, w2 = 0.f; unsigned p1 = 0u, p2 = 0u;
        if (active) {
        const bf16_t* xr = F.xr_row(row) + 8 * kq;
        u32x4 xq[16];
#define R_XLOAD(i, st) do { const int s_ = (st) < 32 ? (st) : 31; if (DRY != 5) xq[i] = *(const u32x4*)(xr + s_ * 32); else xq[i] = (u32x4){(unsigned)s_, 1u, 2u, 3u}; } while (0)
#pragma unroll
        for (int i = 0; i < 16; ++i) R_XLOAD(i, i);
        float ssum = 0.f;
#pragma unroll
        for (int i = 0; i < 4; ++i) { const f32x4 p = *(const f32x4*)(SS + (size_t)row * 16 + 4 * i); ssum += (p[0] + p[1]) + (p[2] + p[3]); }
        const float rms = 1.0f / sqrtf(ssum * (1.f / 1024.f) + EPS);
        f32x4 acc[3];
#pragma unroll
        for (int n = 0; n < 3; ++n) acc[n] = (f32x4){0.f, 0.f, 0.f, 0.f};
        bf16_t* hxr = HX + (size_t)row * DM + 8 * kq;
        const LAS float* gpl = gps + 8 * kq;
#define R_STEP(i, st) do { const u32x4 xb_ = xq[i]; \
            const f32x4 m0 = *(const LAS f32x4*)(gpl + (st) * 32), m1 = *(const LAS f32x4*)(gpl + (st) * 32 + 4), m2 = *(const LAS f32x4*)(gpl + 1024 + (st) * 32), m3 = *(const LAS f32x4*)(gpl + 1024 + (st) * 32 + 4); \
            const f32x4 xf0 = (f32x4){bflo(xb_.x), bfhi(xb_.x), bflo(xb_.y), bfhi(xb_.y)}, xf1 = (f32x4){bflo(xb_.z), bfhi(xb_.z), bflo(xb_.w), bfhi(xb_.w)}; \
            const f32x4 h0 = (xf0 * rms) * m0 + m2, h1 = (xf1 * rms) * m1 + m3; \
            u32x4 hh; hh.x = pk2(h0[0], h0[1]); hh.y = pk2(h0[2], h0[3]); hh.z = pk2(h1[0], h1[1]); hh.w = pk2(h1[2], h1[3]); \
            if (DRY != 4) *(u32x4*)(hxr + (st) * 32) = hh; else if (hh.x == 0x12345678u) *(u32x4*)(hxr + (st) * 32) = hh; \
            if (DRY < 3 || DRY >= 6) { \
            u32x4 hl; hl.x = pk2(h0[0] - bflo(hh.x), h0[1] - bfhi(hh.x)); hl.y = pk2(h0[2] - bflo(hh.y), h0[3] - bfhi(hh.y)); hl.z = pk2(h1[0] - bflo(hh.z), h1[1] - bfhi(hh.z)); hl.w = pk2(h1[2] - bflo(hh.w), h1[3] - bfhi(hh.w)); \
            const bf16x8 bh = __builtin_bit_cast(bf16x8, hh), bl = __builtin_bit_cast(bf16x8, hl); \
            bf16x8 w0h, w1h, w2h, w0l, w1l, w2l; if (DRY == 6) { w0h = w1h = w2h = w0l = w1l = w2l = bh; } else { w0h = *(const LAS bf16x8*)(wl0 + (st) * 2304); w1h = *(const LAS bf16x8*)(wl0 + (st) * 2304 + 1024); w2h = *(const LAS bf16x8*)(wl2 + (st) * 2304); \
            w0l = *(const LAS bf16x8*)(wl0 + RW_BYTES + (st) * 2304); w1l = *(const LAS bf16x8*)(wl0 + RW_BYTES + (st) * 2304 + 1024); w2l = *(const LAS bf16x8*)(wl2 + RW_BYTES + (st) * 2304); } \
            if (DRY == 7) { const bf16x8 sx = w0h ^ w1h ^ w2h ^ w0l ^ w1l ^ w2l ^ bl; acc[0][0] += (float)sx[0]; } else \
            acc[0] = __builtin_amdgcn_mfma_f32_16x16x32_bf16(w0h, bh, acc[0], 0, 0, 0); acc[1] = __builtin_amdgcn_mfma_f32_16x16x32_bf16(w1h, bh, acc[1], 0, 0, 0); acc[2] = __builtin_amdgcn_mfma_f32_16x16x32_bf16(w2h, bh, acc[2], 0, 0, 0); \
            acc[0] = __builtin_amdgcn_mfma_f32_16x16x32_bf16(w0h, bl, acc[0], 0, 0, 0); acc[1] = __builtin_amdgcn_mfma_f32_16x16x32_bf16(w1h, bl, acc[1], 0, 0, 0); acc[2] = __builtin_amdgcn_mfma_f32_16x16x32_bf16(w2h, bl, acc[2], 0, 0, 0); \
            acc[0] = __builtin_amdgcn_mfma_f32_16x16x32_bf16(w0l, bh, acc[0], 0, 0, 0); acc[1] = __builtin_amdgcn_mfma_f32_16x16x32_bf16(w1l, bh, acc[1], 0, 0, 0); acc[2] = __builtin_amdgcn_mfma_f32_16x16x32_bf16(w2l, bh, acc[2], 0, 0, 0); } } while (0)
        for (int st = 0; st < 32; st += 16) {
#pragma unroll
            for (int i = 0; i < 16; ++i) { R_STEP(i, st + i); R_XLOAD(i, st + i + 16); }
        }
#undef R_XLOAD
#undef R_STEP
        if (DRY >= 6 && acc[0][0] + acc[1][1] + acc[2][2] == 123.456f) tokw[row] = 1.f;
        if (DRY < 2) {
            const float lgk = acc[2][0] + gb[kq];
            const float la = __shfl_xor(lgk, 16), lb = __shfl_xor(lgk, 32), lc = __shfl_xor(la, 32);
            const float gm = fmaxf(fmaxf(lgk, la), fmaxf(lb, lc));
            win = (lgk == gm);
            win = win && !(la == gm && (kq ^ 1) < kq) && !(lb == gm && (kq ^ 2) < kq) && !(lc == gm && (kq ^ 3) < kq);
            if (win) {
                const float g_w = 1.f / (expf(lgk - gm) + expf(la - gm) + expf(lb - gm) + expf(lc - gm));
                float el[8];
                { const f32x4 b0 = *(const f32x4*)(eb + 8 * kq), b1 = *(const f32x4*)(eb + 8 * kq + 4);
#pragma unroll
                  for (int i = 0; i < 4; ++i) { el[i] = acc[0][i] + b0[i]; el[4 + i] = acc[1][i] + b1[i]; } }
                int i1 = 0; float m1 = el[0];
#pragma unroll
                for (int i = 1; i < 8; ++i) if (el[i] > m1) { m1 = el[i]; i1 = i; }
                int i2 = 0; float m2 = -3.0e38f;
#pragma unroll
                for (int i = 0; i < 8; ++i) if (i != i1 && el[i] > m2) { m2 = el[i]; i2 = i; }
                const float pp = expf(m2 - m1); w1 = g_w / (1.f + pp); w2 = g_w * pp / (1.f + pp);
                e1 = kq * 8 + i1; e2 = kq * 8 + i2;
                p1 = __hip_atomic_fetch_add(lcnt + e1, 1u, __ATOMIC_RELAXED, __HIP_MEMORY_SCOPE_WORKGROUP); p2 = __hip_atomic_fetch_add(lcnt + e2, 1u, __ATOMIC_RELAXED, __HIP_MEMORY_SCOPE_WORKGROUP);
            }
        }
        }
        __syncthreads();
        if (DRY < 2 && F.tid < 32) { const unsigned n = lcnt[F.tid]; lbase[F.tid] = n ? atomicAdd(cnt + F.tid * 64, n) : 0u; }
        __syncthreads();
        if (win) { const unsigned pos1 = lbase[e1] + p1, pos2 = lbase[e2] + p2;
            list[(size_t)e1 * TT + pos1] = (unsigned)row; list[(size_t)e2 * TT + pos2] = (unsigned)row;
            tokslot[2 * row] = ((unsigned)e1 << 16) | pos1; tokslot[2 * row + 1] = ((unsigned)e2 << 16) | pos2; tokw[2 * row] = w1; tokw[2 * row + 1] = w2; }
    }
    __syncthreads();
}
struct CombBuf { u32x2 x[4], ya[4], yb[4]; };
__device__ __forceinline__ void comb_load(CombBuf& b, const bf16_t* xr, const bf16_t* ya, const bf16_t* yb, int lane) {
#pragma unroll
    for (int j = 0; j < 4; ++j) { const int c = 4 * lane + 256 * j; b.x[j] = *(const u32x2*)(xr + c); b.ya[j] = *(const u32x2*)(ya + c); b.yb[j] = *(const u32x2*)(yb + c); }
}
template <bool LAST, bool DRY> __device__ __forceinline__ void comb_finish(const Frame& F, const CombBuf& b, int l, int row, float wa, float wb, int lane) {
    const int r = modrow(row); const float* g2 = F.mod(l, r, 5); bf16_t* xr = F.xr_row(row);
    float ss = 0.f; f32x4 v[4];
#pragma unroll
    for (int j = 0; j < 4; ++j) { const int c = 4 * lane + 256 * j; const f32x4 gv = *(const f32x4*)(g2 + c);
        f32x4 y; y[0] = wa * bflo(b.ya[j].x) + wb * bflo(b.yb[j].x); y[1] = wa * bfhi(b.ya[j].x) + wb * bfhi(b.yb[j].x); y[2] = wa * bflo(b.ya[j].y) + wb * bflo(b.yb[j].y); y[3] = wa * bfhi(b.ya[j].y) + wb * bfhi(b.yb[j].y);
        const f32x4 x1 = (f32x4){bflo(b.x[j].x), bfhi(b.x[j].x), bflo(b.x[j].y), bfhi(b.x[j].y)};
        v[j] = x1 + gv * y;
        if (LAST) { if (!DRY) *(f32x4*)(F.out + (size_t)row * DM + c) = v[j]; }
        else { u32x2 o; o.x = pk2(v[j][0], v[j][1]); o.y = pk2(v[j][2], v[j][3]); *(u32x2*)(xr + c) = DRY ? b.x[j] : o; }
        ss += (v[j][0] * v[j][0] + v[j][1] * v[j][1]) + (v[j][2] * v[j][2] + v[j][3] * v[j][3]); }
    if (!LAST) { const float rms = 1.0f / sqrtf(wave_sum(ss) * (1.f / 1024.f) + EPS); const float* g = F.in[I_LN1] + (l + 1) * 1024; const float* sh = F.mod(l + 1, r, 0); const float* sc = F.mod(l + 1, r, 1); f32x4 h[4];
#pragma unroll
        for (int j = 0; j < 4; ++j) { const int c = 4 * lane + 256 * j; h[j] = (v[j] * rms * *(const f32x4*)(g + c)) * (1.f + *(const f32x4*)(sc + c)) + *(const f32x4*)(sh + c); }
        store_row_bf16(F.hx() + (size_t)row * DM, lane, h); }
}
template <bool LAST, bool DRY> __device__ __forceinline__ void p_combine(const Frame& F, int l, int ntok, const MoeTab& tb) {
    const int gw = F.vcu * NWAVES + F.wave, NGW = F.G * NWAVES, lane = F.lane;
    const bf16_t* YB = (const bf16_t*)(F.ws + WS_YB);
    const unsigned* tokslot = (const unsigned*)(F.ws + WS_TOK); const float* tokw = (const float*)(F.ws + WS_TOK + 512 * 1024);
    const int ntot = gw < ntok ? (ntok - gw + NGW - 1) / NGW : 0;
    for (int base = 0; base < ntot; base += 64) {
    const int n = ntot - base < 64 ? ntot - base : 64;
    unsigned my_sa = 0u, my_sb = 0u; float my_wa = 0.f, my_wb = 0.f;
    { const int mr = gw + (base + lane) * NGW;
      if (lane < n) { const unsigned sa = tokslot[2 * mr], sb = tokslot[2 * mr + 1]; my_wa = tokw[2 * mr]; my_wb = tokw[2 * mr + 1];
          my_sa = (unsigned)tb.tile0[sa >> 16] * 256u + (sa & 0xffffu); my_sb = (unsigned)tb.tile0[sb >> 16] * 256u + (sb & 0xffffu); } }
    CombBuf A, B;
#define COMB_LOAD(buf, i) do { const int row_ = gw + (base + (i)) * NGW; const unsigned sa_ = __builtin_amdgcn_readlane(my_sa, (i)), sb_ = __builtin_amdgcn_readlane(my_sb, (i)); \
        comb_load(buf, F.xr_row(row_), YB + (size_t)sa_ * 1024, YB + (size_t)sb_ * 1024, lane); } while (0)
#define COMB_FIN(buf, i) do { const float wa_ = __uint_as_float(__builtin_amdgcn_readlane(__float_as_uint(my_wa), (i))), wb_ = __uint_as_float(__builtin_amdgcn_readlane(__float_as_uint(my_wb), (i))); \
        comb_finish<LAST, DRY>(F, buf, l, gw + (base + (i)) * NGW, wa_, wb_, lane); } while (0)
    COMB_LOAD(A, 0);
    for (int i = 0; i < n; i += 2) {
        if (i + 1 < n) COMB_LOAD(B, i + 1);
        COMB_FIN(A, i);
        if (i + 2 < n) COMB_LOAD(A, i + 2);
        if (i + 1 < n) COMB_FIN(B, i + 1);
    }
    }
#undef COMB_LOAD
#undef COMB_FIN
}

__global__ void __launch_bounds__(NTHREADS, 2) fwd_kernel(Params P) {
    extern __shared__ __attribute__((aligned(16))) unsigned char lds_raw[];
    Frame F;
    F.lds = (LAS unsigned char*)lds_raw; F.in = P.in; F.out = P.out; F.ws = P.ws;
    F.tid = threadIdx.x; F.lane = F.tid & 63; F.wave = __builtin_amdgcn_readfirstlane(F.tid >> 6);
    F.G = gridDim.x; { const int bx = blockIdx.x; F.vcu = (F.G % 8 == 0) ? (bx % 8) * (F.G / 8) + bx / 8 : bx; }
    volatile LAS unsigned* misc = (volatile LAS unsigned*)(F.lds + LDS_MISC);
    if (F.tid < 16) misc[F.tid] = 0u;
    __syncthreads();
#if ONE_LAUNCH
    XcdBarrier bar = xcd_barrier_post((unsigned*)(F.ws + WS_CTL) + CW_BAR, misc + 8);
#define GRID_BAR() do { xcd_barrier(bar); } while (0)
#else
#define GRID_BAR() do { } while (0)
#endif
    const int lo = P.ph_lo, hi = P.ph_hi;
#ifndef DRYMASK
#define DRYMASK 0x4000
#endif
#ifndef DRYV
#define DRYV 7
#endif
#ifndef PHMASK
#define PHMASK 0xFFFFFFFFu
#endif
#define IN(k) (((PHMASK >> (k)) & 1u) && lo <= (k) && (k) < hi)
#ifdef PROBE_PH
#define STAMP(k) do { if (blockIdx.x == 0 && F.tid == 0) { const unsigned long long t_ = __builtin_amdgcn_s_memrealtime(); \
        if ((k) == PROBE_PH - 1) { misc[0] = (unsigned)t_; misc[1] = (unsigned)(t_ >> 32); } if ((k) == PROBE_PH) { misc[2] = (unsigned)t_; misc[3] = (unsigned)(t_ >> 32); } } } while (0)
#else
#define STAMP(k) do { } while (0)
#endif
#define SEAM(k) do { if (IN((k) + 1)) GRID_BAR(); STAMP(k); } while (0)
    STAMP(-1);
    bf16_t* HX = F.hx(); bf16_t* Qb = (bf16_t*)(F.ws + WS_Q); bf16_t* KVb = (bf16_t*)(F.ws + WS_KV); bf16_t* Gb = (bf16_t*)(F.ws + WS_G); bf16_t* AO = (bf16_t*)(F.ws + WS_AO);
    bf16_t* HID = (bf16_t*)(F.ws + WS_HID); bf16_t* YB = (bf16_t*)(F.ws + WS_YB);

    if (IN(0)) { Frame Fp = F; asm volatile("" : "+v"(Fp.tid), "+v"(Fp.lane)); p0_prologue(Fp); SEAM(0); }
    if (IN(1)) { Frame Fp = F; asm volatile("" : "+v"(Fp.tid), "+v"(Fp.lane)); p0_misc(Fp); p_norm1_l0(Fp); SEAM(1); }
    if (IN(2)) { Frame Fp = F; asm volatile("" : "+v"(Fp.tid), "+v"(Fp.lane)); SchedDense S{(const bf16_t*)(Fp.ws + WS_WINAB), 1024, TT / 256, 7, 0, 0, Fp.vcu, Fp.G}; EpiInProj<true> E{Qb, KVb, (bf16_t*)(Fp.ws + WS_VN), Gb}; GEMM(Fp, HX, 1024, S, E); SEAM(2); }
    if (IN(3)) { Frame Fp = F; asm volatile("" : "+v"(Fp.tid), "+v"(Fp.lane)); p_k_post(Fp, Fp.in[I_KNA]); p_conv(Fp); SEAM(3); }
    if (IN(4)) { Frame Fp = F; asm volatile("" : "+v"(Fp.tid), "+v"(Fp.lane));
#ifdef ATTN_SIMPLE
        attn_simple<0>(Fp);
#else
        attn_fast<0>(Fp, (char*)lds_raw);
#endif
        SEAM(4); }
    if (IN(5)) { Frame Fp = F; asm volatile("" : "+v"(Fp.tid), "+v"(Fp.lane)); SchedDense S{(const bf16_t*)(Fp.ws + WS_WOUTAB), 1024, TT / 256, 4, 0, 0, Fp.vcu, Fp.G}; EpiOutProj<true> E{Fp, 0}; GEMM(Fp, AO, 1024, S, E);
        SEAM(5); }
    if (IN(6)) { Frame Fp = F; asm volatile("" : "+v"(Fp.tid), "+v"(Fp.lane));
#if (DRYMASK >> 6) & 1
        p_router<DRYV>(Fp, 0, TT); GRID_BAR();
#endif
        p_router<0>(Fp, 0, TT); SEAM(6); }
    if (IN(7)) { Frame Fp = F; asm volatile("" : "+v"(Fp.tid), "+v"(Fp.lane)); const MoeTab tb = moe_tables(Fp, 0); SchedMoe S{(const bf16_t*)(Fp.ws + WS_WGU), (size_t)1024 * 1024, 1024, tb, (const unsigned*)(Fp.ws + WS_LIST), true, Fp.vcu, Fp.G}; EpiMoe1 E{HID}; GEMM(Fp, HX, 1024, S, E); SEAM(7); }
    if (IN(8)) { Frame Fp = F; asm volatile("" : "+v"(Fp.tid), "+v"(Fp.lane)); const MoeTab tb = moe_tables(Fp, 0); SchedMoe S{(const bf16_t*)(Fp.ws + WS_WD), (size_t)1024 * 512, 512, tb, nullptr, false, Fp.vcu, Fp.G}; EpiMoe2 E{YB}; GEMM2(Fp, HID, 512, S, E); SEAM(8); }
    if (IN(9)) { Frame Fp = F; asm volatile("" : "+v"(Fp.tid), "+v"(Fp.lane)); const MoeTab tb = moe_tables(Fp, 0);
#if (DRYMASK >> 9) & 1
        p_combine<false, true>(Fp, 0, TT, tb); GRID_BAR();
#endif
        p_combine<false, false>(Fp, 0, TT, tb); SEAM(9); }
    if (IN(10)) { Frame Fp = F; asm volatile("" : "+v"(Fp.tid), "+v"(Fp.lane)); SchedDense S{(const bf16_t*)(Fp.ws + WS_WINCD), 1024, TX / 256, 5, TC / 256, 2, Fp.vcu, Fp.G}; EpiInProj<false> E{Qb, KVb, (bf16_t*)(Fp.ws + WS_VN), Gb}; GEMM(Fp, HX, 1024, S, E); SEAM(10); }
    if (IN(11)) { Frame Fp = F; asm volatile("" : "+v"(Fp.tid), "+v"(Fp.lane)); p_k_post(Fp, Fp.in[I_KNC]); p_pool(Fp); SEAM(11); }
    if (IN(12)) { Frame Fp = F; asm volatile("" : "+v"(Fp.tid), "+v"(Fp.lane));
#ifdef ATTN_SIMPLE
        attn_simple<1>(Fp);
#else
        attn_fast<1>(Fp, (char*)lds_raw);
#endif
        SEAM(12); }
    if (IN(13)) { Frame Fp = F; asm volatile("" : "+v"(Fp.tid), "+v"(Fp.lane)); SchedDense S{(const bf16_t*)(Fp.ws + WS_WOUTCD), 1024, TX / 256, 4, 0, 0, Fp.vcu, Fp.G};
#if (DRYMASK >> 13) & 1
        { EpiOutProj<false, true> Ed{Fp, 1}; GEMM(Fp, AO, 1024, S, Ed); GRID_BAR(); }
#endif
        EpiOutProj<false> E{Fp, 1}; GEMM(Fp, AO, 1024, S, E); SEAM(13); }
    if (IN(14)) { Frame Fp = F; asm volatile("" : "+v"(Fp.tid), "+v"(Fp.lane));
#if (DRYMASK >> 14) & 1
        p_router<DRYV>(Fp, 1, TX); GRID_BAR();
#endif
        p_router<0>(Fp, 1, TX); SEAM(14); }
    if (IN(15)) { Frame Fp = F; asm volatile("" : "+v"(Fp.tid), "+v"(Fp.lane)); const MoeTab tb = moe_tables(Fp, 1); SchedMoe S{(const bf16_t*)(Fp.ws + WS_WGU) + (size_t)32 * 1024 * 1024, (size_t)1024 * 1024, 1024, tb, (const unsigned*)(Fp.ws + WS_LIST), true, Fp.vcu, Fp.G}; EpiMoe1 E{HID}; GEMM(Fp, HX, 1024, S, E); SEAM(15); }
    if (IN(16)) { Frame Fp = F; asm volatile("" : "+v"(Fp.tid), "+v"(Fp.lane)); const MoeTab tb = moe_tables(Fp, 1); SchedMoe S{(const bf16_t*)(Fp.ws + WS_WD) + (size_t)32 * 1024 * 512, (size_t)1024 * 512, 512, tb, nullptr, false, Fp.vcu, Fp.G}; EpiMoe2 E{YB}; GEMM2(Fp, HID, 512, S, E); SEAM(16); }
    if (IN(17)) { Frame Fp = F; asm volatile("" : "+v"(Fp.tid), "+v"(Fp.lane)); const MoeTab tb = moe_tables(Fp, 1);
#if (DRYMASK >> 17) & 1
        p_combine<true, true>(Fp, 1, TX, tb); GRID_BAR();
#endif
        p_combine<true, false>(Fp, 1, TX, tb); }
#ifdef PROBE_PH
    STAMP(NPH - 1);
    if (blockIdx.x == 0 && F.tid == 0) { const unsigned long long t0 = ((unsigned long long)misc[1] << 32) | misc[0], t1 = ((unsigned long long)misc[3] << 32) | misc[2];
        const unsigned long long te = __builtin_amdgcn_s_memrealtime(), span = (t1 - t0) * 16ull;
        while (__builtin_amdgcn_s_memrealtime() - te < span) __builtin_amdgcn_s_sleep(32); }
#endif
#undef IN
#undef SEAM
}

extern "C" void kernel_launch(void* const* d_in, const int* in_sizes, int n_in, void* d_out, int out_size, void* d_ws, size_t ws_size, hipStream_t stream) {
    static int grid = 0;
    if (grid == 0) {
        if (n_in != 30 || out_size != TX * DM || ws_size < WS_END) { fprintf(stderr, "kernel_launch: unexpected shapes (n_in %d out %d ws %zu)\n", n_in, out_size, ws_size); grid = -1; return; }
        int dev = 0, cus = 0;
        if (hipGetDevice(&dev) != hipSuccess || hipDeviceGetAttribute(&cus, hipDeviceAttributeMultiprocessorCount, dev) != hipSuccess) { grid = -1; return; }
        if (hipFuncSetAttribute((const void*)fwd_kernel, hipFuncAttributeMaxDynamicSharedMemorySize, LDS_BYTES) != hipSuccess) { fprintf(stderr, "kernel_launch: hipFuncSetAttribute failed\n"); grid = -1; return; }
        int per_cu = 0;
        if (hipOccupancyMaxActiveBlocksPerMultiprocessor(&per_cu, (const void*)fwd_kernel, NTHREADS, LDS_BYTES) != hipSuccess || per_cu < 1) { fprintf(stderr, "kernel_launch: occupancy query says %d\n", per_cu); }
        (void)hipGetLastError();
        grid = cus;
    }
    if (grid < 0) return;
    (void)hipMemsetAsync((char*)d_ws + WS_CTL, 0, CTL_ZERO_BYTES, stream);
    Params p{};
    for (int i = 0; i < 30; ++i) p.in[i] = (const float*)d_in[i];
    p.out = (float*)d_out; p.ws = (unsigned char*)d_ws;
#if ONE_LAUNCH
    p.ph_lo = 0; p.ph_hi = NPH;
    hipLaunchKernelGGL(fwd_kernel, dim3(grid), dim3(NTHREADS), LDS_BYTES, stream, p);
#else
    for (int ph = 0; ph < NPH; ++ph) { p.ph_lo = ph; p.ph_hi = ph + 1; hipLaunchKernelGGL(fwd_kernel, dim3(grid), dim3(NTHREADS), LDS_BYTES, stream, p); }
#endif
}
```

```cpp
#include <hip/hip_runtime.h>
#include <cstdio>
#include <cstdint>

#ifndef ONE_LAUNCH
#define ONE_LAUNCH 1
#endif

#ifndef FP8_L0
#define FP8_L0 1
#endif
#ifndef FP8_L1
#define FP8_L1 1
#endif
#define FP8_G1_L0 FP8_L0
#define FP8_G2_L0 FP8_L0
#define FP8_G1_L1 FP8_L1
#define FP8_G2_L1 FP8_L1
#define LAS __attribute__((address_space(3)))
#define GAS __attribute__((address_space(1)))
typedef unsigned short bf16_t;
typedef short bf16x8 __attribute__((ext_vector_type(8)));
typedef float f32x4 __attribute__((ext_vector_type(4)));
typedef float f32x2 __attribute__((ext_vector_type(2)));
typedef unsigned u32x4 __attribute__((ext_vector_type(4)));
typedef unsigned u32x2 __attribute__((ext_vector_type(2)));
typedef __bf16 bf16x2_t __attribute__((ext_vector_type(2)));

constexpr int NB = 8, SEQ = 4096, DM = 1024, CTXL = 256, HD = 64;
constexpr int TX = NB * SEQ, TC = NB * CTXL, TT = TX + TC;
constexpr int KVS = CTXL + SEQ;
constexpr int NE = 32;
constexpr int NTILE_MAX = 576, NSLOT = 304 * 256;
constexpr float EPS = 1e-6f;
constexpr float LOG2E = 1.4426950408889634f;
constexpr float C2 = 0.125f * LOG2E;
constexpr int NWAVES = 8, NTHREADS = 512;
constexpr int NPH = 18;

enum { I_X = 0, I_C, I_CTX, I_CCTX, I_MODW, I_MODB, I_LN1, I_LN2, I_WINAB, I_WOUTAB, I_QNA, I_KNA, I_CONVW, I_CONVB, I_CLNG, I_CLNB,
       I_WINCD, I_WOUTCD, I_QNC, I_KNC, I_SINK, I_POOLW, I_POOLS, I_RGW, I_RGB, I_REW, I_REB, I_EXG, I_EXU, I_EXD };

constexpr size_t MiB = 1u << 20;
constexpr size_t WS_CTL = 0, CTL_ZERO_BYTES = 1 * MiB;
constexpr size_t WS_MOD = 1 * MiB;
constexpr size_t WS_ROPE = 2 * MiB;
constexpr size_t WS_TOK = 3 * MiB;
constexpr size_t WS_LIST = 4 * MiB;
constexpr size_t WS_WINAB = 10 * MiB;
constexpr size_t WS_WOUTAB = 14 * MiB;
constexpr size_t WS_WINCD = 16 * MiB;
constexpr size_t WS_WOUTCD = 19 * MiB;
constexpr size_t WS_XC = 21 * MiB;
constexpr size_t WS_KN = 30 * MiB;
constexpr size_t WS_VN = 39 * MiB;
constexpr size_t WS_WGU = 48 * MiB;
constexpr size_t WS_WD = 176 * MiB;
constexpr size_t WS_XR = 240 * MiB;
constexpr size_t WS_HID = 308 * MiB;
constexpr size_t WS_Q = 384 * MiB;
constexpr size_t WS_KV = 418 * MiB;
constexpr size_t WS_G = 435 * MiB;
constexpr size_t WS_AO = 469 * MiB;
constexpr size_t WS_YB = 384 * MiB;
constexpr size_t WS_SS = 537 * MiB;
constexpr size_t WS_WR = 9 * MiB;
constexpr size_t WS_GP = 3 * MiB + 896 * 1024;
constexpr size_t WS_END = 540 * MiB;
static_assert(WS_YB + (size_t)NSLOT * 1024 * 2 <= WS_END && WS_AO + (size_t)TT * 1024 * 2 <= WS_END, "ws map");
constexpr int CW_CNT = 256;
constexpr int CW_BAR = 16384;

constexpr int RING_BYTES = 131072;
constexpr int RW_BYTES = 73728;
constexpr int LDS_MISC = 2 * RW_BYTES;
constexpr int LDS_TAB = LDS_MISC + 256;
constexpr int LDS_BYTES = 163840;

__device__ __forceinline__ unsigned pk2(float lo, float hi) { f32x2 v = {lo, hi}; bf16x2_t b = __builtin_convertvector(v, bf16x2_t); return __builtin_bit_cast(unsigned, b); }
__device__ __forceinline__ unsigned pk4_fp8(float a, float b, float c, float d) { int t = __builtin_amdgcn_cvt_pk_fp8_f32(a, b, 0, false); t = __builtin_amdgcn_cvt_pk_fp8_f32(c, d, t, true); return (unsigned)t; }
constexpr float W8_SCALE = 32.f, W8_INV = 1.f / 32.f;
__device__ __forceinline__ float bflo(unsigned w) { return __uint_as_float(w << 16); }
__device__ __forceinline__ float bfhi(unsigned w) { return __uint_as_float(w & 0xffff0000u); }
__device__ __forceinline__ float bf2f(bf16_t h) { return __uint_as_float((unsigned)h << 16); }
__device__ __forceinline__ float wave_sum(float v) {
#pragma unroll
    for (int o = 1; o < 64; o <<= 1) v += __shfl_xor(v, o);
    return v;
}
__device__ __forceinline__ float sigmoidf_(float v) { return 1.f / (1.f + __expf(-v)); }

#define XB_TMO      128
#define XB_XCNT(j)  (256  + 64 * (j))
#define XB_XSUB(j)  (1280 + 64 * (j))
#define XB_XGEN(j)  (2304 + 64 * (j))
#define XB_TOP      3328
#define XB_TOPGEN   3392
#define XCD_BAR_WORDS 3456
#define XB_SPIN_CAP (1u << 18)
__device__ __forceinline__ unsigned xb_ld(unsigned* p)              { return __hip_atomic_load(p, __ATOMIC_RELAXED, __HIP_MEMORY_SCOPE_AGENT); }
__device__ __forceinline__ unsigned xb_add(unsigned* p, unsigned v) { return __hip_atomic_fetch_add(p, v, __ATOMIC_RELAXED, __HIP_MEMORY_SCOPE_AGENT); }
__device__ __forceinline__ unsigned xb_xcc_id() { return (unsigned)__builtin_amdgcn_s_getreg((3 << 11) | 20) & 0xFu; }
#define XB_SPIN(cond, bar) do { unsigned _sp = 0; while (cond) { __builtin_amdgcn_s_sleep(1); \
    if ((++_sp & 255u) == 0u) { if (xb_ld(&(bar)[XB_TMO])) break; if (_sp > XB_SPIN_CAP) { atomicAdd(&(bar)[XB_TMO], 1u); break; } } } } while (0)
struct XcdBarrier { unsigned* bar; unsigned x; volatile LAS unsigned* st; };
__device__ __forceinline__ XcdBarrier xcd_barrier_post(unsigned* bar, volatile LAS unsigned* st) {
    XcdBarrier b; b.bar = bar; b.x = xb_xcc_id(); b.st = st;
    if (threadIdx.x == 0) (void)xb_add(&bar[XB_XCNT(b.x)], 1u);
    return b;
}
__device__ __forceinline__ void xcd_barrier_complete(unsigned* bar, unsigned x, unsigned& nloc, unsigned& nx) {
    const unsigned G = gridDim.x * gridDim.y * gridDim.z;
    unsigned sum, cnt, mine, sp = 0u;
    for (;;) {
        sum = 0u; cnt = 0u; mine = 0u;
#pragma unroll
        for (unsigned j = 0; j < 16; ++j) { const unsigned c = xb_ld(&bar[XB_XCNT(j)]); sum += c; cnt += (c > 0u) ? 1u : 0u; mine = (j == x) ? c : mine; }
        if (sum == G) break;
        __builtin_amdgcn_s_sleep(1);
        if ((++sp & 255u) == 0u) { if (xb_ld(&bar[XB_TMO])) break; if (sp > XB_SPIN_CAP) { atomicAdd(&bar[XB_TMO], 1u); break; } }
    }
    nloc = mine > 0u ? mine : 1u; nx = cnt > 0u ? cnt : 1u;
}
__device__ __forceinline__ void xcd_barrier(const XcdBarrier& b) {
    asm volatile("s_waitcnt vmcnt(0)" ::: "memory");
    __syncthreads();
    if (threadIdx.x == 0) {
        unsigned* bar = b.bar;
        __builtin_amdgcn_s_waitcnt(0);
        unsigned nloc = b.st[0], nx = b.st[1];
        if (nloc == 0u) { xcd_barrier_complete(bar, b.x, nloc, nx); b.st[0] = nloc; b.st[1] = nx; }
        const unsigned old = xb_add(&bar[XB_XSUB(b.x)], 1u);
        const unsigned gen = old / nloc;
        if (old + 1u == (gen + 1u) * nloc) {
            __builtin_amdgcn_fence(__ATOMIC_RELEASE, "agent");
            asm volatile("s_waitcnt vmcnt(0)" ::: "memory");
            const unsigned og = xb_add(&bar[XB_TOP], 1u);
            const unsigned tg = og / nx;
            if (og + 1u == (tg + 1u) * nx) xb_add(&bar[XB_TOPGEN], 1u);
            else XB_SPIN(xb_ld(&bar[XB_TOPGEN]) == tg, bar);
            __builtin_amdgcn_fence(__ATOMIC_ACQUIRE, "agent");
            xb_add(&bar[XB_XGEN(b.x)], 1u);
            asm volatile("s_waitcnt vmcnt(0)" ::: "memory");
        } else {
            XB_SPIN(xb_ld(&bar[XB_XGEN(b.x)]) == gen, bar);
            __builtin_amdgcn_fence(__ATOMIC_ACQUIRE, "agent");
            asm volatile("s_waitcnt vmcnt(0)" ::: "memory");
        }
    }
    __syncthreads();
}

struct Params { const float* in[30]; float* out; unsigned char* ws; int ph_lo, ph_hi; };
struct Frame {
    LAS unsigned char* lds;
    const float* const* in;
    float* out; unsigned char* ws;
    int tid, lane, wave, vcu, G;
    __device__ __forceinline__ const float* mod(int l, int r, int chunk) const { return (const float*)(ws + WS_MOD) + ((size_t)(l * 9 + r) * 6144 + chunk * 1024); }
    __device__ __forceinline__ bf16_t* xr_row(int row) const { return (bf16_t*)(ws + WS_XR) + (size_t)row * DM; }
    __device__ __forceinline__ bf16_t* hx() const { return (bf16_t*)out; }
    __device__ __forceinline__ const float* xin_row(int row) const { return row < TX ? in[I_X] + (size_t)row * DM : in[I_CTX] + (size_t)(row - TX) * DM; }
    __device__ __forceinline__ unsigned* cnt(int l) const { return (unsigned*)(ws + WS_CTL) + CW_CNT + l * 32 * 64; }
};
__device__ __forceinline__ int modrow(int row) { return row < TX ? (row >> 12) : 8; }

__device__ __forceinline__ void p0_mod_item(const Frame& F, int item) {
    const int l = item / 96, cg = item % 96;
    LAS float* sc = (LAS float*)F.lds;
    LAS float* red = sc + 9 * 1024;
    for (int i = F.tid; i < 9 * 1024; i += NTHREADS) { const int r = i >> 10, k = i & 1023; const float v = r < 8 ? F.in[I_C][r * 1024 + k] : F.in[I_CCTX][k]; sc[i] = v / (1.f + expf(-v)); }
    __syncthreads();
    const float* W = F.in[I_MODW] + (size_t)l * 1024 * 6144 + cg * 64 + F.lane;
    float acc[9];
#pragma unroll
    for (int r = 0; r < 9; ++r) acc[r] = 0.f;
    for (int kb = 0; kb < 128; kb += 32) { float w[32];
#pragma unroll
        for (int kk = 0; kk < 32; ++kk) w[kk] = W[(size_t)(F.wave * 128 + kb + kk) * 6144];
#pragma unroll
        for (int kk = 0; kk < 32; ++kk) { const int k = F.wave * 128 + kb + kk;
#pragma unroll
            for (int r = 0; r < 9; ++r) acc[r] += sc[r * 1024 + k] * w[kk]; } }
#pragma unroll
    for (int r = 0; r < 9; ++r) red[(F.wave * 9 + r) * 64 + F.lane] = acc[r];
    __syncthreads();
    for (int i = F.tid; i < 9 * 64; i += NTHREADS) { const int r = i >> 6, ln = i & 63; float s = 0.f;
#pragma unroll
        for (int w = 0; w < 8; ++w) s += red[(w * 9 + r) * 64 + ln];
        ((float*)(F.ws + WS_MOD))[(size_t)(l * 9 + r) * 6144 + cg * 64 + ln] = s + F.in[I_MODB][l * 6144 + cg * 64 + ln]; }
    __syncthreads();
}
struct TDesc { const float* src; unsigned char* dst; int ldw; bool fp8; };
__device__ __forceinline__ void t_load(const TDesc& d, f32x4 (&v)[16], int lane) {
    const int sh = d.fp8 ? 3 : 4, kr = lane >> sh, nq = lane & ((1 << sh) - 1), rs = 64 >> sh;
#pragma unroll
    for (int i = 0; i < 16; ++i) v[i] = *(const f32x4*)(d.src + (size_t)(rs * i + kr) * d.ldw + 4 * nq);
}
__device__ __forceinline__ void t_finish(const TDesc& d, const f32x4 (&v)[16], LAS float* scr, int lane) {
    if (!d.fp8) {
        const int kr = lane >> 4, nq = lane & 15;
#pragma unroll
        for (int i = 0; i < 16; ++i) { LAS float* s = scr + (4 * i + kr) * 65 + 4 * nq; s[0] = v[i][0]; s[1] = v[i][1]; s[2] = v[i][2]; s[3] = v[i][3]; }
        asm volatile("s_waitcnt lgkmcnt(0)" ::: "memory");
        const int c = lane & 7;
#pragma unroll
        for (int j = 0; j < 8; ++j) { const int n = (lane >> 3) + 8 * j; const LAS float* s = scr + (8 * c) * 65 + n;
            u32x4 o; o.x = pk2(s[0 * 65], s[1 * 65]); o.y = pk2(s[2 * 65], s[3 * 65]); o.z = pk2(s[4 * 65], s[5 * 65]); o.w = pk2(s[6 * 65], s[7 * 65]);
            *(u32x4*)(d.dst + ((size_t)n * 64 + 8 * c) * 2) = o; }
    } else {
        const int kr = lane >> 3, nq = lane & 7;
#pragma unroll
        for (int i = 0; i < 16; ++i) { LAS float* s = scr + (8 * i + kr) * 33 + 4 * nq; s[0] = v[i][0]; s[1] = v[i][1]; s[2] = v[i][2]; s[3] = v[i][3]; }
        asm volatile("s_waitcnt lgkmcnt(0)" ::: "memory");
        const int c = lane & 7;
#pragma unroll
        for (int j = 0; j < 4; ++j) { const int n = (lane >> 3) + 8 * j; const LAS float* s = scr + (16 * c) * 33 + n;
            u32x4 o;
            o.x = pk4_fp8(s[0 * 33] * W8_SCALE, s[1 * 33] * W8_SCALE, s[2 * 33] * W8_SCALE, s[3 * 33] * W8_SCALE); o.y = pk4_fp8(s[4 * 33] * W8_SCALE, s[5 * 33] * W8_SCALE, s[6 * 33] * W8_SCALE, s[7 * 33] * W8_SCALE);
            o.z = pk4_fp8(s[8 * 33] * W8_SCALE, s[9 * 33] * W8_SCALE, s[10 * 33] * W8_SCALE, s[11 * 33] * W8_SCALE); o.w = pk4_fp8(s[12 * 33] * W8_SCALE, s[13 * 33] * W8_SCALE, s[14 * 33] * W8_SCALE, s[15 * 33] * W8_SCALE);
            *(u32x4*)(d.dst + (size_t)n * 128 + 16 * c) = o; }
    }
    asm volatile("s_waitcnt lgkmcnt(0)" ::: "memory");
}
constexpr int TN_AB = 16 * 28, TN_OAB = 16 * 16, TN_CD = 16 * 20, TN_OCD = 8 * 16, TN_G = 64 * 128, TN_U = 64 * 128, TN_D = 64 * 128;
constexpr int TN_ITEMS = TN_AB + TN_OAB + TN_CD + TN_OCD + TN_G + TN_U + TN_D;
__device__ __forceinline__ TDesc t_decode(const Frame& F, int it) {
    TDesc d; d.fp8 = false; int r = it;
    if (r < TN_AB) { const int kb = r / 28, nb = r % 28, n0 = nb * 64; int d0;
        if (n0 < 768) d0 = n0; else if (n0 < 1280) { const int j = n0 - 768; d0 = 768 + (j >> 7) * 256 + (j & 127); } else { const int j = n0 - 1280; d0 = 768 + (j >> 7) * 256 + 128 + (j & 127); }
        d.src = F.in[I_WINAB] + (size_t)kb * 64 * 1792 + n0; d.ldw = 1792; d.dst = F.ws + WS_WINAB + ((size_t)kb * 1792 + d0) * 128; return d; } r -= TN_AB;
    if (r < TN_OAB) { const int kb = r / 16, nb = r % 16; d.src = F.in[I_WOUTAB] + (size_t)kb * 64 * 1024 + nb * 64; d.ldw = 1024; d.dst = F.ws + WS_WOUTAB + ((size_t)kb * 1024 + nb * 64) * 128; return d; } r -= TN_OAB;
    if (r < TN_CD) { const int kb = r / 20, nb = r % 20; d.src = F.in[I_WINCD] + (size_t)kb * 64 * 1280 + nb * 64; d.ldw = 1280; d.dst = F.ws + WS_WINCD + ((size_t)kb * 1280 + nb * 64) * 128; return d; } r -= TN_CD;
    if (r < TN_OCD) { const int kb = r / 16, nb = r % 16; d.src = F.in[I_WOUTCD] + (size_t)kb * 64 * 1024 + nb * 64; d.ldw = 1024; d.dst = F.ws + WS_WOUTCD + ((size_t)kb * 1024 + nb * 64) * 128; return d; } r -= TN_OCD;
    if (r < TN_G + TN_U) { const bool up = r >= TN_G; if (up) r -= TN_G; const int le = r >> 7, q = r & 127;
        const float* base = F.in[up ? I_EXU : I_EXG] + (size_t)le * 1024 * 512; unsigned char* wb = F.ws + WS_WGU + (size_t)le * 1024 * 1024 * 2;
        if ((le >> 5) ? FP8_G1_L1 : FP8_G1_L0) { const int kb = q >> 4, n0 = (q & 15) * 32, d0 = (n0 >> 7) * 256 + (up ? 128 : 0) + (n0 & 127);
            d.fp8 = true; d.src = base + (size_t)kb * 128 * 512 + n0; d.ldw = 512; d.dst = wb + ((size_t)kb * 1024 + d0) * 128; return d; }
        const int kb = q >> 3, n0 = (q & 7) * 64, d0 = (n0 >> 7) * 256 + (up ? 128 : 0) + (n0 & 127);
        d.src = base + (size_t)kb * 64 * 512 + n0; d.ldw = 512; d.dst = wb + ((size_t)kb * 1024 + d0) * 128; return d; } r -= TN_G + TN_U;
    { const int le = r >> 7, q = r & 127; const float* base = F.in[I_EXD] + (size_t)le * 512 * 1024; unsigned char* wb = F.ws + WS_WD + (size_t)le * 1024 * 512 * 2;
        if ((le >> 5) ? FP8_G2_L1 : FP8_G2_L0) { const int kb = q >> 5, nb = q & 31;
            d.fp8 = true; d.src = base + (size_t)kb * 128 * 1024 + nb * 32; d.ldw = 1024; d.dst = wb + ((size_t)kb * 1024 + nb * 32) * 128; return d; }
        const int kb = q >> 4, nb = q & 15;
        d.src = base + (size_t)kb * 64 * 1024 + nb * 64; d.ldw = 1024; d.dst = wb + ((size_t)kb * 1024 + nb * 64) * 128; return d; }
}
constexpr int TN_DENSE = TN_AB + TN_OAB + TN_CD + TN_OCD;
__device__ __forceinline__ void transpose_range(const Frame& F, int lo, int hi, int w, int nw) {
    LAS float* scr = (LAS float*)(F.lds + F.wave * 16896);
    f32x4 va[16], vb[16]; TDesc da, db;
    const int first = lo + w;
    if (first < hi) { da = t_decode(F, first); t_load(da, va, F.lane); }
    for (int it = first; it < hi; it += 2 * nw) {
        const int it2 = it + nw, it3 = it + 2 * nw;
        if (it2 < hi) { db = t_decode(F, it2); t_load(db, vb, F.lane); }
        t_finish(da, va, scr, F.lane);
        if (it3 < hi) { da = t_decode(F, it3); t_load(da, va, F.lane); }
        if (it2 < hi) t_finish(db, vb, scr, F.lane);
    }
}
__device__ __forceinline__ void p0_prologue(const Frame& F) { for (int it = F.vcu; it < 192; it += F.G) p0_mod_item(F, it); }
__device__ __forceinline__ void p0_misc(const Frame& F) {
    const int gw = F.vcu * NWAVES + F.wave, NGW = F.G * NWAVES;
    const int gt = gw * 64 + F.lane, NGT = NGW * 64;
    { float* rc = (float*)(F.ws + WS_ROPE); float* rs = rc + SEQ * 32;
      for (int i = gt; i < SEQ * 32; i += NGT) { const int s = i >> 5, d = i & 31, f = d & 15; const float pos = (float)(d < 16 ? (s >> 6) : (s & 63));
          const float inv = exp2f(-(float)f * (13.287712379549449f / 16.f)); const float a = pos * inv; rc[i] = cosf(a); rs[i] = sinf(a); } }
    { typedef float f32x16_t __attribute__((ext_vector_type(16)));
      bf16_t* WT = (bf16_t*)(F.ws + WS_WOUTCD); const int l31 = F.lane & 31, lh = F.lane >> 5;
      for (int it = gw; it < 4 * 32 * 4; it += NGW) { const int g = it >> 7, dt = (it >> 2) & 31, ct = it & 3;
          const float* wo = F.in[I_WOUTCD] + (size_t)(512 + g * 128 + lh) * 1024 + dt * 32 + l31;
          const float* pw = F.in[I_POOLW] + (size_t)(g * 128 + ct * 32 + l31) * 128 + lh; const float* ps = F.in[I_POOLS] + g * 128 + lh;
          f32x16_t acc;
#pragma unroll
          for (int r = 0; r < 16; ++r) acc[r] = 0.f;
          for (int dp0 = 0; dp0 < 128; dp0 += 16) { float av[8], bv[8];
#pragma unroll
              for (int u = 0; u < 8; ++u) { av[u] = wo[(size_t)(dp0 + 2 * u) * 1024]; bv[u] = pw[dp0 + 2 * u] * ps[dp0 + 2 * u]; }
#pragma unroll
              for (int u = 0; u < 8; ++u) acc = __builtin_amdgcn_mfma_f32_32x32x2f32(av[u], bv[u], acc, 0, 0, 0); }
#pragma unroll
          for (int r = 0; r < 16; ++r) { const int i = (r & 3) + 8 * (r >> 2) + 4 * lh; const int k_ = 512 + g * 128 + ct * 32 + l31; WT[((size_t)(k_ >> 6) * 1024 + dt * 32 + i) * 64 + (k_ & 63)] = (bf16_t)(pk2(acc[r], 0.f) & 0xffffu); } } }
    { bf16_t* WR = (bf16_t*)(F.ws + WS_WR);
      for (int i = gt; i < 2 * 32 * 144 * 8; i += NGT) { const int j = i & 7, e16 = (i >> 3) % 144, s_ = (i / (8 * 144)) & 31, l = i / (8 * 144 * 32);
          int col; bool grp = false; int c;
          if (e16 < 128) { const int lane_ = e16 & 63, row = lane_ & 15; c = lane_ >> 4; col = 8 * (row >> 2) + (e16 < 64 ? 0 : 4) + (row & 3); }
          else { const int q = e16 - 128; c = q & 3; col = q >> 2; grp = true; }
          const int k = 32 * s_ + 8 * c + j;
          const float w = grp ? F.in[I_RGW][(size_t)l * 4096 + k * 4 + col] : F.in[I_REW][(size_t)l * 32768 + k * 32 + col];
          const unsigned hi = pk2(w, 0.f) & 0xffffu; const unsigned lo = pk2(w - bflo(hi), 0.f) & 0xffffu;
          const size_t o = (size_t)s_ * 1152 + (size_t)e16 * 8 + j;
          WR[(size_t)(l * 2 + 0) * 36864 + o] = (bf16_t)hi; WR[(size_t)(l * 2 + 1) * 36864 + o] = (bf16_t)lo; } }
    transpose_range(F, 0, F.G == 256 ? TN_DENSE : TN_ITEMS, gw, NGW);
}

__device__ __forceinline__ void norm_mod_row(const float* xrow, const float* g, const float* sh, const float* sc, int lane, f32x4 (&h)[4]) {
    f32x4 v[4]; float ss = 0.f;
#pragma unroll
    for (int j = 0; j < 4; ++j) { v[j] = *(const f32x4*)(xrow + 4 * lane + 256 * j); ss += (v[j][0] * v[j][0] + v[j][1] * v[j][1]) + (v[j][2] * v[j][2] + v[j][3] * v[j][3]); }
    const float rms = 1.0f / sqrtf(wave_sum(ss) * (1.f / 1024.f) + EPS);
#pragma unroll
    for (int j = 0; j < 4; ++j) { const int c = 4 * lane + 256 * j; const f32x4 gg = *(const f32x4*)(g + c), s1 = *(const f32x4*)(sc + c), s0 = *(const f32x4*)(sh + c);
        h[j] = (v[j] * rms * gg) * (1.f + s1) + s0; }
}
__device__ __forceinline__ void store_row_bf16(bf16_t* orow, int lane, const f32x4 (&h)[4]) {
#pragma unroll
    for (int j = 0; j < 4; ++j) { u32x2 o; o.x = pk2(h[j][0], h[j][1]); o.y = pk2(h[j][2], h[j][3]); *(u32x2*)(orow + 4 * lane + 256 * j) = o; }
}
struct RowBuf { f32x4 v[4]; };
__device__ __forceinline__ void row_load(RowBuf& b, const float* xrow, int lane) {
#pragma unroll
    for (int j = 0; j < 4; ++j) b.v[j] = *(const f32x4*)(xrow + 4 * lane + 256 * j);
}
__device__ __forceinline__ void row_norm_store(const RowBuf& b, const float* g, const float* sh, const float* sc, bf16_t* orow, int lane) {
    float ss = 0.f;
#pragma unroll
    for (int j = 0; j < 4; ++j) ss += (b.v[j][0] * b.v[j][0] + b.v[j][1] * b.v[j][1]) + (b.v[j][2] * b.v[j][2] + b.v[j][3] * b.v[j][3]);
    const float rms = 1.0f / sqrtf(wave_sum(ss) * (1.f / 1024.f) + EPS);
    f32x4 h[4];
#pragma unroll
    for (int j = 0; j < 4; ++j) { const int c = 4 * lane + 256 * j; h[j] = (b.v[j] * rms * *(const f32x4*)(g + c)) * (1.f + *(const f32x4*)(sc + c)) + *(const f32x4*)(sh + c); }
    store_row_bf16(orow, lane, h);
}
__device__ __forceinline__ void p_norm1_l0(const Frame& F) {
    const int gw = F.vcu * NWAVES + F.wave, NGW = F.G * NWAVES;
    { float* GP = (float*)(F.ws + WS_GP);
      for (int i = gw * 64 + F.lane; i < 2 * 9 * 1024; i += NGW * 64) { const int k = i & 1023, lr = i >> 10; GP[i] = F.in[I_LN2][(lr / 9) * 1024 + k] * (1.f + F.mod(lr / 9, lr % 9, 4)[k]); } }
    bf16_t* HX = F.hx();
    RowBuf A, B;
    if (gw < TT) row_load(A, F.xin_row(gw), F.lane);
    for (int row = gw; row < TT; row += 2 * NGW) {
        const int row2 = row + NGW, row3 = row + 2 * NGW;
        if (row2 < TT) row_load(B, F.xin_row(row2), F.lane);
        { const int r = modrow(row); row_norm_store(A, F.in[I_LN1], F.mod(0, r, 0), F.mod(0, r, 1), HX + (size_t)row * DM, F.lane); }
        if (row3 < TT) row_load(A, F.xin_row(row3), F.lane);
        if (row2 < TT) { const int r = modrow(row2); row_norm_store(B, F.in[I_LN1], F.mod(0, r, 0), F.mod(0, r, 1), HX + (size_t)row2 * DM, F.lane); }
    }
}

struct Unit { int pm, pn, e; };
struct SchedDense {
    const bf16_t* Bt; int K, nMa, nN, nMb, pnb, vcu, G;
    __device__ __forceinline__ bool next(int i, Unit& u) const { int L = i * G + vcu; const int na = nMa * nN; u.e = 0;
        if (L < na) { u.pm = L / nN; u.pn = L % nN; return true; } L -= na; if (L < nMb) { u.pm = nMa + L; u.pn = pnb; return true; } return false; }
    __device__ __forceinline__ int arow(const Unit& u, int r) const { return u.pm * 256 + r; }
    __device__ __forceinline__ const bf16_t* bbase(const Unit& u) const { return Bt + (size_t)u.pn * 256 * 64; }
    __device__ __forceinline__ int brows() const { return nN * 256; }
};
struct MoeTab { const LAS int* tile_e; const LAS int* tile0; const LAS int* cnt; int ntiles; };
struct SchedMoe {
    const bf16_t* Wt; size_t estride; int tsh; MoeTab tb; const unsigned* list; bool gather; int vcu, G;
    __device__ __forceinline__ bool next(int i, Unit& u) const { const int L = i * G + vcu; if (L >= tb.ntiles * 4) return false; u.pm = L >> 2; u.pn = L & 3; u.e = tb.tile_e[u.pm]; return true; }
    __device__ __forceinline__ int arow(const Unit& u, int r) const {
        if (!gather) return (u.pm << tsh) + r;
        int idx = ((u.pm - tb.tile0[u.e]) << tsh) + r; const int c = tb.cnt[u.e]; idx = idx < c ? idx : c - 1;
        return (int)list[(size_t)u.e * TT + idx]; }
    __device__ __forceinline__ const bf16_t* bbase(const Unit& u) const { return Wt + (size_t)u.e * estride + (size_t)u.pn * 256 * 64; }
    __device__ __forceinline__ int brows() const { return 1024; }
};
__device__ __forceinline__ MoeTab moe_tables(const Frame& F, int l, int tsh) {
    LAS int* tile_e = (LAS int*)(F.lds + LDS_TAB); LAS int* tile0 = tile_e + NTILE_MAX; LAS int* cntl = tile0 + 33; LAS int* nt = cntl + 32;
    __syncthreads();
    if (F.tid == 0) { int t = 0; unsigned* cg = F.cnt(l);
        for (int e = 0; e < NE; ++e) { const int c = (int)__hip_atomic_load(cg + e * 64, __ATOMIC_RELAXED, __HIP_MEMORY_SCOPE_AGENT); const int n = (c + (1 << tsh) - 1) >> tsh; tile0[e] = t; cntl[e] = c;
            for (int j = 0; j < n; ++j) tile_e[t + j] = e; t += n; }
        tile0[32] = t; nt[0] = t; }
    __syncthreads();
    MoeTab tb; tb.tile_e = tile_e; tb.tile0 = tile0; tb.cnt = cntl; tb.ntiles = nt[0]; return tb;
}

namespace pg8 {
constexpr int BM = 256, BK = 64, HALF = 128, HTB = HALF * BK * 2;
__device__ __forceinline__ int lds_byte(int r, int c) { const int st = (r >> 4) * 2 + (c >> 5), rr = r & 15, cc = c & 31, ob = rr * 64 + cc * 2; return st * 1024 + (ob ^ (((ob >> 9) & 1) << 5)); }
__device__ __forceinline__ void stage_rc(int b, int& R, int& C) { const int st = b / 1024, sb = b % 1024, swz = sb ^ (((sb >> 9) & 1) << 5); R = (st >> 1) * 16 + swz / 64; C = (st & 1) * 32 + (swz % 64) / 2; }
__device__ __forceinline__ int perm32(int rho) { const int n = rho >> 4, i = rho & 15; return 8 * (i >> 2) + 4 * n + (i & 3); }
}
typedef int v8i_t __attribute__((ext_vector_type(8)));
typedef int v4i_t __attribute__((ext_vector_type(4)));
__device__ __forceinline__ v8i_t frag32(bf16x8 lo, bf16x8 hi) { return __builtin_shufflevector(__builtin_bit_cast(v4i_t, lo), __builtin_bit_cast(v4i_t, hi), 0, 1, 2, 3, 4, 5, 6, 7); }
template <bool ALIGN_EPI, bool FP8, bool HALFM, class Sched, class Epi>
__device__ __forceinline__ void gemm_fast(const Frame& F, const void* A, int KB, const Sched& S, const Epi& E) {
    using namespace pg8;
    LAS unsigned char* lds = F.lds;
    const int tid = F.tid, wid = F.wave, lane = F.lane, wr = wid >> 2, wc = wid & 3, fr = lane & 15, fq = lane >> 4;
    const int nt = KB / (BK * 2);
    unsigned voffB[2];
#pragma unroll
    for (int i = 0; i < 2; ++i) { int R, C; stage_rc(tid * 16 + i * 8192, R, C); const int Rb = (R & ~31) + perm32(R & 31); voffB[i] = (unsigned)(Rb * 64 + C) * 2u; }
    const size_t kstep = (size_t)(BK * 2);
    const size_t kstepB = (size_t)S.brows() * BK * 2;
    const size_t hstep = (size_t)HALF * BK * 2;
    const unsigned ldsw = (unsigned)wid * 1024u;
    const int aoff = lds_byte(wr * 64 + fr, fq * (FP8 ? 16 : 8)), boff = lds_byte(wc * 32 + fr, fq * (FP8 ? 16 : 8));
    const char* Ab = (const char*)A;
#define PG8_SA(b, h) (((b) * 2 + (h)) * HTB)
#define PG8_SB(b, h) ((4 + (b) * 2 + (h)) * HTB)
#define PG8_STAGE(bufoff, gbase, voff) do { _Pragma("unroll") for (int _i = 0; _i < 2; ++_i) \
        __builtin_amdgcn_global_load_lds((const unsigned*)((const char*)(gbase) + (voff)[_i]), (LAS unsigned*)(lds + (bufoff) + ldsw + _i * 8192), 16, 0, 0); } while (0)
#define PG8_LD32(p) __builtin_shufflevector(*(const LAS v4i_t*)(p), *(const LAS v4i_t*)((p) + 16), 0, 1, 2, 3, 4, 5, 6, 7)
#define PG8_LDA(dst, b, h) do { if constexpr (FP8) { _Pragma("unroll") for (int m = 0; m < 4; ++m) dst##8[m] = PG8_LD32(lds + PG8_SA(b, h) + aoff + m * 2048); } \
        else { _Pragma("unroll") for (int m = 0; m < 4; ++m) _Pragma("unroll") for (int k = 0; k < 2; ++k) dst[m][k] = *(const LAS bf16x8*)(lds + PG8_SA(b, h) + aoff + m * 2048 + k * 1024); } } while (0)
#define PG8_LDB(dst, b, h) do { if constexpr (FP8) { _Pragma("unroll") for (int n = 0; n < 2; ++n) dst##8[n] = PG8_LD32(lds + PG8_SB(b, h) + boff + n * 2048); } \
        else { _Pragma("unroll") for (int n = 0; n < 2; ++n) _Pragma("unroll") for (int k = 0; k < 2; ++k) dst[n][k] = *(const LAS bf16x8*)(lds + PG8_SB(b, h) + boff + n * 2048 + k * 1024); } } while (0)
#define PG8_MMA(ai, bj, At, Bt) do { __builtin_amdgcn_s_setprio(1); _Pragma("unroll") for (int m = 0; m < 4; ++m) _Pragma("unroll") for (int n = 0; n < 2; ++n) { \
        if constexpr (FP8) acc[ai][bj][m][n] = __builtin_amdgcn_mfma_scale_f32_16x16x128_f8f6f4(Bt##8[n], At##8[m], acc[ai][bj][m][n], 0, 0, 0, 0x7F7F7F7F, 0, 0x7F7F7F7F); \
        else { _Pragma("unroll") for (int k = 0; k < 2; ++k) acc[ai][bj][m][n] = __builtin_amdgcn_mfma_f32_16x16x32_bf16(Bt[n][k], At[m][k], acc[ai][bj][m][n], 0, 0, 0); } } __builtin_amdgcn_s_setprio(0); } while (0)
#define PG8_WAIT_V(n) asm volatile("s_waitcnt vmcnt(" #n ")" ::: "memory")
#define PG8_WAIT_L(n) asm volatile("s_waitcnt lgkmcnt(" #n ")" ::: "memory")
#define PG8_BAR __builtin_amdgcn_s_barrier()
#define PG8_SCHED __builtin_amdgcn_sched_barrier(0)
    LAS unsigned* rtab = (LAS unsigned*)(lds + RING_BYTES);
    unsigned tA[2], cA[2];
#pragma unroll
    for (int i = 0; i < 2; ++i) { int R, C; stage_rc(tid * 16 + i * 8192, R, C); tA[i] = (unsigned)R; cA[i] = (unsigned)(C * 2); }
#define PG8_RFILL(sel, u) do { if (tid < (HALFM ? 128 : 256)) rtab[(sel) * 256 + tid] = (unsigned)S.arow(u, tid) * (unsigned)KB; } while (0)
#define PG8_STAGEA(bufoff, gbase, sel, h) do { _Pragma("unroll") for (int _i = 0; _i < 2; ++_i) { const unsigned vo_ = rtab[(sel) * 256 + (h) * 128 + tA[_i]] + cA[_i]; \
        __builtin_amdgcn_global_load_lds((const unsigned*)((const char*)(gbase) + vo_), (LAS unsigned*)(lds + (bufoff) + ldsw + _i * 8192), 16, 0, 0); } } while (0)
    Unit cur, nxt; int ui = 0;
    if (!S.next(0, cur)) return;
    f32x4 acc[2][2][4][2];
    float zero_ = 0.f; asm volatile("" : "+v"(zero_));
#pragma unroll
    for (int a = 0; a < 2; ++a)
#pragma unroll
        for (int b = 0; b < 2; ++b)
#pragma unroll
            for (int m = 0; m < 4; ++m)
#pragma unroll
                for (int n = 0; n < 2; ++n) acc[a][b][m][n] = (f32x4){zero_, zero_, zero_, zero_};
    bf16x8 At[4][2], B0[2][2], B1[2][2]; v8i_t At8[4], B08[2], B18[2];
    int csel = 0;
    PG8_RFILL(0, cur);
    PG8_WAIT_L(0); PG8_BAR;
    const char* cB = (const char*)S.bbase(cur);
    PG8_STAGE(PG8_SB(0, 0), cB, voffB); PG8_STAGE(PG8_SB(0, 1), cB + hstep, voffB); PG8_STAGEA(PG8_SA(0, 0), Ab, 0, 0); if constexpr (!HALFM) PG8_STAGEA(PG8_SA(0, 1), Ab, 0, 1);
    if (wr == 1) PG8_BAR;
    if constexpr (HALFM) PG8_WAIT_V(0); else PG8_WAIT_V(2);
    PG8_BAR;
    PG8_STAGE(PG8_SB(1, 0), cB + kstepB, voffB); PG8_STAGEA(PG8_SA(1, 0), Ab + kstep, 0, 0); PG8_STAGE(PG8_SB(1, 1), cB + hstep + kstepB, voffB);
    PG8_WAIT_V(6); PG8_BAR;
    for (;;) {
        const bool has_next = S.next(ui + 1, nxt);
        const char* nB = cB;
        if (has_next) { PG8_RFILL(csel ^ 1, nxt); nB = (const char*)S.bbase(nxt); }
        const int nsel = has_next ? (csel ^ 1) : csel;
#pragma unroll 1
        for (int t = 0; t < nt; t += 2) {
            const bool last = (t == nt - 2);
            const char* a1 = Ab + (size_t)(t + 1) * kstep;
            const char* a2 = last ? Ab : Ab + (size_t)(t + 2) * kstep; const char* b2 = last ? nB : cB + (size_t)(t + 2) * kstepB;
            const char* a3 = a2 + kstep; const char* b3 = b2 + kstepB;
            const int sel2 = last ? nsel : csel;
            PG8_LDB(B0, 0, 0); PG8_LDB(B1, 0, 1); PG8_SCHED; PG8_LDA(At, 0, 0); if constexpr (!HALFM) PG8_STAGEA(PG8_SA(1, 1), a1, csel, 1);
            PG8_WAIT_V(8); PG8_WAIT_L(0); PG8_BAR; PG8_MMA(0, 0, At, B0); PG8_MMA(0, 1, At, B1); PG8_BAR; PG8_SCHED;
            if constexpr (!HALFM) PG8_LDA(At, 0, 1);
            PG8_STAGE(PG8_SB(0, 0), b2, voffB); PG8_STAGE(PG8_SB(0, 1), b2 + hstep, voffB); PG8_STAGEA(PG8_SA(0, 0), a2, sel2, 0);
            if constexpr (HALFM) PG8_WAIT_V(6); else PG8_WAIT_V(8);
            PG8_WAIT_L(0); PG8_BAR; if constexpr (!HALFM) { PG8_MMA(1, 0, At, B0); PG8_MMA(1, 1, At, B1); } PG8_BAR; PG8_SCHED;
            PG8_LDB(B0, 1, 0); PG8_LDB(B1, 1, 1); PG8_SCHED; PG8_LDA(At, 1, 0); if constexpr (!HALFM) PG8_STAGEA(PG8_SA(0, 1), a2, sel2, 1);
            PG8_WAIT_V(8); PG8_WAIT_L(0); PG8_BAR; PG8_MMA(0, 0, At, B0); PG8_MMA(0, 1, At, B1); PG8_BAR; PG8_SCHED;
            if constexpr (!HALFM) PG8_LDA(At, 1, 1);
            PG8_STAGE(PG8_SB(1, 0), b3, voffB); PG8_STAGE(PG8_SB(1, 1), b3 + hstep, voffB); PG8_STAGEA(PG8_SA(1, 0), a3, sel2, 0);
            if constexpr (HALFM) PG8_WAIT_V(6); else PG8_WAIT_V(8);
            PG8_WAIT_L(0); PG8_BAR; if constexpr (!HALFM) { PG8_MMA(1, 0, At, B0); PG8_MMA(1, 1, At, B1); } PG8_BAR; PG8_SCHED;
        }
        if (ALIGN_EPI) { if (wr == 0) PG8_BAR; }
        E(acc, cur, wr, wc, fr, fq);
        if (!has_next) break;
        asm volatile("" : "+v"(zero_));
#pragma unroll
        for (int a = 0; a < 2; ++a)
#pragma unroll
            for (int b = 0; b < 2; ++b)
#pragma unroll
                for (int m = 0; m < 4; ++m)
#pragma unroll
                    for (int n = 0; n < 2; ++n) acc[a][b][m][n] = (f32x4){zero_, zero_, zero_, zero_};
        cur = nxt; cB = nB; ++ui; csel = nsel;
        if (ALIGN_EPI) { if (wr == 1) PG8_BAR; }
    }
    PG8_WAIT_V(0);
    if (!ALIGN_EPI) { if (wr == 0) PG8_BAR; }
    PG8_BAR;
#undef PG8_RFILL
#undef PG8_STAGEA
#undef PG8_SA
#undef PG8_SB
#undef PG8_STAGE
#undef PG8_LD32
#undef PG8_LDA
#undef PG8_LDB
#undef PG8_MMA
#undef PG8_WAIT_V
#undef PG8_WAIT_L
#undef PG8_BAR
#undef PG8_SCHED
}
#ifndef ALIGN_G2
#define ALIGN_G2 false
#endif
#define GEMM gemm_fast<true, false, false>
#define GEMM2 gemm_fast<ALIGN_G2, false, false>

__device__ __forceinline__ u32x4 pack8(const f32x4& a, const f32x4& b) { u32x4 w; w.x = pk2(a[0], a[1]); w.y = pk2(a[2], a[3]); w.z = pk2(b[0], b[1]); w.w = pk2(b[2], b[3]); return w; }
template <bool GLU> struct EpiInProj {
    bf16_t* Q; bf16_t* KR; bf16_t* Vn; bf16_t* Gb;
    __device__ __forceinline__ void operator()(const f32x4 (&acc)[2][2][4][2], const Unit& u, int wr, int wc, int fr, int fq) const {
#pragma unroll
        for (int ai = 0; ai < 2; ++ai)
#pragma unroll
            for (int m = 0; m < 4; ++m) { const int irow = u.pm * 256 + 128 * ai + 64 * wr + 16 * m + fr; const size_t row = (size_t)irow; const int cl = 32 * wc + 8 * fq;
                if (u.pn < 2) { *(u32x4*)(Q + row * 512 + u.pn * 256 + cl) = pack8(acc[ai][0][m][0], acc[ai][0][m][1]); *(u32x4*)(Q + row * 512 + u.pn * 256 + 128 + cl) = pack8(acc[ai][1][m][0], acc[ai][1][m][1]); }
                else if (u.pn == 2) { const size_t kvrow = irow < TX ? (size_t)(irow >> 12) * KVS + CTXL + (irow & 4095) : (size_t)((irow - TX) >> 8) * KVS + ((irow - TX) & 255);
                    *(u32x4*)(KR + kvrow * 128 + cl) = pack8(acc[ai][0][m][0], acc[ai][0][m][1]); *(u32x4*)(Vn + kvrow * 128 + cl) = pack8(acc[ai][1][m][0], acc[ai][1][m][1]); }
                else if (GLU) { f32x4 g0, g1;
#pragma unroll
                    for (int j = 0; j < 4; ++j) { g0[j] = acc[ai][0][m][0][j] * sigmoidf_(acc[ai][1][m][0][j]); g1[j] = acc[ai][0][m][1][j] * sigmoidf_(acc[ai][1][m][1][j]); }
                    *(u32x4*)(Gb + row * 512 + (u.pn - 3) * 128 + cl) = pack8(g0, g1); }
                else { *(u32x4*)(Gb + row * 512 + (u.pn - 3) * 256 + cl) = pack8(acc[ai][0][m][0], acc[ai][0][m][1]); *(u32x4*)(Gb + row * 512 + (u.pn - 3) * 256 + 128 + cl) = pack8(acc[ai][1][m][0], acc[ai][1][m][1]); }
            }
    }
};
template <bool L0, bool DRY = false> struct EpiOutProj {
    Frame F; int l;
    __device__ __forceinline__ void operator()(const f32x4 (&acc)[2][2][4][2], const Unit& u, int wr, int wc, int fr, int fq) const {
        float* SS = (float*)(F.ws + WS_SS);
        const float* g1 = F.mod(l, modrow(u.pm * 256), 2) + u.pn * 256 + 32 * wc + 8 * fq;
        f32x4 gv[2][2];
#pragma unroll
        for (int bj = 0; bj < 2; ++bj)
#pragma unroll
            for (int n = 0; n < 2; ++n) gv[bj][n] = *(const f32x4*)(g1 + 128 * bj + 4 * n);
#pragma unroll
        for (int ai = 0; ai < 2; ++ai) {
            f32x4 xv[4][2][2];
#pragma unroll
            for (int m = 0; m < 4; ++m) { const int row = u.pm * 256 + 128 * ai + 64 * wr + 16 * m + fr; const int c0 = u.pn * 256 + 32 * wc + 8 * fq;
#pragma unroll
                for (int bj = 0; bj < 2; ++bj) {
                    if (L0) { const float* src = F.xin_row(row) + c0 + 128 * bj; xv[m][bj][0] = *(const f32x4*)(src); xv[m][bj][1] = *(const f32x4*)(src + 4); }
                    else { const u32x4 w = *(const u32x4*)(F.xr_row(row) + c0 + 128 * bj); xv[m][bj][0] = (f32x4){bflo(w.x), bfhi(w.x), bflo(w.y), bfhi(w.y)}; xv[m][bj][1] = (f32x4){bflo(w.z), bfhi(w.z), bflo(w.w), bfhi(w.w)}; } } }
#pragma unroll
            for (int m = 0; m < 4; ++m) { const int row = u.pm * 256 + 128 * ai + 64 * wr + 16 * m + fr; bf16_t* dst = F.xr_row(row) + u.pn * 256 + 32 * wc + 8 * fq; float q = 0.f;
#pragma unroll
                for (int bj = 0; bj < 2; ++bj) { const f32x4 v0 = xv[m][bj][0] + gv[bj][0] * acc[ai][bj][m][0], v1 = xv[m][bj][1] + gv[bj][1] * acc[ai][bj][m][1];
                    *(u32x4*)(dst + 128 * bj) = DRY ? pack8(xv[m][bj][0], xv[m][bj][1]) : pack8(v0, v1);
                    q += ((v0[0] * v0[0] + v0[1] * v0[1]) + (v0[2] * v0[2] + v0[3] * v0[3])) + ((v1[0] * v1[0] + v1[1] * v1[1]) + (v1[2] * v1[2] + v1[3] * v1[3])); }
                q += __shfl_xor(q, 16); q += __shfl_xor(q, 32);
                if (fq == 0) SS[(size_t)row * 16 + u.pn * 4 + wc] = q; }
        }
    }
};
template <bool IN8, bool OUT8, bool HALFM> struct EpiMoe1 {
    void* HID;
    __device__ __forceinline__ void operator()(const f32x4 (&acc)[2][2][4][2], const Unit& u, int wr, int wc, int fr, int fq) const {
        const float sc = IN8 ? W8_INV : 1.f;
#pragma unroll
        for (int ai = 0; ai < (HALFM ? 1 : 2); ++ai)
#pragma unroll
            for (int m = 0; m < 4; ++m) { const size_t slot = (size_t)u.pm * (HALFM ? 128 : 256) + 128 * ai + 64 * wr + 16 * m + fr; f32x4 h0, h1;
#pragma unroll
                for (int j = 0; j < 4; ++j) { const float a = acc[ai][0][m][0][j] * sc, b = acc[ai][0][m][1][j] * sc; h0[j] = a * sigmoidf_(a) * (acc[ai][1][m][0][j] * sc); h1[j] = b * sigmoidf_(b) * (acc[ai][1][m][1][j] * sc); }
                if (OUT8) { u32x2 o; o.x = pk4_fp8(h0[0], h0[1], h0[2], h0[3]); o.y = pk4_fp8(h1[0], h1[1], h1[2], h1[3]); *(u32x2*)((unsigned char*)HID + slot * 512 + u.pn * 128 + 32 * wc + 8 * fq) = o; }
                else *(u32x4*)((bf16_t*)HID + slot * 512 + u.pn * 128 + 32 * wc + 8 * fq) = pack8(h0, h1); }
    }
};
template <bool FP8, bool HALFM> struct EpiMoe2 {
    bf16_t* YB;
    __device__ __forceinline__ void operator()(const f32x4 (&acc)[2][2][4][2], const Unit& u, int wr, int wc, int fr, int fq) const {
        const float sc = FP8 ? W8_INV : 1.f;
#pragma unroll
        for (int ai = 0; ai < (HALFM ? 1 : 2); ++ai)
#pragma unroll
            for (int m = 0; m < 4; ++m) { const size_t slot = (size_t)u.pm * (HALFM ? 128 : 256) + 128 * ai + 64 * wr + 16 * m + fr;
#pragma unroll
                for (int bj = 0; bj < 2; ++bj) *(u32x4*)(YB + slot * 1024 + u.pn * 256 + 128 * bj + 32 * wc + 8 * fq) = pack8(acc[ai][bj][m][0] * sc, acc[ai][bj][m][1] * sc); }
    }
};

__device__ __forceinline__ void p_k_post(const Frame& F, const float* kg) {
    const int gw = F.vcu * NWAVES + F.wave, NGW = F.G * NWAVES, lane = F.lane;
    const bf16_t* KR = (const bf16_t*)(F.ws + WS_KV); bf16_t* Kn = (bf16_t*)(F.ws + WS_KN);
    const float* rc = (const float*)(F.ws + WS_ROPE); const float* rs = rc + SEQ * 32;
    const int c16 = lane & 15, i8 = c16 & 7, dd0 = 8 * (i8 & 3), sub = lane >> 4;
    float gk[8];
#pragma unroll
    for (int j = 0; j < 8; ++j) gk[j] = kg[i8 * 8 + j];
    const float sgn = (i8 < 4) ? -1.f : 1.f;
    for (int it = gw; it < NB * KVS / 16; it += NGW) {
        u32x4 w[4];
#pragma unroll
        for (int q = 0; q < 4; ++q) w[q] = *(const u32x4*)(KR + (size_t)(it * 16 + 4 * q + sub) * 128 + c16 * 8);
#pragma unroll
        for (int q = 0; q < 4; ++q) { const int kvrow = it * 16 + 4 * q + sub, pos = kvrow % KVS;
            float cs[8], sn[8];
#pragma unroll
            for (int j = 0; j < 8; ++j) { cs[j] = 1.f; sn[j] = 0.f; }
            if (pos >= CTXL) { const int sq = pos - CTXL; const f32x4 c0 = *(const f32x4*)(rc + sq * 32 + dd0), c1 = *(const f32x4*)(rc + sq * 32 + dd0 + 4), s0 = *(const f32x4*)(rs + sq * 32 + dd0), s1 = *(const f32x4*)(rs + sq * 32 + dd0 + 4);
#pragma unroll
                for (int j = 0; j < 4; ++j) { cs[j] = c0[j]; cs[4 + j] = c1[j]; sn[j] = s0[j]; sn[4 + j] = s1[j]; } }
            float x[8] = {bflo(w[q].x), bfhi(w[q].x), bflo(w[q].y), bfhi(w[q].y), bflo(w[q].z), bfhi(w[q].z), bflo(w[q].w), bfhi(w[q].w)};
            float ss = 0.f;
#pragma unroll
            for (int j = 0; j < 8; ++j) ss += x[j] * x[j];
            ss += __shfl_xor(ss, 1); ss += __shfl_xor(ss, 2); ss += __shfl_xor(ss, 4);
            const float rms = 1.0f / sqrtf(ss * (1.f / 64.f) + EPS);
            float y[8], o[8];
#pragma unroll
            for (int j = 0; j < 8; ++j) y[j] = x[j] * rms * gk[j];
#pragma unroll
            for (int j = 0; j < 8; ++j) { const float yp = __shfl_xor(y[j], 4); o[j] = y[j] * cs[j] + sgn * yp * sn[j]; }
            u32x4 ow; ow.x = pk2(o[0], o[1]); ow.y = pk2(o[2], o[3]); ow.z = pk2(o[4], o[5]); ow.w = pk2(o[6], o[7]);
            *(u32x4*)(Kn + (size_t)kvrow * 128 + c16 * 8) = ow; }
    }
}
__device__ __forceinline__ void p_conv(const Frame& F) {
    const bf16_t* Gb = (const bf16_t*)(F.ws + WS_G); bf16_t* AO = (bf16_t*)(F.ws + WS_AO);
    LAS bf16_t* gl = (LAS bf16_t*)F.lds;
    LAS float* yl = (LAS float*)(F.lds + 65536);
    const int c = F.tid;
    float w[31];
#pragma unroll
    for (int j = 0; j < 31; ++j) w[j] = F.in[I_CONVW][j * 512 + c];
    const float bias = F.in[I_CONVB][c];
    u32x4 pre[8];
#define CONV_ITEM(item, rowbase, t0, len) do { if ((item) < 1024) { rowbase = ((item) >> 7) * SEQ; t0 = ((item) & 127) * 32; len = SEQ; } else { const int it_ = (item) - 1024; rowbase = TX + (it_ >> 3) * CTXL; t0 = (it_ & 7) * 32; len = CTXL; } } while (0)
#define CONV_LOAD(item) do { int rb_, t0_, len_; CONV_ITEM(item, rb_, t0_, len_); _Pragma("unroll") for (int q = 0; q < 8; ++q) { const int ch = F.tid + q * NTHREADS, r = ch >> 6, p = t0_ - 15 + r; pre[q] = (u32x4){0u, 0u, 0u, 0u}; \
        if (ch < 62 * 64 && p >= 0 && p < len_) pre[q] = *(const u32x4*)(Gb + (size_t)(rb_ + p) * 512 + (ch & 63) * 8); } } while (0)
    if (F.vcu < 1024 + 64) CONV_LOAD(F.vcu);
    for (int item = F.vcu; item < 1024 + 64; item += F.G) {
        int rowbase, t0, len; CONV_ITEM(item, rowbase, t0, len);
        __syncthreads();
#pragma unroll
        for (int q = 0; q < 8; ++q) { const int ch = F.tid + q * NTHREADS; if (ch < 62 * 64) *(LAS u32x4*)(gl + (ch >> 6) * 512 + (ch & 63) * 8) = pre[q]; }
        __syncthreads();
        if (item + F.G < 1024 + 64) CONV_LOAD(item + F.G);
        float g[62];
#pragma unroll
        for (int r = 0; r < 62; ++r) g[r] = bf2f(gl[r * 512 + c]);
#pragma unroll
        for (int t = 0; t < 32; ++t) { float y = bias;
#pragma unroll
            for (int j = 0; j < 31; ++j) y += g[t + j] * w[j];
            yl[t * 512 + c] = y; }
        __syncthreads();
#pragma unroll
        for (int tt = 0; tt < 4; ++tt) { const int t = 4 * F.wave + tt; float v[8]; float sm = 0.f;
#pragma unroll
            for (int j = 0; j < 8; ++j) { v[j] = yl[t * 512 + F.lane + 64 * j]; sm += v[j]; }
            const float mean = wave_sum(sm) * (1.f / 512.f); float q = 0.f;
#pragma unroll
            for (int j = 0; j < 8; ++j) { v[j] -= mean; q += v[j] * v[j]; }
            const float rstd = 1.0f / sqrtf(wave_sum(q) * (1.f / 512.f) + EPS);
            bf16_t* orow = AO + (size_t)(rowbase + t0 + t) * 1024 + 512;
#pragma unroll
            for (int j = 0; j < 8; ++j) { const int cc = F.lane + 64 * j; const float yn = v[j] * rstd * F.in[I_CLNG][cc] + F.in[I_CLNB][cc]; orow[cc] = (bf16_t)(pk2(yn * sigmoidf_(yn), 0.f) & 0xffffu); } }
    }
#undef CONV_ITEM
#undef CONV_LOAD
    __syncthreads();
}
__device__ __forceinline__ void p_pool(const Frame& F) {
    const int gw = F.vcu * NWAVES + F.wave, NGW = F.G * NWAVES, lane = F.lane;
    const bf16_t* U = (const bf16_t*)(F.ws + WS_G); bf16_t* AO = (bf16_t*)(F.ws + WS_AO);
    const int hw = 1 << (lane >> 4);
    float wgt[16];
#pragma unroll
    for (int i = 0; i < 16; ++i) wgt[i] = (i >= 8 - hw && i < 8 + hw) ? 1.f : 0.f;
    for (int it = gw; it < TX / 8; it += NGW) {
        const int row0 = it * 8, t0 = row0 & 4095, rb = row0 - t0;
        u32x4 r[23];
#pragma unroll
        for (int j = 0; j < 23; ++j) { const int p = t0 - 8 + j; r[j] = (u32x4){0u, 0u, 0u, 0u}; if (p >= 0 && p < SEQ) r[j] = *(const u32x4*)(U + (size_t)(rb + p) * 512 + lane * 8); }
#pragma unroll
        for (int t = 0; t < 8; ++t) {
            float s[8];
#pragma unroll
            for (int j = 0; j < 8; ++j) s[j] = 0.f;
#pragma unroll
            for (int i = 0; i < 16; ++i) { const u32x4 w = r[t + i]; const float g = wgt[i];
                s[0] += g * bflo(w.x); s[1] += g * bfhi(w.x); s[2] += g * bflo(w.y); s[3] += g * bfhi(w.y); s[4] += g * bflo(w.z); s[5] += g * bfhi(w.z); s[6] += g * bflo(w.w); s[7] += g * bfhi(w.w); }
            const int tt = t0 + t; int lo = tt - hw, hi = tt + hw; lo = lo < 0 ? 0 : lo; hi = hi > SEQ ? SEQ : hi;
            const float inv = 1.f / (float)(hi - lo); const u32x4 w = r[t + 8];
            u32x4 ow; ow.x = pk2(s[0] * inv - bflo(w.x), s[1] * inv - bfhi(w.x)); ow.y = pk2(s[2] * inv - bflo(w.y), s[3] * inv - bfhi(w.y)); ow.z = pk2(s[4] * inv - bflo(w.z), s[5] * inv - bfhi(w.z)); ow.w = pk2(s[6] * inv - bflo(w.w), s[7] * inv - bfhi(w.w));
            *(u32x4*)(AO + (size_t)(row0 + t) * 1024 + 512 + lane * 8) = ow;
        }
    }
}

template <int LAYER> __device__ __forceinline__ void attn_simple(const Frame& F) {
    const bf16_t* Q = (const bf16_t*)(F.ws + WS_Q); const bf16_t* Kn = (const bf16_t*)(F.ws + WS_KN); const bf16_t* Vn = (const bf16_t*)(F.ws + WS_VN); bf16_t* AO = (bf16_t*)(F.ws + WS_AO);
    const int nunits = LAYER == 0 ? 512 + 64 : 512;
    for (int u = F.vcu; u < nunits; u += F.G) {
        int b, h, row, s; bool valid = true, isctx = false;
        if (u < 512) { b = u >> 6; h = (u >> 3) & 7; s = (u & 7) * 512 + F.tid; row = b * SEQ + s; }
        else { const int uc = u - 512; b = uc >> 3; h = uc & 7; s = F.tid; valid = F.tid < 256; row = TX + b * CTXL + (valid ? s : 0); isctx = true; }
        float q[64], o[64];
        { const u32x4* qp = (const u32x4*)(Q + (size_t)row * 512 + h * 64);
#pragma unroll
          for (int c = 0; c < 8; ++c) { const u32x4 w = qp[c]; q[8 * c] = bflo(w.x); q[8 * c + 1] = bfhi(w.x); q[8 * c + 2] = bflo(w.y); q[8 * c + 3] = bfhi(w.y); q[8 * c + 4] = bflo(w.z); q[8 * c + 5] = bfhi(w.z); q[8 * c + 6] = bflo(w.w); q[8 * c + 7] = bfhi(w.w); } }
#pragma unroll
        for (int d = 0; d < 64; ++d) o[d] = 0.f;
        float mx = -1e30f, l = 0.f;
        const bf16_t* Kb = Kn + (size_t)b * KVS * 128 + (h >> 2) * 64; const bf16_t* Vb = Vn + (size_t)b * KVS * 128 + (h >> 2) * 64;
        int k_lo2 = 0, k_hi2 = 0;
        const int k_hi1 = CTXL;
        if (LAYER == 0) { if (!isctx) { k_lo2 = CTXL; k_hi2 = KVS; } }
        else { const int s0 = (u & 7) * 512; int lo = s0 - 128, hi = s0 + 511 + 128 + 1; lo = lo < 0 ? 0 : lo; hi = hi > SEQ ? SEQ : hi; k_lo2 = CTXL + lo; k_hi2 = CTXL + hi; }
        for (int part = 0; part < 2; ++part) {
            const int kb = part == 0 ? 0 : k_lo2, ke = part == 0 ? k_hi1 : k_hi2;
            for (int key = kb; key < ke; ++key) {
                const u32x4* kp = (const u32x4*)(Kb + (size_t)key * 128); float sd = 0.f;
#pragma unroll
                for (int c = 0; c < 8; ++c) { const u32x4 w = kp[c];
                    sd += q[8 * c] * bflo(w.x) + q[8 * c + 1] * bfhi(w.x) + q[8 * c + 2] * bflo(w.y) + q[8 * c + 3] * bfhi(w.y) + q[8 * c + 4] * bflo(w.z) + q[8 * c + 5] * bfhi(w.z) + q[8 * c + 6] * bflo(w.w) + q[8 * c + 7] * bfhi(w.w); }
                bool use = valid;
                if (LAYER == 1 && part == 1) { const int j = key - CTXL; const int dlt = s - j; use = use && (dlt <= 128 && dlt >= -128); }
                const float mn = fmaxf(mx, sd); const float mnew = use ? mn : mx;
                const float alpha = exp2f(mx - mnew), p = use ? exp2f(sd - mnew) : 0.f;
                mx = mnew; l = l * alpha + p;
                const u32x4* vp = (const u32x4*)(Vb + (size_t)key * 128);
#pragma unroll
                for (int c = 0; c < 8; ++c) { const u32x4 w = vp[c];
                    o[8 * c] = o[8 * c] * alpha + p * bflo(w.x); o[8 * c + 1] = o[8 * c + 1] * alpha + p * bfhi(w.x); o[8 * c + 2] = o[8 * c + 2] * alpha + p * bflo(w.y); o[8 * c + 3] = o[8 * c + 3] * alpha + p * bfhi(w.y);
                    o[8 * c + 4] = o[8 * c + 4] * alpha + p * bflo(w.z); o[8 * c + 5] = o[8 * c + 5] * alpha + p * bfhi(w.z); o[8 * c + 6] = o[8 * c + 6] * alpha + p * bflo(w.w); o[8 * c + 7] = o[8 * c + 7] * alpha + p * bfhi(w.w); }
            }
        }
        if (LAYER == 1) l += exp2f(F.in[I_SINK][h] * LOG2E - mx);
        const float il = 1.f / l;
        if (valid) { u32x4* op = (u32x4*)(AO + (size_t)row * 1024 + h * 64);
#pragma unroll
            for (int c = 0; c < 8; ++c) { u32x4 w; w.x = pk2(o[8 * c] * il, o[8 * c + 1] * il); w.y = pk2(o[8 * c + 2] * il, o[8 * c + 3] * il); w.z = pk2(o[8 * c + 4] * il, o[8 * c + 5] * il); w.w = pk2(o[8 * c + 6] * il, o[8 * c + 7] * il); op[c] = w; } }
    }
}

#include <hip/hip_bf16.h>
namespace attn_body {
using bf16=__hip_bfloat16;
using s16x4=__attribute__((ext_vector_type(4)))short;
using f32x16=__attribute__((ext_vector_type(16)))float;
constexpr int NW=8,QBLK=32,QB=QBLK*NW,KVBLK=64;
constexpr int QP=512,KP=128,OP=1024;
__device__ __forceinline__ int crow(int r,int hi){return (r&3)+8*(r>>2)+4*hi;}
#define SBAR() __builtin_amdgcn_sched_barrier(0)
__device__ __forceinline__ void wmask(f32x16&p0,f32x16&p1,int dlt0,int hi){
  const float NEG=-INFINITY; const int kb=dlt0+4*hi;
  #pragma unroll
  for(int r=0;r<16;++r){const int d=kb+(r&3)+8*(r>>2); if(d>128||d<-128)p0[r]=NEG; if(d+32>128||d+32<-128)p1[r]=NEG;}
}

constexpr int NSLOT=3, SLOTB=8192;
constexpr int LDS_K=0, LDS_V=NSLOT*SLOTB, LDS_WS=2*NSLOT*SLOTB, LDS_OST=LDS_WS+NW*64*4, LDS_BYTES=LDS_OST+NW*4096;
__device__ __forceinline__ void glds16(const void*gsrc,unsigned lds_dst){unsigned keep;
  asm volatile("s_mov_b32 %0, m0\n\ts_mov_b32 m0, %2\n\ts_nop 0\n\tglobal_load_lds_dwordx4 %1, off\n\ts_mov_b32 m0, %0":"=&s"(keep):"v"(gsrc),"s"(lds_dst):"memory");}
__device__ __forceinline__ float max3f(float a,float b,float c){float r;asm("v_max3_f32 %0, %1, %2, %3":"=v"(r):"v"(a),"v"(b),"v"(c));return r;}
__device__ __forceinline__ float max2f(float a,float b){float r;asm("v_max_f32_e32 %0, %1, %2":"=v"(r):"v"(a),"v"(b));return r;}
__device__ __forceinline__ float fadd_s(float a,float b){float r;asm("v_add_f32_e32 %0, %1, %2":"=v"(r):"v"(a),"v"(b));return r;}
__device__ __forceinline__ float fsub_s(float a,float b){float r;asm("v_sub_f32_e32 %0, %1, %2":"=v"(r):"v"(a),"v"(b));return r;}
typedef float f32x2_t __attribute__((ext_vector_type(2))); typedef __bf16 bf16x2_t __attribute__((ext_vector_type(2)));
__device__ __forceinline__ unsigned cvtpk_s(float lo,float hi){f32x2_t v={lo,hi};bf16x2_t b=__builtin_convertvector(v,bf16x2_t);return __builtin_bit_cast(unsigned,b);}
#define WAIT_BAR(N) asm volatile("s_waitcnt vmcnt(" #N ") lgkmcnt(0)\n\ts_barrier":::"memory")

__device__ __forceinline__ void qkt(f32x16&p0,f32x16&p1,const char*Kslot,const bf16x8*qr,const f32x16&negm,int r32,int hi){
  const char*kb=Kslot+hi*1024+r32*16;
  #pragma unroll
  for(int d0=0;d0<4;++d0){
    const bf16x8 b0=*reinterpret_cast<const bf16x8*>(kb+d0*2048);
    const bf16x8 b1=*reinterpret_cast<const bf16x8*>(kb+d0*2048+512);
    if(d0==0){p0=__builtin_amdgcn_mfma_f32_32x32x16_bf16(b0,qr[0],negm,0,0,0);p1=__builtin_amdgcn_mfma_f32_32x32x16_bf16(b1,qr[0],negm,0,0,0);}
    else{p0=__builtin_amdgcn_mfma_f32_32x32x16_bf16(b0,qr[d0],p0,0,0,0);p1=__builtin_amdgcn_mfma_f32_32x32x16_bf16(b1,qr[d0],p1,0,0,0);}}
}
typedef __attribute__((address_space(3))) const char* lds_cptr;
typedef short v4i16_t __attribute__((ext_vector_type(4)));
__device__ __forceinline__ void kload8(bf16x8*kf,lds_cptr kp){
  kf[0]=*(const __attribute__((address_space(3))) bf16x8*)(kp);      kf[1]=*(const __attribute__((address_space(3))) bf16x8*)(kp+512);
  kf[2]=*(const __attribute__((address_space(3))) bf16x8*)(kp+2048); kf[3]=*(const __attribute__((address_space(3))) bf16x8*)(kp+2560);
  kf[4]=*(const __attribute__((address_space(3))) bf16x8*)(kp+4096); kf[5]=*(const __attribute__((address_space(3))) bf16x8*)(kp+4608);
  kf[6]=*(const __attribute__((address_space(3))) bf16x8*)(kp+6144); kf[7]=*(const __attribute__((address_space(3))) bf16x8*)(kp+6656);
}
__device__ __forceinline__ void kload2(bf16x8*kf,lds_cptr kp,int j){ kf[2*j]=*(const __attribute__((address_space(3))) bf16x8*)(kp+j*2048); kf[2*j+1]=*(const __attribute__((address_space(3))) bf16x8*)(kp+j*2048+512); }
__device__ __forceinline__ s16x4 vtr(lds_cptr p){ return __builtin_bit_cast(s16x4,__builtin_amdgcn_ds_read_tr16_b64_v4i16((__attribute__((address_space(3))) v4i16_t*)p)); }
__device__ __forceinline__ float rowmax(const f32x16&p0,const f32x16&p1){
  float a=max3f(p0[0],p0[1],p1[0]),b=max3f(p0[2],p0[3],p1[1]);a=max3f(a,p1[2],p1[3]);
  #pragma unroll
  for(int r=4;r<16;r+=4){a=max3f(a,p0[r],p0[r+1]);b=max3f(b,p0[r+2],p0[r+3]);a=max3f(a,p1[r],p1[r+1]);b=max3f(b,p1[r+2],p1[r+3]);}
  const float m=max2f(a,b);
  auto rr=__builtin_amdgcn_permlane32_swap(__float_as_uint(m),__float_as_uint(m),false,false);
  return max2f(__uint_as_float(rr[0]),__uint_as_float(rr[1]));
}
__device__ __forceinline__ void pv(f32x16*o,int vb,bf16x8 pa0,bf16x8 pa1,bf16x8 pa2,bf16x8 pa3){
  #pragma unroll
  for(int d0=0;d0<2;++d0){s16x4 lo[4],hi[4];
    #pragma unroll
    for(int ks=0;ks<4;++ks){
      asm volatile("ds_read_b64_tr_b16 %0,%1 offset:%c2":"=&v"(lo[ks]):"v"(vb),"i"(d0*4096+ks*1024):"memory");
      asm volatile("ds_read_b64_tr_b16 %0,%1 offset:%c2":"=&v"(hi[ks]):"v"(vb),"i"(d0*4096+ks*1024+512):"memory");}
    asm volatile("s_waitcnt lgkmcnt(0)":::"memory");SBAR();
    #define PK(k) (bf16x8){lo[k][0],lo[k][1],lo[k][2],lo[k][3],hi[k][0],hi[k][1],hi[k][2],hi[k][3]}
    o[d0]=__builtin_amdgcn_mfma_f32_32x32x16_bf16(pa0,PK(0),o[d0],0,0,0);
    o[d0]=__builtin_amdgcn_mfma_f32_32x32x16_bf16(pa1,PK(1),o[d0],0,0,0);
    o[d0]=__builtin_amdgcn_mfma_f32_32x32x16_bf16(pa2,PK(2),o[d0],0,0,0);
    o[d0]=__builtin_amdgcn_mfma_f32_32x32x16_bf16(pa3,PK(3),o[d0],0,0,0);
    #undef PK
  }
}

#ifndef ATTN_STORE16
#define ATTN_STORE16(p,v) (*(u32x4*)(p)=(v))
#endif
template<int MODE,int THRL> __device__ __forceinline__ void attn_unit(const bf16*Qu,const bf16*__restrict__ Kh,const bf16*__restrict__ Vh,bf16*Ou,const int NT,const int lat0,const int q0s,const float sinkl2,const float*qg,const float*ropec,const bool rope,char*shm){
  int tid_=threadIdx.x; asm volatile("":"+v"(tid_));
  const int tid=tid_,lane=tid&63,r32=lane&31,hi=lane>>5; const int wid=__builtin_amdgcn_readfirstlane(tid>>6);
  const bf16*Qw=Qu+(long)(wid*QBLK)*QP;
  const unsigned lds0=(unsigned)(uintptr_t)shm;
  float*wsf=(float*)(shm+LDS_WS)+wid*64;
  const bf16*ksrc=Kh+(long)lane*KP+wid*8;
  const bf16*vsrc=Vh+(long)(16*(wid&3)+(lane>>2))*KP+(wid>>2)*32+(lane&3)*8;
  const unsigned kdst=lds0+LDS_K+wid*1024, vdst=lds0+LDS_V+wid*1024;
  #define TROW(t) ((MODE==0||(t)<4)?(t)*KVBLK:lat0+((t)-4)*KVBLK)
  #define DMA_K(t,slot) glds16(ksrc+(long)TROW(t)*KP,(unsigned)__builtin_amdgcn_readfirstlane(kdst+(slot)))
  #define DMA_V(t,slot) glds16(vsrc+(long)TROW(t)*KP,(unsigned)__builtin_amdgcn_readfirstlane(vdst+(slot)))
  const int vb0=(int)(lds0+LDS_V)+((lane>>4)&1)*32+(lane&3)*8+(4*hi+((lane&15)>>2))*64;
  const char*Kbase=shm+LDS_K; bf16x8 kf[8];
  const lds_cptr shm3=(lds_cptr)shm; const lds_cptr kp0=shm3+LDS_K+hi*1024+r32*16; const lds_cptr vp0=shm3+LDS_V+((lane>>4)&1)*32+(lane&3)*8+(4*hi+((lane&15)>>2))*64;
  DMA_K(0,0);DMA_V(0,0);DMA_K(1,SLOTB);
  bf16x8 qr[4];
  const int qpos=q0s+wid*QBLK+r32;
  {
    u32x4 qraw[4];
    #pragma unroll
    for(int d0=0;d0<4;++d0) qraw[d0]=*reinterpret_cast<const u32x4*>(&Qw[(long)r32*QP+d0*16+hi*8]);
    float x[4][8]; float ss=0.f;
    #pragma unroll
    for(int d0=0;d0<4;++d0){ x[d0][0]=bflo(qraw[d0].x);x[d0][1]=bfhi(qraw[d0].x);x[d0][2]=bflo(qraw[d0].y);x[d0][3]=bfhi(qraw[d0].y);x[d0][4]=bflo(qraw[d0].z);x[d0][5]=bfhi(qraw[d0].z);x[d0][6]=bflo(qraw[d0].w);x[d0][7]=bfhi(qraw[d0].w);
      #pragma unroll
      for(int j=0;j<8;++j)ss+=x[d0][j]*x[d0][j]; }
    {auto rr=__builtin_amdgcn_permlane32_swap(__float_as_uint(ss),__float_as_uint(ss),false,false);ss=__uint_as_float(rr[0])+__uint_as_float(rr[1]);}
    const float rms=C2/sqrtf(ss*(1.f/64.f)+EPS);
    SBAR();
    #pragma unroll
    for(int d0=0;d0<2;++d0){
      #pragma unroll
      for(int hf=0;hf<2;++hf){
        const f32x4 ga=*reinterpret_cast<const f32x4*>(qg+d0*16+hi*8+4*hf), gb=*reinterpret_cast<const f32x4*>(qg+(d0+2)*16+hi*8+4*hf);
        f32x4 cc=f32x4{1.f,1.f,1.f,1.f}, sn=f32x4{0.f,0.f,0.f,0.f};
        if(rope){ const float*pc=ropec+(long)qpos*32+d0*16+hi*8+4*hf; cc=*reinterpret_cast<const f32x4*>(pc); sn=*reinterpret_cast<const f32x4*>(pc+SEQ*32); }
        #pragma unroll
        for(int j=0;j<4;++j){ const float a=x[d0][4*hf+j]*rms*ga[j], b=x[d0+2][4*hf+j]*rms*gb[j]; x[d0][4*hf+j]=a*cc[j]-b*sn[j]; x[d0+2][4*hf+j]=b*cc[j]+a*sn[j]; }
        SBAR(); } }
    #pragma unroll
    for(int d0=0;d0<4;++d0){ u32x4 w; w.x=cvtpk_s(x[d0][0],x[d0][1]);w.y=cvtpk_s(x[d0][2],x[d0][3]);w.z=cvtpk_s(x[d0][4],x[d0][5]);w.w=cvtpk_s(x[d0][6],x[d0][7]); qr[d0]=__builtin_bit_cast(bf16x8,w); } }
  float mhat=0.f,l_reg=0.f;f32x16 o[2],negm; { float z_=0.f; asm volatile("":"+v"(z_));
    #pragma unroll
    for(int r=0;r<16;++r){o[0][r]=z_;o[1][r]=z_;negm[r]=z_;} } asm volatile("":"+v"(negm));
  #define CMASK(P0,P1,t) do{ if(MODE==1&&(t)>=4) wmask(P0,P1,(lat0-256)+((t)-4)*KVBLK-qpos,hi); }while(0)
  bool resc=false;
  #define START(P0,P1) do{ const float rm=rowmax(P0,P1); resc=false; \
    { const float dl=rm; mhat=fadd_s(mhat,dl); \
      _Pragma("unroll") for(int r=0;r<16;++r){P0[r]=fsub_s(P0[r],dl);P1[r]=fsub_s(P1[r],dl);} \
      _Pragma("unroll") for(int r=0;r<16;++r)negm[r]=-mhat; asm volatile("":"+v"(negm)); } \
    _Pragma("unroll") for(int r=0;r<16;++r)P0[r]=__builtin_amdgcn_exp2f(P0[r]); }while(0)
  #define RESC() do{ if(resc){ asm volatile("s_waitcnt lgkmcnt(0)":::"memory"); \
      _Pragma("unroll") for(int d_=0;d_<2;++d_) _Pragma("unroll") for(int r=0;r<16;++r)o[d_][r]*=wsf[crow(r,hi)]; } }while(0)
  f32x16 pA0,pA1,pB0,pB1;
  int sl_prev=0,sl_cur=0,sl_next=SLOTB;
  #define ROT() do{sl_prev=sl_cur;sl_cur=sl_next;sl_next=(sl_next==(NSLOT-1)*SLOTB)?0:sl_next+SLOTB;}while(0)
  DMA_K(2,2*SLOTB);
  WAIT_BAR(3);
  qkt(pA0,pA1,Kbase,qr,negm,r32,hi);asm volatile("s_nop 15\n\ts_nop 7":"+v"(pA0),"+v"(pA1));CMASK(pA0,pA1,0);
  START(pA0,pA1);
  _Pragma("unroll") for(int r=0;r<16;++r)pA1[r]=__builtin_amdgcn_exp2f(pA1[r]);
  WAIT_BAR(0);
  DMA_K(3,0);DMA_V(1,SLOTB);
  ROT();
  kload8(kf,kp0+sl_cur);
  WAIT_BAR(2);
  s16x4 vlo[8],vhi[8]; u32x4 pw0,pw1,pw2,pw3;
  #define PKW(P,B) cvtpk_s(P[B],P[B+1])
  #define PAF(k) __builtin_bit_cast(bf16x8,pw##k)
  #define VFR(i) (bf16x8){vlo[i][0],vlo[i][1],vlo[i][2],vlo[i][3],vhi[i][0],vhi[i][1],vhi[i][2],vhi[i][3]}
  #define PIN(x) asm volatile("":"+v"(x))
  #define MX3(a,b,c) __builtin_fmaxf(__builtin_fmaxf((a),(b)),(c))
  #define GAPA(MF,A0,A1,A2,A3,W0,W1,PW) do{ MF; sacc+=A0; sacc+=A1; sacc+=A2; sacc+=A3; PIN(sacc); W0; W1; PIN(PW); SBAR(); }while(0)
  #define EX(v) __builtin_amdgcn_exp2f(v)
  #define GAPB(MF,X,B) do{ MF; X[B]=EX(X[B]); X[B+1]=EX(X[B+1]); X[B+2]=EX(X[B+2]); X[B+3]=EX(X[B+3]); PIN(X); SBAR(); }while(0)
  #define VRD(i) do{ vlo[i]=vtr(vp_+(((i)>>2)*4096+((i)&3)*1024)); vhi[i]=vtr(vp_+(((i)>>2)*4096+((i)&3)*1024+512)); }while(0)
  #define KRD(G,j) do{ if(G){ kload2(kf,kp0+sl_next,j); SBAR(); } }while(0)
  #define STEP(C0,C1,P0,P1,t,GK,GV,GL) do{ SBAR(); \
    const lds_cptr vp_=vp0+sl_prev; \
    VRD(0); SBAR(); float sacc=(P0[0]+P0[1]); \
    GAPA(C0=__builtin_amdgcn_mfma_f32_32x32x16_bf16(kf[0],qr[0],negm,0,0,0), P0[2],P0[3],P0[4],P0[5],     pw0[0]=PKW(P0,0), pw0[1]=PKW(P0,2), pw0); \
    VRD(4); SBAR(); GAPA(C1=__builtin_amdgcn_mfma_f32_32x32x16_bf16(kf[1],qr[0],negm,0,0,0), P0[6],P0[7],P0[8],P0[9],     pw0[2]=PKW(P0,4), pw0[3]=PKW(P0,6), pw0); \
    VRD(1); SBAR(); GAPA(C0=__builtin_amdgcn_mfma_f32_32x32x16_bf16(kf[2],qr[1],C0,0,0,0),   P0[10],P0[11],P0[12],P0[13], pw1[0]=PKW(P0,8), pw1[1]=PKW(P0,10), pw1); \
    VRD(5); SBAR(); GAPA(C1=__builtin_amdgcn_mfma_f32_32x32x16_bf16(kf[3],qr[1],C1,0,0,0),   P0[14],P0[15],P1[0],P1[1],   pw1[2]=PKW(P0,12),pw1[3]=PKW(P0,14), pw1); \
    VRD(2); SBAR(); GAPA(C0=__builtin_amdgcn_mfma_f32_32x32x16_bf16(kf[4],qr[2],C0,0,0,0),   P1[2],P1[3],P1[4],P1[5],     pw2[0]=PKW(P1,0), pw2[1]=PKW(P1,2), pw2); \
    VRD(6); SBAR(); GAPA(C1=__builtin_amdgcn_mfma_f32_32x32x16_bf16(kf[5],qr[2],C1,0,0,0),   P1[6],P1[7],P1[8],P1[9],     pw2[2]=PKW(P1,4), pw2[3]=PKW(P1,6), pw2); \
    VRD(3); SBAR(); GAPA(C0=__builtin_amdgcn_mfma_f32_32x32x16_bf16(kf[6],qr[3],C0,0,0,0),   P1[10],P1[11],P1[12],P1[13], pw3[0]=PKW(P1,8), pw3[1]=PKW(P1,10), pw3); \
    VRD(7); SBAR(); GAPA(C1=__builtin_amdgcn_mfma_f32_32x32x16_bf16(kf[7],qr[3],C1,0,0,0),   P1[14],P1[15],0.f,0.f,       pw3[2]=PKW(P1,12),pw3[3]=PKW(P1,14), pw3); \
    l_reg+=sacc; \
    if(GK){DMA_K((t)+3,sl_cur);} if(GV){DMA_V((t)+1,sl_next);} \
    CMASK(C0,C1,t); \
    { float a=MX3(C0[0],C0[1],C1[0]),b=MX3(C0[2],C0[3],C1[1]); a=MX3(a,C1[2],C1[3]); \
      _Pragma("unroll") for(int r=4;r<16;r+=4){a=MX3(a,C0[r],C0[r+1]);b=MX3(b,C0[r+2],C0[r+3]);a=MX3(a,C1[r],C1[r+1]);b=MX3(b,C1[r+2],C1[r+3]);} \
      float rm=__builtin_fmaxf(a,b); { auto rr=__builtin_amdgcn_permlane32_swap(__float_as_uint(rm),__float_as_uint(rm),false,false); rm=__builtin_fmaxf(__uint_as_float(rr[0]),__uint_as_float(rr[1])); } \
      resc=false; \
      if(__builtin_expect(__any(rm>(float)THRL),0)){ const float dl=__builtin_fmaxf(rm,0.f); mhat+=dl; \
        _Pragma("unroll") for(int r=0;r<16;++r){C0[r]-=dl;C1[r]-=dl;} \
        _Pragma("unroll") for(int r=0;r<16;++r)negm[r]=-mhat; asm volatile("":"+v"(negm)); \
        const float f=__builtin_amdgcn_exp2f(-dl); l_reg*=f; if(hi==0)wsf[r32]=f; resc=true; } } \
    SBAR(); \
    GAPB(o[0]=__builtin_amdgcn_mfma_f32_32x32x16_bf16(PAF(0),VFR(0),o[0],0,0,0), C0,0); \
    GAPB(o[1]=__builtin_amdgcn_mfma_f32_32x32x16_bf16(PAF(0),VFR(4),o[1],0,0,0), C0,4); \
    KRD(GL,0); GAPB(o[0]=__builtin_amdgcn_mfma_f32_32x32x16_bf16(PAF(1),VFR(1),o[0],0,0,0), C0,8); \
    KRD(GL,1); GAPB(o[1]=__builtin_amdgcn_mfma_f32_32x32x16_bf16(PAF(1),VFR(5),o[1],0,0,0), C0,12); \
    KRD(GL,2); GAPB(o[0]=__builtin_amdgcn_mfma_f32_32x32x16_bf16(PAF(2),VFR(2),o[0],0,0,0), C1,0); \
    KRD(GL,3); GAPB(o[1]=__builtin_amdgcn_mfma_f32_32x32x16_bf16(PAF(2),VFR(6),o[1],0,0,0), C1,4); \
    GAPB(o[0]=__builtin_amdgcn_mfma_f32_32x32x16_bf16(PAF(3),VFR(3),o[0],0,0,0), C1,8); \
    GAPB(o[1]=__builtin_amdgcn_mfma_f32_32x32x16_bf16(PAF(3),VFR(7),o[1],0,0,0), C1,12); \
    }while(0)
  int t=1;
  for(;t+5<NT;t+=2){
    STEP(pB0,pB1,pA0,pA1,t,true,true,true);     WAIT_BAR(2); RESC(); ROT();
    STEP(pA0,pA1,pB0,pB1,t+1,true,true,true);   WAIT_BAR(2); RESC(); ROT();
  }
  #define ENDW(tt) do{ if((tt)+3<NT){WAIT_BAR(2);} else if((tt)+2<NT){WAIT_BAR(1);} else {WAIT_BAR(0);} }while(0)
  for(;t+1<NT;t+=2){
    STEP(pB0,pB1,pA0,pA1,t,(t+3<NT),(t+1<NT),(t+1<NT));       ENDW(t);   RESC(); ROT();
    STEP(pA0,pA1,pB0,pB1,t+1,(t+4<NT),(t+2<NT),(t+2<NT));     ENDW(t+1); RESC(); ROT();
  }
  STEP(pB0,pB1,pA0,pA1,NT-1,false,false,false); RESC();
  { float sacc=pB0[0]+pB0[1]; _Pragma("unroll") for(int r=2;r<16;++r)sacc+=pB0[r]; _Pragma("unroll") for(int r=0;r<16;++r)sacc+=pB1[r]; l_reg+=sacc;
    pw0=(u32x4){PKW(pB0,0),PKW(pB0,2),PKW(pB0,4),PKW(pB0,6)};pw1=(u32x4){PKW(pB0,8),PKW(pB0,10),PKW(pB0,12),PKW(pB0,14)};pw2=(u32x4){PKW(pB1,0),PKW(pB1,2),PKW(pB1,4),PKW(pB1,6)};pw3=(u32x4){PKW(pB1,8),PKW(pB1,10),PKW(pB1,12),PKW(pB1,14)};
    SBAR(); pv(o,vb0+sl_cur,PAF(0),PAF(1),PAF(2),PAF(3)); }
  #undef PKW
  #undef PAF
  #undef VFR
  #undef PIN
  #undef MX3
  #undef GAPA
  #undef GAPB
  #undef EX
  #undef VRD
  #undef KRD
  #undef STEP
  #undef ENDW
  {auto rr=__builtin_amdgcn_permlane32_swap(__float_as_uint(l_reg),__float_as_uint(l_reg),false,false);l_reg=__uint_as_float(rr[0])+__uint_as_float(rr[1]);}
  if(MODE==1)l_reg+=__builtin_amdgcn_exp2f(sinkl2-mhat);
  if(hi==0)wsf[32+r32]=l_reg;asm volatile("s_waitcnt lgkmcnt(0)":::"memory");
  float rli[16];
  #pragma unroll
  for(int r=0;r<16;++r)rli[r]=__builtin_amdgcn_rcpf(wsf[32+crow(r,hi)]);
  bf16*Ow=Ou+(long)(wid*QBLK)*OP;
  { bf16*stg=(bf16*)(shm+LDS_OST)+wid*2048;
    #pragma unroll
    for(int r=0;r<16;++r){const int orow=crow(r,hi);
      #pragma unroll
      for(int d0=0;d0<2;++d0)stg[orow*64+d0*32+r32]=__float2bfloat16(o[d0][r]*rli[r]);}
    asm volatile("s_waitcnt lgkmcnt(0)":::"memory");
    #pragma unroll
    for(int i=0;i<4;++i){const int row=i*8+(lane>>3),ch=lane&7; const u32x4 v=*(const u32x4*)(stg+row*64+ch*8); ATTN_STORE16(Ow+(long)row*OP+ch*8,v);} }
  asm volatile("s_waitcnt lgkmcnt(0)\n\ts_barrier":::"memory");
  #undef DMA_K
  #undef TROW
  #undef DMA_V
  #undef CMASK
  #undef START
  #undef RESC
  #undef ROT
}
#undef SBAR
#undef WAIT_BAR
}

template <int LAYER> __device__ __forceinline__ void attn_fast(const Frame& F, char* shm) {
    using attn_body::bf16;
    const bf16* Q = (const bf16*)(F.ws + WS_Q); const bf16* Kn = (const bf16*)(F.ws + WS_KN); const bf16* Vn = (const bf16*)(F.ws + WS_VN); bf16* AO = (bf16*)(F.ws + WS_AO);
    const int nunits = LAYER == 0 ? 1024 + 64 : 1024;
    for (int U = F.vcu; U < nunits; U += F.G) {
        int b, h, NT, lat0 = 0, q0 = 0; size_t row0;
        if (U < 1024) { b = U >> 7; h = ((U >> 6) & 1) * 4 + ((U >> 4) & 3); q0 = (U & 15) * 256; row0 = (size_t)b * SEQ + q0;
            if (LAYER == 0) NT = KVS / 64;
            else { int lo = q0 - 128, hi = q0 + 384; lo = lo < 0 ? 0 : lo; hi = hi > SEQ ? SEQ : hi; NT = 4 + (hi - lo) / 64; lat0 = CTXL + lo; } }
        else { const int uc = U - 1024; b = uc >> 3; h = uc & 7; row0 = (size_t)TX + (size_t)b * CTXL; NT = 4; }
        const bf16* Kh = Kn + (size_t)b * KVS * 128 + (h >> 2) * 64; const bf16* Vh = Vn + (size_t)b * KVS * 128 + (h >> 2) * 64;
        const float sinkl2 = LAYER == 1 ? F.in[I_SINK][h] * LOG2E : 0.f;
        if (LAYER == 0 && F.G == 256 && U < 1024 && (U >> 8) == (F.vcu & 3)) {
            const int lo = TN_DENSE + (F.vcu < 64 ? F.vcu * 72 : 64 * 72 + (F.vcu - 64) * 104); int hi = lo + (F.vcu < 64 ? 72 : 104); hi = hi > TN_ITEMS ? TN_ITEMS : hi;
            Frame Fc = F; asm volatile("" : "+v"(Fc.lane), "+v"(Fc.tid));
            transpose_range(Fc, lo, hi, Fc.wave, NWAVES);
            __syncthreads(); }
        attn_body::attn_unit<LAYER, 8>(Q + row0 * 512 + h * 64, Kh, Vh, AO + row0 * 1024 + h * 64, NT, lat0, q0, sinkl2, F.in[LAYER == 0 ? I_QNA : I_QNC], (const float*)(F.ws + WS_ROPE), U < 1024, shm);
    }
}

template <int DRY, bool FP8> __device__ __forceinline__ void p_router(const Frame& F, int l, int ntok) {
    const int gw = F.vcu * NWAVES + F.wave, NGW = F.G * NWAVES, lane = F.lane, tk = lane & 15, kq = lane >> 4;
    bf16_t* HX = F.hx(); const float* SS = (const float*)(F.ws + WS_SS);
    const float* gb = F.in[I_RGB] + l * 4; const float* eb = F.in[I_REB] + l * 32;
    unsigned* tokslot = (unsigned*)(F.ws + (DRY ? WS_HID : WS_TOK)); float* tokw = (float*)(F.ws + (DRY ? WS_HID : WS_TOK) + 512 * 1024); unsigned* list = (unsigned*)(F.ws + (DRY ? WS_HID + 2 * MiB : WS_LIST));
    unsigned* cnt = F.cnt(DRY ? l + 2 : l);
    {
        const u32x4* src = (const u32x4*)((const bf16_t*)(F.ws + WS_WR) + (size_t)l * 2 * 36864);
        u32x4 t[18];
#pragma unroll
        for (int i = 0; i < 18; ++i) t[i] = src[F.tid + i * NTHREADS];
        __syncthreads();
#pragma unroll
        for (int i = 0; i < 18; ++i) *(LAS u32x4*)(F.lds + (F.tid + i * NTHREADS) * 16) = t[i];
    }
    const LAS unsigned char* wl0 = F.lds + lane * 16;
    const LAS unsigned char* wl2 = F.lds + 2048 + ((tk >> 2) * 4 + kq) * 16;
    LAS unsigned* lcnt = (LAS unsigned*)(F.lds + LDS_TAB + 2048 + 8192); LAS unsigned* lbase = lcnt + 32;
    LAS float* gps = (LAS float*)(F.lds + LDS_TAB + 2048);
    const int nrounds = (ntok / 16 + NGW - 1) / NGW;
    for (int rd = 0; rd < nrounds; ++rd) {
        const int grp0 = F.vcu * NWAVES + rd * NGW, grp = grp0 + F.wave;
        __syncthreads();
        if (F.tid < 32) lcnt[F.tid] = 0u;
        if (grp0 < ntok / 16) { const int r0 = modrow(grp0 * 16); const float* gpg = (const float*)(F.ws + WS_GP) + (size_t)(l * 9 + r0) * 1024; const float* shg = F.mod(l, r0, 3);
            *(LAS f32x4*)(gps + 4 * F.tid) = F.tid < 256 ? *(const f32x4*)(gpg + 4 * F.tid) : *(const f32x4*)(shg + 4 * (F.tid - 256)); }
        __syncthreads();
        const bool active = grp < ntok / 16;
        const int row = (active ? grp : 0) * 16 + tk;
        bool win = false; int e1 = 0, e2 = 0; float w1 = 0.f, w2 = 0.f; unsigned p1 = 0u, p2 = 0u;
        if (active) {
        const bf16_t* xr = F.xr_row(row) + 8 * kq;
        u32x4 xq[16];
#define R_XLOAD(i, st) do { const int s_ = (st) < 32 ? (st) : 31; xq[i] = *(const u32x4*)(xr + s_ * 32); } while (0)
#pragma unroll
        for (int i = 0; i < 16; ++i) R_XLOAD(i, i);
        float ssum = 0.f;
#pragma unroll
        for (int i = 0; i < 4; ++i) { const f32x4 p = *(const f32x4*)(SS + (size_t)row * 16 + 4 * i); ssum += (p[0] + p[1]) + (p[2] + p[3]); }
        const float rms = 1.0f / sqrtf(ssum * (1.f / 1024.f) + EPS);
        f32x4 acc[3];
#pragma unroll
        for (int n = 0; n < 3; ++n) acc[n] = (f32x4){0.f, 0.f, 0.f, 0.f};
        bf16_t* hxr = HX + (size_t)row * DM + 8 * kq; unsigned char* hx8 = (unsigned char*)HX + (size_t)row * DM + 8 * kq;
        const LAS float* gpl = gps + 8 * kq;
#define R_STEP(i, st) do { const u32x4 xb_ = xq[i]; \
            const f32x4 m0 = *(const LAS f32x4*)(gpl + (st) * 32), m1 = *(const LAS f32x4*)(gpl + (st) * 32 + 4), m2 = *(const LAS f32x4*)(gpl + 1024 + (st) * 32), m3 = *(const LAS f32x4*)(gpl + 1024 + (st) * 32 + 4); \
            const f32x4 xf0 = (f32x4){bflo(xb_.x), bfhi(xb_.x), bflo(xb_.y), bfhi(xb_.y)}, xf1 = (f32x4){bflo(xb_.z), bfhi(xb_.z), bflo(xb_.w), bfhi(xb_.w)}; \
            const f32x4 h0 = (xf0 * rms) * m0 + m2, h1 = (xf1 * rms) * m1 + m3; \
            u32x4 hh; hh.x = pk2(h0[0], h0[1]); hh.y = pk2(h0[2], h0[3]); hh.z = pk2(h1[0], h1[1]); hh.w = pk2(h1[2], h1[3]); \
            if (FP8) { u32x2 h8; h8.x = pk4_fp8(h0[0], h0[1], h0[2], h0[3]); h8.y = pk4_fp8(h1[0], h1[1], h1[2], h1[3]); *(u32x2*)(hx8 + (st) * 32) = h8; } else *(u32x4*)(hxr + (st) * 32) = hh; \
            if (DRY < 3 || DRY >= 6) { \
            u32x4 hl; hl.x = pk2(h0[0] - bflo(hh.x), h0[1] - bfhi(hh.x)); hl.y = pk2(h0[2] - bflo(hh.y), h0[3] - bfhi(hh.y)); hl.z = pk2(h1[0] - bflo(hh.z), h1[1] - bfhi(hh.z)); hl.w = pk2(h1[2] - bflo(hh.w), h1[3] - bfhi(hh.w)); \
            const bf16x8 bh = __builtin_bit_cast(bf16x8, hh), bl = __builtin_bit_cast(bf16x8, hl); \
            bf16x8 w0h, w1h, w2h, w0l, w1l, w2l; if (DRY == 6) { w0h = w1h = w2h = w0l = w1l = w2l = bh; } else { w0h = *(const LAS bf16x8*)(wl0 + (st) * 2304); w1h = *(const LAS bf16x8*)(wl0 + (st) * 2304 + 1024); w2h = *(const LAS bf16x8*)(wl2 + (st) * 2304); \
            w0l = *(const LAS bf16x8*)(wl0 + RW_BYTES + (st) * 2304); w1l = *(const LAS bf16x8*)(wl0 + RW_BYTES + (st) * 2304 + 1024); w2l = *(const LAS bf16x8*)(wl2 + RW_BYTES + (st) * 2304); } \
            if (DRY == 7) { const bf16x8 sx = w0h ^ w1h ^ w2h ^ w0l ^ w1l ^ w2l ^ bl; acc[0][0] += (float)sx[0]; } else \
            acc[0] = __builtin_amdgcn_mfma_f32_16x16x32_bf16(w0h, bh, acc[0], 0, 0, 0); acc[1] = __builtin_amdgcn_mfma_f32_16x16x32_bf16(w1h, bh, acc[1], 0, 0, 0); acc[2] = __builtin_amdgcn_mfma_f32_16x16x32_bf16(w2h, bh, acc[2], 0, 0, 0); \
            acc[0] = __builtin_amdgcn_mfma_f32_16x16x32_bf16(w0h, bl, acc[0], 0, 0, 0); acc[1] = __builtin_amdgcn_mfma_f32_16x16x32_bf16(w1h, bl, acc[1], 0, 0, 0); acc[2] = __builtin_amdgcn_mfma_f32_16x16x32_bf16(w2h, bl, acc[2], 0, 0, 0); \
            acc[0] = __builtin_amdgcn_mfma_f32_16x16x32_bf16(w0l, bh, acc[0], 0, 0, 0); acc[1] = __builtin_amdgcn_mfma_f32_16x16x32_bf16(w1l, bh, acc[1], 0, 0, 0); acc[2] = __builtin_amdgcn_mfma_f32_16x16x32_bf16(w2l, bh, acc[2], 0, 0, 0); } } while (0)
        for (int st = 0; st < 32; st += 16) {
#pragma unroll
            for (int i = 0; i < 16; ++i) { R_STEP(i, st + i); R_XLOAD(i, st + i + 16); }
        }
#undef R_XLOAD
#undef R_STEP
        if (DRY >= 6 && acc[0][0] + acc[1][1] + acc[2][2] == 123.456f) tokw[row] = 1.f;
        if (DRY < 2) {
            const float lgk = acc[2][0] + gb[kq];
            const float la = __shfl_xor(lgk, 16), lb = __shfl_xor(lgk, 32), lc = __shfl_xor(la, 32);
            const float gm = fmaxf(fmaxf(lgk, la), fmaxf(lb, lc));
            win = (lgk == gm);
            win = win && !(la == gm && (kq ^ 1) < kq) && !(lb == gm && (kq ^ 2) < kq) && !(lc == gm && (kq ^ 3) < kq);
            if (win) {
                const float g_w = 1.f / (expf(lgk - gm) + expf(la - gm) + expf(lb - gm) + expf(lc - gm));
                float el[8];
                { const f32x4 b0 = *(const f32x4*)(eb + 8 * kq), b1 = *(const f32x4*)(eb + 8 * kq + 4);
#pragma unroll
                  for (int i = 0; i < 4; ++i) { el[i] = acc[0][i] + b0[i]; el[4 + i] = acc[1][i] + b1[i]; } }
                int i1 = 0; float m1 = el[0];
#pragma unroll
                for (int i = 1; i < 8; ++i) if (el[i] > m1) { m1 = el[i]; i1 = i; }
                int i2 = 0; float m2 = -3.0e38f;
#pragma unroll
                for (int i = 0; i < 8; ++i) if (i != i1 && el[i] > m2) { m2 = el[i]; i2 = i; }
                const float pp = expf(m2 - m1); w1 = g_w / (1.f + pp); w2 = g_w * pp / (1.f + pp);
                e1 = kq * 8 + i1; e2 = kq * 8 + i2;
                p1 = __hip_atomic_fetch_add(lcnt + e1, 1u, __ATOMIC_RELAXED, __HIP_MEMORY_SCOPE_WORKGROUP); p2 = __hip_atomic_fetch_add(lcnt + e2, 1u, __ATOMIC_RELAXED, __HIP_MEMORY_SCOPE_WORKGROUP);
            }
        }
        }
        __syncthreads();
        if (DRY < 2 && F.tid < 32) { const unsigned n = lcnt[F.tid]; lbase[F.tid] = n ? atomicAdd(cnt + F.tid * 64, n) : 0u; }
        __syncthreads();
        if (win) { const unsigned pos1 = lbase[e1] + p1, pos2 = lbase[e2] + p2;
            list[(size_t)e1 * TT + pos1] = (unsigned)row; list[(size_t)e2 * TT + pos2] = (unsigned)row;
            tokslot[2 * row] = ((unsigned)e1 << 16) | pos1; tokslot[2 * row + 1] = ((unsigned)e2 << 16) | pos2; tokw[2 * row] = w1; tokw[2 * row + 1] = w2; }
    }
    __syncthreads();
}
struct CombBuf { u32x2 x[4], ya[4], yb[4]; };
__device__ __forceinline__ void comb_load(CombBuf& b, const bf16_t* xr, const bf16_t* ya, const bf16_t* yb, int lane) {
#pragma unroll
    for (int j = 0; j < 4; ++j) { const int c = 4 * lane + 256 * j; b.x[j] = *(const u32x2*)(xr + c); b.ya[j] = *(const u32x2*)(ya + c); b.yb[j] = *(const u32x2*)(yb + c); }
}
template <bool LAST, bool DRY> __device__ __forceinline__ void comb_finish(const Frame& F, const CombBuf& b, int l, int row, float wa, float wb, int lane) {
    const int r = modrow(row); const float* g2 = F.mod(l, r, 5); bf16_t* xr = F.xr_row(row);
    float ss = 0.f; f32x4 v[4];
#pragma unroll
    for (int j = 0; j < 4; ++j) { const int c = 4 * lane + 256 * j; const f32x4 gv = *(const f32x4*)(g2 + c);
        f32x4 y; y[0] = wa * bflo(b.ya[j].x) + wb * bflo(b.yb[j].x); y[1] = wa * bfhi(b.ya[j].x) + wb * bfhi(b.yb[j].x); y[2] = wa * bflo(b.ya[j].y) + wb * bflo(b.yb[j].y); y[3] = wa * bfhi(b.ya[j].y) + wb * bfhi(b.yb[j].y);
        const f32x4 x1 = (f32x4){bflo(b.x[j].x), bfhi(b.x[j].x), bflo(b.x[j].y), bfhi(b.x[j].y)};
        v[j] = x1 + gv * y;
        if (LAST) { if (!DRY) *(f32x4*)(F.out + (size_t)row * DM + c) = v[j]; }
        else { u32x2 o; o.x = pk2(v[j][0], v[j][1]); o.y = pk2(v[j][2], v[j][3]); *(u32x2*)(xr + c) = DRY ? b.x[j] : o; }
        ss += (v[j][0] * v[j][0] + v[j][1] * v[j][1]) + (v[j][2] * v[j][2] + v[j][3] * v[j][3]); }
    if (!LAST) { const float rms = 1.0f / sqrtf(wave_sum(ss) * (1.f / 1024.f) + EPS); const float* g = F.in[I_LN1] + (l + 1) * 1024; const float* sh = F.mod(l + 1, r, 0); const float* sc = F.mod(l + 1, r, 1); f32x4 h[4];
#pragma unroll
        for (int j = 0; j < 4; ++j) { const int c = 4 * lane + 256 * j; h[j] = (v[j] * rms * *(const f32x4*)(g + c)) * (1.f + *(const f32x4*)(sc + c)) + *(const f32x4*)(sh + c); }
        store_row_bf16(F.hx() + (size_t)row * DM, lane, h); }
}
template <bool LAST, bool DRY> __device__ __forceinline__ void p_combine(const Frame& F, int l, int ntok, const MoeTab& tb, int tsh) {
    const int gw = F.vcu * NWAVES + F.wave, NGW = F.G * NWAVES, lane = F.lane;
    const bf16_t* YB = (const bf16_t*)(F.ws + WS_YB);
    const unsigned* tokslot = (const unsigned*)(F.ws + WS_TOK); const float* tokw = (const float*)(F.ws + WS_TOK + 512 * 1024);
    const int ntot = gw < ntok ? (ntok - gw + NGW - 1) / NGW : 0;
    for (int base = 0; base < ntot; base += 64) {
    const int n = ntot - base < 64 ? ntot - base : 64;
    unsigned my_sa = 0u, my_sb = 0u; float my_wa = 0.f, my_wb = 0.f;
    { const int mr = gw + (base + lane) * NGW;
      if (lane < n) { const unsigned sa = tokslot[2 * mr], sb = tokslot[2 * mr + 1]; my_wa = tokw[2 * mr]; my_wb = tokw[2 * mr + 1];
          my_sa = ((unsigned)tb.tile0[sa >> 16] << tsh) + (sa & 0xffffu); my_sb = ((unsigned)tb.tile0[sb >> 16] << tsh) + (sb & 0xffffu); } }
    CombBuf A, B;
#define COMB_LOAD(buf, i) do { const int row_ = gw + (base + (i)) * NGW; const unsigned sa_ = __builtin_amdgcn_readlane(my_sa, (i)), sb_ = __builtin_amdgcn_readlane(my_sb, (i)); \
        comb_load(buf, F.xr_row(row_), YB + (size_t)sa_ * 1024, YB + (size_t)sb_ * 1024, lane); } while (0)
#define COMB_FIN(buf, i) do { const float wa_ = __uint_as_float(__builtin_amdgcn_readlane(__float_as_uint(my_wa), (i))), wb_ = __uint_as_float(__builtin_amdgcn_readlane(__float_as_uint(my_wb), (i))); \
        comb_finish<LAST, DRY>(F, buf, l, gw + (base + (i)) * NGW, wa_, wb_, lane); } while (0)
    COMB_LOAD(A, 0);
    for (int i = 0; i < n; i += 2) {
        if (i + 1 < n) COMB_LOAD(B, i + 1);
        COMB_FIN(A, i);
        if (i + 2 < n) COMB_LOAD(A, i + 2);
        if (i + 1 < n) COMB_FIN(B, i + 1);
    }
    }
#undef COMB_LOAD
#undef COMB_FIN
}

__global__ void __launch_bounds__(NTHREADS, 2) fwd_kernel(Params P) {
    extern __shared__ __attribute__((aligned(16))) unsigned char lds_raw[];
    Frame F;
    F.lds = (LAS unsigned char*)lds_raw; F.in = P.in; F.out = P.out; F.ws = P.ws;
    F.tid = threadIdx.x; F.lane = F.tid & 63; F.wave = __builtin_amdgcn_readfirstlane(F.tid >> 6);
    F.G = gridDim.x; { const int bx = blockIdx.x; F.vcu = (F.G % 8 == 0) ? (bx % 8) * (F.G / 8) + bx / 8 : bx; }
    volatile LAS unsigned* misc = (volatile LAS unsigned*)(F.lds + LDS_MISC);
    if (F.tid < 16) misc[F.tid] = 0u;
    __syncthreads();
#if ONE_LAUNCH
    XcdBarrier bar = xcd_barrier_post((unsigned*)(F.ws + WS_CTL) + CW_BAR, misc + 8);
#define GRID_BAR() do { xcd_barrier(bar); } while (0)
#else
#define GRID_BAR() do { } while (0)
#endif
    const int lo = P.ph_lo, hi = P.ph_hi;
#ifndef DRYMASK
#define DRYMASK 0x4000
#endif
#ifndef DRYV
#define DRYV 7
#endif
#ifndef PHMASK
#define PHMASK 0xFFFFFFFFu
#endif
#define IN(k) (((PHMASK >> (k)) & 1u) && lo <= (k) && (k) < hi)
#ifdef PROBE_PH
#define STAMP(k) do { if (blockIdx.x == 0 && F.tid == 0) { const unsigned long long t_ = __builtin_amdgcn_s_memrealtime(); \
        if ((k) == PROBE_PH - 1) { misc[0] = (unsigned)t_; misc[1] = (unsigned)(t_ >> 32); } if ((k) == PROBE_PH) { misc[2] = (unsigned)t_; misc[3] = (unsigned)(t_ >> 32); } } } while (0)
#else
#define STAMP(k) do { } while (0)
#endif
#define SEAM(k) do { if (IN((k) + 1)) GRID_BAR(); STAMP(k); } while (0)
    STAMP(-1);
    bf16_t* HX = F.hx(); bf16_t* Qb = (bf16_t*)(F.ws + WS_Q); bf16_t* KVb = (bf16_t*)(F.ws + WS_KV); bf16_t* Gb = (bf16_t*)(F.ws + WS_G); bf16_t* AO = (bf16_t*)(F.ws + WS_AO);
    bf16_t* HID = (bf16_t*)(F.ws + WS_HID); bf16_t* YB = (bf16_t*)(F.ws + WS_YB);

    if (IN(0)) { Frame Fp = F; asm volatile("" : "+v"(Fp.tid), "+v"(Fp.lane)); p0_prologue(Fp); SEAM(0); }
    if (IN(1)) { Frame Fp = F; asm volatile("" : "+v"(Fp.tid), "+v"(Fp.lane)); p0_misc(Fp); p_norm1_l0(Fp); SEAM(1); }
    if (IN(2)) { Frame Fp = F; asm volatile("" : "+v"(Fp.tid), "+v"(Fp.lane)); SchedDense S{(const bf16_t*)(Fp.ws + WS_WINAB), 1024, TT / 256, 7, 0, 0, Fp.vcu, Fp.G}; EpiInProj<true> E{Qb, KVb, (bf16_t*)(Fp.ws + WS_VN), Gb}; GEMM(Fp, HX, 2048, S, E); SEAM(2); }
    if (IN(3)) { Frame Fp = F; asm volatile("" : "+v"(Fp.tid), "+v"(Fp.lane)); p_k_post(Fp, Fp.in[I_KNA]); p_conv(Fp); SEAM(3); }
    if (IN(4)) { Frame Fp = F; asm volatile("" : "+v"(Fp.tid), "+v"(Fp.lane));
#ifdef ATTN_SIMPLE
        attn_simple<0>(Fp);
#else
        attn_fast<0>(Fp, (char*)lds_raw);
#endif
        SEAM(4); }
    if (IN(5)) { Frame Fp = F; asm volatile("" : "+v"(Fp.tid), "+v"(Fp.lane)); SchedDense S{(const bf16_t*)(Fp.ws + WS_WOUTAB), 1024, TT / 256, 4, 0, 0, Fp.vcu, Fp.G}; EpiOutProj<true> E{Fp, 0}; GEMM(Fp, AO, 2048, S, E);
        SEAM(5); }
    if (IN(6)) { Frame Fp = F; asm volatile("" : "+v"(Fp.tid), "+v"(Fp.lane));
#if (DRYMASK >> 6) & 1
        p_router<DRYV, FP8_G1_L0>(Fp, 0, TT); GRID_BAR();
#endif
        p_router<0, FP8_G1_L0>(Fp, 0, TT); SEAM(6); }
    if (IN(7)) { Frame Fp = F; asm volatile("" : "+v"(Fp.tid), "+v"(Fp.lane)); const MoeTab tb = moe_tables(Fp, 0, (FP8_L0 ? 7 : 8)); SchedMoe S{(const bf16_t*)(Fp.ws + WS_WGU), (size_t)1024 * 1024, (FP8_L0 ? 7 : 8), tb, (const unsigned*)(Fp.ws + WS_LIST), true, Fp.vcu, Fp.G}; EpiMoe1<FP8_G1_L0, FP8_G2_L0, FP8_L0> E{HID}; gemm_fast<true, FP8_G1_L0, FP8_L0>(Fp, HX, FP8_G1_L0 ? 1024 : 2048, S, E); SEAM(7); }
    if (IN(8)) { Frame Fp = F; asm volatile("" : "+v"(Fp.tid), "+v"(Fp.lane)); const MoeTab tb = moe_tables(Fp, 0, (FP8_L0 ? 7 : 8)); SchedMoe S{(const bf16_t*)(Fp.ws + WS_WD), (size_t)1024 * 512, (FP8_L0 ? 7 : 8), tb, nullptr, false, Fp.vcu, Fp.G}; EpiMoe2<FP8_G2_L0, FP8_L0> E{YB}; gemm_fast<ALIGN_G2, FP8_G2_L0, FP8_L0>(Fp, HID, FP8_G2_L0 ? 512 : 1024, S, E); SEAM(8); }
    if (IN(9)) { Frame Fp = F; asm volatile("" : "+v"(Fp.tid), "+v"(Fp.lane)); const MoeTab tb = moe_tables(Fp, 0, (FP8_L0 ? 7 : 8));
#if (DRYMASK >> 9) & 1
        p_combine<false, true>(Fp, 0, TT, tb, FP8_L0 ? 7 : 8); GRID_BAR();
#endif
        p_combine<false, false>(Fp, 0, TT, tb, FP8_L0 ? 7 : 8); SEAM(9); }
    if (IN(10)) { Frame Fp = F; asm volatile("" : "+v"(Fp.tid), "+v"(Fp.lane)); SchedDense S{(const bf16_t*)(Fp.ws + WS_WINCD), 1024, TX / 256, 5, TC / 256, 2, Fp.vcu, Fp.G}; EpiInProj<false> E{Qb, KVb, (bf16_t*)(Fp.ws + WS_VN), Gb}; GEMM(Fp, HX, 2048, S, E); SEAM(10); }
    if (IN(11)) { Frame Fp = F; asm volatile("" : "+v"(Fp.tid), "+v"(Fp.lane)); p_k_post(Fp, Fp.in[I_KNC]); p_pool(Fp); SEAM(11); }
    if (IN(12)) { Frame Fp = F; asm volatile("" : "+v"(Fp.tid), "+v"(Fp.lane));
#ifdef ATTN_SIMPLE
        attn_simple<1>(Fp);
#else
        attn_fast<1>(Fp, (char*)lds_raw);
#endif
        SEAM(12); }
    if (IN(13)) { Frame Fp = F; asm volatile("" : "+v"(Fp.tid), "+v"(Fp.lane)); SchedDense S{(const bf16_t*)(Fp.ws + WS_WOUTCD), 1024, TX / 256, 4, 0, 0, Fp.vcu, Fp.G};
#if (DRYMASK >> 13) & 1
        { EpiOutProj<false, true> Ed{Fp, 1}; GEMMO(Fp, AO, 2048, S, Ed); GRID_BAR(); }
#endif
        EpiOutProj<false> E{Fp, 1}; GEMM(Fp, AO, 2048, S, E); SEAM(13); }
    if (IN(14)) { Frame Fp = F; asm volatile("" : "+v"(Fp.tid), "+v"(Fp.lane));
#if (DRYMASK >> 14) & 1
        p_router<DRYV, FP8_G1_L1>(Fp, 1, TX); GRID_BAR();
#endif
        p_router<0, FP8_G1_L1>(Fp, 1, TX); SEAM(14); }
    if (IN(15)) { Frame Fp = F; asm volatile("" : "+v"(Fp.tid), "+v"(Fp.lane)); const MoeTab tb = moe_tables(Fp, 1, (FP8_L1 ? 7 : 8)); SchedMoe S{(const bf16_t*)(Fp.ws + WS_WGU) + (size_t)32 * 1024 * 1024, (size_t)1024 * 1024, (FP8_L1 ? 7 : 8), tb, (const unsigned*)(Fp.ws + WS_LIST), true, Fp.vcu, Fp.G}; EpiMoe1<FP8_G1_L1, FP8_G2_L1, FP8_L1> E{HID}; gemm_fast<true, FP8_G1_L1, FP8_L1>(Fp, HX, FP8_G1_L1 ? 1024 : 2048, S, E); SEAM(15); }
    if (IN(16)) { Frame Fp = F; asm volatile("" : "+v"(Fp.tid), "+v"(Fp.lane)); const MoeTab tb = moe_tables(Fp, 1, (FP8_L1 ? 7 : 8)); SchedMoe S{(const bf16_t*)(Fp.ws + WS_WD) + (size_t)32 * 1024 * 512, (size_t)1024 * 512, (FP8_L1 ? 7 : 8), tb, nullptr, false, Fp.vcu, Fp.G}; EpiMoe2<FP8_G2_L1, FP8_L1> E{YB}; gemm_fast<ALIGN_G2, FP8_G2_L1, FP8_L1>(Fp, HID, FP8_G2_L1 ? 512 : 1024, S, E); SEAM(16); }
    if (IN(17)) { Frame Fp = F; asm volatile("" : "+v"(Fp.tid), "+v"(Fp.lane)); const MoeTab tb = moe_tables(Fp, 1, (FP8_L1 ? 7 : 8));
#if (DRYMASK >> 17) & 1
        p_combine<true, true>(Fp, 1, TX, tb, FP8_L1 ? 7 : 8); GRID_BAR();
#endif
        p_combine<true, false>(Fp, 1, TX, tb, FP8_L1 ? 7 : 8); }
#ifdef PROBE_PH
    STAMP(NPH - 1);
    if (blockIdx.x == 0 && F.tid == 0) { const unsigned long long t0 = ((unsigned long long)misc[1] << 32) | misc[0], t1 = ((unsigned long long)misc[3] << 32) | misc[2];
        const unsigned long long te = __builtin_amdgcn_s_memrealtime(), span = (t1 - t0) * 16ull;
        while (__builtin_amdgcn_s_memrealtime() - te < span) __builtin_amdgcn_s_sleep(32); }
#endif
#undef IN
#undef SEAM
}

extern "C" void kernel_launch(void* const* d_in, const int* in_sizes, int n_in, void* d_out, int out_size, void* d_ws, size_t ws_size, hipStream_t stream) {
    static int grid = 0;
    if (grid == 0) {
        if (n_in != 30 || out_size != TX * DM || ws_size < WS_END) { fprintf(stderr, "kernel_launch: unexpected shapes (n_in %d out %d ws %zu)\n", n_in, out_size, ws_size); grid = -1; return; }
        int dev = 0, cus = 0;
        if (hipGetDevice(&dev) != hipSuccess || hipDeviceGetAttribute(&cus, hipDeviceAttributeMultiprocessorCount, dev) != hipSuccess) { grid = -1; return; }
        if (hipFuncSetAttribute((const void*)fwd_kernel, hipFuncAttributeMaxDynamicSharedMemorySize, LDS_BYTES) != hipSuccess) { fprintf(stderr, "kernel_launch: hipFuncSetAttribute failed\n"); grid = -1; return; }
        int per_cu = 0;
        if (hipOccupancyMaxActiveBlocksPerMultiprocessor(&per_cu, (const void*)fwd_kernel, NTHREADS, LDS_BYTES) != hipSuccess || per_cu < 1) { fprintf(stderr, "kernel_launch: occupancy query says %d\n", per_cu); }
        (void)hipGetLastError();
        grid = cus;
    }
    if (grid < 0) return;
    (void)hipMemsetAsync((char*)d_ws + WS_CTL, 0, CTL_ZERO_BYTES, stream);
    Params p{};
    for (int i = 0; i < 30; ++i) p.in[i] = (const float*)d_in[i];
    p.out = (float*)d_out; p.ws = (unsigned char*)d_ws;
#if ONE_LAUNCH
    p.ph_lo = 0; p.ph_hi = NPH;
    hipLaunchKernelGGL(fwd_kernel, dim3(grid), dim3(NTHREADS), LDS_BYTES, stream, p);
#else
    for (int ph = 0; ph < NPH; ++ph) { p.ph_lo = ph; p.ph_hi = ph + 1; hipLaunchKernelGGL(fwd_kernel, dim3(grid), dim3(NTHREADS), LDS_BYTES, stream, p); }
#endif
}
```

```cpp
#include <hip/hip_runtime.h>
#include <cstdio>
#include <cstdint>

#ifndef ONE_LAUNCH
#define ONE_LAUNCH 1
#endif

#ifndef FP8_L0
#define FP8_L0 1
#endif
#ifndef FP8_L1
#define FP8_L1 1
#endif
#ifndef H3
#define H3 1
#endif
#define FP8_G1_L0 FP8_L0
#define FP8_G2_L0 FP8_L0
#define FP8_G1_L1 FP8_L1
#define FP8_G2_L1 FP8_L1
#define LAS __attribute__((address_space(3)))
#define GAS __attribute__((address_space(1)))
typedef unsigned short bf16_t;
typedef short bf16x8 __attribute__((ext_vector_type(8)));
typedef float f32x4 __attribute__((ext_vector_type(4)));
typedef float f32x2 __attribute__((ext_vector_type(2)));
typedef unsigned u32x4 __attribute__((ext_vector_type(4)));
typedef unsigned u32x2 __attribute__((ext_vector_type(2)));
typedef __bf16 bf16x2_t __attribute__((ext_vector_type(2)));

constexpr int NB = 8, SEQ = 4096, DM = 1024, CTXL = 256, HD = 64;
constexpr int TX = NB * SEQ, TC = NB * CTXL, TT = TX + TC;
constexpr int KVS = CTXL + SEQ;
constexpr int NE = 32;
constexpr int NTILE_MAX = 576, NSLOT = 304 * 256;
constexpr float EPS = 1e-6f;
constexpr float LOG2E = 1.4426950408889634f;
constexpr float C2 = 0.125f * LOG2E;
constexpr int NWAVES = 8, NTHREADS = 512;
constexpr int NPH = 18;

enum { I_X = 0, I_C, I_CTX, I_CCTX, I_MODW, I_MODB, I_LN1, I_LN2, I_WINAB, I_WOUTAB, I_QNA, I_KNA, I_CONVW, I_CONVB, I_CLNG, I_CLNB,
       I_WINCD, I_WOUTCD, I_QNC, I_KNC, I_SINK, I_POOLW, I_POOLS, I_RGW, I_RGB, I_REW, I_REB, I_EXG, I_EXU, I_EXD };

constexpr size_t MiB = 1u << 20;
constexpr size_t WS_CTL = 0, CTL_ZERO_BYTES = 1 * MiB;
constexpr size_t WS_MOD = 1 * MiB;
constexpr size_t WS_ROPE = 2 * MiB;
constexpr size_t WS_TOK = 3 * MiB;
constexpr size_t WS_LIST = 4 * MiB;
constexpr size_t WS_WINAB = 10 * MiB;
constexpr size_t WS_WOUTAB = 14 * MiB;
constexpr size_t WS_WINCD = 16 * MiB;
constexpr size_t WS_WOUTCD = 19 * MiB;
constexpr size_t WS_XC = 21 * MiB;
constexpr size_t WS_KN = 30 * MiB;
constexpr size_t WS_VN = 39 * MiB;
constexpr size_t WS_WGU = 48 * MiB;
constexpr size_t WS_WD = 176 * MiB;
constexpr size_t WS_XR = 240 * MiB;
constexpr size_t WS_HID = 308 * MiB;
constexpr size_t WS_Q = 384 * MiB;
constexpr size_t WS_KV = 418 * MiB;
constexpr size_t WS_G = 435 * MiB;
constexpr size_t WS_AO = 469 * MiB;
constexpr size_t WS_YB = 384 * MiB;
constexpr size_t WS_SS = 537 * MiB;
constexpr size_t WS_WR = 9 * MiB;
constexpr size_t WS_GP = 3 * MiB + 896 * 1024;
constexpr size_t WS_END = 540 * MiB;
static_assert(WS_YB + (size_t)NSLOT * 1024 * 2 <= WS_END && WS_AO + (size_t)TT * 1024 * 2 <= WS_END, "ws map");
constexpr int CW_CNT = 256;
constexpr int CW_BAR = 16384;

constexpr int RING_BYTES = 131072;
constexpr int RW_BYTES = 73728;
constexpr int LDS_MISC = 2 * RW_BYTES;
constexpr int LDS_TAB = LDS_MISC + 256;
constexpr int LDS_BYTES = 163840;

__device__ __forceinline__ unsigned pk2(float lo, float hi) { f32x2 v = {lo, hi}; bf16x2_t b = __builtin_convertvector(v, bf16x2_t); return __builtin_bit_cast(unsigned, b); }
__device__ __forceinline__ unsigned pk4_fp8(float a, float b, float c, float d) { int t = __builtin_amdgcn_cvt_pk_fp8_f32(a, b, 0, false); t = __builtin_amdgcn_cvt_pk_fp8_f32(c, d, t, true); return (unsigned)t; }
constexpr float W8_SCALE = 32.f, W8_INV = 1.f / 32.f;
__device__ __forceinline__ float bflo(unsigned w) { return __uint_as_float(w << 16); }
__device__ __forceinline__ float bfhi(unsigned w) { return __uint_as_float(w & 0xffff0000u); }
__device__ __forceinline__ float bf2f(bf16_t h) { return __uint_as_float((unsigned)h << 16); }
__device__ __forceinline__ float wave_sum(float v) {
#pragma unroll
    for (int o = 1; o < 64; o <<= 1) v += __shfl_xor(v, o);
    return v;
}
__device__ __forceinline__ float sigmoidf_(float v) { return 1.f / (1.f + __expf(-v)); }

#define XB_TMO      128
#define XB_XCNT(j)  (256  + 64 * (j))
#define XB_XSUB(j)  (1280 + 64 * (j))
#define XB_XGEN(j)  (2304 + 64 * (j))
#define XB_TOP      3328
#define XB_TOPGEN   3392
#define XCD_BAR_WORDS 3456
#define XB_SPIN_CAP (1u << 18)
__device__ __forceinline__ unsigned xb_ld(unsigned* p)              { return __hip_atomic_load(p, __ATOMIC_RELAXED, __HIP_MEMORY_SCOPE_AGENT); }
__device__ __forceinline__ unsigned xb_add(unsigned* p, unsigned v) { return __hip_atomic_fetch_add(p, v, __ATOMIC_RELAXED, __HIP_MEMORY_SCOPE_AGENT); }
__device__ __forceinline__ unsigned xb_xcc_id() { return (unsigned)__builtin_amdgcn_s_getreg((3 << 11) | 20) & 0xFu; }
#define XB_SPIN(cond, bar) do { unsigned _sp = 0; while (cond) { __builtin_amdgcn_s_sleep(1); \
    if ((++_sp & 255u) == 0u) { if (xb_ld(&(bar)[XB_TMO])) break; if (_sp > XB_SPIN_CAP) { atomicAdd(&(bar)[XB_TMO], 1u); break; } } } } while (0)
struct XcdBarrier { unsigned* bar; unsigned x; volatile LAS unsigned* st; };
__device__ __forceinline__ XcdBarrier xcd_barrier_post(unsigned* bar, volatile LAS unsigned* st) {
    XcdBarrier b; b.bar = bar; b.x = xb_xcc_id(); b.st = st;
    if (threadIdx.x == 0) (void)xb_add(&bar[XB_XCNT(b.x)], 1u);
    return b;
}
__device__ __forceinline__ void xcd_barrier_complete(unsigned* bar, unsigned x, unsigned& nloc, unsigned& nx) {
    const unsigned G = gridDim.x * gridDim.y * gridDim.z;
    unsigned sum, cnt, mine, sp = 0u;
    for (;;) {
        sum = 0u; cnt = 0u; mine = 0u;
#pragma unroll
        for (unsigned j = 0; j < 16; ++j) { const unsigned c = xb_ld(&bar[XB_XCNT(j)]); sum += c; cnt += (c > 0u) ? 1u : 0u; mine = (j == x) ? c : mine; }
        if (sum == G) break;
        __builtin_amdgcn_s_sleep(1);
        if ((++sp & 255u) == 0u) { if (xb_ld(&bar[XB_TMO])) break; if (sp > XB_SPIN_CAP) { atomicAdd(&bar[XB_TMO], 1u); break; } }
    }
    nloc = mine > 0u ? mine : 1u; nx = cnt > 0u ? cnt : 1u;
}
__device__ __forceinline__ void xcd_barrier(const XcdBarrier& b) {
    asm volatile("s_waitcnt vmcnt(0)" ::: "memory");
    __syncthreads();
    if (threadIdx.x == 0) {
        unsigned* bar = b.bar;
        __builtin_amdgcn_s_waitcnt(0);
        unsigned nloc = b.st[0], nx = b.st[1];
        if (nloc == 0u) { xcd_barrier_complete(bar, b.x, nloc, nx); b.st[0] = nloc; b.st[1] = nx; }
        const unsigned old = xb_add(&bar[XB_XSUB(b.x)], 1u);
        const unsigned gen = old / nloc;
        if (old + 1u == (gen + 1u) * nloc) {
            __builtin_amdgcn_fence(__ATOMIC_RELEASE, "agent");
            asm volatile("s_waitcnt vmcnt(0)" ::: "memory");
            const unsigned og = xb_add(&bar[XB_TOP], 1u);
            const unsigned tg = og / nx;
            if (og + 1u == (tg + 1u) * nx) xb_add(&bar[XB_TOPGEN], 1u);
            else XB_SPIN(xb_ld(&bar[XB_TOPGEN]) == tg, bar);
            __builtin_amdgcn_fence(__ATOMIC_ACQUIRE, "agent");
            xb_add(&bar[XB_XGEN(b.x)], 1u);
            asm volatile("s_waitcnt vmcnt(0)" ::: "memory");
        } else {
            XB_SPIN(xb_ld(&bar[XB_XGEN(b.x)]) == gen, bar);
            __builtin_amdgcn_fence(__ATOMIC_ACQUIRE, "agent");
            asm volatile("s_waitcnt vmcnt(0)" ::: "memory");
        }
    }
    __syncthreads();
}

struct Params { const float* in[30]; float* out; unsigned char* ws; int ph_lo, ph_hi; };
struct Frame {
    LAS unsigned char* lds;
    const float* const* in;
    float* out; unsigned char* ws;
    int tid, lane, wave, vcu, G;
    __device__ __forceinline__ const float* mod(int l, int r, int chunk) const { return (const float*)(ws + WS_MOD) + ((size_t)(l * 9 + r) * 6144 + chunk * 1024); }
    __device__ __forceinline__ bf16_t* xr_row(int row) const { return (bf16_t*)(ws + WS_XR) + (size_t)row * DM; }
    __device__ __forceinline__ bf16_t* hx() const { return (bf16_t*)out; }
    __device__ __forceinline__ const float* xin_row(int row) const { return row < TX ? in[I_X] + (size_t)row * DM : in[I_CTX] + (size_t)(row - TX) * DM; }
    __device__ __forceinline__ unsigned* cnt(int l) const { return (unsigned*)(ws + WS_CTL) + CW_CNT + l * 32 * 64; }
};
__device__ __forceinline__ int modrow(int row) { return row < TX ? (row >> 12) : 8; }

__device__ __forceinline__ void p0_mod_item(const Frame& F, int item) {
    const int l = item / 96, cg = item % 96;
    LAS float* sc = (LAS float*)F.lds;
    LAS float* red = sc + 9 * 1024;
    for (int i = F.tid; i < 9 * 1024; i += NTHREADS) { const int r = i >> 10, k = i & 1023; const float v = r < 8 ? F.in[I_C][r * 1024 + k] : F.in[I_CCTX][k]; sc[i] = v / (1.f + expf(-v)); }
    __syncthreads();
    const float* W = F.in[I_MODW] + (size_t)l * 1024 * 6144 + cg * 64 + F.lane;
    float acc[9];
#pragma unroll
    for (int r = 0; r < 9; ++r) acc[r] = 0.f;
    for (int kb = 0; kb < 128; kb += 32) { float w[32];
#pragma unroll
        for (int kk = 0; kk < 32; ++kk) w[kk] = W[(size_t)(F.wave * 128 + kb + kk) * 6144];
#pragma unroll
        for (int kk = 0; kk < 32; ++kk) { const int k = F.wave * 128 + kb + kk;
#pragma unroll
            for (int r = 0; r < 9; ++r) acc[r] += sc[r * 1024 + k] * w[kk]; } }
#pragma unroll
    for (int r = 0; r < 9; ++r) red[(F.wave * 9 + r) * 64 + F.lane] = acc[r];
    __syncthreads();
    for (int i = F.tid; i < 9 * 64; i += NTHREADS) { const int r = i >> 6, ln = i & 63; float s = 0.f;
#pragma unroll
        for (int w = 0; w < 8; ++w) s += red[(w * 9 + r) * 64 + ln];
        ((float*)(F.ws + WS_MOD))[(size_t)(l * 9 + r) * 6144 + cg * 64 + ln] = s + F.in[I_MODB][l * 6144 + cg * 64 + ln]; }
    __syncthreads();
}
struct TDesc { const float* src; unsigned char* dst; int ldw; bool fp8; };
__device__ __forceinline__ void t_load(const TDesc& d, f32x4 (&v)[16], int lane) {
    const int sh = d.fp8 ? 3 : 4, kr = lane >> sh, nq = lane & ((1 << sh) - 1), rs = 64 >> sh;
#pragma unroll
    for (int i = 0; i < 16; ++i) v[i] = *(const f32x4*)(d.src + (size_t)(rs * i + kr) * d.ldw + 4 * nq);
}
__device__ __forceinline__ void t_finish(const TDesc& d, const f32x4 (&v)[16], LAS float* scr, int lane) {
    if (!d.fp8) {
        const int kr = lane >> 4, nq = lane & 15;
#pragma unroll
        for (int i = 0; i < 16; ++i) { LAS float* s = scr + (4 * i + kr) * 65 + 4 * nq; s[0] = v[i][0]; s[1] = v[i][1]; s[2] = v[i][2]; s[3] = v[i][3]; }
        asm volatile("s_waitcnt lgkmcnt(0)" ::: "memory");
        const int c = lane & 7;
#pragma unroll
        for (int j = 0; j < 8; ++j) { const int n = (lane >> 3) + 8 * j; const LAS float* s = scr + (8 * c) * 65 + n;
            u32x4 o; o.x = pk2(s[0 * 65], s[1 * 65]); o.y = pk2(s[2 * 65], s[3 * 65]); o.z = pk2(s[4 * 65], s[5 * 65]); o.w = pk2(s[6 * 65], s[7 * 65]);
            *(u32x4*)(d.dst + ((size_t)n * 64 + 8 * c) * 2) = o; }
    } else {
        const int kr = lane >> 3, nq = lane & 7;
#pragma unroll
        for (int i = 0; i < 16; ++i) { LAS float* s = scr + (8 * i + kr) * 33 + 4 * nq; s[0] = v[i][0]; s[1] = v[i][1]; s[2] = v[i][2]; s[3] = v[i][3]; }
        asm volatile("s_waitcnt lgkmcnt(0)" ::: "memory");
        const int c = lane & 7;
#pragma unroll
        for (int j = 0; j < 4; ++j) { const int n = (lane >> 3) + 8 * j; const LAS float* s = scr + (16 * c) * 33 + n;
            u32x4 o;
            o.x = pk4_fp8(s[0 * 33] * W8_SCALE, s[1 * 33] * W8_SCALE, s[2 * 33] * W8_SCALE, s[3 * 33] * W8_SCALE); o.y = pk4_fp8(s[4 * 33] * W8_SCALE, s[5 * 33] * W8_SCALE, s[6 * 33] * W8_SCALE, s[7 * 33] * W8_SCALE);
            o.z = pk4_fp8(s[8 * 33] * W8_SCALE, s[9 * 33] * W8_SCALE, s[10 * 33] * W8_SCALE, s[11 * 33] * W8_SCALE); o.w = pk4_fp8(s[12 * 33] * W8_SCALE, s[13 * 33] * W8_SCALE, s[14 * 33] * W8_SCALE, s[15 * 33] * W8_SCALE);
            *(u32x4*)(d.dst + (size_t)n * 128 + 16 * c) = o; }
    }
    asm volatile("s_waitcnt lgkmcnt(0)" ::: "memory");
}
constexpr int TN_AB = 16 * 28, TN_OAB = 16 * 16, TN_CD = 16 * 20, TN_OCD = 8 * 16, TN_G = 64 * 128, TN_U = 64 * 128, TN_D = 64 * 128;
constexpr int TN_ITEMS = TN_AB + TN_OAB + TN_CD + TN_OCD + TN_G + TN_U + TN_D;
__device__ __forceinline__ TDesc t_decode(const Frame& F, int it) {
    TDesc d; d.fp8 = false; int r = it;
    if (r < TN_AB) { const int kb = r / 28, nb = r % 28, n0 = nb * 64; int d0;
        if (n0 < 768) d0 = n0; else if (n0 < 1280) { const int j = n0 - 768; d0 = 768 + (j >> 7) * 256 + (j & 127); } else { const int j = n0 - 1280; d0 = 768 + (j >> 7) * 256 + 128 + (j & 127); }
        d.src = F.in[I_WINAB] + (size_t)kb * 64 * 1792 + n0; d.ldw = 1792; d.dst = F.ws + WS_WINAB + ((size_t)kb * 1792 + d0) * 128; return d; } r -= TN_AB;
    if (r < TN_OAB) { const int kb = r / 16, nb = r % 16; d.src = F.in[I_WOUTAB] + (size_t)kb * 64 * 1024 + nb * 64; d.ldw = 1024; d.dst = F.ws + WS_WOUTAB + ((size_t)kb * 1024 + nb * 64) * 128; return d; } r -= TN_OAB;
    if (r < TN_CD) { const int kb = r / 20, nb = r % 20; d.src = F.in[I_WINCD] + (size_t)kb * 64 * 1280 + nb * 64; d.ldw = 1280; d.dst = F.ws + WS_WINCD + ((size_t)kb * 1280 + nb * 64) * 128; return d; } r -= TN_CD;
    if (r < TN_OCD) { const int kb = r / 16, nb = r % 16; d.src = F.in[I_WOUTCD] + (size_t)kb * 64 * 1024 + nb * 64; d.ldw = 1024; d.dst = F.ws + WS_WOUTCD + ((size_t)kb * 1024 + nb * 64) * 128; return d; } r -= TN_OCD;
    if (r < TN_G + TN_U) { const bool up = r >= TN_G; if (up) r -= TN_G; const int le = r >> 7, q = r & 127;
        const float* base = F.in[up ? I_EXU : I_EXG] + (size_t)le * 1024 * 512; unsigned char* wb = F.ws + WS_WGU + (size_t)le * 1024 * 1024 * 2;
        if ((le >> 5) ? FP8_G1_L1 : FP8_G1_L0) { const int kb = q >> 4, n0 = (q & 15) * 32, d0 = (n0 >> 7) * 256 + (up ? 128 : 0) + (n0 & 127);
            d.fp8 = true; d.src = base + (size_t)kb * 128 * 512 + n0; d.ldw = 512; d.dst = wb + ((size_t)kb * 1024 + d0) * 128; return d; }
        const int kb = q >> 3, n0 = (q & 7) * 64, d0 = (n0 >> 7) * 256 + (up ? 128 : 0) + (n0 & 127);
        d.src = base + (size_t)kb * 64 * 512 + n0; d.ldw = 512; d.dst = wb + ((size_t)kb * 1024 + d0) * 128; return d; } r -= TN_G + TN_U;
    { const int le = r >> 7, q = r & 127; const float* base = F.in[I_EXD] + (size_t)le * 512 * 1024; unsigned char* wb = F.ws + WS_WD + (size_t)le * 1024 * 512 * 2;
        if ((le >> 5) ? FP8_G2_L1 : FP8_G2_L0) { const int kb = q >> 5, nb = q & 31;
            d.fp8 = true; d.src = base + (size_t)kb * 128 * 1024 + nb * 32; d.ldw = 1024; d.dst = wb + ((size_t)kb * 1024 + nb * 32) * 128; return d; }
        const int kb = q >> 4, nb = q & 15;
        d.src = base + (size_t)kb * 64 * 1024 + nb * 64; d.ldw = 1024; d.dst = wb + ((size_t)kb * 1024 + nb * 64) * 128; return d; }
}
constexpr int TN_DENSE = TN_AB + TN_OAB + TN_CD + TN_OCD;
__device__ __forceinline__ void transpose_range(const Frame& F, int lo, int hi, int w, int nw) {
    LAS float* scr = (LAS float*)(F.lds + F.wave * 16896);
    f32x4 va[16], vb[16]; TDesc da, db;
    const int first = lo + w;
    if (first < hi) { da = t_decode(F, first); t_load(da, va, F.lane); }
    for (int it = first; it < hi; it += 2 * nw) {
        const int it2 = it + nw, it3 = it + 2 * nw;
        if (it2 < hi) { db = t_decode(F, it2); t_load(db, vb, F.lane); }
        t_finish(da, va, scr, F.lane);
        if (it3 < hi) { da = t_decode(F, it3); t_load(da, va, F.lane); }
        if (it2 < hi) t_finish(db, vb, scr, F.lane);
    }
}
__device__ __forceinline__ void p0_prologue(const Frame& F) { for (int it = F.vcu; it < 192; it += F.G) p0_mod_item(F, it); }
__device__ __forceinline__ void p0_misc(const Frame& F) {
    const int gw = F.vcu * NWAVES + F.wave, NGW = F.G * NWAVES;
    const int gt = gw * 64 + F.lane, NGT = NGW * 64;
    { float* rc = (float*)(F.ws + WS_ROPE); float* rs = rc + SEQ * 32;
      for (int i = gt; i < SEQ * 32; i += NGT) { const int s = i >> 5, d = i & 31, f = d & 15; const float pos = (float)(d < 16 ? (s >> 6) : (s & 63));
          const float inv = exp2f(-(float)f * (13.287712379549449f / 16.f)); const float a = pos * inv; rc[i] = cosf(a); rs[i] = sinf(a); } }
    { typedef float f32x16_t __attribute__((ext_vector_type(16)));
      bf16_t* WT = (bf16_t*)(F.ws + WS_WOUTCD); const int l31 = F.lane & 31, lh = F.lane >> 5;
      for (int it = gw; it < 4 * 32 * 4; it += NGW) { const int g = it >> 7, dt = (it >> 2) & 31, ct = it & 3;
          const float* wo = F.in[I_WOUTCD] + (size_t)(512 + g * 128 + lh) * 1024 + dt * 32 + l31;
          const float* pw = F.in[I_POOLW] + (size_t)(g * 128 + ct * 32 + l31) * 128 + lh; const float* ps = F.in[I_POOLS] + g * 128 + lh;
          f32x16_t acc;
#pragma unroll
          for (int r = 0; r < 16; ++r) acc[r] = 0.f;
          for (int dp0 = 0; dp0 < 128; dp0 += 16) { float av[8], bv[8];
#pragma unroll
              for (int u = 0; u < 8; ++u) { av[u] = wo[(size_t)(dp0 + 2 * u) * 1024]; bv[u] = pw[dp0 + 2 * u] * ps[dp0 + 2 * u]; }
#pragma unroll
              for (int u = 0; u < 8; ++u) acc = __builtin_amdgcn_mfma_f32_32x32x2f32(av[u], bv[u], acc, 0, 0, 0); }
#pragma unroll
          for (int r = 0; r < 16; ++r) { const int i = (r & 3) + 8 * (r >> 2) + 4 * lh; const int k_ = 512 + g * 128 + ct * 32 + l31; WT[((size_t)(k_ >> 6) * 1024 + dt * 32 + i) * 64 + (k_ & 63)] = (bf16_t)(pk2(acc[r], 0.f) & 0xffffu); } } }
    { bf16_t* WR = (bf16_t*)(F.ws + WS_WR);
      for (int i = gt; i < 2 * 32 * 144 * 8; i += NGT) { const int j = i & 7, e16 = (i >> 3) % 144, s_ = (i / (8 * 144)) & 31, l = i / (8 * 144 * 32);
          int col; bool grp = false; int c;
          if (e16 < 128) { const int lane_ = e16 & 63, row = lane_ & 15; c = lane_ >> 4; col = 8 * (row >> 2) + (e16 < 64 ? 0 : 4) + (row & 3); }
          else { const int q = e16 - 128; c = q & 3; col = q >> 2; grp = true; }
          const int k = 32 * s_ + 8 * c + j;
          const float w = grp ? F.in[I_RGW][(size_t)l * 4096 + k * 4 + col] : F.in[I_REW][(size_t)l * 32768 + k * 32 + col];
          const unsigned hi = pk2(w, 0.f) & 0xffffu; const unsigned lo = pk2(w - bflo(hi), 0.f) & 0xffffu;
          const size_t o = (size_t)s_ * 1152 + (size_t)e16 * 8 + j;
          WR[(size_t)(l * 2 + 0) * 36864 + o] = (bf16_t)hi; WR[(size_t)(l * 2 + 1) * 36864 + o] = (bf16_t)lo; } }
    transpose_range(F, 0, F.G == 256 ? TN_DENSE : TN_ITEMS, gw, NGW);
}

__device__ __forceinline__ void norm_mod_row(const float* xrow, const float* g, const float* sh, const float* sc, int lane, f32x4 (&h)[4]) {
    f32x4 v[4]; float ss = 0.f;
#pragma unroll
    for (int j = 0; j < 4; ++j) { v[j] = *(const f32x4*)(xrow + 4 * lane + 256 * j); ss += (v[j][0] * v[j][0] + v[j][1] * v[j][1]) + (v[j][2] * v[j][2] + v[j][3] * v[j][3]); }
    const float rms = 1.0f / sqrtf(wave_sum(ss) * (1.f / 1024.f) + EPS);
#pragma unroll
    for (int j = 0; j < 4; ++j) { const int c = 4 * lane + 256 * j; const f32x4 gg = *(const f32x4*)(g + c), s1 = *(const f32x4*)(sc + c), s0 = *(const f32x4*)(sh + c);
        h[j] = (v[j] * rms * gg) * (1.f + s1) + s0; }
}
__device__ __forceinline__ void store_row_bf16(bf16_t* orow, int lane, const f32x4 (&h)[4]) {
#pragma unroll
    for (int j = 0; j < 4; ++j) { u32x2 o; o.x = pk2(h[j][0], h[j][1]); o.y = pk2(h[j][2], h[j][3]); *(u32x2*)(orow + 4 * lane + 256 * j) = o; }
}
struct RowBuf { f32x4 v[4]; };
__device__ __forceinline__ void row_load(RowBuf& b, const float* xrow, int lane) {
#pragma unroll
    for (int j = 0; j < 4; ++j) b.v[j] = *(const f32x4*)(xrow + 4 * lane + 256 * j);
}
__device__ __forceinline__ void row_norm_store(const RowBuf& b, const float* g, const float* sh, const float* sc, bf16_t* orow, int lane) {
    float ss = 0.f;
#pragma unroll
    for (int j = 0; j < 4; ++j) ss += (b.v[j][0] * b.v[j][0] + b.v[j][1] * b.v[j][1]) + (b.v[j][2] * b.v[j][2] + b.v[j][3] * b.v[j][3]);
    const float rms = 1.0f / sqrtf(wave_sum(ss) * (1.f / 1024.f) + EPS);
    f32x4 h[4];
#pragma unroll
    for (int j = 0; j < 4; ++j) { const int c = 4 * lane + 256 * j; h[j] = (b.v[j] * rms * *(const f32x4*)(g + c)) * (1.f + *(const f32x4*)(sc + c)) + *(const f32x4*)(sh + c); }
    store_row_bf16(orow, lane, h);
}
__device__ __forceinline__ void p_norm1_l0(const Frame& F) {
    const int gw = F.vcu * NWAVES + F.wave, NGW = F.G * NWAVES;
    { float* GP = (float*)(F.ws + WS_GP);
      for (int i = gw * 64 + F.lane; i < 2 * 9 * 1024; i += NGW * 64) { const int k = i & 1023, lr = i >> 10; GP[i] = F.in[I_LN2][(lr / 9) * 1024 + k] * (1.f + F.mod(lr / 9, lr % 9, 4)[k]); } }
    bf16_t* HX = F.hx();
    RowBuf A, B;
    if (gw < TT) row_load(A, F.xin_row(gw), F.lane);
    for (int row = gw; row < TT; row += 2 * NGW) {
        const int row2 = row + NGW, row3 = row + 2 * NGW;
        if (row2 < TT) row_load(B, F.xin_row(row2), F.lane);
        { const int r = modrow(row); row_norm_store(A, F.in[I_LN1], F.mod(0, r, 0), F.mod(0, r, 1), HX + (size_t)row * DM, F.lane); }
        if (row3 < TT) row_load(A, F.xin_row(row3), F.lane);
        if (row2 < TT) { const int r = modrow(row2); row_norm_store(B, F.in[I_LN1], F.mod(0, r, 0), F.mod(0, r, 1), HX + (size_t)row2 * DM, F.lane); }
    }
}

struct Unit { int pm, pn, e; };
struct SchedDense {
    const bf16_t* Bt; int K, nMa, nN, nMb, pnb, vcu, G;
    __device__ __forceinline__ bool next(int i, Unit& u) const { int L = i * G + vcu; const int na = nMa * nN; u.e = 0;
        if (L < na) { u.pm = L / nN; u.pn = L % nN; return true; } L -= na; if (L < nMb) { u.pm = nMa + L; u.pn = pnb; return true; } return false; }
    __device__ __forceinline__ int arow(const Unit& u, int r) const { return u.pm * 256 + r; }
    __device__ __forceinline__ const bf16_t* bbase(const Unit& u) const { return Bt + (size_t)u.pn * 256 * 64; }
    __device__ __forceinline__ int brows() const { return nN * 256; }
};
struct MoeTab { const LAS int* tile_e; const LAS int* tile0; const LAS int* cnt; int ntiles; };
struct SchedMoe {
    const bf16_t* Wt; size_t estride; int tsh; MoeTab tb; const unsigned* list; bool gather; int vcu, G;
    __device__ __forceinline__ bool next(int i, Unit& u) const { const int L = i * G + vcu; if (L >= tb.ntiles * 4) return false; u.pm = L >> 2; u.pn = L & 3; u.e = tb.tile_e[u.pm]; return true; }
    __device__ __forceinline__ int arow(const Unit& u, int r) const {
        if (!gather) return (u.pm << tsh) + r;
        int idx = ((u.pm - tb.tile0[u.e]) << tsh) + r; const int c = tb.cnt[u.e]; idx = idx < c ? idx : c - 1;
        return (int)list[(size_t)u.e * TT + idx]; }
    __device__ __forceinline__ const bf16_t* bbase(const Unit& u) const { return Wt + (size_t)u.e * estride + (size_t)u.pn * 256 * 64; }
    __device__ __forceinline__ int brows() const { return 1024; }
};
__device__ __forceinline__ MoeTab moe_tables(const Frame& F, int l, int tsh) {
    LAS int* tile_e = (LAS int*)(F.lds + LDS_TAB); LAS int* tile0 = tile_e + NTILE_MAX; LAS int* cntl = tile0 + 33; LAS int* nt = cntl + 32;
    __syncthreads();
    if (F.tid < 64) {
        const int e = F.lane & 31; unsigned* cg = F.cnt(l);
        const int c = (int)__hip_atomic_load(cg + e * 64, __ATOMIC_RELAXED, __HIP_MEMORY_SCOPE_AGENT); const int n = (c + (1 << tsh) - 1) >> tsh;
        int incl = n;
#pragma unroll
        for (int o = 1; o < 32; o <<= 1) { const int v = __shfl_up(incl, o, 32); if (e >= o) incl += v; }
        const int t0 = incl - n;
        if (F.lane < 32) { tile0[e] = t0; cntl[e] = c; for (int j = 0; j < n; ++j) tile_e[t0 + j] = e; if (e == 31) { tile0[32] = incl; nt[0] = incl; } }
    }
    __syncthreads();
    MoeTab tb; tb.tile_e = tile_e; tb.tile0 = tile0; tb.cnt = cntl; tb.ntiles = nt[0]; return tb;
}

namespace pg8 {
constexpr int BM = 256, BK = 64, HALF = 128, HTB = HALF * BK * 2;
__device__ __forceinline__ int lds_byte(int r, int c) { const int st = (r >> 4) * 2 + (c >> 5), rr = r & 15, cc = c & 31, ob = rr * 64 + cc * 2; return st * 1024 + (ob ^ (((ob >> 9) & 1) << 5)); }
__device__ __forceinline__ void stage_rc(int b, int& R, int& C) { const int st = b / 1024, sb = b % 1024, swz = sb ^ (((sb >> 9) & 1) << 5); R = (st >> 1) * 16 + swz / 64; C = (st & 1) * 32 + (swz % 64) / 2; }
__device__ __forceinline__ int perm32(int rho) { const int n = rho >> 4, i = rho & 15; return 8 * (i >> 2) + 4 * n + (i & 3); }
}
typedef int v8i_t __attribute__((ext_vector_type(8)));
typedef int v4i_t __attribute__((ext_vector_type(4)));
__device__ __forceinline__ v8i_t frag32(bf16x8 lo, bf16x8 hi) { return __builtin_shufflevector(__builtin_bit_cast(v4i_t, lo), __builtin_bit_cast(v4i_t, hi), 0, 1, 2, 3, 4, 5, 6, 7); }
template <bool ALIGN_EPI, bool FP8, bool HALFM, class Sched, class Epi>
__device__ __forceinline__ void gemm_fast(const Frame& F, const void* A, int KB, const Sched& S, const Epi& E) {
    using namespace pg8;
    LAS unsigned char* lds = F.lds;
    const int tid = F.tid, wid = F.wave, lane = F.lane, wr = wid >> 2, wc = wid & 3, fr = lane & 15, fq = lane >> 4;
    const int nt = KB / (BK * 2);
    unsigned voffB[2];
#pragma unroll
    for (int i = 0; i < 2; ++i) { int R, C; stage_rc(tid * 16 + i * 8192, R, C); const int Rb = (R & ~31) + perm32(R & 31); voffB[i] = (unsigned)(Rb * 64 + C) * 2u; }
    const size_t kstep = (size_t)(BK * 2);
    const size_t kstepB = (size_t)S.brows() * BK * 2;
    const size_t hstep = (size_t)HALF * BK * 2;
    const unsigned ldsw = (unsigned)wid * 1024u;
    const int aoff = lds_byte(wr * 64 + fr, fq * (FP8 ? 16 : 8)), boff = lds_byte(wc * 32 + fr, fq * (FP8 ? 16 : 8));
    const char* Ab = (const char*)A;
#define PG8_SA(b, h) (((b) * 2 + (h)) * HTB)
#define PG8_SB(b, h) ((4 + (b) * 2 + (h)) * HTB)
#define PG8_STAGE(bufoff, gbase, voff) do { _Pragma("unroll") for (int _i = 0; _i < 2; ++_i) \
        __builtin_amdgcn_global_load_lds((const unsigned*)((const char*)(gbase) + (voff)[_i]), (LAS unsigned*)(lds + (bufoff) + ldsw + _i * 8192), 16, 0, 0); } while (0)
#define PG8_LD32(p) __builtin_shufflevector(*(const LAS v4i_t*)(p), *(const LAS v4i_t*)((p) + 16), 0, 1, 2, 3, 4, 5, 6, 7)
#define PG8_LDA(dst, b, h) do { if constexpr (FP8) { _Pragma("unroll") for (int m = 0; m < 4; ++m) dst##8[m] = PG8_LD32(lds + PG8_SA(b, h) + aoff + m * 2048); } \
        else { _Pragma("unroll") for (int m = 0; m < 4; ++m) _Pragma("unroll") for (int k = 0; k < 2; ++k) dst[m][k] = *(const LAS bf16x8*)(lds + PG8_SA(b, h) + aoff + m * 2048 + k * 1024); } } while (0)
#define PG8_LDB(dst, b, h) do { if constexpr (FP8) { _Pragma("unroll") for (int n = 0; n < 2; ++n) dst##8[n] = PG8_LD32(lds + PG8_SB(b, h) + boff + n * 2048); } \
        else { _Pragma("unroll") for (int n = 0; n < 2; ++n) _Pragma("unroll") for (int k = 0; k < 2; ++k) dst[n][k] = *(const LAS bf16x8*)(lds + PG8_SB(b, h) + boff + n * 2048 + k * 1024); } } while (0)
#define PG8_MMA(ai, bj, At, Bt) do { __builtin_amdgcn_s_setprio(1); _Pragma("unroll") for (int m = 0; m < 4; ++m) _Pragma("unroll") for (int n = 0; n < 2; ++n) { \
        if constexpr (FP8) acc[ai][bj][m][n] = __builtin_amdgcn_mfma_scale_f32_16x16x128_f8f6f4(Bt##8[n], At##8[m], acc[ai][bj][m][n], 0, 0, 0, 0x7F7F7F7F, 0, 0x7F7F7F7F); \
        else { _Pragma("unroll") for (int k = 0; k < 2; ++k) acc[ai][bj][m][n] = __builtin_amdgcn_mfma_f32_16x16x32_bf16(Bt[n][k], At[m][k], acc[ai][bj][m][n], 0, 0, 0); } } __builtin_amdgcn_s_setprio(0); } while (0)
#define PG8_WAIT_V(n) asm volatile("s_waitcnt vmcnt(" #n ")" ::: "memory")
#define PG8_WAIT_L(n) asm volatile("s_waitcnt lgkmcnt(" #n ")" ::: "memory")
#define PG8_BAR __builtin_amdgcn_s_barrier()
#define PG8_SCHED __builtin_amdgcn_sched_barrier(0)
    LAS unsigned* rtab = (LAS unsigned*)(lds + RING_BYTES);
    unsigned tA[2], cA[2];
#pragma unroll
    for (int i = 0; i < 2; ++i) { int R, C; stage_rc(tid * 16 + i * 8192, R, C); tA[i] = (unsigned)R; cA[i] = (unsigned)(C * 2); }
#define PG8_RFILL(sel, u) do { if (tid < (HALFM ? 128 : 256)) rtab[(sel) * 256 + tid] = (unsigned)S.arow(u, tid) * (unsigned)KB; } while (0)
#define PG8_STAGEA(bufoff, gbase, sel, h) do { _Pragma("unroll") for (int _i = 0; _i < 2; ++_i) { const unsigned vo_ = rtab[(sel) * 256 + (h) * 128 + tA[_i]] + cA[_i]; \
        __builtin_amdgcn_global_load_lds((const unsigned*)((const char*)(gbase) + vo_), (LAS unsigned*)(lds + (bufoff) + ldsw + _i * 8192), 16, 0, 0); } } while (0)
    Unit cur, nxt; int ui = 0;
    if (!S.next(0, cur)) return;
    f32x4 acc[2][2][4][2];
    float zero_ = 0.f; asm volatile("" : "+v"(zero_));
#pragma unroll
    for (int a = 0; a < 2; ++a)
#pragma unroll
        for (int b = 0; b < 2; ++b)
#pragma unroll
            for (int m = 0; m < 4; ++m)
#pragma unroll
                for (int n = 0; n < 2; ++n) acc[a][b][m][n] = (f32x4){zero_, zero_, zero_, zero_};
    bf16x8 At[4][2], B0[2][2], B1[2][2]; v8i_t At8[4], B08[2], B18[2];
    int csel = 0;
    PG8_RFILL(0, cur);
    PG8_WAIT_L(0); PG8_BAR;
    const char* cB = (const char*)S.bbase(cur);
    PG8_STAGE(PG8_SB(0, 0), cB, voffB); PG8_STAGE(PG8_SB(0, 1), cB + hstep, voffB); PG8_STAGEA(PG8_SA(0, 0), Ab, 0, 0); if constexpr (!HALFM) PG8_STAGEA(PG8_SA(0, 1), Ab, 0, 1);
    if (wr == 1) PG8_BAR;
    if constexpr (HALFM) PG8_WAIT_V(0); else PG8_WAIT_V(2);
    PG8_BAR;
    PG8_STAGE(PG8_SB(1, 0), cB + kstepB, voffB); PG8_STAGEA(PG8_SA(1, 0), Ab + kstep, 0, 0); PG8_STAGE(PG8_SB(1, 1), cB + hstep + kstepB, voffB);
    PG8_WAIT_V(6); PG8_BAR;
    for (;;) {
        const bool has_next = S.next(ui + 1, nxt);
        const char* nB = cB;
        if (has_next) { PG8_RFILL(csel ^ 1, nxt); nB = (const char*)S.bbase(nxt); }
        const int nsel = has_next ? (csel ^ 1) : csel;
#pragma unroll 1
        for (int t = 0; t < nt; t += 2) {
            const bool last = (t == nt - 2);
            const char* a1 = Ab + (size_t)(t + 1) * kstep;
            const char* a2 = last ? Ab : Ab + (size_t)(t + 2) * kstep; const char* b2 = last ? nB : cB + (size_t)(t + 2) * kstepB;
            const char* a3 = a2 + kstep; const char* b3 = b2 + kstepB;
            const int sel2 = last ? nsel : csel;
            PG8_LDB(B0, 0, 0); PG8_LDB(B1, 0, 1); PG8_SCHED; PG8_LDA(At, 0, 0); if constexpr (!HALFM) PG8_STAGEA(PG8_SA(1, 1), a1, csel, 1);
            PG8_WAIT_V(8); PG8_WAIT_L(0); PG8_BAR; PG8_MMA(0, 0, At, B0); PG8_MMA(0, 1, At, B1); PG8_BAR; PG8_SCHED;
            if constexpr (!HALFM) PG8_LDA(At, 0, 1);
            PG8_STAGE(PG8_SB(0, 0), b2, voffB); PG8_STAGE(PG8_SB(0, 1), b2 + hstep, voffB); PG8_STAGEA(PG8_SA(0, 0), a2, sel2, 0);
            if constexpr (HALFM) PG8_WAIT_V(6); else PG8_WAIT_V(8);
            PG8_WAIT_L(0); PG8_BAR; if constexpr (!HALFM) { PG8_MMA(1, 0, At, B0); PG8_MMA(1, 1, At, B1); } PG8_BAR; PG8_SCHED;
            PG8_LDB(B0, 1, 0); PG8_LDB(B1, 1, 1); PG8_SCHED; PG8_LDA(At, 1, 0); if constexpr (!HALFM) PG8_STAGEA(PG8_SA(0, 1), a2, sel2, 1);
            PG8_WAIT_V(8); PG8_WAIT_L(0); PG8_BAR; PG8_MMA(0, 0, At, B0); PG8_MMA(0, 1, At, B1); PG8_BAR; PG8_SCHED;
            if constexpr (!HALFM) PG8_LDA(At, 1, 1);
            PG8_STAGE(PG8_SB(1, 0), b3, voffB); PG8_STAGE(PG8_SB(1, 1), b3 + hstep, voffB); PG8_STAGEA(PG8_SA(1, 0), a3, sel2, 0);
            if constexpr (HALFM) PG8_WAIT_V(6); else PG8_WAIT_V(8);
            PG8_WAIT_L(0); PG8_BAR; if constexpr (!HALFM) { PG8_MMA(1, 0, At, B0); PG8_MMA(1, 1, At, B1); } PG8_BAR; PG8_SCHED;
        }
        if (ALIGN_EPI) { if (wr == 0) PG8_BAR; }
        E(acc, cur, wr, wc, fr, fq);
        if (!has_next) break;
        asm volatile("" : "+v"(zero_));
#pragma unroll
        for (int a = 0; a < 2; ++a)
#pragma unroll
            for (int b = 0; b < 2; ++b)
#pragma unroll
                for (int m = 0; m < 4; ++m)
#pragma unroll
                    for (int n = 0; n < 2; ++n) acc[a][b][m][n] = (f32x4){zero_, zero_, zero_, zero_};
        cur = nxt; cB = nB; ++ui; csel = nsel;
        if (ALIGN_EPI) { if (wr == 1) PG8_BAR; }
    }
    PG8_WAIT_V(0);
    if (!ALIGN_EPI) { if (wr == 0) PG8_BAR; }
    PG8_BAR;
#undef PG8_RFILL
#undef PG8_STAGEA
#undef PG8_SA
#undef PG8_SB
#undef PG8_STAGE
#undef PG8_LD32
#undef PG8_LDA
#undef PG8_LDB
#undef PG8_MMA
#undef PG8_WAIT_V
#undef PG8_WAIT_L
#undef PG8_BAR
#undef PG8_SCHED
}
template <class Sched, class Epi>
__device__ __forceinline__ void gemm_fp8_h3(const Frame& F, const void* A, int KB, const Sched& S, const Epi& E) {
    using namespace pg8;
    LAS unsigned char* lds = F.lds;
    const int tid = F.tid, wid = F.wave, lane = F.lane, wr = wid >> 2, wc = wid & 3, fr = lane & 15, fq = lane >> 4;
#ifdef PROBE_KREP
    const int ntk = KB / 128, nt = 2 * ntk;
#else
    const int ntk = KB / 128, nt = ntk;
#endif
    constexpr int BUF = 49152, RTAB_OFF = LDS_TAB + 2048 + 8192 + 256;
    unsigned voffB[2], tA[2], cA[2];
#pragma unroll
    for (int i = 0; i < 2; ++i) { int R, C; stage_rc(tid * 16 + i * 8192, R, C); const int Rb = (R & ~31) + perm32(R & 31); voffB[i] = (unsigned)(Rb * 64 + C) * 2u; tA[i] = (unsigned)R; cA[i] = (unsigned)(C * 2); }
    const size_t kstepB = (size_t)S.brows() * 128, hstep = (size_t)128 * 128;
    const unsigned ldsw = (unsigned)wid * 1024u;
    const int aoff = lds_byte(wr * 64 + fr, fq * 16), boff = lds_byte(wc * 32 + fr, fq * 16);
    const char* Ab = (const char*)A;
    LAS unsigned* rtab = (LAS unsigned*)(lds + RTAB_OFF);
#define H3_RFILL(sel, u) do { if (tid < 128) rtab[(sel) * 128 + tid] = (unsigned)S.arow(u, tid) * (unsigned)KB; } while (0)
#define H3_STAGE(bo, gbase, voff) do { _Pragma("unroll") for (int _i = 0; _i < 2; ++_i) \
        __builtin_amdgcn_global_load_lds((const unsigned*)((const char*)(gbase) + (voff)[_i]), (LAS unsigned*)(lds + (bo) + ldsw + _i * 8192), 16, 0, 0); } while (0)
#define H3_STAGEA(bo, gbase, sel) do { _Pragma("unroll") for (int _i = 0; _i < 2; ++_i) { const unsigned vo_ = rtab[(sel) * 128 + tA[_i]] + cA[_i]; \
        __builtin_amdgcn_global_load_lds((const unsigned*)((const char*)(gbase) + vo_), (LAS unsigned*)(lds + (bo) + 32768 + ldsw + _i * 8192), 16, 0, 0); } } while (0)
#define H3_LD32(p) __builtin_shufflevector(*(const LAS v4i_t*)(p), *(const LAS v4i_t*)((p) + 16), 0, 1, 2, 3, 4, 5, 6, 7)
#define H3_TILE(bo, bptr, aptr, sel) do { H3_STAGE((bo), (bptr), voffB); H3_STAGE((bo) + 16384, (bptr) + hstep, voffB); H3_STAGEA((bo), (aptr), (sel)); } while (0)
#define H3_BAR __builtin_amdgcn_s_barrier()
    Unit cur, nxt; int ui = 0;
    if (!S.next(0, cur)) return;
    f32x4 acc[2][4][2];
    float zero_ = 0.f; asm volatile("" : "+v"(zero_));
#pragma unroll
    for (int b = 0; b < 2; ++b)
#pragma unroll
        for (int m = 0; m < 4; ++m)
#pragma unroll
            for (int n = 0; n < 2; ++n) acc[b][m][n] = (f32x4){zero_, zero_, zero_, zero_};
    v8i_t At8[4], B08[2], B18[2];
    int csel = 0;
    H3_RFILL(0, cur);
    asm volatile("s_waitcnt lgkmcnt(0)" ::: "memory"); H3_BAR;
    const char* cB = (const char*)S.bbase(cur);
    int o0 = 0, o1 = BUF, o2 = 2 * BUF;
    H3_TILE(o0, cB, Ab, 0); H3_TILE(o1, cB + kstepB, Ab + 128, 0);
    asm volatile("s_waitcnt vmcnt(6)" ::: "memory"); H3_BAR;
    if (wr == 1) H3_BAR;
    for (;;) {
        const bool has_next = S.next(ui + 1, nxt);
        const char* nB = cB;
        unsigned nrow = 0u;
        if (has_next) { if (tid < 128) nrow = (unsigned)S.arow(nxt, tid) * (unsigned)KB; nB = (const char*)S.bbase(nxt); }
        const int nsel = has_next ? (csel ^ 1) : csel;
#pragma unroll 1
        for (int t = 0; t < nt; ++t) {
            const int t2 = t + 2; const bool nx = t2 >= nt; const int k2 = (nx ? t2 - nt : t2) % ntk;
#ifdef PROBE_KREP
            if (t == ntk) {
#pragma unroll
                for (int b_ = 0; b_ < 2; ++b_)
#pragma unroll
                    for (int m_ = 0; m_ < 4; ++m_)
#pragma unroll
                        for (int n_ = 0; n_ < 2; ++n_) acc[b_][m_][n_] = (f32x4){zero_, zero_, zero_, zero_}; }
#endif
            const char* b2 = (nx ? nB : cB) + (size_t)k2 * kstepB; const char* a2 = Ab + (size_t)k2 * 128; const int sel2 = nx ? nsel : csel;
#pragma unroll
            for (int n = 0; n < 2; ++n) { B08[n] = H3_LD32(lds + o0 + boff + n * 2048); B18[n] = H3_LD32(lds + o0 + 16384 + boff + n * 2048); }
            __builtin_amdgcn_sched_barrier(0);
#pragma unroll
            for (int m = 0; m < 4; ++m) At8[m] = H3_LD32(lds + o0 + 32768 + aoff + m * 2048);
            if (t == 1 && has_next && tid < 128) rtab[nsel * 128 + tid] = nrow;
            if (ui > 0 && t == 0) { if constexpr (Epi::NST == 4) asm volatile("s_waitcnt vmcnt(10)" ::: "memory"); else asm volatile("s_waitcnt vmcnt(14)" ::: "memory"); }
            else { H3_TILE(o2, b2, a2, sel2);
                if (ui > 0 && t == 1) { if constexpr (Epi::NST == 4) asm volatile("s_waitcnt vmcnt(10)" ::: "memory"); else asm volatile("s_waitcnt vmcnt(14)" ::: "memory"); }
                else asm volatile("s_waitcnt vmcnt(6)" ::: "memory"); }
            asm volatile("s_waitcnt lgkmcnt(0)" ::: "memory"); H3_BAR;
            __builtin_amdgcn_s_setprio(1);
#pragma unroll
            for (int m = 0; m < 4; ++m)
#pragma unroll
                for (int n = 0; n < 2; ++n) acc[0][m][n] = __builtin_amdgcn_mfma_scale_f32_16x16x128_f8f6f4(B08[n], At8[m], acc[0][m][n], 0, 0, 0, 0x7F7F7F7F, 0, 0x7F7F7F7F);
#pragma unroll
            for (int m = 0; m < 4; ++m)
#pragma unroll
                for (int n = 0; n < 2; ++n) acc[1][m][n] = __builtin_amdgcn_mfma_scale_f32_16x16x128_f8f6f4(B18[n], At8[m], acc[1][m][n], 0, 0, 0, 0x7F7F7F7F, 0, 0x7F7F7F7F);
            __builtin_amdgcn_s_setprio(0);
            H3_BAR; __builtin_amdgcn_sched_barrier(0);
            { const int tmp = o0; o0 = o1; o1 = o2; o2 = tmp; }
        }
        if (has_next) H3_TILE(o2, nB + 2 * kstepB, Ab + 2 * 128, nsel);
        E.half(acc, cur, wr, wc, fr, fq);
        if (!has_next) break;
        asm volatile("" : "+v"(zero_));
#pragma unroll
        for (int b = 0; b < 2; ++b)
#pragma unroll
            for (int m = 0; m < 4; ++m)
#pragma unroll
                for (int n = 0; n < 2; ++n) acc[b][m][n] = (f32x4){zero_, zero_, zero_, zero_};
        cur = nxt; cB = nB; ++ui; csel = nsel;
    }
    asm volatile("s_waitcnt vmcnt(0)" ::: "memory");
    if (wr == 0) H3_BAR;
    H3_BAR;
#undef H3_RFILL
#undef H3_STAGE
#undef H3_STAGEA
#undef H3_LD32
#undef H3_TILE
#undef H3_BAR
}
#ifndef ALIGN_G2
#define ALIGN_G2 false
#endif
#define GEMM gemm_fast<true, false, false>
#define GEMM2 gemm_fast<ALIGN_G2, false, false>

__device__ __forceinline__ u32x4 pack8(const f32x4& a, const f32x4& b) { u32x4 w; w.x = pk2(a[0], a[1]); w.y = pk2(a[2], a[3]); w.z = pk2(b[0], b[1]); w.w = pk2(b[2], b[3]); return w; }
template <bool GLU> struct EpiInProj {
    bf16_t* Q; bf16_t* KR; bf16_t* Vn; bf16_t* Gb;
    __device__ __forceinline__ void operator()(const f32x4 (&acc)[2][2][4][2], const Unit& u, int wr, int wc, int fr, int fq) const {
#pragma unroll
        for (int ai = 0; ai < 2; ++ai)
#pragma unroll
            for (int m = 0; m < 4; ++m) { const int irow = u.pm * 256 + 128 * ai + 64 * wr + 16 * m + fr; const size_t row = (size_t)irow; const int cl = 32 * wc + 8 * fq;
                if (u.pn < 2) { *(u32x4*)(Q + row * 512 + u.pn * 256 + cl) = pack8(acc[ai][0][m][0], acc[ai][0][m][1]); *(u32x4*)(Q + row * 512 + u.pn * 256 + 128 + cl) = pack8(acc[ai][1][m][0], acc[ai][1][m][1]); }
                else if (u.pn == 2) { const size_t kvrow = irow < TX ? (size_t)(irow >> 12) * KVS + CTXL + (irow & 4095) : (size_t)((irow - TX) >> 8) * KVS + ((irow - TX) & 255);
                    *(u32x4*)(KR + kvrow * 128 + cl) = pack8(acc[ai][0][m][0], acc[ai][0][m][1]); *(u32x4*)(Vn + kvrow * 128 + cl) = pack8(acc[ai][1][m][0], acc[ai][1][m][1]); }
                else if (GLU) { f32x4 g0, g1;
#pragma unroll
                    for (int j = 0; j < 4; ++j) { g0[j] = acc[ai][0][m][0][j] * sigmoidf_(acc[ai][1][m][0][j]); g1[j] = acc[ai][0][m][1][j] * sigmoidf_(acc[ai][1][m][1][j]); }
                    *(u32x4*)(Gb + row * 512 + (u.pn - 3) * 128 + cl) = pack8(g0, g1); }
                else { *(u32x4*)(Gb + row * 512 + (u.pn - 3) * 256 + cl) = pack8(acc[ai][0][m][0], acc[ai][0][m][1]); *(u32x4*)(Gb + row * 512 + (u.pn - 3) * 256 + 128 + cl) = pack8(acc[ai][1][m][0], acc[ai][1][m][1]); }
            }
    }
};
template <bool L0, bool DRY = false> struct EpiOutProj {
    Frame F; int l;
    __device__ __forceinline__ void operator()(const f32x4 (&acc)[2][2][4][2], const Unit& u, int wr, int wc, int fr, int fq) const {
        float* SS = (float*)(F.ws + WS_SS);
        const float* g1 = F.mod(l, modrow(u.pm * 256), 2) + u.pn * 256 + 32 * wc + 8 * fq;
        f32x4 gv[2][2];
#pragma unroll
        for (int bj = 0; bj < 2; ++bj)
#pragma unroll
            for (int n = 0; n < 2; ++n) gv[bj][n] = *(const f32x4*)(g1 + 128 * bj + 4 * n);
#pragma unroll
        for (int ai = 0; ai < 2; ++ai) {
            f32x4 xv[4][2][2];
#pragma unroll
            for (int m = 0; m < 4; ++m) { const int row = u.pm * 256 + 128 * ai + 64 * wr + 16 * m + fr; const int c0 = u.pn * 256 + 32 * wc + 8 * fq;
#pragma unroll
                for (int bj = 0; bj < 2; ++bj) {
                    if (L0) { const float* src = F.xin_row(row) + c0 + 128 * bj; xv[m][bj][0] = *(const f32x4*)(src); xv[m][bj][1] = *(const f32x4*)(src + 4); }
                    else { const u32x4 w = *(const u32x4*)(F.xr_row(row) + c0 + 128 * bj); xv[m][bj][0] = (f32x4){bflo(w.x), bfhi(w.x), bflo(w.y), bfhi(w.y)}; xv[m][bj][1] = (f32x4){bflo(w.z), bfhi(w.z), bflo(w.w), bfhi(w.w)}; } } }
#pragma unroll
            for (int m = 0; m < 4; ++m) { const int row = u.pm * 256 + 128 * ai + 64 * wr + 16 * m + fr; bf16_t* dst = F.xr_row(row) + u.pn * 256 + 32 * wc + 8 * fq; float q = 0.f;
#pragma unroll
                for (int bj = 0; bj < 2; ++bj) { const f32x4 v0 = xv[m][bj][0] + gv[bj][0] * acc[ai][bj][m][0], v1 = xv[m][bj][1] + gv[bj][1] * acc[ai][bj][m][1];
                    *(u32x4*)(dst + 128 * bj) = DRY ? pack8(xv[m][bj][0], xv[m][bj][1]) : pack8(v0, v1);
                    q += ((v0[0] * v0[0] + v0[1] * v0[1]) + (v0[2] * v0[2] + v0[3] * v0[3])) + ((v1[0] * v1[0] + v1[1] * v1[1]) + (v1[2] * v1[2] + v1[3] * v1[3])); }
                q += __shfl_xor(q, 16); q += __shfl_xor(q, 32);
                if (fq == 0) SS[(size_t)row * 16 + u.pn * 4 + wc] = q; }
        }
    }
};
template <bool IN8, bool OUT8, bool HALFM> struct EpiMoe1 {   static constexpr int NST = 4;
    void* HID;
    __device__ __forceinline__ void operator()(const f32x4 (&acc)[2][2][4][2], const Unit& u, int wr, int wc, int fr, int fq) const {
        const float sc = IN8 ? W8_INV : 1.f;
#pragma unroll
        for (int ai = 0; ai < (HALFM ? 1 : 2); ++ai)
#pragma unroll
            for (int m = 0; m < 4; ++m) { const size_t slot = (size_t)u.pm * (HALFM ? 128 : 256) + 128 * ai + 64 * wr + 16 * m + fr; f32x4 h0, h1;
#pragma unroll
                for (int j = 0; j < 4; ++j) { const float a = acc[ai][0][m][0][j] * sc, b = acc[ai][0][m][1][j] * sc; h0[j] = a * sigmoidf_(a) * (acc[ai][1][m][0][j] * sc); h1[j] = b * sigmoidf_(b) * (acc[ai][1][m][1][j] * sc); }
                if (OUT8) { u32x2 o; o.x = pk4_fp8(h0[0], h0[1], h0[2], h0[3]); o.y = pk4_fp8(h1[0], h1[1], h1[2], h1[3]); *(u32x2*)((unsigned char*)HID + slot * 512 + u.pn * 128 + 32 * wc + 8 * fq) = o; }
                else *(u32x4*)((bf16_t*)HID + slot * 512 + u.pn * 128 + 32 * wc + 8 * fq) = pack8(h0, h1); }
    }
    __device__ __forceinline__ void half(const f32x4 (&acc)[2][4][2], const Unit& u, int wr, int wc, int fr, int fq) const {
        const float sc = IN8 ? W8_INV : 1.f;
#pragma unroll
        for (int m = 0; m < 4; ++m) { const size_t slot = (size_t)u.pm * 128 + 64 * wr + 16 * m + fr; f32x4 h0, h1;
#pragma unroll
            for (int j = 0; j < 4; ++j) { const float a = acc[0][m][0][j] * sc, b = acc[0][m][1][j] * sc; h0[j] = a * sigmoidf_(a) * (acc[1][m][0][j] * sc); h1[j] = b * sigmoidf_(b) * (acc[1][m][1][j] * sc); }
            u32x2 o; o.x = pk4_fp8(h0[0], h0[1], h0[2], h0[3]); o.y = pk4_fp8(h1[0], h1[1], h1[2], h1[3]); *(u32x2*)((unsigned char*)HID + slot * 512 + u.pn * 128 + 32 * wc + 8 * fq) = o; }
    }
};
template <bool FP8, bool HALFM> struct EpiMoe2 {
    static constexpr int NST = 8;
    bf16_t* YB;
    __device__ __forceinline__ void operator()(const f32x4 (&acc)[2][2][4][2], const Unit& u, int wr, int wc, int fr, int fq) const {
        const float sc = FP8 ? W8_INV : 1.f;
#pragma unroll
        for (int ai = 0; ai < (HALFM ? 1 : 2); ++ai)
#pragma unroll
            for (int m = 0; m < 4; ++m) { const size_t slot = (size_t)u.pm * (HALFM ? 128 : 256) + 128 * ai + 64 * wr + 16 * m + fr;
#pragma unroll
                for (int bj = 0; bj < 2; ++bj) *(u32x4*)(YB + slot * 1024 + u.pn * 256 + 128 * bj + 32 * wc + 8 * fq) = pack8(acc[ai][bj][m][0] * sc, acc[ai][bj][m][1] * sc); }
    }
    __device__ __forceinline__ void half(const f32x4 (&acc)[2][4][2], const Unit& u, int wr, int wc, int fr, int fq) const {
        const float sc = FP8 ? W8_INV : 1.f;
#pragma unroll
        for (int m = 0; m < 4; ++m) { const size_t slot = (size_t)u.pm * 128 + 64 * wr + 16 * m + fr;
#pragma unroll
            for (int bj = 0; bj < 2; ++bj) *(u32x4*)(YB + slot * 1024 + u.pn * 256 + 128 * bj + 32 * wc + 8 * fq) = pack8(acc[bj][m][0] * sc, acc[bj][m][1] * sc); }
    }
};

__device__ __forceinline__ void p_k_post(const Frame& F, const float* kg) {
    const int gw = F.vcu * NWAVES + F.wave, NGW = F.G * NWAVES, lane = F.lane;
    const bf16_t* KR = (const bf16_t*)(F.ws + WS_KV); bf16_t* Kn = (bf16_t*)(F.ws + WS_KN);
    const float* rc = (const float*)(F.ws + WS_ROPE); const float* rs = rc + SEQ * 32;
    const int c16 = lane & 15, i8 = c16 & 7, dd0 = 8 * (i8 & 3), sub = lane >> 4;
    float gk[8];
#pragma unroll
    for (int j = 0; j < 8; ++j) gk[j] = kg[i8 * 8 + j];
    const float sgn = (i8 < 4) ? -1.f : 1.f;
    for (int it = gw; it < NB * KVS / 16; it += NGW) {
        u32x4 w[4];
#pragma unroll
        for (int q = 0; q < 4; ++q) w[q] = *(const u32x4*)(KR + (size_t)(it * 16 + 4 * q + sub) * 128 + c16 * 8);
#pragma unroll
        for (int q = 0; q < 4; ++q) { const int kvrow = it * 16 + 4 * q + sub, pos = kvrow % KVS;
            float cs[8], sn[8];
#pragma unroll
            for (int j = 0; j < 8; ++j) { cs[j] = 1.f; sn[j] = 0.f; }
            if (pos >= CTXL) { const int sq = pos - CTXL; const f32x4 c0 = *(const f32x4*)(rc + sq * 32 + dd0), c1 = *(const f32x4*)(rc + sq * 32 + dd0 + 4), s0 = *(const f32x4*)(rs + sq * 32 + dd0), s1 = *(const f32x4*)(rs + sq * 32 + dd0 + 4);
#pragma unroll
                for (int j = 0; j < 4; ++j) { cs[j] = c0[j]; cs[4 + j] = c1[j]; sn[j] = s0[j]; sn[4 + j] = s1[j]; } }
            float x[8] = {bflo(w[q].x), bfhi(w[q].x), bflo(w[q].y), bfhi(w[q].y), bflo(w[q].z), bfhi(w[q].z), bflo(w[q].w), bfhi(w[q].w)};
            float ss = 0.f;
#pragma unroll
            for (int j = 0; j < 8; ++j) ss += x[j] * x[j];
            ss += __shfl_xor(ss, 1); ss += __shfl_xor(ss, 2); ss += __shfl_xor(ss, 4);
            const float rms = 1.0f / sqrtf(ss * (1.f / 64.f) + EPS);
            float y[8], o[8];
#pragma unroll
            for (int j = 0; j < 8; ++j) y[j] = x[j] * rms * gk[j];
#pragma unroll
            for (int j = 0; j < 8; ++j) { const float yp = __shfl_xor(y[j], 4); o[j] = y[j] * cs[j] + sgn * yp * sn[j]; }
            u32x4 ow; ow.x = pk2(o[0], o[1]); ow.y = pk2(o[2], o[3]); ow.z = pk2(o[4], o[5]); ow.w = pk2(o[6], o[7]);
            *(u32x4*)(Kn + (size_t)kvrow * 128 + c16 * 8) = ow; }
    }
}
__device__ __forceinline__ void p_conv(const Frame& F) {
    const bf16_t* Gb = (const bf16_t*)(F.ws + WS_G); bf16_t* AO = (bf16_t*)(F.ws + WS_AO);
    LAS bf16_t* gl = (LAS bf16_t*)F.lds;
    LAS float* yl = (LAS float*)(F.lds + 65536);
    const int c = F.tid;
    float w[31];
#pragma unroll
    for (int j = 0; j < 31; ++j) w[j] = F.in[I_CONVW][j * 512 + c];
    const float bias = F.in[I_CONVB][c];
    u32x4 pre[8];
#define CONV_ITEM(item, rowbase, t0, len) do { if ((item) < 1024) { rowbase = ((item) >> 7) * SEQ; t0 = ((item) & 127) * 32; len = SEQ; } else { const int it_ = (item) - 1024; rowbase = TX + (it_ >> 3) * CTXL; t0 = (it_ & 7) * 32; len = CTXL; } } while (0)
#define CONV_LOAD(item) do { int rb_, t0_, len_; CONV_ITEM(item, rb_, t0_, len_); _Pragma("unroll") for (int q = 0; q < 8; ++q) { const int ch = F.tid + q * NTHREADS, r = ch >> 6, p = t0_ - 15 + r; pre[q] = (u32x4){0u, 0u, 0u, 0u}; \
        if (ch < 62 * 64 && p >= 0 && p < len_) pre[q] = *(const u32x4*)(Gb + (size_t)(rb_ + p) * 512 + (ch & 63) * 8); } } while (0)
    if (F.vcu < 1024 + 64) CONV_LOAD(F.vcu);
    for (int item = F.vcu; item < 1024 + 64; item += F.G) {
        int rowbase, t0, len; CONV_ITEM(item, rowbase, t0, len);
        __syncthreads();
#pragma unroll
        for (int q = 0; q < 8; ++q) { const int ch = F.tid + q * NTHREADS; if (ch < 62 * 64) *(LAS u32x4*)(gl + (ch >> 6) * 512 + (ch & 63) * 8) = pre[q]; }
        __syncthreads();
        if (item + F.G < 1024 + 64) CONV_LOAD(item + F.G);
        float g[62];
#pragma unroll
        for (int r = 0; r < 62; ++r) g[r] = bf2f(gl[r * 512 + c]);
#pragma unroll
        for (int t = 0; t < 32; ++t) { float y = bias;
#pragma unroll
            for (int j = 0; j < 31; ++j) y += g[t + j] * w[j];
            yl[t * 512 + c] = y; }
        __syncthreads();
#pragma unroll
        for (int tt = 0; tt < 4; ++tt) { const int t = 4 * F.wave + tt; float v[8]; float sm = 0.f;
#pragma unroll
            for (int j = 0; j < 8; ++j) { v[j] = yl[t * 512 + F.lane + 64 * j]; sm += v[j]; }
            const float mean = wave_sum(sm) * (1.f / 512.f); float q = 0.f;
#pragma unroll
            for (int j = 0; j < 8; ++j) { v[j] -= mean; q += v[j] * v[j]; }
            const float rstd = 1.0f / sqrtf(wave_sum(q) * (1.f / 512.f) + EPS);
            bf16_t* orow = AO + (size_t)(rowbase + t0 + t) * 1024 + 512;
#pragma unroll
            for (int j = 0; j < 8; ++j) { const int cc = F.lane + 64 * j; const float yn = v[j] * rstd * F.in[I_CLNG][cc] + F.in[I_CLNB][cc]; orow[cc] = (bf16_t)(pk2(yn * sigmoidf_(yn), 0.f) & 0xffffu); } }
    }
#undef CONV_ITEM
#undef CONV_LOAD
    __syncthreads();
}
__device__ __forceinline__ void p_pool(const Frame& F) {
    const int gw = F.vcu * NWAVES + F.wave, NGW = F.G * NWAVES, lane = F.lane;
    const bf16_t* U = (const bf16_t*)(F.ws + WS_G); bf16_t* AO = (bf16_t*)(F.ws + WS_AO);
    const int hw = 1 << (lane >> 4);
    float wgt[16];
#pragma unroll
    for (int i = 0; i < 16; ++i) wgt[i] = (i >= 8 - hw && i < 8 + hw) ? 1.f : 0.f;
    for (int it = gw; it < TX / 8; it += NGW) {
        const int row0 = it * 8, t0 = row0 & 4095, rb = row0 - t0;
        u32x4 r[23];
#pragma unroll
        for (int j = 0; j < 23; ++j) { const int p = t0 - 8 + j; r[j] = (u32x4){0u, 0u, 0u, 0u}; if (p >= 0 && p < SEQ) r[j] = *(const u32x4*)(U + (size_t)(rb + p) * 512 + lane * 8); }
#pragma unroll
        for (int t = 0; t < 8; ++t) {
            float s[8];
#pragma unroll
            for (int j = 0; j < 8; ++j) s[j] = 0.f;
#pragma unroll
            for (int i = 0; i < 16; ++i) { const u32x4 w = r[t + i]; const float g = wgt[i];
                s[0] += g * bflo(w.x); s[1] += g * bfhi(w.x); s[2] += g * bflo(w.y); s[3] += g * bfhi(w.y); s[4] += g * bflo(w.z); s[5] += g * bfhi(w.z); s[6] += g * bflo(w.w); s[7] += g * bfhi(w.w); }
            const int tt = t0 + t; int lo = tt - hw, hi = tt + hw; lo = lo < 0 ? 0 : lo; hi = hi > SEQ ? SEQ : hi;
            const float inv = 1.f / (float)(hi - lo); const u32x4 w = r[t + 8];
            u32x4 ow; ow.x = pk2(s[0] * inv - bflo(w.x), s[1] * inv - bfhi(w.x)); ow.y = pk2(s[2] * inv - bflo(w.y), s[3] * inv - bfhi(w.y)); ow.z = pk2(s[4] * inv - bflo(w.z), s[5] * inv - bfhi(w.z)); ow.w = pk2(s[6] * inv - bflo(w.w), s[7] * inv - bfhi(w.w));
            *(u32x4*)(AO + (size_t)(row0 + t) * 1024 + 512 + lane * 8) = ow;
        }
    }
}

template <int LAYER> __device__ __forceinline__ void attn_simple(const Frame& F) {
    const bf16_t* Q = (const bf16_t*)(F.ws + WS_Q); const bf16_t* Kn = (const bf16_t*)(F.ws + WS_KN); const bf16_t* Vn = (const bf16_t*)(F.ws + WS_VN); bf16_t* AO = (bf16_t*)(F.ws + WS_AO);
    const int nunits = LAYER == 0 ? 512 + 64 : 512;
    for (int u = F.vcu; u < nunits; u += F.G) {
        int b, h, row, s; bool valid = true, isctx = false;
        if (u < 512) { b = u >> 6; h = (u >> 3) & 7; s = (u & 7) * 512 + F.tid; row = b * SEQ + s; }
        else { const int uc = u - 512; b = uc >> 3; h = uc & 7; s = F.tid; valid = F.tid < 256; row = TX + b * CTXL + (valid ? s : 0); isctx = true; }
        float q[64], o[64];
        { const u32x4* qp = (const u32x4*)(Q + (size_t)row * 512 + h * 64);
#pragma unroll
          for (int c = 0; c < 8; ++c) { const u32x4 w = qp[c]; q[8 * c] = bflo(w.x); q[8 * c + 1] = bfhi(w.x); q[8 * c + 2] = bflo(w.y); q[8 * c + 3] = bfhi(w.y); q[8 * c + 4] = bflo(w.z); q[8 * c + 5] = bfhi(w.z); q[8 * c + 6] = bflo(w.w); q[8 * c + 7] = bfhi(w.w); } }
#pragma unroll
        for (int d = 0; d < 64; ++d) o[d] = 0.f;
        float mx = -1e30f, l = 0.f;
        const bf16_t* Kb = Kn + (size_t)b * KVS * 128 + (h >> 2) * 64; const bf16_t* Vb = Vn + (size_t)b * KVS * 128 + (h >> 2) * 64;
        int k_lo2 = 0, k_hi2 = 0;
        const int k_hi1 = CTXL;
        if (LAYER == 0) { if (!isctx) { k_lo2 = CTXL; k_hi2 = KVS; } }
        else { const int s0 = (u & 7) * 512; int lo = s0 - 128, hi = s0 + 511 + 128 + 1; lo = lo < 0 ? 0 : lo; hi = hi > SEQ ? SEQ : hi; k_lo2 = CTXL + lo; k_hi2 = CTXL + hi; }
        for (int part = 0; part < 2; ++part) {
            const int kb = part == 0 ? 0 : k_lo2, ke = part == 0 ? k_hi1 : k_hi2;
            for (int key = kb; key < ke; ++key) {
                const u32x4* kp = (const u32x4*)(Kb + (size_t)key * 128); float sd = 0.f;
#pragma unroll
                for (int c = 0; c < 8; ++c) { const u32x4 w = kp[c];
                    sd += q[8 * c] * bflo(w.x) + q[8 * c + 1] * bfhi(w.x) + q[8 * c + 2] * bflo(w.y) + q[8 * c + 3] * bfhi(w.y) + q[8 * c + 4] * bflo(w.z) + q[8 * c + 5] * bfhi(w.z) + q[8 * c + 6] * bflo(w.w) + q[8 * c + 7] * bfhi(w.w); }
                bool use = valid;
                if (LAYER == 1 && part == 1) { const int j = key - CTXL; const int dlt = s - j; use = use && (dlt <= 128 && dlt >= -128); }
                const float mn = fmaxf(mx, sd); const float mnew = use ? mn : mx;
                const float alpha = exp2f(mx - mnew), p = use ? exp2f(sd - mnew) : 0.f;
                mx = mnew; l = l * alpha + p;
                const u32x4* vp = (const u32x4*)(Vb + (size_t)key * 128);
#pragma unroll
                for (int c = 0; c < 8; ++c) { const u32x4 w = vp[c];
                    o[8 * c] = o[8 * c] * alpha + p * bflo(w.x); o[8 * c + 1] = o[8 * c + 1] * alpha + p * bfhi(w.x); o[8 * c + 2] = o[8 * c + 2] * alpha + p * bflo(w.y); o[8 * c + 3] = o[8 * c + 3] * alpha + p * bfhi(w.y);
                    o[8 * c + 4] = o[8 * c + 4] * alpha + p * bflo(w.z); o[8 * c + 5] = o[8 * c + 5] * alpha + p * bfhi(w.z); o[8 * c + 6] = o[8 * c + 6] * alpha + p * bflo(w.w); o[8 * c + 7] = o[8 * c + 7] * alpha + p * bfhi(w.w); }
            }
        }
        if (LAYER == 1) l += exp2f(F.in[I_SINK][h] * LOG2E - mx);
        const float il = 1.f / l;
        if (valid) { u32x4* op = (u32x4*)(AO + (size_t)row * 1024 + h * 64);
#pragma unroll
            for (int c = 0; c < 8; ++c) { u32x4 w; w.x = pk2(o[8 * c] * il, o[8 * c + 1] * il); w.y = pk2(o[8 * c + 2] * il, o[8 * c + 3] * il); w.z = pk2(o[8 * c + 4] * il, o[8 * c + 5] * il); w.w = pk2(o[8 * c + 6] * il, o[8 * c + 7] * il); op[c] = w; } }
    }
}

#include <hip/hip_bf16.h>
namespace attn_body {
using bf16=__hip_bfloat16;
using s16x4=__attribute__((ext_vector_type(4)))short;
using f32x16=__attribute__((ext_vector_type(16)))float;
constexpr int NW=8,QBLK=32,QB=QBLK*NW,KVBLK=64;
constexpr int QP=512,KP=128,OP=1024;
__device__ __forceinline__ int crow(int r,int hi){return (r&3)+8*(r>>2)+4*hi;}
#define SBAR() __builtin_amdgcn_sched_barrier(0)
__device__ __forceinline__ void wmask(f32x16&p0,f32x16&p1,int dlt0,int hi){
  const float NEG=-INFINITY; const int kb=dlt0+4*hi;
  #pragma unroll
  for(int r=0;r<16;++r){const int d=kb+(r&3)+8*(r>>2); if(d>128||d<-128)p0[r]=NEG; if(d+32>128||d+32<-128)p1[r]=NEG;}
}

constexpr int NSLOT=3, SLOTB=8192;
constexpr int LDS_K=0, LDS_V=NSLOT*SLOTB, LDS_WS=2*NSLOT*SLOTB, LDS_OST=LDS_WS+NW*64*4, LDS_BYTES=LDS_OST+NW*4096;
__device__ __forceinline__ void glds16(const void*gsrc,unsigned lds_dst){unsigned keep;
  asm volatile("s_mov_b32 %0, m0\n\ts_mov_b32 m0, %2\n\ts_nop 0\n\tglobal_load_lds_dwordx4 %1, off\n\ts_mov_b32 m0, %0":"=&s"(keep):"v"(gsrc),"s"(lds_dst):"memory");}
__device__ __forceinline__ float max3f(float a,float b,float c){float r;asm("v_max3_f32 %0, %1, %2, %3":"=v"(r):"v"(a),"v"(b),"v"(c));return r;}
__device__ __forceinline__ float max2f(float a,float b){float r;asm("v_max_f32_e32 %0, %1, %2":"=v"(r):"v"(a),"v"(b));return r;}
__device__ __forceinline__ float fadd_s(float a,float b){float r;asm("v_add_f32_e32 %0, %1, %2":"=v"(r):"v"(a),"v"(b));return r;}
__device__ __forceinline__ float fsub_s(float a,float b){float r;asm("v_sub_f32_e32 %0, %1, %2":"=v"(r):"v"(a),"v"(b));return r;}
typedef float f32x2_t __attribute__((ext_vector_type(2))); typedef __bf16 bf16x2_t __attribute__((ext_vector_type(2)));
__device__ __forceinline__ unsigned cvtpk_s(float lo,float hi){f32x2_t v={lo,hi};bf16x2_t b=__builtin_convertvector(v,bf16x2_t);return __builtin_bit_cast(unsigned,b);}
#define WAIT_BAR(N) asm volatile("s_waitcnt vmcnt(" #N ") lgkmcnt(0)\n\ts_barrier":::"memory")

__device__ __forceinline__ void qkt(f32x16&p0,f32x16&p1,const char*Kslot,const bf16x8*qr,const f32x16&negm,int r32,int hi){
  const char*kb=Kslot+hi*1024+r32*16;
  #pragma unroll
  for(int d0=0;d0<4;++d0){
    const bf16x8 b0=*reinterpret_cast<const bf16x8*>(kb+d0*2048);
    const bf16x8 b1=*reinterpret_cast<const bf16x8*>(kb+d0*2048+512);
    if(d0==0){p0=__builtin_amdgcn_mfma_f32_32x32x16_bf16(b0,qr[0],negm,0,0,0);p1=__builtin_amdgcn_mfma_f32_32x32x16_bf16(b1,qr[0],negm,0,0,0);}
    else{p0=__builtin_amdgcn_mfma_f32_32x32x16_bf16(b0,qr[d0],p0,0,0,0);p1=__builtin_amdgcn_mfma_f32_32x32x16_bf16(b1,qr[d0],p1,0,0,0);}}
}
typedef __attribute__((address_space(3))) const char* lds_cptr;
typedef short v4i16_t __attribute__((ext_vector_type(4)));
__device__ __forceinline__ void kload8(bf16x8*kf,lds_cptr kp){
  kf[0]=*(const __attribute__((address_space(3))) bf16x8*)(kp);      kf[1]=*(const __attribute__((address_space(3))) bf16x8*)(kp+512);
  kf[2]=*(const __attribute__((address_space(3))) bf16x8*)(kp+2048); kf[3]=*(const __attribute__((address_space(3))) bf16x8*)(kp+2560);
  kf[4]=*(const __attribute__((address_space(3))) bf16x8*)(kp+4096); kf[5]=*(const __attribute__((address_space(3))) bf16x8*)(kp+4608);
  kf[6]=*(const __attribute__((address_space(3))) bf16x8*)(kp+6144); kf[7]=*(const __attribute__((address_space(3))) bf16x8*)(kp+6656);
}
__device__ __forceinline__ void kload2(bf16x8*kf,lds_cptr kp,int j){ kf[2*j]=*(const __attribute__((address_space(3))) bf16x8*)(kp+j*2048); kf[2*j+1]=*(const __attribute__((address_space(3))) bf16x8*)(kp+j*2048+512); }
__device__ __forceinline__ s16x4 vtr(lds_cptr p){ return __builtin_bit_cast(s16x4,__builtin_amdgcn_ds_read_tr16_b64_v4i16((__attribute__((address_space(3))) v4i16_t*)p)); }
__device__ __forceinline__ float rowmax(const f32x16&p0,const f32x16&p1){
  float a=max3f(p0[0],p0[1],p1[0]),b=max3f(p0[2],p0[3],p1[1]);a=max3f(a,p1[2],p1[3]);
  #pragma unroll
  for(int r=4;r<16;r+=4){a=max3f(a,p0[r],p0[r+1]);b=max3f(b,p0[r+2],p0[r+3]);a=max3f(a,p1[r],p1[r+1]);b=max3f(b,p1[r+2],p1[r+3]);}
  const float m=max2f(a,b);
  auto rr=__builtin_amdgcn_permlane32_swap(__float_as_uint(m),__float_as_uint(m),false,false);
  return max2f(__uint_as_float(rr[0]),__uint_as_float(rr[1]));
}
__device__ __forceinline__ void pv(f32x16*o,int vb,bf16x8 pa0,bf16x8 pa1,bf16x8 pa2,bf16x8 pa3){
  #pragma unroll
  for(int d0=0;d0<2;++d0){s16x4 lo[4],hi[4];
    #pragma unroll
    for(int ks=0;ks<4;++ks){
      asm volatile("ds_read_b64_tr_b16 %0,%1 offset:%c2":"=&v"(lo[ks]):"v"(vb),"i"(d0*4096+ks*1024):"memory");
      asm volatile("ds_read_b64_tr_b16 %0,%1 offset:%c2":"=&v"(hi[ks]):"v"(vb),"i"(d0*4096+ks*1024+512):"memory");}
    asm volatile("s_waitcnt lgkmcnt(0)":::"memory");SBAR();
    #define PK(k) (bf16x8){lo[k][0],lo[k][1],lo[k][2],lo[k][3],hi[k][0],hi[k][1],hi[k][2],hi[k][3]}
    o[d0]=__builtin_amdgcn_mfma_f32_32x32x16_bf16(pa0,PK(0),o[d0],0,0,0);
    o[d0]=__builtin_amdgcn_mfma_f32_32x32x16_bf16(pa1,PK(1),o[d0],0,0,0);
    o[d0]=__builtin_amdgcn_mfma_f32_32x32x16_bf16(pa2,PK(2),o[d0],0,0,0);
    o[d0]=__builtin_amdgcn_mfma_f32_32x32x16_bf16(pa3,PK(3),o[d0],0,0,0);
    #undef PK
  }
}

#ifndef ATTN_STORE16
#define ATTN_STORE16(p,v) (*(u32x4*)(p)=(v))
#endif
template<int MODE,int THRL> __device__ __forceinline__ void attn_unit(const bf16*Qu,const bf16*__restrict__ Kh,const bf16*__restrict__ Vh,bf16*Ou,const int NT,const int lat0,const int q0s,const float sinkl2,const float*qg,const float*ropec,const bool rope,char*shm){
  int tid_=threadIdx.x; asm volatile("":"+v"(tid_));
  const int tid=tid_,lane=tid&63,r32=lane&31,hi=lane>>5; const int wid=__builtin_amdgcn_readfirstlane(tid>>6);
  const bf16*Qw=Qu+(long)(wid*QBLK)*QP;
  const unsigned lds0=(unsigned)(uintptr_t)shm;
  float*wsf=(float*)(shm+LDS_WS)+wid*64;
  const bf16*ksrc=Kh+(long)lane*KP+wid*8;
  const bf16*vsrc=Vh+(long)(16*(wid&3)+(lane>>2))*KP+(wid>>2)*32+(lane&3)*8;
  const unsigned kdst=lds0+LDS_K+wid*1024, vdst=lds0+LDS_V+wid*1024;
  #define TROW(t) ((MODE==0||(t)<4)?(t)*KVBLK:lat0+((t)-4)*KVBLK)
  #define DMA_K(t,slot) glds16(ksrc+(long)TROW(t)*KP,(unsigned)__builtin_amdgcn_readfirstlane(kdst+(slot)))
  #define DMA_V(t,slot) glds16(vsrc+(long)TROW(t)*KP,(unsigned)__builtin_amdgcn_readfirstlane(vdst+(slot)))
  const int vb0=(int)(lds0+LDS_V)+((lane>>4)&1)*32+(lane&3)*8+(4*hi+((lane&15)>>2))*64;
  const char*Kbase=shm+LDS_K; bf16x8 kf[8];
  const lds_cptr shm3=(lds_cptr)shm; const lds_cptr kp0=shm3+LDS_K+hi*1024+r32*16; const lds_cptr vp0=shm3+LDS_V+((lane>>4)&1)*32+(lane&3)*8+(4*hi+((lane&15)>>2))*64;
  DMA_K(0,0);DMA_V(0,0);DMA_K(1,SLOTB);
  bf16x8 qr[4];
  const int qpos=q0s+wid*QBLK+r32;
  {
    u32x4 qraw[4];
    #pragma unroll
    for(int d0=0;d0<4;++d0) qraw[d0]=*reinterpret_cast<const u32x4*>(&Qw[(long)r32*QP+d0*16+hi*8]);
    float x[4][8]; float ss=0.f;
    #pragma unroll
    for(int d0=0;d0<4;++d0){ x[d0][0]=bflo(qraw[d0].x);x[d0][1]=bfhi(qraw[d0].x);x[d0][2]=bflo(qraw[d0].y);x[d0][3]=bfhi(qraw[d0].y);x[d0][4]=bflo(qraw[d0].z);x[d0][5]=bfhi(qraw[d0].z);x[d0][6]=bflo(qraw[d0].w);x[d0][7]=bfhi(qraw[d0].w);
      #pragma unroll
      for(int j=0;j<8;++j)ss+=x[d0][j]*x[d0][j]; }
    {auto rr=__builtin_amdgcn_permlane32_swap(__float_as_uint(ss),__float_as_uint(ss),false,false);ss=__uint_as_float(rr[0])+__uint_as_float(rr[1]);}
    const float rms=C2/sqrtf(ss*(1.f/64.f)+EPS);
    SBAR();
    #pragma unroll
    for(int d0=0;d0<2;++d0){
      #pragma unroll
      for(int hf=0;hf<2;++hf){
        const f32x4 ga=*reinterpret_cast<const f32x4*>(qg+d0*16+hi*8+4*hf), gb=*reinterpret_cast<const f32x4*>(qg+(d0+2)*16+hi*8+4*hf);
        f32x4 cc=f32x4{1.f,1.f,1.f,1.f}, sn=f32x4{0.f,0.f,0.f,0.f};
        if(rope){ const float*pc=ropec+(long)qpos*32+d0*16+hi*8+4*hf; cc=*reinterpret_cast<const f32x4*>(pc); sn=*reinterpret_cast<const f32x4*>(pc+SEQ*32); }
        #pragma unroll
        for(int j=0;j<4;++j){ const float a=x[d0][4*hf+j]*rms*ga[j], b=x[d0+2][4*hf+j]*rms*gb[j]; x[d0][4*hf+j]=a*cc[j]-b*sn[j]; x[d0+2][4*hf+j]=b*cc[j]+a*sn[j]; }
        SBAR(); } }
    #pragma unroll
    for(int d0=0;d0<4;++d0){ u32x4 w; w.x=cvtpk_s(x[d0][0],x[d0][1]);w.y=cvtpk_s(x[d0][2],x[d0][3]);w.z=cvtpk_s(x[d0][4],x[d0][5]);w.w=cvtpk_s(x[d0][6],x[d0][7]); qr[d0]=__builtin_bit_cast(bf16x8,w); } }
  float mhat=0.f,l_reg=0.f;f32x16 o[2],negm; { float z_=0.f; asm volatile("":"+v"(z_));
    #pragma unroll
    for(int r=0;r<16;++r){o[0][r]=z_;o[1][r]=z_;negm[r]=z_;} } asm volatile("":"+v"(negm));
  #define CMASK(P0,P1,t) do{ if(MODE==1&&(t)>=4) wmask(P0,P1,(lat0-256)+((t)-4)*KVBLK-qpos,hi); }while(0)
  bool resc=false;
  #define START(P0,P1) do{ const float rm=rowmax(P0,P1); resc=false; \
    { const float dl=rm; mhat=fadd_s(mhat,dl); \
      _Pragma("unroll") for(int r=0;r<16;++r){P0[r]=fsub_s(P0[r],dl);P1[r]=fsub_s(P1[r],dl);} \
      _Pragma("unroll") for(int r=0;r<16;++r)negm[r]=-mhat; asm volatile("":"+v"(negm)); } \
    _Pragma("unroll") for(int r=0;r<16;++r)P0[r]=__builtin_amdgcn_exp2f(P0[r]); }while(0)
  #define RESC() do{ if(resc){ asm volatile("s_waitcnt lgkmcnt(0)":::"memory"); \
      _Pragma("unroll") for(int d_=0;d_<2;++d_) _Pragma("unroll") for(int r=0;r<16;++r)o[d_][r]*=wsf[crow(r,hi)]; } }while(0)
  f32x16 pA0,pA1,pB0,pB1;
  int sl_prev=0,sl_cur=0,sl_next=SLOTB;
  #define ROT() do{sl_prev=sl_cur;sl_cur=sl_next;sl_next=(sl_next==(NSLOT-1)*SLOTB)?0:sl_next+SLOTB;}while(0)
  DMA_K(2,2*SLOTB);
  WAIT_BAR(3);
  qkt(pA0,pA1,Kbase,qr,negm,r32,hi);asm volatile("s_nop 15\n\ts_nop 7":"+v"(pA0),"+v"(pA1));CMASK(pA0,pA1,0);
  START(pA0,pA1);
  _Pragma("unroll") for(int r=0;r<16;++r)pA1[r]=__builtin_amdgcn_exp2f(pA1[r]);
  WAIT_BAR(0);
  DMA_K(3,0);DMA_V(1,SLOTB);
  ROT();
  kload8(kf,kp0+sl_cur);
  WAIT_BAR(2);
  s16x4 vlo[8],vhi[8]; u32x4 pw0,pw1,pw2,pw3;
  #define PKW(P,B) cvtpk_s(P[B],P[B+1])
  #define PAF(k) __builtin_bit_cast(bf16x8,pw##k)
  #define VFR(i) (bf16x8){vlo[i][0],vlo[i][1],vlo[i][2],vlo[i][3],vhi[i][0],vhi[i][1],vhi[i][2],vhi[i][3]}
  #define PIN(x) asm volatile("":"+v"(x))
  #define MX3(a,b,c) __builtin_fmaxf(__builtin_fmaxf((a),(b)),(c))
  #define GAPA(MF,A0,A1,A2,A3,W0,W1,PW) do{ MF; sacc+=A0; sacc+=A1; sacc+=A2; sacc+=A3; PIN(sacc); W0; W1; PIN(PW); SBAR(); }while(0)
  #define EX(v) __builtin_amdgcn_exp2f(v)
  #define GAPB(MF,X,B) do{ MF; X[B]=EX(X[B]); X[B+1]=EX(X[B+1]); X[B+2]=EX(X[B+2]); X[B+3]=EX(X[B+3]); PIN(X); SBAR(); }while(0)
  #define VRD(i) do{ vlo[i]=vtr(vp_+(((i)>>2)*4096+((i)&3)*1024)); vhi[i]=vtr(vp_+(((i)>>2)*4096+((i)&3)*1024+512)); }while(0)
  #define KRD(G,j) do{ if(G){ kload2(kf,kp0+sl_next,j); SBAR(); } }while(0)
  #define STEP(C0,C1,P0,P1,t,GK,GV,GL) do{ SBAR(); \
    const lds_cptr vp_=vp0+sl_prev; \
    VRD(0); SBAR(); float sacc=(P0[0]+P0[1]); \
    GAPA(C0=__builtin_amdgcn_mfma_f32_32x32x16_bf16(kf[0],qr[0],negm,0,0,0), P0[2],P0[3],P0[4],P0[5],     pw0[0]=PKW(P0,0), pw0[1]=PKW(P0,2), pw0); \
    VRD(4); SBAR(); GAPA(C1=__builtin_amdgcn_mfma_f32_32x32x16_bf16(kf[1],qr[0],negm,0,0,0), P0[6],P0[7],P0[8],P0[9],     pw0[2]=PKW(P0,4), pw0[3]=PKW(P0,6), pw0); \
    VRD(1); SBAR(); GAPA(C0=__builtin_amdgcn_mfma_f32_32x32x16_bf16(kf[2],qr[1],C0,0,0,0),   P0[10],P0[11],P0[12],P0[13], pw1[0]=PKW(P0,8), pw1[1]=PKW(P0,10), pw1); \
    VRD(5); SBAR(); GAPA(C1=__builtin_amdgcn_mfma_f32_32x32x16_bf16(kf[3],qr[1],C1,0,0,0),   P0[14],P0[15],P1[0],P1[1],   pw1[2]=PKW(P0,12),pw1[3]=PKW(P0,14), pw1); \
    VRD(2); SBAR(); GAPA(C0=__builtin_amdgcn_mfma_f32_32x32x16_bf16(kf[4],qr[2],C0,0,0,0),   P1[2],P1[3],P1[4],P1[5],     pw2[0]=PKW(P1,0), pw2[1]=PKW(P1,2), pw2); \
    VRD(6); SBAR(); GAPA(C1=__builtin_amdgcn_mfma_f32_32x32x16_bf16(kf[5],qr[2],C1,0,0,0),   P1[6],P1[7],P1[8],P1[9],     pw2[2]=PKW(P1,4), pw2[3]=PKW(P1,6), pw2); \
    VRD(3); SBAR(); GAPA(C0=__builtin_amdgcn_mfma_f32_32x32x16_bf16(kf[6],qr[3],C0,0,0,0),   P1[10],P1[11],P1[12],P1[13], pw3[0]=PKW(P1,8), pw3[1]=PKW(P1,10), pw3); \
    VRD(7); SBAR(); GAPA(C1=__builtin_amdgcn_mfma_f32_32x32x16_bf16(kf[7],qr[3],C1,0,0,0),   P1[14],P1[15],0.f,0.f,       pw3[2]=PKW(P1,12),pw3[3]=PKW(P1,14), pw3); \
    l_reg+=sacc; \
    if(GK){DMA_K((t)+3,sl_cur);} if(GV){DMA_V((t)+1,sl_next);} \
    CMASK(C0,C1,t); \
    { float a=MX3(C0[0],C0[1],C1[0]),b=MX3(C0[2],C0[3],C1[1]); a=MX3(a,C1[2],C1[3]); \
      _Pragma("unroll") for(int r=4;r<16;r+=4){a=MX3(a,C0[r],C0[r+1]);b=MX3(b,C0[r+2],C0[r+3]);a=MX3(a,C1[r],C1[r+1]);b=MX3(b,C1[r+2],C1[r+3]);} \
      float rm=__builtin_fmaxf(a,b); { auto rr=__builtin_amdgcn_permlane32_swap(__float_as_uint(rm),__float_as_uint(rm),false,false); rm=__builtin_fmaxf(__uint_as_float(rr[0]),__uint_as_float(rr[1])); } \
      resc=false; \
      if(__builtin_expect(__any(rm>(float)THRL),0)){ const float dl=__builtin_fmaxf(rm,0.f); mhat+=dl; \
        _Pragma("unroll") for(int r=0;r<16;++r){C0[r]-=dl;C1[r]-=dl;} \
        _Pragma("unroll") for(int r=0;r<16;++r)negm[r]=-mhat; asm volatile("":"+v"(negm)); \
        const float f=__builtin_amdgcn_exp2f(-dl); l_reg*=f; if(hi==0)wsf[r32]=f; resc=true; } } \
    SBAR(); \
    GAPB(o[0]=__builtin_amdgcn_mfma_f32_32x32x16_bf16(PAF(0),VFR(0),o[0],0,0,0), C0,0); \
    GAPB(o[1]=__builtin_amdgcn_mfma_f32_32x32x16_bf16(PAF(0),VFR(4),o[1],0,0,0), C0,4); \
    KRD(GL,0); GAPB(o[0]=__builtin_amdgcn_mfma_f32_32x32x16_bf16(PAF(1),VFR(1),o[0],0,0,0), C0,8); \
    KRD(GL,1); GAPB(o[1]=__builtin_amdgcn_mfma_f32_32x32x16_bf16(PAF(1),VFR(5),o[1],0,0,0), C0,12); \
    KRD(GL,2); GAPB(o[0]=__builtin_amdgcn_mfma_f32_32x32x16_bf16(PAF(2),VFR(2),o[0],0,0,0), C1,0); \
    KRD(GL,3); GAPB(o[1]=__builtin_amdgcn_mfma_f32_32x32x16_bf16(PAF(2),VFR(6),o[1],0,0,0), C1,4); \
    GAPB(o[0]=__builtin_amdgcn_mfma_f32_32x32x16_bf16(PAF(3),VFR(3),o[0],0,0,0), C1,8); \
    GAPB(o[1]=__builtin_amdgcn_mfma_f32_32x32x16_bf16(PAF(3),VFR(7),o[1],0,0,0), C1,12); \
    }while(0)
  int t=1;
  for(;t+5<NT;t+=2){
    STEP(pB0,pB1,pA0,pA1,t,true,true,true);     WAIT_BAR(2); RESC(); ROT();
    STEP(pA0,pA1,pB0,pB1,t+1,true,true,true);   WAIT_BAR(2); RESC(); ROT();
  }
  #define ENDW(tt) do{ if((tt)+3<NT){WAIT_BAR(2);} else if((tt)+2<NT){WAIT_BAR(1);} else {WAIT_BAR(0);} }while(0)
  for(;t+1<NT;t+=2){
    STEP(pB0,pB1,pA0,pA1,t,(t+3<NT),(t+1<NT),(t+1<NT));       ENDW(t);   RESC(); ROT();
    STEP(pA0,pA1,pB0,pB1,t+1,(t+4<NT),(t+2<NT),(t+2<NT));     ENDW(t+1); RESC(); ROT();
  }
  STEP(pB0,pB1,pA0,pA1,NT-1,false,false,false); RESC();
  { float sacc=pB0[0]+pB0[1]; _Pragma("unroll") for(int r=2;r<16;++r)sacc+=pB0[r]; _Pragma("unroll") for(int r=0;r<16;++r)sacc+=pB1[r]; l_reg+=sacc;
    pw0=(u32x4){PKW(pB0,0),PKW(pB0,2),PKW(pB0,4),PKW(pB0,6)};pw1=(u32x4){PKW(pB0,8),PKW(pB0,10),PKW(pB0,12),PKW(pB0,14)};pw2=(u32x4){PKW(pB1,0),PKW(pB1,2),PKW(pB1,4),PKW(pB1,6)};pw3=(u32x4){PKW(pB1,8),PKW(pB1,10),PKW(pB1,12),PKW(pB1,14)};
    SBAR(); pv(o,vb0+sl_cur,PAF(0),PAF(1),PAF(2),PAF(3)); }
  #undef PKW
  #undef PAF
  #undef VFR
  #undef PIN
  #undef MX3
  #undef GAPA
  #undef GAPB
  #undef EX
  #undef VRD
  #undef KRD
  #undef STEP
  #undef ENDW
  {auto rr=__builtin_amdgcn_permlane32_swap(__float_as_uint(l_reg),__float_as_uint(l_reg),false,false);l_reg=__uint_as_float(rr[0])+__uint_as_float(rr[1]);}
  if(MODE==1)l_reg+=__builtin_amdgcn_exp2f(sinkl2-mhat);
  if(hi==0)wsf[32+r32]=l_reg;asm volatile("s_waitcnt lgkmcnt(0)":::"memory");
  float rli[16];
  #pragma unroll
  for(int r=0;r<16;++r)rli[r]=__builtin_amdgcn_rcpf(wsf[32+crow(r,hi)]);
  bf16*Ow=Ou+(long)(wid*QBLK)*OP;
  { bf16*stg=(bf16*)(shm+LDS_OST)+wid*2048;
    #pragma unroll
    for(int r=0;r<16;++r){const int orow=crow(r,hi);
      #pragma unroll
      for(int d0=0;d0<2;++d0)stg[orow*64+d0*32+r32]=__float2bfloat16(o[d0][r]*rli[r]);}
    asm volatile("s_waitcnt lgkmcnt(0)":::"memory");
    #pragma unroll
    for(int i=0;i<4;++i){const int row=i*8+(lane>>3),ch=lane&7; const u32x4 v=*(const u32x4*)(stg+row*64+ch*8); ATTN_STORE16(Ow+(long)row*OP+ch*8,v);} }
  asm volatile("s_waitcnt lgkmcnt(0)\n\ts_barrier":::"memory");
  #undef DMA_K
  #undef TROW
  #undef DMA_V
  #undef CMASK
  #undef START
  #undef RESC
  #undef ROT
}
#undef SBAR
#undef WAIT_BAR
}

template <int LAYER> __device__ __forceinline__ void attn_fast(const Frame& F, char* shm) {
    using attn_body::bf16;
    const bf16* Q = (const bf16*)(F.ws + WS_Q); const bf16* Kn = (const bf16*)(F.ws + WS_KN); const bf16* Vn = (const bf16*)(F.ws + WS_VN); bf16* AO = (bf16*)(F.ws + WS_AO);
    const int nunits = LAYER == 0 ? 1024 + 64 : 1024;
    for (int U = F.vcu; U < nunits; U += F.G) {
        int b, h, NT, lat0 = 0, q0 = 0; size_t row0;
        if (U < 1024) { b = U >> 7; h = ((U >> 6) & 1) * 4 + ((U >> 4) & 3); q0 = (U & 15) * 256; row0 = (size_t)b * SEQ + q0;
            if (LAYER == 0) NT = KVS / 64;
            else { int lo = q0 - 128, hi = q0 + 384; lo = lo < 0 ? 0 : lo; hi = hi > SEQ ? SEQ : hi; NT = 4 + (hi - lo) / 64; lat0 = CTXL + lo; } }
        else { const int uc = U - 1024; b = uc >> 3; h = uc & 7; row0 = (size_t)TX + (size_t)b * CTXL; NT = 4; }
        const bf16* Kh = Kn + (size_t)b * KVS * 128 + (h >> 2) * 64; const bf16* Vh = Vn + (size_t)b * KVS * 128 + (h >> 2) * 64;
        const float sinkl2 = LAYER == 1 ? F.in[I_SINK][h] * LOG2E : 0.f;
        if (LAYER == 0 && F.G == 256 && U < 1024 && (U >> 8) == (F.vcu & 3)) {
            const int lo = TN_DENSE + (F.vcu < 64 ? F.vcu * 72 : 64 * 72 + (F.vcu - 64) * 104); int hi = lo + (F.vcu < 64 ? 72 : 104); hi = hi > TN_ITEMS ? TN_ITEMS : hi;
            Frame Fc = F; asm volatile("" : "+v"(Fc.lane), "+v"(Fc.tid));
            transpose_range(Fc, lo, hi, Fc.wave, NWAVES);
            __syncthreads(); }
        attn_body::attn_unit<LAYER, 8>(Q + row0 * 512 + h * 64, Kh, Vh, AO + row0 * 1024 + h * 64, NT, lat0, q0, sinkl2, F.in[LAYER == 0 ? I_QNA : I_QNC], (const float*)(F.ws + WS_ROPE), U < 1024, shm);
    }
}

template <int DRY, bool FP8> __device__ __forceinline__ void p_router(const Frame& F, int l, int ntok) {
    const int gw = F.vcu * NWAVES + F.wave, NGW = F.G * NWAVES, lane = F.lane, tk = lane & 15, kq = lane >> 4;
    bf16_t* HX = F.hx(); const float* SS = (const float*)(F.ws + WS_SS);
    const float* gb = F.in[I_RGB] + l * 4; const float* eb = F.in[I_REB] + l * 32;
    unsigned* tokslot = (unsigned*)(F.ws + (DRY ? WS_HID : WS_TOK)); float* tokw = (float*)(F.ws + (DRY ? WS_HID : WS_TOK) + 512 * 1024); unsigned* list = (unsigned*)(F.ws + (DRY ? WS_HID + 2 * MiB : WS_LIST));
    unsigned* cnt = F.cnt(DRY ? l + 2 : l);
    {
        const u32x4* src = (const u32x4*)((const bf16_t*)(F.ws + WS_WR) + (size_t)l * 2 * 36864);
        u32x4 t[18];
#pragma unroll
        for (int i = 0; i < 18; ++i) t[i] = src[F.tid + i * NTHREADS];
        __syncthreads();
#pragma unroll
        for (int i = 0; i < 18; ++i) *(LAS u32x4*)(F.lds + (F.tid + i * NTHREADS) * 16) = t[i];
    }
    const LAS unsigned char* wl0 = F.lds + lane * 16;
    const LAS unsigned char* wl2 = F.lds + 2048 + ((tk >> 2) * 4 + kq) * 16;
    LAS unsigned* lcnt = (LAS unsigned*)(F.lds + LDS_TAB + 2048 + 8192); LAS unsigned* lbase = lcnt + 32;
    LAS float* gps = (LAS float*)(F.lds + LDS_TAB + 2048);
    const int nrounds = (ntok / 16 + NGW - 1) / NGW;
    for (int rd = 0; rd < nrounds; ++rd) {
        const int grp0 = F.vcu * NWAVES + rd * NGW, grp = grp0 + F.wave;
        __syncthreads();
        if (F.tid < 32) lcnt[F.tid] = 0u;
        if (grp0 < ntok / 16) { const int r0 = modrow(grp0 * 16); const float* gpg = (const float*)(F.ws + WS_GP) + (size_t)(l * 9 + r0) * 1024; const float* shg = F.mod(l, r0, 3);
            *(LAS f32x4*)(gps + 4 * F.tid) = F.tid < 256 ? *(const f32x4*)(gpg + 4 * F.tid) : *(const f32x4*)(shg + 4 * (F.tid - 256)); }
        __syncthreads();
        const bool active = grp < ntok / 16;
        const int row = (active ? grp : 0) * 16 + tk;
        bool win = false; int e1 = 0, e2 = 0; float w1 = 0.f, w2 = 0.f; unsigned p1 = 0u, p2 = 0u;
        if (active) {
        const bf16_t* xr = F.xr_row(row) + 8 * kq;
        u32x4 xq[16];
#define R_XLOAD(i, st) do { const int s_ = (st) < 32 ? (st) : 31; xq[i] = *(const u32x4*)(xr + s_ * 32); } while (0)
#pragma unroll
        for (int i = 0; i < 16; ++i) R_XLOAD(i, i);
        float ssum = 0.f;
#pragma unroll
        for (int i = 0; i < 4; ++i) { const f32x4 p = *(const f32x4*)(SS + (size_t)row * 16 + 4 * i); ssum += (p[0] + p[1]) + (p[2] + p[3]); }
        const float rms = 1.0f / sqrtf(ssum * (1.f / 1024.f) + EPS);
        f32x4 acc[3];
#pragma unroll
        for (int n = 0; n < 3; ++n) acc[n] = (f32x4){0.f, 0.f, 0.f, 0.f};
        bf16_t* hxr = HX + (size_t)row * DM + 8 * kq; unsigned char* hx8 = (unsigned char*)HX + (size_t)row * DM + 8 * kq;
        const LAS float* gpl = gps + 8 * kq;
#define R_STEP(i, st) do { const u32x4 xb_ = xq[i]; \
            const f32x4 m0 = *(const LAS f32x4*)(gpl + (st) * 32), m1 = *(const LAS f32x4*)(gpl + (st) * 32 + 4), m2 = *(const LAS f32x4*)(gpl + 1024 + (st) * 32), m3 = *(const LAS f32x4*)(gpl + 1024 + (st) * 32 + 4); \
            const f32x4 xf0 = (f32x4){bflo(xb_.x), bfhi(xb_.x), bflo(xb_.y), bfhi(xb_.y)}, xf1 = (f32x4){bflo(xb_.z), bfhi(xb_.z), bflo(xb_.w), bfhi(xb_.w)}; \
            const f32x4 h0 = (xf0 * rms) * m0 + m2, h1 = (xf1 * rms) * m1 + m3; \
            u32x4 hh; hh.x = pk2(h0[0], h0[1]); hh.y = pk2(h0[2], h0[3]); hh.z = pk2(h1[0], h1[1]); hh.w = pk2(h1[2], h1[3]); \
            if (FP8) { u32x2 h8; h8.x = pk4_fp8(h0[0], h0[1], h0[2], h0[3]); h8.y = pk4_fp8(h1[0], h1[1], h1[2], h1[3]); *(u32x2*)(hx8 + (st) * 32) = h8; } else *(u32x4*)(hxr + (st) * 32) = hh; \
            if (DRY < 3 || DRY >= 6) { \
            u32x4 hl; hl.x = pk2(h0[0] - bflo(hh.x), h0[1] - bfhi(hh.x)); hl.y = pk2(h0[2] - bflo(hh.y), h0[3] - bfhi(hh.y)); hl.z = pk2(h1[0] - bflo(hh.z), h1[1] - bfhi(hh.z)); hl.w = pk2(h1[2] - bflo(hh.w), h1[3] - bfhi(hh.w)); \
            const bf16x8 bh = __builtin_bit_cast(bf16x8, hh), bl = __builtin_bit_cast(bf16x8, hl); \
            bf16x8 w0h, w1h, w2h, w0l, w1l, w2l; if (DRY == 6) { w0h = w1h = w2h = w0l = w1l = w2l = bh; } else { w0h = *(const LAS bf16x8*)(wl0 + (st) * 2304); w1h = *(const LAS bf16x8*)(wl0 + (st) * 2304 + 1024); w2h = *(const LAS bf16x8*)(wl2 + (st) * 2304); \
            w0l = *(const LAS bf16x8*)(wl0 + RW_BYTES + (st) * 2304); w1l = *(const LAS bf16x8*)(wl0 + RW_BYTES + (st) * 2304 + 1024); w2l = *(const LAS bf16x8*)(wl2 + RW_BYTES + (st) * 2304); } \
            if (DRY == 7) { const bf16x8 sx = w0h ^ w1h ^ w2h ^ w0l ^ w1l ^ w2l ^ bl; acc[0][0] += (float)sx[0]; } else \
            acc[0] = __builtin_amdgcn_mfma_f32_16x16x32_bf16(w0h, bh, acc[0], 0, 0, 0); acc[1] = __builtin_amdgcn_mfma_f32_16x16x32_bf16(w1h, bh, acc[1], 0, 0, 0); acc[2] = __builtin_amdgcn_mfma_f32_16x16x32_bf16(w2h, bh, acc[2], 0, 0, 0); \
            acc[0] = __builtin_amdgcn_mfma_f32_16x16x32_bf16(w0h, bl, acc[0], 0, 0, 0); acc[1] = __builtin_amdgcn_mfma_f32_16x16x32_bf16(w1h, bl, acc[1], 0, 0, 0); acc[2] = __builtin_amdgcn_mfma_f32_16x16x32_bf16(w2h, bl, acc[2], 0, 0, 0); \
            acc[0] = __builtin_amdgcn_mfma_f32_16x16x32_bf16(w0l, bh, acc[0], 0, 0, 0); acc[1] = __builtin_amdgcn_mfma_f32_16x16x32_bf16(w1l, bh, acc[1], 0, 0, 0); acc[2] = __builtin_amdgcn_mfma_f32_16x16x32_bf16(w2l, bh, acc[2], 0, 0, 0); } } while (0)
        for (int st = 0; st < 32; st += 16) {
#pragma unroll
            for (int i = 0; i < 16; ++i) { R_STEP(i, st + i); R_XLOAD(i, st + i + 16); }
        }
#undef R_XLOAD
#undef R_STEP
        if (DRY >= 6 && acc[0][0] + acc[1][1] + acc[2][2] == 123.456f) tokw[row] = 1.f;
        if (DRY < 2) {
            const float lgk = acc[2][0] + gb[kq];
            const float la = __shfl_xor(lgk, 16), lb = __shfl_xor(lgk, 32), lc = __shfl_xor(la, 32);
            const float gm = fmaxf(fmaxf(lgk, la), fmaxf(lb, lc));
            win = (lgk == gm);
            win = win && !(la == gm && (kq ^ 1) < kq) && !(lb == gm && (kq ^ 2) < kq) && !(lc == gm && (kq ^ 3) < kq);
            if (win) {
                const float g_w = 1.f / (expf(lgk - gm) + expf(la - gm) + expf(lb - gm) + expf(lc - gm));
                float el[8];
                { const f32x4 b0 = *(const f32x4*)(eb + 8 * kq), b1 = *(const f32x4*)(eb + 8 * kq + 4);
#pragma unroll
                  for (int i = 0; i < 4; ++i) { el[i] = acc[0][i] + b0[i]; el[4 + i] = acc[1][i] + b1[i]; } }
                int i1 = 0; float m1 = el[0];
#pragma unroll
                for (int i = 1; i < 8; ++i) if (el[i] > m1) { m1 = el[i]; i1 = i; }
                int i2 = 0; float m2 = -3.0e38f;
#pragma unroll
                for (int i = 0; i < 8; ++i) if (i != i1 && el[i] > m2) { m2 = el[i]; i2 = i; }
                const float pp = expf(m2 - m1); w1 = g_w / (1.f + pp); w2 = g_w * pp / (1.f + pp);
                e1 = kq * 8 + i1; e2 = kq * 8 + i2;
                p1 = __hip_atomic_fetch_add(lcnt + e1, 1u, __ATOMIC_RELAXED, __HIP_MEMORY_SCOPE_WORKGROUP); p2 = __hip_atomic_fetch_add(lcnt + e2, 1u, __ATOMIC_RELAXED, __HIP_MEMORY_SCOPE_WORKGROUP);
            }
        }
        }
        __syncthreads();
        if (DRY < 2 && F.tid < 32) { const unsigned n = lcnt[F.tid]; lbase[F.tid] = n ? atomicAdd(cnt + F.tid * 64, n) : 0u; }
        __syncthreads();
        if (win) { const unsigned pos1 = lbase[e1] + p1, pos2 = lbase[e2] + p2;
            list[(size_t)e1 * TT + pos1] = (unsigned)row; list[(size_t)e2 * TT + pos2] = (unsigned)row;
            tokslot[2 * row] = ((unsigned)e1 << 16) | pos1; tokslot[2 * row + 1] = ((unsigned)e2 << 16) | pos2; tokw[2 * row] = w1; tokw[2 * row + 1] = w2; }
    }
    __syncthreads();
}
struct CombBuf { u32x2 x[4], ya[4], yb[4]; };
__device__ __forceinline__ void comb_load(CombBuf& b, const bf16_t* xr, const bf16_t* ya, const bf16_t* yb, int lane) {
#pragma unroll
    for (int j = 0; j < 4; ++j) { const int c = 4 * lane + 256 * j; b.x[j] = *(const u32x2*)(xr + c); b.ya[j] = *(const u32x2*)(ya + c); b.yb[j] = *(const u32x2*)(yb + c); }
}
template <bool LAST, bool DRY> __device__ __forceinline__ void comb_finish(const Frame& F, const CombBuf& b, int l, int row, float wa, float wb, int lane) {
    const int r = modrow(row); const float* g2 = F.mod(l, r, 5); bf16_t* xr = F.xr_row(row);
    float ss = 0.f; f32x4 v[4];
#pragma unroll
    for (int j = 0; j < 4; ++j) { const int c = 4 * lane + 256 * j; const f32x4 gv = *(const f32x4*)(g2 + c);
        f32x4 y; y[0] = wa * bflo(b.ya[j].x) + wb * bflo(b.yb[j].x); y[1] = wa * bfhi(b.ya[j].x) + wb * bfhi(b.yb[j].x); y[2] = wa * bflo(b.ya[j].y) + wb * bflo(b.yb[j].y); y[3] = wa * bfhi(b.ya[j].y) + wb * bfhi(b.yb[j].y);
        const f32x4 x1 = (f32x4){bflo(b.x[j].x), bfhi(b.x[j].x), bflo(b.x[j].y), bfhi(b.x[j].y)};
        v[j] = x1 + gv * y;
        if (LAST) { if (!DRY) *(f32x4*)(F.out + (size_t)row * DM + c) = v[j]; }
        else { u32x2 o; o.x = pk2(v[j][0], v[j][1]); o.y = pk2(v[j][2], v[j][3]); *(u32x2*)(xr + c) = DRY ? b.x[j] : o; }
        ss += (v[j][0] * v[j][0] + v[j][1] * v[j][1]) + (v[j][2] * v[j][2] + v[j][3] * v[j][3]); }
    if (!LAST) { const float rms = 1.0f / sqrtf(wave_sum(ss) * (1.f / 1024.f) + EPS); const float* g = F.in[I_LN1] + (l + 1) * 1024; const float* sh = F.mod(l + 1, r, 0); const float* sc = F.mod(l + 1, r, 1); f32x4 h[4];
#pragma unroll
        for (int j = 0; j < 4; ++j) { const int c = 4 * lane + 256 * j; h[j] = (v[j] * rms * *(const f32x4*)(g + c)) * (1.f + *(const f32x4*)(sc + c)) + *(const f32x4*)(sh + c); }
        store_row_bf16(F.hx() + (size_t)row * DM, lane, h); }
}
template <bool LAST, bool DRY> __device__ __forceinline__ void p_combine(const Frame& F, int l, int ntok, const MoeTab& tb, int tsh) {
    const int gw = F.vcu * NWAVES + F.wave, NGW = F.G * NWAVES, lane = F.lane;
    const bf16_t* YB = (const bf16_t*)(F.ws + WS_YB);
    const unsigned* tokslot = (const unsigned*)(F.ws + WS_TOK); const float* tokw = (const float*)(F.ws + WS_TOK + 512 * 1024);
    const int ntot = gw < ntok ? (ntok - gw + NGW - 1) / NGW : 0;
    for (int base = 0; base < ntot; base += 64) {
    const int n = ntot - base < 64 ? ntot - base : 64;
    unsigned my_sa = 0u, my_sb = 0u; float my_wa = 0.f, my_wb = 0.f;
    { const int mr = gw + (base + lane) * NGW;
      if (lane < n) { const unsigned sa = tokslot[2 * mr], sb = tokslot[2 * mr + 1]; my_wa = tokw[2 * mr]; my_wb = tokw[2 * mr + 1];
          my_sa = ((unsigned)tb.tile0[sa >> 16] << tsh) + (sa & 0xffffu); my_sb = ((unsigned)tb.tile0[sb >> 16] << tsh) + (sb & 0xffffu); } }
    CombBuf A, B;
#define COMB_LOAD(buf, i) do { const int row_ = gw + (base + (i)) * NGW; const unsigned sa_ = __builtin_amdgcn_readlane(my_sa, (i)), sb_ = __builtin_amdgcn_readlane(my_sb, (i)); \
        comb_load(buf, F.xr_row(row_), YB + (size_t)sa_ * 1024, YB + (size_t)sb_ * 1024, lane); } while (0)
#define COMB_FIN(buf, i) do { const float wa_ = __uint_as_float(__builtin_amdgcn_readlane(__float_as_uint(my_wa), (i))), wb_ = __uint_as_float(__builtin_amdgcn_readlane(__float_as_uint(my_wb), (i))); \
        comb_finish<LAST, DRY>(F, buf, l, gw + (base + (i)) * NGW, wa_, wb_, lane); } while (0)
    COMB_LOAD(A, 0);
    for (int i = 0; i < n; i += 2) {
        if (i + 1 < n) COMB_LOAD(B, i + 1);
        COMB_FIN(A, i);
        if (i + 2 < n) COMB_LOAD(A, i + 2);
        if (i + 1 < n) COMB_FIN(B, i + 1);
    }
    }
#undef COMB_LOAD
#undef COMB_FIN
}

__global__ void __launch_bounds__(NTHREADS, 2) fwd_kernel(Params P) {
    extern __shared__ __attribute__((aligned(16))) unsigned char lds_raw[];
    Frame F;
    F.lds = (LAS unsigned char*)lds_raw; F.in = P.in; F.out = P.out; F.ws = P.ws;
    F.tid = threadIdx.x; F.lane = F.tid & 63; F.wave = __builtin_amdgcn_readfirstlane(F.tid >> 6);
    F.G = gridDim.x; { const int bx = blockIdx.x; F.vcu = (F.G % 8 == 0) ? (bx % 8) * (F.G / 8) + bx / 8 : bx; }
    volatile LAS unsigned* misc = (volatile LAS unsigned*)(F.lds + LDS_MISC);
    if (F.tid < 16) misc[F.tid] = 0u;
    __syncthreads();
#if ONE_LAUNCH
    XcdBarrier bar = xcd_barrier_post((unsigned*)(F.ws + WS_CTL) + CW_BAR, misc + 8);
#define GRID_BAR() do { xcd_barrier(bar); } while (0)
#else
#define GRID_BAR() do { } while (0)
#endif
    const int lo = P.ph_lo, hi = P.ph_hi;
#ifndef DRYMASK
#define DRYMASK 0x4000
#endif
#ifndef DRYV
#define DRYV 7
#endif
#ifndef PHMASK
#define PHMASK 0xFFFFFFFFu
#endif
#define IN(k) (((PHMASK >> (k)) & 1u) && lo <= (k) && (k) < hi)
#ifdef PROBE_PH
#define STAMP(k) do { if (blockIdx.x == 0 && F.tid == 0) { const unsigned long long t_ = __builtin_amdgcn_s_memrealtime(); \
        if ((k) == PROBE_PH - 1) { misc[0] = (unsigned)t_; misc[1] = (unsigned)(t_ >> 32); } if ((k) == PROBE_PH) { misc[2] = (unsigned)t_; misc[3] = (unsigned)(t_ >> 32); } } } while (0)
#else
#define STAMP(k) do { } while (0)
#endif
#define SEAM(k) do { if (IN((k) + 1)) GRID_BAR(); STAMP(k); } while (0)
    STAMP(-1);
    bf16_t* HX = F.hx(); bf16_t* Qb = (bf16_t*)(F.ws + WS_Q); bf16_t* KVb = (bf16_t*)(F.ws + WS_KV); bf16_t* Gb = (bf16_t*)(F.ws + WS_G); bf16_t* AO = (bf16_t*)(F.ws + WS_AO);
    bf16_t* HID = (bf16_t*)(F.ws + WS_HID); bf16_t* YB = (bf16_t*)(F.ws + WS_YB);

    if (IN(0)) { Frame Fp = F; asm volatile("" : "+v"(Fp.tid), "+v"(Fp.lane)); p0_prologue(Fp); SEAM(0); }
    if (IN(1)) { Frame Fp = F; asm volatile("" : "+v"(Fp.tid), "+v"(Fp.lane)); p0_misc(Fp); p_norm1_l0(Fp); SEAM(1); }
    if (IN(2)) { Frame Fp = F; asm volatile("" : "+v"(Fp.tid), "+v"(Fp.lane)); SchedDense S{(const bf16_t*)(Fp.ws + WS_WINAB), 1024, TT / 256, 7, 0, 0, Fp.vcu, Fp.G}; EpiInProj<true> E{Qb, KVb, (bf16_t*)(Fp.ws + WS_VN), Gb}; GEMM(Fp, HX, 2048, S, E); SEAM(2); }
    if (IN(3)) { Frame Fp = F; asm volatile("" : "+v"(Fp.tid), "+v"(Fp.lane)); p_k_post(Fp, Fp.in[I_KNA]); p_conv(Fp); SEAM(3); }
    if (IN(4)) { Frame Fp = F; asm volatile("" : "+v"(Fp.tid), "+v"(Fp.lane));
#ifdef ATTN_SIMPLE
        attn_simple<0>(Fp);
#else
        attn_fast<0>(Fp, (char*)lds_raw);
#endif
        SEAM(4); }
    if (IN(5)) { Frame Fp = F; asm volatile("" : "+v"(Fp.tid), "+v"(Fp.lane)); SchedDense S{(const bf16_t*)(Fp.ws + WS_WOUTAB), 1024, TT / 256, 4, 0, 0, Fp.vcu, Fp.G}; EpiOutProj<true> E{Fp, 0}; GEMM(Fp, AO, 2048, S, E);
        SEAM(5); }
    if (IN(6)) { Frame Fp = F; asm volatile("" : "+v"(Fp.tid), "+v"(Fp.lane));
#if (DRYMASK >> 6) & 1
        p_router<DRYV, FP8_G1_L0>(Fp, 0, TT); GRID_BAR();
#endif
        p_router<0, FP8_G1_L0>(Fp, 0, TT); SEAM(6); }
    if (IN(7)) { Frame Fp = F; asm volatile("" : "+v"(Fp.tid), "+v"(Fp.lane)); const MoeTab tb = moe_tables(Fp, 0, (FP8_L0 ? 7 : 8)); SchedMoe S{(const bf16_t*)(Fp.ws + WS_WGU), (size_t)1024 * 1024, (FP8_L0 ? 7 : 8), tb, (const unsigned*)(Fp.ws + WS_LIST), true, Fp.vcu, Fp.G}; EpiMoe1<FP8_G1_L0, FP8_G2_L0, FP8_L0> E{HID}; if constexpr (FP8_L0 && H3) gemm_fp8_h3(Fp, HX, 1024, S, E); else gemm_fast<true, FP8_G1_L0, FP8_L0>(Fp, HX, FP8_G1_L0 ? 1024 : 2048, S, E); SEAM(7); }
    if (IN(8)) { Frame Fp = F; asm volatile("" : "+v"(Fp.tid), "+v"(Fp.lane)); const MoeTab tb = moe_tables(Fp, 0, (FP8_L0 ? 7 : 8)); SchedMoe S{(const bf16_t*)(Fp.ws + WS_WD), (size_t)1024 * 512, (FP8_L0 ? 7 : 8), tb, nullptr, false, Fp.vcu, Fp.G}; EpiMoe2<FP8_G2_L0, FP8_L0> E{YB}; if constexpr (FP8_L0 && H3) gemm_fp8_h3(Fp, HID, 512, S, E); else gemm_fast<ALIGN_G2, FP8_G2_L0, FP8_L0>(Fp, HID, FP8_G2_L0 ? 512 : 1024, S, E); SEAM(8); }
    if (IN(9)) { Frame Fp = F; asm volatile("" : "+v"(Fp.tid), "+v"(Fp.lane)); const MoeTab tb = moe_tables(Fp, 0, (FP8_L0 ? 7 : 8));
#if (DRYMASK >> 9) & 1
        p_combine<false, true>(Fp, 0, TT, tb, FP8_L0 ? 7 : 8); GRID_BAR();
#endif
        p_combine<false, false>(Fp, 0, TT, tb, FP8_L0 ? 7 : 8); SEAM(9); }
    if (IN(10)) { Frame Fp = F; asm volatile("" : "+v"(Fp.tid), "+v"(Fp.lane)); SchedDense S{(const bf16_t*)(Fp.ws + WS_WINCD), 1024, TX / 256, 5, TC / 256, 2, Fp.vcu, Fp.G}; EpiInProj<false> E{Qb, KVb, (bf16_t*)(Fp.ws + WS_VN), Gb}; GEMM(Fp, HX, 2048, S, E); SEAM(10); }
    if (IN(11)) { Frame Fp = F; asm volatile("" : "+v"(Fp.tid), "+v"(Fp.lane)); p_k_post(Fp, Fp.in[I_KNC]); p_pool(Fp); SEAM(11); }
    if (IN(12)) { Frame Fp = F; asm volatile("" : "+v"(Fp.tid), "+v"(Fp.lane));
#ifdef ATTN_SIMPLE
        attn_simple<1>(Fp);
#else
        attn_fast<1>(Fp, (char*)lds_raw);
#endif
        SEAM(12); }
    if (IN(13)) { Frame Fp = F; asm volatile("" : "+v"(Fp.tid), "+v"(Fp.lane)); SchedDense S{(const bf16_t*)(Fp.ws + WS_WOUTCD), 1024, TX / 256, 4, 0, 0, Fp.vcu, Fp.G};
#if (DRYMASK >> 13) & 1
        { EpiOutProj<false, true> Ed{Fp, 1}; GEMMO(Fp, AO, 2048, S, Ed); GRID_BAR(); }
#endif
        EpiOutProj<false> E{Fp, 1}; GEMM(Fp, AO, 2048, S, E); SEAM(13); }
    if (IN(14)) { Frame Fp = F; asm volatile("" : "+v"(Fp.tid), "+v"(Fp.lane));
#if (DRYMASK >> 14) & 1
        p_router<DRYV, FP8_G1_L1>(Fp, 1, TX); GRID_BAR();
#endif
        p_router<0, FP8_G1_L1>(Fp, 1, TX); SEAM(14); }
    if (IN(15)) { Frame Fp = F; asm volatile("" : "+v"(Fp.tid), "+v"(Fp.lane)); const MoeTab tb = moe_tables(Fp, 1, (FP8_L1 ? 7 : 8)); SchedMoe S{(const bf16_t*)(Fp.ws + WS_WGU) + (size_t)32 * 1024 * 1024, (size_t)1024 * 1024, (FP8_L1 ? 7 : 8), tb, (const unsigned*)(Fp.ws + WS_LIST), true, Fp.vcu, Fp.G}; EpiMoe1<FP8_G1_L1, FP8_G2_L1, FP8_L1> E{HID}; if constexpr (FP8_L1 && H3) gemm_fp8_h3(Fp, HX, 1024, S, E); else gemm_fast<true, FP8_G1_L1, FP8_L1>(Fp, HX, FP8_G1_L1 ? 1024 : 2048, S, E); SEAM(15); }
    if (IN(16)) { Frame Fp = F; asm volatile("" : "+v"(Fp.tid), "+v"(Fp.lane)); const MoeTab tb = moe_tables(Fp, 1, (FP8_L1 ? 7 : 8)); SchedMoe S{(const bf16_t*)(Fp.ws + WS_WD) + (size_t)32 * 1024 * 512, (size_t)1024 * 512, (FP8_L1 ? 7 : 8), tb, nullptr, false, Fp.vcu, Fp.G}; EpiMoe2<FP8_G2_L1, FP8_L1> E{YB}; if constexpr (FP8_L1 && H3) gemm_fp8_h3(Fp, HID, 512, S, E); else gemm_fast<ALIGN_G2, FP8_G2_L1, FP8_L1>(Fp, HID, FP8_G2_L1 ? 512 : 1024, S, E); SEAM(16); }
    if (IN(17)) { Frame Fp = F; asm volatile("" : "+v"(Fp.tid), "+v"(Fp.lane)); const MoeTab tb = moe_tables(Fp, 1, (FP8_L1 ? 7 : 8));
#if (DRYMASK >> 17) & 1
        p_combine<true, true>(Fp, 1, TX, tb, FP8_L1 ? 7 : 8); GRID_BAR();
#endif
        p_combine<true, false>(Fp, 1, TX, tb, FP8_L1 ? 7 : 8); }
#ifdef PROBE_PH
    STAMP(NPH - 1);
    if (blockIdx.x == 0 && F.tid == 0) { const unsigned long long t0 = ((unsigned long long)misc[1] << 32) | misc[0], t1 = ((unsigned long long)misc[3] << 32) | misc[2];
        const unsigned long long te = __builtin_amdgcn_s_memrealtime(), span = (t1 - t0) * 16ull;
        while (__builtin_amdgcn_s_memrealtime() - te < span) __builtin_amdgcn_s_sleep(32); }
#endif
#undef IN
#undef SEAM
}

extern "C" void kernel_launch(void* const* d_in, const int* in_sizes, int n_in, void* d_out, int out_size, void* d_ws, size_t ws_size, hipStream_t stream) {
    static int grid = 0;
    if (grid == 0) {
        if (n_in != 30 || out_size != TX * DM || ws_size < WS_END) { fprintf(stderr, "kernel_launch: unexpected shapes (n_in %d out %d ws %zu)\n", n_in, out_size, ws_size); grid = -1; return; }
        int dev = 0, cus = 0;
        if (hipGetDevice(&dev) != hipSuccess || hipDeviceGetAttribute(&cus, hipDeviceAttributeMultiprocessorCount, dev) != hipSuccess) { grid = -1; return; }
        if (hipFuncSetAttribute((const void*)fwd_kernel, hipFuncAttributeMaxDynamicSharedMemorySize, LDS_BYTES) != hipSuccess) { fprintf(stderr, "kernel_launch: hipFuncSetAttribute failed\n"); grid = -1; return; }
        int per_cu = 0;
        if (hipOccupancyMaxActiveBlocksPerMultiprocessor(&per_cu, (const void*)fwd_kernel, NTHREADS, LDS_BYTES) != hipSuccess || per_cu < 1) { fprintf(stderr, "kernel_launch: occupancy query says %d\n", per_cu); }
        (void)hipGetLastError();
        grid = cus;
    }
    if (grid < 0) return;
    (void)hipMemsetAsync((char*)d_ws + WS_CTL, 0, CTL_ZERO_BYTES, stream);
    Params p{};
    for (int i = 0; i < 30; ++i) p.in[i] = (const float*)d_in[i];
    p.out = (float*)d_out; p.ws = (unsigned char*)d_ws;
#if ONE_LAUNCH
    p.ph_lo = 0; p.ph_hi = NPH;
    hipLaunchKernelGGL(fwd_kernel, dim3(grid), dim3(NTHREADS), LDS_BYTES, stream, p);
#else
    for (int ph = 0; ph < NPH; ++ph) { p.ph_lo = ph; p.ph_hi = ph + 1; hipLaunchKernelGGL(fwd_kernel, dim3(grid), dim3(NTHREADS), LDS_BYTES, stream, p); }
#endif
}
```

```cpp
#include <hip/hip_runtime.h>
#include <cstdio>
#include <cstdint>

#ifndef ONE_LAUNCH
#define ONE_LAUNCH 1
#endif

#ifndef FP8_L0
#define FP8_L0 1
#endif
#ifndef FP8_L1
#define FP8_L1 1
#endif
#ifndef H3_ALIGN
#define H3_ALIGN 1
#endif
#ifndef H3
#define H3 1
#endif
#define FP8_G1_L0 FP8_L0
#define FP8_G2_L0 FP8_L0
#define FP8_G1_L1 FP8_L1
#define FP8_G2_L1 FP8_L1
#define LAS __attribute__((address_space(3)))
#define GAS __attribute__((address_space(1)))
typedef unsigned short bf16_t;
typedef short bf16x8 __attribute__((ext_vector_type(8)));
typedef float f32x4 __attribute__((ext_vector_type(4)));
typedef float f32x2 __attribute__((ext_vector_type(2)));
typedef unsigned u32x4 __attribute__((ext_vector_type(4)));
typedef unsigned u32x2 __attribute__((ext_vector_type(2)));
typedef __bf16 bf16x2_t __attribute__((ext_vector_type(2)));

constexpr int NB = 8, SEQ = 4096, DM = 1024, CTXL = 256, HD = 64;
constexpr int TX = NB * SEQ, TC = NB * CTXL, TT = TX + TC;
constexpr int KVS = CTXL + SEQ;
constexpr int NE = 32;
constexpr int NTILE_MAX = 576, NSLOT = 304 * 256;
constexpr float EPS = 1e-6f;
constexpr float LOG2E = 1.4426950408889634f;
constexpr float C2 = 0.125f * LOG2E;
constexpr int NWAVES = 8, NTHREADS = 512;
constexpr int NPH = 18;

enum { I_X = 0, I_C, I_CTX, I_CCTX, I_MODW, I_MODB, I_LN1, I_LN2, I_WINAB, I_WOUTAB, I_QNA, I_KNA, I_CONVW, I_CONVB, I_CLNG, I_CLNB,
       I_WINCD, I_WOUTCD, I_QNC, I_KNC, I_SINK, I_POOLW, I_POOLS, I_RGW, I_RGB, I_REW, I_REB, I_EXG, I_EXU, I_EXD };

constexpr size_t MiB = 1u << 20;
constexpr size_t WS_CTL = 0, CTL_ZERO_BYTES = 1 * MiB;
constexpr size_t WS_MOD = 1 * MiB;
constexpr size_t WS_ROPE = 2 * MiB;
constexpr size_t WS_TOK = 3 * MiB;
constexpr size_t WS_LIST = 4 * MiB;
constexpr size_t WS_WINAB = 10 * MiB;
constexpr size_t WS_WOUTAB = 14 * MiB;
constexpr size_t WS_WINCD = 16 * MiB;
constexpr size_t WS_WOUTCD = 19 * MiB;
constexpr size_t WS_XC = 21 * MiB;
constexpr size_t WS_KN = 30 * MiB;
constexpr size_t WS_VN = 39 * MiB;
constexpr size_t WS_WGU = 48 * MiB;
constexpr size_t WS_WD = 176 * MiB;
constexpr size_t WS_XR = 240 * MiB;
constexpr size_t WS_HID = 308 * MiB;
constexpr size_t WS_Q = 384 * MiB;
constexpr size_t WS_KV = 418 * MiB;
constexpr size_t WS_G = 435 * MiB;
constexpr size_t WS_AO = 469 * MiB;
constexpr size_t WS_YB = 384 * MiB;
constexpr size_t WS_SS = 537 * MiB;
constexpr size_t WS_WR = 9 * MiB;
constexpr size_t WS_GP = 3 * MiB + 896 * 1024;
constexpr size_t WS_END = 540 * MiB;
static_assert(WS_YB + (size_t)NSLOT * 1024 * 2 <= WS_END && WS_AO + (size_t)TT * 1024 * 2 <= WS_END, "ws map");
constexpr int CW_CNT = 256;
constexpr int CW_BAR = 16384;

constexpr int RING_BYTES = 131072;
constexpr int RW_BYTES = 73728;
constexpr int LDS_MISC = 2 * RW_BYTES;
constexpr int LDS_TAB = LDS_MISC + 256;
constexpr int LDS_BYTES = 163840;

__device__ __forceinline__ unsigned pk2(float lo, float hi) { f32x2 v = {lo, hi}; bf16x2_t b = __builtin_convertvector(v, bf16x2_t); return __builtin_bit_cast(unsigned, b); }
__device__ __forceinline__ unsigned pk4_fp8(float a, float b, float c, float d) { int t = __builtin_amdgcn_cvt_pk_fp8_f32(a, b, 0, false); t = __builtin_amdgcn_cvt_pk_fp8_f32(c, d, t, true); return (unsigned)t; }
constexpr float W8_SCALE = 32.f, W8_INV = 1.f / 32.f;
__device__ __forceinline__ float bflo(unsigned w) { return __uint_as_float(w << 16); }
__device__ __forceinline__ float bfhi(unsigned w) { return __uint_as_float(w & 0xffff0000u); }
__device__ __forceinline__ float bf2f(bf16_t h) { return __uint_as_float((unsigned)h << 16); }
__device__ __forceinline__ float wave_sum(float v) {
#pragma unroll
    for (int o = 1; o < 64; o <<= 1) v += __shfl_xor(v, o);
    return v;
}
__device__ __forceinline__ float sigmoidf_(float v) { return 1.f / (1.f + __expf(-v)); }

#define XB_TMO      128
#define XB_XCNT(j)  (256  + 64 * (j))
#define XB_XSUB(j)  (1280 + 64 * (j))
#define XB_XGEN(j)  (2304 + 64 * (j))
#define XB_TOP      3328
#define XB_TOPGEN   3392
#define XCD_BAR_WORDS 3456
#define XB_SPIN_CAP (1u << 18)
__device__ __forceinline__ unsigned xb_ld(unsigned* p)              { return __hip_atomic_load(p, __ATOMIC_RELAXED, __HIP_MEMORY_SCOPE_AGENT); }
__device__ __forceinline__ unsigned xb_add(unsigned* p, unsigned v) { return __hip_atomic_fetch_add(p, v, __ATOMIC_RELAXED, __HIP_MEMORY_SCOPE_AGENT); }
__device__ __forceinline__ unsigned xb_xcc_id() { return (unsigned)__builtin_amdgcn_s_getreg((3 << 11) | 20) & 0xFu; }
#define XB_SPIN(cond, bar) do { unsigned _sp = 0; while (cond) { __builtin_amdgcn_s_sleep(1); \
    if ((++_sp & 255u) == 0u) { if (xb_ld(&(bar)[XB_TMO])) break; if (_sp > XB_SPIN_CAP) { atomicAdd(&(bar)[XB_TMO], 1u); break; } } } } while (0)
struct XcdBarrier { unsigned* bar; unsigned x; volatile LAS unsigned* st; };
__device__ __forceinline__ XcdBarrier xcd_barrier_post(unsigned* bar, volatile LAS unsigned* st) {
    XcdBarrier b; b.bar = bar; b.x = xb_xcc_id(); b.st = st;
    if (threadIdx.x == 0) (void)xb_add(&bar[XB_XCNT(b.x)], 1u);
    return b;
}
__device__ __forceinline__ void xcd_barrier_complete(unsigned* bar, unsigned x, unsigned& nloc, unsigned& nx) {
    const unsigned G = gridDim.x * gridDim.y * gridDim.z;
    unsigned sum, cnt, mine, sp = 0u;
    for (;;) {
        sum = 0u; cnt = 0u; mine = 0u;
#pragma unroll
        for (unsigned j = 0; j < 16; ++j) { const unsigned c = xb_ld(&bar[XB_XCNT(j)]); sum += c; cnt += (c > 0u) ? 1u : 0u; mine = (j == x) ? c : mine; }
        if (sum == G) break;
        __builtin_amdgcn_s_sleep(1);
        if ((++sp & 255u) == 0u) { if (xb_ld(&bar[XB_TMO])) break; if (sp > XB_SPIN_CAP) { atomicAdd(&bar[XB_TMO], 1u); break; } }
    }
    nloc = mine > 0u ? mine : 1u; nx = cnt > 0u ? cnt : 1u;
}
__device__ __forceinline__ void xcd_barrier(const XcdBarrier& b) {
    asm volatile("s_waitcnt vmcnt(0)" ::: "memory");
    __syncthreads();
    if (threadIdx.x == 0) {
        unsigned* bar = b.bar;
        __builtin_amdgcn_s_waitcnt(0);
        unsigned nloc = b.st[0], nx = b.st[1];
        if (nloc == 0u) { xcd_barrier_complete(bar, b.x, nloc, nx); b.st[0] = nloc; b.st[1] = nx; }
        const unsigned old = xb_add(&bar[XB_XSUB(b.x)], 1u);
        const unsigned gen = old / nloc;
        if (old + 1u == (gen + 1u) * nloc) {
            __builtin_amdgcn_fence(__ATOMIC_RELEASE, "agent");
            asm volatile("s_waitcnt vmcnt(0)" ::: "memory");
            const unsigned og = xb_add(&bar[XB_TOP], 1u);
            const unsigned tg = og / nx;
            if (og + 1u == (tg + 1u) * nx) xb_add(&bar[XB_TOPGEN], 1u);
            else XB_SPIN(xb_ld(&bar[XB_TOPGEN]) == tg, bar);
            __builtin_amdgcn_fence(__ATOMIC_ACQUIRE, "agent");
            xb_add(&bar[XB_XGEN(b.x)], 1u);
            asm volatile("s_waitcnt vmcnt(0)" ::: "memory");
        } else {
            XB_SPIN(xb_ld(&bar[XB_XGEN(b.x)]) == gen, bar);
            __builtin_amdgcn_fence(__ATOMIC_ACQUIRE, "agent");
            asm volatile("s_waitcnt vmcnt(0)" ::: "memory");
        }
    }
    __syncthreads();
}

struct Params { const float* in[30]; float* out; unsigned char* ws; int ph_lo, ph_hi; };
struct Frame {
    LAS unsigned char* lds;
    const float* const* in;
    float* out; unsigned char* ws;
    int tid, lane, wave, vcu, G;
    __device__ __forceinline__ const float* mod(int l, int r, int chunk) const { return (const float*)(ws + WS_MOD) + ((size_t)(l * 9 + r) * 6144 + chunk * 1024); }
    __device__ __forceinline__ bf16_t* xr_row(int row) const { return (bf16_t*)(ws + WS_XR) + (size_t)row * DM; }
    __device__ __forceinline__ bf16_t* hx() const { return (bf16_t*)out; }
    __device__ __forceinline__ const float* xin_row(int row) const { return row < TX ? in[I_X] + (size_t)row * DM : in[I_CTX] + (size_t)(row - TX) * DM; }
    __device__ __forceinline__ unsigned* cnt(int l) const { return (unsigned*)(ws + WS_CTL) + CW_CNT + l * 32 * 64; }
};
__device__ __forceinline__ int modrow(int row) { return row < TX ? (row >> 12) : 8; }

__device__ __forceinline__ void p0_mod_item(const Frame& F, int item) {
    const int l = item / 96, cg = item % 96;
    LAS float* sc = (LAS float*)F.lds;
    LAS float* red = sc + 9 * 1024;
    for (int i = F.tid; i < 9 * 1024; i += NTHREADS) { const int r = i >> 10, k = i & 1023; const float v = r < 8 ? F.in[I_C][r * 1024 + k] : F.in[I_CCTX][k]; sc[i] = v / (1.f + expf(-v)); }
    __syncthreads();
    const float* W = F.in[I_MODW] + (size_t)l * 1024 * 6144 + cg * 64 + F.lane;
    float acc[9];
#pragma unroll
    for (int r = 0; r < 9; ++r) acc[r] = 0.f;
    for (int kb = 0; kb < 128; kb += 32) { float w[32];
#pragma unroll
        for (int kk = 0; kk < 32; ++kk) w[kk] = W[(size_t)(F.wave * 128 + kb + kk) * 6144];
#pragma unroll
        for (int kk = 0; kk < 32; ++kk) { const int k = F.wave * 128 + kb + kk;
#pragma unroll
            for (int r = 0; r < 9; ++r) acc[r] += sc[r * 1024 + k] * w[kk]; } }
#pragma unroll
    for (int r = 0; r < 9; ++r) red[(F.wave * 9 + r) * 64 + F.lane] = acc[r];
    __syncthreads();
    for (int i = F.tid; i < 9 * 64; i += NTHREADS) { const int r = i >> 6, ln = i & 63; float s = 0.f;
#pragma unroll
        for (int w = 0; w < 8; ++w) s += red[(w * 9 + r) * 64 + ln];
        ((float*)(F.ws + WS_MOD))[(size_t)(l * 9 + r) * 6144 + cg * 64 + ln] = s + F.in[I_MODB][l * 6144 + cg * 64 + ln]; }
    __syncthreads();
}
struct TDesc { const float* src; unsigned char* dst; int ldw; bool fp8; };
__device__ __forceinline__ void t_load(const TDesc& d, f32x4 (&v)[16], int lane) {
    const int sh = d.fp8 ? 3 : 4, kr = lane >> sh, nq = lane & ((1 << sh) - 1), rs = 64 >> sh;
#pragma unroll
    for (int i = 0; i < 16; ++i) v[i] = *(const f32x4*)(d.src + (size_t)(rs * i + kr) * d.ldw + 4 * nq);
}
__device__ __forceinline__ void t_finish(const TDesc& d, const f32x4 (&v)[16], LAS float* scr, int lane) {
    if (!d.fp8) {
        const int kr = lane >> 4, nq = lane & 15;
#pragma unroll
        for (int i = 0; i < 16; ++i) { LAS float* s = scr + (4 * i + kr) * 65 + 4 * nq; s[0] = v[i][0]; s[1] = v[i][1]; s[2] = v[i][2]; s[3] = v[i][3]; }
        asm volatile("s_waitcnt lgkmcnt(0)" ::: "memory");
        const int c = lane & 7;
#pragma unroll
        for (int j = 0; j < 8; ++j) { const int n = (lane >> 3) + 8 * j; const LAS float* s = scr + (8 * c) * 65 + n;
            u32x4 o; o.x = pk2(s[0 * 65], s[1 * 65]); o.y = pk2(s[2 * 65], s[3 * 65]); o.z = pk2(s[4 * 65], s[5 * 65]); o.w = pk2(s[6 * 65], s[7 * 65]);
            *(u32x4*)(d.dst + ((size_t)n * 64 + 8 * c) * 2) = o; }
    } else {
        const int kr = lane >> 3, nq = lane & 7;
#pragma unroll
        for (int i = 0; i < 16; ++i) { LAS float* s = scr + (8 * i + kr) * 33 + 4 * nq; s[0] = v[i][0]; s[1] = v[i][1]; s[2] = v[i][2]; s[3] = v[i][3]; }
        asm volatile("s_waitcnt lgkmcnt(0)" ::: "memory");
        const int c = lane & 7;
#pragma unroll
        for (int j = 0; j < 4; ++j) { const int n = (lane >> 3) + 8 * j; const LAS float* s = scr + (16 * c) * 33 + n;
            u32x4 o;
            o.x = pk4_fp8(s[0 * 33] * W8_SCALE, s[1 * 33] * W8_SCALE, s[2 * 33] * W8_SCALE, s[3 * 33] * W8_SCALE); o.y = pk4_fp8(s[4 * 33] * W8_SCALE, s[5 * 33] * W8_SCALE, s[6 * 33] * W8_SCALE, s[7 * 33] * W8_SCALE);
            o.z = pk4_fp8(s[8 * 33] * W8_SCALE, s[9 * 33] * W8_SCALE, s[10 * 33] * W8_SCALE, s[11 * 33] * W8_SCALE); o.w = pk4_fp8(s[12 * 33] * W8_SCALE, s[13 * 33] * W8_SCALE, s[14 * 33] * W8_SCALE, s[15 * 33] * W8_SCALE);
            *(u32x4*)(d.dst + (size_t)n * 128 + 16 * c) = o; }
    }
    asm volatile("s_waitcnt lgkmcnt(0)" ::: "memory");
}
constexpr int TN_AB = 16 * 28, TN_OAB = 16 * 16, TN_CD = 16 * 20, TN_OCD = 8 * 16, TN_G = 64 * 128, TN_U = 64 * 128, TN_D = 64 * 128;
constexpr int TN_ITEMS = TN_AB + TN_OAB + TN_CD + TN_OCD + TN_G + TN_U + TN_D;
__device__ __forceinline__ TDesc t_decode(const Frame& F, int it) {
    TDesc d; d.fp8 = false; int r = it;
    if (r < TN_AB) { const int kb = r / 28, nb = r % 28, n0 = nb * 64; int d0;
        if (n0 < 768) d0 = n0; else if (n0 < 1280) { const int j = n0 - 768; d0 = 768 + (j >> 7) * 256 + (j & 127); } else { const int j = n0 - 1280; d0 = 768 + (j >> 7) * 256 + 128 + (j & 127); }
        d.src = F.in[I_WINAB] + (size_t)kb * 64 * 1792 + n0; d.ldw = 1792; d.dst = F.ws + WS_WINAB + ((size_t)kb * 1792 + d0) * 128; return d; } r -= TN_AB;
    if (r < TN_OAB) { const int kb = r / 16, nb = r % 16; d.src = F.in[I_WOUTAB] + (size_t)kb * 64 * 1024 + nb * 64; d.ldw = 1024; d.dst = F.ws + WS_WOUTAB + ((size_t)kb * 1024 + nb * 64) * 128; return d; } r -= TN_OAB;
    if (r < TN_CD) { const int kb = r / 20, nb = r % 20; d.src = F.in[I_WINCD] + (size_t)kb * 64 * 1280 + nb * 64; d.ldw = 1280; d.dst = F.ws + WS_WINCD + ((size_t)kb * 1280 + nb * 64) * 128; return d; } r -= TN_CD;
    if (r < TN_OCD) { const int kb = r / 16, nb = r % 16; d.src = F.in[I_WOUTCD] + (size_t)kb * 64 * 1024 + nb * 64; d.ldw = 1024; d.dst = F.ws + WS_WOUTCD + ((size_t)kb * 1024 + nb * 64) * 128; return d; } r -= TN_OCD;
    if (r < TN_G + TN_U) { const bool up = r >= TN_G; if (up) r -= TN_G; const int le = r >> 7, q = r & 127;
        const float* base = F.in[up ? I_EXU : I_EXG] + (size_t)le * 1024 * 512; unsigned char* wb = F.ws + WS_WGU + (size_t)le * 1024 * 1024 * 2;
        if ((le >> 5) ? FP8_G1_L1 : FP8_G1_L0) { const int kb = q >> 4, n0 = (q & 15) * 32, d0 = (n0 >> 7) * 256 + (up ? 128 : 0) + (n0 & 127);
            d.fp8 = true; d.src = base + (size_t)kb * 128 * 512 + n0; d.ldw = 512; d.dst = wb + ((size_t)kb * 1024 + d0) * 128; return d; }
        const int kb = q >> 3, n0 = (q & 7) * 64, d0 = (n0 >> 7) * 256 + (up ? 128 : 0) + (n0 & 127);
        d.src = base + (size_t)kb * 64 * 512 + n0; d.ldw = 512; d.dst = wb + ((size_t)kb * 1024 + d0) * 128; return d; } r -= TN_G + TN_U;
    { const int le = r >> 7, q = r & 127; const float* base = F.in[I_EXD] + (size_t)le * 512 * 1024; unsigned char* wb = F.ws + WS_WD + (size_t)le * 1024 * 512 * 2;
        if ((le >> 5) ? FP8_G2_L1 : FP8_G2_L0) { const int kb = q >> 5, nb = q & 31;
            d.fp8 = true; d.src = base + (size_t)kb * 128 * 1024 + nb * 32; d.ldw = 1024; d.dst = wb + ((size_t)kb * 1024 + nb * 32) * 128; return d; }
        const int kb = q >> 4, nb = q & 15;
        d.src = base + (size_t)kb * 64 * 1024 + nb * 64; d.ldw = 1024; d.dst = wb + ((size_t)kb * 1024 + nb * 64) * 128; return d; }
}
constexpr int TN_DENSE = TN_AB + TN_OAB + TN_CD + TN_OCD;
__device__ __forceinline__ void transpose_range(const Frame& F, int lo, int hi, int w, int nw) {
    LAS float* scr = (LAS float*)(F.lds + F.wave * 16896);
    f32x4 va[16], vb[16]; TDesc da, db;
    const int first = lo + w;
    if (first < hi) { da = t_decode(F, first); t_load(da, va, F.lane); }
    for (int it = first; it < hi; it += 2 * nw) {
        const int it2 = it + nw, it3 = it + 2 * nw;
        if (it2 < hi) { db = t_decode(F, it2); t_load(db, vb, F.lane); }
        t_finish(da, va, scr, F.lane);
        if (it3 < hi) { da = t_decode(F, it3); t_load(da, va, F.lane); }
        if (it2 < hi) t_finish(db, vb, scr, F.lane);
    }
}
__device__ __forceinline__ void p0_prologue(const Frame& F) { for (int it = F.vcu; it < 192; it += F.G) p0_mod_item(F, it); }
__device__ __forceinline__ void p0_misc(const Frame& F) {
    const int gw = F.vcu * NWAVES + F.wave, NGW = F.G * NWAVES;
    const int gt = gw * 64 + F.lane, NGT = NGW * 64;
    { float* rc = (float*)(F.ws + WS_ROPE); float* rs = rc + SEQ * 32;
      for (int i = gt; i < SEQ * 32; i += NGT) { const int s = i >> 5, d = i & 31, f = d & 15; const float pos = (float)(d < 16 ? (s >> 6) : (s & 63));
          const float inv = exp2f(-(float)f * (13.287712379549449f / 16.f)); const float a = pos * inv; rc[i] = cosf(a); rs[i] = sinf(a); } }
    { typedef float f32x16_t __attribute__((ext_vector_type(16)));
      bf16_t* WT = (bf16_t*)(F.ws + WS_WOUTCD); const int l31 = F.lane & 31, lh = F.lane >> 5;
      for (int it = gw; it < 4 * 32 * 4; it += NGW) { const int g = it >> 7, dt = (it >> 2) & 31, ct = it & 3;
          const float* wo = F.in[I_WOUTCD] + (size_t)(512 + g * 128 + lh) * 1024 + dt * 32 + l31;
          const float* pw = F.in[I_POOLW] + (size_t)(g * 128 + ct * 32 + l31) * 128 + lh; const float* ps = F.in[I_POOLS] + g * 128 + lh;
          f32x16_t acc;
#pragma unroll
          for (int r = 0; r < 16; ++r) acc[r] = 0.f;
          for (int dp0 = 0; dp0 < 128; dp0 += 16) { float av[8], bv[8];
#pragma unroll
              for (int u = 0; u < 8; ++u) { av[u] = wo[(size_t)(dp0 + 2 * u) * 1024]; bv[u] = pw[dp0 + 2 * u] * ps[dp0 + 2 * u]; }
#pragma unroll
              for (int u = 0; u < 8; ++u) acc = __builtin_amdgcn_mfma_f32_32x32x2f32(av[u], bv[u], acc, 0, 0, 0); }
#pragma unroll
          for (int r = 0; r < 16; ++r) { const int i = (r & 3) + 8 * (r >> 2) + 4 * lh; const int k_ = 512 + g * 128 + ct * 32 + l31; WT[((size_t)(k_ >> 6) * 1024 + dt * 32 + i) * 64 + (k_ & 63)] = (bf16_t)(pk2(acc[r], 0.f) & 0xffffu); } } }
    { bf16_t* WR = (bf16_t*)(F.ws + WS_WR);
      for (int i = gt; i < 2 * 32 * 144 * 8; i += NGT) { const int j = i & 7, e16 = (i >> 3) % 144, s_ = (i / (8 * 144)) & 31, l = i / (8 * 144 * 32);
          int col; bool grp = false; int c;
          if (e16 < 128) { const int lane_ = e16 & 63, row = lane_ & 15; c = lane_ >> 4; col = 8 * (row >> 2) + (e16 < 64 ? 0 : 4) + (row & 3); }
          else { const int q = e16 - 128; c = q & 3; col = q >> 2; grp = true; }
          const int k = 32 * s_ + 8 * c + j;
          const float w = grp ? F.in[I_RGW][(size_t)l * 4096 + k * 4 + col] : F.in[I_REW][(size_t)l * 32768 + k * 32 + col];
          const unsigned hi = pk2(w, 0.f) & 0xffffu; const unsigned lo = pk2(w - bflo(hi), 0.f) & 0xffffu;
          const size_t o = (size_t)s_ * 1152 + (size_t)e16 * 8 + j;
          WR[(size_t)(l * 2 + 0) * 36864 + o] = (bf16_t)hi; WR[(size_t)(l * 2 + 1) * 36864 + o] = (bf16_t)lo; } }
    transpose_range(F, 0, F.G == 256 ? TN_DENSE : TN_ITEMS, gw, NGW);
}

__device__ __forceinline__ void norm_mod_row(const float* xrow, const float* g, const float* sh, const float* sc, int lane, f32x4 (&h)[4]) {
    f32x4 v[4]; float ss = 0.f;
#pragma unroll
    for (int j = 0; j < 4; ++j) { v[j] = *(const f32x4*)(xrow + 4 * lane + 256 * j); ss += (v[j][0] * v[j][0] + v[j][1] * v[j][1]) + (v[j][2] * v[j][2] + v[j][3] * v[j][3]); }
    const float rms = 1.0f / sqrtf(wave_sum(ss) * (1.f / 1024.f) + EPS);
#pragma unroll
    for (int j = 0; j < 4; ++j) { const int c = 4 * lane + 256 * j; const f32x4 gg = *(const f32x4*)(g + c), s1 = *(const f32x4*)(sc + c), s0 = *(const f32x4*)(sh + c);
        h[j] = (v[j] * rms * gg) * (1.f + s1) + s0; }
}
__device__ __forceinline__ void store_row_bf16(bf16_t* orow, int lane, const f32x4 (&h)[4]) {
#pragma unroll
    for (int j = 0; j < 4; ++j) { u32x2 o; o.x = pk2(h[j][0], h[j][1]); o.y = pk2(h[j][2], h[j][3]); *(u32x2*)(orow + 4 * lane + 256 * j) = o; }
}
struct RowBuf { f32x4 v[4]; };
__device__ __forceinline__ void row_load(RowBuf& b, const float* xrow, int lane) {
#pragma unroll
    for (int j = 0; j < 4; ++j) b.v[j] = *(const f32x4*)(xrow + 4 * lane + 256 * j);
}
__device__ __forceinline__ void row_norm_store(const RowBuf& b, const float* g, const float* sh, const float* sc, bf16_t* orow, int lane) {
    float ss = 0.f;
#pragma unroll
    for (int j = 0; j < 4; ++j) ss += (b.v[j][0] * b.v[j][0] + b.v[j][1] * b.v[j][1]) + (b.v[j][2] * b.v[j][2] + b.v[j][3] * b.v[j][3]);
    const float rms = 1.0f / sqrtf(wave_sum(ss) * (1.f / 1024.f) + EPS);
    f32x4 h[4];
#pragma unroll
    for (int j = 0; j < 4; ++j) { const int c = 4 * lane + 256 * j; h[j] = (b.v[j] * rms * *(const f32x4*)(g + c)) * (1.f + *(const f32x4*)(sc + c)) + *(const f32x4*)(sh + c); }
    store_row_bf16(orow, lane, h);
}
__device__ __forceinline__ void p_norm1_l0(const Frame& F) {
    const int gw = F.vcu * NWAVES + F.wave, NGW = F.G * NWAVES;
    { float* GP = (float*)(F.ws + WS_GP);
      for (int i = gw * 64 + F.lane; i < 2 * 9 * 1024; i += NGW * 64) { const int k = i & 1023, lr = i >> 10; GP[i] = F.in[I_LN2][(lr / 9) * 1024 + k] * (1.f + F.mod(lr / 9, lr % 9, 4)[k]); } }
    bf16_t* HX = F.hx();
    RowBuf A, B;
    if (gw < TT) row_load(A, F.xin_row(gw), F.lane);
    for (int row = gw; row < TT; row += 2 * NGW) {
        const int row2 = row + NGW, row3 = row + 2 * NGW;
        if (row2 < TT) row_load(B, F.xin_row(row2), F.lane);
        { const int r = modrow(row); row_norm_store(A, F.in[I_LN1], F.mod(0, r, 0), F.mod(0, r, 1), HX + (size_t)row * DM, F.lane); }
        if (row3 < TT) row_load(A, F.xin_row(row3), F.lane);
        if (row2 < TT) { const int r = modrow(row2); row_norm_store(B, F.in[I_LN1], F.mod(0, r, 0), F.mod(0, r, 1), HX + (size_t)row2 * DM, F.lane); }
    }
}

struct Unit { int pm, pn, e; };
struct SchedDense {
    const bf16_t* Bt; int K, nMa, nN, nMb, pnb, vcu, G;
    __device__ __forceinline__ bool next(int i, Unit& u) const { int L = i * G + vcu; const int na = nMa * nN; u.e = 0;
        if (L < na) { u.pm = L / nN; u.pn = L % nN; return true; } L -= na; if (L < nMb) { u.pm = nMa + L; u.pn = pnb; return true; } return false; }
    __device__ __forceinline__ int arow(const Unit& u, int r) const { return u.pm * 256 + r; }
    __device__ __forceinline__ const bf16_t* bbase(const Unit& u) const { return Bt + (size_t)u.pn * 256 * 64; }
    __device__ __forceinline__ int brows() const { return nN * 256; }
};
struct MoeTab { const LAS int* tile_e; const LAS int* tile0; const LAS int* cnt; int ntiles; };
struct SchedMoe {
    const bf16_t* Wt; size_t estride; int tsh; MoeTab tb; const unsigned* list; bool gather; int vcu, G;
    __device__ __forceinline__ bool next(int i, Unit& u) const { const int L = i * G + vcu; if (L >= tb.ntiles * 4) return false; u.pm = L >> 2; u.pn = L & 3; u.e = tb.tile_e[u.pm]; return true; }
    __device__ __forceinline__ int arow(const Unit& u, int r) const {
        if (!gather) return (u.pm << tsh) + r;
        int idx = ((u.pm - tb.tile0[u.e]) << tsh) + r; const int c = tb.cnt[u.e]; idx = idx < c ? idx : c - 1;
        return (int)list[(size_t)u.e * TT + idx]; }
    __device__ __forceinline__ const bf16_t* bbase(const Unit& u) const { return Wt + (size_t)u.e * estride + (size_t)u.pn * 256 * 64; }
    __device__ __forceinline__ int brows() const { return 1024; }
};
__device__ __forceinline__ MoeTab moe_tables(const Frame& F, int l, int tsh) {
    LAS int* tile_e = (LAS int*)(F.lds + LDS_TAB); LAS int* tile0 = tile_e + NTILE_MAX; LAS int* cntl = tile0 + 33; LAS int* nt = cntl + 32;
    __syncthreads();
    if (F.tid < 64) {
        const int e = F.lane & 31; unsigned* cg = F.cnt(l);
        const int c = (int)__hip_atomic_load(cg + e * 64, __ATOMIC_RELAXED, __HIP_MEMORY_SCOPE_AGENT); const int n = (c + (1 << tsh) - 1) >> tsh;
        int incl = n;
#pragma unroll
        for (int o = 1; o < 32; o <<= 1) { const int v = __shfl_up(incl, o, 32); if (e >= o) incl += v; }
        const int t0 = incl - n;
        if (F.lane < 32) { tile0[e] = t0; cntl[e] = c; for (int j = 0; j < n; ++j) tile_e[t0 + j] = e; if (e == 31) { tile0[32] = incl; nt[0] = incl; } }
    }
    __syncthreads();
    MoeTab tb; tb.tile_e = tile_e; tb.tile0 = tile0; tb.cnt = cntl; tb.ntiles = nt[0]; return tb;
}

namespace pg8 {
constexpr int BM = 256, BK = 64, HALF = 128, HTB = HALF * BK * 2;
__device__ __forceinline__ int lds_byte(int r, int c) { const int st = (r >> 4) * 2 + (c >> 5), rr = r & 15, cc = c & 31, ob = rr * 64 + cc * 2; return st * 1024 + (ob ^ (((ob >> 9) & 1) << 5)); }
__device__ __forceinline__ void stage_rc(int b, int& R, int& C) { const int st = b / 1024, sb = b % 1024, swz = sb ^ (((sb >> 9) & 1) << 5); R = (st >> 1) * 16 + swz / 64; C = (st & 1) * 32 + (swz % 64) / 2; }
__device__ __forceinline__ int perm32(int rho) { const int n = rho >> 4, i = rho & 15; return 8 * (i >> 2) + 4 * n + (i & 3); }
}
typedef int v8i_t __attribute__((ext_vector_type(8)));
typedef int v4i_t __attribute__((ext_vector_type(4)));
__device__ __forceinline__ v8i_t frag32(bf16x8 lo, bf16x8 hi) { return __builtin_shufflevector(__builtin_bit_cast(v4i_t, lo), __builtin_bit_cast(v4i_t, hi), 0, 1, 2, 3, 4, 5, 6, 7); }
template <bool ALIGN_EPI, bool FP8, bool HALFM, class Sched, class Epi>
__device__ __forceinline__ void gemm_fast(const Frame& F, const void* A, int KB, const Sched& S, const Epi& E) {
    using namespace pg8;
    LAS unsigned char* lds = F.lds;
    const int tid = F.tid, wid = F.wave, lane = F.lane, wr = wid >> 2, wc = wid & 3, fr = lane & 15, fq = lane >> 4;
    const int nt = KB / (BK * 2);
    unsigned voffB[2];
#pragma unroll
    for (int i = 0; i < 2; ++i) { int R, C; stage_rc(tid * 16 + i * 8192, R, C); const int Rb = (R & ~31) + perm32(R & 31); voffB[i] = (unsigned)(Rb * 64 + C) * 2u; }
    const size_t kstep = (size_t)(BK * 2);
    const size_t kstepB = (size_t)S.brows() * BK * 2;
    const size_t hstep = (size_t)HALF * BK * 2;
    const unsigned ldsw = (unsigned)wid * 1024u;
    const int aoff = lds_byte(wr * 64 + fr, fq * (FP8 ? 16 : 8)), boff = lds_byte(wc * 32 + fr, fq * (FP8 ? 16 : 8));
    const char* Ab = (const char*)A;
#define PG8_SA(b, h) (((b) * 2 + (h)) * HTB)
#define PG8_SB(b, h) ((4 + (b) * 2 + (h)) * HTB)
#define PG8_STAGE(bufoff, gbase, voff) do { _Pragma("unroll") for (int _i = 0; _i < 2; ++_i) \
        __builtin_amdgcn_global_load_lds((const unsigned*)((const char*)(gbase) + (voff)[_i]), (LAS unsigned*)(lds + (bufoff) + ldsw + _i * 8192), 16, 0, 0); } while (0)
#define PG8_LD32(p) __builtin_shufflevector(*(const LAS v4i_t*)(p), *(const LAS v4i_t*)((p) + 16), 0, 1, 2, 3, 4, 5, 6, 7)
#define PG8_LDA(dst, b, h) do { if constexpr (FP8) { _Pragma("unroll") for (int m = 0; m < 4; ++m) dst##8[m] = PG8_LD32(lds + PG8_SA(b, h) + aoff + m * 2048); } \
        else { _Pragma("unroll") for (int m = 0; m < 4; ++m) _Pragma("unroll") for (int k = 0; k < 2; ++k) dst[m][k] = *(const LAS bf16x8*)(lds + PG8_SA(b, h) + aoff + m * 2048 + k * 1024); } } while (0)
#define PG8_LDB(dst, b, h) do { if constexpr (FP8) { _Pragma("unroll") for (int n = 0; n < 2; ++n) dst##8[n] = PG8_LD32(lds + PG8_SB(b, h) + boff + n * 2048); } \
        else { _Pragma("unroll") for (int n = 0; n < 2; ++n) _Pragma("unroll") for (int k = 0; k < 2; ++k) dst[n][k] = *(const LAS bf16x8*)(lds + PG8_SB(b, h) + boff + n * 2048 + k * 1024); } } while (0)
#define PG8_MMA(ai, bj, At, Bt) do { __builtin_amdgcn_s_setprio(1); _Pragma("unroll") for (int m = 0; m < 4; ++m) _Pragma("unroll") for (int n = 0; n < 2; ++n) { \
        if constexpr (FP8) acc[ai][bj][m][n] = __builtin_amdgcn_mfma_scale_f32_16x16x128_f8f6f4(Bt##8[n], At##8[m], acc[ai][bj][m][n], 0, 0, 0, 0x7F7F7F7F, 0, 0x7F7F7F7F); \
        else { _Pragma("unroll") for (int k = 0; k < 2; ++k) acc[ai][bj][m][n] = __builtin_amdgcn_mfma_f32_16x16x32_bf16(Bt[n][k], At[m][k], acc[ai][bj][m][n], 0, 0, 0); } } __builtin_amdgcn_s_setprio(0); } while (0)
#define PG8_WAIT_V(n) asm volatile("s_waitcnt vmcnt(" #n ")" ::: "memory")
#define PG8_WAIT_L(n) asm volatile("s_waitcnt lgkmcnt(" #n ")" ::: "memory")
#define PG8_BAR __builtin_amdgcn_s_barrier()
#define PG8_SCHED __builtin_amdgcn_sched_barrier(0)
    LAS unsigned* rtab = (LAS unsigned*)(lds + RING_BYTES);
    unsigned tA[2], cA[2];
#pragma unroll
    for (int i = 0; i < 2; ++i) { int R, C; stage_rc(tid * 16 + i * 8192, R, C); tA[i] = (unsigned)R; cA[i] = (unsigned)(C * 2); }
#define PG8_RFILL(sel, u) do { if (tid < (HALFM ? 128 : 256)) rtab[(sel) * 256 + tid] = (unsigned)S.arow(u, tid) * (unsigned)KB; } while (0)
#define PG8_STAGEA(bufoff, gbase, sel, h) do { _Pragma("unroll") for (int _i = 0; _i < 2; ++_i) { const unsigned vo_ = rtab[(sel) * 256 + (h) * 128 + tA[_i]] + cA[_i]; \
        __builtin_amdgcn_global_load_lds((const unsigned*)((const char*)(gbase) + vo_), (LAS unsigned*)(lds + (bufoff) + ldsw + _i * 8192), 16, 0, 0); } } while (0)
    Unit cur, nxt; int ui = 0;
    if (!S.next(0, cur)) return;
    f32x4 acc[2][2][4][2];
    float zero_ = 0.f; asm volatile("" : "+v"(zero_));
#pragma unroll
    for (int a = 0; a < 2; ++a)
#pragma unroll
        for (int b = 0; b < 2; ++b)
#pragma unroll
            for (int m = 0; m < 4; ++m)
#pragma unroll
                for (int n = 0; n < 2; ++n) acc[a][b][m][n] = (f32x4){zero_, zero_, zero_, zero_};
    bf16x8 At[4][2], B0[2][2], B1[2][2]; v8i_t At8[4], B08[2], B18[2];
    int csel = 0;
    PG8_RFILL(0, cur);
    PG8_WAIT_L(0); PG8_BAR;
    const char* cB = (const char*)S.bbase(cur);
    PG8_STAGE(PG8_SB(0, 0), cB, voffB); PG8_STAGE(PG8_SB(0, 1), cB + hstep, voffB); PG8_STAGEA(PG8_SA(0, 0), Ab, 0, 0); if constexpr (!HALFM) PG8_STAGEA(PG8_SA(0, 1), Ab, 0, 1);
    if (wr == 1) PG8_BAR;
    if constexpr (HALFM) PG8_WAIT_V(0); else PG8_WAIT_V(2);
    PG8_BAR;
    PG8_STAGE(PG8_SB(1, 0), cB + kstepB, voffB); PG8_STAGEA(PG8_SA(1, 0), Ab + kstep, 0, 0); PG8_STAGE(PG8_SB(1, 1), cB + hstep + kstepB, voffB);
    PG8_WAIT_V(6); PG8_BAR;
    for (;;) {
        const bool has_next = S.next(ui + 1, nxt);
        const char* nB = cB;
        if (has_next) { PG8_RFILL(csel ^ 1, nxt); nB = (const char*)S.bbase(nxt); }
        const int nsel = has_next ? (csel ^ 1) : csel;
#pragma unroll 1
        for (int t = 0; t < nt; t += 2) {
            const bool last = (t == nt - 2);
            const char* a1 = Ab + (size_t)(t + 1) * kstep;
            const char* a2 = last ? Ab : Ab + (size_t)(t + 2) * kstep; const char* b2 = last ? nB : cB + (size_t)(t + 2) * kstepB;
            const char* a3 = a2 + kstep; const char* b3 = b2 + kstepB;
            const int sel2 = last ? nsel : csel;
            PG8_LDB(B0, 0, 0); PG8_LDB(B1, 0, 1); PG8_SCHED; PG8_LDA(At, 0, 0); if constexpr (!HALFM) PG8_STAGEA(PG8_SA(1, 1), a1, csel, 1);
            PG8_WAIT_V(8); PG8_WAIT_L(0); PG8_BAR; PG8_MMA(0, 0, At, B0); PG8_MMA(0, 1, At, B1); PG8_BAR; PG8_SCHED;
            if constexpr (!HALFM) PG8_LDA(At, 0, 1);
            PG8_STAGE(PG8_SB(0, 0), b2, voffB); PG8_STAGE(PG8_SB(0, 1), b2 + hstep, voffB); PG8_STAGEA(PG8_SA(0, 0), a2, sel2, 0);
            if constexpr (HALFM) PG8_WAIT_V(6); else PG8_WAIT_V(8);
            PG8_WAIT_L(0); PG8_BAR; if constexpr (!HALFM) { PG8_MMA(1, 0, At, B0); PG8_MMA(1, 1, At, B1); } PG8_BAR; PG8_SCHED;
            PG8_LDB(B0, 1, 0); PG8_LDB(B1, 1, 1); PG8_SCHED; PG8_LDA(At, 1, 0); if constexpr (!HALFM) PG8_STAGEA(PG8_SA(0, 1), a2, sel2, 1);
            PG8_WAIT_V(8); PG8_WAIT_L(0); PG8_BAR; PG8_MMA(0, 0, At, B0); PG8_MMA(0, 1, At, B1); PG8_BAR; PG8_SCHED;
            if constexpr (!HALFM) PG8_LDA(At, 1, 1);
            PG8_STAGE(PG8_SB(1, 0), b3, voffB); PG8_STAGE(PG8_SB(1, 1), b3 + hstep, voffB); PG8_STAGEA(PG8_SA(1, 0), a3, sel2, 0);
            if constexpr (HALFM) PG8_WAIT_V(6); else PG8_WAIT_V(8);
            PG8_WAIT_L(0); PG8_BAR; if constexpr (!HALFM) { PG8_MMA(1, 0, At, B0); PG8_MMA(1, 1, At, B1); } PG8_BAR; PG8_SCHED;
        }
        if (ALIGN_EPI) { if (wr == 0) PG8_BAR; }
        E(acc, cur, wr, wc, fr, fq);
        if (!has_next) break;
        asm volatile("" : "+v"(zero_));
#pragma unroll
        for (int a = 0; a < 2; ++a)
#pragma unroll
            for (int b = 0; b < 2; ++b)
#pragma unroll
                for (int m = 0; m < 4; ++m)
#pragma unroll
                    for (int n = 0; n < 2; ++n) acc[a][b][m][n] = (f32x4){zero_, zero_, zero_, zero_};
        cur = nxt; cB = nB; ++ui; csel = nsel;
        if (ALIGN_EPI) { if (wr == 1) PG8_BAR; }
    }
    PG8_WAIT_V(0);
    if (!ALIGN_EPI) { if (wr == 0) PG8_BAR; }
    PG8_BAR;
#undef PG8_RFILL
#undef PG8_STAGEA
#undef PG8_SA
#undef PG8_SB
#undef PG8_STAGE
#undef PG8_LD32
#undef PG8_LDA
#undef PG8_LDB
#undef PG8_MMA
#undef PG8_WAIT_V
#undef PG8_WAIT_L
#undef PG8_BAR
#undef PG8_SCHED
}
template <class Sched, class Epi>
__device__ __forceinline__ void gemm_fp8_h3(const Frame& F, const void* A, int KB, const Sched& S, const Epi& E) {
    using namespace pg8;
    LAS unsigned char* lds = F.lds;
    const int tid = F.tid, wid = F.wave, lane = F.lane, wr = wid >> 2, wc = wid & 3, fr = lane & 15, fq = lane >> 4;
#ifdef PROBE_KREP
    const int ntk = KB / 128, nt = 2 * ntk;
#else
    const int ntk = KB / 128, nt = ntk;
#endif
    constexpr int BUF = 49152, RTAB_OFF = LDS_TAB + 2048 + 8192 + 256;
    unsigned voffB[2], tA[2], cA[2];
#pragma unroll
    for (int i = 0; i < 2; ++i) { int R, C; stage_rc(tid * 16 + i * 8192, R, C); const int Rb = (R & ~31) + perm32(R & 31); voffB[i] = (unsigned)(Rb * 64 + C) * 2u; tA[i] = (unsigned)R; cA[i] = (unsigned)(C * 2); }
    const size_t kstepB = (size_t)S.brows() * 128, hstep = (size_t)128 * 128;
    const unsigned ldsw = (unsigned)wid * 1024u;
    const int aoff = lds_byte(wr * 64 + fr, fq * 16), boff = lds_byte(wc * 32 + fr, fq * 16);
    const char* Ab = (const char*)A;
    LAS unsigned* rtab = (LAS unsigned*)(lds + RTAB_OFF);
#define H3_RFILL(sel, u) do { if (tid < 128) rtab[(sel) * 128 + tid] = (unsigned)S.arow(u, tid) * (unsigned)KB; } while (0)
#define H3_STAGE(bo, gbase, voff) do { _Pragma("unroll") for (int _i = 0; _i < 2; ++_i) \
        __builtin_amdgcn_global_load_lds((const unsigned*)((const char*)(gbase) + (voff)[_i]), (LAS unsigned*)(lds + (bo) + ldsw + _i * 8192), 16, 0, 0); } while (0)
#define H3_STAGEA(bo, gbase, sel) do { _Pragma("unroll") for (int _i = 0; _i < 2; ++_i) { const unsigned vo_ = rtab[(sel) * 128 + tA[_i]] + cA[_i]; \
        __builtin_amdgcn_global_load_lds((const unsigned*)((const char*)(gbase) + vo_), (LAS unsigned*)(lds + (bo) + 32768 + ldsw + _i * 8192), 16, 0, 0); } } while (0)
#define H3_LD32(p) __builtin_shufflevector(*(const LAS v4i_t*)(p), *(const LAS v4i_t*)((p) + 16), 0, 1, 2, 3, 4, 5, 6, 7)
#define H3_TILE(bo, bptr, aptr, sel) do { H3_STAGE((bo), (bptr), voffB); H3_STAGE((bo) + 16384, (bptr) + hstep, voffB); H3_STAGEA((bo), (aptr), (sel)); } while (0)
#define H3_BAR __builtin_amdgcn_s_barrier()
    Unit cur, nxt; int ui = 0;
    if (!S.next(0, cur)) return;
    f32x4 acc[2][4][2];
    float zero_ = 0.f; asm volatile("" : "+v"(zero_));
#pragma unroll
    for (int b = 0; b < 2; ++b)
#pragma unroll
        for (int m = 0; m < 4; ++m)
#pragma unroll
            for (int n = 0; n < 2; ++n) acc[b][m][n] = (f32x4){zero_, zero_, zero_, zero_};
    v8i_t At8[4], B08[2], B18[2];
    int csel = 0;
    H3_RFILL(0, cur);
    asm volatile("s_waitcnt lgkmcnt(0)" ::: "memory"); H3_BAR;
    const char* cB = (const char*)S.bbase(cur);
    int o0 = 0, o1 = BUF, o2 = 2 * BUF;
    H3_TILE(o0, cB, Ab, 0); H3_TILE(o1, cB + kstepB, Ab + 128, 0);
    asm volatile("s_waitcnt vmcnt(6)" ::: "memory"); H3_BAR;
    if (wr == 1) H3_BAR;
    for (;;) {
        const bool has_next = S.next(ui + 1, nxt);
        const char* nB = cB;
        unsigned nrow = 0u;
        if (has_next) { if (tid < 128) nrow = (unsigned)S.arow(nxt, tid) * (unsigned)KB; nB = (const char*)S.bbase(nxt); }
        const int nsel = has_next ? (csel ^ 1) : csel;
#pragma unroll 1
        for (int t = 0; t < nt; ++t) {
            const int t2 = t + 2; const bool nx = t2 >= nt; const int k2 = (nx ? t2 - nt : t2) % ntk;
#ifdef PROBE_KREP
            if (t == ntk) {
#pragma unroll
                for (int b_ = 0; b_ < 2; ++b_)
#pragma unroll
                    for (int m_ = 0; m_ < 4; ++m_)
#pragma unroll
                        for (int n_ = 0; n_ < 2; ++n_) acc[b_][m_][n_] = (f32x4){zero_, zero_, zero_, zero_}; }
#endif
            const char* b2 = (nx ? nB : cB) + (size_t)k2 * kstepB; const char* a2 = Ab + (size_t)k2 * 128; const int sel2 = nx ? nsel : csel;
#pragma unroll
            for (int n = 0; n < 2; ++n) { B08[n] = H3_LD32(lds + o0 + boff + n * 2048); B18[n] = H3_LD32(lds + o0 + 16384 + boff + n * 2048); }
            __builtin_amdgcn_sched_barrier(0);
#pragma unroll
            for (int m = 0; m < 4; ++m) At8[m] = H3_LD32(lds + o0 + 32768 + aoff + m * 2048);
            if (t == 1 && has_next && tid < 128) rtab[nsel * 128 + tid] = nrow;
            if (ui > 0 && t == 0) { if constexpr (Epi::NST == 4) asm volatile("s_waitcnt vmcnt(10)" ::: "memory"); else asm volatile("s_waitcnt vmcnt(14)" ::: "memory"); }
            else { H3_TILE(o2, b2, a2, sel2);
                if (ui > 0 && t == 1) { if constexpr (Epi::NST == 4) asm volatile("s_waitcnt vmcnt(10)" ::: "memory"); else asm volatile("s_waitcnt vmcnt(14)" ::: "memory"); }
                else asm volatile("s_waitcnt vmcnt(6)" ::: "memory"); }
            asm volatile("s_waitcnt lgkmcnt(0)" ::: "memory"); H3_BAR;
            __builtin_amdgcn_s_setprio(1);
#pragma unroll
            for (int m = 0; m < 4; ++m)
#pragma unroll
                for (int n = 0; n < 2; ++n) acc[0][m][n] = __builtin_amdgcn_mfma_scale_f32_16x16x128_f8f6f4(B08[n], At8[m], acc[0][m][n], 0, 0, 0, 0x7F7F7F7F, 0, 0x7F7F7F7F);
#pragma unroll
            for (int m = 0; m < 4; ++m)
#pragma unroll
                for (int n = 0; n < 2; ++n) acc[1][m][n] = __builtin_amdgcn_mfma_scale_f32_16x16x128_f8f6f4(B18[n], At8[m], acc[1][m][n], 0, 0, 0, 0x7F7F7F7F, 0, 0x7F7F7F7F);
            __builtin_amdgcn_s_setprio(0);
            H3_BAR; __builtin_amdgcn_sched_barrier(0);
            { const int tmp = o0; o0 = o1; o1 = o2; o2 = tmp; }
        }
        if (H3_ALIGN) { if (wr == 0) H3_BAR; }
        if (has_next) H3_TILE(o2, nB + 2 * kstepB, Ab + 2 * 128, nsel);
        E.half(acc, cur, wr, wc, fr, fq);
#ifdef PROBE_EREP
        asm volatile("" ::: "memory"); E.half(acc, cur, wr, wc, fr, fq);
#endif
        if (!has_next) break;
        asm volatile("" : "+v"(zero_));
#pragma unroll
        for (int b = 0; b < 2; ++b)
#pragma unroll
            for (int m = 0; m < 4; ++m)
#pragma unroll
                for (int n = 0; n < 2; ++n) acc[b][m][n] = (f32x4){zero_, zero_, zero_, zero_};
        cur = nxt; cB = nB; ++ui; csel = nsel;
        if (H3_ALIGN) { if (wr == 1) H3_BAR; }
    }
    asm volatile("s_waitcnt vmcnt(0)" ::: "memory");
    if (!H3_ALIGN) { if (wr == 0) H3_BAR; }
    H3_BAR;
#undef H3_RFILL
#undef H3_STAGE
#undef H3_STAGEA
#undef H3_LD32
#undef H3_TILE
#undef H3_BAR
}
#ifndef ALIGN_G2
#define ALIGN_G2 false
#endif
#define GEMM gemm_fast<true, false, false>
#define GEMM2 gemm_fast<ALIGN_G2, false, false>

__device__ __forceinline__ u32x4 pack8(const f32x4& a, const f32x4& b) { u32x4 w; w.x = pk2(a[0], a[1]); w.y = pk2(a[2], a[3]); w.z = pk2(b[0], b[1]); w.w = pk2(b[2], b[3]); return w; }
template <bool GLU> struct EpiInProj {
    bf16_t* Q; bf16_t* KR; bf16_t* Vn; bf16_t* Gb;
    __device__ __forceinline__ void operator()(const f32x4 (&acc)[2][2][4][2], const Unit& u, int wr, int wc, int fr, int fq) const {
#pragma unroll
        for (int ai = 0; ai < 2; ++ai)
#pragma unroll
            for (int m = 0; m < 4; ++m) { const int irow = u.pm * 256 + 128 * ai + 64 * wr + 16 * m + fr; const size_t row = (size_t)irow; const int cl = 32 * wc + 8 * fq;
                if (u.pn < 2) { *(u32x4*)(Q + row * 512 + u.pn * 256 + cl) = pack8(acc[ai][0][m][0], acc[ai][0][m][1]); *(u32x4*)(Q + row * 512 + u.pn * 256 + 128 + cl) = pack8(acc[ai][1][m][0], acc[ai][1][m][1]); }
                else if (u.pn == 2) { const size_t kvrow = irow < TX ? (size_t)(irow >> 12) * KVS + CTXL + (irow & 4095) : (size_t)((irow - TX) >> 8) * KVS + ((irow - TX) & 255);
                    *(u32x4*)(KR + kvrow * 128 + cl) = pack8(acc[ai][0][m][0], acc[ai][0][m][1]); *(u32x4*)(Vn + kvrow * 128 + cl) = pack8(acc[ai][1][m][0], acc[ai][1][m][1]); }
                else if (GLU) { f32x4 g0, g1;
#pragma unroll
                    for (int j = 0; j < 4; ++j) { g0[j] = acc[ai][0][m][0][j] * sigmoidf_(acc[ai][1][m][0][j]); g1[j] = acc[ai][0][m][1][j] * sigmoidf_(acc[ai][1][m][1][j]); }
                    *(u32x4*)(Gb + row * 512 + (u.pn - 3) * 128 + cl) = pack8(g0, g1); }
                else { *(u32x4*)(Gb + row * 512 + (u.pn - 3) * 256 + cl) = pack8(acc[ai][0][m][0], acc[ai][0][m][1]); *(u32x4*)(Gb + row * 512 + (u.pn - 3) * 256 + 128 + cl) = pack8(acc[ai][1][m][0], acc[ai][1][m][1]); }
            }
    }
};
template <bool L0, bool DRY = false> struct EpiOutProj {
    Frame F; int l;
    __device__ __forceinline__ void operator()(const f32x4 (&acc)[2][2][4][2], const Unit& u, int wr, int wc, int fr, int fq) const {
        float* SS = (float*)(F.ws + WS_SS);
        const float* g1 = F.mod(l, modrow(u.pm * 256), 2) + u.pn * 256 + 32 * wc + 8 * fq;
        f32x4 gv[2][2];
#pragma unroll
        for (int bj = 0; bj < 2; ++bj)
#pragma unroll
            for (int n = 0; n < 2; ++n) gv[bj][n] = *(const f32x4*)(g1 + 128 * bj + 4 * n);
#pragma unroll
        for (int ai = 0; ai < 2; ++ai) {
            f32x4 xv[4][2][2];
#pragma unroll
            for (int m = 0; m < 4; ++m) { const int row = u.pm * 256 + 128 * ai + 64 * wr + 16 * m + fr; const int c0 = u.pn * 256 + 32 * wc + 8 * fq;
#pragma unroll
                for (int bj = 0; bj < 2; ++bj) {
                    if (L0) { const float* src = F.xin_row(row) + c0 + 128 * bj; xv[m][bj][0] = *(const f32x4*)(src); xv[m][bj][1] = *(const f32x4*)(src + 4); }
                    else { const u32x4 w = *(const u32x4*)(F.xr_row(row) + c0 + 128 * bj); xv[m][bj][0] = (f32x4){bflo(w.x), bfhi(w.x), bflo(w.y), bfhi(w.y)}; xv[m][bj][1] = (f32x4){bflo(w.z), bfhi(w.z), bflo(w.w), bfhi(w.w)}; } } }
#pragma unroll
            for (int m = 0; m < 4; ++m) { const int row = u.pm * 256 + 128 * ai + 64 * wr + 16 * m + fr; bf16_t* dst = F.xr_row(row) + u.pn * 256 + 32 * wc + 8 * fq; float q = 0.f;
#pragma unroll
                for (int bj = 0; bj < 2; ++bj) { const f32x4 v0 = xv[m][bj][0] + gv[bj][0] * acc[ai][bj][m][0], v1 = xv[m][bj][1] + gv[bj][1] * acc[ai][bj][m][1];
                    *(u32x4*)(dst + 128 * bj) = DRY ? pack8(xv[m][bj][0], xv[m][bj][1]) : pack8(v0, v1);
                    q += ((v0[0] * v0[0] + v0[1] * v0[1]) + (v0[2] * v0[2] + v0[3] * v0[3])) + ((v1[0] * v1[0] + v1[1] * v1[1]) + (v1[2] * v1[2] + v1[3] * v1[3])); }
                q += __shfl_xor(q, 16); q += __shfl_xor(q, 32);
                if (fq == 0) SS[(size_t)row * 16 + u.pn * 4 + wc] = q; }
        }
    }
};
template <bool IN8, bool OUT8, bool HALFM> struct EpiMoe1 {   static constexpr int NST = 4;
    void* HID;
    __device__ __forceinline__ void operator()(const f32x4 (&acc)[2][2][4][2], const Unit& u, int wr, int wc, int fr, int fq) const {
        const float sc = IN8 ? W8_INV : 1.f;
#pragma unroll
        for (int ai = 0; ai < (HALFM ? 1 : 2); ++ai)
#pragma unroll
            for (int m = 0; m < 4; ++m) { const size_t slot = (size_t)u.pm * (HALFM ? 128 : 256) + 128 * ai + 64 * wr + 16 * m + fr; f32x4 h0, h1;
#pragma unroll
                for (int j = 0; j < 4; ++j) { const float a = acc[ai][0][m][0][j] * sc, b = acc[ai][0][m][1][j] * sc; h0[j] = a * sigmoidf_(a) * (acc[ai][1][m][0][j] * sc); h1[j] = b * sigmoidf_(b) * (acc[ai][1][m][1][j] * sc); }
                if (OUT8) { u32x2 o; o.x = pk4_fp8(h0[0], h0[1], h0[2], h0[3]); o.y = pk4_fp8(h1[0], h1[1], h1[2], h1[3]); *(u32x2*)((unsigned char*)HID + slot * 512 + u.pn * 128 + 32 * wc + 8 * fq) = o; }
                else *(u32x4*)((bf16_t*)HID + slot * 512 + u.pn * 128 + 32 * wc + 8 * fq) = pack8(h0, h1); }
    }
    __device__ __forceinline__ void half(const f32x4 (&acc)[2][4][2], const Unit& u, int wr, int wc, int fr, int fq) const {
        const float sc = IN8 ? W8_INV : 1.f;
#pragma unroll
        for (int m = 0; m < 4; ++m) { const size_t slot = (size_t)u.pm * 128 + 64 * wr + 16 * m + fr; f32x4 h0, h1;
#pragma unroll
            for (int j = 0; j < 4; ++j) { const float a = acc[0][m][0][j] * sc, b = acc[0][m][1][j] * sc; h0[j] = a * sigmoidf_(a) * (acc[1][m][0][j] * sc); h1[j] = b * sigmoidf_(b) * (acc[1][m][1][j] * sc); }
            u32x2 o; o.x = pk4_fp8(h0[0], h0[1], h0[2], h0[3]); o.y = pk4_fp8(h1[0], h1[1], h1[2], h1[3]); *(u32x2*)((unsigned char*)HID + slot * 512 + u.pn * 128 + 32 * wc + 8 * fq) = o; }
    }
};
template <bool FP8, bool HALFM> struct EpiMoe2 {
    static constexpr int NST = 8;
    bf16_t* YB;
    __device__ __forceinline__ void operator()(const f32x4 (&acc)[2][2][4][2], const Unit& u, int wr, int wc, int fr, int fq) const {
        const float sc = FP8 ? W8_INV : 1.f;
#pragma unroll
        for (int ai = 0; ai < (HALFM ? 1 : 2); ++ai)
#pragma unroll
            for (int m = 0; m < 4; ++m) { const size_t slot = (size_t)u.pm * (HALFM ? 128 : 256) + 128 * ai + 64 * wr + 16 * m + fr;
#pragma unroll
                for (int bj = 0; bj < 2; ++bj) *(u32x4*)(YB + slot * 1024 + u.pn * 256 + 128 * bj + 32 * wc + 8 * fq) = pack8(acc[ai][bj][m][0] * sc, acc[ai][bj][m][1] * sc); }
    }
    __device__ __forceinline__ void half(const f32x4 (&acc)[2][4][2], const Unit& u, int wr, int wc, int fr, int fq) const {
        const float sc = FP8 ? W8_INV : 1.f;
#pragma unroll
        for (int m = 0; m < 4; ++m) { const size_t slot = (size_t)u.pm * 128 + 64 * wr + 16 * m + fr;
#pragma unroll
            for (int bj = 0; bj < 2; ++bj) { const f32x4 v0 = acc[bj][m][0] * sc, v1 = acc[bj][m][1] * sc; u32x2 o; o.x = pk4_fp8(v0[0], v0[1], v0[2], v0[3]); o.y = pk4_fp8(v1[0], v1[1], v1[2], v1[3]);
                *(u32x2*)((unsigned char*)YB + slot * 1024 + u.pn * 256 + 128 * bj + 32 * wc + 8 * fq) = o; } }
    }
};

__device__ __forceinline__ void p_k_post(const Frame& F, const float* kg) {
    const int gw = F.vcu * NWAVES + F.wave, NGW = F.G * NWAVES, lane = F.lane;
    const bf16_t* KR = (const bf16_t*)(F.ws + WS_KV); bf16_t* Kn = (bf16_t*)(F.ws + WS_KN);
    const float* rc = (const float*)(F.ws + WS_ROPE); const float* rs = rc + SEQ * 32;
    const int c16 = lane & 15, i8 = c16 & 7, dd0 = 8 * (i8 & 3), sub = lane >> 4;
    float gk[8];
#pragma unroll
    for (int j = 0; j < 8; ++j) gk[j] = kg[i8 * 8 + j];
    const float sgn = (i8 < 4) ? -1.f : 1.f;
    for (int it = gw; it < NB * KVS / 16; it += NGW) {
        u32x4 w[4];
#pragma unroll
        for (int q = 0; q < 4; ++q) w[q] = *(const u32x4*)(KR + (size_t)(it * 16 + 4 * q + sub) * 128 + c16 * 8);
#pragma unroll
        for (int q = 0; q < 4; ++q) { const int kvrow = it * 16 + 4 * q + sub, pos = kvrow % KVS;
            float cs[8], sn[8];
#pragma unroll
            for (int j = 0; j < 8; ++j) { cs[j] = 1.f; sn[j] = 0.f; }
            if (pos >= CTXL) { const int sq = pos - CTXL; const f32x4 c0 = *(const f32x4*)(rc + sq * 32 + dd0), c1 = *(const f32x4*)(rc + sq * 32 + dd0 + 4), s0 = *(const f32x4*)(rs + sq * 32 + dd0), s1 = *(const f32x4*)(rs + sq * 32 + dd0 + 4);
#pragma unroll
                for (int j = 0; j < 4; ++j) { cs[j] = c0[j]; cs[4 + j] = c1[j]; sn[j] = s0[j]; sn[4 + j] = s1[j]; } }
            float x[8] = {bflo(w[q].x), bfhi(w[q].x), bflo(w[q].y), bfhi(w[q].y), bflo(w[q].z), bfhi(w[q].z), bflo(w[q].w), bfhi(w[q].w)};
            float ss = 0.f;
#pragma unroll
            for (int j = 0; j < 8; ++j) ss += x[j] * x[j];
            ss += __shfl_xor(ss, 1); ss += __shfl_xor(ss, 2); ss += __shfl_xor(ss, 4);
            const float rms = 1.0f / sqrtf(ss * (1.f / 64.f) + EPS);
            float y[8], o[8];
#pragma unroll
            for (int j = 0; j < 8; ++j) y[j] = x[j] * rms * gk[j];
#pragma unroll
            for (int j = 0; j < 8; ++j) { const float yp = __shfl_xor(y[j], 4); o[j] = y[j] * cs[j] + sgn * yp * sn[j]; }
            u32x4 ow; ow.x = pk2(o[0], o[1]); ow.y = pk2(o[2], o[3]); ow.z = pk2(o[4], o[5]); ow.w = pk2(o[6], o[7]);
            *(u32x4*)(Kn + (size_t)kvrow * 128 + c16 * 8) = ow; }
    }
}
__device__ __forceinline__ void p_conv(const Frame& F) {
    const bf16_t* Gb = (const bf16_t*)(F.ws + WS_G); bf16_t* AO = (bf16_t*)(F.ws + WS_AO);
    LAS bf16_t* gl = (LAS bf16_t*)F.lds;
    LAS float* yl = (LAS float*)(F.lds + 65536);
    const int c = F.tid;
    float w[31];
#pragma unroll
    for (int j = 0; j < 31; ++j) w[j] = F.in[I_CONVW][j * 512 + c];
    const float bias = F.in[I_CONVB][c];
    u32x4 pre[8];
#define CONV_ITEM(item, rowbase, t0, len) do { if ((item) < 1024) { rowbase = ((item) >> 7) * SEQ; t0 = ((item) & 127) * 32; len = SEQ; } else { const int it_ = (item) - 1024; rowbase = TX + (it_ >> 3) * CTXL; t0 = (it_ & 7) * 32; len = CTXL; } } while (0)
#define CONV_LOAD(item) do { int rb_, t0_, len_; CONV_ITEM(item, rb_, t0_, len_); _Pragma("unroll") for (int q = 0; q < 8; ++q) { const int ch = F.tid + q * NTHREADS, r = ch >> 6, p = t0_ - 15 + r; pre[q] = (u32x4){0u, 0u, 0u, 0u}; \
        if (ch < 62 * 64 && p >= 0 && p < len_) pre[q] = *(const u32x4*)(Gb + (size_t)(rb_ + p) * 512 + (ch & 63) * 8); } } while (0)
    if (F.vcu < 1024 + 64) CONV_LOAD(F.vcu);
    for (int item = F.vcu; item < 1024 + 64; item += F.G) {
        int rowbase, t0, len; CONV_ITEM(item, rowbase, t0, len);
        __syncthreads();
#pragma unroll
        for (int q = 0; q < 8; ++q) { const int ch = F.tid + q * NTHREADS; if (ch < 62 * 64) *(LAS u32x4*)(gl + (ch >> 6) * 512 + (ch & 63) * 8) = pre[q]; }
        __syncthreads();
        if (item + F.G < 1024 + 64) CONV_LOAD(item + F.G);
        float g[62];
#pragma unroll
        for (int r = 0; r < 62; ++r) g[r] = bf2f(gl[r * 512 + c]);
#pragma unroll
        for (int t = 0; t < 32; ++t) { float y = bias;
#pragma unroll
            for (int j = 0; j < 31; ++j) y += g[t + j] * w[j];
            yl[t * 512 + c] = y; }
        __syncthreads();
#pragma unroll
        for (int tt = 0; tt < 4; ++tt) { const int t = 4 * F.wave + tt; float v[8]; float sm = 0.f;
#pragma unroll
            for (int j = 0; j < 8; ++j) { v[j] = yl[t * 512 + F.lane + 64 * j]; sm += v[j]; }
            const float mean = wave_sum(sm) * (1.f / 512.f); float q = 0.f;
#pragma unroll
            for (int j = 0; j < 8; ++j) { v[j] -= mean; q += v[j] * v[j]; }
            const float rstd = 1.0f / sqrtf(wave_sum(q) * (1.f / 512.f) + EPS);
            bf16_t* orow = AO + (size_t)(rowbase + t0 + t) * 1024 + 512;
#pragma unroll
            for (int j = 0; j < 8; ++j) { const int cc = F.lane + 64 * j; const float yn = v[j] * rstd * F.in[I_CLNG][cc] + F.in[I_CLNB][cc]; orow[cc] = (bf16_t)(pk2(yn * sigmoidf_(yn), 0.f) & 0xffffu); } }
    }
#undef CONV_ITEM
#undef CONV_LOAD
    __syncthreads();
}
__device__ __forceinline__ void p_pool(const Frame& F) {
    const int gw = F.vcu * NWAVES + F.wave, NGW = F.G * NWAVES, lane = F.lane;
    const bf16_t* U = (const bf16_t*)(F.ws + WS_G); bf16_t* AO = (bf16_t*)(F.ws + WS_AO);
    const int hw = 1 << (lane >> 4);
    float wgt[16];
#pragma unroll
    for (int i = 0; i < 16; ++i) wgt[i] = (i >= 8 - hw && i < 8 + hw) ? 1.f : 0.f;
    for (int it = gw; it < TX / 8; it += NGW) {
        const int row0 = it * 8, t0 = row0 & 4095, rb = row0 - t0;
        u32x4 r[23];
#pragma unroll
        for (int j = 0; j < 23; ++j) { const int p = t0 - 8 + j; r[j] = (u32x4){0u, 0u, 0u, 0u}; if (p >= 0 && p < SEQ) r[j] = *(const u32x4*)(U + (size_t)(rb + p) * 512 + lane * 8); }
#pragma unroll
        for (int t = 0; t < 8; ++t) {
            float s[8];
#pragma unroll
            for (int j = 0; j < 8; ++j) s[j] = 0.f;
#pragma unroll
            for (int i = 0; i < 16; ++i) { const u32x4 w = r[t + i]; const float g = wgt[i];
                s[0] += g * bflo(w.x); s[1] += g * bfhi(w.x); s[2] += g * bflo(w.y); s[3] += g * bfhi(w.y); s[4] += g * bflo(w.z); s[5] += g * bfhi(w.z); s[6] += g * bflo(w.w); s[7] += g * bfhi(w.w); }
            const int tt = t0 + t; int lo = tt - hw, hi = tt + hw; lo = lo < 0 ? 0 : lo; hi = hi > SEQ ? SEQ : hi;
            const float inv = 1.f / (float)(hi - lo); const u32x4 w = r[t + 8];
            u32x4 ow; ow.x = pk2(s[0] * inv - bflo(w.x), s[1] * inv - bfhi(w.x)); ow.y = pk2(s[2] * inv - bflo(w.y), s[3] * inv - bfhi(w.y)); ow.z = pk2(s[4] * inv - bflo(w.z), s[5] * inv - bfhi(w.z)); ow.w = pk2(s[6] * inv - bflo(w.w), s[7] * inv - bfhi(w.w));
            *(u32x4*)(AO + (size_t)(row0 + t) * 1024 + 512 + lane * 8) = ow;
        }
    }
}

template <int LAYER> __device__ __forceinline__ void attn_simple(const Frame& F) {
    const bf16_t* Q = (const bf16_t*)(F.ws + WS_Q); const bf16_t* Kn = (const bf16_t*)(F.ws + WS_KN); const bf16_t* Vn = (const bf16_t*)(F.ws + WS_VN); bf16_t* AO = (bf16_t*)(F.ws + WS_AO);
    const int nunits = LAYER == 0 ? 512 + 64 : 512;
    for (int u = F.vcu; u < nunits; u += F.G) {
        int b, h, row, s; bool valid = true, isctx = false;
        if (u < 512) { b = u >> 6; h = (u >> 3) & 7; s = (u & 7) * 512 + F.tid; row = b * SEQ + s; }
        else { const int uc = u - 512; b = uc >> 3; h = uc & 7; s = F.tid; valid = F.tid < 256; row = TX + b * CTXL + (valid ? s : 0); isctx = true; }
        float q[64], o[64];
        { const u32x4* qp = (const u32x4*)(Q + (size_t)row * 512 + h * 64);
#pragma unroll
          for (int c = 0; c < 8; ++c) { const u32x4 w = qp[c]; q[8 * c] = bflo(w.x); q[8 * c + 1] = bfhi(w.x); q[8 * c + 2] = bflo(w.y); q[8 * c + 3] = bfhi(w.y); q[8 * c + 4] = bflo(w.z); q[8 * c + 5] = bfhi(w.z); q[8 * c + 6] = bflo(w.w); q[8 * c + 7] = bfhi(w.w); } }
#pragma unroll
        for (int d = 0; d < 64; ++d) o[d] = 0.f;
        float mx = -1e30f, l = 0.f;
        const bf16_t* Kb = Kn + (size_t)b * KVS * 128 + (h >> 2) * 64; const bf16_t* Vb = Vn + (size_t)b * KVS * 128 + (h >> 2) * 64;
        int k_lo2 = 0, k_hi2 = 0;
        const int k_hi1 = CTXL;
        if (LAYER == 0) { if (!isctx) { k_lo2 = CTXL; k_hi2 = KVS; } }
        else { const int s0 = (u & 7) * 512; int lo = s0 - 128, hi = s0 + 511 + 128 + 1; lo = lo < 0 ? 0 : lo; hi = hi > SEQ ? SEQ : hi; k_lo2 = CTXL + lo; k_hi2 = CTXL + hi; }
        for (int part = 0; part < 2; ++part) {
            const int kb = part == 0 ? 0 : k_lo2, ke = part == 0 ? k_hi1 : k_hi2;
            for (int key = kb; key < ke; ++key) {
                const u32x4* kp = (const u32x4*)(Kb + (size_t)key * 128); float sd = 0.f;
#pragma unroll
                for (int c = 0; c < 8; ++c) { const u32x4 w = kp[c];
                    sd += q[8 * c] * bflo(w.x) + q[8 * c + 1] * bfhi(w.x) + q[8 * c + 2] * bflo(w.y) + q[8 * c + 3] * bfhi(w.y) + q[8 * c + 4] * bflo(w.z) + q[8 * c + 5] * bfhi(w.z) + q[8 * c + 6] * bflo(w.w) + q[8 * c + 7] * bfhi(w.w); }
                bool use = valid;
                if (LAYER == 1 && part == 1) { const int j = key - CTXL; const int dlt = s - j; use = use && (dlt <= 128 && dlt >= -128); }
                const float mn = fmaxf(mx, sd); const float mnew = use ? mn : mx;
                const float alpha = exp2f(mx - mnew), p = use ? exp2f(sd - mnew) : 0.f;
                mx = mnew; l = l * alpha + p;
                const u32x4* vp = (const u32x4*)(Vb + (size_t)key * 128);
#pragma unroll
                for (int c = 0; c < 8; ++c) { const u32x4 w = vp[c];
                    o[8 * c] = o[8 * c] * alpha + p * bflo(w.x); o[8 * c + 1] = o[8 * c + 1] * alpha + p * bfhi(w.x); o[8 * c + 2] = o[8 * c + 2] * alpha + p * bflo(w.y); o[8 * c + 3] = o[8 * c + 3] * alpha + p * bfhi(w.y);
                    o[8 * c + 4] = o[8 * c + 4] * alpha + p * bflo(w.z); o[8 * c + 5] = o[8 * c + 5] * alpha + p * bfhi(w.z); o[8 * c + 6] = o[8 * c + 6] * alpha + p * bflo(w.w); o[8 * c + 7] = o[8 * c + 7] * alpha + p * bfhi(w.w); }
            }
        }
        if (LAYER == 1) l += exp2f(F.in[I_SINK][h] * LOG2E - mx);
        const float il = 1.f / l;
        if (valid) { u32x4* op = (u32x4*)(AO + (size_t)row * 1024 + h * 64);
#pragma unroll
            for (int c = 0; c < 8; ++c) { u32x4 w; w.x = pk2(o[8 * c] * il, o[8 * c + 1] * il); w.y = pk2(o[8 * c + 2] * il, o[8 * c + 3] * il); w.z = pk2(o[8 * c + 4] * il, o[8 * c + 5] * il); w.w = pk2(o[8 * c + 6] * il, o[8 * c + 7] * il); op[c] = w; } }
    }
}

#include <hip/hip_bf16.h>
namespace attn_body {
using bf16=__hip_bfloat16;
using s16x4=__attribute__((ext_vector_type(4)))short;
using f32x16=__attribute__((ext_vector_type(16)))float;
constexpr int NW=8,QBLK=32,QB=QBLK*NW,KVBLK=64;
constexpr int QP=512,KP=128,OP=1024;
__device__ __forceinline__ int crow(int r,int hi){return (r&3)+8*(r>>2)+4*hi;}
#define SBAR() __builtin_amdgcn_sched_barrier(0)
__device__ __forceinline__ void wmask(f32x16&p0,f32x16&p1,int dlt0,int hi){
  const float NEG=-INFINITY; const int kb=dlt0+4*hi;
  #pragma unroll
  for(int r=0;r<16;++r){const int d=kb+(r&3)+8*(r>>2); if(d>128||d<-128)p0[r]=NEG; if(d+32>128||d+32<-128)p1[r]=NEG;}
}

constexpr int NSLOT=3, SLOTB=8192;
constexpr int LDS_K=0, LDS_V=NSLOT*SLOTB, LDS_WS=2*NSLOT*SLOTB, LDS_OST=LDS_WS+NW*64*4, LDS_BYTES=LDS_OST+NW*4096;
__device__ __forceinline__ void glds16(const void*gsrc,unsigned lds_dst){unsigned keep;
  asm volatile("s_mov_b32 %0, m0\n\ts_mov_b32 m0, %2\n\ts_nop 0\n\tglobal_load_lds_dwordx4 %1, off\n\ts_mov_b32 m0, %0":"=&s"(keep):"v"(gsrc),"s"(lds_dst):"memory");}
__device__ __forceinline__ float max3f(float a,float b,float c){float r;asm("v_max3_f32 %0, %1, %2, %3":"=v"(r):"v"(a),"v"(b),"v"(c));return r;}
__device__ __forceinline__ float max2f(float a,float b){float r;asm("v_max_f32_e32 %0, %1, %2":"=v"(r):"v"(a),"v"(b));return r;}
__device__ __forceinline__ float fadd_s(float a,float b){float r;asm("v_add_f32_e32 %0, %1, %2":"=v"(r):"v"(a),"v"(b));return r;}
__device__ __forceinline__ float fsub_s(float a,float b){float r;asm("v_sub_f32_e32 %0, %1, %2":"=v"(r):"v"(a),"v"(b));return r;}
typedef float f32x2_t __attribute__((ext_vector_type(2))); typedef __bf16 bf16x2_t __attribute__((ext_vector_type(2)));
__device__ __forceinline__ unsigned cvtpk_s(float lo,float hi){f32x2_t v={lo,hi};bf16x2_t b=__builtin_convertvector(v,bf16x2_t);return __builtin_bit_cast(unsigned,b);}
#define WAIT_BAR(N) asm volatile("s_waitcnt vmcnt(" #N ") lgkmcnt(0)\n\ts_barrier":::"memory")

__device__ __forceinline__ void qkt(f32x16&p0,f32x16&p1,const char*Kslot,const bf16x8*qr,const f32x16&negm,int r32,int hi){
  const char*kb=Kslot+hi*1024+r32*16;
  #pragma unroll
  for(int d0=0;d0<4;++d0){
    const bf16x8 b0=*reinterpret_cast<const bf16x8*>(kb+d0*2048);
    const bf16x8 b1=*reinterpret_cast<const bf16x8*>(kb+d0*2048+512);
    if(d0==0){p0=__builtin_amdgcn_mfma_f32_32x32x16_bf16(b0,qr[0],negm,0,0,0);p1=__builtin_amdgcn_mfma_f32_32x32x16_bf16(b1,qr[0],negm,0,0,0);}
    else{p0=__builtin_amdgcn_mfma_f32_32x32x16_bf16(b0,qr[d0],p0,0,0,0);p1=__builtin_amdgcn_mfma_f32_32x32x16_bf16(b1,qr[d0],p1,0,0,0);}}
}
typedef __attribute__((address_space(3))) const char* lds_cptr;
typedef short v4i16_t __attribute__((ext_vector_type(4)));
__device__ __forceinline__ void kload8(bf16x8*kf,lds_cptr kp){
  kf[0]=*(const __attribute__((address_space(3))) bf16x8*)(kp);      kf[1]=*(const __attribute__((address_space(3))) bf16x8*)(kp+512);
  kf[2]=*(const __attribute__((address_space(3))) bf16x8*)(kp+2048); kf[3]=*(const __attribute__((address_space(3))) bf16x8*)(kp+2560);
  kf[4]=*(const __attribute__((address_space(3))) bf16x8*)(kp+4096); kf[5]=*(const __attribute__((address_space(3))) bf16x8*)(kp+4608);
  kf[6]=*(const __attribute__((address_space(3))) bf16x8*)(kp+6144); kf[7]=*(const __attribute__((address_space(3))) bf16x8*)(kp+6656);
}
__device__ __forceinline__ void kload2(bf16x8*kf,lds_cptr kp,int j){ kf[2*j]=*(const __attribute__((address_space(3))) bf16x8*)(kp+j*2048); kf[2*j+1]=*(const __attribute__((address_space(3))) bf16x8*)(kp+j*2048+512); }
__device__ __forceinline__ s16x4 vtr(lds_cptr p){ return __builtin_bit_cast(s16x4,__builtin_amdgcn_ds_read_tr16_b64_v4i16((__attribute__((address_space(3))) v4i16_t*)p)); }
__device__ __forceinline__ float rowmax(const f32x16&p0,const f32x16&p1){
  float a=max3f(p0[0],p0[1],p1[0]),b=max3f(p0[2],p0[3],p1[1]);a=max3f(a,p1[2],p1[3]);
  #pragma unroll
  for(int r=4;r<16;r+=4){a=max3f(a,p0[r],p0[r+1]);b=max3f(b,p0[r+2],p0[r+3]);a=max3f(a,p1[r],p1[r+1]);b=max3f(b,p1[r+2],p1[r+3]);}
  const float m=max2f(a,b);
  auto rr=__builtin_amdgcn_permlane32_swap(__float_as_uint(m),__float_as_uint(m),false,false);
  return max2f(__uint_as_float(rr[0]),__uint_as_float(rr[1]));
}
__device__ __forceinline__ void pv(f32x16*o,int vb,bf16x8 pa0,bf16x8 pa1,bf16x8 pa2,bf16x8 pa3){
  #pragma unroll
  for(int d0=0;d0<2;++d0){s16x4 lo[4],hi[4];
    #pragma unroll
    for(int ks=0;ks<4;++ks){
      asm volatile("ds_read_b64_tr_b16 %0,%1 offset:%c2":"=&v"(lo[ks]):"v"(vb),"i"(d0*4096+ks*1024):"memory");
      asm volatile("ds_read_b64_tr_b16 %0,%1 offset:%c2":"=&v"(hi[ks]):"v"(vb),"i"(d0*4096+ks*1024+512):"memory");}
    asm volatile("s_waitcnt lgkmcnt(0)":::"memory");SBAR();
    #define PK(k) (bf16x8){lo[k][0],lo[k][1],lo[k][2],lo[k][3],hi[k][0],hi[k][1],hi[k][2],hi[k][3]}
    o[d0]=__builtin_amdgcn_mfma_f32_32x32x16_bf16(pa0,PK(0),o[d0],0,0,0);
    o[d0]=__builtin_amdgcn_mfma_f32_32x32x16_bf16(pa1,PK(1),o[d0],0,0,0);
    o[d0]=__builtin_amdgcn_mfma_f32_32x32x16_bf16(pa2,PK(2),o[d0],0,0,0);
    o[d0]=__builtin_amdgcn_mfma_f32_32x32x16_bf16(pa3,PK(3),o[d0],0,0,0);
    #undef PK
  }
}

#ifndef ATTN_STORE16
#define ATTN_STORE16(p,v) (*(u32x4*)(p)=(v))
#endif
template<int MODE,int THRL> __device__ __forceinline__ void attn_unit(const bf16*Qu,const bf16*__restrict__ Kh,const bf16*__restrict__ Vh,bf16*Ou,const int NT,const int lat0,const int q0s,const float sinkl2,const float*qg,const float*ropec,const bool rope,char*shm){
  int tid_=threadIdx.x; asm volatile("":"+v"(tid_));
  const int tid=tid_,lane=tid&63,r32=lane&31,hi=lane>>5; const int wid=__builtin_amdgcn_readfirstlane(tid>>6);
  const bf16*Qw=Qu+(long)(wid*QBLK)*QP;
  const unsigned lds0=(unsigned)(uintptr_t)shm;
  float*wsf=(float*)(shm+LDS_WS)+wid*64;
  const bf16*ksrc=Kh+(long)lane*KP+wid*8;
  const bf16*vsrc=Vh+(long)(16*(wid&3)+(lane>>2))*KP+(wid>>2)*32+(lane&3)*8;
  const unsigned kdst=lds0+LDS_K+wid*1024, vdst=lds0+LDS_V+wid*1024;
  #define TROW(t) ((MODE==0||(t)<4)?(t)*KVBLK:lat0+((t)-4)*KVBLK)
  #define DMA_K(t,slot) glds16(ksrc+(long)TROW(t)*KP,(unsigned)__builtin_amdgcn_readfirstlane(kdst+(slot)))
  #define DMA_V(t,slot) glds16(vsrc+(long)TROW(t)*KP,(unsigned)__builtin_amdgcn_readfirstlane(vdst+(slot)))
  const int vb0=(int)(lds0+LDS_V)+((lane>>4)&1)*32+(lane&3)*8+(4*hi+((lane&15)>>2))*64;
  const char*Kbase=shm+LDS_K; bf16x8 kf[8];
  const lds_cptr shm3=(lds_cptr)shm; const lds_cptr kp0=shm3+LDS_K+hi*1024+r32*16; const lds_cptr vp0=shm3+LDS_V+((lane>>4)&1)*32+(lane&3)*8+(4*hi+((lane&15)>>2))*64;
  DMA_K(0,0);DMA_V(0,0);DMA_K(1,SLOTB);
  bf16x8 qr[4];
  const int qpos=q0s+wid*QBLK+r32;
  {
    u32x4 qraw[4];
    #pragma unroll
    for(int d0=0;d0<4;++d0) qraw[d0]=*reinterpret_cast<const u32x4*>(&Qw[(long)r32*QP+d0*16+hi*8]);
    float x[4][8]; float ss=0.f;
    #pragma unroll
    for(int d0=0;d0<4;++d0){ x[d0][0]=bflo(qraw[d0].x);x[d0][1]=bfhi(qraw[d0].x);x[d0][2]=bflo(qraw[d0].y);x[d0][3]=bfhi(qraw[d0].y);x[d0][4]=bflo(qraw[d0].z);x[d0][5]=bfhi(qraw[d0].z);x[d0][6]=bflo(qraw[d0].w);x[d0][7]=bfhi(qraw[d0].w);
      #pragma unroll
      for(int j=0;j<8;++j)ss+=x[d0][j]*x[d0][j]; }
    {auto rr=__builtin_amdgcn_permlane32_swap(__float_as_uint(ss),__float_as_uint(ss),false,false);ss=__uint_as_float(rr[0])+__uint_as_float(rr[1]);}
    const float rms=C2/sqrtf(ss*(1.f/64.f)+EPS);
    SBAR();
    #pragma unroll
    for(int d0=0;d0<2;++d0){
      #pragma unroll
      for(int hf=0;hf<2;++hf){
        const f32x4 ga=*reinterpret_cast<const f32x4*>(qg+d0*16+hi*8+4*hf), gb=*reinterpret_cast<const f32x4*>(qg+(d0+2)*16+hi*8+4*hf);
        f32x4 cc=f32x4{1.f,1.f,1.f,1.f}, sn=f32x4{0.f,0.f,0.f,0.f};
        if(rope){ const float*pc=ropec+(long)qpos*32+d0*16+hi*8+4*hf; cc=*reinterpret_cast<const f32x4*>(pc); sn=*reinterpret_cast<const f32x4*>(pc+SEQ*32); }
        #pragma unroll
        for(int j=0;j<4;++j){ const float a=x[d0][4*hf+j]*rms*ga[j], b=x[d0+2][4*hf+j]*rms*gb[j]; x[d0][4*hf+j]=a*cc[j]-b*sn[j]; x[d0+2][4*hf+j]=b*cc[j]+a*sn[j]; }
        SBAR(); } }
    #pragma unroll
    for(int d0=0;d0<4;++d0){ u32x4 w; w.x=cvtpk_s(x[d0][0],x[d0][1]);w.y=cvtpk_s(x[d0][2],x[d0][3]);w.z=cvtpk_s(x[d0][4],x[d0][5]);w.w=cvtpk_s(x[d0][6],x[d0][7]); qr[d0]=__builtin_bit_cast(bf16x8,w); } }
  float mhat=0.f,l_reg=0.f;f32x16 o[2],negm; { float z_=0.f; asm volatile("":"+v"(z_));
    #pragma unroll
    for(int r=0;r<16;++r){o[0][r]=z_;o[1][r]=z_;negm[r]=z_;} } asm volatile("":"+v"(negm));
  #define CMASK(P0,P1,t) do{ if(MODE==1&&(t)>=4) wmask(P0,P1,(lat0-256)+((t)-4)*KVBLK-qpos,hi); }while(0)
  bool resc=false;
  #define START(P0,P1) do{ const float rm=rowmax(P0,P1); resc=false; \
    { const float dl=rm; mhat=fadd_s(mhat,dl); \
      _Pragma("unroll") for(int r=0;r<16;++r){P0[r]=fsub_s(P0[r],dl);P1[r]=fsub_s(P1[r],dl);} \
      _Pragma("unroll") for(int r=0;r<16;++r)negm[r]=-mhat; asm volatile("":"+v"(negm)); } \
    _Pragma("unroll") for(int r=0;r<16;++r)P0[r]=__builtin_amdgcn_exp2f(P0[r]); }while(0)
  #define RESC() do{ if(resc){ asm volatile("s_waitcnt lgkmcnt(0)":::"memory"); \
      _Pragma("unroll") for(int d_=0;d_<2;++d_) _Pragma("unroll") for(int r=0;r<16;++r)o[d_][r]*=wsf[crow(r,hi)]; } }while(0)
  f32x16 pA0,pA1,pB0,pB1;
  int sl_prev=0,sl_cur=0,sl_next=SLOTB;
  #define ROT() do{sl_prev=sl_cur;sl_cur=sl_next;sl_next=(sl_next==(NSLOT-1)*SLOTB)?0:sl_next+SLOTB;}while(0)
  DMA_K(2,2*SLOTB);
  WAIT_BAR(3);
  qkt(pA0,pA1,Kbase,qr,negm,r32,hi);asm volatile("s_nop 15\n\ts_nop 7":"+v"(pA0),"+v"(pA1));CMASK(pA0,pA1,0);
  START(pA0,pA1);
  _Pragma("unroll") for(int r=0;r<16;++r)pA1[r]=__builtin_amdgcn_exp2f(pA1[r]);
  WAIT_BAR(0);
  DMA_K(3,0);DMA_V(1,SLOTB);
  ROT();
  kload8(kf,kp0+sl_cur);
  WAIT_BAR(2);
  s16x4 vlo[8],vhi[8]; u32x4 pw0,pw1,pw2,pw3;
  #define PKW(P,B) cvtpk_s(P[B],P[B+1])
  #define PAF(k) __builtin_bit_cast(bf16x8,pw##k)
  #define VFR(i) (bf16x8){vlo[i][0],vlo[i][1],vlo[i][2],vlo[i][3],vhi[i][0],vhi[i][1],vhi[i][2],vhi[i][3]}
  #define PIN(x) asm volatile("":"+v"(x))
  #define MX3(a,b,c) __builtin_fmaxf(__builtin_fmaxf((a),(b)),(c))
  #define GAPA(MF,A0,A1,A2,A3,W0,W1,PW) do{ MF; sacc+=A0; sacc+=A1; sacc+=A2; sacc+=A3; PIN(sacc); W0; W1; PIN(PW); SBAR(); }while(0)
  #define EX(v) __builtin_amdgcn_exp2f(v)
  #define GAPB(MF,X,B) do{ MF; X[B]=EX(X[B]); X[B+1]=EX(X[B+1]); X[B+2]=EX(X[B+2]); X[B+3]=EX(X[B+3]); PIN(X); SBAR(); }while(0)
  #define VRD(i) do{ vlo[i]=vtr(vp_+(((i)>>2)*4096+((i)&3)*1024)); vhi[i]=vtr(vp_+(((i)>>2)*4096+((i)&3)*1024+512)); }while(0)
  #define KRD(G,j) do{ if(G){ kload2(kf,kp0+sl_next,j); SBAR(); } }while(0)
  #define STEP(C0,C1,P0,P1,t,GK,GV,GL) do{ SBAR(); \
    const lds_cptr vp_=vp0+sl_prev; \
    VRD(0); SBAR(); float sacc=(P0[0]+P0[1]); \
    GAPA(C0=__builtin_amdgcn_mfma_f32_32x32x16_bf16(kf[0],qr[0],negm,0,0,0), P0[2],P0[3],P0[4],P0[5],     pw0[0]=PKW(P0,0), pw0[1]=PKW(P0,2), pw0); \
    VRD(4); SBAR(); GAPA(C1=__builtin_amdgcn_mfma_f32_32x32x16_bf16(kf[1],qr[0],negm,0,0,0), P0[6],P0[7],P0[8],P0[9],     pw0[2]=PKW(P0,4), pw0[3]=PKW(P0,6), pw0); \
    VRD(1); SBAR(); GAPA(C0=__builtin_amdgcn_mfma_f32_32x32x16_bf16(kf[2],qr[1],C0,0,0,0),   P0[10],P0[11],P0[12],P0[13], pw1[0]=PKW(P0,8), pw1[1]=PKW(P0,10), pw1); \
    VRD(5); SBAR(); GAPA(C1=__builtin_amdgcn_mfma_f32_32x32x16_bf16(kf[3],qr[1],C1,0,0,0),   P0[14],P0[15],P1[0],P1[1],   pw1[2]=PKW(P0,12),pw1[3]=PKW(P0,14), pw1); \
    VRD(2); SBAR(); GAPA(C0=__builtin_amdgcn_mfma_f32_32x32x16_bf16(kf[4],qr[2],C0,0,0,0),   P1[2],P1[3],P1[4],P1[5],     pw2[0]=PKW(P1,0), pw2[1]=PKW(P1,2), pw2); \
    VRD(6); SBAR(); GAPA(C1=__builtin_amdgcn_mfma_f32_32x32x16_bf16(kf[5],qr[2],C1,0,0,0),   P1[6],P1[7],P1[8],P1[9],     pw2[2]=PKW(P1,4), pw2[3]=PKW(P1,6), pw2); \
    VRD(3); SBAR(); GAPA(C0=__builtin_amdgcn_mfma_f32_32x32x16_bf16(kf[6],qr[3],C0,0,0,0),   P1[10],P1[11],P1[12],P1[13], pw3[0]=PKW(P1,8), pw3[1]=PKW(P1,10), pw3); \
    VRD(7); SBAR(); GAPA(C1=__builtin_amdgcn_mfma_f32_32x32x16_bf16(kf[7],qr[3],C1,0,0,0),   P1[14],P1[15],0.f,0.f,       pw3[2]=PKW(P1,12),pw3[3]=PKW(P1,14), pw3); \
    l_reg+=sacc; \
    if(GK){DMA_K((t)+3,sl_cur);} if(GV){DMA_V((t)+1,sl_next);} \
    CMASK(C0,C1,t); \
    { float a=MX3(C0[0],C0[1],C1[0]),b=MX3(C0[2],C0[3],C1[1]); a=MX3(a,C1[2],C1[3]); \
      _Pragma("unroll") for(int r=4;r<16;r+=4){a=MX3(a,C0[r],C0[r+1]);b=MX3(b,C0[r+2],C0[r+3]);a=MX3(a,C1[r],C1[r+1]);b=MX3(b,C1[r+2],C1[r+3]);} \
      float rm=__builtin_fmaxf(a,b); { auto rr=__builtin_amdgcn_permlane32_swap(__float_as_uint(rm),__float_as_uint(rm),false,false); rm=__builtin_fmaxf(__uint_as_float(rr[0]),__uint_as_float(rr[1])); } \
      resc=false; \
      if(__builtin_expect(__any(rm>(float)THRL),0)){ const float dl=__builtin_fmaxf(rm,0.f); mhat+=dl; \
        _Pragma("unroll") for(int r=0;r<16;++r){C0[r]-=dl;C1[r]-=dl;} \
        _Pragma("unroll") for(int r=0;r<16;++r)negm[r]=-mhat; asm volatile("":"+v"(negm)); \
        const float f=__builtin_amdgcn_exp2f(-dl); l_reg*=f; if(hi==0)wsf[r32]=f; resc=true; } } \
    SBAR(); \
    GAPB(o[0]=__builtin_amdgcn_mfma_f32_32x32x16_bf16(PAF(0),VFR(0),o[0],0,0,0), C0,0); \
    GAPB(o[1]=__builtin_amdgcn_mfma_f32_32x32x16_bf16(PAF(0),VFR(4),o[1],0,0,0), C0,4); \
    KRD(GL,0); GAPB(o[0]=__builtin_amdgcn_mfma_f32_32x32x16_bf16(PAF(1),VFR(1),o[0],0,0,0), C0,8); \
    KRD(GL,1); GAPB(o[1]=__builtin_amdgcn_mfma_f32_32x32x16_bf16(PAF(1),VFR(5),o[1],0,0,0), C0,12); \
    KRD(GL,2); GAPB(o[0]=__builtin_amdgcn_mfma_f32_32x32x16_bf16(PAF(2),VFR(2),o[0],0,0,0), C1,0); \
    KRD(GL,3); GAPB(o[1]=__builtin_amdgcn_mfma_f32_32x32x16_bf16(PAF(2),VFR(6),o[1],0,0,0), C1,4); \
    GAPB(o[0]=__builtin_amdgcn_mfma_f32_32x32x16_bf16(PAF(3),VFR(3),o[0],0,0,0), C1,8); \
    GAPB(o[1]=__builtin_amdgcn_mfma_f32_32x32x16_bf16(PAF(3),VFR(7),o[1],0,0,0), C1,12); \
    }while(0)
  int t=1;
  for(;t+5<NT;t+=2){
    STEP(pB0,pB1,pA0,pA1,t,true,true,true);     WAIT_BAR(2); RESC(); ROT();
    STEP(pA0,pA1,pB0,pB1,t+1,true,true,true);   WAIT_BAR(2); RESC(); ROT();
  }
  #define ENDW(tt) do{ if((tt)+3<NT){WAIT_BAR(2);} else if((tt)+2<NT){WAIT_BAR(1);} else {WAIT_BAR(0);} }while(0)
  for(;t+1<NT;t+=2){
    STEP(pB0,pB1,pA0,pA1,t,(t+3<NT),(t+1<NT),(t+1<NT));       ENDW(t);   RESC(); ROT();
    STEP(pA0,pA1,pB0,pB1,t+1,(t+4<NT),(t+2<NT),(t+2<NT));     ENDW(t+1); RESC(); ROT();
  }
  STEP(pB0,pB1,pA0,pA1,NT-1,false,false,false); RESC();
  { float sacc=pB0[0]+pB0[1]; _Pragma("unroll") for(int r=2;r<16;++r)sacc+=pB0[r]; _Pragma("unroll") for(int r=0;r<16;++r)sacc+=pB1[r]; l_reg+=sacc;
    pw0=(u32x4){PKW(pB0,0),PKW(pB0,2),PKW(pB0,4),PKW(pB0,6)};pw1=(u32x4){PKW(pB0,8),PKW(pB0,10),PKW(pB0,12),PKW(pB0,14)};pw2=(u32x4){PKW(pB1,0),PKW(pB1,2),PKW(pB1,4),PKW(pB1,6)};pw3=(u32x4){PKW(pB1,8),PKW(pB1,10),PKW(pB1,12),PKW(pB1,14)};
    SBAR(); pv(o,vb0+sl_cur,PAF(0),PAF(1),PAF(2),PAF(3)); }
  #undef PKW
  #undef PAF
  #undef VFR
  #undef PIN
  #undef MX3
  #undef GAPA
  #undef GAPB
  #undef EX
  #undef VRD
  #undef KRD
  #undef STEP
  #undef ENDW
  {auto rr=__builtin_amdgcn_permlane32_swap(__float_as_uint(l_reg),__float_as_uint(l_reg),false,false);l_reg=__uint_as_float(rr[0])+__uint_as_float(rr[1]);}
  if(MODE==1)l_reg+=__builtin_amdgcn_exp2f(sinkl2-mhat);
  if(hi==0)wsf[32+r32]=l_reg;asm volatile("s_waitcnt lgkmcnt(0)":::"memory");
  float rli[16];
  #pragma unroll
  for(int r=0;r<16;++r)rli[r]=__builtin_amdgcn_rcpf(wsf[32+crow(r,hi)]);
  bf16*Ow=Ou+(long)(wid*QBLK)*OP;
  { bf16*stg=(bf16*)(shm+LDS_OST)+wid*2048;
    #pragma unroll
    for(int r=0;r<16;++r){const int orow=crow(r,hi);
      #pragma unroll
      for(int d0=0;d0<2;++d0)stg[orow*64+d0*32+r32]=__float2bfloat16(o[d0][r]*rli[r]);}
    asm volatile("s_waitcnt lgkmcnt(0)":::"memory");
    #pragma unroll
    for(int i=0;i<4;++i){const int row=i*8+(lane>>3),ch=lane&7; const u32x4 v=*(const u32x4*)(stg+row*64+ch*8); ATTN_STORE16(Ow+(long)row*OP+ch*8,v);} }
  asm volatile("s_waitcnt lgkmcnt(0)\n\ts_barrier":::"memory");
  #undef DMA_K
  #undef TROW
  #undef DMA_V
  #undef CMASK
  #undef START
  #undef RESC
  #undef ROT
}
#undef SBAR
#undef WAIT_BAR
}

template <int LAYER> __device__ __forceinline__ void attn_fast(const Frame& F, char* shm) {
    using attn_body::bf16;
    const bf16* Q = (const bf16*)(F.ws + WS_Q); const bf16* Kn = (const bf16*)(F.ws + WS_KN); const bf16* Vn = (const bf16*)(F.ws + WS_VN); bf16* AO = (bf16*)(F.ws + WS_AO);
    const int nunits = LAYER == 0 ? 1024 + 64 : 1024;
    for (int U = F.vcu; U < nunits; U += F.G) {
        int b, h, NT, lat0 = 0, q0 = 0; size_t row0;
        if (U < 1024) { b = U >> 7; h = ((U >> 6) & 1) * 4 + ((U >> 4) & 3); q0 = (U & 15) * 256; row0 = (size_t)b * SEQ + q0;
            if (LAYER == 0) NT = KVS / 64;
            else { int lo = q0 - 128, hi = q0 + 384; lo = lo < 0 ? 0 : lo; hi = hi > SEQ ? SEQ : hi; NT = 4 + (hi - lo) / 64; lat0 = CTXL + lo; } }
        else { const int uc = U - 1024; b = uc >> 3; h = uc & 7; row0 = (size_t)TX + (size_t)b * CTXL; NT = 4; }
        const bf16* Kh = Kn + (size_t)b * KVS * 128 + (h >> 2) * 64; const bf16* Vh = Vn + (size_t)b * KVS * 128 + (h >> 2) * 64;
        const float sinkl2 = LAYER == 1 ? F.in[I_SINK][h] * LOG2E : 0.f;
        if (LAYER == 0 && F.G == 256 && U < 1024 && (U >> 8) == (F.vcu & 3)) {
            const int lo = TN_DENSE + (F.vcu < 64 ? F.vcu * 72 : 64 * 72 + (F.vcu - 64) * 104); int hi = lo + (F.vcu < 64 ? 72 : 104); hi = hi > TN_ITEMS ? TN_ITEMS : hi;
            Frame Fc = F; asm volatile("" : "+v"(Fc.lane), "+v"(Fc.tid));
            transpose_range(Fc, lo, hi, Fc.wave, NWAVES);
            __syncthreads(); }
        attn_body::attn_unit<LAYER, 8>(Q + row0 * 512 + h * 64, Kh, Vh, AO + row0 * 1024 + h * 64, NT, lat0, q0, sinkl2, F.in[LAYER == 0 ? I_QNA : I_QNC], (const float*)(F.ws + WS_ROPE), U < 1024, shm);
    }
}

template <int DRY, bool FP8> __device__ __forceinline__ void p_router(const Frame& F, int l, int ntok) {
    const int gw = F.vcu * NWAVES + F.wave, NGW = F.G * NWAVES, lane = F.lane, tk = lane & 15, kq = lane >> 4;
    bf16_t* HX = F.hx(); const float* SS = (const float*)(F.ws + WS_SS);
    const float* gb = F.in[I_RGB] + l * 4; const float* eb = F.in[I_REB] + l * 32;
    unsigned* tokslot = (unsigned*)(F.ws + (DRY ? WS_HID : WS_TOK)); float* tokw = (float*)(F.ws + (DRY ? WS_HID : WS_TOK) + 512 * 1024); unsigned* list = (unsigned*)(F.ws + (DRY ? WS_HID + 2 * MiB : WS_LIST));
    unsigned* cnt = F.cnt(DRY ? l + 2 : l);
    {
        const u32x4* src = (const u32x4*)((const bf16_t*)(F.ws + WS_WR) + (size_t)l * 2 * 36864);
        u32x4 t[18];
#pragma unroll
        for (int i = 0; i < 18; ++i) t[i] = src[F.tid + i * NTHREADS];
        __syncthreads();
#pragma unroll
        for (int i = 0; i < 18; ++i) *(LAS u32x4*)(F.lds + (F.tid + i * NTHREADS) * 16) = t[i];
    }
    const LAS unsigned char* wl0 = F.lds + lane * 16;
    const LAS unsigned char* wl2 = F.lds + 2048 + ((tk >> 2) * 4 + kq) * 16;
    LAS unsigned* lcnt = (LAS unsigned*)(F.lds + LDS_TAB + 2048 + 8192); LAS unsigned* lbase = lcnt + 32;
    LAS float* gps = (LAS float*)(F.lds + LDS_TAB + 2048);
    const int nrounds = (ntok / 16 + NGW - 1) / NGW;
    for (int rd = 0; rd < nrounds; ++rd) {
        const int grp0 = F.vcu * NWAVES + rd * NGW, grp = grp0 + F.wave;
        __syncthreads();
        if (F.tid < 32) lcnt[F.tid] = 0u;
        if (grp0 < ntok / 16) { const int r0 = modrow(grp0 * 16); const float* gpg = (const float*)(F.ws + WS_GP) + (size_t)(l * 9 + r0) * 1024; const float* shg = F.mod(l, r0, 3);
            *(LAS f32x4*)(gps + 4 * F.tid) = F.tid < 256 ? *(const f32x4*)(gpg + 4 * F.tid) : *(const f32x4*)(shg + 4 * (F.tid - 256)); }
        __syncthreads();
        const bool active = grp < ntok / 16;
        const int row = (active ? grp : 0) * 16 + tk;
        bool win = false; int e1 = 0, e2 = 0; float w1 = 0.f, w2 = 0.f; unsigned p1 = 0u, p2 = 0u;
        if (active) {
        const bf16_t* xr = F.xr_row(row) + 8 * kq;
        u32x4 xq[16];
#define R_XLOAD(i, st) do { const int s_ = (st) < 32 ? (st) : 31; xq[i] = *(const u32x4*)(xr + s_ * 32); } while (0)
#pragma unroll
        for (int i = 0; i < 16; ++i) R_XLOAD(i, i);
        float ssum = 0.f;
#pragma unroll
        for (int i = 0; i < 4; ++i) { const f32x4 p = *(const f32x4*)(SS + (size_t)row * 16 + 4 * i); ssum += (p[0] + p[1]) + (p[2] + p[3]); }
        const float rms = 1.0f / sqrtf(ssum * (1.f / 1024.f) + EPS);
        f32x4 acc[3];
#pragma unroll
        for (int n = 0; n < 3; ++n) acc[n] = (f32x4){0.f, 0.f, 0.f, 0.f};
        bf16_t* hxr = HX + (size_t)row * DM + 8 * kq; unsigned char* hx8 = (unsigned char*)HX + (size_t)row * DM + 8 * kq;
        const LAS float* gpl = gps + 8 * kq;
#define R_STEP(i, st) do { const u32x4 xb_ = xq[i]; \
            const f32x4 m0 = *(const LAS f32x4*)(gpl + (st) * 32), m1 = *(const LAS f32x4*)(gpl + (st) * 32 + 4), m2 = *(const LAS f32x4*)(gpl + 1024 + (st) * 32), m3 = *(const LAS f32x4*)(gpl + 1024 + (st) * 32 + 4); \
            const f32x4 xf0 = (f32x4){bflo(xb_.x), bfhi(xb_.x), bflo(xb_.y), bfhi(xb_.y)}, xf1 = (f32x4){bflo(xb_.z), bfhi(xb_.z), bflo(xb_.w), bfhi(xb_.w)}; \
            const f32x4 h0 = (xf0 * rms) * m0 + m2, h1 = (xf1 * rms) * m1 + m3; \
            u32x4 hh; hh.x = pk2(h0[0], h0[1]); hh.y = pk2(h0[2], h0[3]); hh.z = pk2(h1[0], h1[1]); hh.w = pk2(h1[2], h1[3]); \
            if (FP8) { u32x2 h8; h8.x = pk4_fp8(h0[0], h0[1], h0[2], h0[3]); h8.y = pk4_fp8(h1[0], h1[1], h1[2], h1[3]); *(u32x2*)(hx8 + (st) * 32) = h8; } else *(u32x4*)(hxr + (st) * 32) = hh; \
            if (DRY < 3 || DRY >= 6) { \
            u32x4 hl; hl.x = pk2(h0[0] - bflo(hh.x), h0[1] - bfhi(hh.x)); hl.y = pk2(h0[2] - bflo(hh.y), h0[3] - bfhi(hh.y)); hl.z = pk2(h1[0] - bflo(hh.z), h1[1] - bfhi(hh.z)); hl.w = pk2(h1[2] - bflo(hh.w), h1[3] - bfhi(hh.w)); \
            const bf16x8 bh = __builtin_bit_cast(bf16x8, hh), bl = __builtin_bit_cast(bf16x8, hl); \
            bf16x8 w0h, w1h, w2h, w0l, w1l, w2l; if (DRY == 6) { w0h = w1h = w2h = w0l = w1l = w2l = bh; } else { w0h = *(const LAS bf16x8*)(wl0 + (st) * 2304); w1h = *(const LAS bf16x8*)(wl0 + (st) * 2304 + 1024); w2h = *(const LAS bf16x8*)(wl2 + (st) * 2304); \
            w0l = *(const LAS bf16x8*)(wl0 + RW_BYTES + (st) * 2304); w1l = *(const LAS bf16x8*)(wl0 + RW_BYTES + (st) * 2304 + 1024); w2l = *(const LAS bf16x8*)(wl2 + RW_BYTES + (st) * 2304); } \
            if (DRY == 7) { const bf16x8 sx = w0h ^ w1h ^ w2h ^ w0l ^ w1l ^ w2l ^ bl; acc[0][0] += (float)sx[0]; } else \
            acc[0] = __builtin_amdgcn_mfma_f32_16x16x32_bf16(w0h, bh, acc[0], 0, 0, 0); acc[1] = __builtin_amdgcn_mfma_f32_16x16x32_bf16(w1h, bh, acc[1], 0, 0, 0); acc[2] = __builtin_amdgcn_mfma_f32_16x16x32_bf16(w2h, bh, acc[2], 0, 0, 0); \
            acc[0] = __builtin_amdgcn_mfma_f32_16x16x32_bf16(w0h, bl, acc[0], 0, 0, 0); acc[1] = __builtin_amdgcn_mfma_f32_16x16x32_bf16(w1h, bl, acc[1], 0, 0, 0); acc[2] = __builtin_amdgcn_mfma_f32_16x16x32_bf16(w2h, bl, acc[2], 0, 0, 0); \
            acc[0] = __builtin_amdgcn_mfma_f32_16x16x32_bf16(w0l, bh, acc[0], 0, 0, 0); acc[1] = __builtin_amdgcn_mfma_f32_16x16x32_bf16(w1l, bh, acc[1], 0, 0, 0); acc[2] = __builtin_amdgcn_mfma_f32_16x16x32_bf16(w2l, bh, acc[2], 0, 0, 0); } } while (0)
        for (int st = 0; st < 32; st += 16) {
#pragma unroll
            for (int i = 0; i < 16; ++i) { R_STEP(i, st + i); R_XLOAD(i, st + i + 16); }
        }
#undef R_XLOAD
#undef R_STEP
        if (DRY >= 6 && acc[0][0] + acc[1][1] + acc[2][2] == 123.456f) tokw[row] = 1.f;
        if (DRY < 2) {
            const float lgk = acc[2][0] + gb[kq];
            const float la = __shfl_xor(lgk, 16), lb = __shfl_xor(lgk, 32), lc = __shfl_xor(la, 32);
            const float gm = fmaxf(fmaxf(lgk, la), fmaxf(lb, lc));
            win = (lgk == gm);
            win = win && !(la == gm && (kq ^ 1) < kq) && !(lb == gm && (kq ^ 2) < kq) && !(lc == gm && (kq ^ 3) < kq);
            if (win) {
                const float g_w = 1.f / (expf(lgk - gm) + expf(la - gm) + expf(lb - gm) + expf(lc - gm));
                float el[8];
                { const f32x4 b0 = *(const f32x4*)(eb + 8 * kq), b1 = *(const f32x4*)(eb + 8 * kq + 4);
#pragma unroll
                  for (int i = 0; i < 4; ++i) { el[i] = acc[0][i] + b0[i]; el[4 + i] = acc[1][i] + b1[i]; } }
                int i1 = 0; float m1 = el[0];
#pragma unroll
                for (int i = 1; i < 8; ++i) if (el[i] > m1) { m1 = el[i]; i1 = i; }
                int i2 = 0; float m2 = -3.0e38f;
#pragma unroll
                for (int i = 0; i < 8; ++i) if (i != i1 && el[i] > m2) { m2 = el[i]; i2 = i; }
                const float pp = expf(m2 - m1); w1 = g_w / (1.f + pp); w2 = g_w * pp / (1.f + pp);
                e1 = kq * 8 + i1; e2 = kq * 8 + i2;
                p1 = __hip_atomic_fetch_add(lcnt + e1, 1u, __ATOMIC_RELAXED, __HIP_MEMORY_SCOPE_WORKGROUP); p2 = __hip_atomic_fetch_add(lcnt + e2, 1u, __ATOMIC_RELAXED, __HIP_MEMORY_SCOPE_WORKGROUP);
            }
        }
        }
        __syncthreads();
        if (DRY < 2 && F.tid < 32) { const unsigned n = lcnt[F.tid]; lbase[F.tid] = n ? atomicAdd(cnt + F.tid * 64, n) : 0u; }
        __syncthreads();
        if (win) { const unsigned pos1 = lbase[e1] + p1, pos2 = lbase[e2] + p2;
            list[(size_t)e1 * TT + pos1] = (unsigned)row; list[(size_t)e2 * TT + pos2] = (unsigned)row;
            tokslot[2 * row] = ((unsigned)e1 << 16) | pos1; tokslot[2 * row + 1] = ((unsigned)e2 << 16) | pos2; tokw[2 * row] = w1; tokw[2 * row + 1] = w2; }
    }
    __syncthreads();
}
struct CombBuf { u32x2 x[4], ya[4], yb[4]; };
template <bool YB8> __device__ __forceinline__ void comb_load(CombBuf& b, const bf16_t* xr, const unsigned char* ya, const unsigned char* yb, int lane) {
#pragma unroll
    for (int j = 0; j < 4; ++j) { const int c = 4 * lane + 256 * j; b.x[j] = *(const u32x2*)(xr + c);
        if (YB8) { b.ya[j].x = *(const unsigned*)(ya + c); b.yb[j].x = *(const unsigned*)(yb + c); b.ya[j].y = 0u; b.yb[j].y = 0u; }
        else { b.ya[j] = *(const u32x2*)(ya + 2 * c); b.yb[j] = *(const u32x2*)(yb + 2 * c); } }
}
template <bool LAST, bool DRY, bool YB8> __device__ __forceinline__ void comb_finish(const Frame& F, const CombBuf& b, int l, int row, float wa, float wb, int lane) {
    const int r = modrow(row); const float* g2 = F.mod(l, r, 5); bf16_t* xr = F.xr_row(row);
    float ss = 0.f; f32x4 v[4];
#pragma unroll
    for (int j = 0; j < 4; ++j) { const int c = 4 * lane + 256 * j; const f32x4 gv = *(const f32x4*)(g2 + c);
        f32x4 y;
        if (YB8) { const f32x2 a0 = __builtin_amdgcn_cvt_pk_f32_fp8((int)b.ya[j].x, false), a1 = __builtin_amdgcn_cvt_pk_f32_fp8((int)b.ya[j].x, true), b0 = __builtin_amdgcn_cvt_pk_f32_fp8((int)b.yb[j].x, false), b1 = __builtin_amdgcn_cvt_pk_f32_fp8((int)b.yb[j].x, true);
            y[0] = wa * a0[0] + wb * b0[0]; y[1] = wa * a0[1] + wb * b0[1]; y[2] = wa * a1[0] + wb * b1[0]; y[3] = wa * a1[1] + wb * b1[1]; }
        else { y[0] = wa * bflo(b.ya[j].x) + wb * bflo(b.yb[j].x); y[1] = wa * bfhi(b.ya[j].x) + wb * bfhi(b.yb[j].x); y[2] = wa * bflo(b.ya[j].y) + wb * bflo(b.yb[j].y); y[3] = wa * bfhi(b.ya[j].y) + wb * bfhi(b.yb[j].y); }
        const f32x4 x1 = (f32x4){bflo(b.x[j].x), bfhi(b.x[j].x), bflo(b.x[j].y), bfhi(b.x[j].y)};
        v[j] = x1 + gv * y;
        if (LAST) { if (!DRY) *(f32x4*)(F.out + (size_t)row * DM + c) = v[j]; }
        else { u32x2 o; o.x = pk2(v[j][0], v[j][1]); o.y = pk2(v[j][2], v[j][3]); *(u32x2*)(xr + c) = DRY ? b.x[j] : o; }
        ss += (v[j][0] * v[j][0] + v[j][1] * v[j][1]) + (v[j][2] * v[j][2] + v[j][3] * v[j][3]); }
    if (!LAST) { const float rms = 1.0f / sqrtf(wave_sum(ss) * (1.f / 1024.f) + EPS); const float* g = F.in[I_LN1] + (l + 1) * 1024; const float* sh = F.mod(l + 1, r, 0); const float* sc = F.mod(l + 1, r, 1); f32x4 h[4];
#pragma unroll
        for (int j = 0; j < 4; ++j) { const int c = 4 * lane + 256 * j; h[j] = (v[j] * rms * *(const f32x4*)(g + c)) * (1.f + *(const f32x4*)(sc + c)) + *(const f32x4*)(sh + c); }
        store_row_bf16(F.hx() + (size_t)row * DM, lane, h); }
}
template <bool LAST, bool DRY, bool YB8> __device__ __forceinline__ void p_combine(const Frame& F, int l, int ntok, const MoeTab& tb, int tsh) {
    const int gw = F.vcu * NWAVES + F.wave, NGW = F.G * NWAVES, lane = F.lane;
    const unsigned char* YB = F.ws + WS_YB;
    const unsigned* tokslot = (const unsigned*)(F.ws + WS_TOK); const float* tokw = (const float*)(F.ws + WS_TOK + 512 * 1024);
    const int ntot = gw < ntok ? (ntok - gw + NGW - 1) / NGW : 0;
    for (int base = 0; base < ntot; base += 64) {
    const int n = ntot - base < 64 ? ntot - base : 64;
    unsigned my_sa = 0u, my_sb = 0u; float my_wa = 0.f, my_wb = 0.f;
    { const int mr = gw + (base + lane) * NGW;
      if (lane < n) { const unsigned sa = tokslot[2 * mr], sb = tokslot[2 * mr + 1]; my_wa = tokw[2 * mr]; my_wb = tokw[2 * mr + 1];
          my_sa = ((unsigned)tb.tile0[sa >> 16] << tsh) + (sa & 0xffffu); my_sb = ((unsigned)tb.tile0[sb >> 16] << tsh) + (sb & 0xffffu); } }
    CombBuf A, B;
#define COMB_LOAD(buf, i) do { const int row_ = gw + (base + (i)) * NGW; const unsigned sa_ = __builtin_amdgcn_readlane(my_sa, (i)), sb_ = __builtin_amdgcn_readlane(my_sb, (i)); \
        comb_load<YB8>(buf, F.xr_row(row_), YB + (size_t)sa_ * (YB8 ? 1024 : 2048), YB + (size_t)sb_ * (YB8 ? 1024 : 2048), lane); } while (0)
#define COMB_FIN(buf, i) do { const float wa_ = __uint_as_float(__builtin_amdgcn_readlane(__float_as_uint(my_wa), (i))), wb_ = __uint_as_float(__builtin_amdgcn_readlane(__float_as_uint(my_wb), (i))); \
        comb_finish<LAST, DRY, YB8>(F, buf, l, gw + (base + (i)) * NGW, wa_, wb_, lane); } while (0)
    COMB_LOAD(A, 0);
    for (int i = 0; i < n; i += 2) {
        if (i + 1 < n) COMB_LOAD(B, i + 1);
        COMB_FIN(A, i);
        if (i + 2 < n) COMB_LOAD(A, i + 2);
        if (i + 1 < n) COMB_FIN(B, i + 1);
    }
    }
#undef COMB_LOAD
#undef COMB_FIN
}

__global__ void __launch_bounds__(NTHREADS, 2) fwd_kernel(Params P) {
    extern __shared__ __attribute__((aligned(16))) unsigned char lds_raw[];
    Frame F;
    F.lds = (LAS unsigned char*)lds_raw; F.in = P.in; F.out = P.out; F.ws = P.ws;
    F.tid = threadIdx.x; F.lane = F.tid & 63; F.wave = __builtin_amdgcn_readfirstlane(F.tid >> 6);
    F.G = gridDim.x; { const int bx = blockIdx.x; F.vcu = (F.G % 8 == 0) ? (bx % 8) * (F.G / 8) + bx / 8 : bx; }
    volatile LAS unsigned* misc = (volatile LAS unsigned*)(F.lds + LDS_MISC);
    if (F.tid < 16) misc[F.tid] = 0u;
    __syncthreads();
#if ONE_LAUNCH
    XcdBarrier bar = xcd_barrier_post((unsigned*)(F.ws + WS_CTL) + CW_BAR, misc + 8);
#define GRID_BAR() do { xcd_barrier(bar); } while (0)
#else
#define GRID_BAR() do { } while (0)
#endif
    const int lo = P.ph_lo, hi = P.ph_hi;
#ifndef DRYMASK
#define DRYMASK 0x4000
#endif
#ifndef DRYV
#define DRYV 7
#endif
#ifndef PHMASK
#define PHMASK 0xFFFFFFFFu
#endif
#define IN(k) (((PHMASK >> (k)) & 1u) && lo <= (k) && (k) < hi)
#ifdef PROBE_PH
#define STAMP(k) do { if (blockIdx.x == 0 && F.tid == 0) { const unsigned long long t_ = __builtin_amdgcn_s_memrealtime(); \
        if ((k) == PROBE_PH - 1) { misc[0] = (unsigned)t_; misc[1] = (unsigned)(t_ >> 32); } if ((k) == PROBE_PH) { misc[2] = (unsigned)t_; misc[3] = (unsigned)(t_ >> 32); } } } while (0)
#else
#define STAMP(k) do { } while (0)
#endif
#define SEAM(k) do { if (IN((k) + 1)) GRID_BAR(); STAMP(k); } while (0)
    STAMP(-1);
    bf16_t* HX = F.hx(); bf16_t* Qb = (bf16_t*)(F.ws + WS_Q); bf16_t* KVb = (bf16_t*)(F.ws + WS_KV); bf16_t* Gb = (bf16_t*)(F.ws + WS_G); bf16_t* AO = (bf16_t*)(F.ws + WS_AO);
    bf16_t* HID = (bf16_t*)(F.ws + WS_HID); bf16_t* YB = (bf16_t*)(F.ws + WS_YB);

    if (IN(0)) { Frame Fp = F; asm volatile("" : "+v"(Fp.tid), "+v"(Fp.lane)); p0_prologue(Fp); SEAM(0); }
    if (IN(1)) { Frame Fp = F; asm volatile("" : "+v"(Fp.tid), "+v"(Fp.lane)); p0_misc(Fp); p_norm1_l0(Fp); SEAM(1); }
    if (IN(2)) { Frame Fp = F; asm volatile("" : "+v"(Fp.tid), "+v"(Fp.lane)); SchedDense S{(const bf16_t*)(Fp.ws + WS_WINAB), 1024, TT / 256, 7, 0, 0, Fp.vcu, Fp.G}; EpiInProj<true> E{Qb, KVb, (bf16_t*)(Fp.ws + WS_VN), Gb}; GEMM(Fp, HX, 2048, S, E); SEAM(2); }
    if (IN(3)) { Frame Fp = F; asm volatile("" : "+v"(Fp.tid), "+v"(Fp.lane)); p_k_post(Fp, Fp.in[I_KNA]); p_conv(Fp); SEAM(3); }
    if (IN(4)) { Frame Fp = F; asm volatile("" : "+v"(Fp.tid), "+v"(Fp.lane));
#ifdef ATTN_SIMPLE
        attn_simple<0>(Fp);
#else
        attn_fast<0>(Fp, (char*)lds_raw);
#endif
        SEAM(4); }
    if (IN(5)) { Frame Fp = F; asm volatile("" : "+v"(Fp.tid), "+v"(Fp.lane)); SchedDense S{(const bf16_t*)(Fp.ws + WS_WOUTAB), 1024, TT / 256, 4, 0, 0, Fp.vcu, Fp.G}; EpiOutProj<true> E{Fp, 0}; GEMM(Fp, AO, 2048, S, E);
        SEAM(5); }
    if (IN(6)) { Frame Fp = F; asm volatile("" : "+v"(Fp.tid), "+v"(Fp.lane));
#if (DRYMASK >> 6) & 1
        p_router<DRYV, FP8_G1_L0>(Fp, 0, TT); GRID_BAR();
#endif
        p_router<0, FP8_G1_L0>(Fp, 0, TT); SEAM(6); }
    if (IN(7)) { Frame Fp = F; asm volatile("" : "+v"(Fp.tid), "+v"(Fp.lane)); const MoeTab tb = moe_tables(Fp, 0, (FP8_L0 ? 7 : 8)); SchedMoe S{(const bf16_t*)(Fp.ws + WS_WGU), (size_t)1024 * 1024, (FP8_L0 ? 7 : 8), tb, (const unsigned*)(Fp.ws + WS_LIST), true, Fp.vcu, Fp.G}; EpiMoe1<FP8_G1_L0, FP8_G2_L0, FP8_L0> E{HID}; if constexpr (FP8_L0 && H3) gemm_fp8_h3(Fp, HX, 1024, S, E); else gemm_fast<true, FP8_G1_L0, FP8_L0>(Fp, HX, FP8_G1_L0 ? 1024 : 2048, S, E); SEAM(7); }
    if (IN(8)) { Frame Fp = F; asm volatile("" : "+v"(Fp.tid), "+v"(Fp.lane)); const MoeTab tb = moe_tables(Fp, 0, (FP8_L0 ? 7 : 8)); SchedMoe S{(const bf16_t*)(Fp.ws + WS_WD), (size_t)1024 * 512, (FP8_L0 ? 7 : 8), tb, nullptr, false, Fp.vcu, Fp.G}; EpiMoe2<FP8_G2_L0, FP8_L0> E{YB}; if constexpr (FP8_L0 && H3) gemm_fp8_h3(Fp, HID, 512, S, E); else gemm_fast<ALIGN_G2, FP8_G2_L0, FP8_L0>(Fp, HID, FP8_G2_L0 ? 512 : 1024, S, E); SEAM(8); }
    if (IN(9)) { Frame Fp = F; asm volatile("" : "+v"(Fp.tid), "+v"(Fp.lane)); const MoeTab tb = moe_tables(Fp, 0, (FP8_L0 ? 7 : 8));
#if (DRYMASK >> 9) & 1
        p_combine<false, true, FP8_L0 && H3>(Fp, 0, TT, tb, FP8_L0 ? 7 : 8); GRID_BAR();
#endif
        p_combine<false, false, FP8_L0 && H3>(Fp, 0, TT, tb, FP8_L0 ? 7 : 8); SEAM(9); }
    if (IN(10)) { Frame Fp = F; asm volatile("" : "+v"(Fp.tid), "+v"(Fp.lane)); SchedDense S{(const bf16_t*)(Fp.ws + WS_WINCD), 1024, TX / 256, 5, TC / 256, 2, Fp.vcu, Fp.G}; EpiInProj<false> E{Qb, KVb, (bf16_t*)(Fp.ws + WS_VN), Gb}; GEMM(Fp, HX, 2048, S, E); SEAM(10); }
    if (IN(11)) { Frame Fp = F; asm volatile("" : "+v"(Fp.tid), "+v"(Fp.lane)); p_k_post(Fp, Fp.in[I_KNC]); p_pool(Fp); SEAM(11); }
    if (IN(12)) { Frame Fp = F; asm volatile("" : "+v"(Fp.tid), "+v"(Fp.lane));
#ifdef ATTN_SIMPLE
        attn_simple<1>(Fp);
#else
        attn_fast<1>(Fp, (char*)lds_raw);
#endif
        SEAM(12); }
    if (IN(13)) { Frame Fp = F; asm volatile("" : "+v"(Fp.tid), "+v"(Fp.lane)); SchedDense S{(const bf16_t*)(Fp.ws + WS_WOUTCD), 1024, TX / 256, 4, 0, 0, Fp.vcu, Fp.G};
#if (DRYMASK >> 13) & 1
        { EpiOutProj<false, true> Ed{Fp, 1}; GEMMO(Fp, AO, 2048, S, Ed); GRID_BAR(); }
#endif
        EpiOutProj<false> E{Fp, 1}; GEMM(Fp, AO, 2048, S, E); SEAM(13); }
    if (IN(14)) { Frame Fp = F; asm volatile("" : "+v"(Fp.tid), "+v"(Fp.lane));
#if (DRYMASK >> 14) & 1
        p_router<DRYV, FP8_G1_L1>(Fp, 1, TX); GRID_BAR();
#endif
        p_router<0, FP8_G1_L1>(Fp, 1, TX); SEAM(14); }
    if (IN(15)) { Frame Fp = F; asm volatile("" : "+v"(Fp.tid), "+v"(Fp.lane)); const MoeTab tb = moe_tables(Fp, 1, (FP8_L1 ? 7 : 8)); SchedMoe S{(const bf16_t*)(Fp.ws + WS_WGU) + (size_t)32 * 1024 * 1024, (size_t)1024 * 1024, (FP8_L1 ? 7 : 8), tb, (const unsigned*)(Fp.ws + WS_LIST), true, Fp.vcu, Fp.G}; EpiMoe1<FP8_G1_L1, FP8_G2_L1, FP8_L1> E{HID}; if constexpr (FP8_L1 && H3) gemm_fp8_h3(Fp, HX, 1024, S, E); else gemm_fast<true, FP8_G1_L1, FP8_L1>(Fp, HX, FP8_G1_L1 ? 1024 : 2048, S, E); SEAM(15); }
    if (IN(16)) { Frame Fp = F; asm volatile("" : "+v"(Fp.tid), "+v"(Fp.lane)); const MoeTab tb = moe_tables(Fp, 1, (FP8_L1 ? 7 : 8)); SchedMoe S{(const bf16_t*)(Fp.ws + WS_WD) + (size_t)32 * 1024 * 512, (size_t)1024 * 512, (FP8_L1 ? 7 : 8), tb, nullptr, false, Fp.vcu, Fp.G}; EpiMoe2<FP8_G2_L1, FP8_L1> E{YB}; if constexpr (FP8_L1 && H3) gemm_fp8_h3(Fp, HID, 512, S, E); else gemm_fast<ALIGN_G2, FP8_G2_L1, FP8_L1>(Fp, HID, FP8_G2_L1 ? 512 : 1024, S, E); SEAM(16); }
    if (IN(17)) { Frame Fp = F; asm volatile("" : "+v"(Fp.tid), "+v"(Fp.lane)); const MoeTab tb = moe_tables(Fp, 1, (FP8_L1 ? 7 : 8));
#if (DRYMASK >> 17) & 1
        p_combine<true, true, FP8_L1 && H3>(Fp, 1, TX, tb, FP8_L1 ? 7 : 8); GRID_BAR();
#endif
        p_combine<true, false, FP8_L1 && H3>(Fp, 1, TX, tb, FP8_L1 ? 7 : 8); }
#ifdef PROBE_PH
    STAMP(NPH - 1);
    if (blockIdx.x == 0 && F.tid == 0) { const unsigned long long t0 = ((unsigned long long)misc[1] << 32) | misc[0], t1 = ((unsigned long long)misc[3] << 32) | misc[2];
        const unsigned long long te = __builtin_amdgcn_s_memrealtime(), span = (t1 - t0) * 16ull;
        while (__builtin_amdgcn_s_memrealtime() - te < span) __builtin_amdgcn_s_sleep(32); }
#endif
#undef IN
#undef SEAM
}

extern "C" void kernel_launch(void* const* d_in, const int* in_sizes, int n_in, void* d_out, int out_size, void* d_ws, size_t ws_size, hipStream_t stream) {
    static int grid = 0;
    if (grid == 0) {
        if (n_in != 30 || out_size != TX * DM || ws_size < WS_END) { fprintf(stderr, "kernel_launch: unexpected shapes (n_in %d out %d ws %zu)\n", n_in, out_size, ws_size); grid = -1; return; }
        int dev = 0, cus = 0;
        if (hipGetDevice(&dev) != hipSuccess || hipDeviceGetAttribute(&cus, hipDeviceAttributeMultiprocessorCount, dev) != hipSuccess) { grid = -1; return; }
        if (hipFuncSetAttribute((const void*)fwd_kernel, hipFuncAttributeMaxDynamicSharedMemorySize, LDS_BYTES) != hipSuccess) { fprintf(stderr, "kernel_launch: hipFuncSetAttribute failed\n"); grid = -1; return; }
        int per_cu = 0;
        if (hipOccupancyMaxActiveBlocksPerMultiprocessor(&per_cu, (const void*)fwd_kernel, NTHREADS, LDS_BYTES) != hipSuccess || per_cu < 1) { fprintf(stderr, "kernel_launch: occupancy query says %d\n", per_cu); }
        (void)hipGetLastError();
        grid = cus;
    }
    if (grid < 0) return;
    (void)hipMemsetAsync((char*)d_ws + WS_CTL, 0, CTL_ZERO_BYTES, stream);
    Params p{};
    for (int i = 0; i < 30; ++i) p.in[i] = (const float*)d_in[i];
    p.out = (float*)d_out; p.ws = (unsigned char*)d_ws;
#if ONE_LAUNCH
    p.ph_lo = 0; p.ph_hi = NPH;
    hipLaunchKernelGGL(fwd_kernel, dim3(grid), dim3(NTHREADS), LDS_BYTES, stream, p);
#else
    for (int ph = 0; ph < NPH; ++ph) { p.ph_lo = ph; p.ph_hi = ph + 1; hipLaunchKernelGGL(fwd_kernel, dim3(grid), dim3(NTHREADS), LDS_BYTES, stream, p); }
#endif
}
```

```cpp
#include <hip/hip_runtime.h>
#include <cstdio>
#include <cstdint>

#ifndef ONE_LAUNCH
#define ONE_LAUNCH 1
#endif

#ifndef FP8_L0
#define FP8_L0 1
#endif
#ifndef FP8_L1
#define FP8_L1 1
#endif
#ifndef H3_ALIGN
#define H3_ALIGN 1
#endif
#ifndef H3
#define H3 1
#endif
#define FP8_G1_L0 FP8_L0
#define FP8_G2_L0 FP8_L0
#define FP8_G1_L1 FP8_L1
#define FP8_G2_L1 FP8_L1
#define LAS __attribute__((address_space(3)))
#define GAS __attribute__((address_space(1)))
typedef unsigned short bf16_t;
typedef short bf16x8 __attribute__((ext_vector_type(8)));
typedef float f32x4 __attribute__((ext_vector_type(4)));
typedef float f32x2 __attribute__((ext_vector_type(2)));
typedef unsigned u32x4 __attribute__((ext_vector_type(4)));
typedef unsigned u32x2 __attribute__((ext_vector_type(2)));
typedef __bf16 bf16x2_t __attribute__((ext_vector_type(2)));

constexpr int NB = 8, SEQ = 4096, DM = 1024, CTXL = 256, HD = 64;
constexpr int TX = NB * SEQ, TC = NB * CTXL, TT = TX + TC;
constexpr int KVS = CTXL + SEQ;
constexpr int NE = 32;
constexpr int NTILE_MAX = 576, NSLOT = 304 * 256;
constexpr float EPS = 1e-6f;
constexpr float LOG2E = 1.4426950408889634f;
constexpr float C2 = 0.125f * LOG2E;
constexpr int NWAVES = 8, NTHREADS = 512;
constexpr int NPH = 18;

enum { I_X = 0, I_C, I_CTX, I_CCTX, I_MODW, I_MODB, I_LN1, I_LN2, I_WINAB, I_WOUTAB, I_QNA, I_KNA, I_CONVW, I_CONVB, I_CLNG, I_CLNB,
       I_WINCD, I_WOUTCD, I_QNC, I_KNC, I_SINK, I_POOLW, I_POOLS, I_RGW, I_RGB, I_REW, I_REB, I_EXG, I_EXU, I_EXD };

constexpr size_t MiB = 1u << 20;
constexpr size_t WS_CTL = 0, CTL_ZERO_BYTES = 1 * MiB;
constexpr size_t WS_MOD = 1 * MiB;
constexpr size_t WS_ROPE = 2 * MiB;
constexpr size_t WS_TOK = 3 * MiB;
constexpr size_t WS_LIST = 4 * MiB;
constexpr size_t WS_WINAB = 10 * MiB;
constexpr size_t WS_WOUTAB = 14 * MiB;
constexpr size_t WS_WINCD = 16 * MiB;
constexpr size_t WS_WOUTCD = 19 * MiB;
constexpr size_t WS_XC = 21 * MiB;
constexpr size_t WS_KN = 30 * MiB;
constexpr size_t WS_VN = 39 * MiB;
constexpr size_t WS_WGU = 48 * MiB;
constexpr size_t WS_WD = 176 * MiB;
constexpr size_t WS_XR = 240 * MiB;
constexpr size_t WS_HID = 308 * MiB;
constexpr size_t WS_Q = 384 * MiB;
constexpr size_t WS_KV = 418 * MiB;
constexpr size_t WS_G = 435 * MiB;
constexpr size_t WS_AO = 469 * MiB;
constexpr size_t WS_YB = 384 * MiB;
constexpr size_t WS_SS = 537 * MiB;
constexpr size_t WS_WR = 9 * MiB;
constexpr size_t WS_GP = 3 * MiB + 896 * 1024;
constexpr size_t WS_END = 540 * MiB;
static_assert(WS_YB + (size_t)NSLOT * 1024 * 2 <= WS_END && WS_AO + (size_t)TT * 1024 * 2 <= WS_END, "ws map");
constexpr int CW_CNT = 256;
constexpr int CW_BAR = 16384;

constexpr int RING_BYTES = 131072;
constexpr int RW_BYTES = 73728;
constexpr int LDS_MISC = 2 * RW_BYTES;
constexpr int LDS_TAB = LDS_MISC + 256;
constexpr int LDS_BYTES = 163840;

__device__ __forceinline__ unsigned pk2(float lo, float hi) { f32x2 v = {lo, hi}; bf16x2_t b = __builtin_convertvector(v, bf16x2_t); return __builtin_bit_cast(unsigned, b); }
__device__ __forceinline__ unsigned pk4_fp8(float a, float b, float c, float d) { int t = __builtin_amdgcn_cvt_pk_fp8_f32(a, b, 0, false); t = __builtin_amdgcn_cvt_pk_fp8_f32(c, d, t, true); return (unsigned)t; }
constexpr float W8_SCALE = 32.f, W8_INV = 1.f / 32.f;
__device__ __forceinline__ float bflo(unsigned w) { return __uint_as_float(w << 16); }
__device__ __forceinline__ float bfhi(unsigned w) { return __uint_as_float(w & 0xffff0000u); }
__device__ __forceinline__ float bf2f(bf16_t h) { return __uint_as_float((unsigned)h << 16); }
__device__ __forceinline__ float wave_sum(float v) {
    v += __int_as_float(__builtin_amdgcn_update_dpp(0, __float_as_int(v), 0xB1, 0xF, 0xF, true));
    v += __int_as_float(__builtin_amdgcn_update_dpp(0, __float_as_int(v), 0x4E, 0xF, 0xF, true));
    v += __int_as_float(__builtin_amdgcn_update_dpp(0, __float_as_int(v), 0x141, 0xF, 0xF, true));
    v += __int_as_float(__builtin_amdgcn_update_dpp(0, __float_as_int(v), 0x140, 0xF, 0xF, true));
    { const auto r = __builtin_amdgcn_permlane16_swap(__float_as_uint(v), __float_as_uint(v), false, false); v = __uint_as_float(r[0]) + __uint_as_float(r[1]); }
    { const auto r = __builtin_amdgcn_permlane32_swap(__float_as_uint(v), __float_as_uint(v), false, false); v = __uint_as_float(r[0]) + __uint_as_float(r[1]); }
    return v;
}
__device__ __forceinline__ float sigmoidf_(float v) { return __builtin_amdgcn_rcpf(1.f + __expf(-v)); }

#define XB_TMO      128
#define XB_XCNT(j)  (256  + 64 * (j))
#define XB_XSUB(j)  (1280 + 64 * (j))
#define XB_XGEN(j)  (2304 + 64 * (j))
#define XB_TOP      3328
#define XB_TOPGEN   3392
#define XCD_BAR_WORDS 3456
#define XB_SPIN_CAP (1u << 18)
__device__ __forceinline__ unsigned xb_ld(unsigned* p)              { return __hip_atomic_load(p, __ATOMIC_RELAXED, __HIP_MEMORY_SCOPE_AGENT); }
__device__ __forceinline__ unsigned xb_add(unsigned* p, unsigned v) { return __hip_atomic_fetch_add(p, v, __ATOMIC_RELAXED, __HIP_MEMORY_SCOPE_AGENT); }
__device__ __forceinline__ unsigned xb_xcc_id() { return (unsigned)__builtin_amdgcn_s_getreg((3 << 11) | 20) & 0xFu; }
#define XB_SPIN(cond, bar) do { unsigned _sp = 0; while (cond) { __builtin_amdgcn_s_sleep(1); \
    if ((++_sp & 255u) == 0u) { if (xb_ld(&(bar)[XB_TMO])) break; if (_sp > XB_SPIN_CAP) { atomicAdd(&(bar)[XB_TMO], 1u); break; } } } } while (0)
struct XcdBarrier { unsigned* bar; unsigned x; volatile LAS unsigned* st; };
__device__ __forceinline__ XcdBarrier xcd_barrier_post(unsigned* bar, volatile LAS unsigned* st) {
    XcdBarrier b; b.bar = bar; b.x = xb_xcc_id(); b.st = st;
    if (threadIdx.x == 0) (void)xb_add(&bar[XB_XCNT(b.x)], 1u);
    return b;
}
__device__ __forceinline__ void xcd_barrier_complete(unsigned* bar, unsigned x, unsigned& nloc, unsigned& nx) {
    const unsigned G = gridDim.x * gridDim.y * gridDim.z;
    unsigned sum, cnt, mine, sp = 0u;
    for (;;) {
        sum = 0u; cnt = 0u; mine = 0u;
#pragma unroll
        for (unsigned j = 0; j < 16; ++j) { const unsigned c = xb_ld(&bar[XB_XCNT(j)]); sum += c; cnt += (c > 0u) ? 1u : 0u; mine = (j == x) ? c : mine; }
        if (sum == G) break;
        __builtin_amdgcn_s_sleep(1);
        if ((++sp & 255u) == 0u) { if (xb_ld(&bar[XB_TMO])) break; if (sp > XB_SPIN_CAP) { atomicAdd(&bar[XB_TMO], 1u); break; } }
    }
    nloc = mine > 0u ? mine : 1u; nx = cnt > 0u ? cnt : 1u;
}
__device__ __forceinline__ void xcd_barrier(const XcdBarrier& b) {
    asm volatile("s_waitcnt vmcnt(0)" ::: "memory");
    __syncthreads();
    if (threadIdx.x == 0) {
        unsigned* bar = b.bar;
        __builtin_amdgcn_s_waitcnt(0);
        unsigned nloc = b.st[0], nx = b.st[1];
        if (nloc == 0u) { xcd_barrier_complete(bar, b.x, nloc, nx); b.st[0] = nloc; b.st[1] = nx; }
        const unsigned old = xb_add(&bar[XB_XSUB(b.x)], 1u);
        const unsigned gen = old / nloc;
        if (old + 1u == (gen + 1u) * nloc) {
            __builtin_amdgcn_fence(__ATOMIC_RELEASE, "agent");
            asm volatile("s_waitcnt vmcnt(0)" ::: "memory");
            const unsigned og = xb_add(&bar[XB_TOP], 1u);
            const unsigned tg = og / nx;
            if (og + 1u == (tg + 1u) * nx) xb_add(&bar[XB_TOPGEN], 1u);
            else XB_SPIN(xb_ld(&bar[XB_TOPGEN]) == tg, bar);
            __builtin_amdgcn_fence(__ATOMIC_ACQUIRE, "agent");
            xb_add(&bar[XB_XGEN(b.x)], 1u);
            asm volatile("s_waitcnt vmcnt(0)" ::: "memory");
        } else {
            XB_SPIN(xb_ld(&bar[XB_XGEN(b.x)]) == gen, bar);
            __builtin_amdgcn_fence(__ATOMIC_ACQUIRE, "agent");
            asm volatile("s_waitcnt vmcnt(0)" ::: "memory");
        }
    }
    __syncthreads();
}

struct Params { const float* in[30]; float* out; unsigned char* ws; int ph_lo, ph_hi; };
struct Frame {
    LAS unsigned char* lds;
    const float* const* in;
    float* out; unsigned char* ws;
    int tid, lane, wave, vcu, G;
    __device__ __forceinline__ const float* mod(int l, int r, int chunk) const { return (const float*)(ws + WS_MOD) + ((size_t)(l * 9 + r) * 6144 + chunk * 1024); }
    __device__ __forceinline__ bf16_t* xr_row(int row) const { return (bf16_t*)(ws + WS_XR) + (size_t)row * DM; }
    __device__ __forceinline__ bf16_t* hx() const { return (bf16_t*)out; }
    __device__ __forceinline__ const float* xin_row(int row) const { return row < TX ? in[I_X] + (size_t)row * DM : in[I_CTX] + (size_t)(row - TX) * DM; }
    __device__ __forceinline__ unsigned* cnt(int l) const { return (unsigned*)(ws + WS_CTL) + CW_CNT + l * 32 * 64; }
};
__device__ __forceinline__ int modrow(int row) { return row < TX ? (row >> 12) : 8; }

__device__ __forceinline__ void p0_mod_item(const Frame& F, int item) {
    const int l = item / 96, cg = item % 96;
    LAS float* sc = (LAS float*)F.lds;
    LAS float* red = sc + 9 * 1024;
    for (int i = F.tid; i < 9 * 1024; i += NTHREADS) { const int r = i >> 10, k = i & 1023; const float v = r < 8 ? F.in[I_C][r * 1024 + k] : F.in[I_CCTX][k]; sc[i] = v / (1.f + expf(-v)); }
    __syncthreads();
    const float* W = F.in[I_MODW] + (size_t)l * 1024 * 6144 + cg * 64 + F.lane;
    float acc[9];
#pragma unroll
    for (int r = 0; r < 9; ++r) acc[r] = 0.f;
    for (int kb = 0; kb < 128; kb += 64) { float w[64];
#pragma unroll
        for (int kk = 0; kk < 64; ++kk) w[kk] = W[(size_t)(F.wave * 128 + kb + kk) * 6144];
#pragma unroll
        for (int kk = 0; kk < 64; ++kk) { const int k = F.wave * 128 + kb + kk;
#pragma unroll
            for (int r = 0; r < 9; ++r) acc[r] += sc[r * 1024 + k] * w[kk]; } }
#pragma unroll
    for (int r = 0; r < 9; ++r) red[(F.wave * 9 + r) * 64 + F.lane] = acc[r];
    __syncthreads();
    for (int i = F.tid; i < 9 * 64; i += NTHREADS) { const int r = i >> 6, ln = i & 63; float s = 0.f;
#pragma unroll
        for (int w = 0; w < 8; ++w) s += red[(w * 9 + r) * 64 + ln];
        ((float*)(F.ws + WS_MOD))[(size_t)(l * 9 + r) * 6144 + cg * 64 + ln] = s + F.in[I_MODB][l * 6144 + cg * 64 + ln]; }
    __syncthreads();
}
struct TDesc { const float* src; unsigned char* dst; int ldw; bool fp8; };
__device__ __forceinline__ void t_load(const TDesc& d, f32x4 (&v)[16], int lane) {
    const int sh = d.fp8 ? 3 : 4, kr = lane >> sh, nq = lane & ((1 << sh) - 1), rs = 64 >> sh;
#pragma unroll
    for (int i = 0; i < 16; ++i) v[i] = *(const f32x4*)(d.src + (size_t)(d.fp8 ? 16 * kr + i : rs * i + kr) * d.ldw + 4 * nq);
}
__device__ __forceinline__ void t_finish(const TDesc& d, const f32x4 (&v)[16], LAS float* scr, int lane) {
    if (!d.fp8) {
        const int kr = lane >> 4, nq = lane & 15;
#pragma unroll
        for (int i = 0; i < 16; ++i) { LAS float* s = scr + (4 * i + kr) * 65 + 4 * nq; s[0] = v[i][0]; s[1] = v[i][1]; s[2] = v[i][2]; s[3] = v[i][3]; }
        asm volatile("s_waitcnt lgkmcnt(0)" ::: "memory");
        const int c = lane & 7;
#pragma unroll
        for (int j = 0; j < 8; ++j) { const int n = (lane >> 3) + 8 * j; const LAS float* s = scr + (8 * c) * 65 + n;
            u32x4 o; o.x = pk2(s[0 * 65], s[1 * 65]); o.y = pk2(s[2 * 65], s[3 * 65]); o.z = pk2(s[4 * 65], s[5 * 65]); o.w = pk2(s[6 * 65], s[7 * 65]);
            *(u32x4*)(d.dst + ((size_t)n * 64 + 8 * c) * 2) = o; }
    } else {
        const int kr = lane >> 3, nq = lane & 7;
        unsigned w[16];
#pragma unroll
        for (int i = 0; i < 16; ++i) w[i] = pk4_fp8(v[i][0] * W8_SCALE, v[i][1] * W8_SCALE, v[i][2] * W8_SCALE, v[i][3] * W8_SCALE);
        unsigned r[4][4];
#pragma unroll
        for (int a = 0; a < 4; ++a) { const unsigned t0 = __builtin_amdgcn_perm(w[4 * a + 1], w[4 * a], 0x05010400u), t1 = __builtin_amdgcn_perm(w[4 * a + 1], w[4 * a], 0x07030602u),
                                                     t2 = __builtin_amdgcn_perm(w[4 * a + 3], w[4 * a + 2], 0x05010400u), t3 = __builtin_amdgcn_perm(w[4 * a + 3], w[4 * a + 2], 0x07030602u);
            r[a][0] = __builtin_amdgcn_perm(t2, t0, 0x05040100u); r[a][1] = __builtin_amdgcn_perm(t2, t0, 0x07060302u); r[a][2] = __builtin_amdgcn_perm(t3, t1, 0x05040100u); r[a][3] = __builtin_amdgcn_perm(t3, t1, 0x07060302u); }
#pragma unroll
        for (int j = 0; j < 4; ++j) { u32x4 o; o.x = r[0][j]; o.y = r[1][j]; o.z = r[2][j]; o.w = r[3][j]; *(u32x4*)(d.dst + (size_t)(4 * nq + j) * 128 + 16 * kr) = o; }
    }
    asm volatile("s_waitcnt lgkmcnt(0)" ::: "memory");
}
constexpr int TN_AB = 16 * 28, TN_OAB = 16 * 16, TN_CD = 16 * 20, TN_OCD = 8 * 16, TN_G = 64 * 128, TN_U = 64 * 128, TN_D = 64 * 128;
constexpr int TN_ITEMS = TN_AB + TN_OAB + TN_CD + TN_OCD + TN_G + TN_U + TN_D;
__device__ __forceinline__ TDesc t_decode(const Frame& F, int it) {
    TDesc d; d.fp8 = false; int r = it;
    if (r < TN_AB) { const int kb = r / 28, nb = r % 28, n0 = nb * 64; int d0;
        if (n0 < 768) d0 = n0; else if (n0 < 1280) { const int j = n0 - 768; d0 = 768 + (j >> 7) * 256 + (j & 127); } else { const int j = n0 - 1280; d0 = 768 + (j >> 7) * 256 + 128 + (j & 127); }
        d.src = F.in[I_WINAB] + (size_t)kb * 64 * 1792 + n0; d.ldw = 1792; d.dst = F.ws + WS_WINAB + ((size_t)kb * 1792 + d0) * 128; return d; } r -= TN_AB;
    if (r < TN_OAB) { const int kb = r / 16, nb = r % 16; d.src = F.in[I_WOUTAB] + (size_t)kb * 64 * 1024 + nb * 64; d.ldw = 1024; d.dst = F.ws + WS_WOUTAB + ((size_t)kb * 1024 + nb * 64) * 128; return d; } r -= TN_OAB;
    if (r < TN_CD) { const int kb = r / 20, nb = r % 20; d.src = F.in[I_WINCD] + (size_t)kb * 64 * 1280 + nb * 64; d.ldw = 1280; d.dst = F.ws + WS_WINCD + ((size_t)kb * 1280 + nb * 64) * 128; return d; } r -= TN_CD;
    if (r < TN_OCD) { const int kb = r / 16, nb = r % 16; d.src = F.in[I_WOUTCD] + (size_t)kb * 64 * 1024 + nb * 64; d.ldw = 1024; d.dst = F.ws + WS_WOUTCD + ((size_t)kb * 1024 + nb * 64) * 128; return d; } r -= TN_OCD;
    if (r < TN_G + TN_U) { const bool up = r >= TN_G; if (up) r -= TN_G; const int le = r >> 7, q = r & 127;
        const float* base = F.in[up ? I_EXU : I_EXG] + (size_t)le * 1024 * 512; unsigned char* wb = F.ws + WS_WGU + (size_t)le * 1024 * 1024 * 2;
        if ((le >> 5) ? FP8_G1_L1 : FP8_G1_L0) { const int kb = q >> 4, n0 = (q & 15) * 32, d0 = (n0 >> 7) * 256 + (up ? 128 : 0) + (n0 & 127);
            d.fp8 = true; d.src = base + (size_t)kb * 128 * 512 + n0; d.ldw = 512; d.dst = wb + ((size_t)kb * 1024 + d0) * 128; return d; }
        const int kb = q >> 3, n0 = (q & 7) * 64, d0 = (n0 >> 7) * 256 + (up ? 128 : 0) + (n0 & 127);
        d.src = base + (size_t)kb * 64 * 512 + n0; d.ldw = 512; d.dst = wb + ((size_t)kb * 1024 + d0) * 128; return d; } r -= TN_G + TN_U;
    { const int le = r >> 7, q = r & 127; const float* base = F.in[I_EXD] + (size_t)le * 512 * 1024; unsigned char* wb = F.ws + WS_WD + (size_t)le * 1024 * 512 * 2;
        if ((le >> 5) ? FP8_G2_L1 : FP8_G2_L0) { const int kb = q >> 5, nb = q & 31;
            d.fp8 = true; d.src = base + (size_t)kb * 128 * 1024 + nb * 32; d.ldw = 1024; d.dst = wb + ((size_t)kb * 1024 + nb * 32) * 128; return d; }
        const int kb = q >> 4, nb = q & 15;
        d.src = base + (size_t)kb * 64 * 1024 + nb * 64; d.ldw = 1024; d.dst = wb + ((size_t)kb * 1024 + nb * 64) * 128; return d; }
}
constexpr int TN_DENSE = TN_AB + TN_OAB + TN_CD + TN_OCD;
__device__ __forceinline__ void transpose_range(const Frame& F, int lo, int hi, int w, int nw) {
    LAS float* scr = (LAS float*)(F.lds + F.wave * 16896);
    f32x4 va[16], vb[16]; TDesc da, db;
    const int first = lo + w;
    if (first < hi) { da = t_decode(F, first); t_load(da, va, F.lane); }
    for (int it = first; it < hi; it += 2 * nw) {
        const int it2 = it + nw, it3 = it + 2 * nw;
        if (it2 < hi) { db = t_decode(F, it2); t_load(db, vb, F.lane); }
        t_finish(da, va, scr, F.lane);
        if (it3 < hi) { da = t_decode(F, it3); t_load(da, va, F.lane); }
        if (it2 < hi) t_finish(db, vb, scr, F.lane);
    }
}
__device__ __forceinline__ void p0_prologue(const Frame& F) { for (int it = F.vcu; it < 192; it += F.G) p0_mod_item(F, it); }
__device__ __forceinline__ bool misc_in_p0(const Frame& F) { return F.G >= 224; }
template <int PART> __device__ __forceinline__ void p0_misc(const Frame& F, int jb, int JB) {
    const int gw = jb * NWAVES + F.wave, NGW = JB * NWAVES;
    const int gt = gw * 64 + F.lane, NGT = NGW * 64;
    if (PART == 2) { float* rc = (float*)(F.ws + WS_ROPE); float* rs = rc + SEQ * 32;
      for (int i = gt; i < SEQ * 32; i += NGT) { const int s = i >> 5, d = i & 31, f = d & 15; const float pos = (float)(d < 16 ? (s >> 6) : (s & 63));
          const float inv = exp2f(-(float)f * (13.287712379549449f / 16.f)); const float a = pos * inv; rc[i] = cosf(a); rs[i] = sinf(a); } }
    if (PART == 1) { typedef float f32x16_t __attribute__((ext_vector_type(16)));
      bf16_t* WT = (bf16_t*)(F.ws + WS_WOUTCD); const int l31 = F.lane & 31, lh = F.lane >> 5;
      for (int it = gw; it < 4 * 32 * 4; it += NGW) { const int g = it >> 7, dt = (it >> 2) & 31, ct = it & 3;
          const float* wo = F.in[I_WOUTCD] + (size_t)(512 + g * 128 + lh) * 1024 + dt * 32 + l31;
          const float* pw = F.in[I_POOLW] + (size_t)(g * 128 + ct * 32 + l31) * 128 + lh; const float* ps = F.in[I_POOLS] + g * 128 + lh;
          f32x16_t acc;
#pragma unroll
          for (int r = 0; r < 16; ++r) acc[r] = 0.f;
          for (int dp0 = 0; dp0 < 128; dp0 += 32) { float av[16], bv[16], cv[16];
#pragma unroll
              for (int u = 0; u < 16; ++u) { av[u] = wo[(size_t)(dp0 + 2 * u) * 1024]; bv[u] = pw[dp0 + 2 * u]; cv[u] = ps[dp0 + 2 * u]; }
#pragma unroll
              for (int u = 0; u < 16; ++u) acc = __builtin_amdgcn_mfma_f32_32x32x2f32(av[u], bv[u] * cv[u], acc, 0, 0, 0); }
#pragma unroll
          for (int r = 0; r < 16; ++r) { const int i = (r & 3) + 8 * (r >> 2) + 4 * lh; const int k_ = 512 + g * 128 + ct * 32 + l31; WT[((size_t)(k_ >> 6) * 1024 + dt * 32 + i) * 64 + (k_ & 63)] = (bf16_t)(pk2(acc[r], 0.f) & 0xffffu); } } }
    if (PART == 2) { bf16_t* WR = (bf16_t*)(F.ws + WS_WR);
      for (int i = gt; i < 2 * 32 * 144 * 8; i += NGT) { const int j = i & 7, e16 = (i >> 3) % 144, s_ = (i / (8 * 144)) & 31, l = i / (8 * 144 * 32);
          int col; bool grp = false; int c;
          if (e16 < 128) { const int lane_ = e16 & 63, row = lane_ & 15; c = lane_ >> 4; col = 8 * (row >> 2) + (e16 < 64 ? 0 : 4) + (row & 3); }
          else { const int q = e16 - 128; c = q & 3; col = q >> 2; grp = true; }
          const int k = 32 * s_ + 8 * c + j;
          const float w = grp ? F.in[I_RGW][(size_t)l * 4096 + k * 4 + col] : F.in[I_REW][(size_t)l * 32768 + k * 32 + col];
          const unsigned hi = pk2(w, 0.f) & 0xffffu; const unsigned lo = pk2(w - bflo(hi), 0.f) & 0xffffu;
          const size_t o = (size_t)s_ * 1152 + (size_t)e16 * 8 + j;
          WR[(size_t)(l * 2 + 0) * 36864 + o] = (bf16_t)hi; WR[(size_t)(l * 2 + 1) * 36864 + o] = (bf16_t)lo; } }
    if (PART == 2) transpose_range(F, 0, F.G == 256 ? TN_DENSE : TN_ITEMS, gw, NGW);
}

__device__ __forceinline__ void norm_mod_row(const float* xrow, const float* g, const float* sh, const float* sc, int lane, f32x4 (&h)[4]) {
    f32x4 v[4]; float ss = 0.f;
#pragma unroll
    for (int j = 0; j < 4; ++j) { v[j] = *(const f32x4*)(xrow + 4 * lane + 256 * j); ss += (v[j][0] * v[j][0] + v[j][1] * v[j][1]) + (v[j][2] * v[j][2] + v[j][3] * v[j][3]); }
    const float rms = 1.0f / sqrtf(wave_sum(ss) * (1.f / 1024.f) + EPS);
#pragma unroll
    for (int j = 0; j < 4; ++j) { const int c = 4 * lane + 256 * j; const f32x4 gg = *(const f32x4*)(g + c), s1 = *(const f32x4*)(sc + c), s0 = *(const f32x4*)(sh + c);
        h[j] = (v[j] * rms * gg) * (1.f + s1) + s0; }
}
__device__ __forceinline__ void store_row_bf16(bf16_t* orow, int lane, const f32x4 (&h)[4]) {
#pragma unroll
    for (int j = 0; j < 4; ++j) { u32x2 o; o.x = pk2(h[j][0], h[j][1]); o.y = pk2(h[j][2], h[j][3]); *(u32x2*)(orow + 4 * lane + 256 * j) = o; }
}
struct RowBuf { f32x4 v[4]; };
__device__ __forceinline__ void row_load(RowBuf& b, const float* xrow, int lane) {
#pragma unroll
    for (int j = 0; j < 4; ++j) b.v[j] = *(const f32x4*)(xrow + 4 * lane + 256 * j);
}
__device__ __forceinline__ void row_norm_store_l(const RowBuf& b, const LAS float* al, const LAS float* bl, bf16_t* orow, int lane) {
    float ss = 0.f;
#pragma unroll
    for (int j = 0; j < 4; ++j) ss += (b.v[j][0] * b.v[j][0] + b.v[j][1] * b.v[j][1]) + (b.v[j][2] * b.v[j][2] + b.v[j][3] * b.v[j][3]);
    const float rms = 1.0f / sqrtf(wave_sum(ss) * (1.f / 1024.f) + EPS);
    f32x4 h[4];
#pragma unroll
    for (int j = 0; j < 4; ++j) { const int c = 4 * lane + 256 * j; h[j] = (b.v[j] * rms) * *(const LAS f32x4*)(al + c) + *(const LAS f32x4*)(bl + c); }
    store_row_bf16(orow, lane, h);
}
__device__ __forceinline__ void row_norm_store(const RowBuf& b, const float* g, const float* sh, const float* sc, bf16_t* orow, int lane) {
    float ss = 0.f;
#pragma unroll
    for (int j = 0; j < 4; ++j) ss += (b.v[j][0] * b.v[j][0] + b.v[j][1] * b.v[j][1]) + (b.v[j][2] * b.v[j][2] + b.v[j][3] * b.v[j][3]);
    const float rms = 1.0f / sqrtf(wave_sum(ss) * (1.f / 1024.f) + EPS);
    f32x4 h[4];
#pragma unroll
    for (int j = 0; j < 4; ++j) { const int c = 4 * lane + 256 * j; h[j] = (b.v[j] * rms * *(const f32x4*)(g + c)) * (1.f + *(const f32x4*)(sc + c)) + *(const f32x4*)(sh + c); }
    store_row_bf16(orow, lane, h);
}
__device__ __forceinline__ void p_norm1_l0(const Frame& F) {
    const int gw = F.vcu * NWAVES + F.wave, NGW = F.G * NWAVES;
    bf16_t* HX = F.hx();
    RowBuf A, B;
    if (gw < TT) row_load(A, F.xin_row(gw), F.lane);
    if (gw + NGW < TT) row_load(B, F.xin_row(gw + NGW), F.lane);
    p0_misc<2>(F, F.vcu, F.G); if (!misc_in_p0(F)) p0_misc<1>(F, F.vcu, F.G);
    { float* GP = (float*)(F.ws + WS_GP);
      for (int i = gw * 64 + F.lane; i < 2 * 9 * 1024; i += NGW * 64) { const int k = i & 1023, lr = i >> 10; GP[i] = F.in[I_LN2][(lr / 9) * 1024 + k] * (1.f + F.mod(lr / 9, lr % 9, 4)[k]); } }
    LAS float* tl = (LAS float*)F.lds;
    __syncthreads();
    for (int i = F.tid; i < 9 * 1024; i += NTHREADS) { const int r = i >> 10, c = i & 1023; tl[i] = F.in[I_LN1][c] * (1.f + F.mod(0, r, 1)[c]); tl[9 * 1024 + i] = F.mod(0, r, 0)[c]; }
    __syncthreads();
    for (int row = gw; row < TT; row += 2 * NGW) {
        const int row2 = row + NGW, row3 = row + 2 * NGW;
        if (row2 < TT && row != gw) row_load(B, F.xin_row(row2), F.lane);
        { const int r = modrow(row); row_norm_store_l(A, tl + r * 1024, tl + (9 + r) * 1024, HX + (size_t)row * DM, F.lane); }
        if (row3 < TT) row_load(A, F.xin_row(row3), F.lane);
        if (row2 < TT) { const int r = modrow(row2); row_norm_store_l(B, tl + r * 1024, tl + (9 + r) * 1024, HX + (size_t)row2 * DM, F.lane); }
    }
}

struct Unit { int pm, pn, e; };
struct SchedDense {
    const bf16_t* Bt; int K, nMa, nN, nMb, pnb, vcu, G;
    __device__ __forceinline__ bool next(int i, Unit& u) const { int L = i * G + vcu; const int na = nMa * nN; u.e = 0;
        if (L < na) { u.pm = L / nN; u.pn = L % nN; return true; } L -= na; if (L < nMb) { u.pm = nMa + L; u.pn = pnb; return true; } return false; }
    __device__ __forceinline__ int arow(const Unit& u, int r) const { return u.pm * 256 + r; }
    __device__ __forceinline__ const bf16_t* bbase(const Unit& u) const { return Bt + (size_t)u.pn * 256 * 64; }
    __device__ __forceinline__ int brows() const { return nN * 256; }
};
struct SchedDenseH {
    const bf16_t* Bt; int row0, nM, nN, vcu, G;
    __device__ __forceinline__ bool next(int i, Unit& u) const { const int L = i * G + vcu; u.e = 0; if (L >= nM * nN) return false; u.pm = L / nN; u.pn = L % nN; return true; }
    __device__ __forceinline__ int arow(const Unit& u, int r) const { return row0 + u.pm * 128 + r; }
    __device__ __forceinline__ const bf16_t* bbase(const Unit& u) const { return Bt + (size_t)u.pn * 256 * 64; }
    __device__ __forceinline__ int brows() const { return nN * 256; }
};
struct MoeTab { const LAS int* tile_e; const LAS int* tile0; const LAS int* cnt; int ntiles; };
struct SchedMoe {
    const bf16_t* Wt; size_t estride; int tsh; MoeTab tb; const unsigned* list; bool gather; int vcu, G;
    __device__ __forceinline__ bool next(int i, Unit& u) const { const int L = i * G + vcu; if (L >= tb.ntiles * 4) return false; u.pm = L >> 2; u.pn = L & 3; u.e = tb.tile_e[u.pm]; return true; }
    __device__ __forceinline__ int arow(const Unit& u, int r) const {
        if (!gather) return (u.pm << tsh) + r;
        int idx = ((u.pm - tb.tile0[u.e]) << tsh) + r; const int c = tb.cnt[u.e]; idx = idx < c ? idx : c - 1;
        return (int)list[(size_t)u.e * TT + idx]; }
    __device__ __forceinline__ const bf16_t* bbase(const Unit& u) const { return Wt + (size_t)u.e * estride + (size_t)u.pn * 256 * 64; }
    __device__ __forceinline__ int brows() const { return 1024; }
};
__device__ __forceinline__ MoeTab moe_tables(const Frame& F, int l, int tsh) {
    LAS int* tile_e = (LAS int*)(F.lds + LDS_TAB); LAS int* tile0 = tile_e + NTILE_MAX; LAS int* cntl = tile0 + 33; LAS int* nt = cntl + 32;
    __syncthreads();
    if (F.tid < 64) {
        const int e = F.lane & 31; unsigned* cg = F.cnt(l);
        const int c = (int)__hip_atomic_load(cg + e * 64, __ATOMIC_RELAXED, __HIP_MEMORY_SCOPE_AGENT); const int n = (c + (1 << tsh) - 1) >> tsh;
        int incl = n;
#pragma unroll
        for (int o = 1; o < 32; o <<= 1) { const int v = __shfl_up(incl, o, 32); if (e >= o) incl += v; }
        const int t0 = incl - n;
        if (F.lane < 32) { tile0[e] = t0; cntl[e] = c; for (int j = 0; j < n; ++j) tile_e[t0 + j] = e; if (e == 31) { tile0[32] = incl; nt[0] = incl; } }
    }
    __syncthreads();
    MoeTab tb; tb.tile_e = tile_e; tb.tile0 = tile0; tb.cnt = cntl; tb.ntiles = nt[0]; return tb;
}

__device__ __forceinline__ MoeTab moe_tables_again(const Frame& F, int l, int tsh) {
#if ONE_LAUNCH
    LAS int* tile_e = (LAS int*)(F.lds + LDS_TAB); LAS int* tile0 = tile_e + NTILE_MAX; LAS int* cntl = tile0 + 33; LAS int* nt = cntl + 32;
    MoeTab tb; tb.tile_e = tile_e; tb.tile0 = tile0; tb.cnt = cntl; tb.ntiles = nt[0]; return tb;
#else
    return moe_tables(F, l, tsh);
#endif
}
namespace pg8 {
constexpr int BM = 256, BK = 64, HALF = 128, HTB = HALF * BK * 2;
__device__ __forceinline__ int lds_byte(int r, int c) { const int st = (r >> 4) * 2 + (c >> 5), rr = r & 15, cc = c & 31, ob = rr * 64 + cc * 2; return st * 1024 + (ob ^ (((ob >> 9) & 1) << 5)); }
__device__ __forceinline__ void stage_rc(int b, int& R, int& C) { const int st = b / 1024, sb = b % 1024, swz = sb ^ (((sb >> 9) & 1) << 5); R = (st >> 1) * 16 + swz / 64; C = (st & 1) * 32 + (swz % 64) / 2; }
__device__ __forceinline__ int perm32(int rho) { const int n = rho >> 4, i = rho & 15; return 8 * (i >> 2) + 4 * n + (i & 3); }
}
typedef int v8i_t __attribute__((ext_vector_type(8)));
typedef int v4i_t __attribute__((ext_vector_type(4)));
__device__ __forceinline__ v8i_t frag32(bf16x8 lo, bf16x8 hi) { return __builtin_shufflevector(__builtin_bit_cast(v4i_t, lo), __builtin_bit_cast(v4i_t, hi), 0, 1, 2, 3, 4, 5, 6, 7); }
template <bool ALIGN_EPI, bool FP8, bool HALFM, class Sched, class Epi>
__device__ __forceinline__ void gemm_fast(const Frame& F, const void* A, int KB, const Sched& S, const Epi& E) {
    using namespace pg8;
    LAS unsigned char* lds = F.lds;
    const int tid = F.tid, wid = F.wave, lane = F.lane, wr = wid >> 2, wc = wid & 3, fr = lane & 15, fq = lane >> 4;
    const int nt = KB / (BK * 2);
    unsigned voffB[2];
#pragma unroll
    for (int i = 0; i < 2; ++i) { int R, C; stage_rc(tid * 16 + i * 8192, R, C); const int Rb = (R & ~31) + perm32(R & 31); voffB[i] = (unsigned)(Rb * 64 + C) * 2u; }
    const size_t kstep = (size_t)(BK * 2);
    const size_t kstepB = (size_t)S.brows() * BK * 2;
    const size_t hstep = (size_t)HALF * BK * 2;
    const unsigned ldsw = (unsigned)wid * 1024u;
    const int aoff = lds_byte(wr * 64 + fr, fq * (FP8 ? 16 : 8)), boff = lds_byte(wc * 32 + fr, fq * (FP8 ? 16 : 8));
    const char* Ab = (const char*)A;
#define PG8_SA(b, h) (((b) * 2 + (h)) * HTB)
#define PG8_SB(b, h) ((4 + (b) * 2 + (h)) * HTB)
#define PG8_STAGE(bufoff, gbase, voff) do { _Pragma("unroll") for (int _i = 0; _i < 2; ++_i) \
        __builtin_amdgcn_global_load_lds((const unsigned*)((const char*)(gbase) + (voff)[_i]), (LAS unsigned*)(lds + (bufoff) + ldsw + _i * 8192), 16, 0, 0); } while (0)
#define PG8_LD32(p) __builtin_shufflevector(*(const LAS v4i_t*)(p), *(const LAS v4i_t*)((p) + 16), 0, 1, 2, 3, 4, 5, 6, 7)
#define PG8_LDA(dst, b, h) do { if constexpr (FP8) { _Pragma("unroll") for (int m = 0; m < 4; ++m) dst##8[m] = PG8_LD32(lds + PG8_SA(b, h) + aoff + m * 2048); } \
        else { _Pragma("unroll") for (int m = 0; m < 4; ++m) _Pragma("unroll") for (int k = 0; k < 2; ++k) dst[m][k] = *(const LAS bf16x8*)(lds + PG8_SA(b, h) + aoff + m * 2048 + k * 1024); } } while (0)
#define PG8_LDB(dst, b, h) do { if constexpr (FP8) { _Pragma("unroll") for (int n = 0; n < 2; ++n) dst##8[n] = PG8_LD32(lds + PG8_SB(b, h) + boff + n * 2048); } \
        else { _Pragma("unroll") for (int n = 0; n < 2; ++n) _Pragma("unroll") for (int k = 0; k < 2; ++k) dst[n][k] = *(const LAS bf16x8*)(lds + PG8_SB(b, h) + boff + n * 2048 + k * 1024); } } while (0)
#define PG8_MMA(ai, bj, At, Bt) do { __builtin_amdgcn_s_setprio(1); _Pragma("unroll") for (int m = 0; m < 4; ++m) _Pragma("unroll") for (int n = 0; n < 2; ++n) { \
        if constexpr (FP8) acc[ai][bj][m][n] = __builtin_amdgcn_mfma_scale_f32_16x16x128_f8f6f4(Bt##8[n], At##8[m], acc[ai][bj][m][n], 0, 0, 0, 0x7F7F7F7F, 0, 0x7F7F7F7F); \
        else { _Pragma("unroll") for (int k = 0; k < 2; ++k) acc[ai][bj][m][n] = __builtin_amdgcn_mfma_f32_16x16x32_bf16(Bt[n][k], At[m][k], acc[ai][bj][m][n], 0, 0, 0); } } __builtin_amdgcn_s_setprio(0); } while (0)
#define PG8_WAIT_V(n) asm volatile("s_waitcnt vmcnt(" #n ")" ::: "memory")
#define PG8_WAIT_L(n) asm volatile("s_waitcnt lgkmcnt(" #n ")" ::: "memory")
#define PG8_BAR __builtin_amdgcn_s_barrier()
#define PG8_SCHED __builtin_amdgcn_sched_barrier(0)
    LAS unsigned* rtab = (LAS unsigned*)(lds + RING_BYTES);
    unsigned tA[2], cA[2];
#pragma unroll
    for (int i = 0; i < 2; ++i) { int R, C; stage_rc(tid * 16 + i * 8192, R, C); tA[i] = (unsigned)R; cA[i] = (unsigned)(C * 2); }
#define PG8_RFILL(sel, u) do { if (tid < (HALFM ? 128 : 256)) rtab[(sel) * 256 + tid] = (unsigned)S.arow(u, tid) * (unsigned)KB; } while (0)
#define PG8_STAGEA(bufoff, gbase, sel, h) do { _Pragma("unroll") for (int _i = 0; _i < 2; ++_i) { const unsigned vo_ = rtab[(sel) * 256 + (h) * 128 + tA[_i]] + cA[_i]; \
        __builtin_amdgcn_global_load_lds((const unsigned*)((const char*)(gbase) + vo_), (LAS unsigned*)(lds + (bufoff) + ldsw + _i * 8192), 16, 0, 0); } } while (0)
    Unit cur, nxt; int ui = 0;
    if (!S.next(0, cur)) return;
    f32x4 acc[2][2][4][2];
    float zero_ = 0.f; asm volatile("" : "+v"(zero_));
#pragma unroll
    for (int a = 0; a < 2; ++a)
#pragma unroll
        for (int b = 0; b < 2; ++b)
#pragma unroll
            for (int m = 0; m < 4; ++m)
#pragma unroll
                for (int n = 0; n < 2; ++n) acc[a][b][m][n] = (f32x4){zero_, zero_, zero_, zero_};
    bf16x8 At[4][2], B0[2][2], B1[2][2]; v8i_t At8[4], B08[2], B18[2];
    int csel = 0;
    PG8_RFILL(0, cur);
    PG8_WAIT_L(0); PG8_BAR;
    const char* cB = (const char*)S.bbase(cur);
    PG8_STAGE(PG8_SB(0, 0), cB, voffB); PG8_STAGE(PG8_SB(0, 1), cB + hstep, voffB); PG8_STAGEA(PG8_SA(0, 0), Ab, 0, 0); if constexpr (!HALFM) PG8_STAGEA(PG8_SA(0, 1), Ab, 0, 1);
    if (wr == 1) PG8_BAR;
    if constexpr (HALFM) PG8_WAIT_V(0); else PG8_WAIT_V(2);
    PG8_BAR;
    PG8_STAGE(PG8_SB(1, 0), cB + kstepB, voffB); PG8_STAGEA(PG8_SA(1, 0), Ab + kstep, 0, 0); PG8_STAGE(PG8_SB(1, 1), cB + hstep + kstepB, voffB);
    PG8_WAIT_V(6); PG8_BAR;
    for (;;) {
        const bool has_next = S.next(ui + 1, nxt);
        const char* nB = cB;
        if (has_next) { PG8_RFILL(csel ^ 1, nxt); nB = (const char*)S.bbase(nxt); }
        const int nsel = has_next ? (csel ^ 1) : csel;
#pragma unroll 1
        for (int t = 0; t < nt; t += 2) {
            const bool last = (t == nt - 2);
            const char* a1 = Ab + (size_t)(t + 1) * kstep;
            const char* a2 = last ? Ab : Ab + (size_t)(t + 2) * kstep; const char* b2 = last ? nB : cB + (size_t)(t + 2) * kstepB;
            const char* a3 = a2 + kstep; const char* b3 = b2 + kstepB;
            const int sel2 = last ? nsel : csel;
            PG8_LDB(B0, 0, 0); PG8_LDB(B1, 0, 1); PG8_SCHED; PG8_LDA(At, 0, 0); if constexpr (!HALFM) PG8_STAGEA(PG8_SA(1, 1), a1, csel, 1);
            PG8_WAIT_V(8); PG8_WAIT_L(0); PG8_BAR; PG8_MMA(0, 0, At, B0); PG8_MMA(0, 1, At, B1); PG8_BAR; PG8_SCHED;
            if constexpr (!HALFM) PG8_LDA(At, 0, 1);
            PG8_STAGE(PG8_SB(0, 0), b2, voffB); PG8_STAGE(PG8_SB(0, 1), b2 + hstep, voffB); PG8_STAGEA(PG8_SA(0, 0), a2, sel2, 0);
            if constexpr (HALFM) PG8_WAIT_V(6); else PG8_WAIT_V(8);
            PG8_WAIT_L(0); PG8_BAR; if constexpr (!HALFM) { PG8_MMA(1, 0, At, B0); PG8_MMA(1, 1, At, B1); } PG8_BAR; PG8_SCHED;
            PG8_LDB(B0, 1, 0); PG8_LDB(B1, 1, 1); PG8_SCHED; PG8_LDA(At, 1, 0); if constexpr (!HALFM) PG8_STAGEA(PG8_SA(0, 1), a2, sel2, 1);
            PG8_WAIT_V(8); PG8_WAIT_L(0); PG8_BAR; PG8_MMA(0, 0, At, B0); PG8_MMA(0, 1, At, B1); PG8_BAR; PG8_SCHED;
            if constexpr (!HALFM) PG8_LDA(At, 1, 1);
            PG8_STAGE(PG8_SB(1, 0), b3, voffB); PG8_STAGE(PG8_SB(1, 1), b3 + hstep, voffB); PG8_STAGEA(PG8_SA(1, 0), a3, sel2, 0);
            if constexpr (HALFM) PG8_WAIT_V(6); else PG8_WAIT_V(8);
            PG8_WAIT_L(0); PG8_BAR; if constexpr (!HALFM) { PG8_MMA(1, 0, At, B0); PG8_MMA(1, 1, At, B1); } PG8_BAR; PG8_SCHED;
        }
        if (ALIGN_EPI) { if (wr == 0) PG8_BAR; }
        E(acc, cur, wr, wc, fr, fq);
        if (!has_next) break;
        asm volatile("" : "+v"(zero_));
#pragma unroll
        for (int a = 0; a < 2; ++a)
#pragma unroll
            for (int b = 0; b < 2; ++b)
#pragma unroll
                for (int m = 0; m < 4; ++m)
#pragma unroll
                    for (int n = 0; n < 2; ++n) acc[a][b][m][n] = (f32x4){zero_, zero_, zero_, zero_};
        cur = nxt; cB = nB; ++ui; csel = nsel;
        if (ALIGN_EPI) { if (wr == 1) PG8_BAR; }
    }
    PG8_WAIT_V(0);
    if (!ALIGN_EPI) { if (wr == 0) PG8_BAR; }
    PG8_BAR;
#undef PG8_RFILL
#undef PG8_STAGEA
#undef PG8_SA
#undef PG8_SB
#undef PG8_STAGE
#undef PG8_LD32
#undef PG8_LDA
#undef PG8_LDB
#undef PG8_MMA
#undef PG8_WAIT_V
#undef PG8_WAIT_L
#undef PG8_BAR
#undef PG8_SCHED
}
template <class Sched, class Epi>
__device__ __forceinline__ void gemm_fp8_h3(const Frame& F, const void* A, int KB, const Sched& S, const Epi& E) {
    using namespace pg8;
    LAS unsigned char* lds = F.lds;
    const int tid = F.tid, wid = F.wave, lane = F.lane, wr = wid >> 2, wc = wid & 3, fr = lane & 15, fq = lane >> 4;
#ifdef PROBE_KREP
    const int ntk = KB / 128, nt = 2 * ntk;
#else
    const int ntk = KB / 128, nt = ntk;
#endif
    constexpr int BUF = 49152, RTAB_OFF = LDS_TAB + 2048 + 8192 + 256;
    unsigned voffB[2], tA[2], cA[2];
#pragma unroll
    for (int i = 0; i < 2; ++i) { int R, C; stage_rc(tid * 16 + i * 8192, R, C); const int Rb = (R & ~31) + perm32(R & 31); voffB[i] = (unsigned)(Rb * 64 + C) * 2u; tA[i] = (unsigned)R; cA[i] = (unsigned)(C * 2); }
    const size_t kstepB = (size_t)S.brows() * 128, hstep = (size_t)128 * 128;
    const unsigned ldsw = (unsigned)wid * 1024u;
    const int aoff = lds_byte(wr * 64 + fr, fq * 16), boff = lds_byte(wc * 32 + fr, fq * 16);
    const char* Ab = (const char*)A;
    LAS unsigned* rtab = (LAS unsigned*)(lds + RTAB_OFF);
#define H3_RFILL(sel, u) do { if (tid < 128) rtab[(sel) * 128 + tid] = (unsigned)S.arow(u, tid) * (unsigned)KB; } while (0)
#define H3_STAGE(bo, gbase, voff) do { _Pragma("unroll") for (int _i = 0; _i < 2; ++_i) \
        __builtin_amdgcn_global_load_lds((const unsigned*)((const char*)(gbase) + (voff)[_i]), (LAS unsigned*)(lds + (bo) + ldsw + _i * 8192), 16, 0, 0); } while (0)
#define H3_STAGEA(bo, gbase, sel) do { _Pragma("unroll") for (int _i = 0; _i < 2; ++_i) { const unsigned vo_ = rtab[(sel) * 128 + tA[_i]] + cA[_i]; \
        __builtin_amdgcn_global_load_lds((const unsigned*)((const char*)(gbase) + vo_), (LAS unsigned*)(lds + (bo) + 32768 + ldsw + _i * 8192), 16, 0, 0); } } while (0)
#define H3_LD32(p) __builtin_shufflevector(*(const LAS v4i_t*)(p), *(const LAS v4i_t*)((p) + 16), 0, 1, 2, 3, 4, 5, 6, 7)
#define H3_TILE(bo, bptr, aptr, sel) do { H3_STAGE((bo), (bptr), voffB); H3_STAGE((bo) + 16384, (bptr) + hstep, voffB); H3_STAGEA((bo), (aptr), (sel)); } while (0)
#define H3_BAR __builtin_amdgcn_s_barrier()
    Unit cur, nxt; int ui = 0;
    if (!S.next(0, cur)) return;
    f32x4 acc[2][4][2];
    float zero_ = 0.f; asm volatile("" : "+v"(zero_));
#pragma unroll
    for (int b = 0; b < 2; ++b)
#pragma unroll
        for (int m = 0; m < 4; ++m)
#pragma unroll
            for (int n = 0; n < 2; ++n) acc[b][m][n] = (f32x4){zero_, zero_, zero_, zero_};
    v8i_t At8[4], B08[2], B18[2];
    int csel = 0;
    H3_RFILL(0, cur);
    asm volatile("s_waitcnt lgkmcnt(0)" ::: "memory"); H3_BAR;
    const char* cB = (const char*)S.bbase(cur);
    int o0 = 0, o1 = BUF, o2 = 2 * BUF;
    H3_TILE(o0, cB, Ab, 0); H3_TILE(o1, cB + kstepB, Ab + 128, 0);
    asm volatile("s_waitcnt vmcnt(6)" ::: "memory"); H3_BAR;
    if (wr == 1) H3_BAR;
    for (;;) {
        const bool has_next = S.next(ui + 1, nxt);
        const char* nB = cB;
        unsigned nrow = 0u;
        if (has_next) { if (tid < 128) nrow = (unsigned)S.arow(nxt, tid) * (unsigned)KB; nB = (const char*)S.bbase(nxt); }
        const int nsel = has_next ? (csel ^ 1) : csel;
#pragma unroll 1
        for (int t = 0; t < nt; ++t) {
            const int t2 = t + 2; const bool nx = t2 >= nt; const int k2 = (nx ? t2 - nt : t2) % ntk;
#ifdef PROBE_KREP
            if (t == ntk) {
#pragma unroll
                for (int b_ = 0; b_ < 2; ++b_)
#pragma unroll
                    for (int m_ = 0; m_ < 4; ++m_)
#pragma unroll
                        for (int n_ = 0; n_ < 2; ++n_) acc[b_][m_][n_] = (f32x4){zero_, zero_, zero_, zero_}; }
#endif
            const char* b2 = (nx ? nB : cB) + (size_t)k2 * kstepB; const char* a2 = Ab + (size_t)k2 * 128; const int sel2 = nx ? nsel : csel;
#pragma unroll
            for (int n = 0; n < 2; ++n) { B08[n] = H3_LD32(lds + o0 + boff + n * 2048); B18[n] = H3_LD32(lds + o0 + 16384 + boff + n * 2048); }
            __builtin_amdgcn_sched_barrier(0);
#pragma unroll
            for (int m = 0; m < 4; ++m) At8[m] = H3_LD32(lds + o0 + 32768 + aoff + m * 2048);
            if (t == 1 && has_next && tid < 128) rtab[nsel * 128 + tid] = nrow;
            if (ui > 0 && t == 0) { if constexpr (Epi::NST == 4) asm volatile("s_waitcnt vmcnt(10)" ::: "memory"); else asm volatile("s_waitcnt vmcnt(14)" ::: "memory"); }
            else { H3_TILE(o2, b2, a2, sel2);
                if (ui > 0 && t == 1) { if constexpr (Epi::NST == 4) asm volatile("s_waitcnt vmcnt(10)" ::: "memory"); else asm volatile("s_waitcnt vmcnt(14)" ::: "memory"); }
                else asm volatile("s_waitcnt vmcnt(6)" ::: "memory"); }
            asm volatile("s_waitcnt lgkmcnt(0)" ::: "memory"); H3_BAR;
            __builtin_amdgcn_s_setprio(1);
#pragma unroll
            for (int m = 0; m < 4; ++m)
#pragma unroll
                for (int n = 0; n < 2; ++n) acc[0][m][n] = __builtin_amdgcn_mfma_scale_f32_16x16x128_f8f6f4(B08[n], At8[m], acc[0][m][n], 0, 0, 0, 0x7F7F7F7F, 0, 0x7F7F7F7F);
#pragma unroll
            for (int m = 0; m < 4; ++m)
#pragma unroll
                for (int n = 0; n < 2; ++n) acc[1][m][n] = __builtin_amdgcn_mfma_scale_f32_16x16x128_f8f6f4(B18[n], At8[m], acc[1][m][n], 0, 0, 0, 0x7F7F7F7F, 0, 0x7F7F7F7F);
            __builtin_amdgcn_s_setprio(0);
            H3_BAR; __builtin_amdgcn_sched_barrier(0);
            { const int tmp = o0; o0 = o1; o1 = o2; o2 = tmp; }
        }
        if (H3_ALIGN) { if (wr == 0) H3_BAR; }
        if (has_next) H3_TILE(o2, nB + 2 * kstepB, Ab + 2 * 128, nsel);
        E.half(acc, cur, wr, wc, fr, fq);
#ifdef PROBE_EREP
        asm volatile("" ::: "memory"); E.half(acc, cur, wr, wc, fr, fq);
#endif
        if (!has_next) break;
        asm volatile("" : "+v"(zero_));
#pragma unroll
        for (int b = 0; b < 2; ++b)
#pragma unroll
            for (int m = 0; m < 4; ++m)
#pragma unroll
                for (int n = 0; n < 2; ++n) acc[b][m][n] = (f32x4){zero_, zero_, zero_, zero_};
        cur = nxt; cB = nB; ++ui; csel = nsel;
        if (H3_ALIGN) { if (wr == 1) H3_BAR; }
    }
    asm volatile("s_waitcnt vmcnt(0)" ::: "memory");
    if (!H3_ALIGN) { if (wr == 0) H3_BAR; }
    H3_BAR;
#undef H3_RFILL
#undef H3_STAGE
#undef H3_STAGEA
#undef H3_LD32
#undef H3_TILE
#undef H3_BAR
}
#ifndef ALIGN_G2
#define ALIGN_G2 false
#endif
#define GEMM gemm_fast<true, false, false>
#define GEMM2 gemm_fast<ALIGN_G2, false, false>

__device__ __forceinline__ u32x4 pack8(const f32x4& a, const f32x4& b) { u32x4 w; w.x = pk2(a[0], a[1]); w.y = pk2(a[2], a[3]); w.z = pk2(b[0], b[1]); w.w = pk2(b[2], b[3]); return w; }
template <bool GLU> struct EpiInProj {
    bf16_t* Q; bf16_t* KR; bf16_t* Vn; bf16_t* Gb;
    __device__ __forceinline__ void operator()(const f32x4 (&acc)[2][2][4][2], const Unit& u, int wr, int wc, int fr, int fq) const {
#pragma unroll
        for (int ai = 0; ai < 2; ++ai)
#pragma unroll
            for (int m = 0; m < 4; ++m) { const int irow = u.pm * 256 + 128 * ai + 64 * wr + 16 * m + fr; const size_t row = (size_t)irow; const int cl = 32 * wc + 8 * fq;
                if (u.pn < 2) { *(u32x4*)(Q + row * 512 + u.pn * 256 + cl) = pack8(acc[ai][0][m][0], acc[ai][0][m][1]); *(u32x4*)(Q + row * 512 + u.pn * 256 + 128 + cl) = pack8(acc[ai][1][m][0], acc[ai][1][m][1]); }
                else if (u.pn == 2) { const size_t kvrow = irow < TX ? (size_t)(irow >> 12) * KVS + CTXL + (irow & 4095) : (size_t)((irow - TX) >> 8) * KVS + ((irow - TX) & 255);
                    *(u32x4*)(KR + kvrow * 128 + cl) = pack8(acc[ai][0][m][0], acc[ai][0][m][1]); *(u32x4*)(Vn + kvrow * 128 + cl) = pack8(acc[ai][1][m][0], acc[ai][1][m][1]); }
                else if (GLU) { f32x4 g0, g1;
#pragma unroll
                    for (int j = 0; j < 4; ++j) { g0[j] = acc[ai][0][m][0][j] * sigmoidf_(acc[ai][1][m][0][j]); g1[j] = acc[ai][0][m][1][j] * sigmoidf_(acc[ai][1][m][1][j]); }
                    *(u32x4*)(Gb + row * 512 + (u.pn - 3) * 128 + cl) = pack8(g0, g1); }
                else { *(u32x4*)(Gb + row * 512 + (u.pn - 3) * 256 + cl) = pack8(acc[ai][0][m][0], acc[ai][0][m][1]); *(u32x4*)(Gb + row * 512 + (u.pn - 3) * 256 + 128 + cl) = pack8(acc[ai][1][m][0], acc[ai][1][m][1]); }
            }
    }
};
template <bool L0, bool DRY = false, bool HALFM = false> struct EpiOutProj {
    Frame F; int l; int row0 = 0;
    __device__ __forceinline__ void operator()(const f32x4 (&acc)[2][2][4][2], const Unit& u, int wr, int wc, int fr, int fq) const {
        float* SS = (float*)(F.ws + WS_SS);
        const int rb = row0 + u.pm * (HALFM ? 128 : 256);
        const float* g1 = F.mod(l, modrow(rb), 2) + u.pn * 256 + 32 * wc + 8 * fq;
        f32x4 gv[2][2];
#pragma unroll
        for (int bj = 0; bj < 2; ++bj)
#pragma unroll
            for (int n = 0; n < 2; ++n) gv[bj][n] = *(const f32x4*)(g1 + 128 * bj + 4 * n);
#pragma unroll
        for (int ai = 0; ai < (HALFM ? 1 : 2); ++ai) {
            f32x4 xv[4][2][2];
#pragma unroll
            for (int m = 0; m < 4; ++m) { const int row = rb + 128 * ai + 64 * wr + 16 * m + fr; const int c0 = u.pn * 256 + 32 * wc + 8 * fq;
#pragma unroll
                for (int bj = 0; bj < 2; ++bj) {
                    if (L0) { const float* src = F.xin_row(row) + c0 + 128 * bj; xv[m][bj][0] = *(const f32x4*)(src); xv[m][bj][1] = *(const f32x4*)(src + 4); }
                    else { const u32x4 w = *(const u32x4*)(F.xr_row(row) + c0 + 128 * bj); xv[m][bj][0] = (f32x4){bflo(w.x), bfhi(w.x), bflo(w.y), bfhi(w.y)}; xv[m][bj][1] = (f32x4){bflo(w.z), bfhi(w.z), bflo(w.w), bfhi(w.w)}; } } }
#pragma unroll
            for (int m = 0; m < 4; ++m) { const int row = rb + 128 * ai + 64 * wr + 16 * m + fr; bf16_t* dst = F.xr_row(row) + u.pn * 256 + 32 * wc + 8 * fq; float q = 0.f;
#pragma unroll
                for (int bj = 0; bj < 2; ++bj) { const f32x4 v0 = xv[m][bj][0] + gv[bj][0] * acc[ai][bj][m][0], v1 = xv[m][bj][1] + gv[bj][1] * acc[ai][bj][m][1];
                    *(u32x4*)(dst + 128 * bj) = DRY ? pack8(xv[m][bj][0], xv[m][bj][1]) : pack8(v0, v1);
                    q += ((v0[0] * v0[0] + v0[1] * v0[1]) + (v0[2] * v0[2] + v0[3] * v0[3])) + ((v1[0] * v1[0] + v1[1] * v1[1]) + (v1[2] * v1[2] + v1[3] * v1[3])); }
                q += __shfl_xor(q, 16); q += __shfl_xor(q, 32);
                if (fq == 0) SS[(size_t)row * 16 + u.pn * 4 + wc] = q; }
        }
    }
};
template <bool IN8, bool OUT8, bool HALFM> struct EpiMoe1 {   static constexpr int NST = 4;
    void* HID;
    __device__ __forceinline__ void operator()(const f32x4 (&acc)[2][2][4][2], const Unit& u, int wr, int wc, int fr, int fq) const {
        const float sc = IN8 ? W8_INV : 1.f;
#pragma unroll
        for (int ai = 0; ai < (HALFM ? 1 : 2); ++ai)
#pragma unroll
            for (int m = 0; m < 4; ++m) { const size_t slot = (size_t)u.pm * (HALFM ? 128 : 256) + 128 * ai + 64 * wr + 16 * m + fr; f32x4 h0, h1;
#pragma unroll
                for (int j = 0; j < 4; ++j) { const float a = acc[ai][0][m][0][j] * sc, b = acc[ai][0][m][1][j] * sc; h0[j] = a * sigmoidf_(a) * (acc[ai][1][m][0][j] * sc); h1[j] = b * sigmoidf_(b) * (acc[ai][1][m][1][j] * sc); }
                if (OUT8) { u32x2 o; o.x = pk4_fp8(h0[0], h0[1], h0[2], h0[3]); o.y = pk4_fp8(h1[0], h1[1], h1[2], h1[3]); *(u32x2*)((unsigned char*)HID + slot * 512 + u.pn * 128 + 32 * wc + 8 * fq) = o; }
                else *(u32x4*)((bf16_t*)HID + slot * 512 + u.pn * 128 + 32 * wc + 8 * fq) = pack8(h0, h1); }
    }
    __device__ __forceinline__ void half(const f32x4 (&acc)[2][4][2], const Unit& u, int wr, int wc, int fr, int fq) const {
        const float sc = IN8 ? W8_INV : 1.f;
#pragma unroll
        for (int m = 0; m < 4; ++m) { const size_t slot = (size_t)u.pm * 128 + 64 * wr + 16 * m + fr; f32x4 h0, h1;
#pragma unroll
            for (int j = 0; j < 4; ++j) { const float a = acc[0][m][0][j] * sc, b = acc[0][m][1][j] * sc; h0[j] = a * sigmoidf_(a) * (acc[1][m][0][j] * sc); h1[j] = b * sigmoidf_(b) * (acc[1][m][1][j] * sc); }
            u32x2 o; o.x = pk4_fp8(h0[0], h0[1], h0[2], h0[3]); o.y = pk4_fp8(h1[0], h1[1], h1[2], h1[3]); *(u32x2*)((unsigned char*)HID + slot * 512 + u.pn * 128 + 32 * wc + 8 * fq) = o; }
    }
};
template <bool FP8, bool HALFM> struct EpiMoe2 {
    static constexpr int NST = 8;
    bf16_t* YB;
    __device__ __forceinline__ void operator()(const f32x4 (&acc)[2][2][4][2], const Unit& u, int wr, int wc, int fr, int fq) const {
        const float sc = FP8 ? W8_INV : 1.f;
#pragma unroll
        for (int ai = 0; ai < (HALFM ? 1 : 2); ++ai)
#pragma unroll
            for (int m = 0; m < 4; ++m) { const size_t slot = (size_t)u.pm * (HALFM ? 128 : 256) + 128 * ai + 64 * wr + 16 * m + fr;
#pragma unroll
                for (int bj = 0; bj < 2; ++bj) *(u32x4*)(YB + slot * 1024 + u.pn * 256 + 128 * bj + 32 * wc + 8 * fq) = pack8(acc[ai][bj][m][0] * sc, acc[ai][bj][m][1] * sc); }
    }
    __device__ __forceinline__ void half(const f32x4 (&acc)[2][4][2], const Unit& u, int wr, int wc, int fr, int fq) const {
        const float sc = FP8 ? W8_INV : 1.f;
#pragma unroll
        for (int m = 0; m < 4; ++m) { const size_t slot = (size_t)u.pm * 128 + 64 * wr + 16 * m + fr;
#pragma unroll
            for (int bj = 0; bj < 2; ++bj) { const f32x4 v0 = acc[bj][m][0] * sc, v1 = acc[bj][m][1] * sc; u32x2 o; o.x = pk4_fp8(v0[0], v0[1], v0[2], v0[3]); o.y = pk4_fp8(v1[0], v1[1], v1[2], v1[3]);
                *(u32x2*)((unsigned char*)YB + slot * 1024 + u.pn * 256 + 128 * bj + 32 * wc + 8 * fq) = o; } }
    }
};

__device__ __forceinline__ void p_k_post(const Frame& F, const float* kg) {
    const int gw = F.vcu * NWAVES + F.wave, NGW = F.G * NWAVES, lane = F.lane;
    const bf16_t* KR = (const bf16_t*)(F.ws + WS_KV); bf16_t* Kn = (bf16_t*)(F.ws + WS_KN);
    const float* rc = (const float*)(F.ws + WS_ROPE); const float* rs = rc + SEQ * 32;
    const int c16 = lane & 15, i8 = c16 & 7, dd0 = 8 * (i8 & 3), sub = lane >> 4;
    float gk[8];
#pragma unroll
    for (int j = 0; j < 8; ++j) gk[j] = kg[i8 * 8 + j];
    const float sgn = (i8 < 4) ? -1.f : 1.f;
    for (int rd = 0; rd * NGW < NB * KVS / 16; ++rd) {
        const int it = rd * NGW + ((rd & 1) ? NGW - 1 - gw : gw); if (it >= NB * KVS / 16) continue;
        u32x4 w[4];
#pragma unroll
        for (int q = 0; q < 4; ++q) w[q] = *(const u32x4*)(KR + (size_t)(it * 16 + 4 * q + sub) * 128 + c16 * 8);
#pragma unroll
        for (int q = 0; q < 4; ++q) { const int kvrow = it * 16 + 4 * q + sub, pos = kvrow % KVS;
            float cs[8], sn[8];
#pragma unroll
            for (int j = 0; j < 8; ++j) { cs[j] = 1.f; sn[j] = 0.f; }
            if (pos >= CTXL) { const int sq = pos - CTXL; const f32x4 c0 = *(const f32x4*)(rc + sq * 32 + dd0), c1 = *(const f32x4*)(rc + sq * 32 + dd0 + 4), s0 = *(const f32x4*)(rs + sq * 32 + dd0), s1 = *(const f32x4*)(rs + sq * 32 + dd0 + 4);
#pragma unroll
                for (int j = 0; j < 4; ++j) { cs[j] = c0[j]; cs[4 + j] = c1[j]; sn[j] = s0[j]; sn[4 + j] = s1[j]; } }
            float x[8] = {bflo(w[q].x), bfhi(w[q].x), bflo(w[q].y), bfhi(w[q].y), bflo(w[q].z), bfhi(w[q].z), bflo(w[q].w), bfhi(w[q].w)};
            float ss = 0.f;
#pragma unroll
            for (int j = 0; j < 8; ++j) ss += x[j] * x[j];
            ss += __shfl_xor(ss, 1); ss += __shfl_xor(ss, 2); ss += __shfl_xor(ss, 4);
            const float rms = 1.0f / sqrtf(ss * (1.f / 64.f) + EPS);
            float y[8], o[8];
#pragma unroll
            for (int j = 0; j < 8; ++j) y[j] = x[j] * rms * gk[j];
#pragma unroll
            for (int j = 0; j < 8; ++j) { const float yp = __shfl_xor(y[j], 4); o[j] = y[j] * cs[j] + sgn * yp * sn[j]; }
            u32x4 ow; ow.x = pk2(o[0], o[1]); ow.y = pk2(o[2], o[3]); ow.z = pk2(o[4], o[5]); ow.w = pk2(o[6], o[7]);
            *(u32x4*)(Kn + (size_t)kvrow * 128 + c16 * 8) = ow; }
    }
}
__device__ __forceinline__ void p_conv(const Frame& F, const float* kg) {
    const bf16_t* Gb = (const bf16_t*)(F.ws + WS_G); bf16_t* AO = (bf16_t*)(F.ws + WS_AO);
    LAS bf16_t* gl = (LAS bf16_t*)F.lds;
    LAS float* yl = (LAS float*)(F.lds + 65536);
    const int c = F.tid;
    float w[31];
#pragma unroll
    for (int j = 0; j < 31; ++j) w[j] = F.in[I_CONVW][j * 512 + c];
    const float bias = F.in[I_CONVB][c];
    u32x4 pre[8];
#define CONV_ITEM(item, rowbase, t0, len) do { if ((item) < 1024) { rowbase = ((item) >> 7) * SEQ; t0 = ((item) & 127) * 32; len = SEQ; } else { const int it_ = (item) - 1024; rowbase = TX + (it_ >> 5) * CTXL; t0 = (it_ & 31) * 8; len = CTXL; } } while (0)
#define CONV_LOAD(item) do { int rb_, t0_, len_; CONV_ITEM(item, rb_, t0_, len_); _Pragma("unroll") for (int q = 0; q < 8; ++q) { const int ch = F.tid + q * NTHREADS, r = ch >> 6, p = t0_ - 15 + r; pre[q] = (u32x4){0u, 0u, 0u, 0u}; \
        if (ch < ((item) < 1024 ? 62 : 38) * 64 && p >= 0 && p < len_) pre[q] = *(const u32x4*)(Gb + (size_t)(rb_ + p) * 512 + (ch & 63) * 8); } } while (0)
    if (F.vcu < 1024 + 256) CONV_LOAD(F.vcu);
    p_k_post(F, kg);
    for (int item = F.vcu; item < 1024 + 256; item += F.G) {
        int rowbase, t0, len; CONV_ITEM(item, rowbase, t0, len); const int ntk = item < 1024 ? 32 : 8;
        __syncthreads();
#pragma unroll
        for (int q = 0; q < 8; ++q) { const int ch = F.tid + q * NTHREADS; if (ch < 62 * 64) *(LAS u32x4*)(gl + (ch >> 6) * 512 + (ch & 63) * 8) = pre[q]; }
        __syncthreads();
        if (item + F.G < 1024 + 256) CONV_LOAD(item + F.G);
        float g[62];
#pragma unroll
        for (int r = 0; r < 62; ++r) g[r] = bf2f(gl[r * 512 + c]);
#pragma unroll
        for (int t = 0; t < 32; ++t) { if (t < ntk) { float y = bias;
#pragma unroll
            for (int j = 0; j < 31; ++j) y += g[t + j] * w[j];
            yl[t * 512 + c] = y; } }
        __syncthreads();
#pragma unroll
        for (int tt = 0; tt < 4; ++tt) { if (tt >= (ntk >> 3)) break; const int t = (ntk >> 3) * F.wave + tt; float v[8]; float sm = 0.f;
#pragma unroll
            for (int j = 0; j < 8; ++j) { v[j] = yl[t * 512 + F.lane + 64 * j]; sm += v[j]; }
            const float mean = wave_sum(sm) * (1.f / 512.f); float q = 0.f;
#pragma unroll
            for (int j = 0; j < 8; ++j) { v[j] -= mean; q += v[j] * v[j]; }
            const float rstd = 1.0f / sqrtf(wave_sum(q) * (1.f / 512.f) + EPS);
            bf16_t* orow = AO + (size_t)(rowbase + t0 + t) * 1024 + 512;
#pragma unroll
            for (int j = 0; j < 8; ++j) { const int cc = F.lane + 64 * j; const float yn = v[j] * rstd * F.in[I_CLNG][cc] + F.in[I_CLNB][cc]; orow[cc] = (bf16_t)(pk2(yn * sigmoidf_(yn), 0.f) & 0xffffu); } }
    }
#undef CONV_ITEM
#undef CONV_LOAD
    __syncthreads();
}
__device__ __forceinline__ void p_pool(const Frame& F, const float* kg) {
    const int gw = F.vcu * NWAVES + F.wave, NGW = F.G * NWAVES, lane = F.lane;
    const bf16_t* U = (const bf16_t*)(F.ws + WS_G); bf16_t* AO = (bf16_t*)(F.ws + WS_AO);
    const int hw = 1 << (lane >> 4);
    float wgt[16];
#pragma unroll
    for (int i = 0; i < 16; ++i) wgt[i] = (i >= 8 - hw && i < 8 + hw) ? 1.f : 0.f;
    u32x4 r[23];
#define POOL_LOAD(it_) do { const int row0_ = (it_) * 8, t0_ = row0_ & 4095, rb_ = row0_ - t0_; \
        _Pragma("unroll") for (int j = 0; j < 23; ++j) { const int p = t0_ - 8 + j; r[j] = (u32x4){0u, 0u, 0u, 0u}; if (p >= 0 && p < SEQ) r[j] = *(const u32x4*)(U + (size_t)(rb_ + p) * 512 + lane * 8); } } while (0)
    if (gw < TX / 8) POOL_LOAD(gw);
    p_k_post(F, kg);
    for (int it = gw; it < TX / 8; it += NGW) {
        const int row0 = it * 8, t0 = row0 & 4095;
        if (it != gw) POOL_LOAD(it);
#pragma unroll
        for (int t = 0; t < 8; ++t) {
            float s[8];
#pragma unroll
            for (int j = 0; j < 8; ++j) s[j] = 0.f;
#pragma unroll
            for (int i = 0; i < 16; ++i) { const u32x4 w = r[t + i]; const float g = wgt[i];
                s[0] += g * bflo(w.x); s[1] += g * bfhi(w.x); s[2] += g * bflo(w.y); s[3] += g * bfhi(w.y); s[4] += g * bflo(w.z); s[5] += g * bfhi(w.z); s[6] += g * bflo(w.w); s[7] += g * bfhi(w.w); }
            const int tt = t0 + t; int lo = tt - hw, hi = tt + hw; lo = lo < 0 ? 0 : lo; hi = hi > SEQ ? SEQ : hi;
            const float inv = 1.f / (float)(hi - lo); const u32x4 w = r[t + 8];
            u32x4 ow; ow.x = pk2(s[0] * inv - bflo(w.x), s[1] * inv - bfhi(w.x)); ow.y = pk2(s[2] * inv - bflo(w.y), s[3] * inv - bfhi(w.y)); ow.z = pk2(s[4] * inv - bflo(w.z), s[5] * inv - bfhi(w.z)); ow.w = pk2(s[6] * inv - bflo(w.w), s[7] * inv - bfhi(w.w));
            *(u32x4*)(AO + (size_t)(row0 + t) * 1024 + 512 + lane * 8) = ow;
        }
    }
}

template <int LAYER> __device__ __forceinline__ void attn_simple(const Frame& F) {
    const bf16_t* Q = (const bf16_t*)(F.ws + WS_Q); const bf16_t* Kn = (const bf16_t*)(F.ws + WS_KN); const bf16_t* Vn = (const bf16_t*)(F.ws + WS_VN); bf16_t* AO = (bf16_t*)(F.ws + WS_AO);
    const int nunits = LAYER == 0 ? 512 + 64 : 512;
    for (int u = F.vcu; u < nunits; u += F.G) {
        int b, h, row, s; bool valid = true, isctx = false;
        if (u < 512) { b = u >> 6; h = (u >> 3) & 7; s = (u & 7) * 512 + F.tid; row = b * SEQ + s; }
        else { const int uc = u - 512; b = uc >> 3; h = uc & 7; s = F.tid; valid = F.tid < 256; row = TX + b * CTXL + (valid ? s : 0); isctx = true; }
        float q[64], o[64];
        { const u32x4* qp = (const u32x4*)(Q + (size_t)row * 512 + h * 64);
#pragma unroll
          for (int c = 0; c < 8; ++c) { const u32x4 w = qp[c]; q[8 * c] = bflo(w.x); q[8 * c + 1] = bfhi(w.x); q[8 * c + 2] = bflo(w.y); q[8 * c + 3] = bfhi(w.y); q[8 * c + 4] = bflo(w.z); q[8 * c + 5] = bfhi(w.z); q[8 * c + 6] = bflo(w.w); q[8 * c + 7] = bfhi(w.w); } }
#pragma unroll
        for (int d = 0; d < 64; ++d) o[d] = 0.f;
        float mx = -1e30f, l = 0.f;
        const bf16_t* Kb = Kn + (size_t)b * KVS * 128 + (h >> 2) * 64; const bf16_t* Vb = Vn + (size_t)b * KVS * 128 + (h >> 2) * 64;
        int k_lo2 = 0, k_hi2 = 0;
        const int k_hi1 = CTXL;
        if (LAYER == 0) { if (!isctx) { k_lo2 = CTXL; k_hi2 = KVS; } }
        else { const int s0 = (u & 7) * 512; int lo = s0 - 128, hi = s0 + 511 + 128 + 1; lo = lo < 0 ? 0 : lo; hi = hi > SEQ ? SEQ : hi; k_lo2 = CTXL + lo; k_hi2 = CTXL + hi; }
        for (int part = 0; part < 2; ++part) {
            const int kb = part == 0 ? 0 : k_lo2, ke = part == 0 ? k_hi1 : k_hi2;
            for (int key = kb; key < ke; ++key) {
                const u32x4* kp = (const u32x4*)(Kb + (size_t)key * 128); float sd = 0.f;
#pragma unroll
                for (int c = 0; c < 8; ++c) { const u32x4 w = kp[c];
                    sd += q[8 * c] * bflo(w.x) + q[8 * c + 1] * bfhi(w.x) + q[8 * c + 2] * bflo(w.y) + q[8 * c + 3] * bfhi(w.y) + q[8 * c + 4] * bflo(w.z) + q[8 * c + 5] * bfhi(w.z) + q[8 * c + 6] * bflo(w.w) + q[8 * c + 7] * bfhi(w.w); }
                bool use = valid;
                if (LAYER == 1 && part == 1) { const int j = key - CTXL; const int dlt = s - j; use = use && (dlt <= 128 && dlt >= -128); }
                const float mn = fmaxf(mx, sd); const float mnew = use ? mn : mx;
                const float alpha = exp2f(mx - mnew), p = use ? exp2f(sd - mnew) : 0.f;
                mx = mnew; l = l * alpha + p;
                const u32x4* vp = (const u32x4*)(Vb + (size_t)key * 128);
#pragma unroll
                for (int c = 0; c < 8; ++c) { const u32x4 w = vp[c];
                    o[8 * c] = o[8 * c] * alpha + p * bflo(w.x); o[8 * c + 1] = o[8 * c + 1] * alpha + p * bfhi(w.x); o[8 * c + 2] = o[8 * c + 2] * alpha + p * bflo(w.y); o[8 * c + 3] = o[8 * c + 3] * alpha + p * bfhi(w.y);
                    o[8 * c + 4] = o[8 * c + 4] * alpha + p * bflo(w.z); o[8 * c + 5] = o[8 * c + 5] * alpha + p * bfhi(w.z); o[8 * c + 6] = o[8 * c + 6] * alpha + p * bflo(w.w); o[8 * c + 7] = o[8 * c + 7] * alpha + p * bfhi(w.w); }
            }
        }
        if (LAYER == 1) l += exp2f(F.in[I_SINK][h] * LOG2E - mx);
        const float il = 1.f / l;
        if (valid) { u32x4* op = (u32x4*)(AO + (size_t)row * 1024 + h * 64);
#pragma unroll
            for (int c = 0; c < 8; ++c) { u32x4 w; w.x = pk2(o[8 * c] * il, o[8 * c + 1] * il); w.y = pk2(o[8 * c + 2] * il, o[8 * c + 3] * il); w.z = pk2(o[8 * c + 4] * il, o[8 * c + 5] * il); w.w = pk2(o[8 * c + 6] * il, o[8 * c + 7] * il); op[c] = w; } }
    }
}

#include <hip/hip_bf16.h>
namespace attn_body {
using bf16=__hip_bfloat16;
using s16x4=__attribute__((ext_vector_type(4)))short;
using f32x16=__attribute__((ext_vector_type(16)))float;
constexpr int NW=8,QBLK=32,QB=QBLK*NW,KVBLK=64;
constexpr int QP=512,KP=128,OP=1024;
__device__ __forceinline__ int crow(int r,int hi){return (r&3)+8*(r>>2)+4*hi;}
#define SBAR() __builtin_amdgcn_sched_barrier(0)
__device__ __forceinline__ void wmask(f32x16&p0,f32x16&p1,int dlt0,int hi){
  const float NEG=-INFINITY; const int kb=dlt0+4*hi;
  #pragma unroll
  for(int r=0;r<16;++r){const int d=kb+(r&3)+8*(r>>2); if(d>128||d<-128)p0[r]=NEG; if(d+32>128||d+32<-128)p1[r]=NEG;}
}

constexpr int NSLOT=3, SLOTB=8192;
constexpr int LDS_K=0, LDS_V=NSLOT*SLOTB, LDS_WS=2*NSLOT*SLOTB, LDS_OST=LDS_WS+NW*64*4, LDS_BYTES=LDS_OST+NW*4096;
__device__ __forceinline__ void glds16(const void*gsrc,unsigned lds_dst){unsigned keep;
  asm volatile("s_mov_b32 %0, m0\n\ts_mov_b32 m0, %2\n\ts_nop 0\n\tglobal_load_lds_dwordx4 %1, off\n\ts_mov_b32 m0, %0":"=&s"(keep):"v"(gsrc),"s"(lds_dst):"memory");}
__device__ __forceinline__ float max3f(float a,float b,float c){float r;asm("v_max3_f32 %0, %1, %2, %3":"=v"(r):"v"(a),"v"(b),"v"(c));return r;}
__device__ __forceinline__ float max2f(float a,float b){float r;asm("v_max_f32_e32 %0, %1, %2":"=v"(r):"v"(a),"v"(b));return r;}
__device__ __forceinline__ float fadd_s(float a,float b){float r;asm("v_add_f32_e32 %0, %1, %2":"=v"(r):"v"(a),"v"(b));return r;}
__device__ __forceinline__ float fsub_s(float a,float b){float r;asm("v_sub_f32_e32 %0, %1, %2":"=v"(r):"v"(a),"v"(b));return r;}
typedef float f32x2_t __attribute__((ext_vector_type(2))); typedef __bf16 bf16x2_t __attribute__((ext_vector_type(2)));
__device__ __forceinline__ unsigned cvtpk_s(float lo,float hi){f32x2_t v={lo,hi};bf16x2_t b=__builtin_convertvector(v,bf16x2_t);return __builtin_bit_cast(unsigned,b);}
#define WAIT_BAR(N) asm volatile("s_waitcnt vmcnt(" #N ") lgkmcnt(0)\n\ts_barrier":::"memory")

__device__ __forceinline__ void qkt(f32x16&p0,f32x16&p1,const char*Kslot,const bf16x8*qr,const f32x16&negm,int r32,int hi){
  const char*kb=Kslot+hi*1024+r32*16;
  #pragma unroll
  for(int d0=0;d0<4;++d0){
    const bf16x8 b0=*reinterpret_cast<const bf16x8*>(kb+d0*2048);
    const bf16x8 b1=*reinterpret_cast<const bf16x8*>(kb+d0*2048+512);
    if(d0==0){p0=__builtin_amdgcn_mfma_f32_32x32x16_bf16(b0,qr[0],negm,0,0,0);p1=__builtin_amdgcn_mfma_f32_32x32x16_bf16(b1,qr[0],negm,0,0,0);}
    else{p0=__builtin_amdgcn_mfma_f32_32x32x16_bf16(b0,qr[d0],p0,0,0,0);p1=__builtin_amdgcn_mfma_f32_32x32x16_bf16(b1,qr[d0],p1,0,0,0);}}
}
typedef __attribute__((address_space(3))) const char* lds_cptr;
typedef short v4i16_t __attribute__((ext_vector_type(4)));
__device__ __forceinline__ void kload8(bf16x8*kf,lds_cptr kp){
  kf[0]=*(const __attribute__((address_space(3))) bf16x8*)(kp);      kf[1]=*(const __attribute__((address_space(3))) bf16x8*)(kp+512);
  kf[2]=*(const __attribute__((address_space(3))) bf16x8*)(kp+2048); kf[3]=*(const __attribute__((address_space(3))) bf16x8*)(kp+2560);
  kf[4]=*(const __attribute__((address_space(3))) bf16x8*)(kp+4096); kf[5]=*(const __attribute__((address_space(3))) bf16x8*)(kp+4608);
  kf[6]=*(const __attribute__((address_space(3))) bf16x8*)(kp+6144); kf[7]=*(const __attribute__((address_space(3))) bf16x8*)(kp+6656);
}
__device__ __forceinline__ void kload2(bf16x8*kf,lds_cptr kp,int j){ kf[2*j]=*(const __attribute__((address_space(3))) bf16x8*)(kp+j*2048); kf[2*j+1]=*(const __attribute__((address_space(3))) bf16x8*)(kp+j*2048+512); }
__device__ __forceinline__ s16x4 vtr(lds_cptr p){ return __builtin_bit_cast(s16x4,__builtin_amdgcn_ds_read_tr16_b64_v4i16((__attribute__((address_space(3))) v4i16_t*)p)); }
__device__ __forceinline__ float rowmax(const f32x16&p0,const f32x16&p1){
  float a=max3f(p0[0],p0[1],p1[0]),b=max3f(p0[2],p0[3],p1[1]);a=max3f(a,p1[2],p1[3]);
  #pragma unroll
  for(int r=4;r<16;r+=4){a=max3f(a,p0[r],p0[r+1]);b=max3f(b,p0[r+2],p0[r+3]);a=max3f(a,p1[r],p1[r+1]);b=max3f(b,p1[r+2],p1[r+3]);}
  const float m=max2f(a,b);
  auto rr=__builtin_amdgcn_permlane32_swap(__float_as_uint(m),__float_as_uint(m),false,false);
  return max2f(__uint_as_float(rr[0]),__uint_as_float(rr[1]));
}
__device__ __forceinline__ void pv(f32x16*o,int vb,bf16x8 pa0,bf16x8 pa1,bf16x8 pa2,bf16x8 pa3){
  #pragma unroll
  for(int d0=0;d0<2;++d0){s16x4 lo[4],hi[4];
    #pragma unroll
    for(int ks=0;ks<4;++ks){
      asm volatile("ds_read_b64_tr_b16 %0,%1 offset:%c2":"=&v"(lo[ks]):"v"(vb),"i"(d0*4096+ks*1024):"memory");
      asm volatile("ds_read_b64_tr_b16 %0,%1 offset:%c2":"=&v"(hi[ks]):"v"(vb),"i"(d0*4096+ks*1024+512):"memory");}
    asm volatile("s_waitcnt lgkmcnt(0)":::"memory");SBAR();
    #define PK(k) (bf16x8){lo[k][0],lo[k][1],lo[k][2],lo[k][3],hi[k][0],hi[k][1],hi[k][2],hi[k][3]}
    o[d0]=__builtin_amdgcn_mfma_f32_32x32x16_bf16(pa0,PK(0),o[d0],0,0,0);
    o[d0]=__builtin_amdgcn_mfma_f32_32x32x16_bf16(pa1,PK(1),o[d0],0,0,0);
    o[d0]=__builtin_amdgcn_mfma_f32_32x32x16_bf16(pa2,PK(2),o[d0],0,0,0);
    o[d0]=__builtin_amdgcn_mfma_f32_32x32x16_bf16(pa3,PK(3),o[d0],0,0,0);
    #undef PK
  }
}

#ifndef ATTN_STORE16
#define ATTN_STORE16(p,v) (*(u32x4*)(p)=(v))
#endif
template<int MODE,int THRL> __device__ __forceinline__ void attn_unit(const bf16*Qu,const bf16*__restrict__ Kh,const bf16*__restrict__ Vh,bf16*Ou,const int NT,const int lat0,const int q0s,const float sinkl2,const float*qg,const float*ropec,const bool rope,char*shm){
  int tid_=threadIdx.x; asm volatile("":"+v"(tid_));
  const int tid=tid_,lane=tid&63,r32=lane&31,hi=lane>>5; const int wid=__builtin_amdgcn_readfirstlane(tid>>6);
  const bf16*Qw=Qu+(long)(wid*QBLK)*QP;
  const unsigned lds0=(unsigned)(uintptr_t)shm;
  float*wsf=(float*)(shm+LDS_WS)+wid*64;
  const bf16*ksrc=Kh+(long)lane*KP+wid*8;
  const bf16*vsrc=Vh+(long)(16*(wid&3)+(lane>>2))*KP+(wid>>2)*32+(lane&3)*8;
  const unsigned kdst=lds0+LDS_K+wid*1024, vdst=lds0+LDS_V+wid*1024;
  #define TROW(t) ((MODE==0||(t)<4)?(t)*KVBLK:lat0+((t)-4)*KVBLK)
  #define DMA_K(t,slot) glds16(ksrc+(long)TROW(t)*KP,(unsigned)__builtin_amdgcn_readfirstlane(kdst+(slot)))
  #define DMA_V(t,slot) glds16(vsrc+(long)TROW(t)*KP,(unsigned)__builtin_amdgcn_readfirstlane(vdst+(slot)))
  const int vb0=(int)(lds0+LDS_V)+((lane>>4)&1)*32+(lane&3)*8+(4*hi+((lane&15)>>2))*64;
  const char*Kbase=shm+LDS_K; bf16x8 kf[8];
  const lds_cptr shm3=(lds_cptr)shm; const lds_cptr kp0=shm3+LDS_K+hi*1024+r32*16; const lds_cptr vp0=shm3+LDS_V+((lane>>4)&1)*32+(lane&3)*8+(4*hi+((lane&15)>>2))*64;
  DMA_K(0,0);DMA_V(0,0);DMA_K(1,SLOTB);
  bf16x8 qr[4];
  const int qpos=q0s+wid*QBLK+r32;
  {
    u32x4 qraw[4];
    #pragma unroll
    for(int d0=0;d0<4;++d0) qraw[d0]=*reinterpret_cast<const u32x4*>(&Qw[(long)r32*QP+d0*16+hi*8]);
    float x[4][8]; float ss=0.f;
    #pragma unroll
    for(int d0=0;d0<4;++d0){ x[d0][0]=bflo(qraw[d0].x);x[d0][1]=bfhi(qraw[d0].x);x[d0][2]=bflo(qraw[d0].y);x[d0][3]=bfhi(qraw[d0].y);x[d0][4]=bflo(qraw[d0].z);x[d0][5]=bfhi(qraw[d0].z);x[d0][6]=bflo(qraw[d0].w);x[d0][7]=bfhi(qraw[d0].w);
      #pragma unroll
      for(int j=0;j<8;++j)ss+=x[d0][j]*x[d0][j]; }
    {auto rr=__builtin_amdgcn_permlane32_swap(__float_as_uint(ss),__float_as_uint(ss),false,false);ss=__uint_as_float(rr[0])+__uint_as_float(rr[1]);}
    const float rms=C2/sqrtf(ss*(1.f/64.f)+EPS);
    SBAR();
    #pragma unroll
    for(int d0=0;d0<2;++d0){
      #pragma unroll
      for(int hf=0;hf<2;++hf){
        const f32x4 ga=*reinterpret_cast<const f32x4*>(qg+d0*16+hi*8+4*hf), gb=*reinterpret_cast<const f32x4*>(qg+(d0+2)*16+hi*8+4*hf);
        f32x4 cc=f32x4{1.f,1.f,1.f,1.f}, sn=f32x4{0.f,0.f,0.f,0.f};
        if(rope){ const float*pc=ropec+(long)qpos*32+d0*16+hi*8+4*hf; cc=*reinterpret_cast<const f32x4*>(pc); sn=*reinterpret_cast<const f32x4*>(pc+SEQ*32); }
        #pragma unroll
        for(int j=0;j<4;++j){ const float a=x[d0][4*hf+j]*rms*ga[j], b=x[d0+2][4*hf+j]*rms*gb[j]; x[d0][4*hf+j]=a*cc[j]-b*sn[j]; x[d0+2][4*hf+j]=b*cc[j]+a*sn[j]; }
        SBAR(); } }
    #pragma unroll
    for(int d0=0;d0<4;++d0){ u32x4 w; w.x=cvtpk_s(x[d0][0],x[d0][1]);w.y=cvtpk_s(x[d0][2],x[d0][3]);w.z=cvtpk_s(x[d0][4],x[d0][5]);w.w=cvtpk_s(x[d0][6],x[d0][7]); qr[d0]=__builtin_bit_cast(bf16x8,w); } }
  float mhat=0.f,l_reg=0.f;f32x16 o[2],negm; { float z_=0.f; asm volatile("":"+v"(z_));
    #pragma unroll
    for(int r=0;r<16;++r){o[0][r]=z_;o[1][r]=z_;negm[r]=z_;} } asm volatile("":"+v"(negm));
  #define CMASK(P0,P1,t) do{ if(MODE==1&&(t)>=4) wmask(P0,P1,(lat0-256)+((t)-4)*KVBLK-qpos,hi); }while(0)
  bool resc=false;
  #define START(P0,P1) do{ const float rm=rowmax(P0,P1); resc=false; \
    { const float dl=rm; mhat=fadd_s(mhat,dl); \
      _Pragma("unroll") for(int r=0;r<16;++r){P0[r]=fsub_s(P0[r],dl);P1[r]=fsub_s(P1[r],dl);} \
      _Pragma("unroll") for(int r=0;r<16;++r)negm[r]=-mhat; asm volatile("":"+v"(negm)); } \
    _Pragma("unroll") for(int r=0;r<16;++r)P0[r]=__builtin_amdgcn_exp2f(P0[r]); }while(0)
  #define RESC() do{ if(resc){ asm volatile("s_waitcnt lgkmcnt(0)":::"memory"); \
      _Pragma("unroll") for(int d_=0;d_<2;++d_) _Pragma("unroll") for(int r=0;r<16;++r)o[d_][r]*=wsf[crow(r,hi)]; } }while(0)
  f32x16 pA0,pA1,pB0,pB1;
  int sl_prev=0,sl_cur=0,sl_next=SLOTB;
  #define ROT() do{sl_prev=sl_cur;sl_cur=sl_next;sl_next=(sl_next==(NSLOT-1)*SLOTB)?0:sl_next+SLOTB;}while(0)
  DMA_K(2,2*SLOTB);
  WAIT_BAR(3);
  qkt(pA0,pA1,Kbase,qr,negm,r32,hi);asm volatile("s_nop 15\n\ts_nop 7":"+v"(pA0),"+v"(pA1));CMASK(pA0,pA1,0);
  START(pA0,pA1);
  _Pragma("unroll") for(int r=0;r<16;++r)pA1[r]=__builtin_amdgcn_exp2f(pA1[r]);
  WAIT_BAR(0);
  DMA_K(3,0);DMA_V(1,SLOTB);
  ROT();
  kload8(kf,kp0+sl_cur);
  WAIT_BAR(2);
  s16x4 vlo[8],vhi[8]; u32x4 pw0,pw1,pw2,pw3;
  #define PKW(P,B) cvtpk_s(P[B],P[B+1])
  #define PAF(k) __builtin_bit_cast(bf16x8,pw##k)
  #define VFR(i) (bf16x8){vlo[i][0],vlo[i][1],vlo[i][2],vlo[i][3],vhi[i][0],vhi[i][1],vhi[i][2],vhi[i][3]}
  #define PIN(x) asm volatile("":"+v"(x))
  #define MX3(a,b,c) __builtin_fmaxf(__builtin_fmaxf((a),(b)),(c))
  #define GAPA(MF,A0,A1,A2,A3,W0,W1,PW) do{ MF; sacc+=A0; sacc+=A1; sacc+=A2; sacc+=A3; PIN(sacc); W0; W1; PIN(PW); SBAR(); }while(0)
  #define EX(v) __builtin_amdgcn_exp2f(v)
  #define GAPB(MF,X,B) do{ MF; X[B]=EX(X[B]); X[B+1]=EX(X[B+1]); X[B+2]=EX(X[B+2]); X[B+3]=EX(X[B+3]); PIN(X); SBAR(); }while(0)
  #define VRD(i) do{ vlo[i]=vtr(vp_+(((i)>>2)*4096+((i)&3)*1024)); vhi[i]=vtr(vp_+(((i)>>2)*4096+((i)&3)*1024+512)); }while(0)
  #define KRD(G,j) do{ if(G){ kload2(kf,kp0+sl_next,j); SBAR(); } }while(0)
  #define STEP(C0,C1,P0,P1,t,GK,GV,GL) do{ SBAR(); \
    const lds_cptr vp_=vp0+sl_prev; \
    VRD(0); SBAR(); float sacc=(P0[0]+P0[1]); \
    GAPA(C0=__builtin_amdgcn_mfma_f32_32x32x16_bf16(kf[0],qr[0],negm,0,0,0), P0[2],P0[3],P0[4],P0[5],     pw0[0]=PKW(P0,0), pw0[1]=PKW(P0,2), pw0); \
    VRD(4); SBAR(); GAPA(C1=__builtin_amdgcn_mfma_f32_32x32x16_bf16(kf[1],qr[0],negm,0,0,0), P0[6],P0[7],P0[8],P0[9],     pw0[2]=PKW(P0,4), pw0[3]=PKW(P0,6), pw0); \
    VRD(1); SBAR(); GAPA(C0=__builtin_amdgcn_mfma_f32_32x32x16_bf16(kf[2],qr[1],C0,0,0,0),   P0[10],P0[11],P0[12],P0[13], pw1[0]=PKW(P0,8), pw1[1]=PKW(P0,10), pw1); \
    VRD(5); SBAR(); GAPA(C1=__builtin_amdgcn_mfma_f32_32x32x16_bf16(kf[3],qr[1],C1,0,0,0),   P0[14],P0[15],P1[0],P1[1],   pw1[2]=PKW(P0,12),pw1[3]=PKW(P0,14), pw1); \
    VRD(2); SBAR(); GAPA(C0=__builtin_amdgcn_mfma_f32_32x32x16_bf16(kf[4],qr[2],C0,0,0,0),   P1[2],P1[3],P1[4],P1[5],     pw2[0]=PKW(P1,0), pw2[1]=PKW(P1,2), pw2); \
    VRD(6); SBAR(); GAPA(C1=__builtin_amdgcn_mfma_f32_32x32x16_bf16(kf[5],qr[2],C1,0,0,0),   P1[6],P1[7],P1[8],P1[9],     pw2[2]=PKW(P1,4), pw2[3]=PKW(P1,6), pw2); \
    VRD(3); SBAR(); GAPA(C0=__builtin_amdgcn_mfma_f32_32x32x16_bf16(kf[6],qr[3],C0,0,0,0),   P1[10],P1[11],P1[12],P1[13], pw3[0]=PKW(P1,8), pw3[1]=PKW(P1,10), pw3); \
    VRD(7); SBAR(); GAPA(C1=__builtin_amdgcn_mfma_f32_32x32x16_bf16(kf[7],qr[3],C1,0,0,0),   P1[14],P1[15],0.f,0.f,       pw3[2]=PKW(P1,12),pw3[3]=PKW(P1,14), pw3); \
    l_reg+=sacc; \
    if(GK){DMA_K((t)+3,sl_cur);} if(GV){DMA_V((t)+1,sl_next);} \
    CMASK(C0,C1,t); \
    { float a=MX3(C0[0],C0[1],C1[0]),b=MX3(C0[2],C0[3],C1[1]); a=MX3(a,C1[2],C1[3]); \
      _Pragma("unroll") for(int r=4;r<16;r+=4){a=MX3(a,C0[r],C0[r+1]);b=MX3(b,C0[r+2],C0[r+3]);a=MX3(a,C1[r],C1[r+1]);b=MX3(b,C1[r+2],C1[r+3]);} \
      float rm=__builtin_fmaxf(a,b); { auto rr=__builtin_amdgcn_permlane32_swap(__float_as_uint(rm),__float_as_uint(rm),false,false); rm=__builtin_fmaxf(__uint_as_float(rr[0]),__uint_as_float(rr[1])); } \
      resc=false; \
      if(__builtin_expect(__any(rm>(float)THRL),0)){ const float dl=__builtin_fmaxf(rm,0.f); mhat+=dl; \
        _Pragma("unroll") for(int r=0;r<16;++r){C0[r]-=dl;C1[r]-=dl;} \
        _Pragma("unroll") for(int r=0;r<16;++r)negm[r]=-mhat; asm volatile("":"+v"(negm)); \
        const float f=__builtin_amdgcn_exp2f(-dl); l_reg*=f; if(hi==0)wsf[r32]=f; resc=true; } } \
    SBAR(); \
    GAPB(o[0]=__builtin_amdgcn_mfma_f32_32x32x16_bf16(PAF(0),VFR(0),o[0],0,0,0), C0,0); \
    GAPB(o[1]=__builtin_amdgcn_mfma_f32_32x32x16_bf16(PAF(0),VFR(4),o[1],0,0,0), C0,4); \
    KRD(GL,0); GAPB(o[0]=__builtin_amdgcn_mfma_f32_32x32x16_bf16(PAF(1),VFR(1),o[0],0,0,0), C0,8); \
    KRD(GL,1); GAPB(o[1]=__builtin_amdgcn_mfma_f32_32x32x16_bf16(PAF(1),VFR(5),o[1],0,0,0), C0,12); \
    KRD(GL,2); GAPB(o[0]=__builtin_amdgcn_mfma_f32_32x32x16_bf16(PAF(2),VFR(2),o[0],0,0,0), C1,0); \
    KRD(GL,3); GAPB(o[1]=__builtin_amdgcn_mfma_f32_32x32x16_bf16(PAF(2),VFR(6),o[1],0,0,0), C1,4); \
    GAPB(o[0]=__builtin_amdgcn_mfma_f32_32x32x16_bf16(PAF(3),VFR(3),o[0],0,0,0), C1,8); \
    GAPB(o[1]=__builtin_amdgcn_mfma_f32_32x32x16_bf16(PAF(3),VFR(7),o[1],0,0,0), C1,12); \
    }while(0)
  int t=1;
  for(;t+5<NT;t+=2){
    STEP(pB0,pB1,pA0,pA1,t,true,true,true);     WAIT_BAR(2); RESC(); ROT();
    STEP(pA0,pA1,pB0,pB1,t+1,true,true,true);   WAIT_BAR(2); RESC(); ROT();
  }
  #define ENDW(tt) do{ if((tt)+3<NT){WAIT_BAR(2);} else if((tt)+2<NT){WAIT_BAR(1);} else {WAIT_BAR(0);} }while(0)
  for(;t+1<NT;t+=2){
    STEP(pB0,pB1,pA0,pA1,t,(t+3<NT),(t+1<NT),(t+1<NT));       ENDW(t);   RESC(); ROT();
    STEP(pA0,pA1,pB0,pB1,t+1,(t+4<NT),(t+2<NT),(t+2<NT));     ENDW(t+1); RESC(); ROT();
  }
  STEP(pB0,pB1,pA0,pA1,NT-1,false,false,false); RESC();
  { float sacc=pB0[0]+pB0[1]; _Pragma("unroll") for(int r=2;r<16;++r)sacc+=pB0[r]; _Pragma("unroll") for(int r=0;r<16;++r)sacc+=pB1[r]; l_reg+=sacc;
    pw0=(u32x4){PKW(pB0,0),PKW(pB0,2),PKW(pB0,4),PKW(pB0,6)};pw1=(u32x4){PKW(pB0,8),PKW(pB0,10),PKW(pB0,12),PKW(pB0,14)};pw2=(u32x4){PKW(pB1,0),PKW(pB1,2),PKW(pB1,4),PKW(pB1,6)};pw3=(u32x4){PKW(pB1,8),PKW(pB1,10),PKW(pB1,12),PKW(pB1,14)};
    SBAR(); pv(o,vb0+sl_cur,PAF(0),PAF(1),PAF(2),PAF(3)); }
  #undef PKW
  #undef PAF
  #undef VFR
  #undef PIN
  #undef MX3
  #undef GAPA
  #undef GAPB
  #undef EX
  #undef VRD
  #undef KRD
  #undef STEP
  #undef ENDW
  {auto rr=__builtin_amdgcn_permlane32_swap(__float_as_uint(l_reg),__float_as_uint(l_reg),false,false);l_reg=__uint_as_float(rr[0])+__uint_as_float(rr[1]);}
  if(MODE==1)l_reg+=__builtin_amdgcn_exp2f(sinkl2-mhat);
  if(hi==0)wsf[32+r32]=l_reg;asm volatile("s_waitcnt lgkmcnt(0)":::"memory");
  float rli[16];
  #pragma unroll
  for(int r=0;r<16;++r)rli[r]=__builtin_amdgcn_rcpf(wsf[32+crow(r,hi)]);
  bf16*Ow=Ou+(long)(wid*QBLK)*OP;
  { bf16*stg=(bf16*)(shm+LDS_OST)+wid*2048;
    #pragma unroll
    for(int r=0;r<16;++r){const int orow=crow(r,hi);
      #pragma unroll
      for(int d0=0;d0<2;++d0)stg[orow*64+d0*32+r32]=__float2bfloat16(o[d0][r]*rli[r]);}
    asm volatile("s_waitcnt lgkmcnt(0)":::"memory");
    #pragma unroll
    for(int i=0;i<4;++i){const int row=i*8+(lane>>3),ch=lane&7; const u32x4 v=*(const u32x4*)(stg+row*64+ch*8); ATTN_STORE16(Ow+(long)row*OP+ch*8,v);} }
  asm volatile("s_waitcnt lgkmcnt(0)\n\ts_barrier":::"memory");
  #undef DMA_K
  #undef TROW
  #undef DMA_V
  #undef CMASK
  #undef START
  #undef RESC
  #undef ROT
}
#undef SBAR
#undef WAIT_BAR
}

template <int LAYER> __device__ __forceinline__ void attn_fast(const Frame& F, char* shm) {
    using attn_body::bf16;
    const bf16* Q = (const bf16*)(F.ws + WS_Q); const bf16* Kn = (const bf16*)(F.ws + WS_KN); const bf16* Vn = (const bf16*)(F.ws + WS_VN); bf16* AO = (bf16*)(F.ws + WS_AO);
    const int nunits = LAYER == 0 ? 1024 + 64 : 1024;
    for (int U = F.vcu; U < nunits; U += F.G) {
        int b, h, NT, lat0 = 0, q0 = 0; size_t row0;
        if (U < 1024) { b = U >> 7; h = ((U >> 6) & 1) * 4 + ((U >> 4) & 3); q0 = (U & 15) * 256; row0 = (size_t)b * SEQ + q0;
            if (LAYER == 0) NT = KVS / 64;
            else { int lo = q0 - 128, hi = q0 + 384; lo = lo < 0 ? 0 : lo; hi = hi > SEQ ? SEQ : hi; NT = 4 + (hi - lo) / 64; lat0 = CTXL + lo; } }
        else { const int uc = U - 1024; b = uc >> 3; h = uc & 7; row0 = (size_t)TX + (size_t)b * CTXL; NT = 4; }
        const bf16* Kh = Kn + (size_t)b * KVS * 128 + (h >> 2) * 64; const bf16* Vh = Vn + (size_t)b * KVS * 128 + (h >> 2) * 64;
        const float sinkl2 = LAYER == 1 ? F.in[I_SINK][h] * LOG2E : 0.f;
        if (LAYER == 0 && F.G == 256 && U < 1024 && (U >> 8) == (F.vcu & 3)) {
            const int lo = TN_DENSE + (F.vcu < 64 ? F.vcu * 72 : 64 * 72 + (F.vcu - 64) * 104); int hi = lo + (F.vcu < 64 ? 72 : 104); hi = hi > TN_ITEMS ? TN_ITEMS : hi;
            Frame Fc = F; asm volatile("" : "+v"(Fc.lane), "+v"(Fc.tid));
            transpose_range(Fc, lo, hi, Fc.wave, NWAVES);
            __syncthreads(); }
        attn_body::attn_unit<LAYER, 8>(Q + row0 * 512 + h * 64, Kh, Vh, AO + row0 * 1024 + h * 64, NT, lat0, q0, sinkl2, F.in[LAYER == 0 ? I_QNA : I_QNC], (const float*)(F.ws + WS_ROPE), U < 1024, shm);
    }
}

template <int DRY, bool FP8> __device__ __forceinline__ void p_router(const Frame& F, int l, int ntok) {
    const int gw = F.vcu * NWAVES + F.wave, NGW = F.G * NWAVES, lane = F.lane, tk = lane & 15, kq = lane >> 4;
    bf16_t* HX = F.hx(); const float* SS = (const float*)(F.ws + WS_SS);
    const float* gb = F.in[I_RGB] + l * 4; const float* eb = F.in[I_REB] + l * 32;
    unsigned* tokslot = (unsigned*)(F.ws + (DRY ? WS_HID : WS_TOK)); float* tokw = (float*)(F.ws + (DRY ? WS_HID : WS_TOK) + 512 * 1024); unsigned* list = (unsigned*)(F.ws + (DRY ? WS_HID + 2 * MiB : WS_LIST));
    unsigned* cnt = F.cnt(DRY ? l + 2 : l);
    {
        const u32x4* src = (const u32x4*)((const bf16_t*)(F.ws + WS_WR) + (size_t)l * 2 * 36864);
        u32x4 t[18];
#pragma unroll
        for (int i = 0; i < 18; ++i) t[i] = src[F.tid + i * NTHREADS];
        __syncthreads();
#pragma unroll
        for (int i = 0; i < 18; ++i) *(LAS u32x4*)(F.lds + (F.tid + i * NTHREADS) * 16) = t[i];
    }
    const LAS unsigned char* wl0 = F.lds + lane * 16;
    const LAS unsigned char* wl2 = F.lds + 2048 + ((tk >> 2) * 4 + kq) * 16;
    LAS unsigned* lcnt = (LAS unsigned*)(F.lds + LDS_TAB + 2048 + 8192); LAS unsigned* lbase = lcnt + 32;
    LAS float* gps = (LAS float*)(F.lds + LDS_TAB + 2048);
    const int ngrp = ntok / 16, nfull = ngrp / NGW, nleft = ngrp - nfull * NGW; const bool splitk = nleft > 0 && nleft <= F.G && nfull > 0;
    const int nrounds = splitk ? nfull + 1 : (ngrp + NGW - 1) / NGW;
    LAS unsigned* stash = (LAS unsigned*)(F.lds + LDS_TAB + 2048 + 8192 + 512);
    if (F.tid < 32) lcnt[F.tid] = 0u;
    for (int rd = 0; rd < nrounds; ++rd) {
        const bool split = splitk && rd == 0; const int fr = splitk ? rd - 1 : rd;
        const int grp0 = split ? nfull * NGW + F.vcu : F.vcu * NWAVES + fr * NGW, grp = split ? grp0 : grp0 + F.wave;
        const bool lastrd = rd == nrounds - 1, alloc = !split;
        __syncthreads();
        if (grp0 < ngrp) { const int r0 = modrow(grp0 * 16); const float* gpg = (const float*)(F.ws + WS_GP) + (size_t)(l * 9 + r0) * 1024; const float* shg = F.mod(l, r0, 3);
            *(LAS f32x4*)(gps + 4 * F.tid) = F.tid < 256 ? *(const f32x4*)(gpg + 4 * F.tid) : *(const f32x4*)(shg + 4 * (F.tid - 256)); }
        __syncthreads();
        const bool active = grp < ngrp;
        const int row = (active ? grp : 0) * 16 + tk;
        bool win = false; int e1 = 0, e2 = 0; float w1 = 0.f, w2 = 0.f; unsigned p1 = 0u, p2 = 0u;
        f32x4 acc[3];
#pragma unroll
        for (int n = 0; n < 3; ++n) acc[n] = (f32x4){0.f, 0.f, 0.f, 0.f};
        u32x4 xq[16]; bf16x8 wq[2][6]; f32x4 mq[2][4];
        const bf16_t* xr = F.xr_row(row) + 8 * kq;
        bf16_t* hxr = HX + (size_t)row * DM + 8 * kq; unsigned char* hx8 = (unsigned char*)HX + (size_t)row * DM + 8 * kq;
        const LAS float* gpl = gps + 8 * kq;
        float rms = 0.f;
#define R_XLOAD(i, st) do { const int s_ = (st) < 32 ? (st) : 31; xq[i] = *(const u32x4*)(xr + s_ * 32); } while (0)
#define R_RMS() do { float ssum = 0.f; _Pragma("unroll") for (int i = 0; i < 4; ++i) { const f32x4 p = *(const f32x4*)(SS + (size_t)row * 16 + 4 * i); ssum += (p[0] + p[1]) + (p[2] + p[3]); } rms = 1.0f / sqrtf(ssum * (1.f / 1024.f) + EPS); } while (0)
#define R_WLOAD(p, st) do { const int s_ = (st) < 32 ? (st) : 31; \
            wq[p][0] = *(const LAS bf16x8*)(wl0 + s_ * 2304); wq[p][1] = *(const LAS bf16x8*)(wl0 + s_ * 2304 + 1024); wq[p][2] = *(const LAS bf16x8*)(wl2 + s_ * 2304); \
            wq[p][3] = *(const LAS bf16x8*)(wl0 + RW_BYTES + s_ * 2304); wq[p][4] = *(const LAS bf16x8*)(wl0 + RW_BYTES + s_ * 2304 + 1024); wq[p][5] = *(const LAS bf16x8*)(wl2 + RW_BYTES + s_ * 2304); \
            mq[p][0] = *(const LAS f32x4*)(gpl + s_ * 32); mq[p][1] = *(const LAS f32x4*)(gpl + s_ * 32 + 4); mq[p][2] = *(const LAS f32x4*)(gpl + 1024 + s_ * 32); mq[p][3] = *(const LAS f32x4*)(gpl + 1024 + s_ * 32 + 4); } while (0)
#define R_STEP(i, st) do { const u32x4 xb_ = xq[i]; const int p_ = (i) & 1; R_WLOAD(p_ ^ 1, (st) + 1); \
            const f32x4 xf0 = (f32x4){bflo(xb_.x), bfhi(xb_.x), bflo(xb_.y), bfhi(xb_.y)}, xf1 = (f32x4){bflo(xb_.z), bfhi(xb_.z), bflo(xb_.w), bfhi(xb_.w)}; \
            const f32x4 h0 = (xf0 * rms) * mq[p_][0] + mq[p_][2], h1 = (xf1 * rms) * mq[p_][1] + mq[p_][3]; \
            u32x4 hh; hh.x = pk2(h0[0], h0[1]); hh.y = pk2(h0[2], h0[3]); hh.z = pk2(h1[0], h1[1]); hh.w = pk2(h1[2], h1[3]); \
            if (FP8) { u32x2 h8; h8.x = pk4_fp8(h0[0], h0[1], h0[2], h0[3]); h8.y = pk4_fp8(h1[0], h1[1], h1[2], h1[3]); *(u32x2*)(hx8 + (st) * 32) = h8; } else *(u32x4*)(hxr + (st) * 32) = hh; \
            if (DRY < 3) { \
            u32x4 hl; hl.x = pk2(h0[0] - bflo(hh.x), h0[1] - bfhi(hh.x)); hl.y = pk2(h0[2] - bflo(hh.y), h0[3] - bfhi(hh.y)); hl.z = pk2(h1[0] - bflo(hh.z), h1[1] - bfhi(hh.z)); hl.w = pk2(h1[2] - bflo(hh.w), h1[3] - bfhi(hh.w)); \
            const bf16x8 bh = __builtin_bit_cast(bf16x8, hh), bl = __builtin_bit_cast(bf16x8, hl); \
            acc[0] = __builtin_amdgcn_mfma_f32_16x16x32_bf16(wq[p_][0], bh, acc[0], 0, 0, 0); acc[1] = __builtin_amdgcn_mfma_f32_16x16x32_bf16(wq[p_][1], bh, acc[1], 0, 0, 0); acc[2] = __builtin_amdgcn_mfma_f32_16x16x32_bf16(wq[p_][2], bh, acc[2], 0, 0, 0); \
            acc[0] = __builtin_amdgcn_mfma_f32_16x16x32_bf16(wq[p_][0], bl, acc[0], 0, 0, 0); acc[1] = __builtin_amdgcn_mfma_f32_16x16x32_bf16(wq[p_][1], bl, acc[1], 0, 0, 0); acc[2] = __builtin_amdgcn_mfma_f32_16x16x32_bf16(wq[p_][2], bl, acc[2], 0, 0, 0); \
            acc[0] = __builtin_amdgcn_mfma_f32_16x16x32_bf16(wq[p_][3], bh, acc[0], 0, 0, 0); acc[1] = __builtin_amdgcn_mfma_f32_16x16x32_bf16(wq[p_][4], bh, acc[1], 0, 0, 0); acc[2] = __builtin_amdgcn_mfma_f32_16x16x32_bf16(wq[p_][5], bh, acc[2], 0, 0, 0); } } while (0)
        bool tail = false;
        if (!split) {
            if (active) {
#pragma unroll
                for (int i = 0; i < 16; ++i) R_XLOAD(i, i);
                R_RMS();
                R_WLOAD(0, 0);
                for (int st = 0; st < 32; st += 16) {
#pragma unroll
                    for (int i = 0; i < 16; ++i) { R_STEP(i, st + i); R_XLOAD(i, st + i + 16); }
                }
                tail = true;
            }
        } else if (active) {
            const int s0 = 4 * F.wave;
#pragma unroll
            for (int i = 0; i < 4; ++i) R_XLOAD(i, s0 + i);
            R_RMS();
            R_WLOAD(0, s0);
#pragma unroll
            for (int i = 0; i < 4; ++i) R_STEP(i, s0 + i);
            LAS f32x4* red = (LAS f32x4*)gps;
#pragma unroll
            for (int n = 0; n < 3; ++n) {
                __syncthreads();
                red[F.wave * 64 + lane] = acc[n];
                __syncthreads();
                if (F.wave == 0) { f32x4 a = red[lane];
#pragma unroll
                    for (int w = 1; w < NWAVES; ++w) a += red[w * 64 + lane];
                    acc[n] = a; }
            }
            tail = F.wave == 0;
        }
#undef R_WLOAD
#undef R_XLOAD
#undef R_STEP
#undef R_RMS
        if (DRY >= 6 && acc[0][0] + acc[1][1] + acc[2][2] == 123.456f) tokw[row] = 1.f;
        if (DRY < 2 && tail) {
            const float lgk = acc[2][0] + gb[kq];
            const float la = __shfl_xor(lgk, 16), lb = __shfl_xor(lgk, 32), lc = __shfl_xor(la, 32);
            const float gm = fmaxf(fmaxf(lgk, la), fmaxf(lb, lc));
            win = (lgk == gm);
            win = win && !(la == gm && (kq ^ 1) < kq) && !(lb == gm && (kq ^ 2) < kq) && !(lc == gm && (kq ^ 3) < kq);
            if (win) {
                const float g_w = 1.f / (expf(lgk - gm) + expf(la - gm) + expf(lb - gm) + expf(lc - gm));
                float el[8];
                { const f32x4 b0 = *(const f32x4*)(eb + 8 * kq), b1 = *(const f32x4*)(eb + 8 * kq + 4);
#pragma unroll
                  for (int i = 0; i < 4; ++i) { el[i] = acc[0][i] + b0[i]; el[4 + i] = acc[1][i] + b1[i]; } }
                int i1 = 0; float m1 = el[0];
#pragma unroll
                for (int i = 1; i < 8; ++i) if (el[i] > m1) { m1 = el[i]; i1 = i; }
                int i2 = 0; float m2 = -3.0e38f;
#pragma unroll
                for (int i = 0; i < 8; ++i) if (i != i1 && el[i] > m2) { m2 = el[i]; i2 = i; }
                const float pp = expf(m2 - m1); w1 = g_w / (1.f + pp); w2 = g_w * pp / (1.f + pp);
                e1 = kq * 8 + i1; e2 = kq * 8 + i2;
                p1 = __hip_atomic_fetch_add(lcnt + e1, 1u, __ATOMIC_RELAXED, __HIP_MEMORY_SCOPE_WORKGROUP); p2 = __hip_atomic_fetch_add(lcnt + e2, 1u, __ATOMIC_RELAXED, __HIP_MEMORY_SCOPE_WORKGROUP);
            }
        }
        if (!alloc) {
            if (F.wave == 0) { stash[lane] = win ? 1u : 0u; stash[64 + lane] = ((unsigned)e1 << 8) | (unsigned)e2; stash[128 + lane] = p1; stash[192 + lane] = p2; stash[256 + lane] = __float_as_uint(w1); stash[320 + lane] = __float_as_uint(w2); stash[384 + lane] = (unsigned)row; }
            continue;
        }
        __syncthreads();
        if (DRY < 2 && F.tid < 32) { const unsigned n = lcnt[F.tid]; lbase[F.tid] = n ? atomicAdd(cnt + F.tid * 64, n) : 0u; }
        __syncthreads();
        if (win) { const unsigned pos1 = lbase[e1] + p1, pos2 = lbase[e2] + p2;
            list[(size_t)e1 * TT + pos1] = (unsigned)row; list[(size_t)e2 * TT + pos2] = (unsigned)row;
            tokslot[2 * row] = ((unsigned)e1 << 16) | pos1; tokslot[2 * row + 1] = ((unsigned)e2 << 16) | pos2; tokw[2 * row] = w1; tokw[2 * row + 1] = w2; }
        if (splitk && fr == 0 && F.wave == 0 && stash[lane] != 0u && nfull * NGW + F.vcu < ngrp) {
            const unsigned ee = stash[64 + lane]; const int f1 = (int)(ee >> 8), f2 = (int)(ee & 255u); const unsigned srow = stash[384 + lane];
            const unsigned pos1 = lbase[f1] + stash[128 + lane], pos2 = lbase[f2] + stash[192 + lane];
            list[(size_t)f1 * TT + pos1] = srow; list[(size_t)f2 * TT + pos2] = srow;
            tokslot[2 * srow] = ((unsigned)f1 << 16) | pos1; tokslot[2 * srow + 1] = ((unsigned)f2 << 16) | pos2; tokw[2 * srow] = __uint_as_float(stash[256 + lane]); tokw[2 * srow + 1] = __uint_as_float(stash[320 + lane]); }
        if (!lastrd) { __syncthreads(); if (F.tid < 32) lcnt[F.tid] = 0u; }
    }
    __syncthreads();
}
struct CombBuf { u32x2 x[4], ya[4], yb[4]; };
template <bool YB8> __device__ __forceinline__ void comb_load(CombBuf& b, const bf16_t* xr, const unsigned char* ya, const unsigned char* yb, int lane) {
#pragma unroll
    for (int j = 0; j < 4; ++j) { const int c = 4 * lane + 256 * j; b.x[j] = *(const u32x2*)(xr + c);
        if (YB8) { b.ya[j].x = *(const unsigned*)(ya + c); b.yb[j].x = *(const unsigned*)(yb + c); b.ya[j].y = 0u; b.yb[j].y = 0u; }
        else { b.ya[j] = *(const u32x2*)(ya + 2 * c); b.yb[j] = *(const u32x2*)(yb + 2 * c); } }
}
template <bool LAST, bool DRY, bool YB8> __device__ __forceinline__ void comb_finish(const Frame& F, const CombBuf& b, int l, int row, float wa, float wb, int lane) {
    const int r = modrow(row); const LAS float* g2 = (const LAS float*)F.lds + r * 1024; bf16_t* xr = F.xr_row(row);
    float ss = 0.f; f32x4 v[4];
#pragma unroll
    for (int j = 0; j < 4; ++j) { const int c = 4 * lane + 256 * j; const f32x4 gv = *(const LAS f32x4*)(g2 + c);
        f32x4 y;
        if (YB8) { const f32x2 a0 = __builtin_amdgcn_cvt_pk_f32_fp8((int)b.ya[j].x, false), a1 = __builtin_amdgcn_cvt_pk_f32_fp8((int)b.ya[j].x, true), b0 = __builtin_amdgcn_cvt_pk_f32_fp8((int)b.yb[j].x, false), b1 = __builtin_amdgcn_cvt_pk_f32_fp8((int)b.yb[j].x, true);
            y[0] = wa * a0[0] + wb * b0[0]; y[1] = wa * a0[1] + wb * b0[1]; y[2] = wa * a1[0] + wb * b1[0]; y[3] = wa * a1[1] + wb * b1[1]; }
        else { y[0] = wa * bflo(b.ya[j].x) + wb * bflo(b.yb[j].x); y[1] = wa * bfhi(b.ya[j].x) + wb * bfhi(b.yb[j].x); y[2] = wa * bflo(b.ya[j].y) + wb * bflo(b.yb[j].y); y[3] = wa * bfhi(b.ya[j].y) + wb * bfhi(b.yb[j].y); }
        const f32x4 x1 = (f32x4){bflo(b.x[j].x), bfhi(b.x[j].x), bflo(b.x[j].y), bfhi(b.x[j].y)};
        v[j] = x1 + gv * y;
        if (LAST) { if (!DRY) *(f32x4*)(F.out + (size_t)row * DM + c) = v[j]; }
        else { u32x2 o; o.x = pk2(v[j][0], v[j][1]); o.y = pk2(v[j][2], v[j][3]); *(u32x2*)(xr + c) = DRY ? b.x[j] : o; }
        ss += (v[j][0] * v[j][0] + v[j][1] * v[j][1]) + (v[j][2] * v[j][2] + v[j][3] * v[j][3]); }
    if (!LAST) { const float rms = 1.0f / sqrtf(wave_sum(ss) * (1.f / 1024.f) + EPS); const LAS float* al = (const LAS float*)F.lds + (9 + r) * 1024; const LAS float* bl = al + 9 * 1024; f32x4 h[4];
#pragma unroll
        for (int j = 0; j < 4; ++j) { const int c = 4 * lane + 256 * j; h[j] = (v[j] * rms) * *(const LAS f32x4*)(al + c) + *(const LAS f32x4*)(bl + c); }
        store_row_bf16(F.hx() + (size_t)row * DM, lane, h); }
}
struct CombRec { unsigned sa, sb; float wa, wb; };
__device__ __forceinline__ CombRec comb_records(const Frame& F, int ntok) {
    const int gw = F.vcu * NWAVES + F.wave, NGW = F.G * NWAVES;
    const unsigned* tokslot = (const unsigned*)(F.ws + WS_TOK); const float* tokw = (const float*)(F.ws + WS_TOK + 512 * 1024);
    const int ntot = gw < ntok ? (ntok - gw + NGW - 1) / NGW : 0; const int n = ntot < 64 ? ntot : 64;
    CombRec r{0u, 0u, 0.f, 0.f}; const int mr = gw + F.lane * NGW;
    if (F.lane < n) { r.sa = tokslot[2 * mr]; r.sb = tokslot[2 * mr + 1]; r.wa = tokw[2 * mr]; r.wb = tokw[2 * mr + 1]; }
    return r;
}
template <bool LAST, bool DRY, bool YB8> __device__ __forceinline__ void p_combine(const Frame& F, int l, int ntok, const MoeTab& tb, int tsh, const CombRec* rec = nullptr) {
    const int gw = F.vcu * NWAVES + F.wave, NGW = F.G * NWAVES, lane = F.lane;
    const unsigned char* YB = F.ws + WS_YB;
    const unsigned* tokslot = (const unsigned*)(F.ws + WS_TOK); const float* tokw = (const float*)(F.ws + WS_TOK + 512 * 1024);
    const int ntot = gw < ntok ? (ntok - gw + NGW - 1) / NGW : 0;
#define COMB_TABLES() do { LAS float* tl = (LAS float*)F.lds; const float* g = F.in[I_LN1] + (LAST ? 0 : (l + 1) * 1024); \
        for (int i = F.tid; i < 9 * 1024; i += NTHREADS) { const int r = i >> 10, c = i & 1023; tl[i] = F.mod(l, r, 5)[c]; \
            if (!LAST) { tl[9 * 1024 + i] = g[c] * (1.f + F.mod(l + 1, r, 1)[c]); tl[18 * 1024 + i] = F.mod(l + 1, r, 0)[c]; } } \
        __syncthreads(); } while (0)
    const bool late_tables = NGW <= ntok;
    if (!late_tables) COMB_TABLES();
    for (int base = 0; base < ntot; base += 64) {
    const int n = ntot - base < 64 ? ntot - base : 64;
    unsigned my_sa = 0u, my_sb = 0u; float my_wa = 0.f, my_wb = 0.f;
    { const int mr = gw + (base + lane) * NGW;
      if (lane < n) { unsigned sa, sb; if (rec != nullptr && base == 0) { sa = rec->sa; sb = rec->sb; my_wa = rec->wa; my_wb = rec->wb; } else { sa = tokslot[2 * mr]; sb = tokslot[2 * mr + 1]; my_wa = tokw[2 * mr]; my_wb = tokw[2 * mr + 1]; }
          my_sa = ((unsigned)tb.tile0[sa >> 16] << tsh) + (sa & 0xffffu); my_sb = ((unsigned)tb.tile0[sb >> 16] << tsh) + (sb & 0xffffu); } }
    CombBuf A, B;
#define COMB_LOAD(buf, i) do { const int row_ = gw + (base + (i)) * NGW; const unsigned sa_ = __builtin_amdgcn_readlane(my_sa, (i)), sb_ = __builtin_amdgcn_readlane(my_sb, (i)); \
        comb_load<YB8>(buf, F.xr_row(row_), YB + (size_t)sa_ * (YB8 ? 1024 : 2048), YB + (size_t)sb_ * (YB8 ? 1024 : 2048), lane); } while (0)
#define COMB_FIN(buf, i) do { const float wa_ = __uint_as_float(__builtin_amdgcn_readlane(__float_as_uint(my_wa), (i))), wb_ = __uint_as_float(__builtin_amdgcn_readlane(__float_as_uint(my_wb), (i))); \
        comb_finish<LAST, DRY, YB8>(F, buf, l, gw + (base + (i)) * NGW, wa_, wb_, lane); } while (0)
    COMB_LOAD(A, 0);
    if (late_tables && base == 0) COMB_TABLES();
    for (int i = 0; i < n; i += 2) {
        if (i + 1 < n) COMB_LOAD(B, i + 1);
        COMB_FIN(A, i);
        if (i + 2 < n) COMB_LOAD(A, i + 2);
        if (i + 1 < n) COMB_FIN(B, i + 1);
    }
    }
#undef COMB_LOAD
#undef COMB_FIN
#undef COMB_TABLES
}

__global__ void __launch_bounds__(NTHREADS, 2) fwd_kernel(Params P) {
    extern __shared__ __attribute__((aligned(16))) unsigned char lds_raw[];
    Frame F;
    F.lds = (LAS unsigned char*)lds_raw; F.in = P.in; F.out = P.out; F.ws = P.ws;
    F.tid = threadIdx.x; F.lane = F.tid & 63; F.wave = __builtin_amdgcn_readfirstlane(F.tid >> 6);
    F.G = gridDim.x; { const int bx = blockIdx.x; F.vcu = (F.G % 8 == 0) ? (bx % 8) * (F.G / 8) + bx / 8 : bx; }
    volatile LAS unsigned* misc = (volatile LAS unsigned*)(F.lds + LDS_MISC);
    if (F.tid < 16) misc[F.tid] = 0u;
    __syncthreads();
#if ONE_LAUNCH
    XcdBarrier bar = xcd_barrier_post((unsigned*)(F.ws + WS_CTL) + CW_BAR, misc + 8);
#define GRID_BAR() do { xcd_barrier(bar); } while (0)
#else
#define GRID_BAR() do { } while (0)
#endif
    const int lo = P.ph_lo, hi = P.ph_hi;
#ifndef DRYMASK
#define DRYMASK 0
#endif
#ifndef DRYV
#define DRYV 1
#endif
#ifndef PHMASK
#define PHMASK 0xFFFFFFFFu
#endif
#define IN(k) (((PHMASK >> (k)) & 1u) && lo <= (k) && (k) < hi)
#ifdef PROBE_PH
#define STAMP(k) do { if (blockIdx.x == 0 && F.tid == 0) { const unsigned long long t_ = __builtin_amdgcn_s_memrealtime(); \
        if ((k) == PROBE_PH - 1) { misc[0] = (unsigned)t_; misc[1] = (unsigned)(t_ >> 32); } if ((k) == PROBE_PH) { misc[2] = (unsigned)t_; misc[3] = (unsigned)(t_ >> 32); } } } while (0)
#else
#define STAMP(k) do { } while (0)
#endif
#define SEAM(k) do { if (IN((k) + 1)) GRID_BAR(); STAMP(k); } while (0)
    STAMP(-1);
    bf16_t* HX = F.hx(); bf16_t* Qb = (bf16_t*)(F.ws + WS_Q); bf16_t* KVb = (bf16_t*)(F.ws + WS_KV); bf16_t* Gb = (bf16_t*)(F.ws + WS_G); bf16_t* AO = (bf16_t*)(F.ws + WS_AO);
    bf16_t* HID = (bf16_t*)(F.ws + WS_HID); bf16_t* YB = (bf16_t*)(F.ws + WS_YB);

    if (IN(0)) { Frame Fp = F; asm volatile("" : "+v"(Fp.tid), "+v"(Fp.lane)); p0_prologue(Fp);
        if (misc_in_p0(Fp) && Fp.vcu >= 192) p0_misc<1>(Fp, Fp.vcu - 192, Fp.G - 192);
        SEAM(0); }
    if (IN(1)) { Frame Fp = F; asm volatile("" : "+v"(Fp.tid), "+v"(Fp.lane)); p_norm1_l0(Fp); SEAM(1); }
    if (IN(2)) { Frame Fp = F; asm volatile("" : "+v"(Fp.tid), "+v"(Fp.lane)); SchedDense S{(const bf16_t*)(Fp.ws + WS_WINAB), 1024, TT / 256, 7, 0, 0, Fp.vcu, Fp.G}; EpiInProj<true> E{Qb, KVb, (bf16_t*)(Fp.ws + WS_VN), Gb}; GEMM(Fp, HX, 2048, S, E); SEAM(2); }
    if (IN(3)) { Frame Fp = F; asm volatile("" : "+v"(Fp.tid), "+v"(Fp.lane)); p_conv(Fp, Fp.in[I_KNA]); SEAM(3); }
    if (IN(4)) { Frame Fp = F; asm volatile("" : "+v"(Fp.tid), "+v"(Fp.lane));
#ifdef ATTN_SIMPLE
        attn_simple<0>(Fp);
#else
        attn_fast<0>(Fp, (char*)lds_raw);
#endif
        SEAM(4); }
    if (IN(5)) { Frame Fp = F; asm volatile("" : "+v"(Fp.tid), "+v"(Fp.lane)); SchedDense S{(const bf16_t*)(Fp.ws + WS_WOUTAB), 1024, TX / 256, 4, 0, 0, Fp.vcu, Fp.G}; EpiOutProj<true> E{Fp, 0}; GEMM(Fp, AO, 2048, S, E);
        { SchedDenseH S2{(const bf16_t*)(Fp.ws + WS_WOUTAB), TX, TC / 128, 4, Fp.vcu, Fp.G}; EpiOutProj<true, false, true> E2{Fp, 0, TX}; gemm_fast<true, false, true>(Fp, AO, 2048, S2, E2); }
        SEAM(5); }
    if (IN(6)) { Frame Fp = F; asm volatile("" : "+v"(Fp.tid), "+v"(Fp.lane));
#if (DRYMASK >> 6) & 1
        p_router<DRYV, FP8_G1_L0>(Fp, 0, TT); GRID_BAR();
#endif
        p_router<0, FP8_G1_L0>(Fp, 0, TT); SEAM(6); }
    if (IN(7)) { Frame Fp = F; asm volatile("" : "+v"(Fp.tid), "+v"(Fp.lane)); const MoeTab tb = moe_tables(Fp, 0, (FP8_L0 ? 7 : 8)); SchedMoe S{(const bf16_t*)(Fp.ws + WS_WGU), (size_t)1024 * 1024, (FP8_L0 ? 7 : 8), tb, (const unsigned*)(Fp.ws + WS_LIST), true, Fp.vcu, Fp.G}; EpiMoe1<FP8_G1_L0, FP8_G2_L0, FP8_L0> E{HID}; if constexpr (FP8_L0 && H3) gemm_fp8_h3(Fp, HX, 1024, S, E); else gemm_fast<true, FP8_G1_L0, FP8_L0>(Fp, HX, FP8_G1_L0 ? 1024 : 2048, S, E); SEAM(7); }
    if (IN(8)) { Frame Fp = F; asm volatile("" : "+v"(Fp.tid), "+v"(Fp.lane)); const MoeTab tb = moe_tables_again(Fp, 0, (FP8_L0 ? 7 : 8)); SchedMoe S{(const bf16_t*)(Fp.ws + WS_WD), (size_t)1024 * 512, (FP8_L0 ? 7 : 8), tb, nullptr, false, Fp.vcu, Fp.G}; EpiMoe2<FP8_G2_L0, FP8_L0> E{YB}; if constexpr (FP8_L0 && H3) gemm_fp8_h3(Fp, HID, 512, S, E); else gemm_fast<ALIGN_G2, FP8_G2_L0, FP8_L0>(Fp, HID, FP8_G2_L0 ? 512 : 1024, S, E); SEAM(8); }
    if (IN(9)) { Frame Fp = F; asm volatile("" : "+v"(Fp.tid), "+v"(Fp.lane)); const CombRec rec = comb_records(Fp, TT); const MoeTab tb = moe_tables_again(Fp, 0, (FP8_L0 ? 7 : 8));
#if (DRYMASK >> 9) & 1
        p_combine<false, true, FP8_L0 && H3>(Fp, 0, TT, tb, FP8_L0 ? 7 : 8); GRID_BAR();
#endif
        p_combine<false, false, FP8_L0 && H3>(Fp, 0, TT, tb, FP8_L0 ? 7 : 8, &rec); SEAM(9); }
    if (IN(10)) { Frame Fp = F; asm volatile("" : "+v"(Fp.tid), "+v"(Fp.lane)); SchedDense S{(const bf16_t*)(Fp.ws + WS_WINCD), 1024, TX / 256, 5, TC / 256, 2, Fp.vcu, Fp.G}; EpiInProj<false> E{Qb, KVb, (bf16_t*)(Fp.ws + WS_VN), Gb}; GEMM(Fp, HX, 2048, S, E); SEAM(10); }
    if (IN(11)) { Frame Fp = F; asm volatile("" : "+v"(Fp.tid), "+v"(Fp.lane)); p_pool(Fp, Fp.in[I_KNC]); SEAM(11); }
    if (IN(12)) { Frame Fp = F; asm volatile("" : "+v"(Fp.tid), "+v"(Fp.lane));
#ifdef ATTN_SIMPLE
        attn_simple<1>(Fp);
#else
        attn_fast<1>(Fp, (char*)lds_raw);
#endif
        SEAM(12); }
    if (IN(13)) { Frame Fp = F; asm volatile("" : "+v"(Fp.tid), "+v"(Fp.lane)); SchedDense S{(const bf16_t*)(Fp.ws + WS_WOUTCD), 1024, TX / 256, 4, 0, 0, Fp.vcu, Fp.G};
#if (DRYMASK >> 13) & 1
        { EpiOutProj<false, true> Ed{Fp, 1}; GEMMO(Fp, AO, 2048, S, Ed); GRID_BAR(); }
#endif
        EpiOutProj<false> E{Fp, 1}; GEMM(Fp, AO, 2048, S, E); SEAM(13); }
    if (IN(14)) { Frame Fp = F; asm volatile("" : "+v"(Fp.tid), "+v"(Fp.lane));
#if (DRYMASK >> 14) & 1
        p_router<DRYV, FP8_G1_L1>(Fp, 1, TX); GRID_BAR();
#endif
        p_router<0, FP8_G1_L1>(Fp, 1, TX); SEAM(14); }
    if (IN(15)) { Frame Fp = F; asm volatile("" : "+v"(Fp.tid), "+v"(Fp.lane)); const MoeTab tb = moe_tables(Fp, 1, (FP8_L1 ? 7 : 8)); SchedMoe S{(const bf16_t*)(Fp.ws + WS_WGU) + (size_t)32 * 1024 * 1024, (size_t)1024 * 1024, (FP8_L1 ? 7 : 8), tb, (const unsigned*)(Fp.ws + WS_LIST), true, Fp.vcu, Fp.G}; EpiMoe1<FP8_G1_L1, FP8_G2_L1, FP8_L1> E{HID}; if constexpr (FP8_L1 && H3) gemm_fp8_h3(Fp, HX, 1024, S, E); else gemm_fast<true, FP8_G1_L1, FP8_L1>(Fp, HX, FP8_G1_L1 ? 1024 : 2048, S, E); SEAM(15); }
    if (IN(16)) { Frame Fp = F; asm volatile("" : "+v"(Fp.tid), "+v"(Fp.lane)); const MoeTab tb = moe_tables_again(Fp, 1, (FP8_L1 ? 7 : 8)); SchedMoe S{(const bf16_t*)(Fp.ws + WS_WD) + (size_t)32 * 1024 * 512, (size_t)1024 * 512, (FP8_L1 ? 7 : 8), tb, nullptr, false, Fp.vcu, Fp.G}; EpiMoe2<FP8_G2_L1, FP8_L1> E{YB}; if constexpr (FP8_L1 && H3) gemm_fp8_h3(Fp, HID, 512, S, E); else gemm_fast<ALIGN_G2, FP8_G2_L1, FP8_L1>(Fp, HID, FP8_G2_L1 ? 512 : 1024, S, E); SEAM(16); }
    if (IN(17)) { Frame Fp = F; asm volatile("" : "+v"(Fp.tid), "+v"(Fp.lane)); const CombRec rec = comb_records(Fp, TX); const MoeTab tb = moe_tables_again(Fp, 1, (FP8_L1 ? 7 : 8));
#if (DRYMASK >> 17) & 1
        p_combine<true, true, FP8_L1 && H3>(Fp, 1, TX, tb, FP8_L1 ? 7 : 8); GRID_BAR();
#endif
        p_combine<true, false, FP8_L1 && H3>(Fp, 1, TX, tb, FP8_L1 ? 7 : 8, &rec); }
#ifdef PROBE_PH
    STAMP(NPH - 1);
    if (blockIdx.x == 0 && F.tid == 0) { const unsigned long long t0 = ((unsigned long long)misc[1] << 32) | misc[0], t1 = ((unsigned long long)misc[3] << 32) | misc[2];
        const unsigned long long te = __builtin_amdgcn_s_memrealtime(), span = (t1 - t0) * 16ull;
        while (__builtin_amdgcn_s_memrealtime() - te < span) __builtin_amdgcn_s_sleep(32); }
#endif
#undef IN
#undef SEAM
}

extern "C" void kernel_launch(void* const* d_in, const int* in_sizes, int n_in, void* d_out, int out_size, void* d_ws, size_t ws_size, hipStream_t stream) {
    static int grid = 0;
    if (grid == 0) {
        if (n_in != 30 || out_size != TX * DM || ws_size < WS_END) { fprintf(stderr, "kernel_launch: unexpected shapes (n_in %d out %d ws %zu)\n", n_in, out_size, ws_size); grid = -1; return; }
        int dev = 0, cus = 0;
        if (hipGetDevice(&dev) != hipSuccess || hipDeviceGetAttribute(&cus, hipDeviceAttributeMultiprocessorCount, dev) != hipSuccess) { grid = -1; return; }
        if (hipFuncSetAttribute((const void*)fwd_kernel, hipFuncAttributeMaxDynamicSharedMemorySize, LDS_BYTES) != hipSuccess) { fprintf(stderr, "kernel_launch: hipFuncSetAttribute failed\n"); grid = -1; return; }
        int per_cu = 0;
        if (hipOccupancyMaxActiveBlocksPerMultiprocessor(&per_cu, (const void*)fwd_kernel, NTHREADS, LDS_BYTES) != hipSuccess || per_cu < 1) { fprintf(stderr, "kernel_launch: occupancy query says %d\n", per_cu); }
        (void)hipGetLastError();
        grid = cus;
    }
    if (grid < 0) return;
    (void)hipMemsetAsync((char*)d_ws + WS_CTL, 0, CTL_ZERO_BYTES, stream);
    Params p{};
    for (int i = 0; i < 30; ++i) p.in[i] = (const float*)d_in[i];
    p.out = (float*)d_out; p.ws = (unsigned char*)d_ws;
#if ONE_LAUNCH
    p.ph_lo = 0; p.ph_hi = NPH;
    hipLaunchKernelGGL(fwd_kernel, dim3(grid), dim3(NTHREADS), LDS_BYTES, stream, p);
#else
    for (int ph = 0; ph < NPH; ++ph) { p.ph_lo = ph; p.ph_hi = ph + 1; hipLaunchKernelGGL(fwd_kernel, dim3(grid), dim3(NTHREADS), LDS_BYTES, stream, p); }
#endif
}
```
